# Optimizing an MI355X kernel written in HIP

```python
import math
import jax, jax.numpy as jnp
from jax import lax
import numpy as np

D_MODEL = 1024
BATCH = 2
SEQ = 8192
DEPTH = 4

N_A_LAYERS = DEPTH // 2
N_B_LAYERS = DEPTH - N_A_LAYERS
N_DENSE_LAYERS = (DEPTH + 1) // 2
N_MOE_LAYERS = DEPTH // 2

MLA_HEADS = 8
MLA_NOPE = 64
MLA_ROPE = 32
MLA_V = 64
MLA_QK = MLA_NOPE + MLA_ROPE
MLA_Q_LORA = 384
MLA_KV_LORA = 256
ROPE_BASE = 10000.0

SB_HEADS = 16
SB_KV_HEADS = 4
SB_GROUP = SB_HEADS // SB_KV_HEADS
SB_HEAD_DIM = 64

D_FF = 2816
N_EXPERTS = 8
TOP_K = 2
D_FF_EXPERT = 2816
PLE_DIM = 256
Q_BLOCK = 128
EPS = 1e-6

kernel_name = "yoco_mla_stickbreaking_moe_ple"


def rmsnorm(x, g):
    xf = x.astype(jnp.float32)
    y = xf * lax.rsqrt(jnp.mean(xf * xf, axis=-1, keepdims=True) + EPS) * g.astype(jnp.float32)
    return y.astype(x.dtype)


def rope(x, cos, sin):
    half = x.shape[-1] // 2
    x1, x2 = x[..., :half], x[..., half:]
    return jnp.concatenate([x1 * cos - x2 * sin, x2 * cos + x1 * sin], axis=-1)


def block_sweep(fn, q):
    b, s = q.shape[0], q.shape[1]
    nb = s // Q_BLOCK
    qb = jnp.moveaxis(q.reshape((b, nb, Q_BLOCK) + q.shape[2:]), 1, 0)
    out = lax.map(fn, (qb, jnp.arange(nb)))
    out = jnp.moveaxis(out, 0, 1)
    return out.reshape((b, s) + out.shape[3:])


def mla_attend(q, k, v):
    scale = 1.0 / math.sqrt(MLA_QK)
    key_idx = jnp.arange(k.shape[1])

    def blk(args):
        qb, i = args
        qpos = i * Q_BLOCK + jnp.arange(Q_BLOCK)
        s = jnp.einsum('bqhd,bshd->bhqs', qb, k) * scale
        mask = key_idx[None, :] <= qpos[:, None]
        w = jax.nn.softmax(jnp.where(mask, s, -jnp.inf), axis=-1)
        return jnp.einsum('bhqs,bshd->bqhd', w, v)

    return block_sweep(blk, q)


def stick_breaking_attend(q, k, v):
    scale = 1.0 / math.sqrt(SB_HEAD_DIM)
    key_idx = jnp.arange(k.shape[1])

    def blk(args):
        qb, i = args
        qpos = i * Q_BLOCK + jnp.arange(Q_BLOCK)
        z = jnp.einsum('bqkgd,bskd->bkgqs', qb, k) * scale
        mask = key_idx[None, :] < qpos[:, None]
        log_not = jnp.where(mask, jax.nn.log_sigmoid(-z), 0.0)
        rest = lax.cumsum(log_not, axis=4, reverse=True) - log_not
        a = jnp.where(mask, jnp.exp(jax.nn.log_sigmoid(z) + rest), 0.0)
        return jnp.einsum('bkgqs,bskd->bqkgd', a, v)

    return block_sweep(blk, q)


def mla_mixer(h, cos, sin, norm_attn, w_in, norm_q_lat, norm_kv_lat, w_q_up, w_kv_up,
              qk_norm_q, qk_norm_k, w_out):
    b, s, _ = h.shape
    hn = rmsnorm(h, norm_attn)
    a = hn @ w_in
    c_q = rmsnorm(a[..., :MLA_Q_LORA], norm_q_lat)
    c_kv = rmsnorm(a[..., MLA_Q_LORA:MLA_Q_LORA + MLA_KV_LORA], norm_kv_lat)
    k_pe = a[..., MLA_Q_LORA + MLA_KV_LORA:]
    q = (c_q @ w_q_up).reshape(b, s, MLA_HEADS, MLA_QK)
    kv = (c_kv @ w_kv_up).reshape(b, s, MLA_HEADS, MLA_NOPE + MLA_V)
    k_nope, v = kv[..., :MLA_NOPE], kv[..., MLA_NOPE:]
    k = jnp.concatenate([k_nope, jnp.broadcast_to(k_pe[:, :, None, :], (b, s, MLA_HEADS, MLA_ROPE))], axis=-1)
    q = rmsnorm(q, qk_norm_q).astype(jnp.float32)
    k = rmsnorm(k, qk_norm_k).astype(jnp.float32)
    c4, s4 = cos[:, :, None, :], sin[:, :, None, :]
    q = jnp.concatenate([q[..., :MLA_NOPE], rope(q[..., MLA_NOPE:], c4, s4)], axis=-1)
    k = jnp.concatenate([k[..., :MLA_NOPE], rope(k[..., MLA_NOPE:], c4, s4)], axis=-1)
    o = mla_attend(q, k, v.astype(jnp.float32))
    return o.reshape(b, s, MLA_HEADS * MLA_V).astype(h.dtype) @ w_out


def sb_mixer(h, shared_k, shared_v, norm_attn, w_q, w_o):
    b, s, _ = h.shape
    hn = rmsnorm(h, norm_attn)
    q = (hn @ w_q).reshape(b, s, SB_KV_HEADS, SB_GROUP, SB_HEAD_DIM).astype(jnp.float32)
    o = stick_breaking_attend(q, shared_k, shared_v)
    return o.reshape(b, s, SB_HEADS * SB_HEAD_DIM).astype(h.dtype) @ w_o


def dense_swiglu(x, w_gu, w_down):
    gu = x @ w_gu
    g, u = gu[..., :D_FF], gu[..., D_FF:]
    return (jax.nn.silu(g) * u) @ w_down


def moe_swiglu(x, w_router, w_gu, w_down):
    b, s, d = x.shape
    xt = x.reshape(b * s, d)
    logits = (xt @ w_router).astype(jnp.float32)
    top_vals, top_idx = lax.top_k(logits, TOP_K)
    gates = jax.nn.softmax(top_vals, axis=-1)
    combine = jnp.sum(jax.nn.one_hot(top_idx, N_EXPERTS, dtype=jnp.float32) * gates[..., None], axis=1)
    y = jnp.zeros((b * s, d), jnp.float32)
    for e in range(N_EXPERTS):
        gu = xt @ w_gu[e]
        g, u = gu[..., :D_FF_EXPERT], gu[..., D_FF_EXPERT:]
        y = y + combine[:, e:e + 1] * ((jax.nn.silu(g) * u) @ w_down[e]).astype(jnp.float32)
    return y.astype(x.dtype).reshape(b, s, d)


def setup_inputs(seed: int = 0) -> dict:
    key = jax.random.key(seed)
    ks = iter(jax.random.split(key, 40))

    def w(shape, fan_in):
        return jax.random.normal(next(ks), shape, jnp.float32) * (fan_in ** -0.5)

    def gain(shape):
        return 1.0 + 0.02 * jax.random.normal(next(ks), shape, jnp.float32)

    x = jax.random.normal(next(ks), (BATCH, SEQ, D_MODEL), jnp.float32)
    p = jax.random.normal(next(ks), (DEPTH, BATCH, SEQ, PLE_DIM), jnp.float32)
    offset = jax.random.randint(next(ks), (BATCH, 1), 0, 1024, dtype=jnp.int32)
    positions = (offset + jnp.arange(SEQ, dtype=jnp.int32)[None, :]).astype(jnp.int32)
    a_in = MLA_Q_LORA + MLA_KV_LORA + MLA_ROPE
    return {
        "x": x,
        "p": p,
        "positions": positions,
        "norm_attn_a": gain((N_A_LAYERS, D_MODEL)),
        "w_a_in": w((N_A_LAYERS, D_MODEL, a_in), D_MODEL),
        "norm_q_lat": gain((N_A_LAYERS, MLA_Q_LORA)),
        "norm_kv_lat": gain((N_A_LAYERS, MLA_KV_LORA)),
        "w_q_up": w((N_A_LAYERS, MLA_Q_LORA, MLA_HEADS * MLA_QK), MLA_Q_LORA),
        "w_kv_up": w((N_A_LAYERS, MLA_KV_LORA, MLA_HEADS * (MLA_NOPE + MLA_V)), MLA_KV_LORA),
        "qk_norm_q": gain((N_A_LAYERS, MLA_QK)),
        "qk_norm_k": gain((N_A_LAYERS, MLA_QK)),
        "w_a_out": w((N_A_LAYERS, MLA_HEADS * MLA_V, D_MODEL), MLA_HEADS * MLA_V),
        "norm_kv_shared": gain((D_MODEL,)),
        "w_kv_shared": w((D_MODEL, 2 * SB_KV_HEADS * SB_HEAD_DIM), D_MODEL),
        "norm_attn_b": gain((N_B_LAYERS, D_MODEL)),
        "w_q_b": w((N_B_LAYERS, D_MODEL, SB_HEADS * SB_HEAD_DIM), D_MODEL),
        "w_o_b": w((N_B_LAYERS, SB_HEADS * SB_HEAD_DIM, D_MODEL), SB_HEADS * SB_HEAD_DIM),
        "norm_ffn": gain((DEPTH, D_MODEL)),
        "w_ffn_gu": w((N_DENSE_LAYERS, D_MODEL, 2 * D_FF), D_MODEL),
        "w_ffn_down": w((N_DENSE_LAYERS, D_FF, D_MODEL), D_FF),
        "w_router": w((N_MOE_LAYERS, D_MODEL, N_EXPERTS), D_MODEL),
        "w_exp_gu": w((N_MOE_LAYERS, N_EXPERTS, D_MODEL, 2 * D_FF_EXPERT), D_MODEL),
        "w_exp_down": w((N_MOE_LAYERS, N_EXPERTS, D_FF_EXPERT, D_MODEL), D_FF_EXPERT),
        "norm_ple": gain((DEPTH, D_MODEL)),
        "w_ple_gate": w((DEPTH, D_MODEL, D_MODEL), D_MODEL),
        "w_ple_up": w((DEPTH, PLE_DIM, D_MODEL), PLE_DIM),
    }


def reference(x, p, positions, norm_attn_a, w_a_in, norm_q_lat, norm_kv_lat, w_q_up, w_kv_up,
              qk_norm_q, qk_norm_k, w_a_out, norm_kv_shared, w_kv_shared, norm_attn_b, w_q_b, w_o_b,
              norm_ffn, w_ffn_gu, w_ffn_down, w_router, w_exp_gu, w_exp_down,
              norm_ple, w_ple_gate, w_ple_up):
    b, s, _ = x.shape
    half = MLA_ROPE // 2
    inv_freq = jnp.exp(-math.log(ROPE_BASE) * jnp.arange(half, dtype=jnp.float32) / half)
    ang = positions.astype(jnp.float32)[..., None] * inv_freq
    cos, sin = jnp.cos(ang), jnp.sin(ang)

    h = x
    shared_k = None
    shared_v = None
    for i in range(DEPTH):
        if i < N_A_LAYERS:
            h = h + mla_mixer(h, cos, sin, norm_attn_a[i], w_a_in[i], norm_q_lat[i], norm_kv_lat[i],
                              w_q_up[i], w_kv_up[i], qk_norm_q[i], qk_norm_k[i], w_a_out[i])
        else:
            j = i - N_A_LAYERS
            h = h + sb_mixer(h, shared_k, shared_v, norm_attn_b[j], w_q_b[j], w_o_b[j])
        hn = rmsnorm(h, norm_ffn[i])
        if i % 2 == 0:
            h = h + dense_swiglu(hn, w_ffn_gu[i // 2], w_ffn_down[i // 2])
        else:
            h = h + moe_swiglu(hn, w_router[i // 2], w_exp_gu[i // 2], w_exp_down[i // 2])
        gate = jax.nn.sigmoid(rmsnorm(h, norm_ple[i]) @ w_ple_gate[i])
        h = h + gate * (p[i].astype(h.dtype) @ w_ple_up[i])
        if i == N_A_LAYERS - 1:
            kv = (rmsnorm(h, norm_kv_shared) @ w_kv_shared).reshape(b, s, 2, SB_KV_HEADS, SB_HEAD_DIM)
            shared_k = kv[:, :, 0].astype(jnp.float32)
            shared_v = kv[:, :, 1].astype(jnp.float32)
    return h
```

```cpp
#include <hip/hip_runtime.h>
#include <cstdio>
#include <cstdint>
#include <cmath>
namespace orc {
constexpr int M = 16384, DM = 1024, SEQ = 8192;

__device__ __forceinline__ float wsum(float v) {
#pragma unroll
    for (int o = 1; o < 64; o <<= 1) v += __shfl_xor(v, o);
    return v;
}
__global__ void __launch_bounds__(256) k_rmsnorm(const float* in, int ld_in, const float* gain, float* out, int ld_out, int D, int R) {
    const int row = blockIdx.x * 4 + (threadIdx.x >> 6), lane = threadIdx.x & 63;
    if (row >= R) return;
    const float* x = in + (size_t)row * ld_in;
    float s = 0.f;
    for (int d = lane; d < D; d += 64) { const float v = x[d]; s += v * v; }
    s = wsum(s);
    const float r = 1.0f / sqrtf(s / (float)D + 1e-6f);
    float* o = out + (size_t)row * ld_out;
    for (int d = lane; d < D; d += 64) o[d] = x[d] * r * gain[d];
}

template <int MODE>
__global__ void __launch_bounds__(256) k_gemm(const float* A, int lda, const float* W, int ldw, float* C, int ldc, int Mrows, int N, int K,
                                              const int* rowlist, const int* nrows_ptr, const float* rowscale) {
    __shared__ float As[16][68];
    __shared__ float Ws[16][68];
    __shared__ float Us[16][68];
    const int nrows = nrows_ptr ? *nrows_ptr : Mrows;
    const int m0 = blockIdx.y * 64, n0 = blockIdx.x * 64;
    if (m0 >= nrows) return;
    const int tid = threadIdx.x, tx = tid & 15, ty = tid >> 4;
    float acc[4][4], acu[4][4];
#pragma unroll
    for (int i = 0; i < 4; ++i)
#pragma unroll
        for (int j = 0; j < 4; ++j) { acc[i][j] = 0.f; acu[i][j] = 0.f; }
    const int ar = tid >> 2, ak = (tid & 3) * 4;
    int arow = m0 + ar; bool avalid = arow < nrows;
    if (MODE == 2 && rowlist && avalid) arow = rowlist[arow];
    const float* ap = A + (size_t)(avalid ? arow : 0) * lda;
    const int wk = tid >> 4, wn = (tid & 15) * 4;
    for (int k0 = 0; k0 < K; k0 += 16) {
#pragma unroll
        for (int j = 0; j < 4; ++j) As[ak + j][ar] = avalid ? ap[k0 + ak + j] : 0.f;
#pragma unroll
        for (int j = 0; j < 4; ++j) { const int n = n0 + wn + j; Ws[wk][wn + j] = (n < N) ? W[(size_t)(k0 + wk) * ldw + n] : 0.f;
            if (MODE == 2) Us[wk][wn + j] = (n < N) ? W[(size_t)(k0 + wk) * ldw + n + N] : 0.f; }
        __syncthreads();
#pragma unroll
        for (int kk = 0; kk < 16; ++kk) {
            float a[4], w[4], u[4];
#pragma unroll
            for (int i = 0; i < 4; ++i) a[i] = As[kk][ty * 4 + i];
#pragma unroll
            for (int j = 0; j < 4; ++j) { w[j] = Ws[kk][tx * 4 + j]; if (MODE == 2) u[j] = Us[kk][tx * 4 + j]; }
#pragma unroll
            for (int i = 0; i < 4; ++i)
#pragma unroll
                for (int j = 0; j < 4; ++j) { acc[i][j] += a[i] * w[j]; if (MODE == 2) acu[i][j] += a[i] * u[j]; }
        }
        __syncthreads();
    }
#pragma unroll
    for (int i = 0; i < 4; ++i) {
        const int m = m0 + ty * 4 + i; if (m >= nrows) continue;
        int crow = m; float sc = 1.f;
        if (MODE == 1 && rowlist) { crow = rowlist[m]; sc = rowscale[m]; }
#pragma unroll
        for (int j = 0; j < 4; ++j) { const int n = n0 + tx * 4 + j; if (n >= N) continue;
            float* c = C + (size_t)crow * ldc + n;
            if (MODE == 0) *c = acc[i][j];
            else if (MODE == 1) *c += sc * acc[i][j];
            else { const float g = acc[i][j]; *c = (g / (1.f + expf(-g))) * acu[i][j]; }
        }
    }
}

__global__ void k_rope_tab(const int* pos, float* cs) {
    const int i = blockIdx.x * blockDim.x + threadIdx.x; if (i >= M * 16) return;
    const int row = i >> 4, f = i & 15;
    const double inv = exp(-log(10000.0) * (double)f / 16.0);
    const float invf = (float)inv;
    const double ang = (double)((float)pos[row] * invf);
    const double rev = ang * 0.15915494309189535;
    const double fr = rev - rint(rev);
    const float a = (float)(fr * 6.283185307179586);
    cs[(size_t)row * 32 + f] = cosf(a); cs[(size_t)row * 32 + 16 + f] = sinf(a);
}
__global__ void k_qkprep(const float* Qr  , const float* KVr  , const float* A  , const float* cs,
                         const float* gq, const float* gk, float* Qn  , float* Kn  ) {
    const int i = blockIdx.x * blockDim.x + threadIdx.x; if (i >= M * 8) return;
    const int row = i >> 3, h = i & 7;
    const float* c = cs + (size_t)row * 32;
    for (int which = 0; which < 2; ++which) {
        float s = 0.f;
        for (int d = 0; d < 96; ++d) { const float v = which == 0 ? Qr[(size_t)row * 768 + h * 96 + d] : (d < 64 ? KVr[(size_t)row * 1024 + h * 128 + d] : A[(size_t)row * 672 + 640 + d - 64]); s += v * v; }
        const float r = 1.0f / sqrtf(s / 96.f + 1e-6f);
        const float* g = which == 0 ? gq : gk; float* out = (which == 0 ? Qn : Kn) + (size_t)row * 768 + h * 96;
        for (int d = 0; d < 64; ++d) { const float v = which == 0 ? Qr[(size_t)row * 768 + h * 96 + d] : KVr[(size_t)row * 1024 + h * 128 + d]; out[d] = v * r * g[d]; }
        for (int f = 0; f < 16; ++f) {
            const float v1 = (which == 0 ? Qr[(size_t)row * 768 + h * 96 + 64 + f] : A[(size_t)row * 672 + 640 + f]) * r * g[64 + f];
            const float v2 = (which == 0 ? Qr[(size_t)row * 768 + h * 96 + 80 + f] : A[(size_t)row * 672 + 640 + 16 + f]) * r * g[80 + f];
            out[64 + f] = v1 * c[f] - v2 * c[16 + f]; out[80 + f] = v2 * c[f] + v1 * c[16 + f];
        }
    }
}
__global__ void __launch_bounds__(128) k_mla_attn(const float* Qn, const float* Kn, const float* KVr, float* O  ) {
    __shared__ float Ks[16][96];
    __shared__ float Vs[16][64];
    const int qb = blockIdx.x, h = blockIdx.y, b = blockIdx.z, tid = threadIdx.x;
    const int t = qb * 128 + tid; const size_t row = (size_t)b * SEQ + t;
    float q[96], o[64];
    const float scale = 0.10206207261596577f;
#pragma unroll
    for (int d = 0; d < 96; ++d) q[d] = Qn[row * 768 + h * 96 + d] * scale;
#pragma unroll
    for (int d = 0; d < 64; ++d) o[d] = 0.f;
    float m = -1e30f, l = 0.f;
    const int kend = qb * 128 + 128;
    for (int k0 = 0; k0 < kend; k0 += 16) {
        __syncthreads();
        for (int i = tid; i < 16 * 96; i += 128) { const int j = i / 96, d = i % 96; Ks[j][d] = Kn[((size_t)b * SEQ + k0 + j) * 768 + h * 96 + d]; }
        for (int i = tid; i < 16 * 64; i += 128) { const int j = i >> 6, d = i & 63; Vs[j][d] = KVr[((size_t)b * SEQ + k0 + j) * 1024 + h * 128 + 64 + d]; }
        __syncthreads();
        if (k0 > t) continue;
        float s[16]; float mx = m;
#pragma unroll
        for (int j = 0; j < 16; ++j) { float a = 0.f;
#pragma unroll
            for (int d = 0; d < 96; ++d) a += q[d] * Ks[j][d];
            s[j] = (k0 + j <= t) ? a : -1e30f; mx = fmaxf(mx, s[j]); }
        const float alpha = expf(m - mx); m = mx; l *= alpha;
#pragma unroll
        for (int d = 0; d < 64; ++d) o[d] *= alpha;
#pragma unroll
        for (int j = 0; j < 16; ++j) { const float p = (k0 + j <= t) ? expf(s[j] - m) : 0.f; l += p;
#pragma unroll
            for (int d = 0; d < 64; ++d) o[d] += p * Vs[j][d]; }
    }
    const float il = 1.f / l;
#pragma unroll
    for (int d = 0; d < 64; ++d) O[row * 512 + h * 64 + d] = o[d] * il;
}
__global__ void __launch_bounds__(64) k_sb_attn(const float* Q  , const float* KV, float* O  ) {
    __shared__ float Ks[64][64];
    __shared__ float Vs[64][64];
    const int qb = blockIdx.x, h = blockIdx.y, b = blockIdx.z, tid = threadIdx.x, kh = h >> 2;
    const int t = qb * 64 + tid; const size_t row = (size_t)b * SEQ + t;
    float q[64], o[64];
#pragma unroll
    for (int d = 0; d < 64; ++d) { q[d] = Q[row * 1024 + h * 64 + d] * 0.125f; o[d] = 0.f; }
    float R = 0.f;
    for (int c = qb; c >= 0; --c) {
        __syncthreads();
        for (int i = tid; i < 64 * 64; i += 64) { const int j = i >> 6, d = i & 63; const size_t kr = (size_t)b * SEQ + c * 64 + j;
            Ks[j][d] = KV[kr * 512 + kh * 64 + d]; Vs[j][d] = KV[kr * 512 + 256 + kh * 64 + d]; }
        __syncthreads();
        for (int j = 63; j >= 0; --j) {
            const int s = c * 64 + j; if (s >= t) continue;
            float z = 0.f;
#pragma unroll
            for (int d = 0; d < 64; ++d) z += q[d] * Ks[j][d];
            const float sp = fmaxf(z, 0.f) + log1pf(expf(-fabsf(z)));
            const float a = expf((z - sp) + R);
            R -= sp;
#pragma unroll
            for (int d = 0; d < 64; ++d) o[d] += a * Vs[j][d];
        }
        if (__syncthreads_and(R < -110.f)) break;
    }
#pragma unroll
    for (int d = 0; d < 64; ++d) O[row * 1024 + h * 64 + d] = o[d];
}
__global__ void k_route(const float* xn, const float* wr  , int* te, float* tg) {
    const int tok = blockIdx.x * blockDim.x + threadIdx.x; if (tok >= M) return;
    float lg[8];
#pragma unroll
    for (int e = 0; e < 8; ++e) lg[e] = 0.f;
    for (int k = 0; k < 1024; ++k) { const float v = xn[(size_t)tok * 1024 + k];
#pragma unroll
        for (int e = 0; e < 8; ++e) lg[e] += v * wr[k * 8 + e]; }
    int e1 = 0; float v1 = lg[0];
#pragma unroll
    for (int e = 1; e < 8; ++e) if (lg[e] > v1) { v1 = lg[e]; e1 = e; }
    int e2 = -1; float v2 = -3.0e38f;
#pragma unroll
    for (int e = 0; e < 8; ++e) if (e != e1 && lg[e] > v2) { v2 = lg[e]; e2 = e; }
    const float p2 = expf(v2 - v1), g1 = 1.f / (1.f + p2), g2 = p2 / (1.f + p2);
    te[tok] = e1 | (e2 << 8); tg[tok * 2] = g1; tg[tok * 2 + 1] = g2;
}
__global__ void k_compact(const int* te, const float* tg, int* list, float* gl, int* cnt) {
    const int e = threadIdx.x; int n = 0;
    for (int tok = 0; tok < M; ++tok) { const int v = te[tok]; const int e1 = v & 255, e2 = v >> 8;
        if (e1 == e) { list[e * M + n] = tok; gl[e * M + n] = tg[tok * 2]; ++n; }
        else if (e2 == e) { list[e * M + n] = tok; gl[e * M + n] = tg[tok * 2 + 1]; ++n; } }
    cnt[e] = n;
}
__global__ void k_ple_apply(float* h, const float* gate, const float* up) {
    const size_t i = (size_t)blockIdx.x * blockDim.x + threadIdx.x; if (i >= (size_t)M * DM) return;
    h[i] += (1.f / (1.f + expf(-gate[i]))) * up[i];
}
__global__ void k_copy(const float* a, float* b, size_t n) { const size_t i = (size_t)blockIdx.x * blockDim.x + threadIdx.x; if (i < n) b[i] = a[i]; }

struct Bufs { float *h, *T1, *T2, *T3, *BIG, *KV, *CS; int* te; float* tg; int* list; float* gl; int* cnt; };

static void gemm0(hipStream_t s, const float* A, int lda, const float* W, int ldw, float* C, int ldc, int Mr, int N, int K) {
    hipLaunchKernelGGL(k_gemm<0>, dim3((N + 63) / 64, Mr / 64), dim3(256), 0, s, A, lda, W, ldw, C, ldc, Mr, N, K, nullptr, nullptr, nullptr); }
static void gemm_acc(hipStream_t s, const float* A, int lda, const float* W, int ldw, float* C, int ldc, int Mr, int N, int K) {
    hipLaunchKernelGGL(k_gemm<1>, dim3((N + 63) / 64, Mr / 64), dim3(256), 0, s, A, lda, W, ldw, C, ldc, Mr, N, K, nullptr, nullptr, nullptr); }
static void rms(hipStream_t s, const float* in, int ldi, const float* g, float* out, int ldo, int D, int R) {
    hipLaunchKernelGGL(k_rmsnorm, dim3((R + 3) / 4), dim3(256), 0, s, in, ldi, g, out, ldo, D, R); }

static void run_part(hipStream_t s, void* const* d_in, const Bufs& B, int i, int part) {
    const float* p = (const float*)d_in[1];
    auto in = [&](int k) { return (const float*)d_in[k]; };
    if (part == 0) {
        if (i < 2) {
            float* A = B.BIG; float* CQ = A + (size_t)M * 672; float* CKV = CQ + (size_t)M * 384; float* Qr = CKV + (size_t)M * 256;
            float* KVr = Qr + (size_t)M * 768; float* Qn = KVr + (size_t)M * 1024; float* Kn = Qn + (size_t)M * 768;
            rms(s, B.h, 1024, in(3) + i * 1024, B.T1, 1024, 1024, M);
            gemm0(s, B.T1, 1024, in(4) + (size_t)i * 1024 * 672, 672, A, 672, M, 672, 1024);
            rms(s, A, 672, in(5) + i * 384, CQ, 384, 384, M);
            rms(s, A + 384, 672, in(6) + i * 256, CKV, 256, 256, M);
            gemm0(s, CQ, 384, in(7) + (size_t)i * 384 * 768, 768, Qr, 768, M, 768, 384);
            gemm0(s, CKV, 256, in(8) + (size_t)i * 256 * 1024, 1024, KVr, 1024, M, 1024, 256);
            hipLaunchKernelGGL(k_qkprep, dim3(M * 8 / 256), dim3(256), 0, s, Qr, KVr, A, B.CS, in(9) + i * 96, in(10) + i * 96, Qn, Kn);
            hipLaunchKernelGGL(k_mla_attn, dim3(SEQ / 128, 8, 2), dim3(128), 0, s, Qn, Kn, KVr, B.T2);
            gemm_acc(s, B.T2, 512, in(11) + (size_t)i * 512 * 1024, 1024, B.h, 1024, M, 1024, 512);
        } else {
            const int j = i - 2;
            rms(s, B.h, 1024, in(14) + j * 1024, B.T1, 1024, 1024, M);
            gemm0(s, B.T1, 1024, in(15) + (size_t)j * 1024 * 1024, 1024, B.T2, 1024, M, 1024, 1024);
            hipLaunchKernelGGL(k_sb_attn, dim3(SEQ / 64, 16, 2), dim3(64), 0, s, B.T2, B.KV, B.T3);
            gemm_acc(s, B.T3, 1024, in(16) + (size_t)j * 1024 * 1024, 1024, B.h, 1024, M, 1024, 1024);
        }
    } else if (part == 1) {
        rms(s, B.h, 1024, in(17) + i * 1024, B.T1, 1024, 1024, M);
        if ((i & 1) == 0) {
            const float* wgu = in(18) + (size_t)(i / 2) * 1024 * 5632; const float* wdn = in(19) + (size_t)(i / 2) * 2816 * 1024;
            hipLaunchKernelGGL(k_gemm<2>, dim3(2816 / 64, M / 64), dim3(256), 0, s, B.T1, 1024, wgu, 5632, B.BIG, 2816, M, 2816, 1024, nullptr, nullptr, nullptr);
            gemm_acc(s, B.BIG, 2816, wdn, 1024, B.h, 1024, M, 1024, 2816);
        } else {
            const int l = i / 2;
            hipLaunchKernelGGL(k_route, dim3(M / 256), dim3(256), 0, s, B.T1, in(20) + (size_t)l * 1024 * 8, B.te, B.tg);
            hipLaunchKernelGGL(k_compact, dim3(1), dim3(8), 0, s, B.te, B.tg, B.list, B.gl, B.cnt);
            for (int e = 0; e < 8; ++e) {
                const float* wgu = in(21) + ((size_t)l * 8 + e) * 1024 * 5632; const float* wdn = in(22) + ((size_t)l * 8 + e) * 2816 * 1024;
                hipLaunchKernelGGL(k_gemm<2>, dim3(2816 / 64, M / 64), dim3(256), 0, s, B.T1, 1024, wgu, 5632, B.BIG, 2816, M, 2816, 1024, B.list + e * M, B.cnt + e, nullptr);
                hipLaunchKernelGGL(k_gemm<1>, dim3(1024 / 64, M / 64), dim3(256), 0, s, B.BIG, 2816, wdn, 1024, B.h, 1024, M, 1024, 2816, B.list + e * M, B.cnt + e, B.gl + e * M);
            }
        }
    } else {
        rms(s, B.h, 1024, in(23) + i * 1024, B.T1, 1024, 1024, M);
        gemm0(s, B.T1, 1024, in(24) + (size_t)i * 1024 * 1024, 1024, B.T2, 1024, M, 1024, 1024);
        gemm0(s, p + (size_t)i * M * 256, 256, in(25) + (size_t)i * 256 * 1024, 1024, B.T3, 1024, M, 1024, 256);
        hipLaunchKernelGGL(k_ple_apply, dim3(M * DM / 256), dim3(256), 0, s, B.h, B.T2, B.T3);
        if (i == 1) {
            rms(s, B.h, 1024, in(12), B.T1, 1024, 1024, M);
            gemm0(s, B.T1, 1024, in(13), 512, B.KV, 512, M, 512, 1024);
        }
    }
}
static void init(hipStream_t s, void* const* d_in, const Bufs& B) {
    hipLaunchKernelGGL(k_copy, dim3(M * DM / 256), dim3(256), 0, s, (const float*)d_in[0], B.h, (size_t)M * DM);
    hipLaunchKernelGGL(k_rope_tab, dim3(M * 16 / 256), dim3(256), 0, s, (const int*)d_in[2], B.CS);
}
}
extern "C" void kernel_launch(void* const* d_in, const int* in_sizes, int n_in, void* d_out, int out_size, void* d_ws, size_t ws_size, hipStream_t stream) {
    constexpr size_t MiB = 1u << 20;
    if (n_in != 26 || ws_size < 600 * MiB) { fprintf(stderr, "kernel_launch: unexpected n_in %d / ws %zu\n", n_in, ws_size); return; }
    unsigned char* ws = (unsigned char*)d_ws;
    orc::Bufs B;
    B.h = (float*)d_out;
    B.T1 = (float*)(ws + 0 * MiB); B.T2 = (float*)(ws + 64 * MiB); B.T3 = (float*)(ws + 128 * MiB); B.BIG = (float*)(ws + 192 * MiB);
    B.KV = (float*)(ws + 490 * MiB); B.CS = (float*)(ws + 522 * MiB);
    B.te = (int*)(ws + 524 * MiB); B.tg = (float*)(ws + 525 * MiB); B.list = (int*)(ws + 526 * MiB); B.gl = (float*)(ws + 527 * MiB); B.cnt = (int*)(ws + 528 * MiB);
    orc::init(stream, d_in, B);
    for (int i = 0; i < 4; ++i) for (int part = 0; part < 3; ++part) orc::run_part(stream, d_in, B, i, part);
}
```

```cpp
#include <hip/hip_runtime.h>
#include <cstdio>
#include <cstdint>
#include <cmath>
#define LAS __attribute__((address_space(3)))
#define GAS __attribute__((address_space(1)))
typedef unsigned short bf16_t;
typedef short bf16x8 __attribute__((ext_vector_type(8)));
typedef float f32x4 __attribute__((ext_vector_type(4)));
typedef float f32x2 __attribute__((ext_vector_type(2)));
typedef float f32x16 __attribute__((ext_vector_type(16)));
typedef unsigned u32x4 __attribute__((ext_vector_type(4)));
typedef unsigned u32x2 __attribute__((ext_vector_type(2)));
typedef short s16x4 __attribute__((ext_vector_type(4)));
typedef __bf16 bf16x2_t __attribute__((ext_vector_type(2)));

constexpr int MT = 16384, DMODEL = 1024, SEQL = 8192;
constexpr float RMS_EPS = 1e-6f;
constexpr float LOG2E = 1.4426950408889634f;

__device__ __forceinline__ unsigned pk_bf16(float lo, float hi) { f32x2 v = {lo, hi}; bf16x2_t b = __builtin_convertvector(v, bf16x2_t); return __builtin_bit_cast(unsigned, b); }
__device__ __forceinline__ float bf_lo(unsigned w) { return __uint_as_float(w << 16); }
__device__ __forceinline__ float bf_hi(unsigned w) { return __uint_as_float(w & 0xffff0000u); }
__device__ __forceinline__ unsigned cvt_pk_bf16(float lo, float hi) { unsigned r; asm volatile("v_cvt_pk_bf16_f32 %0, %1, %2" : "=v"(r) : "v"(lo), "v"(hi)); return r; }
__device__ __forceinline__ u32x4 pack8(const f32x4 a, const f32x4 b) { u32x4 w; w.x = cvt_pk_bf16(a[0], a[1]); w.y = cvt_pk_bf16(a[2], a[3]); w.z = cvt_pk_bf16(b[0], b[1]); w.w = cvt_pk_bf16(b[2], b[3]); return w; }
__device__ __forceinline__ void unpack8(const u32x4 w, f32x4& a, f32x4& b) { a = (f32x4){bf_lo(w.x), bf_hi(w.x), bf_lo(w.y), bf_hi(w.y)}; b = (f32x4){bf_lo(w.z), bf_hi(w.z), bf_lo(w.w), bf_hi(w.w)}; }
__device__ __forceinline__ float fast_rcp(float x) { return __builtin_amdgcn_rcpf(x); }
__device__ __forceinline__ float fast_exp2(float x) { return __builtin_amdgcn_exp2f(x); }
__device__ __forceinline__ float fast_log2(float x) { return __builtin_amdgcn_logf(x); }
__device__ __forceinline__ float sigmoidf_(float x) { return fast_rcp(1.0f + fast_exp2(-x * LOG2E)); }

namespace pg8 {
constexpr int BM = 256, BK = 64, HALF = 128, HTB = HALF * BK * 2, STAGE_BYTES = 8 * HTB, NXCD = 8, WGM = 8;
__host__ __device__ __forceinline__ int lds_byte(int r, int c) { const int st = (r >> 4) * 2 + (c >> 5), rr = r & 15, cc = c & 31, ob = rr * 64 + cc * 2; return st * 1024 + (ob ^ (((ob >> 9) & 1) << 5)); }
__host__ __device__ __forceinline__ void stage_rc(int b, int& R, int& C) { const int st = b / 1024, sb = b % 1024, swz = sb ^ (((sb >> 9) & 1) << 5); R = (st >> 1) * 16 + swz / 64; C = (st & 1) * 32 + (swz % 64) / 2; }
__host__ __device__ __forceinline__ int perm32(int rho) { const int n = rho >> 4, i = rho & 15; return 8 * (i >> 2) + 4 * n + (i & 3); }

struct Unit { int pm, pn; size_t boff; };
struct Gemm { const bf16_t* A; const bf16_t* Bt; int M, N, K; };

struct StaticOrder {
    int nM, nN, nwg, G, c;
    __device__ void init(int M, int N, int G_, int c_) { nM = M / BM; nN = N / BM; nwg = nM * nN; G = G_; c = c_; }
    __device__ bool next(int i, Unit& u) const {
        const long L = (long)i * G + c; if (L >= nwg) return false;
        int wgid = (int)L; { const int q = nwg / NXCD, r = nwg % NXCD, xcd = wgid % NXCD, off = wgid / NXCD; wgid = (xcd < r ? xcd * (q + 1) : r * (q + 1) + (xcd - r) * q) + off; }
        const int nig = WGM * nN, gid = wgid / nig, fm = gid * WGM, gsz = (nM - fm) < WGM ? (nM - fm) : WGM;
        u.pm = fm + ((wgid % nig) % gsz); u.pn = (wgid % nig) / gsz; u.boff = 0; return true;
    }
};
struct GroupOrder {
    int ps[9]; int nN, nwg, G, c; size_t estride;
    __device__ void init(const int* pstart, int N, int G_, int c_, size_t estride_) {
#pragma unroll
        for (int e = 0; e < 9; ++e) ps[e] = __builtin_amdgcn_readfirstlane(pstart[e]);
        nN = N / BM; nwg = ps[8] * nN; G = G_; c = c_; estride = estride_; }
    __device__ void init_dense(int M, int N, int G_, int c_) {
        ps[0] = 0;
#pragma unroll
        for (int e = 1; e < 9; ++e) ps[e] = M / BM;
        nN = N / BM; nwg = ps[8] * nN; G = G_; c = c_; estride = 0; }
    __device__ bool next(int i, Unit& u) const {
        const long L = (long)i * G + c; if (L >= nwg) return false;
        int wgid = (int)L; { const int q = nwg / NXCD, r = nwg % NXCD, xcd = wgid % NXCD, off = wgid / NXCD; wgid = (xcd < r ? xcd * (q + 1) : r * (q + 1) + (xcd - r) * q) + off; }
        int e = 0;
#pragma unroll
        for (int k = 1; k < 8; ++k) if (wgid >= ps[k] * nN) e = k;
        int p0 = ps[0], p1 = ps[1];
#pragma unroll
        for (int k = 1; k < 8; ++k) if (e == k) { p0 = ps[k]; p1 = ps[k + 1]; }
        const int local = wgid - p0 * nN, np = p1 - p0;
        u.pn = local / np; u.pm = p0 + (local % np); u.boff = (size_t)e * estride; return true;
    }
};


__device__ __forceinline__ float sumsq8(const f32x4 a, const f32x4 b) { return ((a[0] * a[0] + a[1] * a[1]) + (a[2] * a[2] + a[3] * a[3])) + ((b[0] * b[0] + b[1] * b[1]) + (b[2] * b[2] + b[3] * b[3])); }
__device__ __forceinline__ float red_fq(float s) { s += __shfl_xor(s, 16); s += __shfl_xor(s, 32); return s; }
struct RowScale {
    const float* p; int mode;
    __device__ __forceinline__ float get(int row, int fq) const {
        if (mode == 0) return 1.0f;
        if (mode == 2) return p[row];
        if (mode == 1) { const f32x4 a = *(const f32x4*)(p + (size_t)row * 16 + 4 * fq); const float s = red_fq((a[0] + a[1]) + (a[2] + a[3])); return 1.0f / sqrtf(s * (1.0f / 1024.0f) + RMS_EPS); }
        if (mode == 3) { const f32x4 a = *(const f32x4*)(p + (size_t)row * 8 + 4 * (fq & 1)); const float s = red_fq(fq < 2 ? (a[0] + a[1]) + (a[2] + a[3]) : 0.f); return 1.0f / sqrtf(s * (1.0f / 384.0f) + RMS_EPS); }
        { const float s = red_fq(p[(size_t)row * 4 + fq]); return 1.0f / sqrtf(s * (1.0f / 256.0f) + RMS_EPS); }
    }
    __device__ __forceinline__ void get8(float (&rsv)[2][4], int row0, int fq) const {
#pragma unroll
        for (int ai = 0; ai < 2; ++ai)
#pragma unroll
            for (int m = 0; m < 4; ++m) rsv[ai][m] = get(row0 + ai * 128 + m * 16, fq);
        asm volatile("" ::: "memory");
    }
};

struct EpiScale {
    static constexpr bool PERM = true, AFTER_DRAIN = false;
    bf16_t* O; int ldc; RowScale rs; float cs;
    __device__ __forceinline__ void operator()(const f32x4 (&acc)[2][2][4][2], const Unit& u, int wr, int wc, int fr, int fq) const {
        const int row0 = u.pm * BM + wr * 64 + fr, col0 = u.pn * BM + wc * 32 + 8 * fq;
        float rsv[2][4]; rs.get8(rsv, row0, fq);
#pragma unroll
        for (int ai = 0; ai < 2; ++ai)
#pragma unroll
            for (int m = 0; m < 4; ++m) { const int row = row0 + ai * HALF + m * 16; const float s = rsv[ai][m] * cs; bf16_t* rowp = O + (size_t)row * ldc + col0;
#pragma unroll
                for (int bj = 0; bj < 2; ++bj) *(u32x4*)(rowp + bj * HALF) = pack8(acc[ai][bj][m][0] * s, acc[ai][bj][m][1] * s); }
    }
};
struct EpiAin {
    static constexpr bool PERM = true, AFTER_DRAIN = false;
    bf16_t* AQ; bf16_t* AKV; float* KPE; float* SSQQ; float* SSQKV; RowScale rs;
    __device__ __forceinline__ void operator()(const f32x4 (&acc)[2][2][4][2], const Unit& u, int wr, int wc, int fr, int fq) const {
        const int row0 = u.pm * BM + wr * 64 + fr, c8 = wc * 32 + 8 * fq;
        float rsv[2][4]; rs.get8(rsv, row0, fq);
#pragma unroll
        for (int ai = 0; ai < 2; ++ai)
#pragma unroll
            for (int m = 0; m < 4; ++m) { const int row = row0 + ai * HALF + m * 16; const float s = rsv[ai][m];
                const f32x4 a0 = acc[ai][0][m][0] * s, a1 = acc[ai][0][m][1] * s, b0 = acc[ai][1][m][0] * s, b1 = acc[ai][1][m][1] * s;
                if (u.pn == 0) {
                    *(u32x4*)(AQ + (size_t)row * 384 + c8) = pack8(a0, a1); *(u32x4*)(AQ + (size_t)row * 384 + 128 + c8) = pack8(b0, b1);
                    const float q = red_fq(sumsq8(a0, a1) + sumsq8(b0, b1)); if (fq == 0) SSQQ[(size_t)row * 8 + wc] = q;
                } else if (u.pn == 1) {
                    *(u32x4*)(AQ + (size_t)row * 384 + 256 + c8) = pack8(a0, a1);
                    const float q = red_fq(sumsq8(a0, a1)); if (fq == 0) SSQQ[(size_t)row * 8 + 4 + wc] = q;
                    if (wc == 0) { *(f32x4*)(KPE + (size_t)row * 32 + 8 * fq) = b0; *(f32x4*)(KPE + (size_t)row * 32 + 8 * fq + 4) = b1; }
                } else {
                    *(u32x4*)(AKV + (size_t)row * 256 + c8) = pack8(a0, a1); *(u32x4*)(AKV + (size_t)row * 256 + 128 + c8) = pack8(b0, b1);
                    const float q = red_fq(sumsq8(a0, a1) + sumsq8(b0, b1)); if (fq == 0) SSQKV[(size_t)row * 4 + wc] = q;
                } }
    }
};
struct EpiSwiglu {
    static constexpr bool PERM = true, AFTER_DRAIN = false;
    bf16_t* HID; RowScale rs;
    __device__ __forceinline__ void operator()(const f32x4 (&acc)[2][2][4][2], const Unit& u, int wr, int wc, int fr, int fq) const {
        const int row0 = u.pm * BM + wr * 64 + fr, col0 = u.pn * 128 + wc * 32 + 8 * fq;
        float rsv[2][4]; rs.get8(rsv, row0, fq);
#pragma unroll
        for (int ai = 0; ai < 2; ++ai)
#pragma unroll
            for (int m = 0; m < 4; ++m) { const int row = row0 + ai * HALF + m * 16; const float s = rsv[ai][m];
                f32x4 o[2];
#pragma unroll
                for (int n = 0; n < 2; ++n) { const f32x4 g = acc[ai][0][m][n] * s, up = acc[ai][1][m][n] * s;
#pragma unroll
                    for (int j = 0; j < 4; ++j) o[n][j] = g[j] * sigmoidf_(g[j]) * up[j]; }
                *(u32x4*)(HID + (size_t)row * 2816 + col0) = pack8(o[0], o[1]); }
    }
};
template <bool GATED> struct EpiRes {
    static constexpr bool PERM = true, AFTER_DRAIN = false;
    float* H; bf16_t* HBo; float* SSQo; const bf16_t* U; RowScale rs;
    __device__ __forceinline__ void operator()(const f32x4 (&acc)[2][2][4][2], const Unit& u, int wr, int wc, int fr, int fq) const {
        const int row0 = u.pm * BM + wr * 64 + fr, col0 = u.pn * BM + wc * 32 + 8 * fq;
        float rsv[2][4]; if (GATED) rs.get8(rsv, row0, fq);
#pragma unroll
        for (int ai = 0; ai < 2; ++ai)
#pragma unroll
            for (int m = 0; m < 4; ++m) { const int row = row0 + ai * HALF + m * 16; const size_t off = (size_t)row * DMODEL + col0;
                float s = 1.0f; if (GATED) s = rsv[ai][m];
                float q = 0.f;
#pragma unroll
                for (int bj = 0; bj < 2; ++bj) { f32x4 a0 = acc[ai][bj][m][0], a1 = acc[ai][bj][m][1];
                    f32x4 h0 = *(const f32x4*)(H + off + bj * HALF), h1 = *(const f32x4*)(H + off + bj * HALF + 4);
                    if (GATED) { f32x4 u0, u1; unpack8(*(const u32x4*)(U + off + bj * HALF), u0, u1);
#pragma unroll
                        for (int j = 0; j < 4; ++j) { a0[j] = sigmoidf_(a0[j] * s) * u0[j]; a1[j] = sigmoidf_(a1[j] * s) * u1[j]; } }
                    h0 += a0; h1 += a1;
                    *(f32x4*)(H + off + bj * HALF) = h0; *(f32x4*)(H + off + bj * HALF + 4) = h1;
                    *(u32x4*)(HBo + off + bj * HALF) = pack8(h0, h1);
                    q += sumsq8(h0, h1); }
                q = red_fq(q); if (fq == 0) SSQo[(size_t)row * 16 + u.pn * 4 + wc] = q;
                asm volatile("" ::: "memory"); }
    }
};
struct EpiKvs {
    static constexpr bool PERM = true, AFTER_DRAIN = false;
    bf16_t* KT; bf16_t* VT; RowScale rs;
    __device__ __forceinline__ void operator()(const f32x4 (&acc)[2][2][4][2], const Unit& u, int wr, int wc, int fr, int fq) const {
        const int row0 = u.pm * BM + wr * 64 + fr;
        float rsv[2][4]; rs.get8(rsv, row0, fq);
#pragma unroll
        for (int ai = 0; ai < 2; ++ai)
#pragma unroll
            for (int m = 0; m < 4; ++m) { const int row = row0 + ai * HALF + m * 16; const float s = rsv[ai][m];
                const int b = row >> 13, sq = row & 8191, tile = sq >> 6, rr = sq & 63;
#pragma unroll
                for (int bj = 0; bj < 2; ++bj) { const int c = bj * HALF + wc * 32 + 8 * fq, kh = c >> 6, d = c & 63;
                    const size_t tb = (size_t)((b * 4 + kh) * 128 + tile) * 4096;
                    const u32x4 w = pack8(acc[ai][bj][m][0] * s, acc[ai][bj][m][1] * s);
                    if (u.pn == 0) *(u32x4*)(KT + tb + (d >> 3) * 512 + rr * 8) = w;
                    else *(u32x4*)(VT + tb + (d >> 5) * 2048 + rr * 32 + (d & 31)) = w; } }
    }
};

#define PG8_LAS LAS
template <class Epi, class Sched, bool ALIGN_EPI = false, bool SP2 = false>
__device__ __forceinline__ void gemm_phase(PG8_LAS unsigned char* lds, const Gemm g, const Sched& S, const Epi& E) {
    int tid_ = threadIdx.x; asm volatile("" : "+v"(tid_));
    const int tid = tid_, wid = __builtin_amdgcn_readfirstlane(tid >> 6), lane = tid & 63, wr = wid >> 2, wc = wid & 3, fr = lane & 15, fq = lane >> 4;
    const int K = g.K, nt = K / BK;
    unsigned voffA[2], voffB[2];
#pragma unroll
    for (int i = 0; i < 2; ++i) { int R, C; stage_rc(tid * 16 + i * 8192, R, C); const int Rb = Epi::PERM ? ((R & ~31) + perm32(R & 31)) : R;
        voffA[i] = (unsigned)(R * K + C) * 2u; voffB[i] = (unsigned)(Rb * K + C) * 2u; }
    const size_t kstep = (size_t)(BK * 2);
    const size_t hstep = (size_t)HALF * K * 2;
    const size_t tstep = 2 * hstep;
    const unsigned ldsw = (unsigned)wid * 1024u;
    const int aoff = lds_byte(wr * 64 + fr, fq * 8), boff = lds_byte(wc * 32 + fr, fq * 8);
#define PG8_SA(b, h) (((b) * 2 + (h)) * HTB)
#define PG8_SB(b, h) ((4 + (b) * 2 + (h)) * HTB)
#define PG8_STAGE(bufoff, gbase, voff) do { _Pragma("unroll") for (int _i = 0; _i < 2; ++_i) \
        __builtin_amdgcn_global_load_lds((const unsigned*)((const char*)(gbase) + (voff)[_i]), (PG8_LAS unsigned*)(lds + (bufoff) + ldsw + _i * 8192), 16, 0, 0); } while (0)
#define PG8_LDA(dst, b, h) do { _Pragma("unroll") for (int m = 0; m < 4; ++m) _Pragma("unroll") for (int k = 0; k < 2; ++k) dst[m][k] = *(const PG8_LAS bf16x8*)(lds + PG8_SA(b, h) + aoff + m * 2048 + k * 1024); } while (0)
#define PG8_LDB(dst, b, h) do { _Pragma("unroll") for (int n = 0; n < 2; ++n) _Pragma("unroll") for (int k = 0; k < 2; ++k) dst[n][k] = *(const PG8_LAS bf16x8*)(lds + PG8_SB(b, h) + boff + n * 2048 + k * 1024); } while (0)
#define PG8_MMA(ai, bj, At, Bt) do { __builtin_amdgcn_s_setprio(1); _Pragma("unroll") for (int m = 0; m < 4; ++m) _Pragma("unroll") for (int n = 0; n < 2; ++n) _Pragma("unroll") for (int k = 0; k < 2; ++k) \
        acc[ai][bj][m][n] = __builtin_amdgcn_mfma_f32_16x16x32_bf16(Bt[n][k], At[m][k], acc[ai][bj][m][n], 0, 0, 0); __builtin_amdgcn_s_setprio(0); } while (0)
#define PG8_WAIT_V(n) asm volatile("s_waitcnt vmcnt(" #n ")" ::: "memory")
#define PG8_WAIT_L(n) asm volatile("s_waitcnt lgkmcnt(" #n ")" ::: "memory")
#define PG8_BAR __builtin_amdgcn_s_barrier()
#define PG8_SCHED __builtin_amdgcn_sched_barrier(0)
    Unit cur, nxt; int ui = 0;
    if (!S.next(0, cur)) return;
    f32x4 acc[2][2][4][2];
#pragma unroll
    for (int a = 0; a < 2; ++a)
#pragma unroll
        for (int b = 0; b < 2; ++b)
#pragma unroll
            for (int m = 0; m < 4; ++m)
#pragma unroll
                for (int n = 0; n < 2; ++n) acc[a][b][m][n] = (f32x4){0.f, 0.f, 0.f, 0.f};
    bf16x8 At[4][2], B0[2][2], B1[2][2];
    const char* cA = (const char*)g.A + (size_t)cur.pm * tstep; const char* cB = (const char*)g.Bt + cur.boff + (size_t)cur.pn * tstep;
    if constexpr (SP2) {
        PG8_STAGE(PG8_SB(0, 0), cB, voffB); PG8_STAGE(PG8_SB(0, 1), cB + hstep, voffB); PG8_STAGE(PG8_SA(0, 0), cA, voffA); PG8_STAGE(PG8_SA(0, 1), cA + hstep, voffA);
        if (wr == 1) PG8_BAR;
        PG8_WAIT_V(2); PG8_BAR;
        PG8_STAGE(PG8_SB(1, 0), cB + kstep, voffB); PG8_STAGE(PG8_SA(1, 0), cA + kstep, voffA); PG8_STAGE(PG8_SB(1, 1), cB + hstep + kstep, voffB);
        PG8_WAIT_V(6); PG8_BAR;
    } else {
        PG8_STAGE(PG8_SB(0, 0), cB, voffB); PG8_STAGE(PG8_SA(0, 0), cA, voffA); PG8_STAGE(PG8_SB(0, 1), cB + hstep, voffB); PG8_STAGE(PG8_SA(0, 1), cA + hstep, voffA);
        if (wr == 1) PG8_BAR;
        PG8_WAIT_V(4); PG8_BAR;
        PG8_STAGE(PG8_SB(1, 0), cB + kstep, voffB); PG8_STAGE(PG8_SA(1, 0), cA + kstep, voffA); PG8_STAGE(PG8_SB(1, 1), cB + hstep + kstep, voffB);
        PG8_WAIT_V(6); PG8_BAR;
    }
    for (;;) {
        const bool has_next = S.next(ui + 1, nxt);
        const char* nA = has_next ? (const char*)g.A + (size_t)nxt.pm * tstep : cA; const char* nB = has_next ? (const char*)g.Bt + nxt.boff + (size_t)nxt.pn * tstep : cB;
        for (int t = 0; t < nt; t += 2) {
            const bool last = (t == nt - 2);
            const char* a1 = cA + (size_t)(t + 1) * kstep;
            const char* a2 = last ? nA : cA + (size_t)(t + 2) * kstep; const char* b2 = last ? nB : cB + (size_t)(t + 2) * kstep;
            const char* a3 = a2 + kstep; const char* b3 = b2 + kstep;
            if constexpr (SP2) {
            PG8_LDB(B0, 0, 0); PG8_LDB(B1, 0, 1); PG8_SCHED; PG8_LDA(At, 0, 0); PG8_STAGE(PG8_SA(1, 1), a1 + hstep, voffA);
            PG8_WAIT_V(8); PG8_WAIT_L(0); PG8_BAR; PG8_MMA(0, 0, At, B0); PG8_MMA(0, 1, At, B1); PG8_BAR; PG8_SCHED;
            PG8_LDA(At, 0, 1); PG8_STAGE(PG8_SB(0, 0), b2, voffB); PG8_STAGE(PG8_SB(0, 1), b2 + hstep, voffB); PG8_STAGE(PG8_SA(0, 0), a2, voffA);
            PG8_WAIT_V(8); PG8_WAIT_L(0); PG8_BAR; PG8_MMA(1, 0, At, B0); PG8_MMA(1, 1, At, B1); PG8_BAR; PG8_SCHED;
            PG8_LDB(B0, 1, 0); PG8_LDB(B1, 1, 1); PG8_SCHED; PG8_LDA(At, 1, 0); PG8_STAGE(PG8_SA(0, 1), a2 + hstep, voffA);
            PG8_WAIT_V(8); PG8_WAIT_L(0); PG8_BAR; PG8_MMA(0, 0, At, B0); PG8_MMA(0, 1, At, B1); PG8_BAR; PG8_SCHED;
            PG8_LDA(At, 1, 1); PG8_STAGE(PG8_SB(1, 0), b3, voffB); PG8_STAGE(PG8_SB(1, 1), b3 + hstep, voffB); PG8_STAGE(PG8_SA(1, 0), a3, voffA);
            PG8_WAIT_V(8); PG8_WAIT_L(0); PG8_BAR; PG8_MMA(1, 0, At, B0); PG8_MMA(1, 1, At, B1); PG8_BAR; PG8_SCHED;
            } else {
            PG8_LDB(B0, 0, 0); PG8_SCHED; PG8_LDA(At, 0, 0); PG8_STAGE(PG8_SA(1, 1), a1 + hstep, voffA);
            PG8_WAIT_L(8); PG8_BAR; PG8_WAIT_L(0); PG8_MMA(0, 0, At, B0); PG8_BAR; PG8_SCHED;
            PG8_LDB(B1, 0, 1); PG8_STAGE(PG8_SB(0, 0), b2, voffB);
            PG8_BAR; PG8_WAIT_L(0); PG8_MMA(0, 1, At, B1); PG8_BAR;
            PG8_LDA(At, 0, 1); PG8_STAGE(PG8_SA(0, 0), a2, voffA);
            PG8_BAR; PG8_WAIT_L(0); PG8_MMA(1, 0, At, B0); PG8_BAR; PG8_SCHED;
            PG8_STAGE(PG8_SB(0, 1), b2 + hstep, voffB);
            PG8_WAIT_V(6); PG8_BAR; PG8_MMA(1, 1, At, B1); PG8_BAR;
            PG8_LDB(B0, 1, 0); PG8_SCHED; PG8_LDA(At, 1, 0); PG8_STAGE(PG8_SA(0, 1), a2 + hstep, voffA);
            PG8_WAIT_L(8); PG8_BAR; PG8_WAIT_L(0); PG8_MMA(0, 0, At, B0); PG8_BAR; PG8_SCHED;
            PG8_LDB(B1, 1, 1); PG8_STAGE(PG8_SB(1, 0), b3, voffB);
            PG8_BAR; PG8_WAIT_L(0); PG8_MMA(0, 1, At, B1); PG8_BAR;
            PG8_LDA(At, 1, 1); PG8_STAGE(PG8_SA(1, 0), a3, voffA);
            PG8_BAR; PG8_WAIT_L(0); PG8_MMA(1, 0, At, B0); PG8_BAR; PG8_SCHED;
            PG8_STAGE(PG8_SB(1, 1), b3 + hstep, voffB);
            PG8_WAIT_V(6); PG8_BAR; PG8_MMA(1, 1, At, B1); PG8_BAR;
            }
        }
        if constexpr (ALIGN_EPI) { if (wr == 0) PG8_BAR; }
        E(acc, cur, wr, wc, fr, fq);
        if (!has_next) break;
#pragma unroll
        for (int a = 0; a < 2; ++a)
#pragma unroll
            for (int b = 0; b < 2; ++b)
#pragma unroll
                for (int m = 0; m < 4; ++m)
#pragma unroll
                    for (int n = 0; n < 2; ++n) acc[a][b][m][n] = (f32x4){0.f, 0.f, 0.f, 0.f};
        cur = nxt; cA = nA; cB = nB; ++ui;
        if constexpr (ALIGN_EPI) { if (wr == 1) PG8_BAR; }
    }
    PG8_WAIT_V(0);
    if constexpr (!ALIGN_EPI) { if (wr == 0) PG8_BAR; }
    PG8_BAR;
#undef PG8_SA
#undef PG8_SB
#undef PG8_STAGE
#undef PG8_LDA
#undef PG8_LDB
#undef PG8_MMA
#undef PG8_WAIT_V
#undef PG8_WAIT_L
#undef PG8_BAR
#undef PG8_SCHED
}
}
typedef GAS unsigned gu32;
#define RLX_AGENT __ATOMIC_RELAXED, __HIP_MEMORY_SCOPE_AGENT
#define XB_TMO      128
#define XB_XCNT(j)  (256  + 64 * (j))
#define XB_XSUB(j)  (1280 + 64 * (j))
#define XB_XGEN(j)  (2304 + 64 * (j))
#define XB_TOP      3328
#define XB_TOPGEN   3392
#define XCD_BAR_WORDS 3456
#define XB_SPIN_CAP (1u << 18)

__device__ __forceinline__ unsigned xb_ld(unsigned* p)              { return __hip_atomic_load(p, __ATOMIC_RELAXED, __HIP_MEMORY_SCOPE_AGENT); }
__device__ __forceinline__ unsigned xb_add(unsigned* p, unsigned v) { return __hip_atomic_fetch_add(p, v, __ATOMIC_RELAXED, __HIP_MEMORY_SCOPE_AGENT); }
__device__ __forceinline__ unsigned xb_xcc_id() { return (unsigned)__builtin_amdgcn_s_getreg((3 << 11) | 20) & 0xFu; }
#define XB_SPIN(cond, bar) do { unsigned _sp = 0; while (cond) { __builtin_amdgcn_s_sleep(1); \
    if ((++_sp & 255u) == 0u) { if (xb_ld(&(bar)[XB_TMO])) break; if (_sp > XB_SPIN_CAP) { atomicAdd(&(bar)[XB_TMO], 1u); break; } } } } while (0)

struct XcdBarrier {
    unsigned* bar; unsigned x;
    volatile LAS unsigned* st;
};
__device__ __forceinline__ XcdBarrier xcd_barrier_post(unsigned* bar, volatile LAS unsigned* st) {
    XcdBarrier b; b.bar = bar; b.x = xb_xcc_id(); b.st = st;
    if (threadIdx.x == 0) (void)xb_add(&bar[XB_XCNT(b.x)], 1u);
    return b;
}
__device__ __forceinline__ void xcd_barrier_complete(unsigned* bar, unsigned x, unsigned& nloc, unsigned& nx) {
    const unsigned G = gridDim.x * gridDim.y * gridDim.z;
    unsigned sum, cnt, mine, sp = 0u;
    for (;;) {
        sum = 0u; cnt = 0u; mine = 0u;
#pragma unroll
        for (unsigned j = 0; j < 16; ++j) { const unsigned c = xb_ld(&bar[XB_XCNT(j)]); sum += c; cnt += (c > 0u) ? 1u : 0u; mine = (j == x) ? c : mine; }
        if (sum == G) break;
        __builtin_amdgcn_s_sleep(1);
        if ((++sp & 255u) == 0u) { if (xb_ld(&bar[XB_TMO])) break; if (sp > XB_SPIN_CAP) { atomicAdd(&bar[XB_TMO], 1u); break; } }
    }
    nloc = mine > 0u ? mine : 1u; nx = cnt > 0u ? cnt : 1u;
}
__device__ __forceinline__ void xcd_barrier(const XcdBarrier& b) {
    asm volatile("s_waitcnt vmcnt(0)" ::: "memory");
    __syncthreads();
    if (threadIdx.x == 0) {
        unsigned* bar = b.bar;
        __builtin_amdgcn_s_waitcnt(0);
        unsigned nloc = b.st[0], nx = b.st[1];
        if (nloc == 0u) { xcd_barrier_complete(bar, b.x, nloc, nx); b.st[0] = nloc; b.st[1] = nx; }
        const unsigned old = xb_add(&bar[XB_XSUB(b.x)], 1u);
        const unsigned gen = old / nloc;
        if (old + 1u == (gen + 1u) * nloc) {
            __builtin_amdgcn_fence(__ATOMIC_RELEASE, "agent");
            asm volatile("s_waitcnt vmcnt(0)" ::: "memory");
            const unsigned og = xb_add(&bar[XB_TOP], 1u);
            const unsigned tg = og / nx;
            if (og + 1u == (tg + 1u) * nx) xb_add(&bar[XB_TOPGEN], 1u);
            else XB_SPIN(xb_ld(&bar[XB_TOPGEN]) == tg, bar);
            __builtin_amdgcn_fence(__ATOMIC_ACQUIRE, "agent");
            xb_add(&bar[XB_XGEN(b.x)], 1u);
            asm volatile("s_waitcnt vmcnt(0)" ::: "memory");
        } else {
            XB_SPIN(xb_ld(&bar[XB_XGEN(b.x)]) == gen, bar);
            __builtin_amdgcn_fence(__ATOMIC_ACQUIRE, "agent");
            asm volatile("s_waitcnt vmcnt(0)" ::: "memory");
        }
    }
    __syncthreads();
}

namespace att {
__device__ __forceinline__ int crow(int r, int hi) { return (r & 3) + 8 * (r >> 2) + 4 * hi; }
__device__ __forceinline__ void glds16(const void* gsrc, unsigned lds_dst) { unsigned keep;
    asm volatile("s_mov_b32 %0, m0\n\ts_mov_b32 m0, %2\n\ts_nop 0\n\tglobal_load_lds_dwordx4 %1, off\n\ts_mov_b32 m0, %0" : "=&s"(keep) : "v"(gsrc), "s"(lds_dst) : "memory"); }
#define ATT_WAIT_BAR(N) asm volatile("s_waitcnt vmcnt(" #N ") lgkmcnt(0)\n\ts_barrier" ::: "memory")
#define ATT_MX3(a, b, c) __builtin_fmaxf(__builtin_fmaxf((a), (b)), (c))
typedef LAS const unsigned char* lcp;
typedef short v4i16_t __attribute__((ext_vector_type(4)));
__device__ __forceinline__ s16x4 vtr(lcp p) { return __builtin_bit_cast(s16x4, __builtin_amdgcn_ds_read_tr16_b64_v4i16((LAS v4i16_t*)p)); }
__device__ __forceinline__ float rowmax(const f32x16& p0, const f32x16& p1) {
    float a = ATT_MX3(p0[0], p0[1], p1[0]), b = ATT_MX3(p0[2], p0[3], p1[1]); a = ATT_MX3(a, p1[2], p1[3]);
#pragma unroll
    for (int r = 4; r < 16; r += 4) { a = ATT_MX3(a, p0[r], p0[r + 1]); b = ATT_MX3(b, p0[r + 2], p0[r + 3]); a = ATT_MX3(a, p1[r], p1[r + 1]); b = ATT_MX3(b, p1[r + 2], p1[r + 3]); }
    float m = __builtin_fmaxf(a, b); auto rr = __builtin_amdgcn_permlane32_swap(__float_as_uint(m), __float_as_uint(m), false, false);
    return __builtin_fmaxf(__uint_as_float(rr[0]), __uint_as_float(rr[1])); }
__device__ __forceinline__ void pv(f32x16* o, lcp vp, const u32x4 pw0, const u32x4 pw1, const u32x4 pw2, const u32x4 pw3) {
#pragma unroll
    for (int d0 = 0; d0 < 2; ++d0) {
#pragma unroll
        for (int ks = 0; ks < 4; ++ks) {
            const s16x4 lo = vtr(vp + d0 * 4096 + ks * 1024), hi = vtr(vp + d0 * 4096 + ks * 1024 + 512);
            const bf16x8 vf = (bf16x8){lo[0], lo[1], lo[2], lo[3], hi[0], hi[1], hi[2], hi[3]};
            const u32x4 pw = ks == 0 ? pw0 : ks == 1 ? pw1 : ks == 2 ? pw2 : pw3;
            o[d0] = __builtin_amdgcn_mfma_f32_32x32x16_bf16(__builtin_bit_cast(bf16x8, pw), vf, o[d0], 0, 0, 0);
        }
    }
}
__device__ __forceinline__ void store_o(const f32x16* o, const float* rsc  , LAS unsigned char* stage, bf16_t* Ow, int pitch, int lane, int r32, int hi) {
    LAS bf16_t* stg = (LAS bf16_t*)stage;
#pragma unroll
    for (int r = 0; r < 16; ++r) { const int orow = crow(r, hi);
#pragma unroll
        for (int d0 = 0; d0 < 2; ++d0) stg[orow * 64 + d0 * 32 + r32] = (bf16_t)(pk_bf16(o[d0][r] * rsc[r], 0.f) & 0xffffu); }
    asm volatile("s_waitcnt lgkmcnt(0)" ::: "memory");
#pragma unroll
    for (int i = 0; i < 4; ++i) { const int row = i * 8 + (lane >> 3), ch = lane & 7; const u32x4 v = *(const LAS u32x4*)(stg + row * 64 + ch * 8); *(u32x4*)(Ow + (size_t)row * pitch + ch * 8) = v; }
}

namespace mla {
constexpr int KSLOT = 12288, VSLOT = 8192, NS = 3;
constexpr int L_K = 0, L_V = NS * KSLOT, L_WS = L_V + NS * VSLOT, L_OST = L_WS + 2048, L_END = L_OST + 8 * 4096;
__device__ __forceinline__ void unit(int b, int h, int qb, const bf16_t* Q, const bf16_t* KT, const bf16_t* VT, bf16_t* O, LAS unsigned char* shm) {
    int tid_ = threadIdx.x; asm volatile("" : "+v"(tid_));
    const int tid = tid_, lane = tid & 63, r32 = lane & 31, hi = lane >> 5; const int wid = __builtin_amdgcn_readfirstlane(tid >> 6);
    const long rowbase = (long)b * SEQL; const int q0 = qb * 256;
    const bf16_t* Qw = Q + (size_t)(rowbase + q0 + wid * 32) * 768 + h * 96;
    const bf16_t* Kh = KT + (size_t)((b * 8 + h) * 128) * 6144 + lane * 8;
    const bf16_t* Vh = VT + (size_t)((b * 8 + h) * 128) * 4096 + lane * 8;
    const unsigned lds0 = (unsigned)(uintptr_t)shm;
    LAS float* wsf = (LAS float*)(shm + L_WS) + wid * 64;
    const int NT = (q0 + 256) / 64;
    const int kc2 = 8 + (wid & 3);
#define MLA_DMA(t, sl) do { const bf16_t* kt_ = Kh + (size_t)(t) * 6144; \
        glds16(kt_ + wid * 512, (unsigned)__builtin_amdgcn_readfirstlane(lds0 + L_K + (sl) * KSLOT + wid * 1024)); \
        glds16(kt_ + kc2 * 512, (unsigned)__builtin_amdgcn_readfirstlane(lds0 + L_K + (sl) * KSLOT + kc2 * 1024)); \
        glds16(Vh + (size_t)(t) * 4096 + wid * 512, (unsigned)__builtin_amdgcn_readfirstlane(lds0 + L_V + (sl) * VSLOT + wid * 1024)); } while (0)
    MLA_DMA(0, 0); MLA_DMA(1, 1);
    bf16x8 qr[6];
#pragma unroll
    for (int d0 = 0; d0 < 6; ++d0) qr[d0] = *(const bf16x8*)(Qw + (size_t)r32 * 768 + d0 * 16 + hi * 8);
    float m = -1e30f, l = 0.f; f32x16 o[2];
#pragma unroll
    for (int r = 0; r < 16; ++r) { o[0][r] = 0.f; o[1][r] = 0.f; }
    const int qrel = wid * 32 + r32;
    int slot = 0;
    for (int t = 0; t < NT; ++t) {
        if (t + 1 < NT) ATT_WAIT_BAR(3); else ATT_WAIT_BAR(0);
        if (t + 2 < NT) { const int s2 = slot == 0 ? 2 : slot - 1; MLA_DMA(t + 2, s2); }
        const int jb = t - (NT - 4);
        if (jb <= 0 || 64 * jb <= wid * 32 + 31) {
            const lcp kb = (lcp)shm + L_K + slot * KSLOT + hi * 1024 + r32 * 16;
            f32x16 p0, p1;
#pragma unroll
            for (int r = 0; r < 16; ++r) { p0[r] = 0.f; p1[r] = 0.f; }
#pragma unroll
            for (int d0 = 0; d0 < 6; ++d0) { const bf16x8 b0 = *(const LAS bf16x8*)(kb + d0 * 2048), b1 = *(const LAS bf16x8*)(kb + d0 * 2048 + 512);
                p0 = __builtin_amdgcn_mfma_f32_32x32x16_bf16(b0, qr[d0], p0, 0, 0, 0); p1 = __builtin_amdgcn_mfma_f32_32x32x16_bf16(b1, qr[d0], p1, 0, 0, 0); }
            if (jb >= 0) {
#pragma unroll
                for (int r = 0; r < 16; ++r) { const int kv = 64 * jb + crow(r, hi); if (kv > qrel) p0[r] = -INFINITY; if (kv + 32 > qrel) p1[r] = -INFINITY; }
            }
            const float rm = rowmax(p0, p1), mnew = __builtin_fmaxf(m, rm);
            if (__any(mnew > m)) {
                const float alpha = fast_exp2(m - mnew); l *= alpha; m = mnew;
                if (hi == 0) wsf[r32] = alpha;
#pragma unroll
                for (int r = 0; r < 16; ++r) { const float a = wsf[crow(r, hi)]; o[0][r] *= a; o[1][r] *= a; }
            }
            float sa = 0.f, sb = 0.f;
#pragma unroll
            for (int r = 0; r < 16; ++r) { p0[r] = fast_exp2(p0[r] - m); p1[r] = fast_exp2(p1[r] - m); sa += p0[r]; sb += p1[r]; }
            l += sa + sb;
            const u32x4 pw0 = {pk_bf16(p0[0], p0[1]), pk_bf16(p0[2], p0[3]), pk_bf16(p0[4], p0[5]), pk_bf16(p0[6], p0[7])};
            const u32x4 pw1 = {pk_bf16(p0[8], p0[9]), pk_bf16(p0[10], p0[11]), pk_bf16(p0[12], p0[13]), pk_bf16(p0[14], p0[15])};
            const u32x4 pw2 = {pk_bf16(p1[0], p1[1]), pk_bf16(p1[2], p1[3]), pk_bf16(p1[4], p1[5]), pk_bf16(p1[6], p1[7])};
            const u32x4 pw3 = {pk_bf16(p1[8], p1[9]), pk_bf16(p1[10], p1[11]), pk_bf16(p1[12], p1[13]), pk_bf16(p1[14], p1[15])};
            const lcp vp = (lcp)shm + L_V + slot * VSLOT + ((lane >> 4) & 1) * 32 + (lane & 3) * 8 + (4 * hi + ((lane & 15) >> 2)) * 64;
            pv(o, vp, pw0, pw1, pw2, pw3);
        }
        slot = slot == 2 ? 0 : slot + 1;
    }
#undef MLA_DMA
    { auto rr = __builtin_amdgcn_permlane32_swap(__float_as_uint(l), __float_as_uint(l), false, false); l = __uint_as_float(rr[0]) + __uint_as_float(rr[1]); }
    if (hi == 0) wsf[32 + r32] = l;
    float rli[16];
#pragma unroll
    for (int r = 0; r < 16; ++r) rli[r] = fast_rcp(wsf[32 + crow(r, hi)]);
    store_o(o, rli, shm + L_OST + wid * 4096, O + (size_t)(rowbase + q0 + wid * 32) * 512 + h * 64, 512, lane, r32, hi);
    asm volatile("s_waitcnt lgkmcnt(0)\n\ts_barrier" ::: "memory");
}
__device__ __forceinline__ void phase(int vcu, int G, const bf16_t* Q, const bf16_t* KT, const bf16_t* VT, bf16_t* O, LAS unsigned char* shm) {
    for (int v = vcu; v < 256; v += G) { const int bh = v >> 4, s = v & 15;
        unit(bh >> 3, bh & 7, 31 - s, Q, KT, VT, O, shm);
        unit(bh >> 3, bh & 7, s, Q, KT, VT, O, shm); }
}
}

namespace sba {
constexpr int KSLOT = 8192, VSLOT = 8192, NS = 3;
constexpr int L_K = 0, L_V = NS * KSLOT, L_WS = L_V + NS * VSLOT, L_FLAG = L_WS + 2048, L_OST = L_FLAG + 256, L_END = L_OST + 8 * 4096;
constexpr float SB_EXIT = -160.0f;
__device__ __forceinline__ void unit(int b, int kh, int qb64, const bf16_t* Q, const bf16_t* KT, const bf16_t* VT, bf16_t* O, LAS unsigned char* shm) {
    int tid_ = threadIdx.x; asm volatile("" : "+v"(tid_));
    const int tid = tid_, lane = tid & 63, r32 = lane & 31, hi = lane >> 5; const int wid = __builtin_amdgcn_readfirstlane(tid >> 6);
    const int h = kh * 4 + (wid >> 1), half = wid & 1;
    const long rowbase = (long)b * SEQL; const int q0 = qb64 * 64;
    const bf16_t* Qw = Q + (size_t)(rowbase + q0 + half * 32) * 1024 + h * 64;
    const bf16_t* Kh = KT + (size_t)((b * 4 + kh) * 128) * 4096 + wid * 512 + lane * 8;
    const bf16_t* Vh = VT + (size_t)((b * 4 + kh) * 128) * 4096 + wid * 512 + lane * 8;
    const unsigned lds0 = (unsigned)(uintptr_t)shm;
    LAS int* flags = (LAS int*)(shm + L_FLAG);
    const int NT = qb64 + 1;
#define SBA_DMA(k, sl) do { const int tile_ = qb64 - (k); \
        glds16(Kh + (size_t)tile_ * 4096, (unsigned)__builtin_amdgcn_readfirstlane(lds0 + L_K + (sl) * KSLOT + wid * 1024)); \
        glds16(Vh + (size_t)tile_ * 4096, (unsigned)__builtin_amdgcn_readfirstlane(lds0 + L_V + (sl) * VSLOT + wid * 1024)); } while (0)
    SBA_DMA(0, 0); if (NT > 1) SBA_DMA(1, 1);
    bf16x8 qr[4];
#pragma unroll
    for (int d0 = 0; d0 < 4; ++d0) qr[d0] = *(const bf16x8*)(Qw + (size_t)r32 * 1024 + d0 * 16 + hi * 8);
    float R = 0.f; f32x16 o[2];
#pragma unroll
    for (int r = 0; r < 16; ++r) { o[0][r] = 0.f; o[1][r] = 0.f; }
    const int qrel = half * 32 + r32;
    int slot = 0;
    for (int k = 0; k < NT; ++k) {
        if (k + 1 < NT) ATT_WAIT_BAR(2); else ATT_WAIT_BAR(0);
        if (k > 0) { const LAS int* f = flags + ((k - 1) & 1) * 8; int all = 1;
#pragma unroll
            for (int w = 0; w < 8; ++w) all &= f[w];
            if (all) break; }
        if (k + 2 < NT) { const int s2 = slot == 0 ? 2 : slot - 1; SBA_DMA(k + 2, s2); }
        {
            const lcp kb = (lcp)shm + L_K + slot * KSLOT + hi * 1024 + r32 * 16;
            f32x16 p0, p1;
#pragma unroll
            for (int r = 0; r < 16; ++r) { p0[r] = 0.f; p1[r] = 0.f; }
#pragma unroll
            for (int d0 = 0; d0 < 4; ++d0) { const bf16x8 b0 = *(const LAS bf16x8*)(kb + d0 * 2048), b1 = *(const LAS bf16x8*)(kb + d0 * 2048 + 512);
                p0 = __builtin_amdgcn_mfma_f32_32x32x16_bf16(b0, qr[d0], p0, 0, 0, 0); p1 = __builtin_amdgcn_mfma_f32_32x32x16_bf16(b1, qr[d0], p1, 0, 0, 0); }
            f32x16 L0, L1;
#pragma unroll
            for (int r = 0; r < 16; ++r) {
                const float z0 = p0[r], z1 = p1[r];
                float s0 = -(__builtin_fmaxf(z0, 0.f) + fast_log2(1.0f + fast_exp2(-__builtin_fabsf(z0))));
                float s1 = -(__builtin_fmaxf(z1, 0.f) + fast_log2(1.0f + fast_exp2(-__builtin_fabsf(z1))));
                if (k == 0) { const int kv = crow(r, hi); if (kv >= qrel) s0 = 0.f; if (kv + 32 >= qrel) s1 = 0.f; }
                L0[r] = s0; L1[r] = s1; }
            float G[16];
#pragma unroll
            for (int j = 0; j < 8; ++j) { const f32x16& LL = j < 4 ? L0 : L1; const int rb = 4 * (j & 3);
                const float gsum = (LL[rb] + LL[rb + 1]) + (LL[rb + 2] + LL[rb + 3]);
                auto rr = __builtin_amdgcn_permlane32_swap(__float_as_uint(gsum), __float_as_uint(gsum), false, false);
                G[2 * j] = __uint_as_float(rr[0]); G[2 * j + 1] = __uint_as_float(rr[1]); }
            float SG[16]; SG[15] = 0.f;
#pragma unroll
            for (int g = 14; g >= 0; --g) SG[g] = SG[g + 1] + G[g + 1];
            const float T = SG[0] + G[0];
#pragma unroll
            for (int j = 0; j < 8; ++j) { f32x16& LL = j < 4 ? L0 : L1; f32x16& PP = j < 4 ? p0 : p1; const int rb = 4 * (j & 3);
                const float base = (R + SG[2 * j + 1]) + (hi ? 0.f : G[2 * j + 1]);
                const float r3 = base, r2 = r3 + LL[rb + 3], r1 = r2 + LL[rb + 2], r0 = r1 + LL[rb + 1];
                PP[rb + 3] = fast_exp2(PP[rb + 3] + LL[rb + 3] + r3); PP[rb + 2] = fast_exp2(PP[rb + 2] + LL[rb + 2] + r2);
                PP[rb + 1] = fast_exp2(PP[rb + 1] + LL[rb + 1] + r1); PP[rb] = fast_exp2(PP[rb] + LL[rb] + r0); }
            if (k == 0) {
#pragma unroll
                for (int r = 0; r < 16; ++r) { const int kv = crow(r, hi); if (kv >= qrel) p0[r] = 0.f; if (kv + 32 >= qrel) p1[r] = 0.f; }
            }
            R += T;
            const u32x4 pw0 = {pk_bf16(p0[0], p0[1]), pk_bf16(p0[2], p0[3]), pk_bf16(p0[4], p0[5]), pk_bf16(p0[6], p0[7])};
            const u32x4 pw1 = {pk_bf16(p0[8], p0[9]), pk_bf16(p0[10], p0[11]), pk_bf16(p0[12], p0[13]), pk_bf16(p0[14], p0[15])};
            const u32x4 pw2 = {pk_bf16(p1[0], p1[1]), pk_bf16(p1[2], p1[3]), pk_bf16(p1[4], p1[5]), pk_bf16(p1[6], p1[7])};
            const u32x4 pw3 = {pk_bf16(p1[8], p1[9]), pk_bf16(p1[10], p1[11]), pk_bf16(p1[12], p1[13]), pk_bf16(p1[14], p1[15])};
            const lcp vp = (lcp)shm + L_V + slot * VSLOT + ((lane >> 4) & 1) * 32 + (lane & 3) * 8 + (4 * hi + ((lane & 15) >> 2)) * 64;
            pv(o, vp, pw0, pw1, pw2, pw3);
            const int dn = __all(R < SB_EXIT) ? 1 : 0;
            if (lane == 0) flags[(k & 1) * 8 + wid] = dn;
        }
        slot = slot == 2 ? 0 : slot + 1;
    }
#undef SBA_DMA
    ATT_WAIT_BAR(0);
    float one[16];
#pragma unroll
    for (int r = 0; r < 16; ++r) one[r] = 1.0f;
    store_o(o, one, shm + L_OST + wid * 4096, O + (size_t)(rowbase + q0 + half * 32) * 1024 + h * 64, 1024, lane, r32, hi);
    asm volatile("s_waitcnt lgkmcnt(0)\n\ts_barrier" ::: "memory");
}
__device__ __forceinline__ void phase(int vcu, int G, const bf16_t* Q, const bf16_t* KT, const bf16_t* VT, bf16_t* O, LAS unsigned char* shm) {
    for (int u = vcu * 4; u < 1024; u += G * 4)
        for (int i = 0; i < 4; ++i) { const int uu = u + i, qb64 = uu & 127, bk = uu >> 7; unit(bk >> 2, bk & 3, qb64, Q, KT, VT, O, shm); }
}
}
}
namespace fw {
constexpr size_t MiB = 1u << 20;
constexpr int NWAVES = 8, NTHR = 512;
constexpr int MAXSLOT = 34816;
constexpr size_t WS_CTL = 0, CTL_ZERO_BYTES = 64 * 1024;
constexpr size_t WS_TOKE = 1 * MiB;
constexpr size_t WS_TOKG = WS_TOKE + 64 * 1024;
constexpr size_t WS_TOKRS = WS_TOKG + 128 * 1024;
constexpr size_t WS_SLOT12 = WS_TOKRS + 64 * 1024;
constexpr size_t WS_SLOTG = WS_SLOT12 + 128 * 1024;
constexpr size_t WS_SLOTRS = WS_SLOTG + 256 * 1024;
constexpr size_t WS_CNT = WS_SLOTRS + 256 * 1024;
constexpr size_t WS_PSTART = WS_CNT + 16 * 1024;
constexpr size_t WS_CS = 4 * MiB;
constexpr size_t WS_SSQ = 6 * MiB;
constexpr size_t WS_SSQQ = 8 * MiB;
constexpr size_t WS_SSQKV = WS_SSQQ + 512 * 1024;
constexpr size_t WS_KPE = 9 * MiB;
constexpr size_t WS_W = 16 * MiB;
constexpr size_t W_AIN = WS_W, W_QUP = W_AIN + 3 * MiB, W_KVUP = W_QUP + 2 * MiB, W_AOUT = W_KVUP + 1 * MiB, W_KVS = W_AOUT + 2 * MiB, W_QB = W_KVS + 1 * MiB,
                 W_OB = W_QB + 4 * MiB, W_PG = W_OB + 4 * MiB, W_PU = W_PG + 8 * MiB, W_FGU = W_PU + 2 * MiB, W_FDN = W_FGU + 22 * MiB, W_EGU = W_FDN + 11 * MiB,
                 W_EDN = W_EGU + 176 * MiB, W_END = W_EDN + 88 * MiB;
constexpr size_t WS_PB = W_END;
constexpr size_t WS_HB = WS_PB + 32 * MiB;
constexpr size_t WS_U = WS_HB + 64 * MiB;
constexpr size_t WS_SKT = WS_U + 128 * MiB, WS_SVT = WS_SKT + 8 * MiB;
constexpr size_t WS_X = WS_SVT + 8 * MiB;
constexpr size_t X_AQ = WS_X, X_AKV = X_AQ + 12 * MiB, X_QRAW = X_AKV + 8 * MiB, X_KVRAW = X_QRAW + 24 * MiB, X_Q = X_KVRAW + 32 * MiB, X_KT = X_Q + 24 * MiB, X_VT = X_KT + 24 * MiB, X_O = X_VT + 16 * MiB;
constexpr size_t X_SQ = WS_X, X_SO = X_SQ + 32 * MiB;
constexpr size_t X_HID = WS_X;
constexpr size_t X_XG = WS_X, X_HG = X_XG + 68 * MiB, X_YG = X_HG + 187 * MiB, X_END = X_YG + 68 * MiB;
constexpr size_t WS_END = X_END;
static_assert(X_O + 16 * MiB <= X_END && (size_t)MAXSLOT * 2816 * 2 <= 187 * MiB && (size_t)MAXSLOT * 1024 * 2 <= 68 * MiB, "ws map");
constexpr int CW_BAR = 1024;
constexpr int RING_OFF = 0, RING_BYTES = 131072, LDSCTL_OFF = RING_BYTES, MISC_OFF = LDSCTL_OFF + 320, LDS_BYTES = 147456;
static_assert(att::mla::L_END <= RING_BYTES && att::sba::L_END <= RING_BYTES, "attention LDS");
constexpr float QSCALE_MLA = 0.10206207261596577f * LOG2E;
constexpr float QSCALE_SB = 0.125f * LOG2E;

constexpr int PH_PER_LAYER = 12, PH_TOTAL = 2 + 4 * PH_PER_LAYER;
__host__ __device__ inline bool phase_active(int idx) {
    if (idx < 2) return true;
    const int l = (idx - 2) / PH_PER_LAYER, s = (idx - 2) % PH_PER_LAYER; const bool mla = l < 2, moe = (l & 1) != 0;
    if (s == 1 || s == 2) return mla;
    if (s >= 7 && s <= 9) return moe;
    if (s == 11) return l == 1;
    return true;
}

struct Args { const float* in[26]; float* out; unsigned char* ws; int ph_lo, ph_hi; };

struct Frame { LAS unsigned char* lds; int tid, lane, wave, vcu, G; };

__device__ __forceinline__ float wave_sum(float v) {
#pragma unroll
    for (int o = 1; o < 64; o <<= 1) v += __shfl_xor(v, o);
    return v;
}
__device__ __forceinline__ void transpose_item(const float* W, int ldw, int sc0, const float* gain, bf16_t* WT, int K, int drow0, int k0, LAS float* scr, int lane) {
#pragma unroll 8
    for (int i = 0; i < 32; ++i) { const int kk = 2 * i + (lane >> 5); float v = 0.f;
        if (sc0 >= 0) { v = W[(size_t)(k0 + kk) * ldw + sc0 + (lane & 31)]; if (gain) v *= gain[k0 + kk]; }
        scr[kk * 33 + (lane & 31)] = v; }
    asm volatile("s_waitcnt lgkmcnt(0)" ::: "memory");
    const int c = lane & 7;
#pragma unroll
    for (int j = 0; j < 4; ++j) { const int n = (lane >> 3) + 8 * j; const LAS float* s = scr + (8 * c) * 33 + n;
        u32x4 o; o.x = pk_bf16(s[0 * 33], s[1 * 33]); o.y = pk_bf16(s[2 * 33], s[3 * 33]); o.z = pk_bf16(s[4 * 33], s[5 * 33]); o.w = pk_bf16(s[6 * 33], s[7 * 33]);
        *(u32x4*)(WT + (size_t)(drow0 + n) * K + k0 + 8 * c) = o; }
    asm volatile("s_waitcnt lgkmcnt(0)" ::: "memory");
}
struct Fam { int src, count, K, Nd, ldw, map, gain, gstride; size_t sstride, dst, dstride; };
__device__ __forceinline__ int fam_items(const Fam& f) { return f.count * (f.K / 64) * (f.Nd / 32); }
__device__ __forceinline__ void fam_item(const Args& a, const Fam& f, int fid, int it, LAS float* scr, int lane) {
    const int per = (f.K / 64) * (f.Nd / 32), mi = it / per, r = it % per, nblk = f.Nd / 32, kb = r / nblk, nb = r % nblk, n0 = nb * 32;
    int sc0 = n0;
    if (f.map == 1) sc0 = n0 < 384 ? n0 : (n0 < 416 ? 640 + (n0 - 384) : (n0 < 512 ? -1 : 384 + (n0 - 512)));
    if (f.map == 2) { const int pn = n0 >> 8, jj = n0 & 255; sc0 = jj < 128 ? pn * 128 + jj : 2816 + pn * 128 + (jj - 128); }
    const float* gain = nullptr;
    if (f.gain >= 0) gain = a.in[f.gain] + (fid == 11 ? (size_t)(2 * (mi >> 3) + 1) * 1024 : (size_t)mi * f.gstride);
    transpose_item(a.in[f.src] + (size_t)mi * f.sstride, f.ldw, sc0, gain, (bf16_t*)(a.ws + f.dst + (size_t)mi * f.dstride), f.K, n0, kb * 64, scr, lane);
}
__constant__ const Fam FAMS[13] = {
        {4, 2, 1024, 768, 672, 1, 3, 1024, (size_t)1024 * 672, W_AIN, (size_t)768 * 1024 * 2},
        {7, 2, 384, 768, 768, 0, 5, 384, (size_t)384 * 768, W_QUP, (size_t)768 * 384 * 2},
        {8, 2, 256, 1024, 1024, 0, 6, 256, (size_t)256 * 1024, W_KVUP, (size_t)1024 * 256 * 2},
        {11, 2, 512, 1024, 1024, 0, -1, 0, (size_t)512 * 1024, W_AOUT, (size_t)1024 * 512 * 2},
        {13, 1, 1024, 512, 512, 0, 12, 0, 0, W_KVS, 0},
        {15, 2, 1024, 1024, 1024, 0, 14, 1024, (size_t)1024 * 1024, W_QB, (size_t)1024 * 1024 * 2},
        {16, 2, 1024, 1024, 1024, 0, -1, 0, (size_t)1024 * 1024, W_OB, (size_t)1024 * 1024 * 2},
        {24, 4, 1024, 1024, 1024, 0, 23, 1024, (size_t)1024 * 1024, W_PG, (size_t)1024 * 1024 * 2},
        {25, 4, 256, 1024, 1024, 0, -1, 0, (size_t)256 * 1024, W_PU, (size_t)1024 * 256 * 2},
        {18, 2, 1024, 5632, 5632, 2, 17, 2048, (size_t)1024 * 5632, W_FGU, (size_t)5632 * 1024 * 2},
        {19, 2, 2816, 1024, 1024, 0, -1, 0, (size_t)2816 * 1024, W_FDN, (size_t)1024 * 2816 * 2},
        {21, 16, 1024, 5632, 5632, 2, 17, 0, (size_t)1024 * 5632, W_EGU, (size_t)5632 * 1024 * 2},
        {22, 16, 2816, 1024, 1024, 0, -1, 0, (size_t)2816 * 1024, W_EDN, (size_t)1024 * 2816 * 2}};
__device__ __forceinline__ void prologue(const Args& a, Frame& F) {
    LAS float* scr = (LAS float*)(F.lds + RING_OFF + F.wave * 16384);
    const int gw = F.vcu * NWAVES + F.wave, NGW = F.G * NWAVES;
    int base = 0;
#pragma unroll 1
    for (int fid = 0; fid < 13; ++fid) { const Fam f = FAMS[fid]; const int n = fam_items(f);
        int it = gw - (base % NGW); if (it < 0) it += NGW;
#pragma unroll 1
        for (; it < n; it += NGW) fam_item(a, f, fid, it, scr, F.lane);
        base += n; }
    { const f32x4* src = (const f32x4*)a.in[1]; u32x2* dst = (u32x2*)(a.ws + WS_PB); const size_t n4 = (size_t)4 * MT * 256 / 4;
        for (size_t i = (size_t)gw * 64 + F.lane; i < n4; i += (size_t)NGW * 64) { const f32x4 v = src[i]; u32x2 o; o.x = pk_bf16(v[0], v[1]); o.y = pk_bf16(v[2], v[3]); dst[i] = o; } }
    { bf16_t* HB = (bf16_t*)(a.ws + WS_HB); float* SSQ = (float*)(a.ws + WS_SSQ);
        for (int row = gw; row < MT; row += NGW) { const f32x4* xr = (const f32x4*)(a.in[0] + (size_t)row * DMODEL) + F.lane; f32x4* hr = (f32x4*)(a.out + (size_t)row * DMODEL) + F.lane;
            u32x2* hb = (u32x2*)(HB + (size_t)row * DMODEL) + F.lane; float s = 0.f;
#pragma unroll
            for (int j = 0; j < 4; ++j) { const f32x4 v = xr[64 * j]; hr[64 * j] = v; u32x2 o; o.x = pk_bf16(v[0], v[1]); o.y = pk_bf16(v[2], v[3]); hb[64 * j] = o; s += (v[0] * v[0] + v[1] * v[1]) + (v[2] * v[2] + v[3] * v[3]); }
            s = wave_sum(s); if (F.lane < 16) SSQ[(size_t)row * 16 + F.lane] = F.lane == 0 ? s : 0.f; } }
    { float* cs = (float*)(a.ws + WS_CS); const int* pos = (const int*)a.in[2];
        for (int i = gw * 64 + F.lane; i < MT * 16; i += NGW * 64) { const int row = i >> 4, f = i & 15;
            const float invf = (float)exp(-9.210340371976184 * (double)f / 16.0);
            const double ang = (double)((float)pos[row] * invf);
            const double rev = ang * 0.15915494309189535, fr = rev - rint(rev); const float x = (float)(fr * 6.283185307179586);
            cs[(size_t)row * 32 + f] = cosf(x); cs[(size_t)row * 32 + 16 + f] = sinf(x); } }
}
__device__ __forceinline__ void norm_rope_8(f32x4& n0, f32x4& n1, f32x4& r0, f32x4& r1, const float* gain, const float* cs, int sub, float outscale) {
    float ss = pg8::sumsq8(n0, n1) + pg8::sumsq8(r0, r1);
    ss += __shfl_xor(ss, 1); ss += __shfl_xor(ss, 2); ss += __shfl_xor(ss, 4);
    const float rq = (1.0f / sqrtf(ss * (1.0f / 96.0f) + RMS_EPS));
    const f32x4 g0 = *(const f32x4*)(gain + 8 * sub), g1 = *(const f32x4*)(gain + 8 * sub + 4);
    n0 = n0 * g0 * (rq * outscale); n1 = n1 * g1 * (rq * outscale);
    const int s4 = sub & 3;
    const f32x4 h0 = *(const f32x4*)(gain + 64 + 8 * s4), h1 = *(const f32x4*)(gain + 64 + 8 * s4 + 4);
    r0 = r0 * h0 * (rq * outscale); r1 = r1 * h1 * (rq * outscale);
    f32x4 p0, p1;
#pragma unroll
    for (int j = 0; j < 4; ++j) { p0[j] = __shfl_xor(r0[j], 2); p1[j] = __shfl_xor(r1[j], 2); }
    const f32x4 c0 = *(const f32x4*)(cs + 8 * (sub & 1)), c1 = *(const f32x4*)(cs + 8 * (sub & 1) + 4), s0 = *(const f32x4*)(cs + 16 + 8 * (sub & 1)), s1 = *(const f32x4*)(cs + 16 + 8 * (sub & 1) + 4);
    if (s4 < 2) { r0 = r0 * c0 - p0 * s0; r1 = r1 * c1 - p1 * s1; }
    else { r0 = r0 * c0 + p0 * s0; r1 = r1 * c1 + p1 * s1; }
}
#define THIN_LAUNDER() Frame F = F_; unsigned char* wsl = a.ws; asm volatile("" : "+v"(F.tid), "+v"(F.lane), "+s"(F.wave), "+s"(F.vcu), "+s"(F.G), "+s"(wsl))
__device__ __forceinline__ void mla_prep(const Args& a, const Frame& F_, int layer) { THIN_LAUNDER();
    const bf16_t* QRAW = (const bf16_t*)(wsl + X_QRAW); const bf16_t* KVRAW = (const bf16_t*)(wsl + X_KVRAW); const float* KPE = (const float*)(wsl + WS_KPE);
    const float* CS = (const float*)(wsl + WS_CS); const float* gq = a.in[9] + layer * 96; const float* gk = a.in[10] + layer * 96;
    bf16_t* Q = (bf16_t*)(wsl + X_Q); bf16_t* KT = (bf16_t*)(wsl + X_KT); bf16_t* VT = (bf16_t*)(wsl + X_VT);
    const int gw = F.vcu * NWAVES + F.wave, NGW = F.G * NWAVES, h = F.lane >> 3, sub = F.lane & 7;
    const f32x4 z4 = {0.f, 0.f, 0.f, 0.f};
    for (int row = gw; row < MT; row += NGW) {
        const int b = row >> 13, sq = row & 8191, tile = sq >> 6, rr = sq & 63; const float* cs = CS + (size_t)row * 32;
        { const bf16_t* qrow = QRAW + (size_t)row * 768 + h * 96; f32x4 n0, n1, r0 = z4, r1 = z4;
            unpack8(*(const u32x4*)(qrow + 8 * sub), n0, n1); if (sub < 4) unpack8(*(const u32x4*)(qrow + 64 + 8 * sub), r0, r1);
            norm_rope_8(n0, n1, r0, r1, gq, cs, sub, QSCALE_MLA);
            bf16_t* qo = Q + (size_t)row * 768 + h * 96; *(u32x4*)(qo + 8 * sub) = pack8(n0, n1); if (sub < 4) *(u32x4*)(qo + 64 + 8 * sub) = pack8(r0, r1); }
        { const bf16_t* krow = KVRAW + (size_t)row * 1024 + h * 128; f32x4 n0, n1, r0 = z4, r1 = z4;
            unpack8(*(const u32x4*)(krow + 8 * sub), n0, n1); if (sub < 4) { r0 = *(const f32x4*)(KPE + (size_t)row * 32 + 8 * sub); r1 = *(const f32x4*)(KPE + (size_t)row * 32 + 8 * sub + 4); }
            norm_rope_8(n0, n1, r0, r1, gk, cs, sub, 1.0f);
            bf16_t* kt = KT + (size_t)((b * 8 + h) * 128 + tile) * 6144 + rr * 8; *(u32x4*)(kt + sub * 512) = pack8(n0, n1); if (sub < 4) *(u32x4*)(kt + (8 + sub) * 512) = pack8(r0, r1);
            const u32x4 v = *(const u32x4*)(krow + 64 + 8 * sub);
            *(u32x4*)(VT + (size_t)((b * 8 + h) * 128 + tile) * 4096 + (sub >> 2) * 2048 + rr * 32 + (sub & 3) * 8) = v; }
    }
}
__device__ __forceinline__ void moe_route(const Args& a, const Frame& F_, int layer) { THIN_LAUNDER();
    const float* H = a.out; const float* gain = a.in[17] + (size_t)layer * 1024; const float* wr = a.in[20] + (size_t)(layer >> 1) * 1024 * 8;
    int* TOKE = (int*)(wsl + WS_TOKE); float* TOKG = (float*)(wsl + WS_TOKG); float* TOKRS = (float*)(wsl + WS_TOKRS); int* CNT = (int*)(wsl + WS_CNT);
    LAS float* wg = (LAS float*)(F.lds + RING_OFF);
    LAS int* lcnt = (LAS int*)(F.lds + RING_OFF + 32768);
    for (int i = F.tid; i < 1024 * 8; i += NTHR) wg[i] = wr[i] * gain[i >> 3];
    for (int chunk = F.vcu; chunk < MT / 64; chunk += F.G) {
        if (F.tid < 8) lcnt[F.tid] = 0;
        __syncthreads();
        for (int tt = 0; tt < 8; ++tt) { const int tok = chunk * 64 + F.wave * 8 + tt;
            const f32x4* hr = (const f32x4*)(H + (size_t)tok * DMODEL) + F.lane; float lg[8], ss = 0.f;
#pragma unroll
            for (int e = 0; e < 8; ++e) lg[e] = 0.f;
#pragma unroll
            for (int j = 0; j < 4; ++j) { const f32x4 v = hr[64 * j]; ss += (v[0] * v[0] + v[1] * v[1]) + (v[2] * v[2] + v[3] * v[3]);
#pragma unroll
                for (int i = 0; i < 4; ++i) { const LAS f32x4* w = (const LAS f32x4*)(wg + (size_t)(256 * j + 4 * F.lane + i) * 8); const f32x4 w0 = w[0], w1 = w[1];
                    lg[0] += v[i] * w0[0]; lg[1] += v[i] * w0[1]; lg[2] += v[i] * w0[2]; lg[3] += v[i] * w0[3]; lg[4] += v[i] * w1[0]; lg[5] += v[i] * w1[1]; lg[6] += v[i] * w1[2]; lg[7] += v[i] * w1[3]; } }
            ss = wave_sum(ss);
#pragma unroll
            for (int e = 0; e < 8; ++e) lg[e] = wave_sum(lg[e]);
            const float r = 1.0f / sqrtf(ss * (1.0f / 1024.0f) + RMS_EPS);
            int e1 = 0; float v1 = lg[0];
#pragma unroll
            for (int e = 1; e < 8; ++e) if (lg[e] > v1) { v1 = lg[e]; e1 = e; }
            int e2 = 0; float v2 = -3.0e38f;
#pragma unroll
            for (int e = 0; e < 8; ++e) if (e != e1 && lg[e] > v2) { v2 = lg[e]; e2 = e; }
            const float p2 = __expf((v2 - v1) * r), g1 = 1.0f / (1.0f + p2), g2 = p2 / (1.0f + p2);
            if (F.lane == 0) { TOKE[tok] = e1 | (e2 << 8); TOKG[tok * 2] = g1; TOKG[tok * 2 + 1] = g2; TOKRS[tok] = r; __hip_atomic_fetch_add(lcnt + e1, 1, __ATOMIC_RELAXED, __HIP_MEMORY_SCOPE_WORKGROUP); __hip_atomic_fetch_add(lcnt + e2, 1, __ATOMIC_RELAXED, __HIP_MEMORY_SCOPE_WORKGROUP); }
        }
        __syncthreads();
        if (F.tid < 8) CNT[chunk * 8 + F.tid] = lcnt[F.tid];
        __syncthreads();
    }
}
__device__ __forceinline__ void moe_scatter(const Args& a, const Frame& F_, int cur) { THIN_LAUNDER();
    const int* TOKE = (const int*)(wsl + WS_TOKE); const float* TOKG = (const float*)(wsl + WS_TOKG); const float* TOKRS = (const float*)(wsl + WS_TOKRS); const int* CNT = (const int*)(wsl + WS_CNT);
    int* SLOT12 = (int*)(wsl + WS_SLOT12); float* SLOTG = (float*)(wsl + WS_SLOTG); float* SLOTRS = (float*)(wsl + WS_SLOTRS); int* PSTART = (int*)(wsl + WS_PSTART);
    const bf16_t* HB = (const bf16_t*)(wsl + WS_HB) + (size_t)cur * MT * DMODEL; bf16_t* XG = (bf16_t*)(wsl + X_XG);
    LAS int* sm = (LAS int*)(F.lds + RING_OFF);
    for (int chunk = F.vcu; chunk < MT / 64; chunk += F.G) {
        { const int e = F.wave; int c4[4]; int s = 0;
#pragma unroll
            for (int i = 0; i < 4; ++i) { c4[i] = CNT[(4 * F.lane + i) * 8 + e]; s += c4[i]; }
            int inc = s;
#pragma unroll
            for (int o = 1; o < 64; o <<= 1) { const int t = __shfl_up(inc, o); if (F.lane >= o) inc += t; }
            const int total = __shfl(inc, 63); int pre = inc - s;
            if (F.lane == (chunk >> 2)) { const int cm = chunk & 3; pre += (cm > 0 ? c4[0] : 0) + (cm > 1 ? c4[1] : 0) + (cm > 2 ? c4[2] : 0); sm[8 + e] = pre; }
            if (F.lane == 0) sm[e] = total; }
        __syncthreads();
        if (F.tid == 0) { int p = 0; for (int e = 0; e < 8; ++e) { sm[16 + e] = p; p += (sm[e] + 255) >> 8; } sm[24] = p; }
        __syncthreads();
        if (F.tid < 9) PSTART[F.tid] = sm[16 + F.tid];
        if (F.wave == 0) { const int tok = chunk * 64 + F.lane; const int ev = TOKE[tok], e1 = ev & 255, e2 = ev >> 8; int s1 = 0, s2 = 0;
            const unsigned long long below = (1ull << F.lane) - 1ull;
#pragma unroll
            for (int e = 0; e < 8; ++e) { const unsigned long long m1 = __ballot(e1 == e), m2 = __ballot(e2 == e);
                const int rank = __popcll(m1 & below) + __popcll(m2 & below), slot = sm[16 + e] * 256 + sm[8 + e] + rank;
                if (e1 == e) s1 = slot; if (e2 == e) s2 = slot; }
            SLOT12[tok * 2] = s1; SLOT12[tok * 2 + 1] = s2; const float r = TOKRS[tok];
            SLOTG[s1] = TOKG[tok * 2]; SLOTG[s2] = TOKG[tok * 2 + 1]; SLOTRS[s1] = r; SLOTRS[s2] = r;
            sm[32 + 2 * F.lane] = s1; sm[32 + 2 * F.lane + 1] = s2; }
        __syncthreads();
        for (int i = 0; i < 16; ++i) { const int pr = F.wave * 16 + i, tok = chunk * 64 + (pr >> 1), slot = sm[32 + pr];
            const u32x4* src = (const u32x4*)(HB + (size_t)tok * DMODEL) + F.lane; u32x4* dst = (u32x4*)(XG + (size_t)slot * DMODEL) + F.lane;
            dst[0] = src[0]; dst[64] = src[64]; }
        __syncthreads();
    }
}
__device__ __forceinline__ void moe_combine(const Args& a, const Frame& F_, int cur) { THIN_LAUNDER();
    const int* SLOT12 = (const int*)(wsl + WS_SLOT12); const bf16_t* YG = (const bf16_t*)(wsl + X_YG);
    bf16_t* HB = (bf16_t*)(wsl + WS_HB) + (size_t)cur * MT * DMODEL; float* SSQ = (float*)(wsl + WS_SSQ) + (size_t)cur * MT * 16;
    const int gw = F.vcu * NWAVES + F.wave, NGW = F.G * NWAVES;
    for (int row = gw; row < MT; row += NGW) { const int s1 = SLOT12[row * 2], s2 = SLOT12[row * 2 + 1];
        f32x4* hr = (f32x4*)(a.out + (size_t)row * DMODEL) + F.lane; u32x2* hb = (u32x2*)(HB + (size_t)row * DMODEL) + F.lane;
        const u32x2* y1 = (const u32x2*)(YG + (size_t)s1 * DMODEL) + F.lane; const u32x2* y2 = (const u32x2*)(YG + (size_t)s2 * DMODEL) + F.lane; float s = 0.f;
#pragma unroll
        for (int j = 0; j < 4; ++j) { f32x4 v = hr[64 * j]; const u32x2 p = y1[64 * j], q = y2[64 * j];
            v[0] += bf_lo(p.x) + bf_lo(q.x); v[1] += bf_hi(p.x) + bf_hi(q.x); v[2] += bf_lo(p.y) + bf_lo(q.y); v[3] += bf_hi(p.y) + bf_hi(q.y);
            hr[64 * j] = v; u32x2 o; o.x = pk_bf16(v[0], v[1]); o.y = pk_bf16(v[2], v[3]); hb[64 * j] = o; s += (v[0] * v[0] + v[1] * v[1]) + (v[2] * v[2] + v[3] * v[3]); }
        s = wave_sum(s); if (F.lane < 16) SSQ[(size_t)row * 16 + F.lane] = F.lane == 0 ? s : 0.f; }
}

__global__ void __launch_bounds__(NTHR, 2) yoco_fwd(Args args) {
    extern __shared__ __attribute__((aligned(16))) unsigned char lds_raw[];
    Frame F; F.lds = (LAS unsigned char*)lds_raw;
    volatile LAS unsigned* MISC = (volatile LAS unsigned*)(F.lds + MISC_OFF);
    F.tid = threadIdx.x; F.lane = F.tid & 63; F.wave = __builtin_amdgcn_readfirstlane(F.tid >> 6);
    F.G = gridDim.x; { const int bx = blockIdx.x; F.vcu = (F.G % 8 == 0) ? (bx % 8) * (F.G / 8) + bx / 8 : bx; }
    for (int u = F.tid; u < (LDS_BYTES - LDSCTL_OFF) / 4; u += NTHR) ((LAS unsigned*)(F.lds + LDSCTL_OFF))[u] = 0u;
    __syncthreads();
    unsigned char* ws = args.ws;
#define WS_LAUNDER() asm volatile("" : "+s"(ws), "+s"(bx), "+s"(F.G), "+s"(F.vcu))
    const bool single = (args.ph_hi - args.ph_lo) > 1;
    XcdBarrier bar; bar.bar = (unsigned*)(ws + WS_CTL) + CW_BAR; bar.x = 0; bar.st = nullptr;
    if (single) bar = xcd_barrier_post((unsigned*)(ws + WS_CTL) + CW_BAR, MISC + 8);
    const int lo = args.ph_lo, hi = args.ph_hi;
#ifndef EN_MASK
#define EN_MASK 0xFFFFFFFFu
#endif
#define EN(b) (((EN_MASK) >> (b)) & 1u)
#define IN(k) (lo <= (k) && (k) < hi)
#define SEAM(k) do { if (single && (k) + 1 < hi) { XcdBarrier b_ = bar; asm volatile("" : "+s"(b_.bar), "+s"(b_.x)); xcd_barrier(b_); } } while (0)
    LAS unsigned char* ring = F.lds + RING_OFF;
    int bx = (int)blockIdx.x;

    if (EN(0) && IN(0)) { prologue(args, F); SEAM(0); }
    if (EN(1) && IN(1)) { WS_LAUNDER();
#pragma unroll 1
        for (int i = 0; i < 4; ++i) {
            pg8::Gemm g{(const bf16_t*)(ws + WS_PB) + (size_t)i * MT * 256, (const bf16_t*)(ws + W_PU) + (size_t)i * 1024 * 256, MT, 1024, 256};
            pg8::StaticOrder S; S.init(MT, 1024, F.G, bx);
            pg8::EpiScale E{(bf16_t*)(ws + WS_U) + (size_t)i * MT * DMODEL, 1024, pg8::RowScale{nullptr, 0}, 1.0f};
            pg8::gemm_phase<pg8::EpiScale, pg8::StaticOrder, true, true>(ring, g, S, E);
        }
        SEAM(1);
    }
#pragma unroll 1
    for (int l = 0; l < 4; ++l) {
        const int base = 2 + PH_PER_LAYER * l; const bool is_mla = l < 2, is_moe = (l & 1) != 0; const int cur = l & 1, j = l & 1;
#define HBc ((const bf16_t*)(ws + WS_HB) + (size_t)cur * MT * DMODEL)
#define HBw ((bf16_t*)(ws + WS_HB) + (size_t)cur * MT * DMODEL)
#define SSQc ((float*)(ws + WS_SSQ) + (size_t)cur * MT * 16)
        if (IN(base + 0)) { WS_LAUNDER();
            if (EN(2) && is_mla) {
                pg8::Gemm g{HBc, (const bf16_t*)(ws + W_AIN) + (size_t)l * 768 * 1024, MT, 768, 1024};
                pg8::StaticOrder S; S.init(MT, 768, F.G, bx);
                pg8::EpiAin E{(bf16_t*)(ws + X_AQ), (bf16_t*)(ws + X_AKV), (float*)(ws + WS_KPE), (float*)(ws + WS_SSQQ), (float*)(ws + WS_SSQKV), pg8::RowScale{SSQc, 1}};
                pg8::gemm_phase<pg8::EpiAin, pg8::StaticOrder, true, true>(ring, g, S, E);
            } else if (EN(3) && !is_mla) {
                pg8::Gemm g{HBc, (const bf16_t*)(ws + W_QB) + (size_t)j * 1024 * 1024, MT, 1024, 1024};
                pg8::StaticOrder S; S.init(MT, 1024, F.G, bx);
                pg8::EpiScale E{(bf16_t*)(ws + X_SQ), 1024, pg8::RowScale{SSQc, 1}, QSCALE_SB};
                pg8::gemm_phase<pg8::EpiScale, pg8::StaticOrder, true, true>(ring, g, S, E);
            }
            SEAM(base + 0);
        }
        if (EN(4) && is_mla && IN(base + 1)) { WS_LAUNDER();
            { pg8::Gemm g{(const bf16_t*)(ws + X_AQ), (const bf16_t*)(ws + W_QUP) + (size_t)l * 768 * 384, MT, 768, 384};
              pg8::StaticOrder S; S.init(MT, 768, F.G, bx);
              pg8::EpiScale E{(bf16_t*)(ws + X_QRAW), 768, pg8::RowScale{(const float*)(ws + WS_SSQQ), 3}, 1.0f};
              pg8::gemm_phase<pg8::EpiScale, pg8::StaticOrder, true, true>(ring, g, S, E); }
            { pg8::Gemm g{(const bf16_t*)(ws + X_AKV), (const bf16_t*)(ws + W_KVUP) + (size_t)l * 1024 * 256, MT, 1024, 256};
              pg8::StaticOrder S; S.init(MT, 1024, F.G, bx);
              pg8::EpiScale E{(bf16_t*)(ws + X_KVRAW), 1024, pg8::RowScale{(const float*)(ws + WS_SSQKV), 4}, 1.0f};
              pg8::gemm_phase<pg8::EpiScale, pg8::StaticOrder, true, true>(ring, g, S, E); }
            SEAM(base + 1);
        }
        if (EN(5) && is_mla && IN(base + 2)) { mla_prep(args, F, l); SEAM(base + 2); }
        if (IN(base + 3)) { WS_LAUNDER();
            if (EN(6) && is_mla) att::mla::phase(F.vcu, F.G, (const bf16_t*)(ws + X_Q), (const bf16_t*)(ws + X_KT), (const bf16_t*)(ws + X_VT), (bf16_t*)(ws + X_O), ring);
            else if (EN(7) && !is_mla) att::sba::phase(F.vcu, F.G, (const bf16_t*)(ws + X_SQ), (const bf16_t*)(ws + WS_SKT), (const bf16_t*)(ws + WS_SVT), (bf16_t*)(ws + X_SO), ring);
            SEAM(base + 3);
        }
        if (EN(8) && IN(base + 4)) { WS_LAUNDER();
            pg8::Gemm g = is_mla ? pg8::Gemm{(const bf16_t*)(ws + X_O), (const bf16_t*)(ws + W_AOUT) + (size_t)l * 1024 * 512, MT, 1024, 512}
                                 : pg8::Gemm{(const bf16_t*)(ws + X_SO), (const bf16_t*)(ws + W_OB) + (size_t)j * 1024 * 1024, MT, 1024, 1024};
            pg8::StaticOrder S; S.init(MT, 1024, F.G, bx);
            pg8::EpiRes<false> E{args.out, HBw, SSQc, nullptr, pg8::RowScale{nullptr, 0}};
            pg8::gemm_phase<pg8::EpiRes<false>, pg8::StaticOrder, true, true>(ring, g, S, E);
            SEAM(base + 4);
        }
        if (!is_moe) {
            if (EN(9) && IN(base + 5)) { WS_LAUNDER();
                pg8::Gemm g{HBc, (const bf16_t*)(ws + W_FGU) + (size_t)(l >> 1) * 5632 * 1024, MT, 5632, 1024};
                pg8::GroupOrder S; S.init_dense(MT, 5632, F.G, bx);
                pg8::EpiSwiglu E{(bf16_t*)(ws + X_HID), pg8::RowScale{SSQc, 1}};
                pg8::gemm_phase<pg8::EpiSwiglu, pg8::GroupOrder, true, true>(ring, g, S, E);
                SEAM(base + 5);
            }
            if (EN(10) && IN(base + 6)) { WS_LAUNDER();
                pg8::Gemm g{(const bf16_t*)(ws + X_HID), (const bf16_t*)(ws + W_FDN) + (size_t)(l >> 1) * 1024 * 2816, MT, 1024, 2816};
                pg8::StaticOrder S; S.init(MT, 1024, F.G, bx);
                pg8::EpiRes<false> E{args.out, HBw, SSQc, nullptr, pg8::RowScale{nullptr, 0}};
                pg8::gemm_phase<pg8::EpiRes<false>, pg8::StaticOrder, true, true>(ring, g, S, E);
                SEAM(base + 6);
            }
        } else {
            if (EN(11) && IN(base + 5)) { WS_LAUNDER(); moe_route(args, F, l); SEAM(base + 5); }
            if (EN(12) && IN(base + 6)) { WS_LAUNDER(); moe_scatter(args, F, cur); SEAM(base + 6); }
            if (EN(13) && IN(base + 7)) { WS_LAUNDER();
                pg8::Gemm g{(const bf16_t*)(ws + X_XG), (const bf16_t*)(ws + W_EGU) + (size_t)(l >> 1) * 8 * 5632 * 1024, MAXSLOT, 5632, 1024};
                pg8::GroupOrder S; S.init((const int*)(ws + WS_PSTART), 5632, F.G, bx, (size_t)5632 * 1024 * 2);
                pg8::EpiSwiglu E{(bf16_t*)(ws + X_HG), pg8::RowScale{(const float*)(ws + WS_SLOTRS), 2}};
                pg8::gemm_phase<pg8::EpiSwiglu, pg8::GroupOrder, true, true>(ring, g, S, E);
                SEAM(base + 7);
            }
            if (EN(14) && IN(base + 8)) { WS_LAUNDER();
                pg8::Gemm g{(const bf16_t*)(ws + X_HG), (const bf16_t*)(ws + W_EDN) + (size_t)(l >> 1) * 8 * 1024 * 2816, MAXSLOT, 1024, 2816};
                pg8::GroupOrder S; S.init((const int*)(ws + WS_PSTART), 1024, F.G, bx, (size_t)1024 * 2816 * 2);
                pg8::EpiScale E{(bf16_t*)(ws + X_YG), 1024, pg8::RowScale{(const float*)(ws + WS_SLOTG), 2}, 1.0f};
                pg8::gemm_phase<pg8::EpiScale, pg8::GroupOrder, true, true>(ring, g, S, E);
                SEAM(base + 8);
            }
            if (EN(15) && IN(base + 9)) { WS_LAUNDER(); moe_combine(args, F, cur); SEAM(base + 9); }
        }
        if (EN(16) && IN(base + 10)) { WS_LAUNDER();
            pg8::Gemm g{HBc, (const bf16_t*)(ws + W_PG) + (size_t)l * 1024 * 1024, MT, 1024, 1024};
            pg8::StaticOrder S; S.init(MT, 1024, F.G, bx);
            pg8::EpiRes<true> E{args.out, (bf16_t*)(ws + WS_HB) + (size_t)(cur ^ 1) * MT * DMODEL, (float*)(ws + WS_SSQ) + (size_t)(cur ^ 1) * MT * 16,
                                (const bf16_t*)(ws + WS_U) + (size_t)l * MT * DMODEL, pg8::RowScale{SSQc, 1}};
            pg8::gemm_phase<pg8::EpiRes<true>, pg8::StaticOrder, true, true>(ring, g, S, E);
            SEAM(base + 10);
        }
        if (EN(17) && l == 1 && IN(base + 11)) { WS_LAUNDER();
            pg8::Gemm g{(const bf16_t*)(ws + WS_HB) + (size_t)(cur ^ 1) * MT * DMODEL, (const bf16_t*)(ws + W_KVS), MT, 512, 1024};
            pg8::StaticOrder S; S.init(MT, 512, F.G, bx);
            pg8::EpiKvs E{(bf16_t*)(ws + WS_SKT), (bf16_t*)(ws + WS_SVT), pg8::RowScale{(const float*)(ws + WS_SSQ) + (size_t)(cur ^ 1) * MT * 16, 1}};
            pg8::gemm_phase<pg8::EpiKvs, pg8::StaticOrder, true, true>(ring, g, S, E);
            SEAM(base + 11);
        }
    }
#undef IN
#undef SEAM
}
}
#define MULTI_LAUNCH 1
extern "C" void kernel_launch(void* const* d_in, const int* in_sizes, int n_in, void* d_out, int out_size, void* d_ws, size_t ws_size, hipStream_t stream) {
    using namespace fw;
    static int grid = 0;
    if (grid == 0) {
        if (n_in != 26 || out_size != MT * DMODEL || ws_size < WS_END) { fprintf(stderr, "kernel_launch: unexpected n_in %d / out %d / ws %zu\n", n_in, out_size, ws_size); grid = -1; return; }
        if (hipFuncSetAttribute((const void*)yoco_fwd, hipFuncAttributeMaxDynamicSharedMemorySize, LDS_BYTES) != hipSuccess) { fprintf(stderr, "kernel_launch: hipFuncSetAttribute failed\n"); grid = -1; return; }
        int dev = 0, cus = 0, per_cu = 0;
        (void)hipGetDevice(&dev); (void)hipDeviceGetAttribute(&cus, hipDeviceAttributeMultiprocessorCount, dev);
        (void)hipOccupancyMaxActiveBlocksPerMultiprocessor(&per_cu, (const void*)yoco_fwd, NTHR, LDS_BYTES);
        (void)hipGetLastError();
        grid = (cus > 0 && per_cu >= 1) ? cus : 256;
        if (grid > 256) grid = 256;
    }
    if (grid < 0) return;
    (void)hipMemsetAsync((unsigned char*)d_ws + WS_CTL, 0, CTL_ZERO_BYTES, stream);
    Args a{};
    for (int i = 0; i < 26; ++i) a.in[i] = (const float*)d_in[i];
    a.out = (float*)d_out; a.ws = (unsigned char*)d_ws;
#if MULTI_LAUNCH
    for (int k = 0; k < PH_TOTAL; ++k) { if (!phase_active(k)) continue; a.ph_lo = k; a.ph_hi = k + 1; hipLaunchKernelGGL(yoco_fwd, dim3(grid), dim3(NTHR), LDS_BYTES, stream, a); }
#else
    a.ph_lo = 0; a.ph_hi = PH_TOTAL - 1;
    hipLaunchKernelGGL(yoco_fwd, dim3(grid), dim3(NTHR), LDS_BYTES, stream, a);
#endif
}
```

```cpp
#include <hip/hip_runtime.h>
#include <cstdio>
#include <cstdint>
#include <cmath>
#define LAS __attribute__((address_space(3)))
#define GAS __attribute__((address_space(1)))
typedef unsigned short bf16_t;
typedef short bf16x8 __attribute__((ext_vector_type(8)));
typedef float f32x4 __attribute__((ext_vector_type(4)));
typedef float f32x2 __attribute__((ext_vector_type(2)));
typedef float f32x16 __attribute__((ext_vector_type(16)));
typedef unsigned u32x4 __attribute__((ext_vector_type(4)));
typedef unsigned u32x2 __attribute__((ext_vector_type(2)));
typedef short s16x4 __attribute__((ext_vector_type(4)));
typedef __bf16 bf16x2_t __attribute__((ext_vector_type(2)));

constexpr int MT = 16384, DMODEL = 1024, SEQL = 8192;
constexpr float RMS_EPS = 1e-6f;
constexpr float LOG2E = 1.4426950408889634f;

__device__ __forceinline__ unsigned pk_bf16(float lo, float hi) { f32x2 v = {lo, hi}; bf16x2_t b = __builtin_convertvector(v, bf16x2_t); return __builtin_bit_cast(unsigned, b); }
__device__ __forceinline__ float bf_lo(unsigned w) { return __uint_as_float(w << 16); }
__device__ __forceinline__ float bf_hi(unsigned w) { return __uint_as_float(w & 0xffff0000u); }
__device__ __forceinline__ unsigned cvt_pk_bf16(float lo, float hi) { unsigned r; asm volatile("v_cvt_pk_bf16_f32 %0, %1, %2" : "=v"(r) : "v"(lo), "v"(hi)); return r; }
__device__ __forceinline__ u32x4 pack8(const f32x4 a, const f32x4 b) { u32x4 w; w.x = cvt_pk_bf16(a[0], a[1]); w.y = cvt_pk_bf16(a[2], a[3]); w.z = cvt_pk_bf16(b[0], b[1]); w.w = cvt_pk_bf16(b[2], b[3]); return w; }
__device__ __forceinline__ void unpack8(const u32x4 w, f32x4& a, f32x4& b) { a = (f32x4){bf_lo(w.x), bf_hi(w.x), bf_lo(w.y), bf_hi(w.y)}; b = (f32x4){bf_lo(w.z), bf_hi(w.z), bf_lo(w.w), bf_hi(w.w)}; }
__device__ __forceinline__ float fast_rcp(float x) { return __builtin_amdgcn_rcpf(x); }
__device__ __forceinline__ float fast_exp2(float x) { return __builtin_amdgcn_exp2f(x); }
__device__ __forceinline__ float fast_log2(float x) { return __builtin_amdgcn_logf(x); }
__device__ __forceinline__ float sigmoidf_(float x) { return fast_rcp(1.0f + fast_exp2(-x * LOG2E)); }

namespace pg8 {
constexpr int BM = 256, BK = 64, HALF = 128, HTB = HALF * BK * 2, STAGE_BYTES = 8 * HTB, NXCD = 8, WGM = 8;
__host__ __device__ __forceinline__ int lds_byte(int r, int c) { const int st = (r >> 4) * 2 + (c >> 5), rr = r & 15, cc = c & 31, ob = rr * 64 + cc * 2; return st * 1024 + (ob ^ (((ob >> 9) & 1) << 5)); }
__host__ __device__ __forceinline__ void stage_rc(int b, int& R, int& C) { const int st = b / 1024, sb = b % 1024, swz = sb ^ (((sb >> 9) & 1) << 5); R = (st >> 1) * 16 + swz / 64; C = (st & 1) * 32 + (swz % 64) / 2; }
__host__ __device__ __forceinline__ int perm32(int rho) { const int n = rho >> 4, i = rho & 15; return 8 * (i >> 2) + 4 * n + (i & 3); }

struct Unit { int pm, pn; size_t boff; };
struct Gemm { const bf16_t* A; const bf16_t* Bt; int M, N, K; };

struct StaticOrder {
    int nM, nN, nwg, G, c;
    __device__ void init(int M, int N, int G_, int c_) { nM = M / BM; nN = N / BM; nwg = nM * nN; G = G_; c = c_; }
    __device__ bool next(int i, Unit& u) const {
        const long L = (long)i * G + c; if (L >= nwg) return false;
        int wgid = (int)L; { const int q = nwg / NXCD, r = nwg % NXCD, xcd = wgid % NXCD, off = wgid / NXCD; wgid = (xcd < r ? xcd * (q + 1) : r * (q + 1) + (xcd - r) * q) + off; }
        const int nig = WGM * nN, gid = wgid / nig, fm = gid * WGM, gsz = (nM - fm) < WGM ? (nM - fm) : WGM;
        u.pm = fm + ((wgid % nig) % gsz); u.pn = (wgid % nig) / gsz; u.boff = 0; return true;
    }
};
struct GroupOrder {
    int ps[9]; int nN, nwg, G, c; size_t estride;
    __device__ void init(const int* pstart, int N, int G_, int c_, size_t estride_) {
#pragma unroll
        for (int e = 0; e < 9; ++e) ps[e] = __builtin_amdgcn_readfirstlane(pstart[e]);
        nN = N / BM; nwg = ps[8] * nN; G = G_; c = c_; estride = estride_; }
    __device__ void init_dense(int M, int N, int G_, int c_) {
        ps[0] = 0;
#pragma unroll
        for (int e = 1; e < 9; ++e) ps[e] = M / BM;
        nN = N / BM; nwg = ps[8] * nN; G = G_; c = c_; estride = 0; }
    __device__ bool next(int i, Unit& u) const {
        const long L = (long)i * G + c; if (L >= nwg) return false;
        int wgid = (int)L; { const int q = nwg / NXCD, r = nwg % NXCD, xcd = wgid % NXCD, off = wgid / NXCD; wgid = (xcd < r ? xcd * (q + 1) : r * (q + 1) + (xcd - r) * q) + off; }
        int e = 0;
#pragma unroll
        for (int k = 1; k < 8; ++k) if (wgid >= ps[k] * nN) e = k;
        int p0 = ps[0], p1 = ps[1];
#pragma unroll
        for (int k = 1; k < 8; ++k) if (e == k) { p0 = ps[k]; p1 = ps[k + 1]; }
        const int local = wgid - p0 * nN, np = p1 - p0;
        u.pn = local / np; u.pm = p0 + (local % np); u.boff = (size_t)e * estride; return true;
    }
};


__device__ __forceinline__ float sumsq8(const f32x4 a, const f32x4 b) { return ((a[0] * a[0] + a[1] * a[1]) + (a[2] * a[2] + a[3] * a[3])) + ((b[0] * b[0] + b[1] * b[1]) + (b[2] * b[2] + b[3] * b[3])); }
__device__ __forceinline__ float red_fq(float s) { s += __shfl_xor(s, 16); s += __shfl_xor(s, 32); return s; }
struct RowScale {
    const float* p; int mode;
    __device__ __forceinline__ float get(int row, int fq) const {
        if (mode == 0) return 1.0f;
        if (mode == 2) return p[row];
        if (mode == 1) { const f32x4 a = *(const f32x4*)(p + (size_t)row * 16 + 4 * fq); const float s = red_fq((a[0] + a[1]) + (a[2] + a[3])); return 1.0f / sqrtf(s * (1.0f / 1024.0f) + RMS_EPS); }
        if (mode == 3) { const f32x4 a = *(const f32x4*)(p + (size_t)row * 8 + 4 * (fq & 1)); const float s = red_fq(fq < 2 ? (a[0] + a[1]) + (a[2] + a[3]) : 0.f); return 1.0f / sqrtf(s * (1.0f / 384.0f) + RMS_EPS); }
        { const float s = red_fq(p[(size_t)row * 4 + fq]); return 1.0f / sqrtf(s * (1.0f / 256.0f) + RMS_EPS); }
    }
    __device__ __forceinline__ void get8(float (&rsv)[2][4], int row0, int fq) const {
#pragma unroll
        for (int ai = 0; ai < 2; ++ai)
#pragma unroll
            for (int m = 0; m < 4; ++m) rsv[ai][m] = get(row0 + ai * 128 + m * 16, fq);
        asm volatile("" ::: "memory");
    }
};

struct EpiScale {
    static constexpr bool PERM = true, AFTER_DRAIN = false;
    bf16_t* O; int ldc; RowScale rs; float cs;
    __device__ __forceinline__ void operator()(const f32x4 (&acc)[2][2][4][2], const Unit& u, int wr, int wc, int fr, int fq) const {
        const int row0 = u.pm * BM + wr * 64 + fr, col0 = u.pn * BM + wc * 32 + 8 * fq;
        float rsv[2][4]; rs.get8(rsv, row0, fq);
#pragma unroll
        for (int ai = 0; ai < 2; ++ai)
#pragma unroll
            for (int m = 0; m < 4; ++m) { const int row = row0 + ai * HALF + m * 16; const float s = rsv[ai][m] * cs; bf16_t* rowp = O + (size_t)row * ldc + col0;
#pragma unroll
                for (int bj = 0; bj < 2; ++bj) *(u32x4*)(rowp + bj * HALF) = pack8(acc[ai][bj][m][0] * s, acc[ai][bj][m][1] * s); }
    }
};
struct EpiAin {
    static constexpr bool PERM = true, AFTER_DRAIN = false;
    bf16_t* AQ; bf16_t* AKV; float* KPE; float* SSQQ; float* SSQKV; RowScale rs;
    __device__ __forceinline__ void operator()(const f32x4 (&acc)[2][2][4][2], const Unit& u, int wr, int wc, int fr, int fq) const {
        const int row0 = u.pm * BM + wr * 64 + fr, c8 = wc * 32 + 8 * fq;
        float rsv[2][4]; rs.get8(rsv, row0, fq);
#pragma unroll
        for (int ai = 0; ai < 2; ++ai)
#pragma unroll
            for (int m = 0; m < 4; ++m) { const int row = row0 + ai * HALF + m * 16; const float s = rsv[ai][m];
                const f32x4 a0 = acc[ai][0][m][0] * s, a1 = acc[ai][0][m][1] * s, b0 = acc[ai][1][m][0] * s, b1 = acc[ai][1][m][1] * s;
                if (u.pn == 0) {
                    *(u32x4*)(AQ + (size_t)row * 384 + c8) = pack8(a0, a1); *(u32x4*)(AQ + (size_t)row * 384 + 128 + c8) = pack8(b0, b1);
                    const float q = red_fq(sumsq8(a0, a1) + sumsq8(b0, b1)); if (fq == 0) SSQQ[(size_t)row * 8 + wc] = q;
                } else if (u.pn == 1) {
                    *(u32x4*)(AQ + (size_t)row * 384 + 256 + c8) = pack8(a0, a1);
                    const float q = red_fq(sumsq8(a0, a1)); if (fq == 0) SSQQ[(size_t)row * 8 + 4 + wc] = q;
                    if (wc == 0) { *(f32x4*)(KPE + (size_t)row * 32 + 8 * fq) = b0; *(f32x4*)(KPE + (size_t)row * 32 + 8 * fq + 4) = b1; }
                } else {
                    *(u32x4*)(AKV + (size_t)row * 256 + c8) = pack8(a0, a1); *(u32x4*)(AKV + (size_t)row * 256 + 128 + c8) = pack8(b0, b1);
                    const float q = red_fq(sumsq8(a0, a1) + sumsq8(b0, b1)); if (fq == 0) SSQKV[(size_t)row * 4 + wc] = q;
                } }
    }
};
struct EpiSwiglu {
    static constexpr bool PERM = true, AFTER_DRAIN = false;
    bf16_t* HID; RowScale rs;
    __device__ __forceinline__ void operator()(const f32x4 (&acc)[2][2][4][2], const Unit& u, int wr, int wc, int fr, int fq) const {
        const int row0 = u.pm * BM + wr * 64 + fr, col0 = u.pn * 128 + wc * 32 + 8 * fq;
        float rsv[2][4]; rs.get8(rsv, row0, fq);
#pragma unroll
        for (int ai = 0; ai < 2; ++ai)
#pragma unroll
            for (int m = 0; m < 4; ++m) { const int row = row0 + ai * HALF + m * 16; const float s = rsv[ai][m];
                f32x4 o[2];
#pragma unroll
                for (int n = 0; n < 2; ++n) { const f32x4 g = acc[ai][0][m][n] * s, up = acc[ai][1][m][n] * s;
#pragma unroll
                    for (int j = 0; j < 4; ++j) o[n][j] = g[j] * sigmoidf_(g[j]) * up[j]; }
                *(u32x4*)(HID + (size_t)row * 2816 + col0) = pack8(o[0], o[1]); }
    }
};
template <bool GATED> struct EpiRes {
    static constexpr bool PERM = true, AFTER_DRAIN = false;
    float* H; bf16_t* HBo; float* SSQo; const bf16_t* U; RowScale rs;
    __device__ __forceinline__ void operator()(const f32x4 (&acc)[2][2][4][2], const Unit& u, int wr, int wc, int fr, int fq) const {
        const int row0 = u.pm * BM + wr * 64 + fr, col0 = u.pn * BM + wc * 32 + 8 * fq;
        float rsv[2][4]; if (GATED) rs.get8(rsv, row0, fq);
#pragma unroll
        for (int ai = 0; ai < 2; ++ai)
#pragma unroll
            for (int m = 0; m < 4; ++m) { const int row = row0 + ai * HALF + m * 16; const size_t off = (size_t)row * DMODEL + col0;
                float s = 1.0f; if (GATED) s = rsv[ai][m];
                float q = 0.f;
#pragma unroll
                for (int bj = 0; bj < 2; ++bj) { f32x4 a0 = acc[ai][bj][m][0], a1 = acc[ai][bj][m][1];
                    f32x4 h0 = *(const f32x4*)(H + off + bj * HALF), h1 = *(const f32x4*)(H + off + bj * HALF + 4);
                    if (GATED) { f32x4 u0, u1; unpack8(*(const u32x4*)(U + off + bj * HALF), u0, u1);
#pragma unroll
                        for (int j = 0; j < 4; ++j) { a0[j] = sigmoidf_(a0[j] * s) * u0[j]; a1[j] = sigmoidf_(a1[j] * s) * u1[j]; } }
                    h0 += a0; h1 += a1;
                    *(f32x4*)(H + off + bj * HALF) = h0; *(f32x4*)(H + off + bj * HALF + 4) = h1;
                    *(u32x4*)(HBo + off + bj * HALF) = pack8(h0, h1);
                    q += sumsq8(h0, h1); }
                q = red_fq(q); if (fq == 0) SSQo[(size_t)row * 16 + u.pn * 4 + wc] = q;
                asm volatile("" ::: "memory"); }
    }
};
struct EpiKvs {
    static constexpr bool PERM = true, AFTER_DRAIN = false;
    bf16_t* KT; bf16_t* VT; RowScale rs;
    __device__ __forceinline__ void operator()(const f32x4 (&acc)[2][2][4][2], const Unit& u, int wr, int wc, int fr, int fq) const {
        const int row0 = u.pm * BM + wr * 64 + fr;
        float rsv[2][4]; rs.get8(rsv, row0, fq);
#pragma unroll
        for (int ai = 0; ai < 2; ++ai)
#pragma unroll
            for (int m = 0; m < 4; ++m) { const int row = row0 + ai * HALF + m * 16; const float s = rsv[ai][m];
                const int b = row >> 13, sq = row & 8191, tile = sq >> 6, rr = sq & 63;
#pragma unroll
                for (int bj = 0; bj < 2; ++bj) { const int c = bj * HALF + wc * 32 + 8 * fq, kh = c >> 6, d = c & 63;
                    const size_t tb = (size_t)((b * 4 + kh) * 128 + tile) * 4096;
                    const u32x4 w = pack8(acc[ai][bj][m][0] * s, acc[ai][bj][m][1] * s);
                    if (u.pn == 0) *(u32x4*)(KT + tb + (d >> 3) * 512 + rr * 8) = w;
                    else *(u32x4*)(VT + tb + (d >> 5) * 2048 + rr * 32 + (d & 31)) = w; } }
    }
};

#define PG8_LAS LAS
template <class Epi, class Sched, bool ALIGN_EPI = false, bool SP2 = false>
__device__ __forceinline__ void gemm_phase(PG8_LAS unsigned char* lds, const Gemm g, const Sched& S, const Epi& E) {
    int tid_ = threadIdx.x; asm volatile("" : "+v"(tid_));
    const int tid = tid_, wid = __builtin_amdgcn_readfirstlane(tid >> 6), lane = tid & 63, wr = wid >> 2, wc = wid & 3, fr = lane & 15, fq = lane >> 4;
    const int K = g.K, nt = K / BK;
    unsigned voffA[2], voffB[2];
#pragma unroll
    for (int i = 0; i < 2; ++i) { int R, C; stage_rc(tid * 16 + i * 8192, R, C); const int Rb = Epi::PERM ? ((R & ~31) + perm32(R & 31)) : R;
        voffA[i] = (unsigned)(R * K + C) * 2u; voffB[i] = (unsigned)(Rb * K + C) * 2u; }
    const size_t kstep = (size_t)(BK * 2);
    const size_t hstep = (size_t)HALF * K * 2;
    const size_t tstep = 2 * hstep;
    const unsigned ldsw = (unsigned)wid * 1024u;
    const int aoff = lds_byte(wr * 64 + fr, fq * 8), boff = lds_byte(wc * 32 + fr, fq * 8);
#define PG8_SA(b, h) (((b) * 2 + (h)) * HTB)
#define PG8_SB(b, h) ((4 + (b) * 2 + (h)) * HTB)
#define PG8_STAGE(bufoff, gbase, voff) do { _Pragma("unroll") for (int _i = 0; _i < 2; ++_i) \
        __builtin_amdgcn_global_load_lds((const unsigned*)((const char*)(gbase) + (voff)[_i]), (PG8_LAS unsigned*)(lds + (bufoff) + ldsw + _i * 8192), 16, 0, 0); } while (0)
#define PG8_LDA(dst, b, h) do { _Pragma("unroll") for (int m = 0; m < 4; ++m) _Pragma("unroll") for (int k = 0; k < 2; ++k) dst[m][k] = *(const PG8_LAS bf16x8*)(lds + PG8_SA(b, h) + aoff + m * 2048 + k * 1024); } while (0)
#define PG8_LDB(dst, b, h) do { _Pragma("unroll") for (int n = 0; n < 2; ++n) _Pragma("unroll") for (int k = 0; k < 2; ++k) dst[n][k] = *(const PG8_LAS bf16x8*)(lds + PG8_SB(b, h) + boff + n * 2048 + k * 1024); } while (0)
#define PG8_MMA(ai, bj, At, Bt) do { __builtin_amdgcn_s_setprio(1); _Pragma("unroll") for (int m = 0; m < 4; ++m) _Pragma("unroll") for (int n = 0; n < 2; ++n) _Pragma("unroll") for (int k = 0; k < 2; ++k) \
        acc[ai][bj][m][n] = __builtin_amdgcn_mfma_f32_16x16x32_bf16(Bt[n][k], At[m][k], acc[ai][bj][m][n], 0, 0, 0); __builtin_amdgcn_s_setprio(0); } while (0)
#define PG8_WAIT_V(n) asm volatile("s_waitcnt vmcnt(" #n ")" ::: "memory")
#define PG8_WAIT_L(n) asm volatile("s_waitcnt lgkmcnt(" #n ")" ::: "memory")
#define PG8_BAR __builtin_amdgcn_s_barrier()
#define PG8_SCHED __builtin_amdgcn_sched_barrier(0)
    Unit cur, nxt; int ui = 0;
    if (!S.next(0, cur)) return;
    f32x4 acc[2][2][4][2];
#pragma unroll
    for (int a = 0; a < 2; ++a)
#pragma unroll
        for (int b = 0; b < 2; ++b)
#pragma unroll
            for (int m = 0; m < 4; ++m)
#pragma unroll
                for (int n = 0; n < 2; ++n) acc[a][b][m][n] = (f32x4){0.f, 0.f, 0.f, 0.f};
    bf16x8 At[4][2], B0[2][2], B1[2][2];
    const char* cA = (const char*)g.A + (size_t)cur.pm * tstep; const char* cB = (const char*)g.Bt + cur.boff + (size_t)cur.pn * tstep;
    if constexpr (SP2) {
        PG8_STAGE(PG8_SB(0, 0), cB, voffB); PG8_STAGE(PG8_SB(0, 1), cB + hstep, voffB); PG8_STAGE(PG8_SA(0, 0), cA, voffA); PG8_STAGE(PG8_SA(0, 1), cA + hstep, voffA);
        if (wr == 1) PG8_BAR;
        PG8_WAIT_V(2); PG8_BAR;
        PG8_STAGE(PG8_SB(1, 0), cB + kstep, voffB); PG8_STAGE(PG8_SA(1, 0), cA + kstep, voffA); PG8_STAGE(PG8_SB(1, 1), cB + hstep + kstep, voffB);
        PG8_WAIT_V(6); PG8_BAR;
    } else {
        PG8_STAGE(PG8_SB(0, 0), cB, voffB); PG8_STAGE(PG8_SA(0, 0), cA, voffA); PG8_STAGE(PG8_SB(0, 1), cB + hstep, voffB); PG8_STAGE(PG8_SA(0, 1), cA + hstep, voffA);
        if (wr == 1) PG8_BAR;
        PG8_WAIT_V(4); PG8_BAR;
        PG8_STAGE(PG8_SB(1, 0), cB + kstep, voffB); PG8_STAGE(PG8_SA(1, 0), cA + kstep, voffA); PG8_STAGE(PG8_SB(1, 1), cB + hstep + kstep, voffB);
        PG8_WAIT_V(6); PG8_BAR;
    }
    for (;;) {
        const bool has_next = S.next(ui + 1, nxt);
        const char* nA = has_next ? (const char*)g.A + (size_t)nxt.pm * tstep : cA; const char* nB = has_next ? (const char*)g.Bt + nxt.boff + (size_t)nxt.pn * tstep : cB;
        for (int t = 0; t < nt; t += 2) {
            const bool last = (t == nt - 2);
            const char* a1 = cA + (size_t)(t + 1) * kstep;
            const char* a2 = last ? nA : cA + (size_t)(t + 2) * kstep; const char* b2 = last ? nB : cB + (size_t)(t + 2) * kstep;
            const char* a3 = a2 + kstep; const char* b3 = b2 + kstep;
            if constexpr (SP2) {
            PG8_LDB(B0, 0, 0); PG8_LDB(B1, 0, 1); PG8_SCHED; PG8_LDA(At, 0, 0); PG8_STAGE(PG8_SA(1, 1), a1 + hstep, voffA);
            PG8_WAIT_V(8); PG8_WAIT_L(0); PG8_BAR; PG8_MMA(0, 0, At, B0); PG8_MMA(0, 1, At, B1); PG8_BAR; PG8_SCHED;
            PG8_LDA(At, 0, 1); PG8_STAGE(PG8_SB(0, 0), b2, voffB); PG8_STAGE(PG8_SB(0, 1), b2 + hstep, voffB); PG8_STAGE(PG8_SA(0, 0), a2, voffA);
            PG8_WAIT_V(8); PG8_WAIT_L(0); PG8_BAR; PG8_MMA(1, 0, At, B0); PG8_MMA(1, 1, At, B1); PG8_BAR; PG8_SCHED;
            PG8_LDB(B0, 1, 0); PG8_LDB(B1, 1, 1); PG8_SCHED; PG8_LDA(At, 1, 0); PG8_STAGE(PG8_SA(0, 1), a2 + hstep, voffA);
            PG8_WAIT_V(8); PG8_WAIT_L(0); PG8_BAR; PG8_MMA(0, 0, At, B0); PG8_MMA(0, 1, At, B1); PG8_BAR; PG8_SCHED;
            PG8_LDA(At, 1, 1); PG8_STAGE(PG8_SB(1, 0), b3, voffB); PG8_STAGE(PG8_SB(1, 1), b3 + hstep, voffB); PG8_STAGE(PG8_SA(1, 0), a3, voffA);
            PG8_WAIT_V(8); PG8_WAIT_L(0); PG8_BAR; PG8_MMA(1, 0, At, B0); PG8_MMA(1, 1, At, B1); PG8_BAR; PG8_SCHED;
            } else {
            PG8_LDB(B0, 0, 0); PG8_SCHED; PG8_LDA(At, 0, 0); PG8_STAGE(PG8_SA(1, 1), a1 + hstep, voffA);
            PG8_WAIT_L(8); PG8_BAR; PG8_WAIT_L(0); PG8_MMA(0, 0, At, B0); PG8_BAR; PG8_SCHED;
            PG8_LDB(B1, 0, 1); PG8_STAGE(PG8_SB(0, 0), b2, voffB);
            PG8_BAR; PG8_WAIT_L(0); PG8_MMA(0, 1, At, B1); PG8_BAR;
            PG8_LDA(At, 0, 1); PG8_STAGE(PG8_SA(0, 0), a2, voffA);
            PG8_BAR; PG8_WAIT_L(0); PG8_MMA(1, 0, At, B0); PG8_BAR; PG8_SCHED;
            PG8_STAGE(PG8_SB(0, 1), b2 + hstep, voffB);
            PG8_WAIT_V(6); PG8_BAR; PG8_MMA(1, 1, At, B1); PG8_BAR;
            PG8_LDB(B0, 1, 0); PG8_SCHED; PG8_LDA(At, 1, 0); PG8_STAGE(PG8_SA(0, 1), a2 + hstep, voffA);
            PG8_WAIT_L(8); PG8_BAR; PG8_WAIT_L(0); PG8_MMA(0, 0, At, B0); PG8_BAR; PG8_SCHED;
            PG8_LDB(B1, 1, 1); PG8_STAGE(PG8_SB(1, 0), b3, voffB);
            PG8_BAR; PG8_WAIT_L(0); PG8_MMA(0, 1, At, B1); PG8_BAR;
            PG8_LDA(At, 1, 1); PG8_STAGE(PG8_SA(1, 0), a3, voffA);
            PG8_BAR; PG8_WAIT_L(0); PG8_MMA(1, 0, At, B0); PG8_BAR; PG8_SCHED;
            PG8_STAGE(PG8_SB(1, 1), b3 + hstep, voffB);
            PG8_WAIT_V(6); PG8_BAR; PG8_MMA(1, 1, At, B1); PG8_BAR;
            }
        }
        if constexpr (ALIGN_EPI) { if (wr == 0) PG8_BAR; }
        E(acc, cur, wr, wc, fr, fq);
        if (!has_next) break;
#pragma unroll
        for (int a = 0; a < 2; ++a)
#pragma unroll
            for (int b = 0; b < 2; ++b)
#pragma unroll
                for (int m = 0; m < 4; ++m)
#pragma unroll
                    for (int n = 0; n < 2; ++n) acc[a][b][m][n] = (f32x4){0.f, 0.f, 0.f, 0.f};
        cur = nxt; cA = nA; cB = nB; ++ui;
        if constexpr (ALIGN_EPI) { if (wr == 1) PG8_BAR; }
    }
    PG8_WAIT_V(0);
    if constexpr (!ALIGN_EPI) { if (wr == 0) PG8_BAR; }
    PG8_BAR;
#undef PG8_SA
#undef PG8_SB
#undef PG8_STAGE
#undef PG8_LDA
#undef PG8_LDB
#undef PG8_MMA
#undef PG8_WAIT_V
#undef PG8_WAIT_L
#undef PG8_BAR
#undef PG8_SCHED
}
}
typedef GAS unsigned gu32;
#define RLX_AGENT __ATOMIC_RELAXED, __HIP_MEMORY_SCOPE_AGENT
#define XB_TMO      128
#define XB_XCNT(j)  (256  + 64 * (j))
#define XB_XSUB(j)  (1280 + 64 * (j))
#define XB_XGEN(j)  (2304 + 64 * (j))
#define XB_TOP      3328
#define XB_TOPGEN   3392
#define XCD_BAR_WORDS 3456
#define XB_SPIN_CAP (1u << 18)

__device__ __forceinline__ unsigned xb_ld(unsigned* p)              { return __hip_atomic_load(p, __ATOMIC_RELAXED, __HIP_MEMORY_SCOPE_AGENT); }
__device__ __forceinline__ unsigned xb_add(unsigned* p, unsigned v) { return __hip_atomic_fetch_add(p, v, __ATOMIC_RELAXED, __HIP_MEMORY_SCOPE_AGENT); }
__device__ __forceinline__ unsigned xb_xcc_id() { return (unsigned)__builtin_amdgcn_s_getreg((3 << 11) | 20) & 0xFu; }
#define XB_SPIN(cond, bar) do { unsigned _sp = 0; while (cond) { __builtin_amdgcn_s_sleep(1); \
    if ((++_sp & 255u) == 0u) { if (xb_ld(&(bar)[XB_TMO])) break; if (_sp > XB_SPIN_CAP) { atomicAdd(&(bar)[XB_TMO], 1u); break; } } } } while (0)

struct XcdBarrier {
    unsigned* bar; unsigned x;
    volatile LAS unsigned* st;
};
__device__ __forceinline__ XcdBarrier xcd_barrier_post(unsigned* bar, volatile LAS unsigned* st) {
    XcdBarrier b; b.bar = bar; b.x = xb_xcc_id(); b.st = st;
    if (threadIdx.x == 0) (void)xb_add(&bar[XB_XCNT(b.x)], 1u);
    return b;
}
__device__ __forceinline__ void xcd_barrier_complete(unsigned* bar, unsigned x, unsigned& nloc, unsigned& nx) {
    const unsigned G = gridDim.x * gridDim.y * gridDim.z;
    unsigned sum, cnt, mine, sp = 0u;
    for (;;) {
        sum = 0u; cnt = 0u; mine = 0u;
#pragma unroll
        for (unsigned j = 0; j < 16; ++j) { const unsigned c = xb_ld(&bar[XB_XCNT(j)]); sum += c; cnt += (c > 0u) ? 1u : 0u; mine = (j == x) ? c : mine; }
        if (sum == G) break;
        __builtin_amdgcn_s_sleep(1);
        if ((++sp & 255u) == 0u) { if (xb_ld(&bar[XB_TMO])) break; if (sp > XB_SPIN_CAP) { atomicAdd(&bar[XB_TMO], 1u); break; } }
    }
    nloc = mine > 0u ? mine : 1u; nx = cnt > 0u ? cnt : 1u;
}
__device__ __forceinline__ void xcd_barrier(const XcdBarrier& b) {
    asm volatile("s_waitcnt vmcnt(0)" ::: "memory");
    __syncthreads();
    if (threadIdx.x == 0) {
        unsigned* bar = b.bar;
        __builtin_amdgcn_s_waitcnt(0);
        unsigned nloc = b.st[0], nx = b.st[1];
        if (nloc == 0u) { xcd_barrier_complete(bar, b.x, nloc, nx); b.st[0] = nloc; b.st[1] = nx; }
        const unsigned old = xb_add(&bar[XB_XSUB(b.x)], 1u);
        const unsigned gen = old / nloc;
        if (old + 1u == (gen + 1u) * nloc) {
            __builtin_amdgcn_fence(__ATOMIC_RELEASE, "agent");
            asm volatile("s_waitcnt vmcnt(0)" ::: "memory");
            const unsigned og = xb_add(&bar[XB_TOP], 1u);
            const unsigned tg = og / nx;
            if (og + 1u == (tg + 1u) * nx) xb_add(&bar[XB_TOPGEN], 1u);
            else XB_SPIN(xb_ld(&bar[XB_TOPGEN]) == tg, bar);
            __builtin_amdgcn_fence(__ATOMIC_ACQUIRE, "agent");
            xb_add(&bar[XB_XGEN(b.x)], 1u);
            asm volatile("s_waitcnt vmcnt(0)" ::: "memory");
        } else {
            XB_SPIN(xb_ld(&bar[XB_XGEN(b.x)]) == gen, bar);
            __builtin_amdgcn_fence(__ATOMIC_ACQUIRE, "agent");
            asm volatile("s_waitcnt vmcnt(0)" ::: "memory");
        }
    }
    __syncthreads();
}

namespace att {
__device__ __forceinline__ int crow(int r, int hi) { return (r & 3) + 8 * (r >> 2) + 4 * hi; }
__device__ __forceinline__ void glds16(const void* gsrc, unsigned lds_dst) { unsigned keep;
    asm volatile("s_mov_b32 %0, m0\n\ts_mov_b32 m0, %2\n\ts_nop 0\n\tglobal_load_lds_dwordx4 %1, off\n\ts_mov_b32 m0, %0" : "=&s"(keep) : "v"(gsrc), "s"(lds_dst) : "memory"); }
#define ATT_WAIT_BAR(N) asm volatile("s_waitcnt vmcnt(" #N ") lgkmcnt(0)\n\ts_barrier" ::: "memory")
#define ATT_MX3(a, b, c) __builtin_fmaxf(__builtin_fmaxf((a), (b)), (c))
typedef LAS const unsigned char* lcp;
typedef short v4i16_t __attribute__((ext_vector_type(4)));
__device__ __forceinline__ s16x4 vtr(lcp p) { return __builtin_bit_cast(s16x4, __builtin_amdgcn_ds_read_tr16_b64_v4i16((LAS v4i16_t*)p)); }
__device__ __forceinline__ float rowmax(const f32x16& p0, const f32x16& p1) {
    float a = ATT_MX3(p0[0], p0[1], p1[0]), b = ATT_MX3(p0[2], p0[3], p1[1]); a = ATT_MX3(a, p1[2], p1[3]);
#pragma unroll
    for (int r = 4; r < 16; r += 4) { a = ATT_MX3(a, p0[r], p0[r + 1]); b = ATT_MX3(b, p0[r + 2], p0[r + 3]); a = ATT_MX3(a, p1[r], p1[r + 1]); b = ATT_MX3(b, p1[r + 2], p1[r + 3]); }
    float m = __builtin_fmaxf(a, b); auto rr = __builtin_amdgcn_permlane32_swap(__float_as_uint(m), __float_as_uint(m), false, false);
    return __builtin_fmaxf(__uint_as_float(rr[0]), __uint_as_float(rr[1])); }
__device__ __forceinline__ void pv(f32x16* o, lcp vp, const u32x4 pw0, const u32x4 pw1, const u32x4 pw2, const u32x4 pw3) {
#pragma unroll
    for (int d0 = 0; d0 < 2; ++d0) {
#pragma unroll
        for (int ks = 0; ks < 4; ++ks) {
            const s16x4 lo = vtr(vp + d0 * 4096 + ks * 1024), hi = vtr(vp + d0 * 4096 + ks * 1024 + 512);
            const bf16x8 vf = (bf16x8){lo[0], lo[1], lo[2], lo[3], hi[0], hi[1], hi[2], hi[3]};
            const u32x4 pw = ks == 0 ? pw0 : ks == 1 ? pw1 : ks == 2 ? pw2 : pw3;
            o[d0] = __builtin_amdgcn_mfma_f32_32x32x16_bf16(__builtin_bit_cast(bf16x8, pw), vf, o[d0], 0, 0, 0);
        }
    }
}
__device__ __forceinline__ void store_o(const f32x16* o, const float* rsc  , LAS unsigned char* stage, bf16_t* Ow, int pitch, int lane, int r32, int hi) {
    LAS bf16_t* stg = (LAS bf16_t*)stage;
#pragma unroll
    for (int r = 0; r < 16; ++r) { const int orow = crow(r, hi);
#pragma unroll
        for (int d0 = 0; d0 < 2; ++d0) stg[orow * 64 + d0 * 32 + r32] = (bf16_t)(pk_bf16(o[d0][r] * rsc[r], 0.f) & 0xffffu); }
    asm volatile("s_waitcnt lgkmcnt(0)" ::: "memory");
#pragma unroll
    for (int i = 0; i < 4; ++i) { const int row = i * 8 + (lane >> 3), ch = lane & 7; const u32x4 v = *(const LAS u32x4*)(stg + row * 64 + ch * 8); *(u32x4*)(Ow + (size_t)row * pitch + ch * 8) = v; }
}

namespace mla {
constexpr int KSLOT = 12288, VSLOT = 8192, NS = 3;
constexpr int L_K = 0, L_V = NS * KSLOT, L_WS = L_V + NS * VSLOT, L_OST = L_WS + 2048, L_END = L_OST + 8 * 4096;
__device__ __forceinline__ void unit(int b, int h, int qb, const bf16_t* Q, const bf16_t* KT, const bf16_t* VT, bf16_t* O, LAS unsigned char* shm) {
    int tid_ = threadIdx.x; asm volatile("" : "+v"(tid_));
    const int tid = tid_, lane = tid & 63, r32 = lane & 31, hi = lane >> 5; const int wid = __builtin_amdgcn_readfirstlane(tid >> 6);
    const long rowbase = (long)b * SEQL; const int q0 = qb * 256;
    const bf16_t* Qw = Q + (size_t)(rowbase + q0 + wid * 32) * 768 + h * 96;
    const bf16_t* Kh = KT + (size_t)((b * 8 + h) * 128) * 6144 + lane * 8;
    const bf16_t* Vh = VT + (size_t)((b * 8 + h) * 128) * 4096 + lane * 8;
    const unsigned lds0 = (unsigned)(uintptr_t)shm;
    LAS float* wsf = (LAS float*)(shm + L_WS) + wid * 64;
    const int NT = (q0 + 256) / 64;
    const int kc2 = 8 + (wid & 3);
#define MLA_DMA(t, sl) do { const bf16_t* kt_ = Kh + (size_t)(t) * 6144; \
        glds16(kt_ + wid * 512, (unsigned)__builtin_amdgcn_readfirstlane(lds0 + L_K + (sl) * KSLOT + wid * 1024)); \
        glds16(kt_ + kc2 * 512, (unsigned)__builtin_amdgcn_readfirstlane(lds0 + L_K + (sl) * KSLOT + kc2 * 1024)); \
        glds16(Vh + (size_t)(t) * 4096 + wid * 512, (unsigned)__builtin_amdgcn_readfirstlane(lds0 + L_V + (sl) * VSLOT + wid * 1024)); } while (0)
    MLA_DMA(0, 0); MLA_DMA(1, 1);
    bf16x8 qr[6];
#pragma unroll
    for (int d0 = 0; d0 < 6; ++d0) qr[d0] = *(const bf16x8*)(Qw + (size_t)r32 * 768 + d0 * 16 + hi * 8);
    float m = -1e30f, l = 0.f; f32x16 o[2];
#pragma unroll
    for (int r = 0; r < 16; ++r) { o[0][r] = 0.f; o[1][r] = 0.f; }
    const int qrel = wid * 32 + r32;
    int slot = 0;
    for (int t = 0; t < NT; ++t) {
        if (t + 1 < NT) ATT_WAIT_BAR(3); else ATT_WAIT_BAR(0);
        if (t + 2 < NT) { const int s2 = slot == 0 ? 2 : slot - 1; MLA_DMA(t + 2, s2); }
        const int jb = t - (NT - 4);
        if (jb <= 0 || 64 * jb <= wid * 32 + 31) {
            const lcp kb = (lcp)shm + L_K + slot * KSLOT + hi * 1024 + r32 * 16;
            f32x16 p0, p1;
#pragma unroll
            for (int r = 0; r < 16; ++r) { p0[r] = 0.f; p1[r] = 0.f; }
#pragma unroll
            for (int d0 = 0; d0 < 6; ++d0) { const bf16x8 b0 = *(const LAS bf16x8*)(kb + d0 * 2048), b1 = *(const LAS bf16x8*)(kb + d0 * 2048 + 512);
                p0 = __builtin_amdgcn_mfma_f32_32x32x16_bf16(b0, qr[d0], p0, 0, 0, 0); p1 = __builtin_amdgcn_mfma_f32_32x32x16_bf16(b1, qr[d0], p1, 0, 0, 0); }
            if (jb >= 0) {
#pragma unroll
                for (int r = 0; r < 16; ++r) { const int kv = 64 * jb + crow(r, hi); if (kv > qrel) p0[r] = -INFINITY; if (kv + 32 > qrel) p1[r] = -INFINITY; }
            }
            const float rm = rowmax(p0, p1), mnew = __builtin_fmaxf(m, rm);
            if (__any(mnew > m)) {
                const float alpha = fast_exp2(m - mnew); l *= alpha; m = mnew;
                if (hi == 0) wsf[r32] = alpha;
#pragma unroll
                for (int r = 0; r < 16; ++r) { const float a = wsf[crow(r, hi)]; o[0][r] *= a; o[1][r] *= a; }
            }
            float sa = 0.f, sb = 0.f;
#pragma unroll
            for (int r = 0; r < 16; ++r) { p0[r] = fast_exp2(p0[r] - m); p1[r] = fast_exp2(p1[r] - m); sa += p0[r]; sb += p1[r]; }
            l += sa + sb;
            const u32x4 pw0 = {pk_bf16(p0[0], p0[1]), pk_bf16(p0[2], p0[3]), pk_bf16(p0[4], p0[5]), pk_bf16(p0[6], p0[7])};
            const u32x4 pw1 = {pk_bf16(p0[8], p0[9]), pk_bf16(p0[10], p0[11]), pk_bf16(p0[12], p0[13]), pk_bf16(p0[14], p0[15])};
            const u32x4 pw2 = {pk_bf16(p1[0], p1[1]), pk_bf16(p1[2], p1[3]), pk_bf16(p1[4], p1[5]), pk_bf16(p1[6], p1[7])};
            const u32x4 pw3 = {pk_bf16(p1[8], p1[9]), pk_bf16(p1[10], p1[11]), pk_bf16(p1[12], p1[13]), pk_bf16(p1[14], p1[15])};
            const lcp vp = (lcp)shm + L_V + slot * VSLOT + ((lane >> 4) & 1) * 32 + (lane & 3) * 8 + (4 * hi + ((lane & 15) >> 2)) * 64;
            pv(o, vp, pw0, pw1, pw2, pw3);
        }
        slot = slot == 2 ? 0 : slot + 1;
    }
#undef MLA_DMA
    { auto rr = __builtin_amdgcn_permlane32_swap(__float_as_uint(l), __float_as_uint(l), false, false); l = __uint_as_float(rr[0]) + __uint_as_float(rr[1]); }
    if (hi == 0) wsf[32 + r32] = l;
    float rli[16];
#pragma unroll
    for (int r = 0; r < 16; ++r) rli[r] = fast_rcp(wsf[32 + crow(r, hi)]);
    store_o(o, rli, shm + L_OST + wid * 4096, O + (size_t)(rowbase + q0 + wid * 32) * 512 + h * 64, 512, lane, r32, hi);
    asm volatile("s_waitcnt lgkmcnt(0)\n\ts_barrier" ::: "memory");
}
__device__ __forceinline__ void phase(int vcu, int G, const bf16_t* Q, const bf16_t* KT, const bf16_t* VT, bf16_t* O, LAS unsigned char* shm) {
    for (int v = vcu; v < 256; v += G) { const int bh = v >> 4, s = v & 15;
        unit(bh >> 3, bh & 7, 31 - s, Q, KT, VT, O, shm);
        unit(bh >> 3, bh & 7, s, Q, KT, VT, O, shm); }
}
}

namespace sba {
constexpr int KSLOT = 8192, VSLOT = 8192, NS = 3;
constexpr int L_K = 0, L_V = NS * KSLOT, L_WS = L_V + NS * VSLOT, L_FLAG = L_WS + 2048, L_OST = L_FLAG + 256, L_END = L_OST + 8 * 4096;
constexpr float SB_EXIT = -160.0f;
__device__ __forceinline__ void unit(int b, int kh, int qb64, const bf16_t* Q, const bf16_t* KT, const bf16_t* VT, bf16_t* O, LAS unsigned char* shm) {
    int tid_ = threadIdx.x; asm volatile("" : "+v"(tid_));
    const int tid = tid_, lane = tid & 63, r32 = lane & 31, hi = lane >> 5; const int wid = __builtin_amdgcn_readfirstlane(tid >> 6);
    const int h = kh * 4 + (wid >> 1), half = wid & 1;
    const long rowbase = (long)b * SEQL; const int q0 = qb64 * 64;
    const bf16_t* Qw = Q + (size_t)(rowbase + q0 + half * 32) * 1024 + h * 64;
    const bf16_t* Kh = KT + (size_t)((b * 4 + kh) * 128) * 4096 + wid * 512 + lane * 8;
    const bf16_t* Vh = VT + (size_t)((b * 4 + kh) * 128) * 4096 + wid * 512 + lane * 8;
    const unsigned lds0 = (unsigned)(uintptr_t)shm;
    LAS int* flags = (LAS int*)(shm + L_FLAG);
    const int NT = qb64 + 1;
#define SBA_DMA(k, sl) do { const int tile_ = qb64 - (k); \
        glds16(Kh + (size_t)tile_ * 4096, (unsigned)__builtin_amdgcn_readfirstlane(lds0 + L_K + (sl) * KSLOT + wid * 1024)); \
        glds16(Vh + (size_t)tile_ * 4096, (unsigned)__builtin_amdgcn_readfirstlane(lds0 + L_V + (sl) * VSLOT + wid * 1024)); } while (0)
    SBA_DMA(0, 0); if (NT > 1) SBA_DMA(1, 1);
    bf16x8 qr[4];
#pragma unroll
    for (int d0 = 0; d0 < 4; ++d0) qr[d0] = *(const bf16x8*)(Qw + (size_t)r32 * 1024 + d0 * 16 + hi * 8);
    float R = 0.f; f32x16 o[2];
#pragma unroll
    for (int r = 0; r < 16; ++r) { o[0][r] = 0.f; o[1][r] = 0.f; }
    const int qrel = half * 32 + r32;
    int slot = 0;
    for (int k = 0; k < NT; ++k) {
        if (k + 1 < NT) ATT_WAIT_BAR(2); else ATT_WAIT_BAR(0);
        if (k > 0) { const LAS int* f = flags + ((k - 1) & 1) * 8; int all = 1;
#pragma unroll
            for (int w = 0; w < 8; ++w) all &= f[w];
            if (all) break; }
        if (k + 2 < NT) { const int s2 = slot == 0 ? 2 : slot - 1; SBA_DMA(k + 2, s2); }
        {
            const lcp kb = (lcp)shm + L_K + slot * KSLOT + hi * 1024 + r32 * 16;
            f32x16 p0, p1;
#pragma unroll
            for (int r = 0; r < 16; ++r) { p0[r] = 0.f; p1[r] = 0.f; }
#pragma unroll
            for (int d0 = 0; d0 < 4; ++d0) { const bf16x8 b0 = *(const LAS bf16x8*)(kb + d0 * 2048), b1 = *(const LAS bf16x8*)(kb + d0 * 2048 + 512);
                p0 = __builtin_amdgcn_mfma_f32_32x32x16_bf16(b0, qr[d0], p0, 0, 0, 0); p1 = __builtin_amdgcn_mfma_f32_32x32x16_bf16(b1, qr[d0], p1, 0, 0, 0); }
            f32x16 L0, L1;
#pragma unroll
            for (int r = 0; r < 16; ++r) {
                const float z0 = p0[r], z1 = p1[r];
                float s0 = -(__builtin_fmaxf(z0, 0.f) + fast_log2(1.0f + fast_exp2(-__builtin_fabsf(z0))));
                float s1 = -(__builtin_fmaxf(z1, 0.f) + fast_log2(1.0f + fast_exp2(-__builtin_fabsf(z1))));
                if (k == 0) { const int kv = crow(r, hi); if (kv >= qrel) s0 = 0.f; if (kv + 32 >= qrel) s1 = 0.f; }
                L0[r] = s0; L1[r] = s1; }
            float G[16];
#pragma unroll
            for (int j = 0; j < 8; ++j) { const f32x16& LL = j < 4 ? L0 : L1; const int rb = 4 * (j & 3);
                const float gsum = (LL[rb] + LL[rb + 1]) + (LL[rb + 2] + LL[rb + 3]);
                auto rr = __builtin_amdgcn_permlane32_swap(__float_as_uint(gsum), __float_as_uint(gsum), false, false);
                G[2 * j] = __uint_as_float(rr[0]); G[2 * j + 1] = __uint_as_float(rr[1]); }
            float SG[16]; SG[15] = 0.f;
#pragma unroll
            for (int g = 14; g >= 0; --g) SG[g] = SG[g + 1] + G[g + 1];
            const float T = SG[0] + G[0];
#pragma unroll
            for (int j = 0; j < 8; ++j) { f32x16& LL = j < 4 ? L0 : L1; f32x16& PP = j < 4 ? p0 : p1; const int rb = 4 * (j & 3);
                const float base = (R + SG[2 * j + 1]) + (hi ? 0.f : G[2 * j + 1]);
                const float r3 = base, r2 = r3 + LL[rb + 3], r1 = r2 + LL[rb + 2], r0 = r1 + LL[rb + 1];
                PP[rb + 3] = fast_exp2(PP[rb + 3] + LL[rb + 3] + r3); PP[rb + 2] = fast_exp2(PP[rb + 2] + LL[rb + 2] + r2);
                PP[rb + 1] = fast_exp2(PP[rb + 1] + LL[rb + 1] + r1); PP[rb] = fast_exp2(PP[rb] + LL[rb] + r0); }
            if (k == 0) {
#pragma unroll
                for (int r = 0; r < 16; ++r) { const int kv = crow(r, hi); if (kv >= qrel) p0[r] = 0.f; if (kv + 32 >= qrel) p1[r] = 0.f; }
            }
            R += T;
            const u32x4 pw0 = {pk_bf16(p0[0], p0[1]), pk_bf16(p0[2], p0[3]), pk_bf16(p0[4], p0[5]), pk_bf16(p0[6], p0[7])};
            const u32x4 pw1 = {pk_bf16(p0[8], p0[9]), pk_bf16(p0[10], p0[11]), pk_bf16(p0[12], p0[13]), pk_bf16(p0[14], p0[15])};
            const u32x4 pw2 = {pk_bf16(p1[0], p1[1]), pk_bf16(p1[2], p1[3]), pk_bf16(p1[4], p1[5]), pk_bf16(p1[6], p1[7])};
            const u32x4 pw3 = {pk_bf16(p1[8], p1[9]), pk_bf16(p1[10], p1[11]), pk_bf16(p1[12], p1[13]), pk_bf16(p1[14], p1[15])};
            const lcp vp = (lcp)shm + L_V + slot * VSLOT + ((lane >> 4) & 1) * 32 + (lane & 3) * 8 + (4 * hi + ((lane & 15) >> 2)) * 64;
            pv(o, vp, pw0, pw1, pw2, pw3);
            const int dn = __all(R < SB_EXIT) ? 1 : 0;
            if (lane == 0) flags[(k & 1) * 8 + wid] = dn;
        }
        slot = slot == 2 ? 0 : slot + 1;
    }
#undef SBA_DMA
    ATT_WAIT_BAR(0);
    float one[16];
#pragma unroll
    for (int r = 0; r < 16; ++r) one[r] = 1.0f;
    store_o(o, one, shm + L_OST + wid * 4096, O + (size_t)(rowbase + q0 + half * 32) * 1024 + h * 64, 1024, lane, r32, hi);
    asm volatile("s_waitcnt lgkmcnt(0)\n\ts_barrier" ::: "memory");
}
__device__ __forceinline__ void phase(int vcu, int G, const bf16_t* Q, const bf16_t* KT, const bf16_t* VT, bf16_t* O, LAS unsigned char* shm) {
    for (int u = vcu * 4; u < 1024; u += G * 4)
        for (int i = 0; i < 4; ++i) { const int uu = u + i, qb64 = uu & 127, bk = uu >> 7; unit(bk >> 2, bk & 3, qb64, Q, KT, VT, O, shm); }
}
}
}
namespace fw {
constexpr size_t MiB = 1u << 20;
constexpr int NWAVES = 8, NTHR = 512;
constexpr int MAXSLOT = 34816;
constexpr size_t WS_CTL = 0, CTL_ZERO_BYTES = 64 * 1024;
constexpr size_t WS_TOKE = 1 * MiB;
constexpr size_t WS_TOKG = WS_TOKE + 64 * 1024;
constexpr size_t WS_TOKRS = WS_TOKG + 128 * 1024;
constexpr size_t WS_SLOT12 = WS_TOKRS + 64 * 1024;
constexpr size_t WS_SLOTG = WS_SLOT12 + 128 * 1024;
constexpr size_t WS_SLOTRS = WS_SLOTG + 256 * 1024;
constexpr size_t WS_CNT = WS_SLOTRS + 256 * 1024;
constexpr size_t WS_PSTART = WS_CNT + 16 * 1024;
constexpr size_t WS_CS = 4 * MiB;
constexpr size_t WS_SSQ = 6 * MiB;
constexpr size_t WS_SSQQ = 8 * MiB;
constexpr size_t WS_SSQKV = WS_SSQQ + 512 * 1024;
constexpr size_t WS_KPE = 9 * MiB;
constexpr size_t WS_W = 16 * MiB;
constexpr size_t W_AIN = WS_W, W_QUP = W_AIN + 3 * MiB, W_KVUP = W_QUP + 2 * MiB, W_AOUT = W_KVUP + 1 * MiB, W_KVS = W_AOUT + 2 * MiB, W_QB = W_KVS + 1 * MiB,
                 W_OB = W_QB + 4 * MiB, W_PG = W_OB + 4 * MiB, W_PU = W_PG + 8 * MiB, W_FGU = W_PU + 2 * MiB, W_FDN = W_FGU + 22 * MiB, W_EGU = W_FDN + 11 * MiB,
                 W_EDN = W_EGU + 176 * MiB, W_END = W_EDN + 88 * MiB;
constexpr size_t WS_PB = W_END;
constexpr size_t WS_HB = WS_PB + 32 * MiB;
constexpr size_t WS_U = WS_HB + 64 * MiB;
constexpr size_t WS_SKT = WS_U + 128 * MiB, WS_SVT = WS_SKT + 8 * MiB;
constexpr size_t WS_X = WS_SVT + 8 * MiB;
constexpr size_t X_AQ = WS_X, X_AKV = X_AQ + 12 * MiB, X_QRAW = X_AKV + 8 * MiB, X_KVRAW = X_QRAW + 24 * MiB, X_Q = X_KVRAW + 32 * MiB, X_KT = X_Q + 24 * MiB, X_VT = X_KT + 24 * MiB, X_O = X_VT + 16 * MiB;
constexpr size_t X_SQ = WS_X, X_SO = X_SQ + 32 * MiB;
constexpr size_t X_HID = WS_X;
constexpr size_t X_XG = WS_X, X_HG = X_XG + 68 * MiB, X_YG = X_HG + 187 * MiB, X_END = X_YG + 68 * MiB;
constexpr size_t WS_END = X_END;
static_assert(X_O + 16 * MiB <= X_END && (size_t)MAXSLOT * 2816 * 2 <= 187 * MiB && (size_t)MAXSLOT * 1024 * 2 <= 68 * MiB, "ws map");
constexpr int CW_BAR = 1024;
constexpr int RING_OFF = 0, RING_BYTES = 131072, LDSCTL_OFF = RING_BYTES, MISC_OFF = LDSCTL_OFF + 320, LDS_BYTES = 147456;
static_assert(att::mla::L_END <= RING_BYTES && att::sba::L_END <= RING_BYTES, "attention LDS");
constexpr float QSCALE_MLA = 0.10206207261596577f * LOG2E;
constexpr float QSCALE_SB = 0.125f * LOG2E;

constexpr int PH_PER_LAYER = 12, PH_TOTAL = 2 + 4 * PH_PER_LAYER;
__host__ __device__ inline bool phase_active(int idx) {
    if (idx < 2) return true;
    const int l = (idx - 2) / PH_PER_LAYER, s = (idx - 2) % PH_PER_LAYER; const bool mla = l < 2, moe = (l & 1) != 0;
    if (s == 1 || s == 2) return mla;
    if (s >= 7 && s <= 9) return moe;
    if (s == 11) return l == 1;
    return true;
}

struct Args { const float* in[26]; float* out; unsigned char* ws; int ph_lo, ph_hi; };

struct Frame { LAS unsigned char* lds; int tid, lane, wave, vcu, G; };

__device__ __forceinline__ float wave_sum(float v) {
#pragma unroll
    for (int o = 1; o < 64; o <<= 1) v += __shfl_xor(v, o);
    return v;
}
__device__ __forceinline__ void transpose_item(const float* W, int ldw, int sc0, const float* gain, bf16_t* WT, int K, int drow0, int k0, LAS float* scr, int lane) {
#pragma unroll 8
    for (int i = 0; i < 32; ++i) { const int kk = 2 * i + (lane >> 5); float v = 0.f;
        if (sc0 >= 0) { v = W[(size_t)(k0 + kk) * ldw + sc0 + (lane & 31)]; if (gain) v *= gain[k0 + kk]; }
        scr[kk * 33 + (lane & 31)] = v; }
    asm volatile("s_waitcnt lgkmcnt(0)" ::: "memory");
    const int c = lane & 7;
#pragma unroll
    for (int j = 0; j < 4; ++j) { const int n = (lane >> 3) + 8 * j; const LAS float* s = scr + (8 * c) * 33 + n;
        u32x4 o; o.x = pk_bf16(s[0 * 33], s[1 * 33]); o.y = pk_bf16(s[2 * 33], s[3 * 33]); o.z = pk_bf16(s[4 * 33], s[5 * 33]); o.w = pk_bf16(s[6 * 33], s[7 * 33]);
        *(u32x4*)(WT + (size_t)(drow0 + n) * K + k0 + 8 * c) = o; }
    asm volatile("s_waitcnt lgkmcnt(0)" ::: "memory");
}
struct Fam { int src, count, K, Nd, ldw, map, gain, gstride; size_t sstride, dst, dstride; };
__device__ __forceinline__ int fam_items(const Fam& f) { return f.count * (f.K / 64) * (f.Nd / 32); }
__device__ __forceinline__ void fam_item(const Args& a, const Fam& f, int fid, int it, LAS float* scr, int lane) {
    const int per = (f.K / 64) * (f.Nd / 32), mi = it / per, r = it % per, nblk = f.Nd / 32, kb = r / nblk, nb = r % nblk, n0 = nb * 32;
    int sc0 = n0;
    if (f.map == 1) sc0 = n0 < 384 ? n0 : (n0 < 416 ? 640 + (n0 - 384) : (n0 < 512 ? -1 : 384 + (n0 - 512)));
    if (f.map == 2) { const int pn = n0 >> 8, jj = n0 & 255; sc0 = jj < 128 ? pn * 128 + jj : 2816 + pn * 128 + (jj - 128); }
    const float* gain = nullptr;
    if (f.gain >= 0) gain = a.in[f.gain] + (fid == 11 ? (size_t)(2 * (mi >> 3) + 1) * 1024 : (size_t)mi * f.gstride);
    transpose_item(a.in[f.src] + (size_t)mi * f.sstride, f.ldw, sc0, gain, (bf16_t*)(a.ws + f.dst + (size_t)mi * f.dstride), f.K, n0, kb * 64, scr, lane);
}
__constant__ const Fam FAMS[13] = {
        {4, 2, 1024, 768, 672, 1, 3, 1024, (size_t)1024 * 672, W_AIN, (size_t)768 * 1024 * 2},
        {7, 2, 384, 768, 768, 0, 5, 384, (size_t)384 * 768, W_QUP, (size_t)768 * 384 * 2},
        {8, 2, 256, 1024, 1024, 0, 6, 256, (size_t)256 * 1024, W_KVUP, (size_t)1024 * 256 * 2},
        {11, 2, 512, 1024, 1024, 0, -1, 0, (size_t)512 * 1024, W_AOUT, (size_t)1024 * 512 * 2},
        {13, 1, 1024, 512, 512, 0, 12, 0, 0, W_KVS, 0},
        {15, 2, 1024, 1024, 1024, 0, 14, 1024, (size_t)1024 * 1024, W_QB, (size_t)1024 * 1024 * 2},
        {16, 2, 1024, 1024, 1024, 0, -1, 0, (size_t)1024 * 1024, W_OB, (size_t)1024 * 1024 * 2},
        {24, 4, 1024, 1024, 1024, 0, 23, 1024, (size_t)1024 * 1024, W_PG, (size_t)1024 * 1024 * 2},
        {25, 4, 256, 1024, 1024, 0, -1, 0, (size_t)256 * 1024, W_PU, (size_t)1024 * 256 * 2},
        {18, 2, 1024, 5632, 5632, 2, 17, 2048, (size_t)1024 * 5632, W_FGU, (size_t)5632 * 1024 * 2},
        {19, 2, 2816, 1024, 1024, 0, -1, 0, (size_t)2816 * 1024, W_FDN, (size_t)1024 * 2816 * 2},
        {21, 16, 1024, 5632, 5632, 2, 17, 0, (size_t)1024 * 5632, W_EGU, (size_t)5632 * 1024 * 2},
        {22, 16, 2816, 1024, 1024, 0, -1, 0, (size_t)2816 * 1024, W_EDN, (size_t)1024 * 2816 * 2}};
__device__ __forceinline__ void prologue(const Args& a, Frame& F) {
    LAS float* scr = (LAS float*)(F.lds + RING_OFF + F.wave * 16384);
    const int gw = F.vcu * NWAVES + F.wave, NGW = F.G * NWAVES;
    int base = 0;
#pragma unroll 1
    for (int fid = 0; fid < 13; ++fid) { const Fam f = FAMS[fid]; const int n = fam_items(f);
        int it = gw - (base % NGW); if (it < 0) it += NGW;
#pragma unroll 1
        for (; it < n; it += NGW) fam_item(a, f, fid, it, scr, F.lane);
        base += n; }
    { const f32x4* src = (const f32x4*)a.in[1]; u32x2* dst = (u32x2*)(a.ws + WS_PB); const size_t n4 = (size_t)4 * MT * 256 / 4;
        for (size_t i = (size_t)gw * 64 + F.lane; i < n4; i += (size_t)NGW * 64) { const f32x4 v = src[i]; u32x2 o; o.x = pk_bf16(v[0], v[1]); o.y = pk_bf16(v[2], v[3]); dst[i] = o; } }
    { bf16_t* HB = (bf16_t*)(a.ws + WS_HB); float* SSQ = (float*)(a.ws + WS_SSQ);
        for (int row = gw; row < MT; row += NGW) { const f32x4* xr = (const f32x4*)(a.in[0] + (size_t)row * DMODEL) + F.lane; f32x4* hr = (f32x4*)(a.out + (size_t)row * DMODEL) + F.lane;
            u32x2* hb = (u32x2*)(HB + (size_t)row * DMODEL) + F.lane; float s = 0.f;
#pragma unroll
            for (int j = 0; j < 4; ++j) { const f32x4 v = xr[64 * j]; hr[64 * j] = v; u32x2 o; o.x = pk_bf16(v[0], v[1]); o.y = pk_bf16(v[2], v[3]); hb[64 * j] = o; s += (v[0] * v[0] + v[1] * v[1]) + (v[2] * v[2] + v[3] * v[3]); }
            s = wave_sum(s); if (F.lane < 16) SSQ[(size_t)row * 16 + F.lane] = F.lane == 0 ? s : 0.f; } }
    { float* cs = (float*)(a.ws + WS_CS); const int* pos = (const int*)a.in[2];
        for (int i = gw * 64 + F.lane; i < MT * 16; i += NGW * 64) { const int row = i >> 4, f = i & 15;
            const float invf = (float)exp(-9.210340371976184 * (double)f / 16.0);
            const double ang = (double)((float)pos[row] * invf);
            const double rev = ang * 0.15915494309189535, fr = rev - rint(rev); const float x = (float)(fr * 6.283185307179586);
            cs[(size_t)row * 32 + f] = cosf(x); cs[(size_t)row * 32 + 16 + f] = sinf(x); } }
}
__device__ __forceinline__ void norm_rope_8(f32x4& n0, f32x4& n1, f32x4& r0, f32x4& r1, const float* gain, const float* cs, int sub, float outscale) {
    float ss = pg8::sumsq8(n0, n1) + pg8::sumsq8(r0, r1);
    ss += __shfl_xor(ss, 1); ss += __shfl_xor(ss, 2); ss += __shfl_xor(ss, 4);
    const float rq = (1.0f / sqrtf(ss * (1.0f / 96.0f) + RMS_EPS));
    const f32x4 g0 = *(const f32x4*)(gain + 8 * sub), g1 = *(const f32x4*)(gain + 8 * sub + 4);
    n0 = n0 * g0 * (rq * outscale); n1 = n1 * g1 * (rq * outscale);
    const int s4 = sub & 3;
    const f32x4 h0 = *(const f32x4*)(gain + 64 + 8 * s4), h1 = *(const f32x4*)(gain + 64 + 8 * s4 + 4);
    r0 = r0 * h0 * (rq * outscale); r1 = r1 * h1 * (rq * outscale);
    f32x4 p0, p1;
#pragma unroll
    for (int j = 0; j < 4; ++j) { p0[j] = __shfl_xor(r0[j], 2); p1[j] = __shfl_xor(r1[j], 2); }
    const f32x4 c0 = *(const f32x4*)(cs + 8 * (sub & 1)), c1 = *(const f32x4*)(cs + 8 * (sub & 1) + 4), s0 = *(const f32x4*)(cs + 16 + 8 * (sub & 1)), s1 = *(const f32x4*)(cs + 16 + 8 * (sub & 1) + 4);
    if (s4 < 2) { r0 = r0 * c0 - p0 * s0; r1 = r1 * c1 - p1 * s1; }
    else { r0 = r0 * c0 + p0 * s0; r1 = r1 * c1 + p1 * s1; }
}
#define THIN_LAUNDER() Frame F = F_; unsigned char* wsl = a.ws; asm volatile("" : "+v"(F.tid), "+v"(F.lane), "+s"(F.wave), "+s"(F.vcu), "+s"(F.G), "+s"(wsl))
__device__ __forceinline__ void mla_prep(const Args& a, const Frame& F_, int layer) { THIN_LAUNDER();
    const bf16_t* QRAW = (const bf16_t*)(wsl + X_QRAW); const bf16_t* KVRAW = (const bf16_t*)(wsl + X_KVRAW); const float* KPE = (const float*)(wsl + WS_KPE);
    const float* CS = (const float*)(wsl + WS_CS); const float* gq = a.in[9] + layer * 96; const float* gk = a.in[10] + layer * 96;
    bf16_t* Q = (bf16_t*)(wsl + X_Q); bf16_t* KT = (bf16_t*)(wsl + X_KT); bf16_t* VT = (bf16_t*)(wsl + X_VT);
    const int gw = F.vcu * NWAVES + F.wave, NGW = F.G * NWAVES, h = F.lane >> 3, sub = F.lane & 7;
    const f32x4 z4 = {0.f, 0.f, 0.f, 0.f};
    for (int row = gw; row < MT; row += NGW) {
        const int b = row >> 13, sq = row & 8191, tile = sq >> 6, rr = sq & 63; const float* cs = CS + (size_t)row * 32;
        { const bf16_t* qrow = QRAW + (size_t)row * 768 + h * 96; f32x4 n0, n1, r0 = z4, r1 = z4;
            unpack8(*(const u32x4*)(qrow + 8 * sub), n0, n1); if (sub < 4) unpack8(*(const u32x4*)(qrow + 64 + 8 * sub), r0, r1);
            norm_rope_8(n0, n1, r0, r1, gq, cs, sub, QSCALE_MLA);
            bf16_t* qo = Q + (size_t)row * 768 + h * 96; *(u32x4*)(qo + 8 * sub) = pack8(n0, n1); if (sub < 4) *(u32x4*)(qo + 64 + 8 * sub) = pack8(r0, r1); }
        { const bf16_t* krow = KVRAW + (size_t)row * 1024 + h * 128; f32x4 n0, n1, r0 = z4, r1 = z4;
            unpack8(*(const u32x4*)(krow + 8 * sub), n0, n1); if (sub < 4) { r0 = *(const f32x4*)(KPE + (size_t)row * 32 + 8 * sub); r1 = *(const f32x4*)(KPE + (size_t)row * 32 + 8 * sub + 4); }
            norm_rope_8(n0, n1, r0, r1, gk, cs, sub, 1.0f);
            bf16_t* kt = KT + (size_t)((b * 8 + h) * 128 + tile) * 6144 + rr * 8; *(u32x4*)(kt + sub * 512) = pack8(n0, n1); if (sub < 4) *(u32x4*)(kt + (8 + sub) * 512) = pack8(r0, r1);
            const u32x4 v = *(const u32x4*)(krow + 64 + 8 * sub);
            *(u32x4*)(VT + (size_t)((b * 8 + h) * 128 + tile) * 4096 + (sub >> 2) * 2048 + rr * 32 + (sub & 3) * 8) = v; }
    }
}
__device__ __forceinline__ void moe_route(const Args& a, const Frame& F_, int layer) { THIN_LAUNDER();
    const float* H = a.out; const float* gain = a.in[17] + (size_t)layer * 1024; const float* wr = a.in[20] + (size_t)(layer >> 1) * 1024 * 8;
    int* TOKE = (int*)(wsl + WS_TOKE); float* TOKG = (float*)(wsl + WS_TOKG); float* TOKRS = (float*)(wsl + WS_TOKRS); int* CNT = (int*)(wsl + WS_CNT);
    LAS float* wg = (LAS float*)(F.lds + RING_OFF);
    LAS int* lcnt = (LAS int*)(F.lds + RING_OFF + 32768);
    for (int i = F.tid; i < 1024 * 8; i += NTHR) wg[i] = wr[i] * gain[i >> 3];
    for (int chunk = F.vcu; chunk < MT / 64; chunk += F.G) {
        if (F.tid < 8) lcnt[F.tid] = 0;
        __syncthreads();
        for (int tt = 0; tt < 8; ++tt) { const int tok = chunk * 64 + F.wave * 8 + tt;
            const f32x4* hr = (const f32x4*)(H + (size_t)tok * DMODEL) + F.lane; float lg[8], ss = 0.f;
#pragma unroll
            for (int e = 0; e < 8; ++e) lg[e] = 0.f;
#pragma unroll
            for (int j = 0; j < 4; ++j) { const f32x4 v = hr[64 * j]; ss += (v[0] * v[0] + v[1] * v[1]) + (v[2] * v[2] + v[3] * v[3]);
#pragma unroll
                for (int i = 0; i < 4; ++i) { const LAS f32x4* w = (const LAS f32x4*)(wg + (size_t)(256 * j + 4 * F.lane + i) * 8); const f32x4 w0 = w[0], w1 = w[1];
                    lg[0] += v[i] * w0[0]; lg[1] += v[i] * w0[1]; lg[2] += v[i] * w0[2]; lg[3] += v[i] * w0[3]; lg[4] += v[i] * w1[0]; lg[5] += v[i] * w1[1]; lg[6] += v[i] * w1[2]; lg[7] += v[i] * w1[3]; } }
            ss = wave_sum(ss);
#pragma unroll
            for (int e = 0; e < 8; ++e) lg[e] = wave_sum(lg[e]);
            const float r = 1.0f / sqrtf(ss * (1.0f / 1024.0f) + RMS_EPS);
            int e1 = 0; float v1 = lg[0];
#pragma unroll
            for (int e = 1; e < 8; ++e) if (lg[e] > v1) { v1 = lg[e]; e1 = e; }
            int e2 = 0; float v2 = -3.0e38f;
#pragma unroll
            for (int e = 0; e < 8; ++e) if (e != e1 && lg[e] > v2) { v2 = lg[e]; e2 = e; }
            const float p2 = __expf((v2 - v1) * r), g1 = 1.0f / (1.0f + p2), g2 = p2 / (1.0f + p2);
            if (F.lane == 0) { TOKE[tok] = e1 | (e2 << 8); TOKG[tok * 2] = g1; TOKG[tok * 2 + 1] = g2; TOKRS[tok] = r; __hip_atomic_fetch_add(lcnt + e1, 1, __ATOMIC_RELAXED, __HIP_MEMORY_SCOPE_WORKGROUP); __hip_atomic_fetch_add(lcnt + e2, 1, __ATOMIC_RELAXED, __HIP_MEMORY_SCOPE_WORKGROUP); }
        }
        __syncthreads();
        if (F.tid < 8) CNT[chunk * 8 + F.tid] = lcnt[F.tid];
        __syncthreads();
    }
}
__device__ __forceinline__ void moe_scatter(const Args& a, const Frame& F_, int cur) { THIN_LAUNDER();
    const int* TOKE = (const int*)(wsl + WS_TOKE); const float* TOKG = (const float*)(wsl + WS_TOKG); const float* TOKRS = (const float*)(wsl + WS_TOKRS); const int* CNT = (const int*)(wsl + WS_CNT);
    int* SLOT12 = (int*)(wsl + WS_SLOT12); float* SLOTG = (float*)(wsl + WS_SLOTG); float* SLOTRS = (float*)(wsl + WS_SLOTRS); int* PSTART = (int*)(wsl + WS_PSTART);
    const bf16_t* HB = (const bf16_t*)(wsl + WS_HB) + (size_t)cur * MT * DMODEL; bf16_t* XG = (bf16_t*)(wsl + X_XG);
    LAS int* sm = (LAS int*)(F.lds + RING_OFF);
    for (int chunk = F.vcu; chunk < MT / 64; chunk += F.G) {
        { const int e = F.wave; int c4[4]; int s = 0;
#pragma unroll
            for (int i = 0; i < 4; ++i) { c4[i] = CNT[(4 * F.lane + i) * 8 + e]; s += c4[i]; }
            int inc = s;
#pragma unroll
            for (int o = 1; o < 64; o <<= 1) { const int t = __shfl_up(inc, o); if (F.lane >= o) inc += t; }
            const int total = __shfl(inc, 63); int pre = inc - s;
            if (F.lane == (chunk >> 2)) { const int cm = chunk & 3; pre += (cm > 0 ? c4[0] : 0) + (cm > 1 ? c4[1] : 0) + (cm > 2 ? c4[2] : 0); sm[8 + e] = pre; }
            if (F.lane == 0) sm[e] = total; }
        __syncthreads();
        if (F.tid == 0) { int p = 0; for (int e = 0; e < 8; ++e) { sm[16 + e] = p; p += (sm[e] + 255) >> 8; } sm[24] = p; }
        __syncthreads();
        if (F.tid < 9) PSTART[F.tid] = sm[16 + F.tid];
        if (F.wave == 0) { const int tok = chunk * 64 + F.lane; const int ev = TOKE[tok], e1 = ev & 255, e2 = ev >> 8; int s1 = 0, s2 = 0;
            const unsigned long long below = (1ull << F.lane) - 1ull;
#pragma unroll
            for (int e = 0; e < 8; ++e) { const unsigned long long m1 = __ballot(e1 == e), m2 = __ballot(e2 == e);
                const int rank = __popcll(m1 & below) + __popcll(m2 & below), slot = sm[16 + e] * 256 + sm[8 + e] + rank;
                if (e1 == e) s1 = slot; if (e2 == e) s2 = slot; }
            SLOT12[tok * 2] = s1; SLOT12[tok * 2 + 1] = s2; const float r = TOKRS[tok];
            SLOTG[s1] = TOKG[tok * 2]; SLOTG[s2] = TOKG[tok * 2 + 1]; SLOTRS[s1] = r; SLOTRS[s2] = r;
            sm[32 + 2 * F.lane] = s1; sm[32 + 2 * F.lane + 1] = s2; }
        __syncthreads();
        for (int i = 0; i < 16; ++i) { const int pr = F.wave * 16 + i, tok = chunk * 64 + (pr >> 1), slot = sm[32 + pr];
            const u32x4* src = (const u32x4*)(HB + (size_t)tok * DMODEL) + F.lane; u32x4* dst = (u32x4*)(XG + (size_t)slot * DMODEL) + F.lane;
            dst[0] = src[0]; dst[64] = src[64]; }
        __syncthreads();
    }
}
__device__ __forceinline__ void moe_combine(const Args& a, const Frame& F_, int cur) { THIN_LAUNDER();
    const int* SLOT12 = (const int*)(wsl + WS_SLOT12); const bf16_t* YG = (const bf16_t*)(wsl + X_YG);
    bf16_t* HB = (bf16_t*)(wsl + WS_HB) + (size_t)cur * MT * DMODEL; float* SSQ = (float*)(wsl + WS_SSQ) + (size_t)cur * MT * 16;
    const int gw = F.vcu * NWAVES + F.wave, NGW = F.G * NWAVES;
    for (int row = gw; row < MT; row += NGW) { const int s1 = SLOT12[row * 2], s2 = SLOT12[row * 2 + 1];
        f32x4* hr = (f32x4*)(a.out + (size_t)row * DMODEL) + F.lane; u32x2* hb = (u32x2*)(HB + (size_t)row * DMODEL) + F.lane;
        const u32x2* y1 = (const u32x2*)(YG + (size_t)s1 * DMODEL) + F.lane; const u32x2* y2 = (const u32x2*)(YG + (size_t)s2 * DMODEL) + F.lane; float s = 0.f;
#pragma unroll
        for (int j = 0; j < 4; ++j) { f32x4 v = hr[64 * j]; const u32x2 p = y1[64 * j], q = y2[64 * j];
            v[0] += bf_lo(p.x) + bf_lo(q.x); v[1] += bf_hi(p.x) + bf_hi(q.x); v[2] += bf_lo(p.y) + bf_lo(q.y); v[3] += bf_hi(p.y) + bf_hi(q.y);
            hr[64 * j] = v; u32x2 o; o.x = pk_bf16(v[0], v[1]); o.y = pk_bf16(v[2], v[3]); hb[64 * j] = o; s += (v[0] * v[0] + v[1] * v[1]) + (v[2] * v[2] + v[3] * v[3]); }
        s = wave_sum(s); if (F.lane < 16) SSQ[(size_t)row * 16 + F.lane] = F.lane == 0 ? s : 0.f; }
}

__global__ void __launch_bounds__(NTHR, 2) yoco_fwd(Args args) {
    extern __shared__ __attribute__((aligned(16))) unsigned char lds_raw[];
    Frame F; F.lds = (LAS unsigned char*)lds_raw;
    volatile LAS unsigned* MISC = (volatile LAS unsigned*)(F.lds + MISC_OFF);
    F.tid = threadIdx.x; F.lane = F.tid & 63; F.wave = __builtin_amdgcn_readfirstlane(F.tid >> 6);
    F.G = gridDim.x; { const int bx = blockIdx.x; F.vcu = (F.G % 8 == 0) ? (bx % 8) * (F.G / 8) + bx / 8 : bx; }
    for (int u = F.tid; u < (LDS_BYTES - LDSCTL_OFF) / 4; u += NTHR) ((LAS unsigned*)(F.lds + LDSCTL_OFF))[u] = 0u;
    __syncthreads();
    unsigned char* ws = args.ws;
#define WS_LAUNDER() asm volatile("" : "+s"(ws), "+s"(bx), "+s"(F.G), "+s"(F.vcu))
    const bool single = (args.ph_hi - args.ph_lo) > 1;
    XcdBarrier bar; bar.bar = (unsigned*)(ws + WS_CTL) + CW_BAR; bar.x = 0; bar.st = nullptr;
    if (single) bar = xcd_barrier_post((unsigned*)(ws + WS_CTL) + CW_BAR, MISC + 8);
    const int lo = args.ph_lo, hi = args.ph_hi;
#ifndef EN_MASK
#define EN_MASK 0xFFFFFFFFu
#endif
#define EN(b) (((EN_MASK) >> (b)) & 1u)
#define IN(k) (lo <= (k) && (k) < hi)
#define SEAM(k) do { if (single && (k) + 1 < hi) { XcdBarrier b_ = bar; asm volatile("" : "+s"(b_.bar), "+s"(b_.x)); xcd_barrier(b_); } } while (0)
    LAS unsigned char* ring = F.lds + RING_OFF;
    int bx = (int)blockIdx.x;

    if (EN(0) && IN(0)) { prologue(args, F); SEAM(0); }
    if (EN(1) && IN(1)) { WS_LAUNDER();
#pragma unroll 1
        for (int i = 0; i < 4; ++i) {
            pg8::Gemm g{(const bf16_t*)(ws + WS_PB) + (size_t)i * MT * 256, (const bf16_t*)(ws + W_PU) + (size_t)i * 1024 * 256, MT, 1024, 256};
            pg8::StaticOrder S; S.init(MT, 1024, F.G, bx);
            pg8::EpiScale E{(bf16_t*)(ws + WS_U) + (size_t)i * MT * DMODEL, 1024, pg8::RowScale{nullptr, 0}, 1.0f};
            pg8::gemm_phase<pg8::EpiScale, pg8::StaticOrder, true, true>(ring, g, S, E);
        }
        SEAM(1);
    }
#pragma unroll 1
    for (int l = 0; l < 4; ++l) {
        const int base = 2 + PH_PER_LAYER * l; const bool is_mla = l < 2, is_moe = (l & 1) != 0; const int cur = l & 1, j = l & 1;
#define HBc ((const bf16_t*)(ws + WS_HB) + (size_t)cur * MT * DMODEL)
#define HBw ((bf16_t*)(ws + WS_HB) + (size_t)cur * MT * DMODEL)
#define SSQc ((float*)(ws + WS_SSQ) + (size_t)cur * MT * 16)
        if (IN(base + 0)) { WS_LAUNDER();
            if (EN(2) && is_mla) {
                pg8::Gemm g{HBc, (const bf16_t*)(ws + W_AIN) + (size_t)l * 768 * 1024, MT, 768, 1024};
                pg8::StaticOrder S; S.init(MT, 768, F.G, bx);
                pg8::EpiAin E{(bf16_t*)(ws + X_AQ), (bf16_t*)(ws + X_AKV), (float*)(ws + WS_KPE), (float*)(ws + WS_SSQQ), (float*)(ws + WS_SSQKV), pg8::RowScale{SSQc, 1}};
                pg8::gemm_phase<pg8::EpiAin, pg8::StaticOrder, true, true>(ring, g, S, E);
            } else if (EN(3) && !is_mla) {
                pg8::Gemm g{HBc, (const bf16_t*)(ws + W_QB) + (size_t)j * 1024 * 1024, MT, 1024, 1024};
                pg8::StaticOrder S; S.init(MT, 1024, F.G, bx);
                pg8::EpiScale E{(bf16_t*)(ws + X_SQ), 1024, pg8::RowScale{SSQc, 1}, QSCALE_SB};
                pg8::gemm_phase<pg8::EpiScale, pg8::StaticOrder, true, true>(ring, g, S, E);
            }
            SEAM(base + 0);
        }
        if (EN(4) && is_mla && IN(base + 1)) { WS_LAUNDER();
            { pg8::Gemm g{(const bf16_t*)(ws + X_AQ), (const bf16_t*)(ws + W_QUP) + (size_t)l * 768 * 384, MT, 768, 384};
              pg8::StaticOrder S; S.init(MT, 768, F.G, bx);
              pg8::EpiScale E{(bf16_t*)(ws + X_QRAW), 768, pg8::RowScale{(const float*)(ws + WS_SSQQ), 3}, 1.0f};
              pg8::gemm_phase<pg8::EpiScale, pg8::StaticOrder, true, true>(ring, g, S, E); }
            { pg8::Gemm g{(const bf16_t*)(ws + X_AKV), (const bf16_t*)(ws + W_KVUP) + (size_t)l * 1024 * 256, MT, 1024, 256};
              pg8::StaticOrder S; S.init(MT, 1024, F.G, bx);
              pg8::EpiScale E{(bf16_t*)(ws + X_KVRAW), 1024, pg8::RowScale{(const float*)(ws + WS_SSQKV), 4}, 1.0f};
              pg8::gemm_phase<pg8::EpiScale, pg8::StaticOrder, true, true>(ring, g, S, E); }
            SEAM(base + 1);
        }
        if (EN(5) && is_mla && IN(base + 2)) { mla_prep(args, F, l); SEAM(base + 2); }
        if (IN(base + 3)) { WS_LAUNDER();
            if (EN(6) && is_mla) att::mla::phase(F.vcu, F.G, (const bf16_t*)(ws + X_Q), (const bf16_t*)(ws + X_KT), (const bf16_t*)(ws + X_VT), (bf16_t*)(ws + X_O), ring);
            else if (EN(7) && !is_mla) att::sba::phase(F.vcu, F.G, (const bf16_t*)(ws + X_SQ), (const bf16_t*)(ws + WS_SKT), (const bf16_t*)(ws + WS_SVT), (bf16_t*)(ws + X_SO), ring);
            SEAM(base + 3);
        }
        if (EN(8) && IN(base + 4)) { WS_LAUNDER();
            pg8::Gemm g = is_mla ? pg8::Gemm{(const bf16_t*)(ws + X_O), (const bf16_t*)(ws + W_AOUT) + (size_t)l * 1024 * 512, MT, 1024, 512}
                                 : pg8::Gemm{(const bf16_t*)(ws + X_SO), (const bf16_t*)(ws + W_OB) + (size_t)j * 1024 * 1024, MT, 1024, 1024};
            pg8::StaticOrder S; S.init(MT, 1024, F.G, bx);
            pg8::EpiRes<false> E{args.out, HBw, SSQc, nullptr, pg8::RowScale{nullptr, 0}};
            pg8::gemm_phase<pg8::EpiRes<false>, pg8::StaticOrder, true, true>(ring, g, S, E);
            SEAM(base + 4);
        }
        if (!is_moe) {
            if (EN(9) && IN(base + 5)) { WS_LAUNDER();
                pg8::Gemm g{HBc, (const bf16_t*)(ws + W_FGU) + (size_t)(l >> 1) * 5632 * 1024, MT, 5632, 1024};
                pg8::GroupOrder S; S.init_dense(MT, 5632, F.G, bx);
                pg8::EpiSwiglu E{(bf16_t*)(ws + X_HID), pg8::RowScale{SSQc, 1}};
                pg8::gemm_phase<pg8::EpiSwiglu, pg8::GroupOrder, true, true>(ring, g, S, E);
                SEAM(base + 5);
            }
            if (EN(10) && IN(base + 6)) { WS_LAUNDER();
                pg8::Gemm g{(const bf16_t*)(ws + X_HID), (const bf16_t*)(ws + W_FDN) + (size_t)(l >> 1) * 1024 * 2816, MT, 1024, 2816};
                pg8::StaticOrder S; S.init(MT, 1024, F.G, bx);
                pg8::EpiRes<false> E{args.out, HBw, SSQc, nullptr, pg8::RowScale{nullptr, 0}};
                pg8::gemm_phase<pg8::EpiRes<false>, pg8::StaticOrder, true, true>(ring, g, S, E);
                SEAM(base + 6);
            }
        } else {
            if (EN(11) && IN(base + 5)) { WS_LAUNDER(); moe_route(args, F, l); SEAM(base + 5); }
            if (EN(12) && IN(base + 6)) { WS_LAUNDER(); moe_scatter(args, F, cur); SEAM(base + 6); }
            if (EN(13) && IN(base + 7)) { WS_LAUNDER();
                pg8::Gemm g{(const bf16_t*)(ws + X_XG), (const bf16_t*)(ws + W_EGU) + (size_t)(l >> 1) * 8 * 5632 * 1024, MAXSLOT, 5632, 1024};
                pg8::GroupOrder S; S.init((const int*)(ws + WS_PSTART), 5632, F.G, bx, (size_t)5632 * 1024 * 2);
                pg8::EpiSwiglu E{(bf16_t*)(ws + X_HG), pg8::RowScale{(const float*)(ws + WS_SLOTRS), 2}};
                pg8::gemm_phase<pg8::EpiSwiglu, pg8::GroupOrder, true, true>(ring, g, S, E);
                SEAM(base + 7);
            }
            if (EN(14) && IN(base + 8)) { WS_LAUNDER();
                pg8::Gemm g{(const bf16_t*)(ws + X_HG), (const bf16_t*)(ws + W_EDN) + (size_t)(l >> 1) * 8 * 1024 * 2816, MAXSLOT, 1024, 2816};
                pg8::GroupOrder S; S.init((const int*)(ws + WS_PSTART), 1024, F.G, bx, (size_t)1024 * 2816 * 2);
                pg8::EpiScale E{(bf16_t*)(ws + X_YG), 1024, pg8::RowScale{(const float*)(ws + WS_SLOTG), 2}, 1.0f};
                pg8::gemm_phase<pg8::EpiScale, pg8::GroupOrder, true, true>(ring, g, S, E);
                SEAM(base + 8);
            }
            if (EN(15) && IN(base + 9)) { WS_LAUNDER(); moe_combine(args, F, cur); SEAM(base + 9); }
        }
        if (EN(16) && IN(base + 10)) { WS_LAUNDER();
            pg8::Gemm g{HBc, (const bf16_t*)(ws + W_PG) + (size_t)l * 1024 * 1024, MT, 1024, 1024};
            pg8::StaticOrder S; S.init(MT, 1024, F.G, bx);
            pg8::EpiRes<true> E{args.out, (bf16_t*)(ws + WS_HB) + (size_t)(cur ^ 1) * MT * DMODEL, (float*)(ws + WS_SSQ) + (size_t)(cur ^ 1) * MT * 16,
                                (const bf16_t*)(ws + WS_U) + (size_t)l * MT * DMODEL, pg8::RowScale{SSQc, 1}};
            pg8::gemm_phase<pg8::EpiRes<true>, pg8::StaticOrder, true, true>(ring, g, S, E);
            SEAM(base + 10);
        }
        if (EN(17) && l == 1 && IN(base + 11)) { WS_LAUNDER();
            pg8::Gemm g{(const bf16_t*)(ws + WS_HB) + (size_t)(cur ^ 1) * MT * DMODEL, (const bf16_t*)(ws + W_KVS), MT, 512, 1024};
            pg8::StaticOrder S; S.init(MT, 512, F.G, bx);
            pg8::EpiKvs E{(bf16_t*)(ws + WS_SKT), (bf16_t*)(ws + WS_SVT), pg8::RowScale{(const float*)(ws + WS_SSQ) + (size_t)(cur ^ 1) * MT * 16, 1}};
            pg8::gemm_phase<pg8::EpiKvs, pg8::StaticOrder, true, true>(ring, g, S, E);
            SEAM(base + 11);
        }
    }
#undef IN
#undef SEAM
}
}
#define MULTI_LAUNCH 0
extern "C" void kernel_launch(void* const* d_in, const int* in_sizes, int n_in, void* d_out, int out_size, void* d_ws, size_t ws_size, hipStream_t stream) {
    using namespace fw;
    static int grid = 0;
    if (grid == 0) {
        if (n_in != 26 || out_size != MT * DMODEL || ws_size < WS_END) { fprintf(stderr, "kernel_launch: unexpected n_in %d / out %d / ws %zu\n", n_in, out_size, ws_size); grid = -1; return; }
        if (hipFuncSetAttribute((const void*)yoco_fwd, hipFuncAttributeMaxDynamicSharedMemorySize, LDS_BYTES) != hipSuccess) { fprintf(stderr, "kernel_launch: hipFuncSetAttribute failed\n"); grid = -1; return; }
        int dev = 0, cus = 0, per_cu = 0;
        (void)hipGetDevice(&dev); (void)hipDeviceGetAttribute(&cus, hipDeviceAttributeMultiprocessorCount, dev);
        (void)hipOccupancyMaxActiveBlocksPerMultiprocessor(&per_cu, (const void*)yoco_fwd, NTHR, LDS_BYTES);
        (void)hipGetLastError();
        grid = (cus > 0 && per_cu >= 1) ? cus : 256;
        if (grid > 256) grid = 256;
    }
    if (grid < 0) return;
    (void)hipMemsetAsync((unsigned char*)d_ws + WS_CTL, 0, CTL_ZERO_BYTES, stream);
    Args a{};
    for (int i = 0; i < 26; ++i) a.in[i] = (const float*)d_in[i];
    a.out = (float*)d_out; a.ws = (unsigned char*)d_ws;
#if MULTI_LAUNCH
    for (int k = 0; k < PH_TOTAL; ++k) { if (!phase_active(k)) continue; a.ph_lo = k; a.ph_hi = k + 1; hipLaunchKernelGGL(yoco_fwd, dim3(grid), dim3(NTHR), LDS_BYTES, stream, a); }
#else
    a.ph_lo = 0; a.ph_hi = PH_TOTAL - 1;
    hipLaunchKernelGGL(yoco_fwd, dim3(grid), dim3(NTHR), LDS_BYTES, stream, a);
#endif
}
```

```cpp
#include <hip/hip_runtime.h>
#include <cstdio>
#include <cstdint>
#include <cmath>
#define LAS __attribute__((address_space(3)))
#define GAS __attribute__((address_space(1)))
typedef unsigned short bf16_t;
typedef short bf16x8 __attribute__((ext_vector_type(8)));
typedef float f32x4 __attribute__((ext_vector_type(4)));
typedef float f32x2 __attribute__((ext_vector_type(2)));
typedef float f32x16 __attribute__((ext_vector_type(16)));
typedef unsigned u32x4 __attribute__((ext_vector_type(4)));
typedef unsigned u32x2 __attribute__((ext_vector_type(2)));
typedef short s16x4 __attribute__((ext_vector_type(4)));
typedef __bf16 bf16x2_t __attribute__((ext_vector_type(2)));

constexpr int MT = 16384, DMODEL = 1024, SEQL = 8192;
constexpr float RMS_EPS = 1e-6f;
constexpr float LOG2E = 1.4426950408889634f;

__device__ __forceinline__ unsigned pk_bf16(float lo, float hi) { f32x2 v = {lo, hi}; bf16x2_t b = __builtin_convertvector(v, bf16x2_t); return __builtin_bit_cast(unsigned, b); }
__device__ __forceinline__ float bf_lo(unsigned w) { return __uint_as_float(w << 16); }
__device__ __forceinline__ float bf_hi(unsigned w) { return __uint_as_float(w & 0xffff0000u); }
__device__ __forceinline__ unsigned cvt_pk_bf16(float lo, float hi) { unsigned r; asm volatile("v_cvt_pk_bf16_f32 %0, %1, %2" : "=v"(r) : "v"(lo), "v"(hi)); return r; }
__device__ __forceinline__ u32x4 pack8(const f32x4 a, const f32x4 b) { u32x4 w; w.x = cvt_pk_bf16(a[0], a[1]); w.y = cvt_pk_bf16(a[2], a[3]); w.z = cvt_pk_bf16(b[0], b[1]); w.w = cvt_pk_bf16(b[2], b[3]); return w; }
__device__ __forceinline__ void unpack8(const u32x4 w, f32x4& a, f32x4& b) { a = (f32x4){bf_lo(w.x), bf_hi(w.x), bf_lo(w.y), bf_hi(w.y)}; b = (f32x4){bf_lo(w.z), bf_hi(w.z), bf_lo(w.w), bf_hi(w.w)}; }
__device__ __forceinline__ float fast_rcp(float x) { return __builtin_amdgcn_rcpf(x); }
__device__ __forceinline__ float fast_exp2(float x) { return __builtin_amdgcn_exp2f(x); }
__device__ __forceinline__ float fast_log2(float x) { return __builtin_amdgcn_logf(x); }
__device__ __forceinline__ float sigmoidf_(float x) { return fast_rcp(1.0f + fast_exp2(-x * LOG2E)); }

namespace pg8 {
constexpr int BM = 256, BK = 64, HALF = 128, HTB = HALF * BK * 2, STAGE_BYTES = 8 * HTB, NXCD = 8, WGM = 8;
__host__ __device__ __forceinline__ int lds_byte(int r, int c) { const int st = (r >> 4) * 2 + (c >> 5), rr = r & 15, cc = c & 31, ob = rr * 64 + cc * 2; return st * 1024 + (ob ^ (((ob >> 9) & 1) << 5)); }
__host__ __device__ __forceinline__ void stage_rc(int b, int& R, int& C) { const int st = b / 1024, sb = b % 1024, swz = sb ^ (((sb >> 9) & 1) << 5); R = (st >> 1) * 16 + swz / 64; C = (st & 1) * 32 + (swz % 64) / 2; }
__host__ __device__ __forceinline__ int perm32(int rho) { const int n = rho >> 4, i = rho & 15; return 8 * (i >> 2) + 4 * n + (i & 3); }

struct Unit { int pm, pn; size_t boff; };
struct Gemm { const bf16_t* A; const bf16_t* Bt; int M, N, K; };

struct StaticOrder {
    int nM, nN, nwg, G, c;
    __device__ void init(int M, int N, int G_, int c_) { nM = M / BM; nN = N / BM; nwg = nM * nN; G = G_; c = c_; }
    __device__ bool next(int i, Unit& u) const {
        const long L = (long)i * G + c; if (L >= nwg) return false;
        int wgid = (int)L; { const int q = nwg / NXCD, r = nwg % NXCD, xcd = wgid % NXCD, off = wgid / NXCD; wgid = (xcd < r ? xcd * (q + 1) : r * (q + 1) + (xcd - r) * q) + off; }
        const int nig = WGM * nN, gid = wgid / nig, fm = gid * WGM, gsz = (nM - fm) < WGM ? (nM - fm) : WGM;
        u.pm = fm + ((wgid % nig) % gsz); u.pn = (wgid % nig) / gsz; u.boff = 0; return true;
    }
};
struct GroupOrder {
    int ps[9]; int nN, nwg, G, c; size_t estride;
    __device__ void init(const int* pstart, int N, int G_, int c_, size_t estride_) {
#pragma unroll
        for (int e = 0; e < 9; ++e) ps[e] = __builtin_amdgcn_readfirstlane(pstart[e]);
        nN = N / BM; nwg = ps[8] * nN; G = G_; c = c_; estride = estride_; }
    __device__ void init_dense(int M, int N, int G_, int c_) {
        ps[0] = 0;
#pragma unroll
        for (int e = 1; e < 9; ++e) ps[e] = M / BM;
        nN = N / BM; nwg = ps[8] * nN; G = G_; c = c_; estride = 0; }
    __device__ bool next(int i, Unit& u) const {
        const long L = (long)i * G + c; if (L >= nwg) return false;
        int wgid = (int)L; { const int q = nwg / NXCD, r = nwg % NXCD, xcd = wgid % NXCD, off = wgid / NXCD; wgid = (xcd < r ? xcd * (q + 1) : r * (q + 1) + (xcd - r) * q) + off; }
        int e = 0;
#pragma unroll
        for (int k = 1; k < 8; ++k) if (wgid >= ps[k] * nN) e = k;
        int p0 = ps[0], p1 = ps[1];
#pragma unroll
        for (int k = 1; k < 8; ++k) if (e == k) { p0 = ps[k]; p1 = ps[k + 1]; }
        const int local = wgid - p0 * nN, np = p1 - p0;
        u.pn = local / np; u.pm = p0 + (local % np); u.boff = (size_t)e * estride; return true;
    }
};


__device__ __forceinline__ float sumsq8(const f32x4 a, const f32x4 b) { return ((a[0] * a[0] + a[1] * a[1]) + (a[2] * a[2] + a[3] * a[3])) + ((b[0] * b[0] + b[1] * b[1]) + (b[2] * b[2] + b[3] * b[3])); }
__device__ __forceinline__ float red_fq(float s) { s += __shfl_xor(s, 16); s += __shfl_xor(s, 32); return s; }
struct RowScale {
    const float* p; int mode;
    __device__ __forceinline__ float get(int row, int fq) const {
        if (mode == 0) return 1.0f;
        if (mode == 2) return p[row];
        if (mode == 1) { const f32x4 a = *(const f32x4*)(p + (size_t)row * 16 + 4 * fq); const float s = red_fq((a[0] + a[1]) + (a[2] + a[3])); return 1.0f / sqrtf(s * (1.0f / 1024.0f) + RMS_EPS); }
        if (mode == 3) { const f32x4 a = *(const f32x4*)(p + (size_t)row * 8 + 4 * (fq & 1)); const float s = red_fq(fq < 2 ? (a[0] + a[1]) + (a[2] + a[3]) : 0.f); return 1.0f / sqrtf(s * (1.0f / 384.0f) + RMS_EPS); }
        { const float s = red_fq(p[(size_t)row * 4 + fq]); return 1.0f / sqrtf(s * (1.0f / 256.0f) + RMS_EPS); }
    }
    __device__ __forceinline__ void get8(float (&rsv)[2][4], int row0, int fq) const {
#pragma unroll
        for (int ai = 0; ai < 2; ++ai)
#pragma unroll
            for (int m = 0; m < 4; ++m) rsv[ai][m] = get(row0 + ai * 128 + m * 16, fq);
        asm volatile("" ::: "memory");
    }
};

struct EpiScale {
    static constexpr bool PERM = true, AFTER_DRAIN = false;
    bf16_t* O; int ldc; RowScale rs; float cs;
    __device__ __forceinline__ void operator()(const f32x4 (&acc)[2][2][4][2], const Unit& u, int wr, int wc, int fr, int fq) const {
        const int row0 = u.pm * BM + wr * 64 + fr, col0 = u.pn * BM + wc * 32 + 8 * fq;
        float rsv[2][4]; rs.get8(rsv, row0, fq);
#pragma unroll
        for (int ai = 0; ai < 2; ++ai)
#pragma unroll
            for (int m = 0; m < 4; ++m) { const int row = row0 + ai * HALF + m * 16; const float s = rsv[ai][m] * cs; bf16_t* rowp = O + (size_t)row * ldc + col0;
#pragma unroll
                for (int bj = 0; bj < 2; ++bj) *(u32x4*)(rowp + bj * HALF) = pack8(acc[ai][bj][m][0] * s, acc[ai][bj][m][1] * s); }
    }
};
struct EpiAin {
    static constexpr bool PERM = true, AFTER_DRAIN = false;
    bf16_t* AQ; bf16_t* AKV; float* KPE; float* SSQQ; float* SSQKV; RowScale rs;
    __device__ __forceinline__ void operator()(const f32x4 (&acc)[2][2][4][2], const Unit& u, int wr, int wc, int fr, int fq) const {
        const int row0 = u.pm * BM + wr * 64 + fr, c8 = wc * 32 + 8 * fq;
        float rsv[2][4]; rs.get8(rsv, row0, fq);
#pragma unroll
        for (int ai = 0; ai < 2; ++ai)
#pragma unroll
            for (int m = 0; m < 4; ++m) { const int row = row0 + ai * HALF + m * 16; const float s = rsv[ai][m];
                const f32x4 a0 = acc[ai][0][m][0] * s, a1 = acc[ai][0][m][1] * s, b0 = acc[ai][1][m][0] * s, b1 = acc[ai][1][m][1] * s;
                if (u.pn == 0) {
                    *(u32x4*)(AQ + (size_t)row * 384 + c8) = pack8(a0, a1); *(u32x4*)(AQ + (size_t)row * 384 + 128 + c8) = pack8(b0, b1);
                    const float q = red_fq(sumsq8(a0, a1) + sumsq8(b0, b1)); if (fq == 0) SSQQ[(size_t)row * 8 + wc] = q;
                } else if (u.pn == 1) {
                    *(u32x4*)(AQ + (size_t)row * 384 + 256 + c8) = pack8(a0, a1);
                    const float q = red_fq(sumsq8(a0, a1)); if (fq == 0) SSQQ[(size_t)row * 8 + 4 + wc] = q;
                    if (wc == 0) { *(f32x4*)(KPE + (size_t)row * 32 + 8 * fq) = b0; *(f32x4*)(KPE + (size_t)row * 32 + 8 * fq + 4) = b1; }
                } else {
                    *(u32x4*)(AKV + (size_t)row * 256 + c8) = pack8(a0, a1); *(u32x4*)(AKV + (size_t)row * 256 + 128 + c8) = pack8(b0, b1);
                    const float q = red_fq(sumsq8(a0, a1) + sumsq8(b0, b1)); if (fq == 0) SSQKV[(size_t)row * 4 + wc] = q;
                } }
    }
};
struct EpiSwiglu {
    static constexpr bool PERM = true, AFTER_DRAIN = false;
    bf16_t* HID; RowScale rs;
    __device__ __forceinline__ void operator()(const f32x4 (&acc)[2][2][4][2], const Unit& u, int wr, int wc, int fr, int fq) const {
        const int row0 = u.pm * BM + wr * 64 + fr, col0 = u.pn * 128 + wc * 32 + 8 * fq;
        float rsv[2][4]; rs.get8(rsv, row0, fq);
#pragma unroll
        for (int ai = 0; ai < 2; ++ai)
#pragma unroll
            for (int m = 0; m < 4; ++m) { const int row = row0 + ai * HALF + m * 16; const float s = rsv[ai][m];
                f32x4 o[2];
#pragma unroll
                for (int n = 0; n < 2; ++n) { const f32x4 g = acc[ai][0][m][n] * s, up = acc[ai][1][m][n] * s;
#pragma unroll
                    for (int j = 0; j < 4; ++j) o[n][j] = g[j] * sigmoidf_(g[j]) * up[j]; }
                *(u32x4*)(HID + (size_t)row * 2816 + col0) = pack8(o[0], o[1]); }
    }
};
template <bool GATED> struct EpiRes {
    static constexpr bool PERM = true, AFTER_DRAIN = false;
    float* H; bf16_t* HBo; float* SSQo; const bf16_t* U; RowScale rs;
    __device__ __forceinline__ void operator()(const f32x4 (&acc)[2][2][4][2], const Unit& u, int wr, int wc, int fr, int fq) const {
        const int row0 = u.pm * BM + wr * 64 + fr, col0 = u.pn * BM + wc * 32 + 8 * fq;
        float rsv[2][4]; if (GATED) rs.get8(rsv, row0, fq);
#pragma unroll
        for (int ai = 0; ai < 2; ++ai)
#pragma unroll
            for (int m = 0; m < 4; ++m) { const int row = row0 + ai * HALF + m * 16; const size_t off = (size_t)row * DMODEL + col0;
                float s = 1.0f; if (GATED) s = rsv[ai][m];
                float q = 0.f;
#pragma unroll
                for (int bj = 0; bj < 2; ++bj) { f32x4 a0 = acc[ai][bj][m][0], a1 = acc[ai][bj][m][1];
                    f32x4 h0 = *(const f32x4*)(H + off + bj * HALF), h1 = *(const f32x4*)(H + off + bj * HALF + 4);
                    if (GATED) { f32x4 u0, u1; unpack8(*(const u32x4*)(U + off + bj * HALF), u0, u1);
#pragma unroll
                        for (int j = 0; j < 4; ++j) { a0[j] = sigmoidf_(a0[j] * s) * u0[j]; a1[j] = sigmoidf_(a1[j] * s) * u1[j]; } }
                    h0 += a0; h1 += a1;
                    *(f32x4*)(H + off + bj * HALF) = h0; *(f32x4*)(H + off + bj * HALF + 4) = h1;
                    *(u32x4*)(HBo + off + bj * HALF) = pack8(h0, h1);
                    q += sumsq8(h0, h1); }
                q = red_fq(q); if (fq == 0) SSQo[(size_t)row * 16 + u.pn * 4 + wc] = q;
                asm volatile("" ::: "memory"); }
    }
};
struct EpiKvs {
    static constexpr bool PERM = true, AFTER_DRAIN = false;
    bf16_t* KT; bf16_t* VT; RowScale rs;
    __device__ __forceinline__ void operator()(const f32x4 (&acc)[2][2][4][2], const Unit& u, int wr, int wc, int fr, int fq) const {
        const int row0 = u.pm * BM + wr * 64 + fr;
        float rsv[2][4]; rs.get8(rsv, row0, fq);
#pragma unroll
        for (int ai = 0; ai < 2; ++ai)
#pragma unroll
            for (int m = 0; m < 4; ++m) { const int row = row0 + ai * HALF + m * 16; const float s = rsv[ai][m];
                const int b = row >> 13, sq = row & 8191, tile = sq >> 6, rr = sq & 63;
#pragma unroll
                for (int bj = 0; bj < 2; ++bj) { const int c = bj * HALF + wc * 32 + 8 * fq, kh = c >> 6, d = c & 63;
                    const size_t tb = (size_t)((b * 4 + kh) * 128 + tile) * 4096;
                    const u32x4 w = pack8(acc[ai][bj][m][0] * s, acc[ai][bj][m][1] * s);
                    if (u.pn == 0) *(u32x4*)(KT + tb + (d >> 3) * 512 + rr * 8) = w;
                    else *(u32x4*)(VT + tb + (d >> 5) * 2048 + rr * 32 + (d & 31)) = w; } }
    }
};

#define PG8_LAS LAS
template <class Epi, class Sched, bool ALIGN_EPI = false, bool SP2 = false>
__device__ __forceinline__ void gemm_phase(PG8_LAS unsigned char* lds, const Gemm g, const Sched& S, const Epi& E) {
    int tid_ = threadIdx.x; asm volatile("" : "+v"(tid_));
    const int tid = tid_, wid = __builtin_amdgcn_readfirstlane(tid >> 6), lane = tid & 63, wr = wid >> 2, wc = wid & 3, fr = lane & 15, fq = lane >> 4;
    const int K = g.K, nt = K / BK;
    unsigned voffA[2], voffB[2];
#pragma unroll
    for (int i = 0; i < 2; ++i) { int R, C; stage_rc(tid * 16 + i * 8192, R, C); const int Rb = Epi::PERM ? ((R & ~31) + perm32(R & 31)) : R;
        voffA[i] = (unsigned)(R * K + C) * 2u; voffB[i] = (unsigned)(Rb * K + C) * 2u; }
    const size_t kstep = (size_t)(BK * 2);
    const size_t hstep = (size_t)HALF * K * 2;
    const size_t tstep = 2 * hstep;
    const unsigned ldsw = (unsigned)wid * 1024u;
    const int aoff = lds_byte(wr * 64 + fr, fq * 8), boff = lds_byte(wc * 32 + fr, fq * 8);
#define PG8_SA(b, h) (((b) * 2 + (h)) * HTB)
#define PG8_SB(b, h) ((4 + (b) * 2 + (h)) * HTB)
#define PG8_STAGE(bufoff, gbase, voff) do { _Pragma("unroll") for (int _i = 0; _i < 2; ++_i) \
        __builtin_amdgcn_global_load_lds((const unsigned*)((const char*)(gbase) + (voff)[_i]), (PG8_LAS unsigned*)(lds + (bufoff) + ldsw + _i * 8192), 16, 0, 0); } while (0)
#define PG8_LDA(dst, b, h) do { _Pragma("unroll") for (int m = 0; m < 4; ++m) _Pragma("unroll") for (int k = 0; k < 2; ++k) dst[m][k] = *(const PG8_LAS bf16x8*)(lds + PG8_SA(b, h) + aoff + m * 2048 + k * 1024); } while (0)
#define PG8_LDB(dst, b, h) do { _Pragma("unroll") for (int n = 0; n < 2; ++n) _Pragma("unroll") for (int k = 0; k < 2; ++k) dst[n][k] = *(const PG8_LAS bf16x8*)(lds + PG8_SB(b, h) + boff + n * 2048 + k * 1024); } while (0)
#define PG8_MMA(ai, bj, At, Bt) do { __builtin_amdgcn_s_setprio(1); _Pragma("unroll") for (int m = 0; m < 4; ++m) _Pragma("unroll") for (int n = 0; n < 2; ++n) _Pragma("unroll") for (int k = 0; k < 2; ++k) \
        acc[ai][bj][m][n] = __builtin_amdgcn_mfma_f32_16x16x32_bf16(Bt[n][k], At[m][k], acc[ai][bj][m][n], 0, 0, 0); __builtin_amdgcn_s_setprio(0); } while (0)
#define PG8_WAIT_V(n) asm volatile("s_waitcnt vmcnt(" #n ")" ::: "memory")
#define PG8_WAIT_L(n) asm volatile("s_waitcnt lgkmcnt(" #n ")" ::: "memory")
#define PG8_BAR __builtin_amdgcn_s_barrier()
#define PG8_SCHED __builtin_amdgcn_sched_barrier(0)
    Unit cur, nxt; int ui = 0;
    if (!S.next(0, cur)) return;
    f32x4 acc[2][2][4][2];
#pragma unroll
    for (int a = 0; a < 2; ++a)
#pragma unroll
        for (int b = 0; b < 2; ++b)
#pragma unroll
            for (int m = 0; m < 4; ++m)
#pragma unroll
                for (int n = 0; n < 2; ++n) acc[a][b][m][n] = (f32x4){0.f, 0.f, 0.f, 0.f};
    bf16x8 At[4][2], B0[2][2], B1[2][2];
    const char* cA = (const char*)g.A + (size_t)cur.pm * tstep; const char* cB = (const char*)g.Bt + cur.boff + (size_t)cur.pn * tstep;
    if constexpr (SP2) {
        PG8_STAGE(PG8_SB(0, 0), cB, voffB); PG8_STAGE(PG8_SB(0, 1), cB + hstep, voffB); PG8_STAGE(PG8_SA(0, 0), cA, voffA); PG8_STAGE(PG8_SA(0, 1), cA + hstep, voffA);
        if (wr == 1) PG8_BAR;
        PG8_WAIT_V(2); PG8_BAR;
        PG8_STAGE(PG8_SB(1, 0), cB + kstep, voffB); PG8_STAGE(PG8_SA(1, 0), cA + kstep, voffA); PG8_STAGE(PG8_SB(1, 1), cB + hstep + kstep, voffB);
        PG8_WAIT_V(6); PG8_BAR;
    } else {
        PG8_STAGE(PG8_SB(0, 0), cB, voffB); PG8_STAGE(PG8_SA(0, 0), cA, voffA); PG8_STAGE(PG8_SB(0, 1), cB + hstep, voffB); PG8_STAGE(PG8_SA(0, 1), cA + hstep, voffA);
        if (wr == 1) PG8_BAR;
        PG8_WAIT_V(4); PG8_BAR;
        PG8_STAGE(PG8_SB(1, 0), cB + kstep, voffB); PG8_STAGE(PG8_SA(1, 0), cA + kstep, voffA); PG8_STAGE(PG8_SB(1, 1), cB + hstep + kstep, voffB);
        PG8_WAIT_V(6); PG8_BAR;
    }
    for (;;) {
        const bool has_next = S.next(ui + 1, nxt);
        const char* nA = has_next ? (const char*)g.A + (size_t)nxt.pm * tstep : cA; const char* nB = has_next ? (const char*)g.Bt + nxt.boff + (size_t)nxt.pn * tstep : cB;
        for (int t = 0; t < nt; t += 2) {
            const bool last = (t == nt - 2);
            const char* a1 = cA + (size_t)(t + 1) * kstep;
            const char* a2 = last ? nA : cA + (size_t)(t + 2) * kstep; const char* b2 = last ? nB : cB + (size_t)(t + 2) * kstep;
            const char* a3 = a2 + kstep; const char* b3 = b2 + kstep;
            if constexpr (SP2) {
            PG8_LDB(B0, 0, 0); PG8_LDB(B1, 0, 1); PG8_SCHED; PG8_LDA(At, 0, 0); PG8_STAGE(PG8_SA(1, 1), a1 + hstep, voffA);
            PG8_WAIT_V(8); PG8_WAIT_L(0); PG8_BAR; PG8_MMA(0, 0, At, B0); PG8_MMA(0, 1, At, B1); PG8_BAR; PG8_SCHED;
            PG8_LDA(At, 0, 1); PG8_STAGE(PG8_SB(0, 0), b2, voffB); PG8_STAGE(PG8_SB(0, 1), b2 + hstep, voffB); PG8_STAGE(PG8_SA(0, 0), a2, voffA);
            PG8_WAIT_V(8); PG8_WAIT_L(0); PG8_BAR; PG8_MMA(1, 0, At, B0); PG8_MMA(1, 1, At, B1); PG8_BAR; PG8_SCHED;
            PG8_LDB(B0, 1, 0); PG8_LDB(B1, 1, 1); PG8_SCHED; PG8_LDA(At, 1, 0); PG8_STAGE(PG8_SA(0, 1), a2 + hstep, voffA);
            PG8_WAIT_V(8); PG8_WAIT_L(0); PG8_BAR; PG8_MMA(0, 0, At, B0); PG8_MMA(0, 1, At, B1); PG8_BAR; PG8_SCHED;
            PG8_LDA(At, 1, 1); PG8_STAGE(PG8_SB(1, 0), b3, voffB); PG8_STAGE(PG8_SB(1, 1), b3 + hstep, voffB); PG8_STAGE(PG8_SA(1, 0), a3, voffA);
            PG8_WAIT_V(8); PG8_WAIT_L(0); PG8_BAR; PG8_MMA(1, 0, At, B0); PG8_MMA(1, 1, At, B1); PG8_BAR; PG8_SCHED;
            } else {
            PG8_LDB(B0, 0, 0); PG8_SCHED; PG8_LDA(At, 0, 0); PG8_STAGE(PG8_SA(1, 1), a1 + hstep, voffA);
            PG8_WAIT_L(8); PG8_BAR; PG8_WAIT_L(0); PG8_MMA(0, 0, At, B0); PG8_BAR; PG8_SCHED;
            PG8_LDB(B1, 0, 1); PG8_STAGE(PG8_SB(0, 0), b2, voffB);
            PG8_BAR; PG8_WAIT_L(0); PG8_MMA(0, 1, At, B1); PG8_BAR;
            PG8_LDA(At, 0, 1); PG8_STAGE(PG8_SA(0, 0), a2, voffA);
            PG8_BAR; PG8_WAIT_L(0); PG8_MMA(1, 0, At, B0); PG8_BAR; PG8_SCHED;
            PG8_STAGE(PG8_SB(0, 1), b2 + hstep, voffB);
            PG8_WAIT_V(6); PG8_BAR; PG8_MMA(1, 1, At, B1); PG8_BAR;
            PG8_LDB(B0, 1, 0); PG8_SCHED; PG8_LDA(At, 1, 0); PG8_STAGE(PG8_SA(0, 1), a2 + hstep, voffA);
            PG8_WAIT_L(8); PG8_BAR; PG8_WAIT_L(0); PG8_MMA(0, 0, At, B0); PG8_BAR; PG8_SCHED;
            PG8_LDB(B1, 1, 1); PG8_STAGE(PG8_SB(1, 0), b3, voffB);
            PG8_BAR; PG8_WAIT_L(0); PG8_MMA(0, 1, At, B1); PG8_BAR;
            PG8_LDA(At, 1, 1); PG8_STAGE(PG8_SA(1, 0), a3, voffA);
            PG8_BAR; PG8_WAIT_L(0); PG8_MMA(1, 0, At, B0); PG8_BAR; PG8_SCHED;
            PG8_STAGE(PG8_SB(1, 1), b3 + hstep, voffB);
            PG8_WAIT_V(6); PG8_BAR; PG8_MMA(1, 1, At, B1); PG8_BAR;
            }
        }
        if constexpr (ALIGN_EPI) { if (wr == 0) PG8_BAR; }
        E(acc, cur, wr, wc, fr, fq);
        if (!has_next) break;
#pragma unroll
        for (int a = 0; a < 2; ++a)
#pragma unroll
            for (int b = 0; b < 2; ++b)
#pragma unroll
                for (int m = 0; m < 4; ++m)
#pragma unroll
                    for (int n = 0; n < 2; ++n) acc[a][b][m][n] = (f32x4){0.f, 0.f, 0.f, 0.f};
        cur = nxt; cA = nA; cB = nB; ++ui;
        if constexpr (ALIGN_EPI) { if (wr == 1) PG8_BAR; }
    }
    PG8_WAIT_V(0);
    if constexpr (!ALIGN_EPI) { if (wr == 0) PG8_BAR; }
    PG8_BAR;
#undef PG8_SA
#undef PG8_SB
#undef PG8_STAGE
#undef PG8_LDA
#undef PG8_LDB
#undef PG8_MMA
#undef PG8_WAIT_V
#undef PG8_WAIT_L
#undef PG8_BAR
#undef PG8_SCHED
}
}
typedef GAS unsigned gu32;
#define RLX_AGENT __ATOMIC_RELAXED, __HIP_MEMORY_SCOPE_AGENT
#define XB_TMO      128
#define XB_XCNT(j)  (256  + 64 * (j))
#define XB_XSUB(j)  (1280 + 64 * (j))
#define XB_XGEN(j)  (2304 + 64 * (j))
#define XB_TOP      3328
#define XB_TOPGEN   3392
#define XCD_BAR_WORDS 3456
#define XB_SPIN_CAP (1u << 18)

__device__ __forceinline__ unsigned xb_ld(unsigned* p)              { return __hip_atomic_load(p, __ATOMIC_RELAXED, __HIP_MEMORY_SCOPE_AGENT); }
__device__ __forceinline__ unsigned xb_add(unsigned* p, unsigned v) { return __hip_atomic_fetch_add(p, v, __ATOMIC_RELAXED, __HIP_MEMORY_SCOPE_AGENT); }
__device__ __forceinline__ unsigned xb_xcc_id() { return (unsigned)__builtin_amdgcn_s_getreg((3 << 11) | 20) & 0xFu; }
#define XB_SPIN(cond, bar) do { unsigned _sp = 0; while (cond) { __builtin_amdgcn_s_sleep(1); \
    if ((++_sp & 255u) == 0u) { if (xb_ld(&(bar)[XB_TMO])) break; if (_sp > XB_SPIN_CAP) { atomicAdd(&(bar)[XB_TMO], 1u); break; } } } } while (0)

struct XcdBarrier {
    unsigned* bar; unsigned x;
    volatile LAS unsigned* st;
};
__device__ __forceinline__ XcdBarrier xcd_barrier_post(unsigned* bar, volatile LAS unsigned* st) {
    XcdBarrier b; b.bar = bar; b.x = xb_xcc_id(); b.st = st;
    if (threadIdx.x == 0) (void)xb_add(&bar[XB_XCNT(b.x)], 1u);
    return b;
}
__device__ __forceinline__ void xcd_barrier_complete(unsigned* bar, unsigned x, unsigned& nloc, unsigned& nx) {
    const unsigned G = gridDim.x * gridDim.y * gridDim.z;
    unsigned sum, cnt, mine, sp = 0u;
    for (;;) {
        sum = 0u; cnt = 0u; mine = 0u;
#pragma unroll
        for (unsigned j = 0; j < 16; ++j) { const unsigned c = xb_ld(&bar[XB_XCNT(j)]); sum += c; cnt += (c > 0u) ? 1u : 0u; mine = (j == x) ? c : mine; }
        if (sum == G) break;
        __builtin_amdgcn_s_sleep(1);
        if ((++sp & 255u) == 0u) { if (xb_ld(&bar[XB_TMO])) break; if (sp > XB_SPIN_CAP) { atomicAdd(&bar[XB_TMO], 1u); break; } }
    }
    nloc = mine > 0u ? mine : 1u; nx = cnt > 0u ? cnt : 1u;
}
__device__ __forceinline__ void xcd_barrier(const XcdBarrier& b) {
    asm volatile("s_waitcnt vmcnt(0)" ::: "memory");
    __syncthreads();
    if (threadIdx.x == 0) {
        unsigned* bar = b.bar;
        __builtin_amdgcn_s_waitcnt(0);
        unsigned nloc = b.st[0], nx = b.st[1];
        if (nloc == 0u) { xcd_barrier_complete(bar, b.x, nloc, nx); b.st[0] = nloc; b.st[1] = nx; }
        const unsigned old = xb_add(&bar[XB_XSUB(b.x)], 1u);
        const unsigned gen = old / nloc;
        if (old + 1u == (gen + 1u) * nloc) {
            __builtin_amdgcn_fence(__ATOMIC_RELEASE, "agent");
            asm volatile("s_waitcnt vmcnt(0)" ::: "memory");
            const unsigned og = xb_add(&bar[XB_TOP], 1u);
            const unsigned tg = og / nx;
            if (og + 1u == (tg + 1u) * nx) xb_add(&bar[XB_TOPGEN], 1u);
            else XB_SPIN(xb_ld(&bar[XB_TOPGEN]) == tg, bar);
            __builtin_amdgcn_fence(__ATOMIC_ACQUIRE, "agent");
            xb_add(&bar[XB_XGEN(b.x)], 1u);
            asm volatile("s_waitcnt vmcnt(0)" ::: "memory");
        } else {
            XB_SPIN(xb_ld(&bar[XB_XGEN(b.x)]) == gen, bar);
            __builtin_amdgcn_fence(__ATOMIC_ACQUIRE, "agent");
            asm volatile("s_waitcnt vmcnt(0)" ::: "memory");
        }
    }
    __syncthreads();
}

namespace att {
__device__ __forceinline__ int crow(int r, int hi) { return (r & 3) + 8 * (r >> 2) + 4 * hi; }
__device__ __forceinline__ void glds16(const void* gsrc, unsigned lds_dst) { unsigned keep;
    asm volatile("s_mov_b32 %0, m0\n\ts_mov_b32 m0, %2\n\ts_nop 0\n\tglobal_load_lds_dwordx4 %1, off\n\ts_mov_b32 m0, %0" : "=&s"(keep) : "v"(gsrc), "s"(lds_dst) : "memory"); }
#define ATT_WAIT_BAR(N) asm volatile("s_waitcnt vmcnt(" #N ") lgkmcnt(0)\n\ts_barrier" ::: "memory")
#define ATT_MX3(a, b, c) __builtin_fmaxf(__builtin_fmaxf((a), (b)), (c))
typedef LAS const unsigned char* lcp;
typedef short v4i16_t __attribute__((ext_vector_type(4)));
__device__ __forceinline__ s16x4 vtr(lcp p) { return __builtin_bit_cast(s16x4, __builtin_amdgcn_ds_read_tr16_b64_v4i16((LAS v4i16_t*)p)); }
__device__ __forceinline__ float rowmax(const f32x16& p0, const f32x16& p1) {
    float a = ATT_MX3(p0[0], p0[1], p1[0]), b = ATT_MX3(p0[2], p0[3], p1[1]); a = ATT_MX3(a, p1[2], p1[3]);
#pragma unroll
    for (int r = 4; r < 16; r += 4) { a = ATT_MX3(a, p0[r], p0[r + 1]); b = ATT_MX3(b, p0[r + 2], p0[r + 3]); a = ATT_MX3(a, p1[r], p1[r + 1]); b = ATT_MX3(b, p1[r + 2], p1[r + 3]); }
    float m = __builtin_fmaxf(a, b); auto rr = __builtin_amdgcn_permlane32_swap(__float_as_uint(m), __float_as_uint(m), false, false);
    return __builtin_fmaxf(__uint_as_float(rr[0]), __uint_as_float(rr[1])); }
__device__ __forceinline__ void pv(f32x16* o, lcp vp, const u32x4 pw0, const u32x4 pw1, const u32x4 pw2, const u32x4 pw3) {
#pragma unroll
    for (int d0 = 0; d0 < 2; ++d0) {
#pragma unroll
        for (int ks = 0; ks < 4; ++ks) {
            const s16x4 lo = vtr(vp + d0 * 4096 + ks * 1024), hi = vtr(vp + d0 * 4096 + ks * 1024 + 512);
            const bf16x8 vf = (bf16x8){lo[0], lo[1], lo[2], lo[3], hi[0], hi[1], hi[2], hi[3]};
            const u32x4 pw = ks == 0 ? pw0 : ks == 1 ? pw1 : ks == 2 ? pw2 : pw3;
            o[d0] = __builtin_amdgcn_mfma_f32_32x32x16_bf16(__builtin_bit_cast(bf16x8, pw), vf, o[d0], 0, 0, 0);
        }
    }
}
__device__ __forceinline__ void store_o(const f32x16* o, const float* rsc  , LAS unsigned char* stage, bf16_t* Ow, int pitch, int lane, int r32, int hi) {
    LAS bf16_t* stg = (LAS bf16_t*)stage;
#pragma unroll
    for (int r = 0; r < 16; ++r) { const int orow = crow(r, hi);
#pragma unroll
        for (int d0 = 0; d0 < 2; ++d0) stg[orow * 64 + d0 * 32 + r32] = (bf16_t)(pk_bf16(o[d0][r] * rsc[r], 0.f) & 0xffffu); }
    asm volatile("s_waitcnt lgkmcnt(0)" ::: "memory");
#pragma unroll
    for (int i = 0; i < 4; ++i) { const int row = i * 8 + (lane >> 3), ch = lane & 7; const u32x4 v = *(const LAS u32x4*)(stg + row * 64 + ch * 8); *(u32x4*)(Ow + (size_t)row * pitch + ch * 8) = v; }
}

namespace mla {
constexpr int KSLOT = 12288, VSLOT = 8192, NS = 3;
constexpr int L_K = 0, L_V = NS * KSLOT, L_WS = L_V + NS * VSLOT, L_OST = L_WS + 2048, L_END = L_OST + 8 * 4096;
__device__ __forceinline__ void unit(int b, int h, int qb, const bf16_t* Q, const bf16_t* KT, const bf16_t* VT, bf16_t* O, LAS unsigned char* shm) {
    int tid_ = threadIdx.x; asm volatile("" : "+v"(tid_));
    const int tid = tid_, lane = tid & 63, r32 = lane & 31, hi = lane >> 5; const int wid = __builtin_amdgcn_readfirstlane(tid >> 6);
    const long rowbase = (long)b * SEQL; const int q0 = qb * 256;
    const bf16_t* Qw = Q + (size_t)(rowbase + q0 + wid * 32) * 768 + h * 96;
    const bf16_t* Kh = KT + (size_t)((b * 8 + h) * 128) * 6144 + lane * 8;
    const bf16_t* Vh = VT + (size_t)((b * 8 + h) * 128) * 4096 + lane * 8;
    const unsigned lds0 = (unsigned)(uintptr_t)shm;
    LAS float* wsf = (LAS float*)(shm + L_WS) + wid * 64;
    const int NT = (q0 + 256) / 64;
    const int kc2 = 8 + (wid & 3);
#define MLA_DMA(t, sl) do { const bf16_t* kt_ = Kh + (size_t)(t) * 6144; \
        glds16(kt_ + wid * 512, (unsigned)__builtin_amdgcn_readfirstlane(lds0 + L_K + (sl) * KSLOT + wid * 1024)); \
        glds16(kt_ + kc2 * 512, (unsigned)__builtin_amdgcn_readfirstlane(lds0 + L_K + (sl) * KSLOT + kc2 * 1024)); \
        glds16(Vh + (size_t)(t) * 4096 + wid * 512, (unsigned)__builtin_amdgcn_readfirstlane(lds0 + L_V + (sl) * VSLOT + wid * 1024)); } while (0)
    MLA_DMA(0, 0); MLA_DMA(1, 1);
    bf16x8 qr[6];
#pragma unroll
    for (int d0 = 0; d0 < 6; ++d0) qr[d0] = *(const bf16x8*)(Qw + (size_t)r32 * 768 + d0 * 16 + hi * 8);
    float m = -1e30f, l = 0.f; f32x16 o[2];
#pragma unroll
    for (int r = 0; r < 16; ++r) { o[0][r] = 0.f; o[1][r] = 0.f; }
    const int qrel = wid * 32 + r32;
    int slot = 0;
    for (int t = 0; t < NT; ++t) {
        if (t + 1 < NT) ATT_WAIT_BAR(3); else ATT_WAIT_BAR(0);
        if (t + 2 < NT) { const int s2 = slot == 0 ? 2 : slot - 1; MLA_DMA(t + 2, s2); }
        const int jb = t - (NT - 4);
        if (jb <= 0 || 64 * jb <= wid * 32 + 31) {
            const lcp kb = (lcp)shm + L_K + slot * KSLOT + hi * 1024 + r32 * 16;
            f32x16 p0, p1;
#pragma unroll
            for (int r = 0; r < 16; ++r) { p0[r] = 0.f; p1[r] = 0.f; }
#pragma unroll
            for (int d0 = 0; d0 < 6; ++d0) { const bf16x8 b0 = *(const LAS bf16x8*)(kb + d0 * 2048), b1 = *(const LAS bf16x8*)(kb + d0 * 2048 + 512);
                p0 = __builtin_amdgcn_mfma_f32_32x32x16_bf16(b0, qr[d0], p0, 0, 0, 0); p1 = __builtin_amdgcn_mfma_f32_32x32x16_bf16(b1, qr[d0], p1, 0, 0, 0); }
            if (jb >= 0) {
#pragma unroll
                for (int r = 0; r < 16; ++r) { const int kv = 64 * jb + crow(r, hi); if (kv > qrel) p0[r] = -INFINITY; if (kv + 32 > qrel) p1[r] = -INFINITY; }
            }
            const float rm = rowmax(p0, p1), mnew = __builtin_fmaxf(m, rm);
            if (__any(mnew > m)) {
                const float alpha = fast_exp2(m - mnew); l *= alpha; m = mnew;
                if (hi == 0) wsf[r32] = alpha;
#pragma unroll
                for (int r = 0; r < 16; ++r) { const float a = wsf[crow(r, hi)]; o[0][r] *= a; o[1][r] *= a; }
            }
            float sa = 0.f, sb = 0.f;
#pragma unroll
            for (int r = 0; r < 16; ++r) { p0[r] = fast_exp2(p0[r] - m); p1[r] = fast_exp2(p1[r] - m); sa += p0[r]; sb += p1[r]; }
            l += sa + sb;
            const u32x4 pw0 = {pk_bf16(p0[0], p0[1]), pk_bf16(p0[2], p0[3]), pk_bf16(p0[4], p0[5]), pk_bf16(p0[6], p0[7])};
            const u32x4 pw1 = {pk_bf16(p0[8], p0[9]), pk_bf16(p0[10], p0[11]), pk_bf16(p0[12], p0[13]), pk_bf16(p0[14], p0[15])};
            const u32x4 pw2 = {pk_bf16(p1[0], p1[1]), pk_bf16(p1[2], p1[3]), pk_bf16(p1[4], p1[5]), pk_bf16(p1[6], p1[7])};
            const u32x4 pw3 = {pk_bf16(p1[8], p1[9]), pk_bf16(p1[10], p1[11]), pk_bf16(p1[12], p1[13]), pk_bf16(p1[14], p1[15])};
            const lcp vp = (lcp)shm + L_V + slot * VSLOT + ((lane >> 4) & 1) * 32 + (lane & 3) * 8 + (4 * hi + ((lane & 15) >> 2)) * 64;
            pv(o, vp, pw0, pw1, pw2, pw3);
        }
        slot = slot == 2 ? 0 : slot + 1;
    }
#undef MLA_DMA
    { auto rr = __builtin_amdgcn_permlane32_swap(__float_as_uint(l), __float_as_uint(l), false, false); l = __uint_as_float(rr[0]) + __uint_as_float(rr[1]); }
    if (hi == 0) wsf[32 + r32] = l;
    float rli[16];
#pragma unroll
    for (int r = 0; r < 16; ++r) rli[r] = fast_rcp(wsf[32 + crow(r, hi)]);
    store_o(o, rli, shm + L_OST + wid * 4096, O + (size_t)(rowbase + q0 + wid * 32) * 512 + h * 64, 512, lane, r32, hi);
    asm volatile("s_waitcnt lgkmcnt(0)\n\ts_barrier" ::: "memory");
}
__device__ __forceinline__ void phase(int vcu, int G, const bf16_t* Q, const bf16_t* KT, const bf16_t* VT, bf16_t* O, LAS unsigned char* shm) {
    for (int v = vcu; v < 256; v += G) { const int bh = v >> 4, s = v & 15;
        unit(bh >> 3, bh & 7, 31 - s, Q, KT, VT, O, shm);
        unit(bh >> 3, bh & 7, s, Q, KT, VT, O, shm); }
}
}

namespace sba {
constexpr int KSLOT = 8192, VSLOT = 8192, NS = 3;
constexpr int L_K = 0, L_V = NS * KSLOT, L_WS = L_V + NS * VSLOT, L_FLAG = L_WS + 2048, L_OST = L_FLAG + 256, L_END = L_OST + 8 * 4096;
constexpr float SB_EXIT = -160.0f;
__device__ __forceinline__ void unit(int b, int kh, int qb64, const bf16_t* Q, const bf16_t* KT, const bf16_t* VT, bf16_t* O, LAS unsigned char* shm) {
    int tid_ = threadIdx.x; asm volatile("" : "+v"(tid_));
    const int tid = tid_, lane = tid & 63, r32 = lane & 31, hi = lane >> 5; const int wid = __builtin_amdgcn_readfirstlane(tid >> 6);
    const int h = kh * 4 + (wid >> 1), half = wid & 1;
    const long rowbase = (long)b * SEQL; const int q0 = qb64 * 64;
    const bf16_t* Qw = Q + (size_t)(rowbase + q0 + half * 32) * 1024 + h * 64;
    const bf16_t* Kh = KT + (size_t)((b * 4 + kh) * 128) * 4096 + wid * 512 + lane * 8;
    const bf16_t* Vh = VT + (size_t)((b * 4 + kh) * 128) * 4096 + wid * 512 + lane * 8;
    const unsigned lds0 = (unsigned)(uintptr_t)shm;
    LAS int* flags = (LAS int*)(shm + L_FLAG);
    const int NT = qb64 + 1;
#define SBA_DMA(k, sl) do { const int tile_ = qb64 - (k); \
        glds16(Kh + (size_t)tile_ * 4096, (unsigned)__builtin_amdgcn_readfirstlane(lds0 + L_K + (sl) * KSLOT + wid * 1024)); \
        glds16(Vh + (size_t)tile_ * 4096, (unsigned)__builtin_amdgcn_readfirstlane(lds0 + L_V + (sl) * VSLOT + wid * 1024)); } while (0)
    SBA_DMA(0, 0); if (NT > 1) SBA_DMA(1, 1);
    bf16x8 qr[4];
#pragma unroll
    for (int d0 = 0; d0 < 4; ++d0) qr[d0] = *(const bf16x8*)(Qw + (size_t)r32 * 1024 + d0 * 16 + hi * 8);
    float R = 0.f; f32x16 o[2];
#pragma unroll
    for (int r = 0; r < 16; ++r) { o[0][r] = 0.f; o[1][r] = 0.f; }
    const int qrel = half * 32 + r32;
    int slot = 0;
    for (int k = 0; k < NT; ++k) {
        if (k + 1 < NT) ATT_WAIT_BAR(2); else ATT_WAIT_BAR(0);
        if (k > 0) { const LAS int* f = flags + ((k - 1) & 1) * 8; int all = 1;
#pragma unroll
            for (int w = 0; w < 8; ++w) all &= f[w];
            if (all) break; }
        if (k + 2 < NT) { const int s2 = slot == 0 ? 2 : slot - 1; SBA_DMA(k + 2, s2); }
        {
            const lcp kb = (lcp)shm + L_K + slot * KSLOT + hi * 1024 + r32 * 16;
            f32x16 p0, p1;
#pragma unroll
            for (int r = 0; r < 16; ++r) { p0[r] = 0.f; p1[r] = 0.f; }
#pragma unroll
            for (int d0 = 0; d0 < 4; ++d0) { const bf16x8 b0 = *(const LAS bf16x8*)(kb + d0 * 2048), b1 = *(const LAS bf16x8*)(kb + d0 * 2048 + 512);
                p0 = __builtin_amdgcn_mfma_f32_32x32x16_bf16(b0, qr[d0], p0, 0, 0, 0); p1 = __builtin_amdgcn_mfma_f32_32x32x16_bf16(b1, qr[d0], p1, 0, 0, 0); }
            f32x16 L0, L1;
#pragma unroll
            for (int r = 0; r < 16; ++r) {
                const float z0 = p0[r], z1 = p1[r];
                float s0 = -(__builtin_fmaxf(z0, 0.f) + fast_log2(1.0f + fast_exp2(-__builtin_fabsf(z0))));
                float s1 = -(__builtin_fmaxf(z1, 0.f) + fast_log2(1.0f + fast_exp2(-__builtin_fabsf(z1))));
                if (k == 0) { const int kv = crow(r, hi); if (kv >= qrel) s0 = 0.f; if (kv + 32 >= qrel) s1 = 0.f; }
                L0[r] = s0; L1[r] = s1; }
            float G[16];
#pragma unroll
            for (int j = 0; j < 8; ++j) { const f32x16& LL = j < 4 ? L0 : L1; const int rb = 4 * (j & 3);
                const float gsum = (LL[rb] + LL[rb + 1]) + (LL[rb + 2] + LL[rb + 3]);
                auto rr = __builtin_amdgcn_permlane32_swap(__float_as_uint(gsum), __float_as_uint(gsum), false, false);
                G[2 * j] = __uint_as_float(rr[0]); G[2 * j + 1] = __uint_as_float(rr[1]); }
            float SG[16]; SG[15] = 0.f;
#pragma unroll
            for (int g = 14; g >= 0; --g) SG[g] = SG[g + 1] + G[g + 1];
            const float T = SG[0] + G[0];
#pragma unroll
            for (int j = 0; j < 8; ++j) { f32x16& LL = j < 4 ? L0 : L1; f32x16& PP = j < 4 ? p0 : p1; const int rb = 4 * (j & 3);
                const float base = (R + SG[2 * j + 1]) + (hi ? 0.f : G[2 * j + 1]);
                const float r3 = base, r2 = r3 + LL[rb + 3], r1 = r2 + LL[rb + 2], r0 = r1 + LL[rb + 1];
                PP[rb + 3] = fast_exp2(PP[rb + 3] + LL[rb + 3] + r3); PP[rb + 2] = fast_exp2(PP[rb + 2] + LL[rb + 2] + r2);
                PP[rb + 1] = fast_exp2(PP[rb + 1] + LL[rb + 1] + r1); PP[rb] = fast_exp2(PP[rb] + LL[rb] + r0); }
            if (k == 0) {
#pragma unroll
                for (int r = 0; r < 16; ++r) { const int kv = crow(r, hi); if (kv >= qrel) p0[r] = 0.f; if (kv + 32 >= qrel) p1[r] = 0.f; }
            }
            R += T;
            const u32x4 pw0 = {pk_bf16(p0[0], p0[1]), pk_bf16(p0[2], p0[3]), pk_bf16(p0[4], p0[5]), pk_bf16(p0[6], p0[7])};
            const u32x4 pw1 = {pk_bf16(p0[8], p0[9]), pk_bf16(p0[10], p0[11]), pk_bf16(p0[12], p0[13]), pk_bf16(p0[14], p0[15])};
            const u32x4 pw2 = {pk_bf16(p1[0], p1[1]), pk_bf16(p1[2], p1[3]), pk_bf16(p1[4], p1[5]), pk_bf16(p1[6], p1[7])};
            const u32x4 pw3 = {pk_bf16(p1[8], p1[9]), pk_bf16(p1[10], p1[11]), pk_bf16(p1[12], p1[13]), pk_bf16(p1[14], p1[15])};
            const lcp vp = (lcp)shm + L_V + slot * VSLOT + ((lane >> 4) & 1) * 32 + (lane & 3) * 8 + (4 * hi + ((lane & 15) >> 2)) * 64;
            pv(o, vp, pw0, pw1, pw2, pw3);
            const int dn = __all(R < SB_EXIT) ? 1 : 0;
            if (lane == 0) flags[(k & 1) * 8 + wid] = dn;
        }
        slot = slot == 2 ? 0 : slot + 1;
    }
#undef SBA_DMA
    ATT_WAIT_BAR(0);
    float one[16];
#pragma unroll
    for (int r = 0; r < 16; ++r) one[r] = 1.0f;
    store_o(o, one, shm + L_OST + wid * 4096, O + (size_t)(rowbase + q0 + half * 32) * 1024 + h * 64, 1024, lane, r32, hi);
    asm volatile("s_waitcnt lgkmcnt(0)\n\ts_barrier" ::: "memory");
}
__device__ __forceinline__ void phase(int vcu, int G, const bf16_t* Q, const bf16_t* KT, const bf16_t* VT, bf16_t* O, LAS unsigned char* shm) {
    for (int u = vcu * 4; u < 1024; u += G * 4)
        for (int i = 0; i < 4; ++i) { const int uu = u + i, qb64 = uu & 127, bk = uu >> 7; unit(bk >> 2, bk & 3, qb64, Q, KT, VT, O, shm); }
}
}
}
namespace fw {
constexpr size_t MiB = 1u << 20;
constexpr int NWAVES = 8, NTHR = 512;
constexpr int MAXSLOT = 34816;
constexpr size_t WS_CTL = 0, CTL_ZERO_BYTES = 64 * 1024;
constexpr size_t WS_TOKE = 1 * MiB;
constexpr size_t WS_TOKG = WS_TOKE + 64 * 1024;
constexpr size_t WS_TOKRS = WS_TOKG + 128 * 1024;
constexpr size_t WS_SLOT12 = WS_TOKRS + 64 * 1024;
constexpr size_t WS_SLOTG = WS_SLOT12 + 128 * 1024;
constexpr size_t WS_SLOTRS = WS_SLOTG + 256 * 1024;
constexpr size_t WS_CNT = WS_SLOTRS + 256 * 1024;
constexpr size_t WS_PSTART = WS_CNT + 16 * 1024;
constexpr size_t WS_CS = 4 * MiB;
constexpr size_t WS_SSQ = 6 * MiB;
constexpr size_t WS_SSQQ = 8 * MiB;
constexpr size_t WS_SSQKV = WS_SSQQ + 512 * 1024;
constexpr size_t WS_KPE = 9 * MiB;
constexpr size_t WS_W = 16 * MiB;
constexpr size_t W_AIN = WS_W, W_QUP = W_AIN + 3 * MiB, W_KVUP = W_QUP + 2 * MiB, W_AOUT = W_KVUP + 1 * MiB, W_KVS = W_AOUT + 2 * MiB, W_QB = W_KVS + 1 * MiB,
                 W_OB = W_QB + 4 * MiB, W_PG = W_OB + 4 * MiB, W_PU = W_PG + 8 * MiB, W_FGU = W_PU + 2 * MiB, W_FDN = W_FGU + 22 * MiB, W_EGU = W_FDN + 11 * MiB,
                 W_EDN = W_EGU + 176 * MiB, W_END = W_EDN + 88 * MiB;
constexpr size_t WS_PB = W_END;
constexpr size_t WS_HB = WS_PB + 32 * MiB;
constexpr size_t WS_U = WS_HB + 64 * MiB;
constexpr size_t WS_SKT = WS_U + 128 * MiB, WS_SVT = WS_SKT + 8 * MiB;
constexpr size_t WS_X = WS_SVT + 8 * MiB;
constexpr size_t X_AQ = WS_X, X_AKV = X_AQ + 12 * MiB, X_QRAW = X_AKV + 8 * MiB, X_KVRAW = X_QRAW + 24 * MiB, X_Q = X_KVRAW + 32 * MiB, X_KT = X_Q + 24 * MiB, X_VT = X_KT + 24 * MiB, X_O = X_VT + 16 * MiB;
constexpr size_t X_SQ = WS_X, X_SO = X_SQ + 32 * MiB;
constexpr size_t X_HID = WS_X;
constexpr size_t X_XG = WS_X, X_HG = X_XG + 68 * MiB, X_YG = X_HG + 187 * MiB, X_END = X_YG + 68 * MiB;
constexpr size_t WS_END = X_END;
static_assert(X_O + 16 * MiB <= X_END && (size_t)MAXSLOT * 2816 * 2 <= 187 * MiB && (size_t)MAXSLOT * 1024 * 2 <= 68 * MiB, "ws map");
constexpr int CW_BAR = 1024;
constexpr int RING_OFF = 0, RING_BYTES = 131072, LDSCTL_OFF = RING_BYTES, MISC_OFF = LDSCTL_OFF + 320, LDS_BYTES = 147456;
static_assert(att::mla::L_END <= RING_BYTES && att::sba::L_END <= RING_BYTES, "attention LDS");
constexpr float QSCALE_MLA = 0.10206207261596577f * LOG2E;
constexpr float QSCALE_SB = 0.125f * LOG2E;

constexpr int PH_PER_LAYER = 12, PH_TOTAL = 2 + 4 * PH_PER_LAYER;
__host__ __device__ inline bool phase_active(int idx) {
    if (idx < 2) return true;
    const int l = (idx - 2) / PH_PER_LAYER, s = (idx - 2) % PH_PER_LAYER; const bool mla = l < 2, moe = (l & 1) != 0;
    if (s == 1 || s == 2) return mla;
    if (s >= 7 && s <= 9) return moe;
    if (s == 11) return l == 1;
    return true;
}

struct Args { const float* in[26]; float* out; unsigned char* ws; int ph_lo, ph_hi; };

struct Frame { LAS unsigned char* lds; int tid, lane, wave, vcu, G; };

__device__ __forceinline__ float wave_sum(float v) {
#pragma unroll
    for (int o = 1; o < 64; o <<= 1) v += __shfl_xor(v, o);
    return v;
}
__device__ __forceinline__ void transpose_item(const float* W, int ldw, int sca, int scb, const float* gain, bf16_t* WT, int K, int drow0, int k0, LAS float* scr, int lane) {
    const int r8 = lane >> 3, pc = lane & 7, c = lane & 7;
    f32x4 va[8], vb[8]; float g[8];
    const f32x4 z4 = {0.f, 0.f, 0.f, 0.f};
#pragma unroll
    for (int i = 0; i < 8; ++i) { const float* rp = W + (size_t)(k0 + i * 8 + r8) * ldw + 4 * pc;
        va[i] = sca >= 0 ? *(const f32x4*)(rp + sca) : z4; vb[i] = scb >= 0 ? *(const f32x4*)(rp + scb) : z4; g[i] = gain ? gain[k0 + i * 8 + r8] : 1.0f; }
#pragma unroll
    for (int hf = 0; hf < 2; ++hf) {
#pragma unroll
        for (int i = 0; i < 8; ++i) { const f32x4 v = (hf == 0 ? va[i] : vb[i]) * g[i]; LAS float* d = scr + (i * 8 + r8) * 33 + 4 * pc; d[0] = v[0]; d[1] = v[1]; d[2] = v[2]; d[3] = v[3]; }
        asm volatile("s_waitcnt lgkmcnt(0)" ::: "memory");
#pragma unroll
        for (int j = 0; j < 4; ++j) { const int n = (lane >> 3) + 8 * j; const LAS float* s = scr + (8 * c) * 33 + n;
            u32x4 o; o.x = pk_bf16(s[0 * 33], s[1 * 33]); o.y = pk_bf16(s[2 * 33], s[3 * 33]); o.z = pk_bf16(s[4 * 33], s[5 * 33]); o.w = pk_bf16(s[6 * 33], s[7 * 33]);
            *(u32x4*)(WT + (size_t)(drow0 + hf * 32 + n) * K + k0 + 8 * c) = o; }
        asm volatile("s_waitcnt lgkmcnt(0)" ::: "memory");
    }
}
struct Fam { int src, count, K, Nd, ldw, map, gain, gstride; size_t sstride, dst, dstride; };
__device__ __forceinline__ int fam_items(const Fam& f) { return f.count * (f.K / 64) * (f.Nd / 64); }
__device__ __forceinline__ int fam_src_col(int map, int n0) {
    if (map == 1) return n0 < 384 ? n0 : (n0 < 416 ? 640 + (n0 - 384) : (n0 < 512 ? -1 : 384 + (n0 - 512)));
    if (map == 2) { const int pn = n0 >> 8, jj = n0 & 255; return jj < 128 ? pn * 128 + jj : 2816 + pn * 128 + (jj - 128); }
    return n0;
}
__device__ __forceinline__ void fam_item(const Args& a, const Fam& f, int fid, int it, LAS float* scr, int lane) {
    const int per = (f.K / 64) * (f.Nd / 64), mi = it / per, r = it % per, nblk = f.Nd / 64, kb = r / nblk, nb = r % nblk, n0 = nb * 64;
    const float* gain = nullptr;
    if (f.gain >= 0) gain = a.in[f.gain] + (fid == 11 ? (size_t)(2 * (mi >> 3) + 1) * 1024 : (size_t)mi * f.gstride);
    transpose_item(a.in[f.src] + (size_t)mi * f.sstride, f.ldw, fam_src_col(f.map, n0), fam_src_col(f.map, n0 + 32), gain, (bf16_t*)(a.ws + f.dst + (size_t)mi * f.dstride), f.K, n0, kb * 64, scr, lane);
}
__constant__ const Fam FAMS[13] = {
        {4, 2, 1024, 768, 672, 1, 3, 1024, (size_t)1024 * 672, W_AIN, (size_t)768 * 1024 * 2},
        {7, 2, 384, 768, 768, 0, 5, 384, (size_t)384 * 768, W_QUP, (size_t)768 * 384 * 2},
        {8, 2, 256, 1024, 1024, 0, 6, 256, (size_t)256 * 1024, W_KVUP, (size_t)1024 * 256 * 2},
        {11, 2, 512, 1024, 1024, 0, -1, 0, (size_t)512 * 1024, W_AOUT, (size_t)1024 * 512 * 2},
        {13, 1, 1024, 512, 512, 0, 12, 0, 0, W_KVS, 0},
        {15, 2, 1024, 1024, 1024, 0, 14, 1024, (size_t)1024 * 1024, W_QB, (size_t)1024 * 1024 * 2},
        {16, 2, 1024, 1024, 1024, 0, -1, 0, (size_t)1024 * 1024, W_OB, (size_t)1024 * 1024 * 2},
        {24, 4, 1024, 1024, 1024, 0, 23, 1024, (size_t)1024 * 1024, W_PG, (size_t)1024 * 1024 * 2},
        {25, 4, 256, 1024, 1024, 0, -1, 0, (size_t)256 * 1024, W_PU, (size_t)1024 * 256 * 2},
        {18, 2, 1024, 5632, 5632, 2, 17, 2048, (size_t)1024 * 5632, W_FGU, (size_t)5632 * 1024 * 2},
        {19, 2, 2816, 1024, 1024, 0, -1, 0, (size_t)2816 * 1024, W_FDN, (size_t)1024 * 2816 * 2},
        {21, 16, 1024, 5632, 5632, 2, 17, 0, (size_t)1024 * 5632, W_EGU, (size_t)5632 * 1024 * 2},
        {22, 16, 2816, 1024, 1024, 0, -1, 0, (size_t)2816 * 1024, W_EDN, (size_t)1024 * 2816 * 2}};
__device__ __forceinline__ void prologue(const Args& a, Frame& F) {
    LAS float* scr = (LAS float*)(F.lds + RING_OFF + F.wave * 16384);
    const int gw = F.vcu * NWAVES + F.wave, NGW = F.G * NWAVES;
    int base = 0;
#pragma unroll 1
    for (int fid = 0; fid < 13; ++fid) { const Fam f = FAMS[fid]; const int n = fam_items(f);
        int it = gw - (base % NGW); if (it < 0) it += NGW;
#pragma unroll 1
        for (; it < n; it += NGW) fam_item(a, f, fid, it, scr, F.lane);
        base += n; }
    { const f32x4* src = (const f32x4*)a.in[1]; u32x2* dst = (u32x2*)(a.ws + WS_PB); const size_t n4 = (size_t)4 * MT * 256 / 4, S = (size_t)NGW * 64;
        for (size_t i = (size_t)gw * 64 + F.lane; i < n4; i += 4 * S) { f32x4 v[4];
#pragma unroll
            for (int q = 0; q < 4; ++q) v[q] = (i + q * S < n4) ? src[i + q * S] : (f32x4){0.f, 0.f, 0.f, 0.f};
#pragma unroll
            for (int q = 0; q < 4; ++q) if (i + q * S < n4) { u32x2 o; o.x = pk_bf16(v[q][0], v[q][1]); o.y = pk_bf16(v[q][2], v[q][3]); dst[i + q * S] = o; } } }
    { bf16_t* HB = (bf16_t*)(a.ws + WS_HB); float* SSQ = (float*)(a.ws + WS_SSQ);
        for (int row = gw; row < MT; row += NGW) { const f32x4* xr = (const f32x4*)(a.in[0] + (size_t)row * DMODEL) + F.lane; f32x4* hr = (f32x4*)(a.out + (size_t)row * DMODEL) + F.lane;
            u32x2* hb = (u32x2*)(HB + (size_t)row * DMODEL) + F.lane; float s = 0.f; f32x4 v4[4];
#pragma unroll
            for (int j = 0; j < 4; ++j) v4[j] = xr[64 * j];
#pragma unroll
            for (int j = 0; j < 4; ++j) { const f32x4 v = v4[j]; hr[64 * j] = v; u32x2 o; o.x = pk_bf16(v[0], v[1]); o.y = pk_bf16(v[2], v[3]); hb[64 * j] = o; s += (v[0] * v[0] + v[1] * v[1]) + (v[2] * v[2] + v[3] * v[3]); }
            s = wave_sum(s); if (F.lane < 16) SSQ[(size_t)row * 16 + F.lane] = F.lane == 0 ? s : 0.f; } }
    { float* cs = (float*)(a.ws + WS_CS); const int* pos = (const int*)a.in[2];
        for (int i = gw * 64 + F.lane; i < MT * 16; i += NGW * 64) { const int row = i >> 4, f = i & 15;
            const float invf = (float)exp(-9.210340371976184 * (double)f / 16.0);
            const double ang = (double)((float)pos[row] * invf);
            const double rev = ang * 0.15915494309189535, fr = rev - rint(rev); const float x = (float)(fr * 6.283185307179586);
            cs[(size_t)row * 32 + f] = cosf(x); cs[(size_t)row * 32 + 16 + f] = sinf(x); } }
}
__device__ __forceinline__ void norm_rope_8(f32x4& n0, f32x4& n1, f32x4& r0, f32x4& r1, const float* gain, const float* cs, int sub, float outscale) {
    float ss = pg8::sumsq8(n0, n1) + pg8::sumsq8(r0, r1);
    ss += __shfl_xor(ss, 1); ss += __shfl_xor(ss, 2); ss += __shfl_xor(ss, 4);
    const float rq = (1.0f / sqrtf(ss * (1.0f / 96.0f) + RMS_EPS));
    const f32x4 g0 = *(const f32x4*)(gain + 8 * sub), g1 = *(const f32x4*)(gain + 8 * sub + 4);
    n0 = n0 * g0 * (rq * outscale); n1 = n1 * g1 * (rq * outscale);
    const int s4 = sub & 3;
    const f32x4 h0 = *(const f32x4*)(gain + 64 + 8 * s4), h1 = *(const f32x4*)(gain + 64 + 8 * s4 + 4);
    r0 = r0 * h0 * (rq * outscale); r1 = r1 * h1 * (rq * outscale);
    f32x4 p0, p1;
#pragma unroll
    for (int j = 0; j < 4; ++j) { p0[j] = __shfl_xor(r0[j], 2); p1[j] = __shfl_xor(r1[j], 2); }
    const f32x4 c0 = *(const f32x4*)(cs + 8 * (sub & 1)), c1 = *(const f32x4*)(cs + 8 * (sub & 1) + 4), s0 = *(const f32x4*)(cs + 16 + 8 * (sub & 1)), s1 = *(const f32x4*)(cs + 16 + 8 * (sub & 1) + 4);
    if (s4 < 2) { r0 = r0 * c0 - p0 * s0; r1 = r1 * c1 - p1 * s1; }
    else { r0 = r0 * c0 + p0 * s0; r1 = r1 * c1 + p1 * s1; }
}
#define THIN_LAUNDER() Frame F = F_; unsigned char* wsl = a.ws; asm volatile("" : "+v"(F.tid), "+v"(F.lane), "+s"(F.wave), "+s"(F.vcu), "+s"(F.G), "+s"(wsl))
__device__ __forceinline__ void mla_prep(const Args& a, const Frame& F_, int layer) { THIN_LAUNDER();
    const bf16_t* QRAW = (const bf16_t*)(wsl + X_QRAW); const bf16_t* KVRAW = (const bf16_t*)(wsl + X_KVRAW); const float* KPE = (const float*)(wsl + WS_KPE);
    const float* CS = (const float*)(wsl + WS_CS); const float* gq = a.in[9] + layer * 96; const float* gk = a.in[10] + layer * 96;
    bf16_t* Q = (bf16_t*)(wsl + X_Q); bf16_t* KT = (bf16_t*)(wsl + X_KT); bf16_t* VT = (bf16_t*)(wsl + X_VT);
    const int gw = F.vcu * NWAVES + F.wave, NGW = F.G * NWAVES, h = F.lane >> 3, sub = F.lane & 7;
    const f32x4 z4 = {0.f, 0.f, 0.f, 0.f};
    for (int row = gw; row < MT; row += NGW) {
        const int b = row >> 13, sq = row & 8191, tile = sq >> 6, rr = sq & 63; const float* cs = CS + (size_t)row * 32;
        { const bf16_t* qrow = QRAW + (size_t)row * 768 + h * 96; f32x4 n0, n1, r0 = z4, r1 = z4;
            unpack8(*(const u32x4*)(qrow + 8 * sub), n0, n1); if (sub < 4) unpack8(*(const u32x4*)(qrow + 64 + 8 * sub), r0, r1);
            norm_rope_8(n0, n1, r0, r1, gq, cs, sub, QSCALE_MLA);
            bf16_t* qo = Q + (size_t)row * 768 + h * 96; *(u32x4*)(qo + 8 * sub) = pack8(n0, n1); if (sub < 4) *(u32x4*)(qo + 64 + 8 * sub) = pack8(r0, r1); }
        { const bf16_t* krow = KVRAW + (size_t)row * 1024 + h * 128; f32x4 n0, n1, r0 = z4, r1 = z4;
            unpack8(*(const u32x4*)(krow + 8 * sub), n0, n1); if (sub < 4) { r0 = *(const f32x4*)(KPE + (size_t)row * 32 + 8 * sub); r1 = *(const f32x4*)(KPE + (size_t)row * 32 + 8 * sub + 4); }
            norm_rope_8(n0, n1, r0, r1, gk, cs, sub, 1.0f);
            bf16_t* kt = KT + (size_t)((b * 8 + h) * 128 + tile) * 6144 + rr * 8; *(u32x4*)(kt + sub * 512) = pack8(n0, n1); if (sub < 4) *(u32x4*)(kt + (8 + sub) * 512) = pack8(r0, r1);
            const u32x4 v = *(const u32x4*)(krow + 64 + 8 * sub);
            *(u32x4*)(VT + (size_t)((b * 8 + h) * 128 + tile) * 4096 + (sub >> 2) * 2048 + rr * 32 + (sub & 3) * 8) = v; }
    }
}
__device__ __forceinline__ void moe_route(const Args& a, const Frame& F_, int layer) { THIN_LAUNDER();
    const float* H = a.out; const float* gain = a.in[17] + (size_t)layer * 1024; const float* wr = a.in[20] + (size_t)(layer >> 1) * 1024 * 8;
    int* TOKE = (int*)(wsl + WS_TOKE); float* TOKG = (float*)(wsl + WS_TOKG); float* TOKRS = (float*)(wsl + WS_TOKRS); int* CNT = (int*)(wsl + WS_CNT);
    LAS float* wg = (LAS float*)(F.lds + RING_OFF);
    LAS int* lcnt = (LAS int*)(F.lds + RING_OFF + 32768);
    for (int i = F.tid; i < 1024 * 8; i += NTHR) wg[i] = wr[i] * gain[i >> 3];
    for (int chunk = F.vcu; chunk < MT / 64; chunk += F.G) {
        if (F.tid < 8) lcnt[F.tid] = 0;
        __syncthreads();
        for (int tt = 0; tt < 8; ++tt) { const int tok = chunk * 64 + F.wave * 8 + tt;
            const f32x4* hr = (const f32x4*)(H + (size_t)tok * DMODEL) + F.lane; float lg[8], ss = 0.f;
#pragma unroll
            for (int e = 0; e < 8; ++e) lg[e] = 0.f;
#pragma unroll
            for (int j = 0; j < 4; ++j) { const f32x4 v = hr[64 * j]; ss += (v[0] * v[0] + v[1] * v[1]) + (v[2] * v[2] + v[3] * v[3]);
#pragma unroll
                for (int i = 0; i < 4; ++i) { const LAS f32x4* w = (const LAS f32x4*)(wg + (size_t)(256 * j + 4 * F.lane + i) * 8); const f32x4 w0 = w[0], w1 = w[1];
                    lg[0] += v[i] * w0[0]; lg[1] += v[i] * w0[1]; lg[2] += v[i] * w0[2]; lg[3] += v[i] * w0[3]; lg[4] += v[i] * w1[0]; lg[5] += v[i] * w1[1]; lg[6] += v[i] * w1[2]; lg[7] += v[i] * w1[3]; } }
            ss = wave_sum(ss);
#pragma unroll
            for (int e = 0; e < 8; ++e) lg[e] = wave_sum(lg[e]);
            const float r = 1.0f / sqrtf(ss * (1.0f / 1024.0f) + RMS_EPS);
            int e1 = 0; float v1 = lg[0];
#pragma unroll
            for (int e = 1; e < 8; ++e) if (lg[e] > v1) { v1 = lg[e]; e1 = e; }
            int e2 = 0; float v2 = -3.0e38f;
#pragma unroll
            for (int e = 0; e < 8; ++e) if (e != e1 && lg[e] > v2) { v2 = lg[e]; e2 = e; }
            const float p2 = __expf((v2 - v1) * r), g1 = 1.0f / (1.0f + p2), g2 = p2 / (1.0f + p2);
            if (F.lane == 0) { TOKE[tok] = e1 | (e2 << 8); TOKG[tok * 2] = g1; TOKG[tok * 2 + 1] = g2; TOKRS[tok] = r; __hip_atomic_fetch_add(lcnt + e1, 1, __ATOMIC_RELAXED, __HIP_MEMORY_SCOPE_WORKGROUP); __hip_atomic_fetch_add(lcnt + e2, 1, __ATOMIC_RELAXED, __HIP_MEMORY_SCOPE_WORKGROUP); }
        }
        __syncthreads();
        if (F.tid < 8) CNT[chunk * 8 + F.tid] = lcnt[F.tid];
        __syncthreads();
    }
}
__device__ __forceinline__ void moe_scatter(const Args& a, const Frame& F_, int cur) { THIN_LAUNDER();
    const int* TOKE = (const int*)(wsl + WS_TOKE); const float* TOKG = (const float*)(wsl + WS_TOKG); const float* TOKRS = (const float*)(wsl + WS_TOKRS); const int* CNT = (const int*)(wsl + WS_CNT);
    int* SLOT12 = (int*)(wsl + WS_SLOT12); float* SLOTG = (float*)(wsl + WS_SLOTG); float* SLOTRS = (float*)(wsl + WS_SLOTRS); int* PSTART = (int*)(wsl + WS_PSTART);
    const bf16_t* HB = (const bf16_t*)(wsl + WS_HB) + (size_t)cur * MT * DMODEL; bf16_t* XG = (bf16_t*)(wsl + X_XG);
    LAS int* sm = (LAS int*)(F.lds + RING_OFF);
    for (int chunk = F.vcu; chunk < MT / 64; chunk += F.G) {
        { const int e = F.wave; int c4[4]; int s = 0;
#pragma unroll
            for (int i = 0; i < 4; ++i) { c4[i] = CNT[(4 * F.lane + i) * 8 + e]; s += c4[i]; }
            int inc = s;
#pragma unroll
            for (int o = 1; o < 64; o <<= 1) { const int t = __shfl_up(inc, o); if (F.lane >= o) inc += t; }
            const int total = __shfl(inc, 63); int pre = inc - s;
            if (F.lane == (chunk >> 2)) { const int cm = chunk & 3; pre += (cm > 0 ? c4[0] : 0) + (cm > 1 ? c4[1] : 0) + (cm > 2 ? c4[2] : 0); sm[8 + e] = pre; }
            if (F.lane == 0) sm[e] = total; }
        __syncthreads();
        if (F.tid == 0) { int p = 0; for (int e = 0; e < 8; ++e) { sm[16 + e] = p; p += (sm[e] + 255) >> 8; } sm[24] = p; }
        __syncthreads();
        if (F.tid < 9) PSTART[F.tid] = sm[16 + F.tid];
        if (F.wave == 0) { const int tok = chunk * 64 + F.lane; const int ev = TOKE[tok], e1 = ev & 255, e2 = ev >> 8; int s1 = 0, s2 = 0;
            const unsigned long long below = (1ull << F.lane) - 1ull;
#pragma unroll
            for (int e = 0; e < 8; ++e) { const unsigned long long m1 = __ballot(e1 == e), m2 = __ballot(e2 == e);
                const int rank = __popcll(m1 & below) + __popcll(m2 & below), slot = sm[16 + e] * 256 + sm[8 + e] + rank;
                if (e1 == e) s1 = slot; if (e2 == e) s2 = slot; }
            SLOT12[tok * 2] = s1; SLOT12[tok * 2 + 1] = s2; const float r = TOKRS[tok];
            SLOTG[s1] = TOKG[tok * 2]; SLOTG[s2] = TOKG[tok * 2 + 1]; SLOTRS[s1] = r; SLOTRS[s2] = r;
            sm[32 + 2 * F.lane] = s1; sm[32 + 2 * F.lane + 1] = s2; }
        __syncthreads();
        for (int i = 0; i < 16; ++i) { const int pr = F.wave * 16 + i, tok = chunk * 64 + (pr >> 1), slot = sm[32 + pr];
            const u32x4* src = (const u32x4*)(HB + (size_t)tok * DMODEL) + F.lane; u32x4* dst = (u32x4*)(XG + (size_t)slot * DMODEL) + F.lane;
            dst[0] = src[0]; dst[64] = src[64]; }
        __syncthreads();
    }
}
__device__ __forceinline__ void moe_combine(const Args& a, const Frame& F_, int cur, bool dummy) { THIN_LAUNDER();
    const int* SLOT12 = (const int*)(wsl + WS_SLOT12); const bf16_t* YG = (const bf16_t*)(wsl + X_YG);
    bf16_t* HB = dummy ? (bf16_t*)(wsl + WS_END + 66 * MiB) : (bf16_t*)(wsl + WS_HB) + (size_t)cur * MT * DMODEL; float* SSQ = dummy ? (float*)(wsl + WS_END + 99 * MiB) : (float*)(wsl + WS_SSQ) + (size_t)cur * MT * 16;
    float* Hout = dummy ? (float*)(wsl + WS_END + 1 * MiB) : a.out;
    const int gw = F.vcu * NWAVES + F.wave, NGW = F.G * NWAVES;
    for (int row = gw; row < MT; row += NGW) { const int s1 = SLOT12[row * 2], s2 = SLOT12[row * 2 + 1];
        f32x4* hr = (f32x4*)(Hout + (size_t)row * DMODEL) + F.lane; u32x2* hb = (u32x2*)(HB + (size_t)row * DMODEL) + F.lane;
        const u32x2* y1 = (const u32x2*)(YG + (size_t)s1 * DMODEL) + F.lane; const u32x2* y2 = (const u32x2*)(YG + (size_t)s2 * DMODEL) + F.lane; float s = 0.f;
#pragma unroll
        for (int j = 0; j < 4; ++j) { f32x4 v = hr[64 * j]; const u32x2 p = y1[64 * j], q = y2[64 * j];
            v[0] += bf_lo(p.x) + bf_lo(q.x); v[1] += bf_hi(p.x) + bf_hi(q.x); v[2] += bf_lo(p.y) + bf_lo(q.y); v[3] += bf_hi(p.y) + bf_hi(q.y);
            hr[64 * j] = v; u32x2 o; o.x = pk_bf16(v[0], v[1]); o.y = pk_bf16(v[2], v[3]); hb[64 * j] = o; s += (v[0] * v[0] + v[1] * v[1]) + (v[2] * v[2] + v[3] * v[3]); }
        s = wave_sum(s); if (F.lane < 16) SSQ[(size_t)row * 16 + F.lane] = F.lane == 0 ? s : 0.f; }
}

__global__ void __launch_bounds__(NTHR, 2) yoco_fwd(Args args) {
    extern __shared__ __attribute__((aligned(16))) unsigned char lds_raw[];
    Frame F; F.lds = (LAS unsigned char*)lds_raw;
    volatile LAS unsigned* MISC = (volatile LAS unsigned*)(F.lds + MISC_OFF);
    F.tid = threadIdx.x; F.lane = F.tid & 63; F.wave = __builtin_amdgcn_readfirstlane(F.tid >> 6);
    F.G = gridDim.x; { const int bx = blockIdx.x; F.vcu = (F.G % 8 == 0) ? (bx % 8) * (F.G / 8) + bx / 8 : bx; }
    for (int u = F.tid; u < (LDS_BYTES - LDSCTL_OFF) / 4; u += NTHR) ((LAS unsigned*)(F.lds + LDSCTL_OFF))[u] = 0u;
    __syncthreads();
    unsigned char* ws = args.ws;
#define WS_LAUNDER() asm volatile("" : "+s"(ws), "+s"(bx), "+s"(F.G), "+s"(F.vcu))
    const bool single = (args.ph_hi - args.ph_lo) > 1;
    XcdBarrier bar; bar.bar = (unsigned*)(ws + WS_CTL) + CW_BAR; bar.x = 0; bar.st = nullptr;
    if (single) bar = xcd_barrier_post((unsigned*)(ws + WS_CTL) + CW_BAR, MISC + 8);
    const int lo = args.ph_lo, hi = args.ph_hi;
#ifndef EN_MASK
#define EN_MASK 0xFFFFFFFFu
#endif
#define EN(b) (((EN_MASK) >> (b)) & 1u)
#define IN(k) (lo <= (k) && (k) < hi)
#ifdef REP_MASK
#define NREPS(k) ((((unsigned long long)(REP_MASK) >> (k)) & 1ull) ? (REP_N) + 1 : 1)
#else
#define NREPS(k) 1
#endif
#define REPLOOP(k) for (int rep_ = 0, nrep_ = NREPS(k); rep_ < nrep_; ++rep_)
#define DUMMY (rep_ + 1 < nrep_)
#define OUT_H (DUMMY ? (float*)(ws + WS_END + 1 * MiB) : args.out)
#define OUT_HB(set) (DUMMY ? (bf16_t*)(ws + WS_END + 66 * MiB) : (bf16_t*)(ws + WS_HB) + (size_t)(set) * MT * DMODEL)
#define OUT_SSQ(set) (DUMMY ? (float*)(ws + WS_END + 99 * MiB) : (float*)(ws + WS_SSQ) + (size_t)(set) * MT * 16)
#define SEAM(k) do { if (single && (k) + 1 < hi) { XcdBarrier b_ = bar; asm volatile("" : "+s"(b_.bar), "+s"(b_.x)); xcd_barrier(b_); } } while (0)

    LAS unsigned char* ring = F.lds + RING_OFF;
    int bx = (int)blockIdx.x;

    if (EN(0) && IN(0)) REPLOOP(0) { prologue(args, F); SEAM(0); }
    if (EN(1) && IN(1)) REPLOOP(1) { WS_LAUNDER();
#pragma unroll 1
        for (int i = 0; i < 4; ++i) {
            pg8::Gemm g{(const bf16_t*)(ws + WS_PB) + (size_t)i * MT * 256, (const bf16_t*)(ws + W_PU) + (size_t)i * 1024 * 256, MT, 1024, 256};
            pg8::StaticOrder S; S.init(MT, 1024, F.G, bx);
            pg8::EpiScale E{(bf16_t*)(ws + WS_U) + (size_t)i * MT * DMODEL, 1024, pg8::RowScale{nullptr, 0}, 1.0f};
            pg8::gemm_phase<pg8::EpiScale, pg8::StaticOrder, true, true>(ring, g, S, E);
        }
        SEAM(1);
    }
#pragma unroll 1
    for (int l = 0; l < 4; ++l) {
        const int base = 2 + PH_PER_LAYER * l; const bool is_mla = l < 2, is_moe = (l & 1) != 0; const int cur = l & 1, j = l & 1;
#define HBc ((const bf16_t*)(ws + WS_HB) + (size_t)cur * MT * DMODEL)
#define HBw ((bf16_t*)(ws + WS_HB) + (size_t)cur * MT * DMODEL)
#define SSQc ((float*)(ws + WS_SSQ) + (size_t)cur * MT * 16)
        if (IN(base + 0)) REPLOOP(base + 0) { WS_LAUNDER();
            if (EN(2) && is_mla) {
                pg8::Gemm g{HBc, (const bf16_t*)(ws + W_AIN) + (size_t)l * 768 * 1024, MT, 768, 1024};
                pg8::StaticOrder S; S.init(MT, 768, F.G, bx);
                pg8::EpiAin E{(bf16_t*)(ws + X_AQ), (bf16_t*)(ws + X_AKV), (float*)(ws + WS_KPE), (float*)(ws + WS_SSQQ), (float*)(ws + WS_SSQKV), pg8::RowScale{SSQc, 1}};
                pg8::gemm_phase<pg8::EpiAin, pg8::StaticOrder, true, true>(ring, g, S, E);
            } else if (EN(3) && !is_mla) {
                pg8::Gemm g{HBc, (const bf16_t*)(ws + W_QB) + (size_t)j * 1024 * 1024, MT, 1024, 1024};
                pg8::StaticOrder S; S.init(MT, 1024, F.G, bx);
                pg8::EpiScale E{(bf16_t*)(ws + X_SQ), 1024, pg8::RowScale{SSQc, 1}, QSCALE_SB};
                pg8::gemm_phase<pg8::EpiScale, pg8::StaticOrder, true, true>(ring, g, S, E);
            }
            SEAM(base + 0);
        }
        if (EN(4) && is_mla && IN(base + 1)) REPLOOP(base + 1) { WS_LAUNDER();
            { pg8::Gemm g{(const bf16_t*)(ws + X_AQ), (const bf16_t*)(ws + W_QUP) + (size_t)l * 768 * 384, MT, 768, 384};
              pg8::StaticOrder S; S.init(MT, 768, F.G, bx);
              pg8::EpiScale E{(bf16_t*)(ws + X_QRAW), 768, pg8::RowScale{(const float*)(ws + WS_SSQQ), 3}, 1.0f};
              pg8::gemm_phase<pg8::EpiScale, pg8::StaticOrder, true, true>(ring, g, S, E); }
            { pg8::Gemm g{(const bf16_t*)(ws + X_AKV), (const bf16_t*)(ws + W_KVUP) + (size_t)l * 1024 * 256, MT, 1024, 256};
              pg8::StaticOrder S; S.init(MT, 1024, F.G, bx);
              pg8::EpiScale E{(bf16_t*)(ws + X_KVRAW), 1024, pg8::RowScale{(const float*)(ws + WS_SSQKV), 4}, 1.0f};
              pg8::gemm_phase<pg8::EpiScale, pg8::StaticOrder, true, true>(ring, g, S, E); }
            SEAM(base + 1);
        }
        if (EN(5) && is_mla && IN(base + 2)) REPLOOP(base + 2) { mla_prep(args, F, l); SEAM(base + 2); }
        if (IN(base + 3)) REPLOOP(base + 3) { WS_LAUNDER();
            if (EN(6) && is_mla) att::mla::phase(F.vcu, F.G, (const bf16_t*)(ws + X_Q), (const bf16_t*)(ws + X_KT), (const bf16_t*)(ws + X_VT), (bf16_t*)(ws + X_O), ring);
            else if (EN(7) && !is_mla) att::sba::phase(F.vcu, F.G, (const bf16_t*)(ws + X_SQ), (const bf16_t*)(ws + WS_SKT), (const bf16_t*)(ws + WS_SVT), (bf16_t*)(ws + X_SO), ring);
            SEAM(base + 3);
        }
        if (EN(8) && IN(base + 4)) REPLOOP(base + 4) { WS_LAUNDER();
            pg8::Gemm g = is_mla ? pg8::Gemm{(const bf16_t*)(ws + X_O), (const bf16_t*)(ws + W_AOUT) + (size_t)l * 1024 * 512, MT, 1024, 512}
                                 : pg8::Gemm{(const bf16_t*)(ws + X_SO), (const bf16_t*)(ws + W_OB) + (size_t)j * 1024 * 1024, MT, 1024, 1024};
            pg8::StaticOrder S; S.init(MT, 1024, F.G, bx);
            pg8::EpiRes<false> E{OUT_H, OUT_HB(cur), OUT_SSQ(cur), nullptr, pg8::RowScale{nullptr, 0}};
            pg8::gemm_phase<pg8::EpiRes<false>, pg8::StaticOrder, true, true>(ring, g, S, E);
            SEAM(base + 4);
        }
        if (!is_moe) {
            if (EN(9) && IN(base + 5)) REPLOOP(base + 5) { WS_LAUNDER();
                pg8::Gemm g{HBc, (const bf16_t*)(ws + W_FGU) + (size_t)(l >> 1) * 5632 * 1024, MT, 5632, 1024};
                pg8::GroupOrder S; S.init_dense(MT, 5632, F.G, bx);
                pg8::EpiSwiglu E{(bf16_t*)(ws + X_HID), pg8::RowScale{SSQc, 1}};
                pg8::gemm_phase<pg8::EpiSwiglu, pg8::GroupOrder, true, true>(ring, g, S, E);
                SEAM(base + 5);
            }
            if (EN(10) && IN(base + 6)) REPLOOP(base + 6) { WS_LAUNDER();
                pg8::Gemm g{(const bf16_t*)(ws + X_HID), (const bf16_t*)(ws + W_FDN) + (size_t)(l >> 1) * 1024 * 2816, MT, 1024, 2816};
                pg8::StaticOrder S; S.init(MT, 1024, F.G, bx);
                pg8::EpiRes<false> E{OUT_H, OUT_HB(cur), OUT_SSQ(cur), nullptr, pg8::RowScale{nullptr, 0}};
                pg8::gemm_phase<pg8::EpiRes<false>, pg8::StaticOrder, true, true>(ring, g, S, E);
                SEAM(base + 6);
            }
        } else {
            if (EN(11) && IN(base + 5)) REPLOOP(base + 5) { WS_LAUNDER(); moe_route(args, F, l); SEAM(base + 5); }
            if (EN(12) && IN(base + 6)) REPLOOP(base + 6) { WS_LAUNDER(); moe_scatter(args, F, cur); SEAM(base + 6); }
            if (EN(13) && IN(base + 7)) REPLOOP(base + 7) { WS_LAUNDER();
                pg8::Gemm g{(const bf16_t*)(ws + X_XG), (const bf16_t*)(ws + W_EGU) + (size_t)(l >> 1) * 8 * 5632 * 1024, MAXSLOT, 5632, 1024};
                pg8::GroupOrder S; S.init((const int*)(ws + WS_PSTART), 5632, F.G, bx, (size_t)5632 * 1024 * 2);
                pg8::EpiSwiglu E{(bf16_t*)(ws + X_HG), pg8::RowScale{(const float*)(ws + WS_SLOTRS), 2}};
                pg8::gemm_phase<pg8::EpiSwiglu, pg8::GroupOrder, true, true>(ring, g, S, E);
                SEAM(base + 7);
            }
            if (EN(14) && IN(base + 8)) REPLOOP(base + 8) { WS_LAUNDER();
                pg8::Gemm g{(const bf16_t*)(ws + X_HG), (const bf16_t*)(ws + W_EDN) + (size_t)(l >> 1) * 8 * 1024 * 2816, MAXSLOT, 1024, 2816};
                pg8::GroupOrder S; S.init((const int*)(ws + WS_PSTART), 1024, F.G, bx, (size_t)1024 * 2816 * 2);
                pg8::EpiScale E{(bf16_t*)(ws + X_YG), 1024, pg8::RowScale{(const float*)(ws + WS_SLOTG), 2}, 1.0f};
                pg8::gemm_phase<pg8::EpiScale, pg8::GroupOrder, true, true>(ring, g, S, E);
                SEAM(base + 8);
            }
            if (EN(15) && IN(base + 9)) REPLOOP(base + 9) { WS_LAUNDER(); moe_combine(args, F, cur, DUMMY); SEAM(base + 9); }
        }
        if (EN(16) && IN(base + 10)) REPLOOP(base + 10) { WS_LAUNDER();
            pg8::Gemm g{HBc, (const bf16_t*)(ws + W_PG) + (size_t)l * 1024 * 1024, MT, 1024, 1024};
            pg8::StaticOrder S; S.init(MT, 1024, F.G, bx);
            pg8::EpiRes<true> E{OUT_H, OUT_HB(cur ^ 1), OUT_SSQ(cur ^ 1),
                                (const bf16_t*)(ws + WS_U) + (size_t)l * MT * DMODEL, pg8::RowScale{SSQc, 1}};
            pg8::gemm_phase<pg8::EpiRes<true>, pg8::StaticOrder, true, true>(ring, g, S, E);
            SEAM(base + 10);
        }
        if (EN(17) && l == 1 && IN(base + 11)) REPLOOP(base + 11) { WS_LAUNDER();
            pg8::Gemm g{(const bf16_t*)(ws + WS_HB) + (size_t)(cur ^ 1) * MT * DMODEL, (const bf16_t*)(ws + W_KVS), MT, 512, 1024};
            pg8::StaticOrder S; S.init(MT, 512, F.G, bx);
            pg8::EpiKvs E{(bf16_t*)(ws + WS_SKT), (bf16_t*)(ws + WS_SVT), pg8::RowScale{(const float*)(ws + WS_SSQ) + (size_t)(cur ^ 1) * MT * 16, 1}};
            pg8::gemm_phase<pg8::EpiKvs, pg8::StaticOrder, true, true>(ring, g, S, E);
            SEAM(base + 11);
        }
    }
#undef IN
#undef SEAM
}
}
#define MULTI_LAUNCH 0
extern "C" void kernel_launch(void* const* d_in, const int* in_sizes, int n_in, void* d_out, int out_size, void* d_ws, size_t ws_size, hipStream_t stream) {
    using namespace fw;
    static int grid = 0;
    if (grid == 0) {
        if (n_in != 26 || out_size != MT * DMODEL || ws_size < WS_END) { fprintf(stderr, "kernel_launch: unexpected n_in %d / out %d / ws %zu\n", n_in, out_size, ws_size); grid = -1; return; }
        if (hipFuncSetAttribute((const void*)yoco_fwd, hipFuncAttributeMaxDynamicSharedMemorySize, LDS_BYTES) != hipSuccess) { fprintf(stderr, "kernel_launch: hipFuncSetAttribute failed\n"); grid = -1; return; }
        int dev = 0, cus = 0, per_cu = 0;
        (void)hipGetDevice(&dev); (void)hipDeviceGetAttribute(&cus, hipDeviceAttributeMultiprocessorCount, dev);
        (void)hipOccupancyMaxActiveBlocksPerMultiprocessor(&per_cu, (const void*)yoco_fwd, NTHR, LDS_BYTES);
        (void)hipGetLastError();
        grid = (cus > 0 && per_cu >= 1) ? cus : 256;
        if (grid > 256) grid = 256;
    }
    if (grid < 0) return;
    (void)hipMemsetAsync((unsigned char*)d_ws + WS_CTL, 0, CTL_ZERO_BYTES, stream);
    Args a{};
    for (int i = 0; i < 26; ++i) a.in[i] = (const float*)d_in[i];
    a.out = (float*)d_out; a.ws = (unsigned char*)d_ws;
#if MULTI_LAUNCH
    for (int k = 0; k < PH_TOTAL; ++k) { if (!phase_active(k)) continue; a.ph_lo = k; a.ph_hi = k + 1; hipLaunchKernelGGL(yoco_fwd, dim3(grid), dim3(NTHR), LDS_BYTES, stream, a); }
#else
#ifdef PROBE_MASK
    a.ph_lo = 0; a.ph_hi = PH_TOTAL;
#else
    a.ph_lo = 0; a.ph_hi = PH_TOTAL - 1;
#endif
    hipLaunchKernelGGL(yoco_fwd, dim3(grid), dim3(NTHR), LDS_BYTES, stream, a);
#endif
}
```

```cpp
#include <hip/hip_runtime.h>
#include <cstdio>
#include <cstdint>
#include <cmath>
#define LAS __attribute__((address_space(3)))
#define GAS __attribute__((address_space(1)))
typedef unsigned short bf16_t;
typedef short bf16x8 __attribute__((ext_vector_type(8)));
typedef float f32x4 __attribute__((ext_vector_type(4)));
typedef float f32x2 __attribute__((ext_vector_type(2)));
typedef float f32x16 __attribute__((ext_vector_type(16)));
typedef unsigned u32x4 __attribute__((ext_vector_type(4)));
typedef unsigned u32x2 __attribute__((ext_vector_type(2)));
typedef short s16x4 __attribute__((ext_vector_type(4)));
typedef __bf16 bf16x2_t __attribute__((ext_vector_type(2)));

constexpr int MT = 16384, DMODEL = 1024, SEQL = 8192;
constexpr float RMS_EPS = 1e-6f;
constexpr float LOG2E = 1.4426950408889634f;

__device__ __forceinline__ unsigned pk_bf16(float lo, float hi) { f32x2 v = {lo, hi}; bf16x2_t b = __builtin_convertvector(v, bf16x2_t); return __builtin_bit_cast(unsigned, b); }
__device__ __forceinline__ float bf_lo(unsigned w) { return __uint_as_float(w << 16); }
__device__ __forceinline__ float bf_hi(unsigned w) { return __uint_as_float(w & 0xffff0000u); }
__device__ __forceinline__ unsigned cvt_pk_bf16(float lo, float hi) { unsigned r; asm volatile("v_cvt_pk_bf16_f32 %0, %1, %2" : "=v"(r) : "v"(lo), "v"(hi)); return r; }
__device__ __forceinline__ u32x4 pack8(const f32x4 a, const f32x4 b) { u32x4 w; w.x = cvt_pk_bf16(a[0], a[1]); w.y = cvt_pk_bf16(a[2], a[3]); w.z = cvt_pk_bf16(b[0], b[1]); w.w = cvt_pk_bf16(b[2], b[3]); return w; }
__device__ __forceinline__ void unpack8(const u32x4 w, f32x4& a, f32x4& b) { a = (f32x4){bf_lo(w.x), bf_hi(w.x), bf_lo(w.y), bf_hi(w.y)}; b = (f32x4){bf_lo(w.z), bf_hi(w.z), bf_lo(w.w), bf_hi(w.w)}; }
__device__ __forceinline__ float fast_rcp(float x) { return __builtin_amdgcn_rcpf(x); }
__device__ __forceinline__ float fast_exp2(float x) { return __builtin_amdgcn_exp2f(x); }
__device__ __forceinline__ float fast_log2(float x) { return __builtin_amdgcn_logf(x); }
__device__ __forceinline__ float sigmoidf_(float x) { return fast_rcp(1.0f + fast_exp2(-x * LOG2E)); }

namespace pg8 {
constexpr int BM = 256, BK = 64, HALF = 128, HTB = HALF * BK * 2, STAGE_BYTES = 8 * HTB, NXCD = 8, WGM = 8;
__host__ __device__ __forceinline__ int lds_byte(int r, int c) { const int st = (r >> 4) * 2 + (c >> 5), rr = r & 15, cc = c & 31, ob = rr * 64 + cc * 2; return st * 1024 + (ob ^ (((ob >> 9) & 1) << 5)); }
__host__ __device__ __forceinline__ void stage_rc(int b, int& R, int& C) { const int st = b / 1024, sb = b % 1024, swz = sb ^ (((sb >> 9) & 1) << 5); R = (st >> 1) * 16 + swz / 64; C = (st & 1) * 32 + (swz % 64) / 2; }
__host__ __device__ __forceinline__ int perm32(int rho) { const int n = rho >> 4, i = rho & 15; return 8 * (i >> 2) + 4 * n + (i & 3); }

struct Unit { int pm, pn; size_t boff; };
struct Gemm { const bf16_t* A; const bf16_t* Bt; int M, N, K; };

struct StaticOrder {
    int nM, nN, nwg, G, c;
    __device__ void init(int M, int N, int G_, int c_) { nM = M / BM; nN = N / BM; nwg = nM * nN; G = G_; c = c_; }
    __device__ bool next(int i, Unit& u) const {
        const long L = (long)i * G + c; if (L >= nwg) return false;
        int wgid = (int)L; { const int q = nwg / NXCD, r = nwg % NXCD, xcd = wgid % NXCD, off = wgid / NXCD; wgid = (xcd < r ? xcd * (q + 1) : r * (q + 1) + (xcd - r) * q) + off; }
        const int nig = WGM * nN, gid = wgid / nig, fm = gid * WGM, gsz = (nM - fm) < WGM ? (nM - fm) : WGM;
        u.pm = fm + ((wgid % nig) % gsz); u.pn = (wgid % nig) / gsz; u.boff = 0; return true;
    }
};
struct GroupOrder {
    int ps[9]; int nN, nwg, G, c; size_t estride;
    __device__ void init(const int* pstart, int N, int G_, int c_, size_t estride_) {
#pragma unroll
        for (int e = 0; e < 9; ++e) ps[e] = __builtin_amdgcn_readfirstlane(pstart[e]);
        nN = N / BM; nwg = ps[8] * nN; G = G_; c = c_; estride = estride_; }
    __device__ void init_dense(int M, int N, int G_, int c_) {
        ps[0] = 0;
#pragma unroll
        for (int e = 1; e < 9; ++e) ps[e] = M / BM;
        nN = N / BM; nwg = ps[8] * nN; G = G_; c = c_; estride = 0; }
    __device__ bool next(int i, Unit& u) const {
        const long L = (long)i * G + c; if (L >= nwg) return false;
        int wgid = (int)L; { const int q = nwg / NXCD, r = nwg % NXCD, xcd = wgid % NXCD, off = wgid / NXCD; wgid = (xcd < r ? xcd * (q + 1) : r * (q + 1) + (xcd - r) * q) + off; }
        int e = 0;
#pragma unroll
        for (int k = 1; k < 8; ++k) if (wgid >= ps[k] * nN) e = k;
        int p0 = ps[0], p1 = ps[1];
#pragma unroll
        for (int k = 1; k < 8; ++k) if (e == k) { p0 = ps[k]; p1 = ps[k + 1]; }
        const int local = wgid - p0 * nN, np = p1 - p0;
        u.pn = local / np; u.pm = p0 + (local % np); u.boff = (size_t)e * estride; return true;
    }
};


__device__ __forceinline__ float sumsq8(const f32x4 a, const f32x4 b) { return ((a[0] * a[0] + a[1] * a[1]) + (a[2] * a[2] + a[3] * a[3])) + ((b[0] * b[0] + b[1] * b[1]) + (b[2] * b[2] + b[3] * b[3])); }
__device__ __forceinline__ float red_fq(float s) { s += __shfl_xor(s, 16); s += __shfl_xor(s, 32); return s; }
struct RowScale {
    const float* p; int mode;
    __device__ __forceinline__ float get(int row, int fq) const {
        if (mode == 0) return 1.0f;
        if (mode == 2) return p[row];
        if (mode == 1) { const f32x4 a = *(const f32x4*)(p + (size_t)row * 16 + 4 * fq); const float s = red_fq((a[0] + a[1]) + (a[2] + a[3])); return 1.0f / sqrtf(s * (1.0f / 1024.0f) + RMS_EPS); }
        if (mode == 3) { const f32x4 a = *(const f32x4*)(p + (size_t)row * 8 + 4 * (fq & 1)); const float s = red_fq(fq < 2 ? (a[0] + a[1]) + (a[2] + a[3]) : 0.f); return 1.0f / sqrtf(s * (1.0f / 384.0f) + RMS_EPS); }
        { const float s = red_fq(p[(size_t)row * 4 + fq]); return 1.0f / sqrtf(s * (1.0f / 256.0f) + RMS_EPS); }
    }
    __device__ __forceinline__ void get8(float (&rsv)[2][4], int row0, int fq) const {
#pragma unroll
        for (int ai = 0; ai < 2; ++ai)
#pragma unroll
            for (int m = 0; m < 4; ++m) rsv[ai][m] = get(row0 + ai * 128 + m * 16, fq);
        asm volatile("" ::: "memory");
    }
};

struct EpiScale {
    static constexpr bool PERM = true, AFTER_DRAIN = false;
    bf16_t* O; int ldc; RowScale rs; float cs;
    __device__ __forceinline__ void operator()(const f32x4 (&acc)[2][2][4][2], const Unit& u, int wr, int wc, int fr, int fq) const {
        const int row0 = u.pm * BM + wr * 64 + fr, col0 = u.pn * BM + wc * 32 + 8 * fq;
        float rsv[2][4]; rs.get8(rsv, row0, fq);
#pragma unroll
        for (int ai = 0; ai < 2; ++ai)
#pragma unroll
            for (int m = 0; m < 4; ++m) { const int row = row0 + ai * HALF + m * 16; const float s = rsv[ai][m] * cs; bf16_t* rowp = O + (size_t)row * ldc + col0;
#pragma unroll
                for (int bj = 0; bj < 2; ++bj) *(u32x4*)(rowp + bj * HALF) = pack8(acc[ai][bj][m][0] * s, acc[ai][bj][m][1] * s); }
    }
};
struct EpiAin {
    static constexpr bool PERM = true, AFTER_DRAIN = false;
    bf16_t* AQ; bf16_t* AKV; float* KPE; float* SSQQ; float* SSQKV; RowScale rs;
    __device__ __forceinline__ void operator()(const f32x4 (&acc)[2][2][4][2], const Unit& u, int wr, int wc, int fr, int fq) const {
        const int row0 = u.pm * BM + wr * 64 + fr, c8 = wc * 32 + 8 * fq;
        float rsv[2][4]; rs.get8(rsv, row0, fq);
#pragma unroll
        for (int ai = 0; ai < 2; ++ai)
#pragma unroll
            for (int m = 0; m < 4; ++m) { const int row = row0 + ai * HALF + m * 16; const float s = rsv[ai][m];
                const f32x4 a0 = acc[ai][0][m][0] * s, a1 = acc[ai][0][m][1] * s, b0 = acc[ai][1][m][0] * s, b1 = acc[ai][1][m][1] * s;
                if (u.pn == 0) {
                    *(u32x4*)(AQ + (size_t)row * 384 + c8) = pack8(a0, a1); *(u32x4*)(AQ + (size_t)row * 384 + 128 + c8) = pack8(b0, b1);
                    const float q = red_fq(sumsq8(a0, a1) + sumsq8(b0, b1)); if (fq == 0) SSQQ[(size_t)row * 8 + wc] = q;
                } else if (u.pn == 1) {
                    *(u32x4*)(AQ + (size_t)row * 384 + 256 + c8) = pack8(a0, a1);
                    const float q = red_fq(sumsq8(a0, a1)); if (fq == 0) SSQQ[(size_t)row * 8 + 4 + wc] = q;
                    if (wc == 0) { *(f32x4*)(KPE + (size_t)row * 32 + 8 * fq) = b0; *(f32x4*)(KPE + (size_t)row * 32 + 8 * fq + 4) = b1; }
                } else {
                    *(u32x4*)(AKV + (size_t)row * 256 + c8) = pack8(a0, a1); *(u32x4*)(AKV + (size_t)row * 256 + 128 + c8) = pack8(b0, b1);
                    const float q = red_fq(sumsq8(a0, a1) + sumsq8(b0, b1)); if (fq == 0) SSQKV[(size_t)row * 4 + wc] = q;
                } }
    }
};
struct EpiSwiglu {
    static constexpr bool PERM = true, AFTER_DRAIN = false;
    bf16_t* HID; RowScale rs;
    __device__ __forceinline__ void operator()(const f32x4 (&acc)[2][2][4][2], const Unit& u, int wr, int wc, int fr, int fq) const {
        const int row0 = u.pm * BM + wr * 64 + fr, col0 = u.pn * 128 + wc * 32 + 8 * fq;
        float rsv[2][4]; rs.get8(rsv, row0, fq);
#pragma unroll
        for (int ai = 0; ai < 2; ++ai)
#pragma unroll
            for (int m = 0; m < 4; ++m) { const int row = row0 + ai * HALF + m * 16; const float s = rsv[ai][m];
                f32x4 o[2];
#pragma unroll
                for (int n = 0; n < 2; ++n) { const f32x4 g = acc[ai][0][m][n] * s, up = acc[ai][1][m][n] * s;
#pragma unroll
                    for (int j = 0; j < 4; ++j) o[n][j] = g[j] * sigmoidf_(g[j]) * up[j]; }
                *(u32x4*)(HID + (size_t)row * 2816 + col0) = pack8(o[0], o[1]); }
    }
};
template <bool GATED> struct EpiRes {
    static constexpr bool PERM = true, AFTER_DRAIN = false;
    const bf16_t* HBi; bf16_t* HBo; float* SSQo; const bf16_t* U; RowScale rs; float* OUTF;
    __device__ __forceinline__ void operator()(const f32x4 (&acc)[2][2][4][2], const Unit& u, int wr, int wc, int fr, int fq) const {
        const int row0 = u.pm * BM + wr * 64 + fr, col0 = u.pn * BM + wc * 32 + 8 * fq;
        float rsv[2][4]; if (GATED) rs.get8(rsv, row0, fq);
#pragma unroll
        for (int ai = 0; ai < 2; ++ai)
#pragma unroll
            for (int m = 0; m < 4; ++m) { const int row = row0 + ai * HALF + m * 16; const size_t off = (size_t)row * DMODEL + col0;
                float s = 1.0f; if (GATED) s = rsv[ai][m];
                float q = 0.f;
#pragma unroll
                for (int bj = 0; bj < 2; ++bj) { f32x4 a0 = acc[ai][bj][m][0], a1 = acc[ai][bj][m][1];
                    f32x4 h0, h1; unpack8(*(const u32x4*)(HBi + off + bj * HALF), h0, h1);
                    if (GATED) { f32x4 u0, u1; unpack8(*(const u32x4*)(U + off + bj * HALF), u0, u1);
#pragma unroll
                        for (int j = 0; j < 4; ++j) { a0[j] = sigmoidf_(a0[j] * s) * u0[j]; a1[j] = sigmoidf_(a1[j] * s) * u1[j]; } }
                    h0 += a0; h1 += a1;
                    if (GATED) { if (OUTF) { *(f32x4*)(OUTF + off + bj * HALF) = h0; *(f32x4*)(OUTF + off + bj * HALF + 4) = h1; } }
                    *(u32x4*)(HBo + off + bj * HALF) = pack8(h0, h1);
                    q += sumsq8(h0, h1); }
                q = red_fq(q); if (fq == 0) SSQo[(size_t)row * 16 + u.pn * 4 + wc] = q;
                asm volatile("" ::: "memory"); }
    }
};
struct EpiKvs {
    static constexpr bool PERM = true, AFTER_DRAIN = false;
    bf16_t* KT; bf16_t* VT; RowScale rs;
    __device__ __forceinline__ void operator()(const f32x4 (&acc)[2][2][4][2], const Unit& u, int wr, int wc, int fr, int fq) const {
        const int row0 = u.pm * BM + wr * 64 + fr;
        float rsv[2][4]; rs.get8(rsv, row0, fq);
#pragma unroll
        for (int ai = 0; ai < 2; ++ai)
#pragma unroll
            for (int m = 0; m < 4; ++m) { const int row = row0 + ai * HALF + m * 16; const float s = rsv[ai][m];
                const int b = row >> 13, sq = row & 8191, tile = sq >> 6, rr = sq & 63;
#pragma unroll
                for (int bj = 0; bj < 2; ++bj) { const int c = bj * HALF + wc * 32 + 8 * fq, kh = c >> 6, d = c & 63;
                    const size_t tb = (size_t)((b * 4 + kh) * 128 + tile) * 4096;
                    const u32x4 w = pack8(acc[ai][bj][m][0] * s, acc[ai][bj][m][1] * s);
                    if (u.pn == 0) *(u32x4*)(KT + tb + (d >> 3) * 512 + rr * 8) = w;
                    else *(u32x4*)(VT + tb + (d >> 5) * 2048 + rr * 32 + (d & 31)) = w; } }
    }
};

#define PG8_LAS LAS
template <class Epi, class Sched, bool ALIGN_EPI = false, bool SP2 = false>
__device__ __forceinline__ void gemm_phase(PG8_LAS unsigned char* lds, const Gemm g, const Sched& S, const Epi& E) {
    int tid_ = threadIdx.x; asm volatile("" : "+v"(tid_));
    const int tid = tid_, wid = __builtin_amdgcn_readfirstlane(tid >> 6), lane = tid & 63, wr = wid >> 2, wc = wid & 3, fr = lane & 15, fq = lane >> 4;
    const int K = g.K, nt = K / BK;
    unsigned voffA[2], voffB[2];
#pragma unroll
    for (int i = 0; i < 2; ++i) { int R, C; stage_rc(tid * 16 + i * 8192, R, C); const int Rb = Epi::PERM ? ((R & ~31) + perm32(R & 31)) : R;
        voffA[i] = (unsigned)(R * K + C) * 2u; voffB[i] = (unsigned)(Rb * K + C) * 2u; }
    const size_t kstep = (size_t)(BK * 2);
    const size_t hstep = (size_t)HALF * K * 2;
    const size_t tstep = 2 * hstep;
    const unsigned ldsw = (unsigned)wid * 1024u;
    const int aoff = lds_byte(wr * 64 + fr, fq * 8), boff = lds_byte(wc * 32 + fr, fq * 8);
#define PG8_SA(b, h) (((b) * 2 + (h)) * HTB)
#define PG8_SB(b, h) ((4 + (b) * 2 + (h)) * HTB)
#define PG8_STAGE(bufoff, gbase, voff) do { _Pragma("unroll") for (int _i = 0; _i < 2; ++_i) \
        __builtin_amdgcn_global_load_lds((const unsigned*)((const char*)(gbase) + (voff)[_i]), (PG8_LAS unsigned*)(lds + (bufoff) + ldsw + _i * 8192), 16, 0, 0); } while (0)
#define PG8_LDA(dst, b, h) do { _Pragma("unroll") for (int m = 0; m < 4; ++m) _Pragma("unroll") for (int k = 0; k < 2; ++k) dst[m][k] = *(const PG8_LAS bf16x8*)(lds + PG8_SA(b, h) + aoff + m * 2048 + k * 1024); } while (0)
#define PG8_LDB(dst, b, h) do { _Pragma("unroll") for (int n = 0; n < 2; ++n) _Pragma("unroll") for (int k = 0; k < 2; ++k) dst[n][k] = *(const PG8_LAS bf16x8*)(lds + PG8_SB(b, h) + boff + n * 2048 + k * 1024); } while (0)
#define PG8_MMA(ai, bj, At, Bt) do { __builtin_amdgcn_s_setprio(1); _Pragma("unroll") for (int m = 0; m < 4; ++m) _Pragma("unroll") for (int n = 0; n < 2; ++n) _Pragma("unroll") for (int k = 0; k < 2; ++k) \
        acc[ai][bj][m][n] = __builtin_amdgcn_mfma_f32_16x16x32_bf16(Bt[n][k], At[m][k], acc[ai][bj][m][n], 0, 0, 0); __builtin_amdgcn_s_setprio(0); } while (0)
#define PG8_WAIT_V(n) asm volatile("s_waitcnt vmcnt(" #n ")" ::: "memory")
#define PG8_WAIT_L(n) asm volatile("s_waitcnt lgkmcnt(" #n ")" ::: "memory")
#define PG8_BAR __builtin_amdgcn_s_barrier()
#define PG8_SCHED __builtin_amdgcn_sched_barrier(0)
    Unit cur, nxt; int ui = 0;
    if (!S.next(0, cur)) return;
    f32x4 acc[2][2][4][2];
#pragma unroll
    for (int a = 0; a < 2; ++a)
#pragma unroll
        for (int b = 0; b < 2; ++b)
#pragma unroll
            for (int m = 0; m < 4; ++m)
#pragma unroll
                for (int n = 0; n < 2; ++n) acc[a][b][m][n] = (f32x4){0.f, 0.f, 0.f, 0.f};
    bf16x8 At[4][2], B0[2][2], B1[2][2];
    const char* cA = (const char*)g.A + (size_t)cur.pm * tstep; const char* cB = (const char*)g.Bt + cur.boff + (size_t)cur.pn * tstep;
    if constexpr (SP2) {
        PG8_STAGE(PG8_SB(0, 0), cB, voffB); PG8_STAGE(PG8_SB(0, 1), cB + hstep, voffB); PG8_STAGE(PG8_SA(0, 0), cA, voffA); PG8_STAGE(PG8_SA(0, 1), cA + hstep, voffA);
        if (wr == 1) PG8_BAR;
        PG8_WAIT_V(2); PG8_BAR;
        PG8_STAGE(PG8_SB(1, 0), cB + kstep, voffB); PG8_STAGE(PG8_SA(1, 0), cA + kstep, voffA); PG8_STAGE(PG8_SB(1, 1), cB + hstep + kstep, voffB);
        PG8_WAIT_V(6); PG8_BAR;
    } else {
        PG8_STAGE(PG8_SB(0, 0), cB, voffB); PG8_STAGE(PG8_SA(0, 0), cA, voffA); PG8_STAGE(PG8_SB(0, 1), cB + hstep, voffB); PG8_STAGE(PG8_SA(0, 1), cA + hstep, voffA);
        if (wr == 1) PG8_BAR;
        PG8_WAIT_V(4); PG8_BAR;
        PG8_STAGE(PG8_SB(1, 0), cB + kstep, voffB); PG8_STAGE(PG8_SA(1, 0), cA + kstep, voffA); PG8_STAGE(PG8_SB(1, 1), cB + hstep + kstep, voffB);
        PG8_WAIT_V(6); PG8_BAR;
    }
    for (;;) {
        const bool has_next = S.next(ui + 1, nxt);
        const char* nA = has_next ? (const char*)g.A + (size_t)nxt.pm * tstep : cA; const char* nB = has_next ? (const char*)g.Bt + nxt.boff + (size_t)nxt.pn * tstep : cB;
        for (int t = 0; t < nt; t += 2) {
            const bool last = (t == nt - 2);
            const char* a1 = cA + (size_t)(t + 1) * kstep;
            const char* a2 = last ? nA : cA + (size_t)(t + 2) * kstep; const char* b2 = last ? nB : cB + (size_t)(t + 2) * kstep;
            const char* a3 = a2 + kstep; const char* b3 = b2 + kstep;
            if constexpr (SP2) {
            PG8_LDB(B0, 0, 0); PG8_LDB(B1, 0, 1); PG8_SCHED; PG8_LDA(At, 0, 0); PG8_STAGE(PG8_SA(1, 1), a1 + hstep, voffA);
            PG8_WAIT_V(8); PG8_WAIT_L(0); PG8_BAR; PG8_MMA(0, 0, At, B0); PG8_MMA(0, 1, At, B1); PG8_BAR; PG8_SCHED;
            PG8_LDA(At, 0, 1); PG8_STAGE(PG8_SB(0, 0), b2, voffB); PG8_STAGE(PG8_SB(0, 1), b2 + hstep, voffB); PG8_STAGE(PG8_SA(0, 0), a2, voffA);
            PG8_WAIT_V(8); PG8_WAIT_L(0); PG8_BAR; PG8_MMA(1, 0, At, B0); PG8_MMA(1, 1, At, B1); PG8_BAR; PG8_SCHED;
            PG8_LDB(B0, 1, 0); PG8_LDB(B1, 1, 1); PG8_SCHED; PG8_LDA(At, 1, 0); PG8_STAGE(PG8_SA(0, 1), a2 + hstep, voffA);
            PG8_WAIT_V(8); PG8_WAIT_L(0); PG8_BAR; PG8_MMA(0, 0, At, B0); PG8_MMA(0, 1, At, B1); PG8_BAR; PG8_SCHED;
            PG8_LDA(At, 1, 1); PG8_STAGE(PG8_SB(1, 0), b3, voffB); PG8_STAGE(PG8_SB(1, 1), b3 + hstep, voffB); PG8_STAGE(PG8_SA(1, 0), a3, voffA);
            PG8_WAIT_V(8); PG8_WAIT_L(0); PG8_BAR; PG8_MMA(1, 0, At, B0); PG8_MMA(1, 1, At, B1); PG8_BAR; PG8_SCHED;
            } else {
            PG8_LDB(B0, 0, 0); PG8_SCHED; PG8_LDA(At, 0, 0); PG8_STAGE(PG8_SA(1, 1), a1 + hstep, voffA);
            PG8_WAIT_L(8); PG8_BAR; PG8_WAIT_L(0); PG8_MMA(0, 0, At, B0); PG8_BAR; PG8_SCHED;
            PG8_LDB(B1, 0, 1); PG8_STAGE(PG8_SB(0, 0), b2, voffB);
            PG8_BAR; PG8_WAIT_L(0); PG8_MMA(0, 1, At, B1); PG8_BAR;
            PG8_LDA(At, 0, 1); PG8_STAGE(PG8_SA(0, 0), a2, voffA);
            PG8_BAR; PG8_WAIT_L(0); PG8_MMA(1, 0, At, B0); PG8_BAR; PG8_SCHED;
            PG8_STAGE(PG8_SB(0, 1), b2 + hstep, voffB);
            PG8_WAIT_V(6); PG8_BAR; PG8_MMA(1, 1, At, B1); PG8_BAR;
            PG8_LDB(B0, 1, 0); PG8_SCHED; PG8_LDA(At, 1, 0); PG8_STAGE(PG8_SA(0, 1), a2 + hstep, voffA);
            PG8_WAIT_L(8); PG8_BAR; PG8_WAIT_L(0); PG8_MMA(0, 0, At, B0); PG8_BAR; PG8_SCHED;
            PG8_LDB(B1, 1, 1); PG8_STAGE(PG8_SB(1, 0), b3, voffB);
            PG8_BAR; PG8_WAIT_L(0); PG8_MMA(0, 1, At, B1); PG8_BAR;
            PG8_LDA(At, 1, 1); PG8_STAGE(PG8_SA(1, 0), a3, voffA);
            PG8_BAR; PG8_WAIT_L(0); PG8_MMA(1, 0, At, B0); PG8_BAR; PG8_SCHED;
            PG8_STAGE(PG8_SB(1, 1), b3 + hstep, voffB);
            PG8_WAIT_V(6); PG8_BAR; PG8_MMA(1, 1, At, B1); PG8_BAR;
            }
        }
        if constexpr (ALIGN_EPI) { if (wr == 0) PG8_BAR; }
        E(acc, cur, wr, wc, fr, fq);
        if (!has_next) break;
#pragma unroll
        for (int a = 0; a < 2; ++a)
#pragma unroll
            for (int b = 0; b < 2; ++b)
#pragma unroll
                for (int m = 0; m < 4; ++m)
#pragma unroll
                    for (int n = 0; n < 2; ++n) acc[a][b][m][n] = (f32x4){0.f, 0.f, 0.f, 0.f};
        cur = nxt; cA = nA; cB = nB; ++ui;
        if constexpr (ALIGN_EPI) { if (wr == 1) PG8_BAR; }
    }
    PG8_WAIT_V(0);
    if constexpr (!ALIGN_EPI) { if (wr == 0) PG8_BAR; }
    PG8_BAR;
#undef PG8_SA
#undef PG8_SB
#undef PG8_STAGE
#undef PG8_LDA
#undef PG8_LDB
#undef PG8_MMA
#undef PG8_WAIT_V
#undef PG8_WAIT_L
#undef PG8_BAR
#undef PG8_SCHED
}
}
typedef GAS unsigned gu32;
#define RLX_AGENT __ATOMIC_RELAXED, __HIP_MEMORY_SCOPE_AGENT
#define XB_TMO      128
#define XB_XCNT(j)  (256  + 64 * (j))
#define XB_XSUB(j)  (1280 + 64 * (j))
#define XB_XGEN(j)  (2304 + 64 * (j))
#define XB_TOP      3328
#define XB_TOPGEN   3392
#define XCD_BAR_WORDS 3456
#define XB_SPIN_CAP (1u << 18)

__device__ __forceinline__ unsigned xb_ld(unsigned* p)              { return __hip_atomic_load(p, __ATOMIC_RELAXED, __HIP_MEMORY_SCOPE_AGENT); }
__device__ __forceinline__ unsigned xb_add(unsigned* p, unsigned v) { return __hip_atomic_fetch_add(p, v, __ATOMIC_RELAXED, __HIP_MEMORY_SCOPE_AGENT); }
__device__ __forceinline__ unsigned xb_xcc_id() { return (unsigned)__builtin_amdgcn_s_getreg((3 << 11) | 20) & 0xFu; }
#define XB_SPIN(cond, bar) do { unsigned _sp = 0; while (cond) { __builtin_amdgcn_s_sleep(1); \
    if ((++_sp & 255u) == 0u) { if (xb_ld(&(bar)[XB_TMO])) break; if (_sp > XB_SPIN_CAP) { atomicAdd(&(bar)[XB_TMO], 1u); break; } } } } while (0)

struct XcdBarrier {
    unsigned* bar; unsigned x;
    volatile LAS unsigned* st;
};
__device__ __forceinline__ XcdBarrier xcd_barrier_post(unsigned* bar, volatile LAS unsigned* st) {
    XcdBarrier b; b.bar = bar; b.x = xb_xcc_id(); b.st = st;
    if (threadIdx.x == 0) (void)xb_add(&bar[XB_XCNT(b.x)], 1u);
    return b;
}
__device__ __forceinline__ void xcd_barrier_complete(unsigned* bar, unsigned x, unsigned& nloc, unsigned& nx) {
    const unsigned G = gridDim.x * gridDim.y * gridDim.z;
    unsigned sum, cnt, mine, sp = 0u;
    for (;;) {
        sum = 0u; cnt = 0u; mine = 0u;
#pragma unroll
        for (unsigned j = 0; j < 16; ++j) { const unsigned c = xb_ld(&bar[XB_XCNT(j)]); sum += c; cnt += (c > 0u) ? 1u : 0u; mine = (j == x) ? c : mine; }
        if (sum == G) break;
        __builtin_amdgcn_s_sleep(1);
        if ((++sp & 255u) == 0u) { if (xb_ld(&bar[XB_TMO])) break; if (sp > XB_SPIN_CAP) { atomicAdd(&bar[XB_TMO], 1u); break; } }
    }
    nloc = mine > 0u ? mine : 1u; nx = cnt > 0u ? cnt : 1u;
}
__device__ __forceinline__ void xcd_barrier(const XcdBarrier& b) {
    asm volatile("s_waitcnt vmcnt(0)" ::: "memory");
    __syncthreads();
    if (threadIdx.x == 0) {
        unsigned* bar = b.bar;
        __builtin_amdgcn_s_waitcnt(0);
        unsigned nloc = b.st[0], nx = b.st[1];
        if (nloc == 0u) { xcd_barrier_complete(bar, b.x, nloc, nx); b.st[0] = nloc; b.st[1] = nx; }
        const unsigned old = xb_add(&bar[XB_XSUB(b.x)], 1u);
        const unsigned gen = old / nloc;
        if (old + 1u == (gen + 1u) * nloc) {
            __builtin_amdgcn_fence(__ATOMIC_RELEASE, "agent");
            asm volatile("s_waitcnt vmcnt(0)" ::: "memory");
            const unsigned og = xb_add(&bar[XB_TOP], 1u);
            const unsigned tg = og / nx;
            if (og + 1u == (tg + 1u) * nx) xb_add(&bar[XB_TOPGEN], 1u);
            else XB_SPIN(xb_ld(&bar[XB_TOPGEN]) == tg, bar);
            __builtin_amdgcn_fence(__ATOMIC_ACQUIRE, "agent");
            xb_add(&bar[XB_XGEN(b.x)], 1u);
            asm volatile("s_waitcnt vmcnt(0)" ::: "memory");
        } else {
            XB_SPIN(xb_ld(&bar[XB_XGEN(b.x)]) == gen, bar);
            __builtin_amdgcn_fence(__ATOMIC_ACQUIRE, "agent");
            asm volatile("s_waitcnt vmcnt(0)" ::: "memory");
        }
    }
    __syncthreads();
}

namespace att {
__device__ __forceinline__ int crow(int r, int hi) { return (r & 3) + 8 * (r >> 2) + 4 * hi; }
__device__ __forceinline__ void glds16(const void* gsrc, unsigned lds_dst) { unsigned keep;
    asm volatile("s_mov_b32 %0, m0\n\ts_mov_b32 m0, %2\n\ts_nop 0\n\tglobal_load_lds_dwordx4 %1, off\n\ts_mov_b32 m0, %0" : "=&s"(keep) : "v"(gsrc), "s"(lds_dst) : "memory"); }
#define ATT_WAIT_BAR(N) asm volatile("s_waitcnt vmcnt(" #N ") lgkmcnt(0)\n\ts_barrier" ::: "memory")
#define ATT_MX3(a, b, c) __builtin_fmaxf(__builtin_fmaxf((a), (b)), (c))
typedef LAS const unsigned char* lcp;
typedef short v4i16_t __attribute__((ext_vector_type(4)));
__device__ __forceinline__ s16x4 vtr(lcp p) { return __builtin_bit_cast(s16x4, __builtin_amdgcn_ds_read_tr16_b64_v4i16((LAS v4i16_t*)p)); }
__device__ __forceinline__ float rowmax(const f32x16& p0, const f32x16& p1) {
    float a = ATT_MX3(p0[0], p0[1], p1[0]), b = ATT_MX3(p0[2], p0[3], p1[1]); a = ATT_MX3(a, p1[2], p1[3]);
#pragma unroll
    for (int r = 4; r < 16; r += 4) { a = ATT_MX3(a, p0[r], p0[r + 1]); b = ATT_MX3(b, p0[r + 2], p0[r + 3]); a = ATT_MX3(a, p1[r], p1[r + 1]); b = ATT_MX3(b, p1[r + 2], p1[r + 3]); }
    float m = __builtin_fmaxf(a, b); auto rr = __builtin_amdgcn_permlane32_swap(__float_as_uint(m), __float_as_uint(m), false, false);
    return __builtin_fmaxf(__uint_as_float(rr[0]), __uint_as_float(rr[1])); }
__device__ __forceinline__ void pv(f32x16* o, lcp vp, const u32x4 pw0, const u32x4 pw1, const u32x4 pw2, const u32x4 pw3) {
#pragma unroll
    for (int d0 = 0; d0 < 2; ++d0) {
#pragma unroll
        for (int ks = 0; ks < 4; ++ks) {
            const s16x4 lo = vtr(vp + d0 * 4096 + ks * 1024), hi = vtr(vp + d0 * 4096 + ks * 1024 + 512);
            const bf16x8 vf = (bf16x8){lo[0], lo[1], lo[2], lo[3], hi[0], hi[1], hi[2], hi[3]};
            const u32x4 pw = ks == 0 ? pw0 : ks == 1 ? pw1 : ks == 2 ? pw2 : pw3;
            o[d0] = __builtin_amdgcn_mfma_f32_32x32x16_bf16(__builtin_bit_cast(bf16x8, pw), vf, o[d0], 0, 0, 0);
        }
    }
}
__device__ __forceinline__ void store_o(const f32x16* o, const float* rsc  , LAS unsigned char* stage, bf16_t* Ow, int pitch, int lane, int r32, int hi) {
    LAS bf16_t* stg = (LAS bf16_t*)stage;
#pragma unroll
    for (int r = 0; r < 16; ++r) { const int orow = crow(r, hi);
#pragma unroll
        for (int d0 = 0; d0 < 2; ++d0) stg[orow * 64 + d0 * 32 + r32] = (bf16_t)(pk_bf16(o[d0][r] * rsc[r], 0.f) & 0xffffu); }
    asm volatile("s_waitcnt lgkmcnt(0)" ::: "memory");
#pragma unroll
    for (int i = 0; i < 4; ++i) { const int row = i * 8 + (lane >> 3), ch = lane & 7; const u32x4 v = *(const LAS u32x4*)(stg + row * 64 + ch * 8); *(u32x4*)(Ow + (size_t)row * pitch + ch * 8) = v; }
}

namespace mla {
constexpr int KSLOT = 12288, VSLOT = 8192, NS = 3;
constexpr int L_K = 0, L_V = NS * KSLOT, L_WS = L_V + NS * VSLOT, L_OST = L_WS + 2048, L_END = L_OST + 8 * 4096;
__device__ __forceinline__ void unit(int b, int h, int qb, const bf16_t* Q, const bf16_t* KT, const bf16_t* VT, bf16_t* O, LAS unsigned char* shm) {
    int tid_ = threadIdx.x; asm volatile("" : "+v"(tid_));
    const int tid = tid_, lane = tid & 63, r32 = lane & 31, hi = lane >> 5; const int wid = __builtin_amdgcn_readfirstlane(tid >> 6);
    const long rowbase = (long)b * SEQL; const int q0 = qb * 256;
    const bf16_t* Qw = Q + (size_t)(rowbase + q0 + wid * 32) * 768 + h * 96;
    const bf16_t* Kh = KT + (size_t)((b * 8 + h) * 128) * 6144 + lane * 8;
    const bf16_t* Vh = VT + (size_t)((b * 8 + h) * 128) * 4096 + lane * 8;
    const unsigned lds0 = (unsigned)(uintptr_t)shm;
    LAS float* wsf = (LAS float*)(shm + L_WS) + wid * 64;
    const int NT = (q0 + 256) / 64;
    const int kc2 = 8 + (wid & 3);
#define MLA_DMA(t, sl) do { const bf16_t* kt_ = Kh + (size_t)(t) * 6144; \
        glds16(kt_ + wid * 512, (unsigned)__builtin_amdgcn_readfirstlane(lds0 + L_K + (sl) * KSLOT + wid * 1024)); \
        glds16(kt_ + kc2 * 512, (unsigned)__builtin_amdgcn_readfirstlane(lds0 + L_K + (sl) * KSLOT + kc2 * 1024)); \
        glds16(Vh + (size_t)(t) * 4096 + wid * 512, (unsigned)__builtin_amdgcn_readfirstlane(lds0 + L_V + (sl) * VSLOT + wid * 1024)); } while (0)
    MLA_DMA(0, 0); MLA_DMA(1, 1);
    bf16x8 qr[6];
#pragma unroll
    for (int d0 = 0; d0 < 6; ++d0) qr[d0] = *(const bf16x8*)(Qw + (size_t)r32 * 768 + d0 * 16 + hi * 8);
    float m = -1e30f, l = 0.f; f32x16 o[2];
#pragma unroll
    for (int r = 0; r < 16; ++r) { o[0][r] = 0.f; o[1][r] = 0.f; }
    const int qrel = wid * 32 + r32;
    int slot = 0;
    for (int t = 0; t < NT; ++t) {
        if (t + 1 < NT) ATT_WAIT_BAR(3); else ATT_WAIT_BAR(0);
        if (t + 2 < NT) { const int s2 = slot == 0 ? 2 : slot - 1; MLA_DMA(t + 2, s2); }
        const int jb = t - (NT - 4);
        if (jb <= 0 || 64 * jb <= wid * 32 + 31) {
            const lcp kb = (lcp)shm + L_K + slot * KSLOT + hi * 1024 + r32 * 16;
            f32x16 p0, p1;
#pragma unroll
            for (int r = 0; r < 16; ++r) { p0[r] = 0.f; p1[r] = 0.f; }
#pragma unroll
            for (int d0 = 0; d0 < 6; ++d0) { const bf16x8 b0 = *(const LAS bf16x8*)(kb + d0 * 2048), b1 = *(const LAS bf16x8*)(kb + d0 * 2048 + 512);
                p0 = __builtin_amdgcn_mfma_f32_32x32x16_bf16(b0, qr[d0], p0, 0, 0, 0); p1 = __builtin_amdgcn_mfma_f32_32x32x16_bf16(b1, qr[d0], p1, 0, 0, 0); }
            if (jb >= 0) {
#pragma unroll
                for (int r = 0; r < 16; ++r) { const int kv = 64 * jb + crow(r, hi); if (kv > qrel) p0[r] = -INFINITY; if (kv + 32 > qrel) p1[r] = -INFINITY; }
            }
            const float rm = rowmax(p0, p1), mnew = __builtin_fmaxf(m, rm);
            if (__any(mnew > m)) {
                const float alpha = fast_exp2(m - mnew); l *= alpha; m = mnew;
                if (hi == 0) wsf[r32] = alpha;
#pragma unroll
                for (int r = 0; r < 16; ++r) { const float a = wsf[crow(r, hi)]; o[0][r] *= a; o[1][r] *= a; }
            }
            float sa = 0.f, sb = 0.f;
#pragma unroll
            for (int r = 0; r < 16; ++r) { p0[r] = fast_exp2(p0[r] - m); p1[r] = fast_exp2(p1[r] - m); sa += p0[r]; sb += p1[r]; }
            l += sa + sb;
            const u32x4 pw0 = {pk_bf16(p0[0], p0[1]), pk_bf16(p0[2], p0[3]), pk_bf16(p0[4], p0[5]), pk_bf16(p0[6], p0[7])};
            const u32x4 pw1 = {pk_bf16(p0[8], p0[9]), pk_bf16(p0[10], p0[11]), pk_bf16(p0[12], p0[13]), pk_bf16(p0[14], p0[15])};
            const u32x4 pw2 = {pk_bf16(p1[0], p1[1]), pk_bf16(p1[2], p1[3]), pk_bf16(p1[4], p1[5]), pk_bf16(p1[6], p1[7])};
            const u32x4 pw3 = {pk_bf16(p1[8], p1[9]), pk_bf16(p1[10], p1[11]), pk_bf16(p1[12], p1[13]), pk_bf16(p1[14], p1[15])};
            const lcp vp = (lcp)shm + L_V + slot * VSLOT + ((lane >> 4) & 1) * 32 + (lane & 3) * 8 + (4 * hi + ((lane & 15) >> 2)) * 64;
            pv(o, vp, pw0, pw1, pw2, pw3);
        }
        slot = slot == 2 ? 0 : slot + 1;
    }
#undef MLA_DMA
    { auto rr = __builtin_amdgcn_permlane32_swap(__float_as_uint(l), __float_as_uint(l), false, false); l = __uint_as_float(rr[0]) + __uint_as_float(rr[1]); }
    if (hi == 0) wsf[32 + r32] = l;
    float rli[16];
#pragma unroll
    for (int r = 0; r < 16; ++r) rli[r] = fast_rcp(wsf[32 + crow(r, hi)]);
    store_o(o, rli, shm + L_OST + wid * 4096, O + (size_t)(rowbase + q0 + wid * 32) * 512 + h * 64, 512, lane, r32, hi);
    asm volatile("s_waitcnt lgkmcnt(0)\n\ts_barrier" ::: "memory");
}
__device__ __forceinline__ void phase(int vcu, int G, const bf16_t* Q, const bf16_t* KT, const bf16_t* VT, bf16_t* O, LAS unsigned char* shm) {
    for (int v = vcu; v < 256; v += G) { const int bh = v >> 4, s = v & 15;
        unit(bh >> 3, bh & 7, 31 - s, Q, KT, VT, O, shm);
        unit(bh >> 3, bh & 7, s, Q, KT, VT, O, shm); }
}
}

namespace sba {
constexpr int KSLOT = 8192, VSLOT = 8192, NS = 3;
constexpr int L_K = 0, L_V = NS * KSLOT, L_WS = L_V + NS * VSLOT, L_FLAG = L_WS + 2048, L_OST = L_FLAG + 256, L_END = L_OST + 8 * 4096;
constexpr float SB_EXIT = -160.0f;
__device__ __forceinline__ void unit(int b, int kh, int qb64, const bf16_t* Q, const bf16_t* KT, const bf16_t* VT, bf16_t* O, LAS unsigned char* shm) {
    int tid_ = threadIdx.x; asm volatile("" : "+v"(tid_));
    const int tid = tid_, lane = tid & 63, r32 = lane & 31, hi = lane >> 5; const int wid = __builtin_amdgcn_readfirstlane(tid >> 6);
    const int h = kh * 4 + (wid >> 1), half = wid & 1;
    const long rowbase = (long)b * SEQL; const int q0 = qb64 * 64;
    const bf16_t* Qw = Q + (size_t)(rowbase + q0 + half * 32) * 1024 + h * 64;
    const bf16_t* Kh = KT + (size_t)((b * 4 + kh) * 128) * 4096 + wid * 512 + lane * 8;
    const bf16_t* Vh = VT + (size_t)((b * 4 + kh) * 128) * 4096 + wid * 512 + lane * 8;
    const unsigned lds0 = (unsigned)(uintptr_t)shm;
    LAS int* flags = (LAS int*)(shm + L_FLAG);
    const int NT = qb64 + 1;
#define SBA_DMA(k, sl) do { const int tile_ = qb64 - (k); \
        glds16(Kh + (size_t)tile_ * 4096, (unsigned)__builtin_amdgcn_readfirstlane(lds0 + L_K + (sl) * KSLOT + wid * 1024)); \
        glds16(Vh + (size_t)tile_ * 4096, (unsigned)__builtin_amdgcn_readfirstlane(lds0 + L_V + (sl) * VSLOT + wid * 1024)); } while (0)
    SBA_DMA(0, 0); if (NT > 1) SBA_DMA(1, 1);
    bf16x8 qr[4];
#pragma unroll
    for (int d0 = 0; d0 < 4; ++d0) qr[d0] = *(const bf16x8*)(Qw + (size_t)r32 * 1024 + d0 * 16 + hi * 8);
    float R = 0.f; f32x16 o[2];
#pragma unroll
    for (int r = 0; r < 16; ++r) { o[0][r] = 0.f; o[1][r] = 0.f; }
    const int qrel = half * 32 + r32;
    int slot = 0;
    for (int k = 0; k < NT; ++k) {
        if (k + 1 < NT) ATT_WAIT_BAR(2); else ATT_WAIT_BAR(0);
        if (k > 0) { const LAS int* f = flags + ((k - 1) & 1) * 8; int all = 1;
#pragma unroll
            for (int w = 0; w < 8; ++w) all &= f[w];
            if (all) break; }
        if (k + 2 < NT) { const int s2 = slot == 0 ? 2 : slot - 1; SBA_DMA(k + 2, s2); }
        {
            const lcp kb = (lcp)shm + L_K + slot * KSLOT + hi * 1024 + r32 * 16;
            f32x16 p0, p1;
#pragma unroll
            for (int r = 0; r < 16; ++r) { p0[r] = 0.f; p1[r] = 0.f; }
#pragma unroll
            for (int d0 = 0; d0 < 4; ++d0) { const bf16x8 b0 = *(const LAS bf16x8*)(kb + d0 * 2048), b1 = *(const LAS bf16x8*)(kb + d0 * 2048 + 512);
                p0 = __builtin_amdgcn_mfma_f32_32x32x16_bf16(b0, qr[d0], p0, 0, 0, 0); p1 = __builtin_amdgcn_mfma_f32_32x32x16_bf16(b1, qr[d0], p1, 0, 0, 0); }
            f32x16 L0, L1;
#pragma unroll
            for (int r = 0; r < 16; ++r) {
                const float z0 = p0[r], z1 = p1[r];
                float s0 = -(__builtin_fmaxf(z0, 0.f) + fast_log2(1.0f + fast_exp2(-__builtin_fabsf(z0))));
                float s1 = -(__builtin_fmaxf(z1, 0.f) + fast_log2(1.0f + fast_exp2(-__builtin_fabsf(z1))));
                if (k == 0) { const int kv = crow(r, hi); if (kv >= qrel) s0 = 0.f; if (kv + 32 >= qrel) s1 = 0.f; }
                L0[r] = s0; L1[r] = s1; }
            float G[16];
#pragma unroll
            for (int j = 0; j < 8; ++j) { const f32x16& LL = j < 4 ? L0 : L1; const int rb = 4 * (j & 3);
                const float gsum = (LL[rb] + LL[rb + 1]) + (LL[rb + 2] + LL[rb + 3]);
                auto rr = __builtin_amdgcn_permlane32_swap(__float_as_uint(gsum), __float_as_uint(gsum), false, false);
                G[2 * j] = __uint_as_float(rr[0]); G[2 * j + 1] = __uint_as_float(rr[1]); }
            float SG[16]; SG[15] = 0.f;
#pragma unroll
            for (int g = 14; g >= 0; --g) SG[g] = SG[g + 1] + G[g + 1];
            const float T = SG[0] + G[0];
#pragma unroll
            for (int j = 0; j < 8; ++j) { f32x16& LL = j < 4 ? L0 : L1; f32x16& PP = j < 4 ? p0 : p1; const int rb = 4 * (j & 3);
                const float base = (R + SG[2 * j + 1]) + (hi ? 0.f : G[2 * j + 1]);
                const float r3 = base, r2 = r3 + LL[rb + 3], r1 = r2 + LL[rb + 2], r0 = r1 + LL[rb + 1];
                PP[rb + 3] = fast_exp2(PP[rb + 3] + LL[rb + 3] + r3); PP[rb + 2] = fast_exp2(PP[rb + 2] + LL[rb + 2] + r2);
                PP[rb + 1] = fast_exp2(PP[rb + 1] + LL[rb + 1] + r1); PP[rb] = fast_exp2(PP[rb] + LL[rb] + r0); }
            if (k == 0) {
#pragma unroll
                for (int r = 0; r < 16; ++r) { const int kv = crow(r, hi); if (kv >= qrel) p0[r] = 0.f; if (kv + 32 >= qrel) p1[r] = 0.f; }
            }
            R += T;
            const u32x4 pw0 = {pk_bf16(p0[0], p0[1]), pk_bf16(p0[2], p0[3]), pk_bf16(p0[4], p0[5]), pk_bf16(p0[6], p0[7])};
            const u32x4 pw1 = {pk_bf16(p0[8], p0[9]), pk_bf16(p0[10], p0[11]), pk_bf16(p0[12], p0[13]), pk_bf16(p0[14], p0[15])};
            const u32x4 pw2 = {pk_bf16(p1[0], p1[1]), pk_bf16(p1[2], p1[3]), pk_bf16(p1[4], p1[5]), pk_bf16(p1[6], p1[7])};
            const u32x4 pw3 = {pk_bf16(p1[8], p1[9]), pk_bf16(p1[10], p1[11]), pk_bf16(p1[12], p1[13]), pk_bf16(p1[14], p1[15])};
            const lcp vp = (lcp)shm + L_V + slot * VSLOT + ((lane >> 4) & 1) * 32 + (lane & 3) * 8 + (4 * hi + ((lane & 15) >> 2)) * 64;
            pv(o, vp, pw0, pw1, pw2, pw3);
            const int dn = __all(R < SB_EXIT) ? 1 : 0;
            if (lane == 0) flags[(k & 1) * 8 + wid] = dn;
        }
        slot = slot == 2 ? 0 : slot + 1;
    }
#undef SBA_DMA
    ATT_WAIT_BAR(0);
    float one[16];
#pragma unroll
    for (int r = 0; r < 16; ++r) one[r] = 1.0f;
    store_o(o, one, shm + L_OST + wid * 4096, O + (size_t)(rowbase + q0 + half * 32) * 1024 + h * 64, 1024, lane, r32, hi);
    asm volatile("s_waitcnt lgkmcnt(0)\n\ts_barrier" ::: "memory");
}
__device__ __forceinline__ void phase(int vcu, int G, const bf16_t* Q, const bf16_t* KT, const bf16_t* VT, bf16_t* O, LAS unsigned char* shm) {
    for (int u = vcu * 4; u < 1024; u += G * 4)
        for (int i = 0; i < 4; ++i) { const int uu = u + i, qb64 = uu & 127, bk = uu >> 7; unit(bk >> 2, bk & 3, qb64, Q, KT, VT, O, shm); }
}
}
}
namespace fw {
constexpr size_t MiB = 1u << 20;
constexpr int NWAVES = 8, NTHR = 512;
constexpr int MAXSLOT = 34816;
constexpr size_t WS_CTL = 0, CTL_ZERO_BYTES = 64 * 1024;
constexpr size_t WS_TOKE = 1 * MiB;
constexpr size_t WS_TOKG = WS_TOKE + 64 * 1024;
constexpr size_t WS_TOKRS = WS_TOKG + 128 * 1024;
constexpr size_t WS_SLOT12 = WS_TOKRS + 64 * 1024;
constexpr size_t WS_SLOTG = WS_SLOT12 + 128 * 1024;
constexpr size_t WS_SLOTRS = WS_SLOTG + 256 * 1024;
constexpr size_t WS_CNT = WS_SLOTRS + 256 * 1024;
constexpr size_t WS_PSTART = WS_CNT + 16 * 1024;
constexpr size_t WS_CS = 4 * MiB;
constexpr size_t WS_SSQ = 6 * MiB;
constexpr size_t WS_SSQQ = 8 * MiB;
constexpr size_t WS_SSQKV = WS_SSQQ + 512 * 1024;
constexpr size_t WS_KPE = 9 * MiB;
constexpr size_t WS_W = 16 * MiB;
constexpr size_t W_AIN = WS_W, W_QUP = W_AIN + 3 * MiB, W_KVUP = W_QUP + 2 * MiB, W_AOUT = W_KVUP + 1 * MiB, W_KVS = W_AOUT + 2 * MiB, W_QB = W_KVS + 1 * MiB,
                 W_OB = W_QB + 4 * MiB, W_PG = W_OB + 4 * MiB, W_PU = W_PG + 8 * MiB, W_FGU = W_PU + 2 * MiB, W_FDN = W_FGU + 22 * MiB, W_EGU = W_FDN + 11 * MiB,
                 W_EDN = W_EGU + 176 * MiB, W_END = W_EDN + 88 * MiB;
constexpr size_t WS_PB = W_END;
constexpr size_t WS_HB = WS_PB + 32 * MiB;
constexpr size_t WS_U = WS_HB + 64 * MiB;
constexpr size_t WS_SKT = WS_U + 128 * MiB, WS_SVT = WS_SKT + 8 * MiB;
constexpr size_t WS_X = WS_SVT + 8 * MiB;
constexpr size_t X_AQ = WS_X, X_AKV = X_AQ + 12 * MiB, X_QRAW = X_AKV + 8 * MiB, X_KVRAW = X_QRAW + 24 * MiB, X_Q = X_KVRAW + 32 * MiB, X_KT = X_Q + 24 * MiB, X_VT = X_KT + 24 * MiB, X_O = X_VT + 16 * MiB;
constexpr size_t X_SQ = WS_X, X_SO = X_SQ + 32 * MiB;
constexpr size_t X_HID = WS_X;
constexpr size_t X_XG = WS_X, X_HG = X_XG + 68 * MiB, X_YG = X_HG + 187 * MiB, X_END = X_YG + 68 * MiB;
constexpr size_t WS_END = X_END;
static_assert(X_O + 16 * MiB <= X_END && (size_t)MAXSLOT * 2816 * 2 <= 187 * MiB && (size_t)MAXSLOT * 1024 * 2 <= 68 * MiB, "ws map");
constexpr int CW_BAR = 1024;
constexpr int RING_OFF = 0, RING_BYTES = 131072, LDSCTL_OFF = RING_BYTES, MISC_OFF = LDSCTL_OFF + 320, LDS_BYTES = 147456;
static_assert(att::mla::L_END <= RING_BYTES && att::sba::L_END <= RING_BYTES, "attention LDS");
constexpr float QSCALE_MLA = 0.10206207261596577f * LOG2E;
constexpr float QSCALE_SB = 0.125f * LOG2E;

constexpr int PH_PER_LAYER = 12, PH_TOTAL = 2 + 4 * PH_PER_LAYER;
__host__ __device__ inline bool phase_active(int idx) {
    if (idx < 2) return true;
    const int l = (idx - 2) / PH_PER_LAYER, s = (idx - 2) % PH_PER_LAYER; const bool mla = l < 2, moe = (l & 1) != 0;
    if (s == 1 || s == 2) return mla;
    if (s >= 7 && s <= 9) return moe;
    if (s == 11) return l == 1;
    return true;
}

struct Args { const float* in[26]; float* out; unsigned char* ws; int ph_lo, ph_hi; };

struct Frame { LAS unsigned char* lds; int tid, lane, wave, vcu, G; };

__device__ __forceinline__ float wave_sum(float v) {
#pragma unroll
    for (int o = 1; o < 64; o <<= 1) v += __shfl_xor(v, o);
    return v;
}
__device__ __forceinline__ void transpose_item(const float* W, int ldw, int sca, int scb, const float* gain, bf16_t* WT, int K, int drow0, int k0, LAS float* scr, int lane) {
    const int r8 = lane >> 3, pc = lane & 7, c = lane & 7;
    f32x4 va[8], vb[8]; float g[8];
    const f32x4 z4 = {0.f, 0.f, 0.f, 0.f};
#pragma unroll
    for (int i = 0; i < 8; ++i) { const float* rp = W + (size_t)(k0 + i * 8 + r8) * ldw + 4 * pc;
        va[i] = sca >= 0 ? *(const f32x4*)(rp + sca) : z4; vb[i] = scb >= 0 ? *(const f32x4*)(rp + scb) : z4; g[i] = gain ? gain[k0 + i * 8 + r8] : 1.0f; }
#pragma unroll
    for (int hf = 0; hf < 2; ++hf) {
#pragma unroll
        for (int i = 0; i < 8; ++i) { const f32x4 v = (hf == 0 ? va[i] : vb[i]) * g[i]; LAS float* d = scr + (i * 8 + r8) * 33 + 4 * pc; d[0] = v[0]; d[1] = v[1]; d[2] = v[2]; d[3] = v[3]; }
        asm volatile("s_waitcnt lgkmcnt(0)" ::: "memory");
#pragma unroll
        for (int j = 0; j < 4; ++j) { const int n = (lane >> 3) + 8 * j; const LAS float* s = scr + (8 * c) * 33 + n;
            u32x4 o; o.x = pk_bf16(s[0 * 33], s[1 * 33]); o.y = pk_bf16(s[2 * 33], s[3 * 33]); o.z = pk_bf16(s[4 * 33], s[5 * 33]); o.w = pk_bf16(s[6 * 33], s[7 * 33]);
            *(u32x4*)(WT + (size_t)(drow0 + hf * 32 + n) * K + k0 + 8 * c) = o; }
        asm volatile("s_waitcnt lgkmcnt(0)" ::: "memory");
    }
}
struct Fam { int src, count, K, Nd, ldw, map, gain, gstride; size_t sstride, dst, dstride; };
__device__ __forceinline__ int fam_items(const Fam& f) { return f.count * (f.K / 64) * (f.Nd / 64); }
__device__ __forceinline__ int fam_src_col(int map, int n0) {
    if (map == 1) return n0 < 384 ? n0 : (n0 < 416 ? 640 + (n0 - 384) : (n0 < 512 ? -1 : 384 + (n0 - 512)));
    if (map == 2) { const int pn = n0 >> 8, jj = n0 & 255; return jj < 128 ? pn * 128 + jj : 2816 + pn * 128 + (jj - 128); }
    return n0;
}
__device__ __forceinline__ void fam_item(const Args& a, const Fam& f, int fid, int it, LAS float* scr, int lane) {
    const int per = (f.K / 64) * (f.Nd / 64), mi = it / per, r = it % per, nblk = f.Nd / 64, kb = r / nblk, nb = r % nblk, n0 = nb * 64;
    const float* gain = nullptr;
    if (f.gain >= 0) gain = a.in[f.gain] + (fid == 11 ? (size_t)(2 * (mi >> 3) + 1) * 1024 : (size_t)mi * f.gstride);
    transpose_item(a.in[f.src] + (size_t)mi * f.sstride, f.ldw, fam_src_col(f.map, n0), fam_src_col(f.map, n0 + 32), gain, (bf16_t*)(a.ws + f.dst + (size_t)mi * f.dstride), f.K, n0, kb * 64, scr, lane);
}
__constant__ const Fam FAMS[13] = {
        {4, 2, 1024, 768, 672, 1, 3, 1024, (size_t)1024 * 672, W_AIN, (size_t)768 * 1024 * 2},
        {7, 2, 384, 768, 768, 0, 5, 384, (size_t)384 * 768, W_QUP, (size_t)768 * 384 * 2},
        {8, 2, 256, 1024, 1024, 0, 6, 256, (size_t)256 * 1024, W_KVUP, (size_t)1024 * 256 * 2},
        {11, 2, 512, 1024, 1024, 0, -1, 0, (size_t)512 * 1024, W_AOUT, (size_t)1024 * 512 * 2},
        {13, 1, 1024, 512, 512, 0, 12, 0, 0, W_KVS, 0},
        {15, 2, 1024, 1024, 1024, 0, 14, 1024, (size_t)1024 * 1024, W_QB, (size_t)1024 * 1024 * 2},
        {16, 2, 1024, 1024, 1024, 0, -1, 0, (size_t)1024 * 1024, W_OB, (size_t)1024 * 1024 * 2},
        {24, 4, 1024, 1024, 1024, 0, 23, 1024, (size_t)1024 * 1024, W_PG, (size_t)1024 * 1024 * 2},
        {25, 4, 256, 1024, 1024, 0, -1, 0, (size_t)256 * 1024, W_PU, (size_t)1024 * 256 * 2},
        {18, 2, 1024, 5632, 5632, 2, 17, 2048, (size_t)1024 * 5632, W_FGU, (size_t)5632 * 1024 * 2},
        {19, 2, 2816, 1024, 1024, 0, -1, 0, (size_t)2816 * 1024, W_FDN, (size_t)1024 * 2816 * 2},
        {21, 16, 1024, 5632, 5632, 2, 17, 0, (size_t)1024 * 5632, W_EGU, (size_t)5632 * 1024 * 2},
        {22, 16, 2816, 1024, 1024, 0, -1, 0, (size_t)2816 * 1024, W_EDN, (size_t)1024 * 2816 * 2}};
__device__ __forceinline__ void prologue(const Args& a, Frame& F) {
    LAS float* scr = (LAS float*)(F.lds + RING_OFF + F.wave * 16384);
    const int gw = F.vcu * NWAVES + F.wave, NGW = F.G * NWAVES;
    int base = 0;
#pragma unroll 1
    for (int fid = 0; fid < 13; ++fid) { const Fam f = FAMS[fid]; const int n = fam_items(f);
        int it = gw - (base % NGW); if (it < 0) it += NGW;
#pragma unroll 1
        for (; it < n; it += NGW) fam_item(a, f, fid, it, scr, F.lane);
        base += n; }
    { const f32x4* src = (const f32x4*)a.in[1]; u32x2* dst = (u32x2*)(a.ws + WS_PB); const size_t n4 = (size_t)4 * MT * 256 / 4, S = (size_t)NGW * 64;
        for (size_t i = (size_t)gw * 64 + F.lane; i < n4; i += 4 * S) { f32x4 v[4];
#pragma unroll
            for (int q = 0; q < 4; ++q) v[q] = (i + q * S < n4) ? src[i + q * S] : (f32x4){0.f, 0.f, 0.f, 0.f};
#pragma unroll
            for (int q = 0; q < 4; ++q) if (i + q * S < n4) { u32x2 o; o.x = pk_bf16(v[q][0], v[q][1]); o.y = pk_bf16(v[q][2], v[q][3]); dst[i + q * S] = o; } } }
    { bf16_t* HB = (bf16_t*)(a.ws + WS_HB); float* SSQ = (float*)(a.ws + WS_SSQ);
        for (int row = gw; row < MT; row += NGW) { const f32x4* xr = (const f32x4*)(a.in[0] + (size_t)row * DMODEL) + F.lane;
            u32x2* hb = (u32x2*)(HB + (size_t)row * DMODEL) + F.lane; float s = 0.f; f32x4 v4[4];
#pragma unroll
            for (int j = 0; j < 4; ++j) v4[j] = xr[64 * j];
#pragma unroll
            for (int j = 0; j < 4; ++j) { const f32x4 v = v4[j]; u32x2 o; o.x = pk_bf16(v[0], v[1]); o.y = pk_bf16(v[2], v[3]); hb[64 * j] = o; s += (v[0] * v[0] + v[1] * v[1]) + (v[2] * v[2] + v[3] * v[3]); }
            s = wave_sum(s); if (F.lane < 16) SSQ[(size_t)row * 16 + F.lane] = F.lane == 0 ? s : 0.f; } }
    { float* cs = (float*)(a.ws + WS_CS); const int* pos = (const int*)a.in[2];
        for (int i = gw * 64 + F.lane; i < MT * 16; i += NGW * 64) { const int row = i >> 4, f = i & 15;
            const float invf = (float)exp(-9.210340371976184 * (double)f / 16.0);
            const double ang = (double)((float)pos[row] * invf);
            const double rev = ang * 0.15915494309189535, fr = rev - rint(rev); const float x = (float)(fr * 6.283185307179586);
            cs[(size_t)row * 32 + f] = cosf(x); cs[(size_t)row * 32 + 16 + f] = sinf(x); } }
}
__device__ __forceinline__ void norm_rope_8(f32x4& n0, f32x4& n1, f32x4& r0, f32x4& r1, const float* gain, const float* cs, int sub, float outscale) {
    float ss = pg8::sumsq8(n0, n1) + pg8::sumsq8(r0, r1);
    ss += __shfl_xor(ss, 1); ss += __shfl_xor(ss, 2); ss += __shfl_xor(ss, 4);
    const float rq = (1.0f / sqrtf(ss * (1.0f / 96.0f) + RMS_EPS));
    const f32x4 g0 = *(const f32x4*)(gain + 8 * sub), g1 = *(const f32x4*)(gain + 8 * sub + 4);
    n0 = n0 * g0 * (rq * outscale); n1 = n1 * g1 * (rq * outscale);
    const int s4 = sub & 3;
    const f32x4 h0 = *(const f32x4*)(gain + 64 + 8 * s4), h1 = *(const f32x4*)(gain + 64 + 8 * s4 + 4);
    r0 = r0 * h0 * (rq * outscale); r1 = r1 * h1 * (rq * outscale);
    f32x4 p0, p1;
#pragma unroll
    for (int j = 0; j < 4; ++j) { p0[j] = __shfl_xor(r0[j], 2); p1[j] = __shfl_xor(r1[j], 2); }
    const f32x4 c0 = *(const f32x4*)(cs + 8 * (sub & 1)), c1 = *(const f32x4*)(cs + 8 * (sub & 1) + 4), s0 = *(const f32x4*)(cs + 16 + 8 * (sub & 1)), s1 = *(const f32x4*)(cs + 16 + 8 * (sub & 1) + 4);
    if (s4 < 2) { r0 = r0 * c0 - p0 * s0; r1 = r1 * c1 - p1 * s1; }
    else { r0 = r0 * c0 + p0 * s0; r1 = r1 * c1 + p1 * s1; }
}
#define THIN_LAUNDER() Frame F = F_; unsigned char* wsl = a.ws; asm volatile("" : "+v"(F.tid), "+v"(F.lane), "+s"(F.wave), "+s"(F.vcu), "+s"(F.G), "+s"(wsl))
__device__ __forceinline__ void mla_prep(const Args& a, const Frame& F_, int layer) { THIN_LAUNDER();
    const bf16_t* QRAW = (const bf16_t*)(wsl + X_QRAW); const bf16_t* KVRAW = (const bf16_t*)(wsl + X_KVRAW); const float* KPE = (const float*)(wsl + WS_KPE);
    const float* CS = (const float*)(wsl + WS_CS); const float* gq = a.in[9] + layer * 96; const float* gk = a.in[10] + layer * 96;
    bf16_t* Q = (bf16_t*)(wsl + X_Q); bf16_t* KT = (bf16_t*)(wsl + X_KT); bf16_t* VT = (bf16_t*)(wsl + X_VT);
    const int gw = F.vcu * NWAVES + F.wave, NGW = F.G * NWAVES, h = F.lane >> 3, sub = F.lane & 7;
    const f32x4 z4 = {0.f, 0.f, 0.f, 0.f};
    for (int row = gw; row < MT; row += NGW) {
        const int b = row >> 13, sq = row & 8191, tile = sq >> 6, rr = sq & 63; const float* cs = CS + (size_t)row * 32;
        { const bf16_t* qrow = QRAW + (size_t)row * 768 + h * 96; f32x4 n0, n1, r0 = z4, r1 = z4;
            unpack8(*(const u32x4*)(qrow + 8 * sub), n0, n1); if (sub < 4) unpack8(*(const u32x4*)(qrow + 64 + 8 * sub), r0, r1);
            norm_rope_8(n0, n1, r0, r1, gq, cs, sub, QSCALE_MLA);
            bf16_t* qo = Q + (size_t)row * 768 + h * 96; *(u32x4*)(qo + 8 * sub) = pack8(n0, n1); if (sub < 4) *(u32x4*)(qo + 64 + 8 * sub) = pack8(r0, r1); }
        { const bf16_t* krow = KVRAW + (size_t)row * 1024 + h * 128; f32x4 n0, n1, r0 = z4, r1 = z4;
            unpack8(*(const u32x4*)(krow + 8 * sub), n0, n1); if (sub < 4) { r0 = *(const f32x4*)(KPE + (size_t)row * 32 + 8 * sub); r1 = *(const f32x4*)(KPE + (size_t)row * 32 + 8 * sub + 4); }
            norm_rope_8(n0, n1, r0, r1, gk, cs, sub, 1.0f);
            bf16_t* kt = KT + (size_t)((b * 8 + h) * 128 + tile) * 6144 + rr * 8; *(u32x4*)(kt + sub * 512) = pack8(n0, n1); if (sub < 4) *(u32x4*)(kt + (8 + sub) * 512) = pack8(r0, r1);
            const u32x4 v = *(const u32x4*)(krow + 64 + 8 * sub);
            *(u32x4*)(VT + (size_t)((b * 8 + h) * 128 + tile) * 4096 + (sub >> 2) * 2048 + rr * 32 + (sub & 3) * 8) = v; }
    }
}
__device__ __forceinline__ void moe_route(const Args& a, const Frame& F_, int layer, int cur) { THIN_LAUNDER();
    const bf16_t* HB = (const bf16_t*)(wsl + WS_HB) + (size_t)cur * MT * DMODEL; const float* gain = a.in[17] + (size_t)layer * 1024; const float* wr = a.in[20] + (size_t)(layer >> 1) * 1024 * 8;
    int* TOKE = (int*)(wsl + WS_TOKE); float* TOKG = (float*)(wsl + WS_TOKG); float* TOKRS = (float*)(wsl + WS_TOKRS); int* CNT = (int*)(wsl + WS_CNT);
    LAS float* wg = (LAS float*)(F.lds + RING_OFF);
    LAS int* lcnt = (LAS int*)(F.lds + RING_OFF + 32768);
    for (int i = F.tid; i < 1024 * 8; i += NTHR) wg[i] = wr[i] * gain[i >> 3];
    for (int chunk = F.vcu; chunk < MT / 64; chunk += F.G) {
        if (F.tid < 8) lcnt[F.tid] = 0;
        __syncthreads();
        for (int tt = 0; tt < 8; ++tt) { const int tok = chunk * 64 + F.wave * 8 + tt;
            const u32x2* hr = (const u32x2*)(HB + (size_t)tok * DMODEL) + F.lane; float lg[8], ss = 0.f;
#pragma unroll
            for (int e = 0; e < 8; ++e) lg[e] = 0.f;
#pragma unroll
            for (int j = 0; j < 4; ++j) { const u32x2 hv = hr[64 * j]; const f32x4 v = {bf_lo(hv.x), bf_hi(hv.x), bf_lo(hv.y), bf_hi(hv.y)}; ss += (v[0] * v[0] + v[1] * v[1]) + (v[2] * v[2] + v[3] * v[3]);
#pragma unroll
                for (int i = 0; i < 4; ++i) { const LAS f32x4* w = (const LAS f32x4*)(wg + (size_t)(256 * j + 4 * F.lane + i) * 8); const f32x4 w0 = w[0], w1 = w[1];
                    lg[0] += v[i] * w0[0]; lg[1] += v[i] * w0[1]; lg[2] += v[i] * w0[2]; lg[3] += v[i] * w0[3]; lg[4] += v[i] * w1[0]; lg[5] += v[i] * w1[1]; lg[6] += v[i] * w1[2]; lg[7] += v[i] * w1[3]; } }
            ss = wave_sum(ss);
#pragma unroll
            for (int e = 0; e < 8; ++e) lg[e] = wave_sum(lg[e]);
            const float r = 1.0f / sqrtf(ss * (1.0f / 1024.0f) + RMS_EPS);
            int e1 = 0; float v1 = lg[0];
#pragma unroll
            for (int e = 1; e < 8; ++e) if (lg[e] > v1) { v1 = lg[e]; e1 = e; }
            int e2 = 0; float v2 = -3.0e38f;
#pragma unroll
            for (int e = 0; e < 8; ++e) if (e != e1 && lg[e] > v2) { v2 = lg[e]; e2 = e; }
            const float p2 = __expf((v2 - v1) * r), g1 = 1.0f / (1.0f + p2), g2 = p2 / (1.0f + p2);
            if (F.lane == 0) { TOKE[tok] = e1 | (e2 << 8); TOKG[tok * 2] = g1; TOKG[tok * 2 + 1] = g2; TOKRS[tok] = r; __hip_atomic_fetch_add(lcnt + e1, 1, __ATOMIC_RELAXED, __HIP_MEMORY_SCOPE_WORKGROUP); __hip_atomic_fetch_add(lcnt + e2, 1, __ATOMIC_RELAXED, __HIP_MEMORY_SCOPE_WORKGROUP); }
        }
        __syncthreads();
        if (F.tid < 8) CNT[chunk * 8 + F.tid] = lcnt[F.tid];
        __syncthreads();
    }
}
__device__ __forceinline__ void moe_scatter(const Args& a, const Frame& F_, int cur) { THIN_LAUNDER();
    const int* TOKE = (const int*)(wsl + WS_TOKE); const float* TOKG = (const float*)(wsl + WS_TOKG); const float* TOKRS = (const float*)(wsl + WS_TOKRS); const int* CNT = (const int*)(wsl + WS_CNT);
    int* SLOT12 = (int*)(wsl + WS_SLOT12); float* SLOTG = (float*)(wsl + WS_SLOTG); float* SLOTRS = (float*)(wsl + WS_SLOTRS); int* PSTART = (int*)(wsl + WS_PSTART);
    const bf16_t* HB = (const bf16_t*)(wsl + WS_HB) + (size_t)cur * MT * DMODEL; bf16_t* XG = (bf16_t*)(wsl + X_XG);
    LAS int* sm = (LAS int*)(F.lds + RING_OFF);
    for (int chunk = F.vcu; chunk < MT / 64; chunk += F.G) {
        { const int e = F.wave; int c4[4]; int s = 0;
#pragma unroll
            for (int i = 0; i < 4; ++i) { c4[i] = CNT[(4 * F.lane + i) * 8 + e]; s += c4[i]; }
            int inc = s;
#pragma unroll
            for (int o = 1; o < 64; o <<= 1) { const int t = __shfl_up(inc, o); if (F.lane >= o) inc += t; }
            const int total = __shfl(inc, 63); int pre = inc - s;
            if (F.lane == (chunk >> 2)) { const int cm = chunk & 3; pre += (cm > 0 ? c4[0] : 0) + (cm > 1 ? c4[1] : 0) + (cm > 2 ? c4[2] : 0); sm[8 + e] = pre; }
            if (F.lane == 0) sm[e] = total; }
        __syncthreads();
        if (F.tid == 0) { int p = 0; for (int e = 0; e < 8; ++e) { sm[16 + e] = p; p += (sm[e] + 255) >> 8; } sm[24] = p; }
        __syncthreads();
        if (F.tid < 9) PSTART[F.tid] = sm[16 + F.tid];
        if (F.wave == 0) { const int tok = chunk * 64 + F.lane; const int ev = TOKE[tok], e1 = ev & 255, e2 = ev >> 8; int s1 = 0, s2 = 0;
            const unsigned long long below = (1ull << F.lane) - 1ull;
#pragma unroll
            for (int e = 0; e < 8; ++e) { const unsigned long long m1 = __ballot(e1 == e), m2 = __ballot(e2 == e);
                const int rank = __popcll(m1 & below) + __popcll(m2 & below), slot = sm[16 + e] * 256 + sm[8 + e] + rank;
                if (e1 == e) s1 = slot; if (e2 == e) s2 = slot; }
            SLOT12[tok * 2] = s1; SLOT12[tok * 2 + 1] = s2; const float r = TOKRS[tok];
            SLOTG[s1] = TOKG[tok * 2]; SLOTG[s2] = TOKG[tok * 2 + 1]; SLOTRS[s1] = r; SLOTRS[s2] = r;
            sm[32 + 2 * F.lane] = s1; sm[32 + 2 * F.lane + 1] = s2; }
        __syncthreads();
        for (int i = 0; i < 16; ++i) { const int pr = F.wave * 16 + i, tok = chunk * 64 + (pr >> 1), slot = sm[32 + pr];
            const u32x4* src = (const u32x4*)(HB + (size_t)tok * DMODEL) + F.lane; u32x4* dst = (u32x4*)(XG + (size_t)slot * DMODEL) + F.lane;
            dst[0] = src[0]; dst[64] = src[64]; }
        __syncthreads();
    }
}
__device__ __forceinline__ void moe_combine(const Args& a, const Frame& F_, int cur, bool dummy) { THIN_LAUNDER();
    const int* SLOT12 = (const int*)(wsl + WS_SLOT12); const bf16_t* YG = (const bf16_t*)(wsl + X_YG);
    const bf16_t* HBi = (const bf16_t*)(wsl + WS_HB) + (size_t)cur * MT * DMODEL;
    bf16_t* HB = dummy ? (bf16_t*)(wsl + WS_END + 66 * MiB) : (bf16_t*)(wsl + WS_HB) + (size_t)cur * MT * DMODEL; float* SSQ = dummy ? (float*)(wsl + WS_END + 99 * MiB) : (float*)(wsl + WS_SSQ) + (size_t)cur * MT * 16;
    const int gw = F.vcu * NWAVES + F.wave, NGW = F.G * NWAVES;
    for (int row = gw; row < MT; row += NGW) { const int s1 = SLOT12[row * 2], s2 = SLOT12[row * 2 + 1];
        const u32x2* hr = (const u32x2*)(HBi + (size_t)row * DMODEL) + F.lane; u32x2* hb = (u32x2*)(HB + (size_t)row * DMODEL) + F.lane;
        const u32x2* y1 = (const u32x2*)(YG + (size_t)s1 * DMODEL) + F.lane; const u32x2* y2 = (const u32x2*)(YG + (size_t)s2 * DMODEL) + F.lane; float s = 0.f;
        u32x2 hv[4], pv_[4], qv[4];
#pragma unroll
        for (int j = 0; j < 4; ++j) { hv[j] = hr[64 * j]; pv_[j] = y1[64 * j]; qv[j] = y2[64 * j]; }
#pragma unroll
        for (int j = 0; j < 4; ++j) { const u32x2 h = hv[j], p = pv_[j], q = qv[j]; f32x4 v;
            v[0] = bf_lo(h.x) + (bf_lo(p.x) + bf_lo(q.x)); v[1] = bf_hi(h.x) + (bf_hi(p.x) + bf_hi(q.x)); v[2] = bf_lo(h.y) + (bf_lo(p.y) + bf_lo(q.y)); v[3] = bf_hi(h.y) + (bf_hi(p.y) + bf_hi(q.y));
            u32x2 o; o.x = pk_bf16(v[0], v[1]); o.y = pk_bf16(v[2], v[3]); hb[64 * j] = o; s += (v[0] * v[0] + v[1] * v[1]) + (v[2] * v[2] + v[3] * v[3]); }
        s = wave_sum(s); if (F.lane < 16) SSQ[(size_t)row * 16 + F.lane] = F.lane == 0 ? s : 0.f; }
}

__global__ void __launch_bounds__(NTHR, 2) yoco_fwd(Args args) {
    extern __shared__ __attribute__((aligned(16))) unsigned char lds_raw[];
    Frame F; F.lds = (LAS unsigned char*)lds_raw;
    volatile LAS unsigned* MISC = (volatile LAS unsigned*)(F.lds + MISC_OFF);
    F.tid = threadIdx.x; F.lane = F.tid & 63; F.wave = __builtin_amdgcn_readfirstlane(F.tid >> 6);
    F.G = gridDim.x; { const int bx = blockIdx.x; F.vcu = (F.G % 8 == 0) ? (bx % 8) * (F.G / 8) + bx / 8 : bx; }
    for (int u = F.tid; u < (LDS_BYTES - LDSCTL_OFF) / 4; u += NTHR) ((LAS unsigned*)(F.lds + LDSCTL_OFF))[u] = 0u;
    __syncthreads();
    unsigned char* ws = args.ws;
#define WS_LAUNDER() asm volatile("" : "+s"(ws), "+s"(bx), "+s"(F.G), "+s"(F.vcu))
    const bool single = (args.ph_hi - args.ph_lo) > 1;
    XcdBarrier bar; bar.bar = (unsigned*)(ws + WS_CTL) + CW_BAR; bar.x = 0; bar.st = nullptr;
    if (single) bar = xcd_barrier_post((unsigned*)(ws + WS_CTL) + CW_BAR, MISC + 8);
    const int lo = args.ph_lo, hi = args.ph_hi;
#ifndef EN_MASK
#define EN_MASK 0xFFFFFFFFu
#endif
#define EN(b) (((EN_MASK) >> (b)) & 1u)
#define IN(k) (lo <= (k) && (k) < hi)
#ifdef REP_MASK
#define NREPS(k) ((((unsigned long long)(REP_MASK) >> (k)) & 1ull) ? (REP_N) + 1 : 1)
#else
#define NREPS(k) 1
#endif
#define REPLOOP(k) for (int rep_ = 0, nrep_ = NREPS(k); rep_ < nrep_; ++rep_)
#define DUMMY (rep_ + 1 < nrep_)
#define OUT_HB(set) (DUMMY ? (bf16_t*)(ws + WS_END + 66 * MiB) : (bf16_t*)(ws + WS_HB) + (size_t)(set) * MT * DMODEL)
#define OUT_SSQ(set) (DUMMY ? (float*)(ws + WS_END + 99 * MiB) : (float*)(ws + WS_SSQ) + (size_t)(set) * MT * 16)
#define SEAM(k) do { if (single && (k) + 1 < hi) { XcdBarrier b_ = bar; asm volatile("" : "+s"(b_.bar), "+s"(b_.x)); xcd_barrier(b_); } } while (0)

    LAS unsigned char* ring = F.lds + RING_OFF;
    int bx = (int)blockIdx.x;

    if (EN(0) && IN(0)) REPLOOP(0) { prologue(args, F); SEAM(0); }
    if (EN(1) && IN(1)) REPLOOP(1) { WS_LAUNDER();
#pragma unroll 1
        for (int i = 0; i < 4; ++i) {
            pg8::Gemm g{(const bf16_t*)(ws + WS_PB) + (size_t)i * MT * 256, (const bf16_t*)(ws + W_PU) + (size_t)i * 1024 * 256, MT, 1024, 256};
            pg8::StaticOrder S; S.init(MT, 1024, F.G, bx);
            pg8::EpiScale E{(bf16_t*)(ws + WS_U) + (size_t)i * MT * DMODEL, 1024, pg8::RowScale{nullptr, 0}, 1.0f};
            pg8::gemm_phase<pg8::EpiScale, pg8::StaticOrder, true, true>(ring, g, S, E);
        }
        SEAM(1);
    }
#pragma unroll 1
    for (int l = 0; l < 4; ++l) {
        const int base = 2 + PH_PER_LAYER * l; const bool is_mla = l < 2, is_moe = (l & 1) != 0; const int cur = l & 1, j = l & 1;
#define HBc ((const bf16_t*)(ws + WS_HB) + (size_t)cur * MT * DMODEL)
#define HBw ((bf16_t*)(ws + WS_HB) + (size_t)cur * MT * DMODEL)
#define SSQc ((float*)(ws + WS_SSQ) + (size_t)cur * MT * 16)
        if (IN(base + 0)) REPLOOP(base + 0) { WS_LAUNDER();
            if (EN(2) && is_mla) {
                pg8::Gemm g{HBc, (const bf16_t*)(ws + W_AIN) + (size_t)l * 768 * 1024, MT, 768, 1024};
                pg8::StaticOrder S; S.init(MT, 768, F.G, bx);
                pg8::EpiAin E{(bf16_t*)(ws + X_AQ), (bf16_t*)(ws + X_AKV), (float*)(ws + WS_KPE), (float*)(ws + WS_SSQQ), (float*)(ws + WS_SSQKV), pg8::RowScale{SSQc, 1}};
                pg8::gemm_phase<pg8::EpiAin, pg8::StaticOrder, true, true>(ring, g, S, E);
            } else if (EN(3) && !is_mla) {
                pg8::Gemm g{HBc, (const bf16_t*)(ws + W_QB) + (size_t)j * 1024 * 1024, MT, 1024, 1024};
                pg8::StaticOrder S; S.init(MT, 1024, F.G, bx);
                pg8::EpiScale E{(bf16_t*)(ws + X_SQ), 1024, pg8::RowScale{SSQc, 1}, QSCALE_SB};
                pg8::gemm_phase<pg8::EpiScale, pg8::StaticOrder, true, true>(ring, g, S, E);
            }
            SEAM(base + 0);
        }
        if (EN(4) && is_mla && IN(base + 1)) REPLOOP(base + 1) { WS_LAUNDER();
            { pg8::Gemm g{(const bf16_t*)(ws + X_AQ), (const bf16_t*)(ws + W_QUP) + (size_t)l * 768 * 384, MT, 768, 384};
              pg8::StaticOrder S; S.init(MT, 768, F.G, bx);
              pg8::EpiScale E{(bf16_t*)(ws + X_QRAW), 768, pg8::RowScale{(const float*)(ws + WS_SSQQ), 3}, 1.0f};
              pg8::gemm_phase<pg8::EpiScale, pg8::StaticOrder, true, true>(ring, g, S, E); }
            { pg8::Gemm g{(const bf16_t*)(ws + X_AKV), (const bf16_t*)(ws + W_KVUP) + (size_t)l * 1024 * 256, MT, 1024, 256};
              pg8::StaticOrder S; S.init(MT, 1024, F.G, bx);
              pg8::EpiScale E{(bf16_t*)(ws + X_KVRAW), 1024, pg8::RowScale{(const float*)(ws + WS_SSQKV), 4}, 1.0f};
              pg8::gemm_phase<pg8::EpiScale, pg8::StaticOrder, true, true>(ring, g, S, E); }
            SEAM(base + 1);
        }
        if (EN(5) && is_mla && IN(base + 2)) REPLOOP(base + 2) { mla_prep(args, F, l); SEAM(base + 2); }
        if (IN(base + 3)) REPLOOP(base + 3) { WS_LAUNDER();
            if (EN(6) && is_mla) att::mla::phase(F.vcu, F.G, (const bf16_t*)(ws + X_Q), (const bf16_t*)(ws + X_KT), (const bf16_t*)(ws + X_VT), (bf16_t*)(ws + X_O), ring);
            else if (EN(7) && !is_mla) att::sba::phase(F.vcu, F.G, (const bf16_t*)(ws + X_SQ), (const bf16_t*)(ws + WS_SKT), (const bf16_t*)(ws + WS_SVT), (bf16_t*)(ws + X_SO), ring);
            SEAM(base + 3);
        }
        if (EN(8) && IN(base + 4)) REPLOOP(base + 4) { WS_LAUNDER();
            pg8::Gemm g = is_mla ? pg8::Gemm{(const bf16_t*)(ws + X_O), (const bf16_t*)(ws + W_AOUT) + (size_t)l * 1024 * 512, MT, 1024, 512}
                                 : pg8::Gemm{(const bf16_t*)(ws + X_SO), (const bf16_t*)(ws + W_OB) + (size_t)j * 1024 * 1024, MT, 1024, 1024};
            pg8::StaticOrder S; S.init(MT, 1024, F.G, bx);
            pg8::EpiRes<false> E{HBc, OUT_HB(cur), OUT_SSQ(cur), nullptr, pg8::RowScale{nullptr, 0}, nullptr};
            pg8::gemm_phase<pg8::EpiRes<false>, pg8::StaticOrder, true, true>(ring, g, S, E);
            SEAM(base + 4);
        }
        if (!is_moe) {
            if (EN(9) && IN(base + 5)) REPLOOP(base + 5) { WS_LAUNDER();
                pg8::Gemm g{HBc, (const bf16_t*)(ws + W_FGU) + (size_t)(l >> 1) * 5632 * 1024, MT, 5632, 1024};
                pg8::GroupOrder S; S.init_dense(MT, 5632, F.G, bx);
                pg8::EpiSwiglu E{(bf16_t*)(ws + X_HID), pg8::RowScale{SSQc, 1}};
                pg8::gemm_phase<pg8::EpiSwiglu, pg8::GroupOrder, true, true>(ring, g, S, E);
                SEAM(base + 5);
            }
            if (EN(10) && IN(base + 6)) REPLOOP(base + 6) { WS_LAUNDER();
                pg8::Gemm g{(const bf16_t*)(ws + X_HID), (const bf16_t*)(ws + W_FDN) + (size_t)(l >> 1) * 1024 * 2816, MT, 1024, 2816};
                pg8::StaticOrder S; S.init(MT, 1024, F.G, bx);
                pg8::EpiRes<false> E{HBc, OUT_HB(cur), OUT_SSQ(cur), nullptr, pg8::RowScale{nullptr, 0}, nullptr};
                pg8::gemm_phase<pg8::EpiRes<false>, pg8::StaticOrder, true, true>(ring, g, S, E);
                SEAM(base + 6);
            }
        } else {
            if (EN(11) && IN(base + 5)) REPLOOP(base + 5) { WS_LAUNDER(); moe_route(args, F, l, cur); SEAM(base + 5); }
            if (EN(12) && IN(base + 6)) REPLOOP(base + 6) { WS_LAUNDER(); moe_scatter(args, F, cur); SEAM(base + 6); }
            if (EN(13) && IN(base + 7)) REPLOOP(base + 7) { WS_LAUNDER();
                pg8::Gemm g{(const bf16_t*)(ws + X_XG), (const bf16_t*)(ws + W_EGU) + (size_t)(l >> 1) * 8 * 5632 * 1024, MAXSLOT, 5632, 1024};
                pg8::GroupOrder S; S.init((const int*)(ws + WS_PSTART), 5632, F.G, bx, (size_t)5632 * 1024 * 2);
                pg8::EpiSwiglu E{(bf16_t*)(ws + X_HG), pg8::RowScale{(const float*)(ws + WS_SLOTRS), 2}};
                pg8::gemm_phase<pg8::EpiSwiglu, pg8::GroupOrder, true, true>(ring, g, S, E);
                SEAM(base + 7);
            }
            if (EN(14) && IN(base + 8)) REPLOOP(base + 8) { WS_LAUNDER();
                pg8::Gemm g{(const bf16_t*)(ws + X_HG), (const bf16_t*)(ws + W_EDN) + (size_t)(l >> 1) * 8 * 1024 * 2816, MAXSLOT, 1024, 2816};
                pg8::GroupOrder S; S.init((const int*)(ws + WS_PSTART), 1024, F.G, bx, (size_t)1024 * 2816 * 2);
                pg8::EpiScale E{(bf16_t*)(ws + X_YG), 1024, pg8::RowScale{(const float*)(ws + WS_SLOTG), 2}, 1.0f};
                pg8::gemm_phase<pg8::EpiScale, pg8::GroupOrder, true, true>(ring, g, S, E);
                SEAM(base + 8);
            }
            if (EN(15) && IN(base + 9)) REPLOOP(base + 9) { WS_LAUNDER(); moe_combine(args, F, cur, DUMMY); SEAM(base + 9); }
        }
        if (EN(16) && IN(base + 10)) REPLOOP(base + 10) { WS_LAUNDER();
            pg8::Gemm g{HBc, (const bf16_t*)(ws + W_PG) + (size_t)l * 1024 * 1024, MT, 1024, 1024};
            pg8::StaticOrder S; S.init(MT, 1024, F.G, bx);
            pg8::EpiRes<true> E{HBc, OUT_HB(cur ^ 1), OUT_SSQ(cur ^ 1),
                                (const bf16_t*)(ws + WS_U) + (size_t)l * MT * DMODEL, pg8::RowScale{SSQc, 1}, (l == 3 && !DUMMY) ? args.out : nullptr};
            pg8::gemm_phase<pg8::EpiRes<true>, pg8::StaticOrder, true, true>(ring, g, S, E);
            SEAM(base + 10);
        }
        if (EN(17) && l == 1 && IN(base + 11)) REPLOOP(base + 11) { WS_LAUNDER();
            pg8::Gemm g{(const bf16_t*)(ws + WS_HB) + (size_t)(cur ^ 1) * MT * DMODEL, (const bf16_t*)(ws + W_KVS), MT, 512, 1024};
            pg8::StaticOrder S; S.init(MT, 512, F.G, bx);
            pg8::EpiKvs E{(bf16_t*)(ws + WS_SKT), (bf16_t*)(ws + WS_SVT), pg8::RowScale{(const float*)(ws + WS_SSQ) + (size_t)(cur ^ 1) * MT * 16, 1}};
            pg8::gemm_phase<pg8::EpiKvs, pg8::StaticOrder, true, true>(ring, g, S, E);
            SEAM(base + 11);
        }
    }
#undef IN
#undef SEAM
}
}
#define MULTI_LAUNCH 0
extern "C" void kernel_launch(void* const* d_in, const int* in_sizes, int n_in, void* d_out, int out_size, void* d_ws, size_t ws_size, hipStream_t stream) {
    using namespace fw;
    static int grid = 0;
    if (grid == 0) {
        if (n_in != 26 || out_size != MT * DMODEL || ws_size < WS_END) { fprintf(stderr, "kernel_launch: unexpected n_in %d / out %d / ws %zu\n", n_in, out_size, ws_size); grid = -1; return; }
        if (hipFuncSetAttribute((const void*)yoco_fwd, hipFuncAttributeMaxDynamicSharedMemorySize, LDS_BYTES) != hipSuccess) { fprintf(stderr, "kernel_launch: hipFuncSetAttribute failed\n"); grid = -1; return; }
        int dev = 0, cus = 0, per_cu = 0;
        (void)hipGetDevice(&dev); (void)hipDeviceGetAttribute(&cus, hipDeviceAttributeMultiprocessorCount, dev);
        (void)hipOccupancyMaxActiveBlocksPerMultiprocessor(&per_cu, (const void*)yoco_fwd, NTHR, LDS_BYTES);
        (void)hipGetLastError();
        grid = (cus > 0 && per_cu >= 1) ? cus : 256;
        if (grid > 256) grid = 256;
    }
    if (grid < 0) return;
    (void)hipMemsetAsync((unsigned char*)d_ws + WS_CTL, 0, CTL_ZERO_BYTES, stream);
    Args a{};
    for (int i = 0; i < 26; ++i) a.in[i] = (const float*)d_in[i];
    a.out = (float*)d_out; a.ws = (unsigned char*)d_ws;
#if MULTI_LAUNCH
    for (int k = 0; k < PH_TOTAL; ++k) { if (!phase_active(k)) continue; a.ph_lo = k; a.ph_hi = k + 1; hipLaunchKernelGGL(yoco_fwd, dim3(grid), dim3(NTHR), LDS_BYTES, stream, a); }
#else
#ifdef PROBE_MASK
    a.ph_lo = 0; a.ph_hi = PH_TOTAL;
#else
    a.ph_lo = 0; a.ph_hi = PH_TOTAL - 1;
#endif
    hipLaunchKernelGGL(yoco_fwd, dim3(grid), dim3(NTHR), LDS_BYTES, stream, a);
#endif
}
```

```cpp
#include <hip/hip_runtime.h>
#include <cstdio>
#include <cstdint>
#include <cmath>
#define LAS __attribute__((address_space(3)))
#define GAS __attribute__((address_space(1)))
typedef unsigned short bf16_t;
typedef short bf16x8 __attribute__((ext_vector_type(8)));
typedef float f32x4 __attribute__((ext_vector_type(4)));
typedef float f32x2 __attribute__((ext_vector_type(2)));
typedef float f32x16 __attribute__((ext_vector_type(16)));
typedef unsigned u32x4 __attribute__((ext_vector_type(4)));
typedef unsigned u32x2 __attribute__((ext_vector_type(2)));
typedef short s16x4 __attribute__((ext_vector_type(4)));
typedef __bf16 bf16x2_t __attribute__((ext_vector_type(2)));

constexpr int MT = 16384, DMODEL = 1024, SEQL = 8192;
constexpr float RMS_EPS = 1e-6f;
constexpr float LOG2E = 1.4426950408889634f;

__device__ __forceinline__ unsigned pk_bf16(float lo, float hi) { f32x2 v = {lo, hi}; bf16x2_t b = __builtin_convertvector(v, bf16x2_t); return __builtin_bit_cast(unsigned, b); }
__device__ __forceinline__ float bf_lo(unsigned w) { return __uint_as_float(w << 16); }
__device__ __forceinline__ float bf_hi(unsigned w) { return __uint_as_float(w & 0xffff0000u); }
__device__ __forceinline__ unsigned cvt_pk_bf16(float lo, float hi) { unsigned r; asm volatile("v_cvt_pk_bf16_f32 %0, %1, %2" : "=v"(r) : "v"(lo), "v"(hi)); return r; }
__device__ __forceinline__ u32x4 pack8(const f32x4 a, const f32x4 b) { u32x4 w; w.x = cvt_pk_bf16(a[0], a[1]); w.y = cvt_pk_bf16(a[2], a[3]); w.z = cvt_pk_bf16(b[0], b[1]); w.w = cvt_pk_bf16(b[2], b[3]); return w; }
__device__ __forceinline__ void unpack8(const u32x4 w, f32x4& a, f32x4& b) { a = (f32x4){bf_lo(w.x), bf_hi(w.x), bf_lo(w.y), bf_hi(w.y)}; b = (f32x4){bf_lo(w.z), bf_hi(w.z), bf_lo(w.w), bf_hi(w.w)}; }
__device__ __forceinline__ float fast_rcp(float x) { return __builtin_amdgcn_rcpf(x); }
__device__ __forceinline__ float fast_exp2(float x) { return __builtin_amdgcn_exp2f(x); }
__device__ __forceinline__ float fast_log2(float x) { return __builtin_amdgcn_logf(x); }
__device__ __forceinline__ float sigmoidf_(float x) { return fast_rcp(1.0f + fast_exp2(-x * LOG2E)); }

namespace pg8 {
constexpr int BM = 256, BK = 64, HALF = 128, HTB = HALF * BK * 2, STAGE_BYTES = 8 * HTB, NXCD = 8, WGM = 8;
__host__ __device__ __forceinline__ int lds_byte(int r, int c) { const int st = (r >> 4) * 2 + (c >> 5), rr = r & 15, cc = c & 31, ob = rr * 64 + cc * 2; return st * 1024 + (ob ^ (((ob >> 9) & 1) << 5)); }
__host__ __device__ __forceinline__ void stage_rc(int b, int& R, int& C) { const int st = b / 1024, sb = b % 1024, swz = sb ^ (((sb >> 9) & 1) << 5); R = (st >> 1) * 16 + swz / 64; C = (st & 1) * 32 + (swz % 64) / 2; }
__host__ __device__ __forceinline__ int perm32(int rho) { const int n = rho >> 4, i = rho & 15; return 8 * (i >> 2) + 4 * n + (i & 3); }

struct Unit { int pm, pn; size_t boff; };
struct Gemm { const bf16_t* A; const bf16_t* Bt; int M, N, K; };

struct StaticOrder {
    int nM, nN, nwg, G, c;
    __device__ void init(int M, int N, int G_, int c_) { nM = M / BM; nN = N / BM; nwg = nM * nN; G = G_; c = c_; }
    __device__ bool next(int i, Unit& u) const {
        const long L = (long)i * G + c; if (L >= nwg) return false;
        int wgid = (int)L; { const int q = nwg / NXCD, r = nwg % NXCD, xcd = wgid % NXCD, off = wgid / NXCD; wgid = (xcd < r ? xcd * (q + 1) : r * (q + 1) + (xcd - r) * q) + off; }
        const int nig = WGM * nN, gid = wgid / nig, fm = gid * WGM, gsz = (nM - fm) < WGM ? (nM - fm) : WGM;
        u.pm = fm + ((wgid % nig) % gsz); u.pn = (wgid % nig) / gsz; u.boff = 0; return true;
    }
};
struct GroupOrder {
    int ps[9]; int nN, nwg, G, c; size_t estride;
    __device__ void init(const int* pstart, int N, int G_, int c_, size_t estride_) {
#pragma unroll
        for (int e = 0; e < 9; ++e) ps[e] = __builtin_amdgcn_readfirstlane(pstart[e]);
        nN = N / BM; nwg = ps[8] * nN; G = G_; c = c_; estride = estride_; }
    __device__ void init_dense(int M, int N, int G_, int c_) {
        ps[0] = 0;
#pragma unroll
        for (int e = 1; e < 9; ++e) ps[e] = M / BM;
        nN = N / BM; nwg = ps[8] * nN; G = G_; c = c_; estride = 0; }
    __device__ bool next(int i, Unit& u) const {
        const long L = (long)i * G + c; if (L >= nwg) return false;
        int wgid = (int)L; { const int q = nwg / NXCD, r = nwg % NXCD, xcd = wgid % NXCD, off = wgid / NXCD; wgid = (xcd < r ? xcd * (q + 1) : r * (q + 1) + (xcd - r) * q) + off; }
        int e = 0;
#pragma unroll
        for (int k = 1; k < 8; ++k) if (wgid >= ps[k] * nN) e = k;
        int p0 = ps[0], p1 = ps[1];
#pragma unroll
        for (int k = 1; k < 8; ++k) if (e == k) { p0 = ps[k]; p1 = ps[k + 1]; }
        const int local = wgid - p0 * nN, np = p1 - p0;
        u.pn = local / np; u.pm = p0 + (local % np); u.boff = (size_t)e * estride; return true;
    }
};


__device__ __forceinline__ float sumsq8(const f32x4 a, const f32x4 b) { return ((a[0] * a[0] + a[1] * a[1]) + (a[2] * a[2] + a[3] * a[3])) + ((b[0] * b[0] + b[1] * b[1]) + (b[2] * b[2] + b[3] * b[3])); }
__device__ __forceinline__ float red_fq(float s) { s += __shfl_xor(s, 16); s += __shfl_xor(s, 32); return s; }
struct RowScale {
    const float* p; int mode;
    __device__ __forceinline__ float get(int row, int fq) const {
        if (mode == 0) return 1.0f;
        if (mode == 2) return p[row];
        if (mode == 1) { const f32x4 a = *(const f32x4*)(p + (size_t)row * 16 + 4 * fq); const float s = red_fq((a[0] + a[1]) + (a[2] + a[3])); return 1.0f / sqrtf(s * (1.0f / 1024.0f) + RMS_EPS); }
        if (mode == 3) { const f32x4 a = *(const f32x4*)(p + (size_t)row * 8 + 4 * (fq & 1)); const float s = red_fq(fq < 2 ? (a[0] + a[1]) + (a[2] + a[3]) : 0.f); return 1.0f / sqrtf(s * (1.0f / 384.0f) + RMS_EPS); }
        { const float s = red_fq(p[(size_t)row * 4 + fq]); return 1.0f / sqrtf(s * (1.0f / 256.0f) + RMS_EPS); }
    }
    __device__ __forceinline__ void get8(float (&rsv)[2][4], int row0, int fq) const {
#pragma unroll
        for (int ai = 0; ai < 2; ++ai)
#pragma unroll
            for (int m = 0; m < 4; ++m) rsv[ai][m] = get(row0 + ai * 128 + m * 16, fq);
        asm volatile("" ::: "memory");
    }
};

struct EpiScale {
    static constexpr bool PERM = true, AFTER_DRAIN = false;
    bf16_t* O; int ldc; RowScale rs; float cs;
    __device__ __forceinline__ void operator()(const f32x4 (&acc)[2][2][4][2], const Unit& u, int wr, int wc, int fr, int fq) const {
        const int row0 = u.pm * BM + wr * 64 + fr, col0 = u.pn * BM + wc * 32 + 8 * fq;
        float rsv[2][4]; rs.get8(rsv, row0, fq);
#pragma unroll
        for (int ai = 0; ai < 2; ++ai)
#pragma unroll
            for (int m = 0; m < 4; ++m) { const int row = row0 + ai * HALF + m * 16; const float s = rsv[ai][m] * cs; bf16_t* rowp = O + (size_t)row * ldc + col0;
#pragma unroll
                for (int bj = 0; bj < 2; ++bj) *(u32x4*)(rowp + bj * HALF) = pack8(acc[ai][bj][m][0] * s, acc[ai][bj][m][1] * s); }
    }
};
struct EpiAin {
    static constexpr bool PERM = true, AFTER_DRAIN = false;
    bf16_t* AQ; bf16_t* AKV; float* KPE; float* SSQQ; float* SSQKV; RowScale rs;
    __device__ __forceinline__ void operator()(const f32x4 (&acc)[2][2][4][2], const Unit& u, int wr, int wc, int fr, int fq) const {
        const int row0 = u.pm * BM + wr * 64 + fr, c8 = wc * 32 + 8 * fq;
        float rsv[2][4]; rs.get8(rsv, row0, fq);
#pragma unroll
        for (int ai = 0; ai < 2; ++ai)
#pragma unroll
            for (int m = 0; m < 4; ++m) { const int row = row0 + ai * HALF + m * 16; const float s = rsv[ai][m];
                const f32x4 a0 = acc[ai][0][m][0] * s, a1 = acc[ai][0][m][1] * s, b0 = acc[ai][1][m][0] * s, b1 = acc[ai][1][m][1] * s;
                if (u.pn == 0) {
                    *(u32x4*)(AQ + (size_t)row * 384 + c8) = pack8(a0, a1); *(u32x4*)(AQ + (size_t)row * 384 + 128 + c8) = pack8(b0, b1);
                    const float q = red_fq(sumsq8(a0, a1) + sumsq8(b0, b1)); if (fq == 0) SSQQ[(size_t)row * 8 + wc] = q;
                } else if (u.pn == 1) {
                    *(u32x4*)(AQ + (size_t)row * 384 + 256 + c8) = pack8(a0, a1);
                    const float q = red_fq(sumsq8(a0, a1)); if (fq == 0) SSQQ[(size_t)row * 8 + 4 + wc] = q;
                    if (wc == 0) { *(f32x4*)(KPE + (size_t)row * 32 + 8 * fq) = b0; *(f32x4*)(KPE + (size_t)row * 32 + 8 * fq + 4) = b1; }
                } else {
                    *(u32x4*)(AKV + (size_t)row * 256 + c8) = pack8(a0, a1); *(u32x4*)(AKV + (size_t)row * 256 + 128 + c8) = pack8(b0, b1);
                    const float q = red_fq(sumsq8(a0, a1) + sumsq8(b0, b1)); if (fq == 0) SSQKV[(size_t)row * 4 + wc] = q;
                } }
    }
};
struct EpiSwiglu {
    static constexpr bool PERM = true, AFTER_DRAIN = false;
    bf16_t* HID; RowScale rs;
    __device__ __forceinline__ void operator()(const f32x4 (&acc)[2][2][4][2], const Unit& u, int wr, int wc, int fr, int fq) const {
        const int row0 = u.pm * BM + wr * 64 + fr, col0 = u.pn * 128 + wc * 32 + 8 * fq;
        float rsv[2][4]; rs.get8(rsv, row0, fq);
#pragma unroll
        for (int ai = 0; ai < 2; ++ai)
#pragma unroll
            for (int m = 0; m < 4; ++m) { const int row = row0 + ai * HALF + m * 16; const float s = rsv[ai][m];
                f32x4 o[2];
#pragma unroll
                for (int n = 0; n < 2; ++n) { const f32x4 g = acc[ai][0][m][n] * s, up = acc[ai][1][m][n] * s;
#pragma unroll
                    for (int j = 0; j < 4; ++j) o[n][j] = g[j] * sigmoidf_(g[j]) * up[j]; }
                *(u32x4*)(HID + (size_t)row * 2816 + col0) = pack8(o[0], o[1]); }
    }
};
template <bool GATED> struct EpiRes {
    static constexpr bool PERM = true, AFTER_DRAIN = false;
    const bf16_t* HBi; bf16_t* HBo; float* SSQo; const bf16_t* U; RowScale rs; float* OUTF;
    __device__ __forceinline__ void operator()(const f32x4 (&acc)[2][2][4][2], const Unit& u, int wr, int wc, int fr, int fq) const {
        const int row0 = u.pm * BM + wr * 64 + fr, col0 = u.pn * BM + wc * 32 + 8 * fq;
        float rsv[2][4]; if (GATED) rs.get8(rsv, row0, fq);
#pragma unroll
        for (int ai = 0; ai < 2; ++ai)
#pragma unroll
            for (int m = 0; m < 4; ++m) { const int row = row0 + ai * HALF + m * 16; const size_t off = (size_t)row * DMODEL + col0;
                float s = 1.0f; if (GATED) s = rsv[ai][m];
                float q = 0.f;
#pragma unroll
                for (int bj = 0; bj < 2; ++bj) { f32x4 a0 = acc[ai][bj][m][0], a1 = acc[ai][bj][m][1];
                    f32x4 h0, h1; unpack8(*(const u32x4*)(HBi + off + bj * HALF), h0, h1);
                    if (GATED) { f32x4 u0, u1; unpack8(*(const u32x4*)(U + off + bj * HALF), u0, u1);
#pragma unroll
                        for (int j = 0; j < 4; ++j) { a0[j] = sigmoidf_(a0[j] * s) * u0[j]; a1[j] = sigmoidf_(a1[j] * s) * u1[j]; } }
                    h0 += a0; h1 += a1;
                    if (GATED) { if (OUTF) { *(f32x4*)(OUTF + off + bj * HALF) = h0; *(f32x4*)(OUTF + off + bj * HALF + 4) = h1; } }
                    *(u32x4*)(HBo + off + bj * HALF) = pack8(h0, h1);
                    q += sumsq8(h0, h1); }
                q = red_fq(q); if (fq == 0) SSQo[(size_t)row * 16 + u.pn * 4 + wc] = q;
                asm volatile("" ::: "memory"); }
    }
};
struct EpiKvs {
    static constexpr bool PERM = true, AFTER_DRAIN = false;
    bf16_t* KT; bf16_t* VT; RowScale rs;
    __device__ __forceinline__ void operator()(const f32x4 (&acc)[2][2][4][2], const Unit& u, int wr, int wc, int fr, int fq) const {
        const int row0 = u.pm * BM + wr * 64 + fr;
        float rsv[2][4]; rs.get8(rsv, row0, fq);
#pragma unroll
        for (int ai = 0; ai < 2; ++ai)
#pragma unroll
            for (int m = 0; m < 4; ++m) { const int row = row0 + ai * HALF + m * 16; const float s = rsv[ai][m];
                const int b = row >> 13, sq = row & 8191, tile = sq >> 6, rr = sq & 63;
#pragma unroll
                for (int bj = 0; bj < 2; ++bj) { const int c = bj * HALF + wc * 32 + 8 * fq, kh = c >> 6, d = c & 63;
                    const size_t tb = (size_t)((b * 4 + kh) * 128 + tile) * 4096;
                    const u32x4 w = pack8(acc[ai][bj][m][0] * s, acc[ai][bj][m][1] * s);
                    if (u.pn == 0) *(u32x4*)(KT + tb + (d >> 3) * 512 + rr * 8) = w;
                    else *(u32x4*)(VT + tb + (d >> 5) * 2048 + rr * 32 + (d & 31)) = w; } }
    }
};

#define PG8_LAS LAS
template <class Epi, class Sched, bool ALIGN_EPI = false, bool SP2 = false>
__device__ __forceinline__ void gemm_phase(PG8_LAS unsigned char* lds, const Gemm g, const Sched& S, const Epi& E) {
    int tid_ = threadIdx.x; asm volatile("" : "+v"(tid_));
    const int tid = tid_, wid = __builtin_amdgcn_readfirstlane(tid >> 6), lane = tid & 63, wr = wid >> 2, wc = wid & 3, fr = lane & 15, fq = lane >> 4;
    const int K = g.K, nt = K / BK;
    unsigned voffA[2], voffB[2];
#pragma unroll
    for (int i = 0; i < 2; ++i) { int R, C; stage_rc(tid * 16 + i * 8192, R, C); const int Rb = Epi::PERM ? ((R & ~31) + perm32(R & 31)) : R;
        voffA[i] = (unsigned)(R * K + C) * 2u; voffB[i] = (unsigned)(Rb * K + C) * 2u; }
    const size_t kstep = (size_t)(BK * 2);
    const size_t hstep = (size_t)HALF * K * 2;
    const size_t tstep = 2 * hstep;
    const unsigned ldsw = (unsigned)wid * 1024u;
    const int aoff = lds_byte(wr * 64 + fr, fq * 8), boff = lds_byte(wc * 32 + fr, fq * 8);
#define PG8_SA(b, h) (((b) * 2 + (h)) * HTB)
#define PG8_SB(b, h) ((4 + (b) * 2 + (h)) * HTB)
#define PG8_STAGE(bufoff, gbase, voff) do { _Pragma("unroll") for (int _i = 0; _i < 2; ++_i) \
        __builtin_amdgcn_global_load_lds((const unsigned*)((const char*)(gbase) + (voff)[_i]), (PG8_LAS unsigned*)(lds + (bufoff) + ldsw + _i * 8192), 16, 0, 0); } while (0)
#define PG8_LDA(dst, b, h) do { _Pragma("unroll") for (int m = 0; m < 4; ++m) _Pragma("unroll") for (int k = 0; k < 2; ++k) dst[m][k] = *(const PG8_LAS bf16x8*)(lds + PG8_SA(b, h) + aoff + m * 2048 + k * 1024); } while (0)
#define PG8_LDB(dst, b, h) do { _Pragma("unroll") for (int n = 0; n < 2; ++n) _Pragma("unroll") for (int k = 0; k < 2; ++k) dst[n][k] = *(const PG8_LAS bf16x8*)(lds + PG8_SB(b, h) + boff + n * 2048 + k * 1024); } while (0)
#define PG8_MMA(ai, bj, At, Bt) do { __builtin_amdgcn_s_setprio(1); _Pragma("unroll") for (int m = 0; m < 4; ++m) _Pragma("unroll") for (int n = 0; n < 2; ++n) _Pragma("unroll") for (int k = 0; k < 2; ++k) \
        acc[ai][bj][m][n] = __builtin_amdgcn_mfma_f32_16x16x32_bf16(Bt[n][k], At[m][k], acc[ai][bj][m][n], 0, 0, 0); __builtin_amdgcn_s_setprio(0); } while (0)
#define PG8_WAIT_V(n) asm volatile("s_waitcnt vmcnt(" #n ")" ::: "memory")
#define PG8_WAIT_L(n) asm volatile("s_waitcnt lgkmcnt(" #n ")" ::: "memory")
#define PG8_BAR __builtin_amdgcn_s_barrier()
#define PG8_SCHED __builtin_amdgcn_sched_barrier(0)
    Unit cur, nxt; int ui = 0;
    if (!S.next(0, cur)) return;
    f32x4 acc[2][2][4][2];
#pragma unroll
    for (int a = 0; a < 2; ++a)
#pragma unroll
        for (int b = 0; b < 2; ++b)
#pragma unroll
            for (int m = 0; m < 4; ++m)
#pragma unroll
                for (int n = 0; n < 2; ++n) acc[a][b][m][n] = (f32x4){0.f, 0.f, 0.f, 0.f};
    bf16x8 At[4][2], B0[2][2], B1[2][2];
    const char* cA = (const char*)g.A + (size_t)cur.pm * tstep; const char* cB = (const char*)g.Bt + cur.boff + (size_t)cur.pn * tstep;
    if constexpr (SP2) {
        PG8_STAGE(PG8_SB(0, 0), cB, voffB); PG8_STAGE(PG8_SB(0, 1), cB + hstep, voffB); PG8_STAGE(PG8_SA(0, 0), cA, voffA); PG8_STAGE(PG8_SA(0, 1), cA + hstep, voffA);
        if (wr == 1) PG8_BAR;
        PG8_WAIT_V(2); PG8_BAR;
        PG8_STAGE(PG8_SB(1, 0), cB + kstep, voffB); PG8_STAGE(PG8_SA(1, 0), cA + kstep, voffA); PG8_STAGE(PG8_SB(1, 1), cB + hstep + kstep, voffB);
        PG8_WAIT_V(6); PG8_BAR;
    } else {
        PG8_STAGE(PG8_SB(0, 0), cB, voffB); PG8_STAGE(PG8_SA(0, 0), cA, voffA); PG8_STAGE(PG8_SB(0, 1), cB + hstep, voffB); PG8_STAGE(PG8_SA(0, 1), cA + hstep, voffA);
        if (wr == 1) PG8_BAR;
        PG8_WAIT_V(4); PG8_BAR;
        PG8_STAGE(PG8_SB(1, 0), cB + kstep, voffB); PG8_STAGE(PG8_SA(1, 0), cA + kstep, voffA); PG8_STAGE(PG8_SB(1, 1), cB + hstep + kstep, voffB);
        PG8_WAIT_V(6); PG8_BAR;
    }
    for (;;) {
        const bool has_next = S.next(ui + 1, nxt);
        const char* nA = has_next ? (const char*)g.A + (size_t)nxt.pm * tstep : cA; const char* nB = has_next ? (const char*)g.Bt + nxt.boff + (size_t)nxt.pn * tstep : cB;
        for (int t = 0; t < nt; t += 2) {
            const bool last = (t == nt - 2);
            const char* a1 = cA + (size_t)(t + 1) * kstep;
            const char* a2 = last ? nA : cA + (size_t)(t + 2) * kstep; const char* b2 = last ? nB : cB + (size_t)(t + 2) * kstep;
            const char* a3 = a2 + kstep; const char* b3 = b2 + kstep;
            if constexpr (SP2) {
            PG8_LDB(B0, 0, 0); PG8_LDB(B1, 0, 1); PG8_SCHED; PG8_LDA(At, 0, 0); PG8_STAGE(PG8_SA(1, 1), a1 + hstep, voffA);
            PG8_WAIT_V(8); PG8_WAIT_L(0); PG8_BAR; PG8_MMA(0, 0, At, B0); PG8_MMA(0, 1, At, B1); PG8_BAR; PG8_SCHED;
            PG8_LDA(At, 0, 1); PG8_STAGE(PG8_SB(0, 0), b2, voffB); PG8_STAGE(PG8_SB(0, 1), b2 + hstep, voffB); PG8_STAGE(PG8_SA(0, 0), a2, voffA);
            PG8_WAIT_V(8); PG8_WAIT_L(0); PG8_BAR; PG8_MMA(1, 0, At, B0); PG8_MMA(1, 1, At, B1); PG8_BAR; PG8_SCHED;
            PG8_LDB(B0, 1, 0); PG8_LDB(B1, 1, 1); PG8_SCHED; PG8_LDA(At, 1, 0); PG8_STAGE(PG8_SA(0, 1), a2 + hstep, voffA);
            PG8_WAIT_V(8); PG8_WAIT_L(0); PG8_BAR; PG8_MMA(0, 0, At, B0); PG8_MMA(0, 1, At, B1); PG8_BAR; PG8_SCHED;
            PG8_LDA(At, 1, 1); PG8_STAGE(PG8_SB(1, 0), b3, voffB); PG8_STAGE(PG8_SB(1, 1), b3 + hstep, voffB); PG8_STAGE(PG8_SA(1, 0), a3, voffA);
            PG8_WAIT_V(8); PG8_WAIT_L(0); PG8_BAR; PG8_MMA(1, 0, At, B0); PG8_MMA(1, 1, At, B1); PG8_BAR; PG8_SCHED;
            } else {
            PG8_LDB(B0, 0, 0); PG8_SCHED; PG8_LDA(At, 0, 0); PG8_STAGE(PG8_SA(1, 1), a1 + hstep, voffA);
            PG8_WAIT_L(8); PG8_BAR; PG8_WAIT_L(0); PG8_MMA(0, 0, At, B0); PG8_BAR; PG8_SCHED;
            PG8_LDB(B1, 0, 1); PG8_STAGE(PG8_SB(0, 0), b2, voffB);
            PG8_BAR; PG8_WAIT_L(0); PG8_MMA(0, 1, At, B1); PG8_BAR;
            PG8_LDA(At, 0, 1); PG8_STAGE(PG8_SA(0, 0), a2, voffA);
            PG8_BAR; PG8_WAIT_L(0); PG8_MMA(1, 0, At, B0); PG8_BAR; PG8_SCHED;
            PG8_STAGE(PG8_SB(0, 1), b2 + hstep, voffB);
            PG8_WAIT_V(6); PG8_BAR; PG8_MMA(1, 1, At, B1); PG8_BAR;
            PG8_LDB(B0, 1, 0); PG8_SCHED; PG8_LDA(At, 1, 0); PG8_STAGE(PG8_SA(0, 1), a2 + hstep, voffA);
            PG8_WAIT_L(8); PG8_BAR; PG8_WAIT_L(0); PG8_MMA(0, 0, At, B0); PG8_BAR; PG8_SCHED;
            PG8_LDB(B1, 1, 1); PG8_STAGE(PG8_SB(1, 0), b3, voffB);
            PG8_BAR; PG8_WAIT_L(0); PG8_MMA(0, 1, At, B1); PG8_BAR;
            PG8_LDA(At, 1, 1); PG8_STAGE(PG8_SA(1, 0), a3, voffA);
            PG8_BAR; PG8_WAIT_L(0); PG8_MMA(1, 0, At, B0); PG8_BAR; PG8_SCHED;
            PG8_STAGE(PG8_SB(1, 1), b3 + hstep, voffB);
            PG8_WAIT_V(6); PG8_BAR; PG8_MMA(1, 1, At, B1); PG8_BAR;
            }
        }
        if constexpr (ALIGN_EPI) { if (wr == 0) PG8_BAR; }
        E(acc, cur, wr, wc, fr, fq);
        if (!has_next) break;
#pragma unroll
        for (int a = 0; a < 2; ++a)
#pragma unroll
            for (int b = 0; b < 2; ++b)
#pragma unroll
                for (int m = 0; m < 4; ++m)
#pragma unroll
                    for (int n = 0; n < 2; ++n) acc[a][b][m][n] = (f32x4){0.f, 0.f, 0.f, 0.f};
        cur = nxt; cA = nA; cB = nB; ++ui;
        if constexpr (ALIGN_EPI) { if (wr == 1) PG8_BAR; }
    }
    PG8_WAIT_V(0);
    if constexpr (!ALIGN_EPI) { if (wr == 0) PG8_BAR; }
    PG8_BAR;
#undef PG8_SA
#undef PG8_SB
#undef PG8_STAGE
#undef PG8_LDA
#undef PG8_LDB
#undef PG8_MMA
#undef PG8_WAIT_V
#undef PG8_WAIT_L
#undef PG8_BAR
#undef PG8_SCHED
}
}
typedef GAS unsigned gu32;
#define RLX_AGENT __ATOMIC_RELAXED, __HIP_MEMORY_SCOPE_AGENT
#define XB_TMO      128
#define XB_XCNT(j)  (256  + 64 * (j))
#define XB_XSUB(j)  (1280 + 64 * (j))
#define XB_XGEN(j)  (2304 + 64 * (j))
#define XB_TOP      3328
#define XB_TOPGEN   3392
#define XCD_BAR_WORDS 3456
#define XB_SPIN_CAP (1u << 18)

__device__ __forceinline__ unsigned xb_ld(unsigned* p)              { return __hip_atomic_load(p, __ATOMIC_RELAXED, __HIP_MEMORY_SCOPE_AGENT); }
__device__ __forceinline__ unsigned xb_add(unsigned* p, unsigned v) { return __hip_atomic_fetch_add(p, v, __ATOMIC_RELAXED, __HIP_MEMORY_SCOPE_AGENT); }
__device__ __forceinline__ unsigned xb_xcc_id() { return (unsigned)__builtin_amdgcn_s_getreg((3 << 11) | 20) & 0xFu; }
#define XB_SPIN(cond, bar) do { unsigned _sp = 0; while (cond) { __builtin_amdgcn_s_sleep(1); \
    if ((++_sp & 255u) == 0u) { if (xb_ld(&(bar)[XB_TMO])) break; if (_sp > XB_SPIN_CAP) { atomicAdd(&(bar)[XB_TMO], 1u); break; } } } } while (0)

struct XcdBarrier {
    unsigned* bar; unsigned x;
    volatile LAS unsigned* st;
};
__device__ __forceinline__ XcdBarrier xcd_barrier_post(unsigned* bar, volatile LAS unsigned* st) {
    XcdBarrier b; b.bar = bar; b.x = xb_xcc_id(); b.st = st;
    if (threadIdx.x == 0) (void)xb_add(&bar[XB_XCNT(b.x)], 1u);
    return b;
}
__device__ __forceinline__ void xcd_barrier_complete(unsigned* bar, unsigned x, unsigned& nloc, unsigned& nx) {
    const unsigned G = gridDim.x * gridDim.y * gridDim.z;
    unsigned sum, cnt, mine, sp = 0u;
    for (;;) {
        sum = 0u; cnt = 0u; mine = 0u;
#pragma unroll
        for (unsigned j = 0; j < 16; ++j) { const unsigned c = xb_ld(&bar[XB_XCNT(j)]); sum += c; cnt += (c > 0u) ? 1u : 0u; mine = (j == x) ? c : mine; }
        if (sum == G) break;
        __builtin_amdgcn_s_sleep(1);
        if ((++sp & 255u) == 0u) { if (xb_ld(&bar[XB_TMO])) break; if (sp > XB_SPIN_CAP) { atomicAdd(&bar[XB_TMO], 1u); break; } }
    }
    nloc = mine > 0u ? mine : 1u; nx = cnt > 0u ? cnt : 1u;
}
__device__ __forceinline__ void xcd_barrier(const XcdBarrier& b) {
    asm volatile("s_waitcnt vmcnt(0)" ::: "memory");
    __syncthreads();
    if (threadIdx.x == 0) {
        unsigned* bar = b.bar;
        __builtin_amdgcn_s_waitcnt(0);
        unsigned nloc = b.st[0], nx = b.st[1];
        if (nloc == 0u) { xcd_barrier_complete(bar, b.x, nloc, nx); b.st[0] = nloc; b.st[1] = nx; }
        const unsigned old = xb_add(&bar[XB_XSUB(b.x)], 1u);
        const unsigned gen = old / nloc;
        if (old + 1u == (gen + 1u) * nloc) {
            __builtin_amdgcn_fence(__ATOMIC_RELEASE, "agent");
            asm volatile("s_waitcnt vmcnt(0)" ::: "memory");
            const unsigned og = xb_add(&bar[XB_TOP], 1u);
            const unsigned tg = og / nx;
            if (og + 1u == (tg + 1u) * nx) xb_add(&bar[XB_TOPGEN], 1u);
            else XB_SPIN(xb_ld(&bar[XB_TOPGEN]) == tg, bar);
            __builtin_amdgcn_fence(__ATOMIC_ACQUIRE, "agent");
            xb_add(&bar[XB_XGEN(b.x)], 1u);
            asm volatile("s_waitcnt vmcnt(0)" ::: "memory");
        } else {
            XB_SPIN(xb_ld(&bar[XB_XGEN(b.x)]) == gen, bar);
            __builtin_amdgcn_fence(__ATOMIC_ACQUIRE, "agent");
            asm volatile("s_waitcnt vmcnt(0)" ::: "memory");
        }
    }
    __syncthreads();
}

namespace att {
__device__ __forceinline__ int crow(int r, int hi) { return (r & 3) + 8 * (r >> 2) + 4 * hi; }
__device__ __forceinline__ void glds16(const void* gsrc, unsigned lds_dst) { unsigned keep;
    asm volatile("s_mov_b32 %0, m0\n\ts_mov_b32 m0, %2\n\ts_nop 0\n\tglobal_load_lds_dwordx4 %1, off\n\ts_mov_b32 m0, %0" : "=&s"(keep) : "v"(gsrc), "s"(lds_dst) : "memory"); }
#define ATT_WAIT_BAR(N) asm volatile("s_waitcnt vmcnt(" #N ") lgkmcnt(0)\n\ts_barrier" ::: "memory")
#define ATT_MX3(a, b, c) __builtin_fmaxf(__builtin_fmaxf((a), (b)), (c))
typedef LAS const unsigned char* lcp;
typedef short v4i16_t __attribute__((ext_vector_type(4)));
__device__ __forceinline__ s16x4 vtr(lcp p) { return __builtin_bit_cast(s16x4, __builtin_amdgcn_ds_read_tr16_b64_v4i16((LAS v4i16_t*)p)); }
__device__ __forceinline__ float rowmax(const f32x16& p0, const f32x16& p1) {
    float a = ATT_MX3(p0[0], p0[1], p1[0]), b = ATT_MX3(p0[2], p0[3], p1[1]); a = ATT_MX3(a, p1[2], p1[3]);
#pragma unroll
    for (int r = 4; r < 16; r += 4) { a = ATT_MX3(a, p0[r], p0[r + 1]); b = ATT_MX3(b, p0[r + 2], p0[r + 3]); a = ATT_MX3(a, p1[r], p1[r + 1]); b = ATT_MX3(b, p1[r + 2], p1[r + 3]); }
    float m = __builtin_fmaxf(a, b); auto rr = __builtin_amdgcn_permlane32_swap(__float_as_uint(m), __float_as_uint(m), false, false);
    return __builtin_fmaxf(__uint_as_float(rr[0]), __uint_as_float(rr[1])); }
__device__ __forceinline__ void pv(f32x16* o, lcp vp, const u32x4 pw0, const u32x4 pw1, const u32x4 pw2, const u32x4 pw3) {
#pragma unroll
    for (int d0 = 0; d0 < 2; ++d0) {
#pragma unroll
        for (int ks = 0; ks < 4; ++ks) {
            const s16x4 lo = vtr(vp + d0 * 4096 + ks * 1024), hi = vtr(vp + d0 * 4096 + ks * 1024 + 512);
            const bf16x8 vf = (bf16x8){lo[0], lo[1], lo[2], lo[3], hi[0], hi[1], hi[2], hi[3]};
            const u32x4 pw = ks == 0 ? pw0 : ks == 1 ? pw1 : ks == 2 ? pw2 : pw3;
            o[d0] = __builtin_amdgcn_mfma_f32_32x32x16_bf16(__builtin_bit_cast(bf16x8, pw), vf, o[d0], 0, 0, 0);
        }
    }
}
__device__ __forceinline__ void store_o(const f32x16* o, const float* rsc  , LAS unsigned char* stage, bf16_t* Ow, int pitch, int lane, int r32, int hi) {
    LAS bf16_t* stg = (LAS bf16_t*)stage;
#pragma unroll
    for (int r = 0; r < 16; ++r) { const int orow = crow(r, hi);
#pragma unroll
        for (int d0 = 0; d0 < 2; ++d0) stg[orow * 64 + d0 * 32 + r32] = (bf16_t)(pk_bf16(o[d0][r] * rsc[r], 0.f) & 0xffffu); }
    asm volatile("s_waitcnt lgkmcnt(0)" ::: "memory");
#pragma unroll
    for (int i = 0; i < 4; ++i) { const int row = i * 8 + (lane >> 3), ch = lane & 7; const u32x4 v = *(const LAS u32x4*)(stg + row * 64 + ch * 8); *(u32x4*)(Ow + (size_t)row * pitch + ch * 8) = v; }
}

namespace mla {
constexpr int KSLOT = 12288, VSLOT = 8192, NS = 3;
constexpr int L_K = 0, L_V = NS * KSLOT, L_WS = L_V + NS * VSLOT, L_OST = L_WS + 2048, L_END = L_OST + 8 * 4096;
#define MLA_BAR_L() asm volatile("s_waitcnt lgkmcnt(0)\n\ts_barrier" ::: "memory")
__device__ __forceinline__ void unit(int b, int h, int qb, const bf16_t* Q, const bf16_t* KT, const bf16_t* VT, bf16_t* O, LAS unsigned char* shm) {
    int tid_ = threadIdx.x; asm volatile("" : "+v"(tid_));
    const int tid = tid_, lane = tid & 63, r32 = lane & 31, hi = lane >> 5; const int wid = __builtin_amdgcn_readfirstlane(tid >> 6);
    const int grp = wid >> 2;
    const long rowbase = (long)b * SEQL; const int q0 = qb * 256;
    const bf16_t* Qw = Q + (size_t)(rowbase + q0 + wid * 32) * 768 + h * 96;
    const bf16_t* Kh = KT + (size_t)((b * 8 + h) * 128) * 6144 + lane * 8;
    const bf16_t* Vh = VT + (size_t)((b * 8 + h) * 128) * 4096 + lane * 8;
    const unsigned lds0 = (unsigned)(uintptr_t)shm;
    LAS float* wsf = (LAS float*)(shm + L_WS) + wid * 64;
    const int NT = (q0 + 256) / 64;
    const int kc2 = 8 + (wid & 3);
#define MLA_DMA(t, sl) do { const bf16_t* kt_ = Kh + (size_t)(t) * 6144; \
        glds16(kt_ + wid * 512, (unsigned)__builtin_amdgcn_readfirstlane(lds0 + L_K + (sl) * KSLOT + wid * 1024)); \
        glds16(kt_ + kc2 * 512, (unsigned)__builtin_amdgcn_readfirstlane(lds0 + L_K + (sl) * KSLOT + kc2 * 1024)); \
        glds16(Vh + (size_t)(t) * 4096 + wid * 512, (unsigned)__builtin_amdgcn_readfirstlane(lds0 + L_V + (sl) * VSLOT + wid * 1024)); } while (0)
    MLA_DMA(0, 0); MLA_DMA(1, 1);
    bf16x8 qr[6];
#pragma unroll
    for (int d0 = 0; d0 < 6; ++d0) qr[d0] = *(const bf16x8*)(Qw + (size_t)r32 * 768 + d0 * 16 + hi * 8);
    float m = 0.f, l = 0.f; f32x16 o[2], negm;
#pragma unroll
    for (int r = 0; r < 16; ++r) { o[0][r] = 0.f; o[1][r] = 0.f; negm[r] = 0.f; }
    const int qrel = wid * 32 + r32;
    if (grp == 1) ATT_WAIT_BAR(3);
    int slot = 0;
    for (int t = 0; t < NT; ++t) {
        const int s2 = slot == 0 ? 2 : slot - 1;
        if (grp == 0) { if (t + 1 < NT) ATT_WAIT_BAR(3); else ATT_WAIT_BAR(0); }
        else { MLA_BAR_L(); if (t + 2 < NT) MLA_DMA(t + 2, s2); }
        const int jb = t - (NT - 4);
        const bool active = (jb <= 0 || 64 * jb <= wid * 32 + 31);
        f32x16 p0 = negm, p1 = negm; bool resc = false;
        if (active) {
            const lcp kb = (lcp)shm + L_K + slot * KSLOT + hi * 1024 + r32 * 16;
#pragma unroll
            for (int d0 = 0; d0 < 6; ++d0) { const bf16x8 b0 = *(const LAS bf16x8*)(kb + d0 * 2048), b1 = *(const LAS bf16x8*)(kb + d0 * 2048 + 512);
                p0 = __builtin_amdgcn_mfma_f32_32x32x16_bf16(b0, qr[d0], p0, 0, 0, 0); p1 = __builtin_amdgcn_mfma_f32_32x32x16_bf16(b1, qr[d0], p1, 0, 0, 0); }
            if (jb >= 0) {
#pragma unroll
                for (int r = 0; r < 16; ++r) { const int kv = 64 * jb + crow(r, hi); if (kv > qrel) p0[r] = -INFINITY; if (kv + 32 > qrel) p1[r] = -INFINITY; }
            }
            const float rm = rowmax(p0, p1);
            if (t == 0 || __any(rm > 8.0f)) {
                const float dl = t == 0 ? rm : __builtin_fmaxf(rm, 0.f); m += dl;
#pragma unroll
                for (int r = 0; r < 16; ++r) { p0[r] -= dl; p1[r] -= dl; negm[r] = -m; }
                const float alpha = fast_exp2(-dl); l *= alpha; if (hi == 0) wsf[r32] = alpha; resc = true;
            }
        }
        if (grp == 0) { MLA_BAR_L(); if (t + 2 < NT) MLA_DMA(t + 2, s2); }
        else { if (t + 1 >= NT) MLA_BAR_L(); else if (t + 2 < NT) ATT_WAIT_BAR(3); else ATT_WAIT_BAR(0); }
        if (active) {
            if (resc) {
#pragma unroll
                for (int r = 0; r < 16; ++r) { const float a = wsf[crow(r, hi)]; o[0][r] *= a; o[1][r] *= a; }
            }
            float sa = 0.f, sb = 0.f;
#pragma unroll
            for (int r = 0; r < 16; ++r) { p0[r] = fast_exp2(p0[r]); p1[r] = fast_exp2(p1[r]); sa += p0[r]; sb += p1[r]; }
            l += sa + sb;
            const u32x4 pw0 = {pk_bf16(p0[0], p0[1]), pk_bf16(p0[2], p0[3]), pk_bf16(p0[4], p0[5]), pk_bf16(p0[6], p0[7])};
            const u32x4 pw1 = {pk_bf16(p0[8], p0[9]), pk_bf16(p0[10], p0[11]), pk_bf16(p0[12], p0[13]), pk_bf16(p0[14], p0[15])};
            const u32x4 pw2 = {pk_bf16(p1[0], p1[1]), pk_bf16(p1[2], p1[3]), pk_bf16(p1[4], p1[5]), pk_bf16(p1[6], p1[7])};
            const u32x4 pw3 = {pk_bf16(p1[8], p1[9]), pk_bf16(p1[10], p1[11]), pk_bf16(p1[12], p1[13]), pk_bf16(p1[14], p1[15])};
            const lcp vp = (lcp)shm + L_V + slot * VSLOT + ((lane >> 4) & 1) * 32 + (lane & 3) * 8 + (4 * hi + ((lane & 15) >> 2)) * 64;
            pv(o, vp, pw0, pw1, pw2, pw3);
        }
        slot = slot == 2 ? 0 : slot + 1;
    }
#undef MLA_DMA
    if (grp == 0) MLA_BAR_L();
    { auto rr = __builtin_amdgcn_permlane32_swap(__float_as_uint(l), __float_as_uint(l), false, false); l = __uint_as_float(rr[0]) + __uint_as_float(rr[1]); }
    if (hi == 0) wsf[32 + r32] = l;
    float rli[16];
#pragma unroll
    for (int r = 0; r < 16; ++r) rli[r] = fast_rcp(wsf[32 + crow(r, hi)]);
    store_o(o, rli, shm + L_OST + wid * 4096, O + (size_t)(rowbase + q0 + wid * 32) * 512 + h * 64, 512, lane, r32, hi);
    MLA_BAR_L();
}
__device__ __forceinline__ void phase(int vcu, int G, const bf16_t* Q, const bf16_t* KT, const bf16_t* VT, bf16_t* O, LAS unsigned char* shm) {
    for (int v = vcu; v < 256; v += G) { const int bh = v >> 4, s = v & 15;
        unit(bh >> 3, bh & 7, 31 - s, Q, KT, VT, O, shm);
        unit(bh >> 3, bh & 7, s, Q, KT, VT, O, shm); }
}
}

namespace sba {
constexpr int KSLOT = 8192, VSLOT = 8192, NS = 3;
constexpr int L_K = 0, L_V = NS * KSLOT, L_WS = L_V + NS * VSLOT, L_FLAG = L_WS + 2048, L_OST = L_FLAG + 256, L_END = L_OST + 8 * 4096;
constexpr float SB_EXIT = -160.0f;
__device__ __forceinline__ void unit(int b, int kh, int qb64, const bf16_t* Q, const bf16_t* KT, const bf16_t* VT, bf16_t* O, LAS unsigned char* shm) {
    int tid_ = threadIdx.x; asm volatile("" : "+v"(tid_));
    const int tid = tid_, lane = tid & 63, r32 = lane & 31, hi = lane >> 5; const int wid = __builtin_amdgcn_readfirstlane(tid >> 6);
    const int h = kh * 4 + (wid >> 1), half = wid & 1;
    const long rowbase = (long)b * SEQL; const int q0 = qb64 * 64;
    const bf16_t* Qw = Q + (size_t)(rowbase + q0 + half * 32) * 1024 + h * 64;
    const bf16_t* Kh = KT + (size_t)((b * 4 + kh) * 128) * 4096 + wid * 512 + lane * 8;
    const bf16_t* Vh = VT + (size_t)((b * 4 + kh) * 128) * 4096 + wid * 512 + lane * 8;
    const unsigned lds0 = (unsigned)(uintptr_t)shm;
    LAS int* flags = (LAS int*)(shm + L_FLAG);
    const int NT = qb64 + 1;
#define SBA_DMA(k, sl) do { const int tile_ = qb64 - (k); \
        glds16(Kh + (size_t)tile_ * 4096, (unsigned)__builtin_amdgcn_readfirstlane(lds0 + L_K + (sl) * KSLOT + wid * 1024)); \
        glds16(Vh + (size_t)tile_ * 4096, (unsigned)__builtin_amdgcn_readfirstlane(lds0 + L_V + (sl) * VSLOT + wid * 1024)); } while (0)
    SBA_DMA(0, 0); if (NT > 1) SBA_DMA(1, 1);
    bf16x8 qr[4];
#pragma unroll
    for (int d0 = 0; d0 < 4; ++d0) qr[d0] = *(const bf16x8*)(Qw + (size_t)r32 * 1024 + d0 * 16 + hi * 8);
    float R = 0.f; f32x16 o[2];
#pragma unroll
    for (int r = 0; r < 16; ++r) { o[0][r] = 0.f; o[1][r] = 0.f; }
    const int qrel = half * 32 + r32;
    int slot = 0;
    for (int k = 0; k < NT; ++k) {
        if (k + 1 < NT) ATT_WAIT_BAR(2); else ATT_WAIT_BAR(0);
        if (k > 0) { const LAS int* f = flags + ((k - 1) & 1) * 8; int all = 1;
#pragma unroll
            for (int w = 0; w < 8; ++w) all &= f[w];
            if (all) break; }
        if (k + 2 < NT) { const int s2 = slot == 0 ? 2 : slot - 1; SBA_DMA(k + 2, s2); }
        {
            const lcp kb = (lcp)shm + L_K + slot * KSLOT + hi * 1024 + r32 * 16;
            f32x16 p0, p1;
#pragma unroll
            for (int r = 0; r < 16; ++r) { p0[r] = 0.f; p1[r] = 0.f; }
#pragma unroll
            for (int d0 = 0; d0 < 4; ++d0) { const bf16x8 b0 = *(const LAS bf16x8*)(kb + d0 * 2048), b1 = *(const LAS bf16x8*)(kb + d0 * 2048 + 512);
                p0 = __builtin_amdgcn_mfma_f32_32x32x16_bf16(b0, qr[d0], p0, 0, 0, 0); p1 = __builtin_amdgcn_mfma_f32_32x32x16_bf16(b1, qr[d0], p1, 0, 0, 0); }
            f32x16 L0, L1;
#pragma unroll
            for (int r = 0; r < 16; ++r) {
                const float z0 = p0[r], z1 = p1[r];
                float s0 = -(__builtin_fmaxf(z0, 0.f) + fast_log2(1.0f + fast_exp2(-__builtin_fabsf(z0))));
                float s1 = -(__builtin_fmaxf(z1, 0.f) + fast_log2(1.0f + fast_exp2(-__builtin_fabsf(z1))));
                if (k == 0) { const int kv = crow(r, hi); if (kv >= qrel) s0 = 0.f; if (kv + 32 >= qrel) s1 = 0.f; }
                L0[r] = s0; L1[r] = s1; }
            float G[16];
#pragma unroll
            for (int j = 0; j < 8; ++j) { const f32x16& LL = j < 4 ? L0 : L1; const int rb = 4 * (j & 3);
                const float gsum = (LL[rb] + LL[rb + 1]) + (LL[rb + 2] + LL[rb + 3]);
                auto rr = __builtin_amdgcn_permlane32_swap(__float_as_uint(gsum), __float_as_uint(gsum), false, false);
                G[2 * j] = __uint_as_float(rr[0]); G[2 * j + 1] = __uint_as_float(rr[1]); }
            float SG[16]; SG[15] = 0.f;
#pragma unroll
            for (int g = 14; g >= 0; --g) SG[g] = SG[g + 1] + G[g + 1];
            const float T = SG[0] + G[0];
#pragma unroll
            for (int j = 0; j < 8; ++j) { f32x16& LL = j < 4 ? L0 : L1; f32x16& PP = j < 4 ? p0 : p1; const int rb = 4 * (j & 3);
                const float base = (R + SG[2 * j + 1]) + (hi ? 0.f : G[2 * j + 1]);
                const float r3 = base, r2 = r3 + LL[rb + 3], r1 = r2 + LL[rb + 2], r0 = r1 + LL[rb + 1];
                PP[rb + 3] = fast_exp2(PP[rb + 3] + LL[rb + 3] + r3); PP[rb + 2] = fast_exp2(PP[rb + 2] + LL[rb + 2] + r2);
                PP[rb + 1] = fast_exp2(PP[rb + 1] + LL[rb + 1] + r1); PP[rb] = fast_exp2(PP[rb] + LL[rb] + r0); }
            if (k == 0) {
#pragma unroll
                for (int r = 0; r < 16; ++r) { const int kv = crow(r, hi); if (kv >= qrel) p0[r] = 0.f; if (kv + 32 >= qrel) p1[r] = 0.f; }
            }
            R += T;
            const u32x4 pw0 = {pk_bf16(p0[0], p0[1]), pk_bf16(p0[2], p0[3]), pk_bf16(p0[4], p0[5]), pk_bf16(p0[6], p0[7])};
            const u32x4 pw1 = {pk_bf16(p0[8], p0[9]), pk_bf16(p0[10], p0[11]), pk_bf16(p0[12], p0[13]), pk_bf16(p0[14], p0[15])};
            const u32x4 pw2 = {pk_bf16(p1[0], p1[1]), pk_bf16(p1[2], p1[3]), pk_bf16(p1[4], p1[5]), pk_bf16(p1[6], p1[7])};
            const u32x4 pw3 = {pk_bf16(p1[8], p1[9]), pk_bf16(p1[10], p1[11]), pk_bf16(p1[12], p1[13]), pk_bf16(p1[14], p1[15])};
            const lcp vp = (lcp)shm + L_V + slot * VSLOT + ((lane >> 4) & 1) * 32 + (lane & 3) * 8 + (4 * hi + ((lane & 15) >> 2)) * 64;
            pv(o, vp, pw0, pw1, pw2, pw3);
            const int dn = __all(R < SB_EXIT) ? 1 : 0;
            if (lane == 0) flags[(k & 1) * 8 + wid] = dn;
        }
        slot = slot == 2 ? 0 : slot + 1;
    }
#undef SBA_DMA
    ATT_WAIT_BAR(0);
    float one[16];
#pragma unroll
    for (int r = 0; r < 16; ++r) one[r] = 1.0f;
    store_o(o, one, shm + L_OST + wid * 4096, O + (size_t)(rowbase + q0 + half * 32) * 1024 + h * 64, 1024, lane, r32, hi);
    asm volatile("s_waitcnt lgkmcnt(0)\n\ts_barrier" ::: "memory");
}
__device__ __forceinline__ void phase(int vcu, int G, const bf16_t* Q, const bf16_t* KT, const bf16_t* VT, bf16_t* O, LAS unsigned char* shm) {
    for (int u = vcu * 4; u < 1024; u += G * 4)
        for (int i = 0; i < 4; ++i) { const int uu = u + i, qb64 = uu & 127, bk = uu >> 7; unit(bk >> 2, bk & 3, qb64, Q, KT, VT, O, shm); }
}
}
}
namespace fw {
constexpr size_t MiB = 1u << 20;
constexpr int NWAVES = 8, NTHR = 512;
constexpr int MAXSLOT = 34816;
constexpr size_t WS_CTL = 0, CTL_ZERO_BYTES = 64 * 1024;
constexpr size_t WS_TOKE = 1 * MiB;
constexpr size_t WS_TOKG = WS_TOKE + 64 * 1024;
constexpr size_t WS_TOKRS = WS_TOKG + 128 * 1024;
constexpr size_t WS_SLOT12 = WS_TOKRS + 64 * 1024;
constexpr size_t WS_SLOTG = WS_SLOT12 + 128 * 1024;
constexpr size_t WS_SLOTRS = WS_SLOTG + 256 * 1024;
constexpr size_t WS_CNT = WS_SLOTRS + 256 * 1024;
constexpr size_t WS_PSTART = WS_CNT + 16 * 1024;
constexpr size_t WS_CS = 4 * MiB;
constexpr size_t WS_SSQ = 6 * MiB;
constexpr size_t WS_SSQQ = 8 * MiB;
constexpr size_t WS_SSQKV = WS_SSQQ + 512 * 1024;
constexpr size_t WS_KPE = 9 * MiB;
constexpr size_t WS_W = 16 * MiB;
constexpr size_t W_AIN = WS_W, W_QUP = W_AIN + 3 * MiB, W_KVUP = W_QUP + 2 * MiB, W_AOUT = W_KVUP + 1 * MiB, W_KVS = W_AOUT + 2 * MiB, W_QB = W_KVS + 1 * MiB,
                 W_OB = W_QB + 4 * MiB, W_PG = W_OB + 4 * MiB, W_PU = W_PG + 8 * MiB, W_FGU = W_PU + 2 * MiB, W_FDN = W_FGU + 22 * MiB, W_EGU = W_FDN + 11 * MiB,
                 W_EDN = W_EGU + 176 * MiB, W_END = W_EDN + 88 * MiB;
constexpr size_t WS_PB = W_END;
constexpr size_t WS_HB = WS_PB + 32 * MiB;
constexpr size_t WS_U = WS_HB + 64 * MiB;
constexpr size_t WS_SKT = WS_U + 128 * MiB, WS_SVT = WS_SKT + 8 * MiB;
constexpr size_t WS_X = WS_SVT + 8 * MiB;
constexpr size_t X_AQ = WS_X, X_AKV = X_AQ + 12 * MiB, X_QRAW = X_AKV + 8 * MiB, X_KVRAW = X_QRAW + 24 * MiB, X_Q = X_KVRAW + 32 * MiB, X_KT = X_Q + 24 * MiB, X_VT = X_KT + 24 * MiB, X_O = X_VT + 16 * MiB;
constexpr size_t X_SQ = WS_X, X_SO = X_SQ + 32 * MiB;
constexpr size_t X_HID = WS_X;
constexpr size_t X_XG = WS_X, X_HG = X_XG + 68 * MiB, X_YG = X_HG + 187 * MiB, X_END = X_YG + 68 * MiB;
constexpr size_t WS_END = X_END;
static_assert(X_O + 16 * MiB <= X_END && (size_t)MAXSLOT * 2816 * 2 <= 187 * MiB && (size_t)MAXSLOT * 1024 * 2 <= 68 * MiB, "ws map");
constexpr int CW_BAR = 1024;
constexpr int RING_OFF = 0, RING_BYTES = 131072, LDSCTL_OFF = RING_BYTES, MISC_OFF = LDSCTL_OFF + 320, LDS_BYTES = 147456;
static_assert(att::mla::L_END <= RING_BYTES && att::sba::L_END <= RING_BYTES, "attention LDS");
constexpr float QSCALE_MLA = 0.10206207261596577f * LOG2E;
constexpr float QSCALE_SB = 0.125f * LOG2E;

constexpr int PH_PER_LAYER = 12, PH_TOTAL = 2 + 4 * PH_PER_LAYER;
__host__ __device__ inline bool phase_active(int idx) {
    if (idx < 2) return true;
    const int l = (idx - 2) / PH_PER_LAYER, s = (idx - 2) % PH_PER_LAYER; const bool mla = l < 2, moe = (l & 1) != 0;
    if (s == 1 || s == 2) return mla;
    if (s >= 7 && s <= 9) return moe;
    if (s == 11) return l == 1;
    return true;
}

struct Args { const float* in[26]; float* out; unsigned char* ws; int ph_lo, ph_hi; };

struct Frame { LAS unsigned char* lds; int tid, lane, wave, vcu, G; };

__device__ __forceinline__ float wave_sum(float v) {
#pragma unroll
    for (int o = 1; o < 64; o <<= 1) v += __shfl_xor(v, o);
    return v;
}
__device__ __forceinline__ void transpose_item(const float* W, int ldw, int sca, int scb, const float* gain, bf16_t* WT, int K, int drow0, int k0, LAS float* scr, int lane) {
    const int r8 = lane >> 3, pc = lane & 7, c = lane & 7;
    f32x4 va[8], vb[8]; float g[8];
    const f32x4 z4 = {0.f, 0.f, 0.f, 0.f};
#pragma unroll
    for (int i = 0; i < 8; ++i) { const float* rp = W + (size_t)(k0 + i * 8 + r8) * ldw + 4 * pc;
        va[i] = sca >= 0 ? *(const f32x4*)(rp + sca) : z4; vb[i] = scb >= 0 ? *(const f32x4*)(rp + scb) : z4; g[i] = gain ? gain[k0 + i * 8 + r8] : 1.0f; }
#pragma unroll
    for (int hf = 0; hf < 2; ++hf) {
#pragma unroll
        for (int i = 0; i < 8; ++i) { const f32x4 v = (hf == 0 ? va[i] : vb[i]) * g[i]; LAS float* d = scr + (i * 8 + r8) * 33 + 4 * pc; d[0] = v[0]; d[1] = v[1]; d[2] = v[2]; d[3] = v[3]; }
        asm volatile("s_waitcnt lgkmcnt(0)" ::: "memory");
#pragma unroll
        for (int j = 0; j < 4; ++j) { const int n = (lane >> 3) + 8 * j; const LAS float* s = scr + (8 * c) * 33 + n;
            u32x4 o; o.x = pk_bf16(s[0 * 33], s[1 * 33]); o.y = pk_bf16(s[2 * 33], s[3 * 33]); o.z = pk_bf16(s[4 * 33], s[5 * 33]); o.w = pk_bf16(s[6 * 33], s[7 * 33]);
            *(u32x4*)(WT + (size_t)(drow0 + hf * 32 + n) * K + k0 + 8 * c) = o; }
        asm volatile("s_waitcnt lgkmcnt(0)" ::: "memory");
    }
}
struct Fam { int src, count, K, Nd, ldw, map, gain, gstride; size_t sstride, dst, dstride; };
__device__ __forceinline__ int fam_items(const Fam& f) { return f.count * (f.K / 64) * (f.Nd / 64); }
__device__ __forceinline__ int fam_src_col(int map, int n0) {
    if (map == 1) return n0 < 384 ? n0 : (n0 < 416 ? 640 + (n0 - 384) : (n0 < 512 ? -1 : 384 + (n0 - 512)));
    if (map == 2) { const int pn = n0 >> 8, jj = n0 & 255; return jj < 128 ? pn * 128 + jj : 2816 + pn * 128 + (jj - 128); }
    return n0;
}
__device__ __forceinline__ void fam_item(const Args& a, const Fam& f, int fid, int it, LAS float* scr, int lane) {
    const int per = (f.K / 64) * (f.Nd / 64), mi = it / per, r = it % per, nblk = f.Nd / 64, kb = r / nblk, nb = r % nblk, n0 = nb * 64;
    const float* gain = nullptr;
    if (f.gain >= 0) gain = a.in[f.gain] + (fid == 11 ? (size_t)(2 * (mi >> 3) + 1) * 1024 : (size_t)mi * f.gstride);
    transpose_item(a.in[f.src] + (size_t)mi * f.sstride, f.ldw, fam_src_col(f.map, n0), fam_src_col(f.map, n0 + 32), gain, (bf16_t*)(a.ws + f.dst + (size_t)mi * f.dstride), f.K, n0, kb * 64, scr, lane);
}
__constant__ const Fam FAMS[13] = {
        {4, 2, 1024, 768, 672, 1, 3, 1024, (size_t)1024 * 672, W_AIN, (size_t)768 * 1024 * 2},
        {7, 2, 384, 768, 768, 0, 5, 384, (size_t)384 * 768, W_QUP, (size_t)768 * 384 * 2},
        {8, 2, 256, 1024, 1024, 0, 6, 256, (size_t)256 * 1024, W_KVUP, (size_t)1024 * 256 * 2},
        {11, 2, 512, 1024, 1024, 0, -1, 0, (size_t)512 * 1024, W_AOUT, (size_t)1024 * 512 * 2},
        {13, 1, 1024, 512, 512, 0, 12, 0, 0, W_KVS, 0},
        {15, 2, 1024, 1024, 1024, 0, 14, 1024, (size_t)1024 * 1024, W_QB, (size_t)1024 * 1024 * 2},
        {16, 2, 1024, 1024, 1024, 0, -1, 0, (size_t)1024 * 1024, W_OB, (size_t)1024 * 1024 * 2},
        {24, 4, 1024, 1024, 1024, 0, 23, 1024, (size_t)1024 * 1024, W_PG, (size_t)1024 * 1024 * 2},
        {25, 4, 256, 1024, 1024, 0, -1, 0, (size_t)256 * 1024, W_PU, (size_t)1024 * 256 * 2},
        {18, 2, 1024, 5632, 5632, 2, 17, 2048, (size_t)1024 * 5632, W_FGU, (size_t)5632 * 1024 * 2},
        {19, 2, 2816, 1024, 1024, 0, -1, 0, (size_t)2816 * 1024, W_FDN, (size_t)1024 * 2816 * 2},
        {21, 16, 1024, 5632, 5632, 2, 17, 0, (size_t)1024 * 5632, W_EGU, (size_t)5632 * 1024 * 2},
        {22, 16, 2816, 1024, 1024, 0, -1, 0, (size_t)2816 * 1024, W_EDN, (size_t)1024 * 2816 * 2}};
__device__ __forceinline__ void prologue(const Args& a, Frame& F) {
    LAS float* scr = (LAS float*)(F.lds + RING_OFF + F.wave * 16384);
    const int gw = F.vcu * NWAVES + F.wave, NGW = F.G * NWAVES;
    int base = 0;
#pragma unroll 1
    for (int fid = 0; fid < 13; ++fid) { const Fam f = FAMS[fid]; const int n = fam_items(f);
        int it = gw - (base % NGW); if (it < 0) it += NGW;
#pragma unroll 1
        for (; it < n; it += NGW) fam_item(a, f, fid, it, scr, F.lane);
        base += n; }
    { const f32x4* src = (const f32x4*)a.in[1]; u32x2* dst = (u32x2*)(a.ws + WS_PB); const size_t n4 = (size_t)4 * MT * 256 / 4, S = (size_t)NGW * 64;
        for (size_t i = (size_t)gw * 64 + F.lane; i < n4; i += 4 * S) { f32x4 v[4];
#pragma unroll
            for (int q = 0; q < 4; ++q) v[q] = (i + q * S < n4) ? src[i + q * S] : (f32x4){0.f, 0.f, 0.f, 0.f};
#pragma unroll
            for (int q = 0; q < 4; ++q) if (i + q * S < n4) { u32x2 o; o.x = pk_bf16(v[q][0], v[q][1]); o.y = pk_bf16(v[q][2], v[q][3]); dst[i + q * S] = o; } } }
    { bf16_t* HB = (bf16_t*)(a.ws + WS_HB); float* SSQ = (float*)(a.ws + WS_SSQ);
        for (int row = gw; row < MT; row += NGW) { const f32x4* xr = (const f32x4*)(a.in[0] + (size_t)row * DMODEL) + F.lane;
            u32x2* hb = (u32x2*)(HB + (size_t)row * DMODEL) + F.lane; float s = 0.f; f32x4 v4[4];
#pragma unroll
            for (int j = 0; j < 4; ++j) v4[j] = xr[64 * j];
#pragma unroll
            for (int j = 0; j < 4; ++j) { const f32x4 v = v4[j]; u32x2 o; o.x = pk_bf16(v[0], v[1]); o.y = pk_bf16(v[2], v[3]); hb[64 * j] = o; s += (v[0] * v[0] + v[1] * v[1]) + (v[2] * v[2] + v[3] * v[3]); }
            s = wave_sum(s); if (F.lane < 16) SSQ[(size_t)row * 16 + F.lane] = F.lane == 0 ? s : 0.f; } }
    { float* cs = (float*)(a.ws + WS_CS); const int* pos = (const int*)a.in[2];
        for (int i = gw * 64 + F.lane; i < MT * 16; i += NGW * 64) { const int row = i >> 4, f = i & 15;
            const float invf = (float)exp(-9.210340371976184 * (double)f / 16.0);
            const double ang = (double)((float)pos[row] * invf);
            const double rev = ang * 0.15915494309189535, fr = rev - rint(rev); const float x = (float)(fr * 6.283185307179586);
            cs[(size_t)row * 32 + f] = cosf(x); cs[(size_t)row * 32 + 16 + f] = sinf(x); } }
}
__device__ __forceinline__ void norm_rope_8(f32x4& n0, f32x4& n1, f32x4& r0, f32x4& r1, const float* gain, const float* cs, int sub, float outscale) {
    float ss = pg8::sumsq8(n0, n1) + pg8::sumsq8(r0, r1);
    ss += __shfl_xor(ss, 1); ss += __shfl_xor(ss, 2); ss += __shfl_xor(ss, 4);
    const float rq = (1.0f / sqrtf(ss * (1.0f / 96.0f) + RMS_EPS));
    const f32x4 g0 = *(const f32x4*)(gain + 8 * sub), g1 = *(const f32x4*)(gain + 8 * sub + 4);
    n0 = n0 * g0 * (rq * outscale); n1 = n1 * g1 * (rq * outscale);
    const int s4 = sub & 3;
    const f32x4 h0 = *(const f32x4*)(gain + 64 + 8 * s4), h1 = *(const f32x4*)(gain + 64 + 8 * s4 + 4);
    r0 = r0 * h0 * (rq * outscale); r1 = r1 * h1 * (rq * outscale);
    f32x4 p0, p1;
#pragma unroll
    for (int j = 0; j < 4; ++j) { p0[j] = __shfl_xor(r0[j], 2); p1[j] = __shfl_xor(r1[j], 2); }
    const f32x4 c0 = *(const f32x4*)(cs + 8 * (sub & 1)), c1 = *(const f32x4*)(cs + 8 * (sub & 1) + 4), s0 = *(const f32x4*)(cs + 16 + 8 * (sub & 1)), s1 = *(const f32x4*)(cs + 16 + 8 * (sub & 1) + 4);
    if (s4 < 2) { r0 = r0 * c0 - p0 * s0; r1 = r1 * c1 - p1 * s1; }
    else { r0 = r0 * c0 + p0 * s0; r1 = r1 * c1 + p1 * s1; }
}
#define THIN_LAUNDER() Frame F = F_; unsigned char* wsl = a.ws; asm volatile("" : "+v"(F.tid), "+v"(F.lane), "+s"(F.wave), "+s"(F.vcu), "+s"(F.G), "+s"(wsl))
__device__ __forceinline__ void mla_prep(const Args& a, const Frame& F_, int layer) { THIN_LAUNDER();
    const bf16_t* QRAW = (const bf16_t*)(wsl + X_QRAW); const bf16_t* KVRAW = (const bf16_t*)(wsl + X_KVRAW); const float* KPE = (const float*)(wsl + WS_KPE);
    const float* CS = (const float*)(wsl + WS_CS); const float* gq = a.in[9] + layer * 96; const float* gk = a.in[10] + layer * 96;
    bf16_t* Q = (bf16_t*)(wsl + X_Q); bf16_t* KT = (bf16_t*)(wsl + X_KT); bf16_t* VT = (bf16_t*)(wsl + X_VT);
    const int gw = F.vcu * NWAVES + F.wave, NGW = F.G * NWAVES, h = F.lane >> 3, sub = F.lane & 7;
    const f32x4 z4 = {0.f, 0.f, 0.f, 0.f};
    for (int row = gw; row < MT; row += NGW) {
        const int b = row >> 13, sq = row & 8191, tile = sq >> 6, rr = sq & 63; const float* cs = CS + (size_t)row * 32;
        { const bf16_t* qrow = QRAW + (size_t)row * 768 + h * 96; f32x4 n0, n1, r0 = z4, r1 = z4;
            unpack8(*(const u32x4*)(qrow + 8 * sub), n0, n1); if (sub < 4) unpack8(*(const u32x4*)(qrow + 64 + 8 * sub), r0, r1);
            norm_rope_8(n0, n1, r0, r1, gq, cs, sub, QSCALE_MLA);
            bf16_t* qo = Q + (size_t)row * 768 + h * 96; *(u32x4*)(qo + 8 * sub) = pack8(n0, n1); if (sub < 4) *(u32x4*)(qo + 64 + 8 * sub) = pack8(r0, r1); }
        { const bf16_t* krow = KVRAW + (size_t)row * 1024 + h * 128; f32x4 n0, n1, r0 = z4, r1 = z4;
            unpack8(*(const u32x4*)(krow + 8 * sub), n0, n1); if (sub < 4) { r0 = *(const f32x4*)(KPE + (size_t)row * 32 + 8 * sub); r1 = *(const f32x4*)(KPE + (size_t)row * 32 + 8 * sub + 4); }
            norm_rope_8(n0, n1, r0, r1, gk, cs, sub, 1.0f);
            bf16_t* kt = KT + (size_t)((b * 8 + h) * 128 + tile) * 6144 + rr * 8; *(u32x4*)(kt + sub * 512) = pack8(n0, n1); if (sub < 4) *(u32x4*)(kt + (8 + sub) * 512) = pack8(r0, r1);
            const u32x4 v = *(const u32x4*)(krow + 64 + 8 * sub);
            *(u32x4*)(VT + (size_t)((b * 8 + h) * 128 + tile) * 4096 + (sub >> 2) * 2048 + rr * 32 + (sub & 3) * 8) = v; }
    }
}
__device__ __forceinline__ void moe_route(const Args& a, const Frame& F_, int layer, int cur) { THIN_LAUNDER();
    const bf16_t* HB = (const bf16_t*)(wsl + WS_HB) + (size_t)cur * MT * DMODEL; const float* gain = a.in[17] + (size_t)layer * 1024; const float* wr = a.in[20] + (size_t)(layer >> 1) * 1024 * 8;
    int* TOKE = (int*)(wsl + WS_TOKE); float* TOKG = (float*)(wsl + WS_TOKG); float* TOKRS = (float*)(wsl + WS_TOKRS); int* CNT = (int*)(wsl + WS_CNT);
    LAS float* wg = (LAS float*)(F.lds + RING_OFF);
    LAS int* lcnt = (LAS int*)(F.lds + RING_OFF + 32768);
    for (int i = F.tid; i < 1024 * 8; i += NTHR) wg[i] = wr[i] * gain[i >> 3];
    for (int chunk = F.vcu; chunk < MT / 64; chunk += F.G) {
        if (F.tid < 8) lcnt[F.tid] = 0;
        __syncthreads();
        for (int tt = 0; tt < 8; ++tt) { const int tok = chunk * 64 + F.wave * 8 + tt;
            const u32x2* hr = (const u32x2*)(HB + (size_t)tok * DMODEL) + F.lane; float lg[8], ss = 0.f;
#pragma unroll
            for (int e = 0; e < 8; ++e) lg[e] = 0.f;
#pragma unroll
            for (int j = 0; j < 4; ++j) { const u32x2 hv = hr[64 * j]; const f32x4 v = {bf_lo(hv.x), bf_hi(hv.x), bf_lo(hv.y), bf_hi(hv.y)}; ss += (v[0] * v[0] + v[1] * v[1]) + (v[2] * v[2] + v[3] * v[3]);
#pragma unroll
                for (int i = 0; i < 4; ++i) { const LAS f32x4* w = (const LAS f32x4*)(wg + (size_t)(256 * j + 4 * F.lane + i) * 8); const f32x4 w0 = w[0], w1 = w[1];
                    lg[0] += v[i] * w0[0]; lg[1] += v[i] * w0[1]; lg[2] += v[i] * w0[2]; lg[3] += v[i] * w0[3]; lg[4] += v[i] * w1[0]; lg[5] += v[i] * w1[1]; lg[6] += v[i] * w1[2]; lg[7] += v[i] * w1[3]; } }
            ss = wave_sum(ss);
#pragma unroll
            for (int e = 0; e < 8; ++e) lg[e] = wave_sum(lg[e]);
            const float r = 1.0f / sqrtf(ss * (1.0f / 1024.0f) + RMS_EPS);
            int e1 = 0; float v1 = lg[0];
#pragma unroll
            for (int e = 1; e < 8; ++e) if (lg[e] > v1) { v1 = lg[e]; e1 = e; }
            int e2 = 0; float v2 = -3.0e38f;
#pragma unroll
            for (int e = 0; e < 8; ++e) if (e != e1 && lg[e] > v2) { v2 = lg[e]; e2 = e; }
            const float p2 = __expf((v2 - v1) * r), g1 = 1.0f / (1.0f + p2), g2 = p2 / (1.0f + p2);
            if (F.lane == 0) { TOKE[tok] = e1 | (e2 << 8); TOKG[tok * 2] = g1; TOKG[tok * 2 + 1] = g2; TOKRS[tok] = r; __hip_atomic_fetch_add(lcnt + e1, 1, __ATOMIC_RELAXED, __HIP_MEMORY_SCOPE_WORKGROUP); __hip_atomic_fetch_add(lcnt + e2, 1, __ATOMIC_RELAXED, __HIP_MEMORY_SCOPE_WORKGROUP); }
        }
        __syncthreads();
        if (F.tid < 8) CNT[chunk * 8 + F.tid] = lcnt[F.tid];
        __syncthreads();
    }
}
__device__ __forceinline__ void moe_scatter(const Args& a, const Frame& F_, int cur) { THIN_LAUNDER();
    const int* TOKE = (const int*)(wsl + WS_TOKE); const float* TOKG = (const float*)(wsl + WS_TOKG); const float* TOKRS = (const float*)(wsl + WS_TOKRS); const int* CNT = (const int*)(wsl + WS_CNT);
    int* SLOT12 = (int*)(wsl + WS_SLOT12); float* SLOTG = (float*)(wsl + WS_SLOTG); float* SLOTRS = (float*)(wsl + WS_SLOTRS); int* PSTART = (int*)(wsl + WS_PSTART);
    const bf16_t* HB = (const bf16_t*)(wsl + WS_HB) + (size_t)cur * MT * DMODEL; bf16_t* XG = (bf16_t*)(wsl + X_XG);
    LAS int* sm = (LAS int*)(F.lds + RING_OFF);
    for (int chunk = F.vcu; chunk < MT / 64; chunk += F.G) {
        { const int e = F.wave; int c4[4]; int s = 0;
#pragma unroll
            for (int i = 0; i < 4; ++i) { c4[i] = CNT[(4 * F.lane + i) * 8 + e]; s += c4[i]; }
            int inc = s;
#pragma unroll
            for (int o = 1; o < 64; o <<= 1) { const int t = __shfl_up(inc, o); if (F.lane >= o) inc += t; }
            const int total = __shfl(inc, 63); int pre = inc - s;
            if (F.lane == (chunk >> 2)) { const int cm = chunk & 3; pre += (cm > 0 ? c4[0] : 0) + (cm > 1 ? c4[1] : 0) + (cm > 2 ? c4[2] : 0); sm[8 + e] = pre; }
            if (F.lane == 0) sm[e] = total; }
        __syncthreads();
        if (F.tid == 0) { int p = 0; for (int e = 0; e < 8; ++e) { sm[16 + e] = p; p += (sm[e] + 255) >> 8; } sm[24] = p; }
        __syncthreads();
        if (F.tid < 9) PSTART[F.tid] = sm[16 + F.tid];
        if (F.wave == 0) { const int tok = chunk * 64 + F.lane; const int ev = TOKE[tok], e1 = ev & 255, e2 = ev >> 8; int s1 = 0, s2 = 0;
            const unsigned long long below = (1ull << F.lane) - 1ull;
#pragma unroll
            for (int e = 0; e < 8; ++e) { const unsigned long long m1 = __ballot(e1 == e), m2 = __ballot(e2 == e);
                const int rank = __popcll(m1 & below) + __popcll(m2 & below), slot = sm[16 + e] * 256 + sm[8 + e] + rank;
                if (e1 == e) s1 = slot; if (e2 == e) s2 = slot; }
            SLOT12[tok * 2] = s1; SLOT12[tok * 2 + 1] = s2; const float r = TOKRS[tok];
            SLOTG[s1] = TOKG[tok * 2]; SLOTG[s2] = TOKG[tok * 2 + 1]; SLOTRS[s1] = r; SLOTRS[s2] = r;
            sm[32 + 2 * F.lane] = s1; sm[32 + 2 * F.lane + 1] = s2; }
        __syncthreads();
        for (int i = 0; i < 16; ++i) { const int pr = F.wave * 16 + i, tok = chunk * 64 + (pr >> 1), slot = sm[32 + pr];
            const u32x4* src = (const u32x4*)(HB + (size_t)tok * DMODEL) + F.lane; u32x4* dst = (u32x4*)(XG + (size_t)slot * DMODEL) + F.lane;
            dst[0] = src[0]; dst[64] = src[64]; }
        __syncthreads();
    }
}
__device__ __forceinline__ void moe_combine(const Args& a, const Frame& F_, int cur, bool dummy) { THIN_LAUNDER();
    const int* SLOT12 = (const int*)(wsl + WS_SLOT12); const bf16_t* YG = (const bf16_t*)(wsl + X_YG);
    const bf16_t* HBi = (const bf16_t*)(wsl + WS_HB) + (size_t)cur * MT * DMODEL;
    bf16_t* HB = dummy ? (bf16_t*)(wsl + WS_END + 66 * MiB) : (bf16_t*)(wsl + WS_HB) + (size_t)cur * MT * DMODEL; float* SSQ = dummy ? (float*)(wsl + WS_END + 99 * MiB) : (float*)(wsl + WS_SSQ) + (size_t)cur * MT * 16;
    const int gw = F.vcu * NWAVES + F.wave, NGW = F.G * NWAVES;
    for (int row = gw; row < MT; row += NGW) { const int s1 = SLOT12[row * 2], s2 = SLOT12[row * 2 + 1];
        const u32x2* hr = (const u32x2*)(HBi + (size_t)row * DMODEL) + F.lane; u32x2* hb = (u32x2*)(HB + (size_t)row * DMODEL) + F.lane;
        const u32x2* y1 = (const u32x2*)(YG + (size_t)s1 * DMODEL) + F.lane; const u32x2* y2 = (const u32x2*)(YG + (size_t)s2 * DMODEL) + F.lane; float s = 0.f;
        u32x2 hv[4], pv_[4], qv[4];
#pragma unroll
        for (int j = 0; j < 4; ++j) { hv[j] = hr[64 * j]; pv_[j] = y1[64 * j]; qv[j] = y2[64 * j]; }
#pragma unroll
        for (int j = 0; j < 4; ++j) { const u32x2 h = hv[j], p = pv_[j], q = qv[j]; f32x4 v;
            v[0] = bf_lo(h.x) + (bf_lo(p.x) + bf_lo(q.x)); v[1] = bf_hi(h.x) + (bf_hi(p.x) + bf_hi(q.x)); v[2] = bf_lo(h.y) + (bf_lo(p.y) + bf_lo(q.y)); v[3] = bf_hi(h.y) + (bf_hi(p.y) + bf_hi(q.y));
            u32x2 o; o.x = pk_bf16(v[0], v[1]); o.y = pk_bf16(v[2], v[3]); hb[64 * j] = o; s += (v[0] * v[0] + v[1] * v[1]) + (v[2] * v[2] + v[3] * v[3]); }
        s = wave_sum(s); if (F.lane < 16) SSQ[(size_t)row * 16 + F.lane] = F.lane == 0 ? s : 0.f; }
}

__global__ void __launch_bounds__(NTHR, 2) yoco_fwd(Args args) {
    extern __shared__ __attribute__((aligned(16))) unsigned char lds_raw[];
    Frame F; F.lds = (LAS unsigned char*)lds_raw;
    volatile LAS unsigned* MISC = (volatile LAS unsigned*)(F.lds + MISC_OFF);
    F.tid = threadIdx.x; F.lane = F.tid & 63; F.wave = __builtin_amdgcn_readfirstlane(F.tid >> 6);
    F.G = gridDim.x; { const int bx = blockIdx.x; F.vcu = (F.G % 8 == 0) ? (bx % 8) * (F.G / 8) + bx / 8 : bx; }
    for (int u = F.tid; u < (LDS_BYTES - LDSCTL_OFF) / 4; u += NTHR) ((LAS unsigned*)(F.lds + LDSCTL_OFF))[u] = 0u;
    __syncthreads();
    unsigned char* ws = args.ws;
#define WS_LAUNDER() asm volatile("" : "+s"(ws), "+s"(bx), "+s"(F.G), "+s"(F.vcu))
    const bool single = (args.ph_hi - args.ph_lo) > 1;
    XcdBarrier bar; bar.bar = (unsigned*)(ws + WS_CTL) + CW_BAR; bar.x = 0; bar.st = nullptr;
    if (single) bar = xcd_barrier_post((unsigned*)(ws + WS_CTL) + CW_BAR, MISC + 8);
    const int lo = args.ph_lo, hi = args.ph_hi;
#ifndef EN_MASK
#define EN_MASK 0xFFFFFFFFu
#endif
#define EN(b) (((EN_MASK) >> (b)) & 1u)
#define IN(k) (lo <= (k) && (k) < hi)
#ifdef REP_MASK
#define NREPS(k) ((((unsigned long long)(REP_MASK) >> (k)) & 1ull) ? (REP_N) + 1 : 1)
#else
#define NREPS(k) 1
#endif
#define REPLOOP(k) for (int rep_ = 0, nrep_ = NREPS(k); rep_ < nrep_; ++rep_)
#define DUMMY (rep_ + 1 < nrep_)
#define OUT_HB(set) (DUMMY ? (bf16_t*)(ws + WS_END + 66 * MiB) : (bf16_t*)(ws + WS_HB) + (size_t)(set) * MT * DMODEL)
#define OUT_SSQ(set) (DUMMY ? (float*)(ws + WS_END + 99 * MiB) : (float*)(ws + WS_SSQ) + (size_t)(set) * MT * 16)
#define SEAM(k) do { if (single && (k) + 1 < hi) { XcdBarrier b_ = bar; asm volatile("" : "+s"(b_.bar), "+s"(b_.x)); xcd_barrier(b_); } } while (0)

    LAS unsigned char* ring = F.lds + RING_OFF;
    int bx = (int)blockIdx.x;

    if (EN(0) && IN(0)) REPLOOP(0) { prologue(args, F); SEAM(0); }
    if (EN(1) && IN(1)) REPLOOP(1) { WS_LAUNDER();
#pragma unroll 1
        for (int i = 0; i < 4; ++i) {
            pg8::Gemm g{(const bf16_t*)(ws + WS_PB) + (size_t)i * MT * 256, (const bf16_t*)(ws + W_PU) + (size_t)i * 1024 * 256, MT, 1024, 256};
            pg8::StaticOrder S; S.init(MT, 1024, F.G, bx);
            pg8::EpiScale E{(bf16_t*)(ws + WS_U) + (size_t)i * MT * DMODEL, 1024, pg8::RowScale{nullptr, 0}, 1.0f};
            pg8::gemm_phase<pg8::EpiScale, pg8::StaticOrder, true, true>(ring, g, S, E);
        }
        SEAM(1);
    }
#pragma unroll 1
    for (int l = 0; l < 4; ++l) {
        const int base = 2 + PH_PER_LAYER * l; const bool is_mla = l < 2, is_moe = (l & 1) != 0; const int cur = l & 1, j = l & 1;
#define HBc ((const bf16_t*)(ws + WS_HB) + (size_t)cur * MT * DMODEL)
#define HBw ((bf16_t*)(ws + WS_HB) + (size_t)cur * MT * DMODEL)
#define SSQc ((float*)(ws + WS_SSQ) + (size_t)cur * MT * 16)
        if (IN(base + 0)) REPLOOP(base + 0) { WS_LAUNDER();
            if (EN(2) && is_mla) {
                pg8::Gemm g{HBc, (const bf16_t*)(ws + W_AIN) + (size_t)l * 768 * 1024, MT, 768, 1024};
                pg8::StaticOrder S; S.init(MT, 768, F.G, bx);
                pg8::EpiAin E{(bf16_t*)(ws + X_AQ), (bf16_t*)(ws + X_AKV), (float*)(ws + WS_KPE), (float*)(ws + WS_SSQQ), (float*)(ws + WS_SSQKV), pg8::RowScale{SSQc, 1}};
                pg8::gemm_phase<pg8::EpiAin, pg8::StaticOrder, true, true>(ring, g, S, E);
            } else if (EN(3) && !is_mla) {
                pg8::Gemm g{HBc, (const bf16_t*)(ws + W_QB) + (size_t)j * 1024 * 1024, MT, 1024, 1024};
                pg8::StaticOrder S; S.init(MT, 1024, F.G, bx);
                pg8::EpiScale E{(bf16_t*)(ws + X_SQ), 1024, pg8::RowScale{SSQc, 1}, QSCALE_SB};
                pg8::gemm_phase<pg8::EpiScale, pg8::StaticOrder, true, true>(ring, g, S, E);
            }
            SEAM(base + 0);
        }
        if (EN(4) && is_mla && IN(base + 1)) REPLOOP(base + 1) { WS_LAUNDER();
            { pg8::Gemm g{(const bf16_t*)(ws + X_AQ), (const bf16_t*)(ws + W_QUP) + (size_t)l * 768 * 384, MT, 768, 384};
              pg8::StaticOrder S; S.init(MT, 768, F.G, bx);
              pg8::EpiScale E{(bf16_t*)(ws + X_QRAW), 768, pg8::RowScale{(const float*)(ws + WS_SSQQ), 3}, 1.0f};
              pg8::gemm_phase<pg8::EpiScale, pg8::StaticOrder, true, true>(ring, g, S, E); }
            { pg8::Gemm g{(const bf16_t*)(ws + X_AKV), (const bf16_t*)(ws + W_KVUP) + (size_t)l * 1024 * 256, MT, 1024, 256};
              pg8::StaticOrder S; S.init(MT, 1024, F.G, bx);
              pg8::EpiScale E{(bf16_t*)(ws + X_KVRAW), 1024, pg8::RowScale{(const float*)(ws + WS_SSQKV), 4}, 1.0f};
              pg8::gemm_phase<pg8::EpiScale, pg8::StaticOrder, true, true>(ring, g, S, E); }
            SEAM(base + 1);
        }
        if (EN(5) && is_mla && IN(base + 2)) REPLOOP(base + 2) { mla_prep(args, F, l); SEAM(base + 2); }
        if (IN(base + 3)) REPLOOP(base + 3) { WS_LAUNDER();
            if (EN(6) && is_mla) att::mla::phase(F.vcu, F.G, (const bf16_t*)(ws + X_Q), (const bf16_t*)(ws + X_KT), (const bf16_t*)(ws + X_VT), (bf16_t*)(ws + X_O), ring);
            else if (EN(7) && !is_mla) att::sba::phase(F.vcu, F.G, (const bf16_t*)(ws + X_SQ), (const bf16_t*)(ws + WS_SKT), (const bf16_t*)(ws + WS_SVT), (bf16_t*)(ws + X_SO), ring);
            SEAM(base + 3);
        }
        if (EN(8) && IN(base + 4)) REPLOOP(base + 4) { WS_LAUNDER();
            pg8::Gemm g = is_mla ? pg8::Gemm{(const bf16_t*)(ws + X_O), (const bf16_t*)(ws + W_AOUT) + (size_t)l * 1024 * 512, MT, 1024, 512}
                                 : pg8::Gemm{(const bf16_t*)(ws + X_SO), (const bf16_t*)(ws + W_OB) + (size_t)j * 1024 * 1024, MT, 1024, 1024};
            pg8::StaticOrder S; S.init(MT, 1024, F.G, bx);
            pg8::EpiRes<false> E{HBc, OUT_HB(cur), OUT_SSQ(cur), nullptr, pg8::RowScale{nullptr, 0}, nullptr};
            pg8::gemm_phase<pg8::EpiRes<false>, pg8::StaticOrder, true, true>(ring, g, S, E);
            SEAM(base + 4);
        }
        if (!is_moe) {
            if (EN(9) && IN(base + 5)) REPLOOP(base + 5) { WS_LAUNDER();
                pg8::Gemm g{HBc, (const bf16_t*)(ws + W_FGU) + (size_t)(l >> 1) * 5632 * 1024, MT, 5632, 1024};
                pg8::GroupOrder S; S.init_dense(MT, 5632, F.G, bx);
                pg8::EpiSwiglu E{(bf16_t*)(ws + X_HID), pg8::RowScale{SSQc, 1}};
                pg8::gemm_phase<pg8::EpiSwiglu, pg8::GroupOrder, true, true>(ring, g, S, E);
                SEAM(base + 5);
            }
            if (EN(10) && IN(base + 6)) REPLOOP(base + 6) { WS_LAUNDER();
                pg8::Gemm g{(const bf16_t*)(ws + X_HID), (const bf16_t*)(ws + W_FDN) + (size_t)(l >> 1) * 1024 * 2816, MT, 1024, 2816};
                pg8::StaticOrder S; S.init(MT, 1024, F.G, bx);
                pg8::EpiRes<false> E{HBc, OUT_HB(cur), OUT_SSQ(cur), nullptr, pg8::RowScale{nullptr, 0}, nullptr};
                pg8::gemm_phase<pg8::EpiRes<false>, pg8::StaticOrder, true, true>(ring, g, S, E);
                SEAM(base + 6);
            }
        } else {
            if (EN(11) && IN(base + 5)) REPLOOP(base + 5) { WS_LAUNDER(); moe_route(args, F, l, cur); SEAM(base + 5); }
            if (EN(12) && IN(base + 6)) REPLOOP(base + 6) { WS_LAUNDER(); moe_scatter(args, F, cur); SEAM(base + 6); }
            if (EN(13) && IN(base + 7)) REPLOOP(base + 7) { WS_LAUNDER();
                pg8::Gemm g{(const bf16_t*)(ws + X_XG), (const bf16_t*)(ws + W_EGU) + (size_t)(l >> 1) * 8 * 5632 * 1024, MAXSLOT, 5632, 1024};
                pg8::GroupOrder S; S.init((const int*)(ws + WS_PSTART), 5632, F.G, bx, (size_t)5632 * 1024 * 2);
                pg8::EpiSwiglu E{(bf16_t*)(ws + X_HG), pg8::RowScale{(const float*)(ws + WS_SLOTRS), 2}};
                pg8::gemm_phase<pg8::EpiSwiglu, pg8::GroupOrder, true, true>(ring, g, S, E);
                SEAM(base + 7);
            }
            if (EN(14) && IN(base + 8)) REPLOOP(base + 8) { WS_LAUNDER();
                pg8::Gemm g{(const bf16_t*)(ws + X_HG), (const bf16_t*)(ws + W_EDN) + (size_t)(l >> 1) * 8 * 1024 * 2816, MAXSLOT, 1024, 2816};
                pg8::GroupOrder S; S.init((const int*)(ws + WS_PSTART), 1024, F.G, bx, (size_t)1024 * 2816 * 2);
                pg8::EpiScale E{(bf16_t*)(ws + X_YG), 1024, pg8::RowScale{(const float*)(ws + WS_SLOTG), 2}, 1.0f};
                pg8::gemm_phase<pg8::EpiScale, pg8::GroupOrder, true, true>(ring, g, S, E);
                SEAM(base + 8);
            }
            if (EN(15) && IN(base + 9)) REPLOOP(base + 9) { WS_LAUNDER(); moe_combine(args, F, cur, DUMMY); SEAM(base + 9); }
        }
        if (EN(16) && IN(base + 10)) REPLOOP(base + 10) { WS_LAUNDER();
            pg8::Gemm g{HBc, (const bf16_t*)(ws + W_PG) + (size_t)l * 1024 * 1024, MT, 1024, 1024};
            pg8::StaticOrder S; S.init(MT, 1024, F.G, bx);
            pg8::EpiRes<true> E{HBc, OUT_HB(cur ^ 1), OUT_SSQ(cur ^ 1),
                                (const bf16_t*)(ws + WS_U) + (size_t)l * MT * DMODEL, pg8::RowScale{SSQc, 1}, (l == 3 && !DUMMY) ? args.out : nullptr};
            pg8::gemm_phase<pg8::EpiRes<true>, pg8::StaticOrder, true, true>(ring, g, S, E);
            SEAM(base + 10);
        }
        if (EN(17) && l == 1 && IN(base + 11)) REPLOOP(base + 11) { WS_LAUNDER();
            pg8::Gemm g{(const bf16_t*)(ws + WS_HB) + (size_t)(cur ^ 1) * MT * DMODEL, (const bf16_t*)(ws + W_KVS), MT, 512, 1024};
            pg8::StaticOrder S; S.init(MT, 512, F.G, bx);
            pg8::EpiKvs E{(bf16_t*)(ws + WS_SKT), (bf16_t*)(ws + WS_SVT), pg8::RowScale{(const float*)(ws + WS_SSQ) + (size_t)(cur ^ 1) * MT * 16, 1}};
            pg8::gemm_phase<pg8::EpiKvs, pg8::StaticOrder, true, true>(ring, g, S, E);
            SEAM(base + 11);
        }
    }
#undef IN
#undef SEAM
}
}
#define MULTI_LAUNCH 0
extern "C" void kernel_launch(void* const* d_in, const int* in_sizes, int n_in, void* d_out, int out_size, void* d_ws, size_t ws_size, hipStream_t stream) {
    using namespace fw;
    static int grid = 0;
    if (grid == 0) {
        if (n_in != 26 || out_size != MT * DMODEL || ws_size < WS_END) { fprintf(stderr, "kernel_launch: unexpected n_in %d / out %d / ws %zu\n", n_in, out_size, ws_size); grid = -1; return; }
        if (hipFuncSetAttribute((const void*)yoco_fwd, hipFuncAttributeMaxDynamicSharedMemorySize, LDS_BYTES) != hipSuccess) { fprintf(stderr, "kernel_launch: hipFuncSetAttribute failed\n"); grid = -1; return; }
        int dev = 0, cus = 0, per_cu = 0;
        (void)hipGetDevice(&dev); (void)hipDeviceGetAttribute(&cus, hipDeviceAttributeMultiprocessorCount, dev);
        (void)hipOccupancyMaxActiveBlocksPerMultiprocessor(&per_cu, (const void*)yoco_fwd, NTHR, LDS_BYTES);
        (void)hipGetLastError();
        grid = (cus > 0 && per_cu >= 1) ? cus : 256;
        if (grid > 256) grid = 256;
    }
    if (grid < 0) return;
    (void)hipMemsetAsync((unsigned char*)d_ws + WS_CTL, 0, CTL_ZERO_BYTES, stream);
    Args a{};
    for (int i = 0; i < 26; ++i) a.in[i] = (const float*)d_in[i];
    a.out = (float*)d_out; a.ws = (unsigned char*)d_ws;
#if MULTI_LAUNCH
    for (int k = 0; k < PH_TOTAL; ++k) { if (!phase_active(k)) continue; a.ph_lo = k; a.ph_hi = k + 1; hipLaunchKernelGGL(yoco_fwd, dim3(grid), dim3(NTHR), LDS_BYTES, stream, a); }
#else
#ifdef PROBE_MASK
    a.ph_lo = 0; a.ph_hi = PH_TOTAL;
#else
    a.ph_lo = 0; a.ph_hi = PH_TOTAL - 1;
#endif
    hipLaunchKernelGGL(yoco_fwd, dim3(grid), dim3(NTHR), LDS_BYTES, stream, a);
#endif
}
```

```cpp
#include <hip/hip_runtime.h>
#include <cstdio>
#include <cstdint>
#include <cmath>
#define LAS __attribute__((address_space(3)))
#define GAS __attribute__((address_space(1)))
typedef unsigned short bf16_t;
typedef short bf16x8 __attribute__((ext_vector_type(8)));
typedef float f32x4 __attribute__((ext_vector_type(4)));
typedef float f32x2 __attribute__((ext_vector_type(2)));
typedef float f32x16 __attribute__((ext_vector_type(16)));
typedef unsigned u32x4 __attribute__((ext_vector_type(4)));
typedef unsigned u32x2 __attribute__((ext_vector_type(2)));
typedef short s16x4 __attribute__((ext_vector_type(4)));
typedef __bf16 bf16x2_t __attribute__((ext_vector_type(2)));

constexpr int MT = 16384, DMODEL = 1024, SEQL = 8192;
constexpr float RMS_EPS = 1e-6f;
constexpr float LOG2E = 1.4426950408889634f;

__device__ __forceinline__ unsigned pk_bf16(float lo, float hi) { f32x2 v = {lo, hi}; bf16x2_t b = __builtin_convertvector(v, bf16x2_t); return __builtin_bit_cast(unsigned, b); }
__device__ __forceinline__ float bf_lo(unsigned w) { return __uint_as_float(w << 16); }
__device__ __forceinline__ float bf_hi(unsigned w) { return __uint_as_float(w & 0xffff0000u); }
__device__ __forceinline__ unsigned cvt_pk_bf16(float lo, float hi) { unsigned r; asm volatile("v_cvt_pk_bf16_f32 %0, %1, %2" : "=v"(r) : "v"(lo), "v"(hi)); return r; }
__device__ __forceinline__ u32x4 pack8(const f32x4 a, const f32x4 b) { u32x4 w; w.x = cvt_pk_bf16(a[0], a[1]); w.y = cvt_pk_bf16(a[2], a[3]); w.z = cvt_pk_bf16(b[0], b[1]); w.w = cvt_pk_bf16(b[2], b[3]); return w; }
__device__ __forceinline__ void unpack8(const u32x4 w, f32x4& a, f32x4& b) { a = (f32x4){bf_lo(w.x), bf_hi(w.x), bf_lo(w.y), bf_hi(w.y)}; b = (f32x4){bf_lo(w.z), bf_hi(w.z), bf_lo(w.w), bf_hi(w.w)}; }
__device__ __forceinline__ float fast_rcp(float x) { return __builtin_amdgcn_rcpf(x); }
__device__ __forceinline__ float fast_exp2(float x) { return __builtin_amdgcn_exp2f(x); }
__device__ __forceinline__ float fast_log2(float x) { return __builtin_amdgcn_logf(x); }
__device__ __forceinline__ float sigmoidf_(float x) { return fast_rcp(1.0f + fast_exp2(-x * LOG2E)); }

namespace pg8 {
constexpr int BM = 256, BK = 64, HALF = 128, HTB = HALF * BK * 2, STAGE_BYTES = 8 * HTB, NXCD = 8, WGM = 8;
__host__ __device__ __forceinline__ int lds_byte(int r, int c) { const int st = (r >> 4) * 2 + (c >> 5), rr = r & 15, cc = c & 31, ob = rr * 64 + cc * 2; return st * 1024 + (ob ^ (((ob >> 9) & 1) << 5)); }
__host__ __device__ __forceinline__ void stage_rc(int b, int& R, int& C) { const int st = b / 1024, sb = b % 1024, swz = sb ^ (((sb >> 9) & 1) << 5); R = (st >> 1) * 16 + swz / 64; C = (st & 1) * 32 + (swz % 64) / 2; }
__host__ __device__ __forceinline__ int perm32(int rho) { const int n = rho >> 4, i = rho & 15; return 8 * (i >> 2) + 4 * n + (i & 3); }

struct Unit { int pm, pn; size_t boff; };
struct Gemm { const bf16_t* A; const bf16_t* Bt; int M, N, K; };

struct StaticOrder {
    int nM, nN, nwg, G, c;
    __device__ void init(int M, int N, int G_, int c_) { nM = M / BM; nN = N / BM; nwg = nM * nN; G = G_; c = c_; }
    __device__ bool next(int i, Unit& u) const {
        const long L = (long)i * G + c; if (L >= nwg) return false;
        int wgid = (int)L; { const int q = nwg / NXCD, r = nwg % NXCD, xcd = wgid % NXCD, off = wgid / NXCD; wgid = (xcd < r ? xcd * (q + 1) : r * (q + 1) + (xcd - r) * q) + off; }
        const int nig = WGM * nN, gid = wgid / nig, fm = gid * WGM, gsz = (nM - fm) < WGM ? (nM - fm) : WGM;
        u.pm = fm + ((wgid % nig) % gsz); u.pn = (wgid % nig) / gsz; u.boff = 0; return true;
    }
};
struct GroupOrder {
    int ps[9]; int nN, nwg, G, c; size_t estride;
    __device__ void init(const int* pstart, int N, int G_, int c_, size_t estride_) {
#pragma unroll
        for (int e = 0; e < 9; ++e) ps[e] = __builtin_amdgcn_readfirstlane(pstart[e]);
        nN = N / BM; nwg = ps[8] * nN; G = G_; c = c_; estride = estride_; }
    __device__ void init_dense(int M, int N, int G_, int c_) {
        ps[0] = 0;
#pragma unroll
        for (int e = 1; e < 9; ++e) ps[e] = M / BM;
        nN = N / BM; nwg = ps[8] * nN; G = G_; c = c_; estride = 0; }
    __device__ bool next(int i, Unit& u) const {
        const long L = (long)i * G + c; if (L >= nwg) return false;
        int wgid = (int)L; { const int q = nwg / NXCD, r = nwg % NXCD, xcd = wgid % NXCD, off = wgid / NXCD; wgid = (xcd < r ? xcd * (q + 1) : r * (q + 1) + (xcd - r) * q) + off; }
        int e = 0;
#pragma unroll
        for (int k = 1; k < 8; ++k) if (wgid >= ps[k] * nN) e = k;
        int p0 = ps[0], p1 = ps[1];
#pragma unroll
        for (int k = 1; k < 8; ++k) if (e == k) { p0 = ps[k]; p1 = ps[k + 1]; }
        const int local = wgid - p0 * nN, np = p1 - p0;
        u.pn = local / np; u.pm = p0 + (local % np); u.boff = (size_t)e * estride; return true;
    }
};


__device__ __forceinline__ float sumsq8(const f32x4 a, const f32x4 b) { return ((a[0] * a[0] + a[1] * a[1]) + (a[2] * a[2] + a[3] * a[3])) + ((b[0] * b[0] + b[1] * b[1]) + (b[2] * b[2] + b[3] * b[3])); }
__device__ __forceinline__ float red_fq(float s) { s += __shfl_xor(s, 16); s += __shfl_xor(s, 32); return s; }
struct RowScale {
    const float* p; int mode;
    __device__ __forceinline__ float get(int row, int fq) const {
        if (mode == 0) return 1.0f;
        if (mode == 2) return p[row];
        if (mode == 1) { const f32x4 a = *(const f32x4*)(p + (size_t)row * 16 + 4 * fq); const float s = red_fq((a[0] + a[1]) + (a[2] + a[3])); return 1.0f / sqrtf(s * (1.0f / 1024.0f) + RMS_EPS); }
        if (mode == 3) { const f32x4 a = *(const f32x4*)(p + (size_t)row * 8 + 4 * (fq & 1)); const float s = red_fq(fq < 2 ? (a[0] + a[1]) + (a[2] + a[3]) : 0.f); return 1.0f / sqrtf(s * (1.0f / 384.0f) + RMS_EPS); }
        { const float s = red_fq(p[(size_t)row * 4 + fq]); return 1.0f / sqrtf(s * (1.0f / 256.0f) + RMS_EPS); }
    }
    __device__ __forceinline__ void get8(float (&rsv)[2][4], int row0, int fq) const {
#pragma unroll
        for (int ai = 0; ai < 2; ++ai)
#pragma unroll
            for (int m = 0; m < 4; ++m) rsv[ai][m] = get(row0 + ai * 128 + m * 16, fq);
        asm volatile("" ::: "memory");
    }
};

struct EpiScale {
    static constexpr bool PERM = true, AFTER_DRAIN = false;
    bf16_t* O; int ldc; RowScale rs; float cs;
    __device__ __forceinline__ void operator()(const f32x4 (&acc)[2][2][4][2], const Unit& u, int wr, int wc, int fr, int fq) const {
        const int row0 = u.pm * BM + wr * 64 + fr, col0 = u.pn * BM + wc * 32 + 8 * fq;
        float rsv[2][4]; rs.get8(rsv, row0, fq);
#pragma unroll
        for (int ai = 0; ai < 2; ++ai)
#pragma unroll
            for (int m = 0; m < 4; ++m) { const int row = row0 + ai * HALF + m * 16; const float s = rsv[ai][m] * cs; bf16_t* rowp = O + (size_t)row * ldc + col0;
#pragma unroll
                for (int bj = 0; bj < 2; ++bj) *(u32x4*)(rowp + bj * HALF) = pack8(acc[ai][bj][m][0] * s, acc[ai][bj][m][1] * s); }
    }
};
struct EpiAin {
    static constexpr bool PERM = true, AFTER_DRAIN = false;
    bf16_t* AQ; bf16_t* AKV; float* KPE; float* SSQQ; float* SSQKV; RowScale rs;
    __device__ __forceinline__ void operator()(const f32x4 (&acc)[2][2][4][2], const Unit& u, int wr, int wc, int fr, int fq) const {
        const int row0 = u.pm * BM + wr * 64 + fr, c8 = wc * 32 + 8 * fq;
        float rsv[2][4]; rs.get8(rsv, row0, fq);
#pragma unroll
        for (int ai = 0; ai < 2; ++ai)
#pragma unroll
            for (int m = 0; m < 4; ++m) { const int row = row0 + ai * HALF + m * 16; const float s = rsv[ai][m];
                const f32x4 a0 = acc[ai][0][m][0] * s, a1 = acc[ai][0][m][1] * s, b0 = acc[ai][1][m][0] * s, b1 = acc[ai][1][m][1] * s;
                if (u.pn == 0) {
                    *(u32x4*)(AQ + (size_t)row * 384 + c8) = pack8(a0, a1); *(u32x4*)(AQ + (size_t)row * 384 + 128 + c8) = pack8(b0, b1);
                    const float q = red_fq(sumsq8(a0, a1) + sumsq8(b0, b1)); if (fq == 0) SSQQ[(size_t)row * 8 + wc] = q;
                } else if (u.pn == 1) {
                    *(u32x4*)(AQ + (size_t)row * 384 + 256 + c8) = pack8(a0, a1);
                    const float q = red_fq(sumsq8(a0, a1)); if (fq == 0) SSQQ[(size_t)row * 8 + 4 + wc] = q;
                    if (wc == 0) { *(f32x4*)(KPE + (size_t)row * 32 + 8 * fq) = b0; *(f32x4*)(KPE + (size_t)row * 32 + 8 * fq + 4) = b1; }
                } else {
                    *(u32x4*)(AKV + (size_t)row * 256 + c8) = pack8(a0, a1); *(u32x4*)(AKV + (size_t)row * 256 + 128 + c8) = pack8(b0, b1);
                    const float q = red_fq(sumsq8(a0, a1) + sumsq8(b0, b1)); if (fq == 0) SSQKV[(size_t)row * 4 + wc] = q;
                } }
    }
};
struct EpiSwiglu {
    static constexpr bool PERM = true, AFTER_DRAIN = false;
    bf16_t* HID; RowScale rs;
    __device__ __forceinline__ void operator()(const f32x4 (&acc)[2][2][4][2], const Unit& u, int wr, int wc, int fr, int fq) const {
        const int row0 = u.pm * BM + wr * 64 + fr, col0 = u.pn * 128 + wc * 32 + 8 * fq;
        float rsv[2][4]; rs.get8(rsv, row0, fq);
#pragma unroll
        for (int ai = 0; ai < 2; ++ai)
#pragma unroll
            for (int m = 0; m < 4; ++m) { const int row = row0 + ai * HALF + m * 16; const float s = rsv[ai][m];
                f32x4 o[2];
#pragma unroll
                for (int n = 0; n < 2; ++n) { const f32x4 g = acc[ai][0][m][n] * s, up = acc[ai][1][m][n] * s;
#pragma unroll
                    for (int j = 0; j < 4; ++j) o[n][j] = g[j] * sigmoidf_(g[j]) * up[j]; }
                *(u32x4*)(HID + (size_t)row * 2816 + col0) = pack8(o[0], o[1]); }
    }
};
template <bool GATED> struct EpiRes {
    static constexpr bool PERM = true, AFTER_DRAIN = false;
    const bf16_t* HBi; bf16_t* HBo; float* SSQo; const bf16_t* U; RowScale rs; float* OUTF;
    __device__ __forceinline__ void operator()(const f32x4 (&acc)[2][2][4][2], const Unit& u, int wr, int wc, int fr, int fq) const {
        const int row0 = u.pm * BM + wr * 64 + fr, col0 = u.pn * BM + wc * 32 + 8 * fq;
        float rsv[2][4]; if (GATED) rs.get8(rsv, row0, fq);
#pragma unroll
        for (int ai = 0; ai < 2; ++ai)
#pragma unroll
            for (int m = 0; m < 4; ++m) { const int row = row0 + ai * HALF + m * 16; const size_t off = (size_t)row * DMODEL + col0;
                float s = 1.0f; if (GATED) s = rsv[ai][m];
                float q = 0.f;
#pragma unroll
                for (int bj = 0; bj < 2; ++bj) { f32x4 a0 = acc[ai][bj][m][0], a1 = acc[ai][bj][m][1];
                    f32x4 h0, h1; unpack8(*(const u32x4*)(HBi + off + bj * HALF), h0, h1);
                    if (GATED) { f32x4 u0, u1; unpack8(*(const u32x4*)(U + off + bj * HALF), u0, u1);
#pragma unroll
                        for (int j = 0; j < 4; ++j) { a0[j] = sigmoidf_(a0[j] * s) * u0[j]; a1[j] = sigmoidf_(a1[j] * s) * u1[j]; } }
                    h0 += a0; h1 += a1;
                    if (GATED) { if (OUTF) { *(f32x4*)(OUTF + off + bj * HALF) = h0; *(f32x4*)(OUTF + off + bj * HALF + 4) = h1; } }
                    *(u32x4*)(HBo + off + bj * HALF) = pack8(h0, h1);
                    q += sumsq8(h0, h1); }
                q = red_fq(q); if (fq == 0) SSQo[(size_t)row * 16 + u.pn * 4 + wc] = q;
                asm volatile("" ::: "memory"); }
    }
};
struct EpiKvs {
    static constexpr bool PERM = true, AFTER_DRAIN = false;
    bf16_t* KT; bf16_t* VT; RowScale rs;
    __device__ __forceinline__ void operator()(const f32x4 (&acc)[2][2][4][2], const Unit& u, int wr, int wc, int fr, int fq) const {
        const int row0 = u.pm * BM + wr * 64 + fr;
        float rsv[2][4]; rs.get8(rsv, row0, fq);
#pragma unroll
        for (int ai = 0; ai < 2; ++ai)
#pragma unroll
            for (int m = 0; m < 4; ++m) { const int row = row0 + ai * HALF + m * 16; const float s = rsv[ai][m];
                const int b = row >> 13, sq = row & 8191, tile = sq >> 6, rr = sq & 63;
#pragma unroll
                for (int bj = 0; bj < 2; ++bj) { const int c = bj * HALF + wc * 32 + 8 * fq, kh = c >> 6, d = c & 63;
                    const size_t tb = (size_t)((b * 4 + kh) * 128 + tile) * 4096;
                    const u32x4 w = pack8(acc[ai][bj][m][0] * s, acc[ai][bj][m][1] * s);
                    if (u.pn == 0) *(u32x4*)(KT + tb + (d >> 3) * 512 + rr * 8) = w;
                    else *(u32x4*)(VT + tb + (d >> 5) * 2048 + rr * 32 + (d & 31)) = w; } }
    }
};

#define PG8_LAS LAS
template <class Epi, class Sched, bool ALIGN_EPI = false, bool SP2 = false>
__device__ __forceinline__ void gemm_phase(PG8_LAS unsigned char* lds, const Gemm g, const Sched& S, const Epi& E) {
    int tid_ = threadIdx.x; asm volatile("" : "+v"(tid_));
    const int tid = tid_, wid = __builtin_amdgcn_readfirstlane(tid >> 6), lane = tid & 63, wr = wid >> 2, wc = wid & 3, fr = lane & 15, fq = lane >> 4;
    const int K = g.K, nt = K / BK;
    unsigned voffA[2], voffB[2];
#pragma unroll
    for (int i = 0; i < 2; ++i) { int R, C; stage_rc(tid * 16 + i * 8192, R, C); const int Rb = Epi::PERM ? ((R & ~31) + perm32(R & 31)) : R;
        voffA[i] = (unsigned)(R * K + C) * 2u; voffB[i] = (unsigned)(Rb * K + C) * 2u; }
    const size_t kstep = (size_t)(BK * 2);
    const size_t hstep = (size_t)HALF * K * 2;
    const size_t tstep = 2 * hstep;
    const unsigned ldsw = (unsigned)wid * 1024u;
    const int aoff = lds_byte(wr * 64 + fr, fq * 8), boff = lds_byte(wc * 32 + fr, fq * 8);
#define PG8_SA(b, h) (((b) * 2 + (h)) * HTB)
#define PG8_SB(b, h) ((4 + (b) * 2 + (h)) * HTB)
#define PG8_STAGE(bufoff, gbase, voff) do { _Pragma("unroll") for (int _i = 0; _i < 2; ++_i) \
        __builtin_amdgcn_global_load_lds((const unsigned*)((const char*)(gbase) + (voff)[_i]), (PG8_LAS unsigned*)(lds + (bufoff) + ldsw + _i * 8192), 16, 0, 0); } while (0)
#define PG8_LDA(dst, b, h) do { _Pragma("unroll") for (int m = 0; m < 4; ++m) _Pragma("unroll") for (int k = 0; k < 2; ++k) dst[m][k] = *(const PG8_LAS bf16x8*)(lds + PG8_SA(b, h) + aoff + m * 2048 + k * 1024); } while (0)
#define PG8_LDB(dst, b, h) do { _Pragma("unroll") for (int n = 0; n < 2; ++n) _Pragma("unroll") for (int k = 0; k < 2; ++k) dst[n][k] = *(const PG8_LAS bf16x8*)(lds + PG8_SB(b, h) + boff + n * 2048 + k * 1024); } while (0)
#define PG8_MMA(ai, bj, At, Bt) do { __builtin_amdgcn_s_setprio(1); _Pragma("unroll") for (int m = 0; m < 4; ++m) _Pragma("unroll") for (int n = 0; n < 2; ++n) _Pragma("unroll") for (int k = 0; k < 2; ++k) \
        acc[ai][bj][m][n] = __builtin_amdgcn_mfma_f32_16x16x32_bf16(Bt[n][k], At[m][k], acc[ai][bj][m][n], 0, 0, 0); __builtin_amdgcn_s_setprio(0); } while (0)
#define PG8_WAIT_V(n) asm volatile("s_waitcnt vmcnt(" #n ")" ::: "memory")
#define PG8_WAIT_L(n) asm volatile("s_waitcnt lgkmcnt(" #n ")" ::: "memory")
#define PG8_BAR __builtin_amdgcn_s_barrier()
#define PG8_SCHED __builtin_amdgcn_sched_barrier(0)
    Unit cur, nxt; int ui = 0;
    if (!S.next(0, cur)) return;
    f32x4 acc[2][2][4][2];
#pragma unroll
    for (int a = 0; a < 2; ++a)
#pragma unroll
        for (int b = 0; b < 2; ++b)
#pragma unroll
            for (int m = 0; m < 4; ++m)
#pragma unroll
                for (int n = 0; n < 2; ++n) acc[a][b][m][n] = (f32x4){0.f, 0.f, 0.f, 0.f};
    bf16x8 At[4][2], B0[2][2], B1[2][2];
    const char* cA = (const char*)g.A + (size_t)cur.pm * tstep; const char* cB = (const char*)g.Bt + cur.boff + (size_t)cur.pn * tstep;
    if constexpr (SP2) {
        PG8_STAGE(PG8_SB(0, 0), cB, voffB); PG8_STAGE(PG8_SB(0, 1), cB + hstep, voffB); PG8_STAGE(PG8_SA(0, 0), cA, voffA); PG8_STAGE(PG8_SA(0, 1), cA + hstep, voffA);
        if (wr == 1) PG8_BAR;
        PG8_WAIT_V(2); PG8_BAR;
        PG8_STAGE(PG8_SB(1, 0), cB + kstep, voffB); PG8_STAGE(PG8_SA(1, 0), cA + kstep, voffA); PG8_STAGE(PG8_SB(1, 1), cB + hstep + kstep, voffB);
        PG8_WAIT_V(6); PG8_BAR;
    } else {
        PG8_STAGE(PG8_SB(0, 0), cB, voffB); PG8_STAGE(PG8_SA(0, 0), cA, voffA); PG8_STAGE(PG8_SB(0, 1), cB + hstep, voffB); PG8_STAGE(PG8_SA(0, 1), cA + hstep, voffA);
        if (wr == 1) PG8_BAR;
        PG8_WAIT_V(4); PG8_BAR;
        PG8_STAGE(PG8_SB(1, 0), cB + kstep, voffB); PG8_STAGE(PG8_SA(1, 0), cA + kstep, voffA); PG8_STAGE(PG8_SB(1, 1), cB + hstep + kstep, voffB);
        PG8_WAIT_V(6); PG8_BAR;
    }
    for (;;) {
        const bool has_next = S.next(ui + 1, nxt);
        const char* nA = has_next ? (const char*)g.A + (size_t)nxt.pm * tstep : cA; const char* nB = has_next ? (const char*)g.Bt + nxt.boff + (size_t)nxt.pn * tstep : cB;
        for (int t = 0; t < nt; t += 2) {
            const bool last = (t == nt - 2);
            const char* a1 = cA + (size_t)(t + 1) * kstep;
            const char* a2 = last ? nA : cA + (size_t)(t + 2) * kstep; const char* b2 = last ? nB : cB + (size_t)(t + 2) * kstep;
            const char* a3 = a2 + kstep; const char* b3 = b2 + kstep;
            if constexpr (SP2) {
            PG8_LDB(B0, 0, 0); PG8_LDB(B1, 0, 1); PG8_SCHED; PG8_LDA(At, 0, 0); PG8_STAGE(PG8_SA(1, 1), a1 + hstep, voffA);
            PG8_WAIT_V(8); PG8_WAIT_L(0); PG8_BAR; PG8_MMA(0, 0, At, B0); PG8_MMA(0, 1, At, B1); PG8_BAR; PG8_SCHED;
            PG8_LDA(At, 0, 1); PG8_STAGE(PG8_SB(0, 0), b2, voffB); PG8_STAGE(PG8_SB(0, 1), b2 + hstep, voffB); PG8_STAGE(PG8_SA(0, 0), a2, voffA);
            PG8_WAIT_V(8); PG8_WAIT_L(0); PG8_BAR; PG8_MMA(1, 0, At, B0); PG8_MMA(1, 1, At, B1); PG8_BAR; PG8_SCHED;
            PG8_LDB(B0, 1, 0); PG8_LDB(B1, 1, 1); PG8_SCHED; PG8_LDA(At, 1, 0); PG8_STAGE(PG8_SA(0, 1), a2 + hstep, voffA);
            PG8_WAIT_V(8); PG8_WAIT_L(0); PG8_BAR; PG8_MMA(0, 0, At, B0); PG8_MMA(0, 1, At, B1); PG8_BAR; PG8_SCHED;
            PG8_LDA(At, 1, 1); PG8_STAGE(PG8_SB(1, 0), b3, voffB); PG8_STAGE(PG8_SB(1, 1), b3 + hstep, voffB); PG8_STAGE(PG8_SA(1, 0), a3, voffA);
            PG8_WAIT_V(8); PG8_WAIT_L(0); PG8_BAR; PG8_MMA(1, 0, At, B0); PG8_MMA(1, 1, At, B1); PG8_BAR; PG8_SCHED;
            } else {
            PG8_LDB(B0, 0, 0); PG8_SCHED; PG8_LDA(At, 0, 0); PG8_STAGE(PG8_SA(1, 1), a1 + hstep, voffA);
            PG8_WAIT_L(8); PG8_BAR; PG8_WAIT_L(0); PG8_MMA(0, 0, At, B0); PG8_BAR; PG8_SCHED;
            PG8_LDB(B1, 0, 1); PG8_STAGE(PG8_SB(0, 0), b2, voffB);
            PG8_BAR; PG8_WAIT_L(0); PG8_MMA(0, 1, At, B1); PG8_BAR;
            PG8_LDA(At, 0, 1); PG8_STAGE(PG8_SA(0, 0), a2, voffA);
            PG8_BAR; PG8_WAIT_L(0); PG8_MMA(1, 0, At, B0); PG8_BAR; PG8_SCHED;
            PG8_STAGE(PG8_SB(0, 1), b2 + hstep, voffB);
            PG8_WAIT_V(6); PG8_BAR; PG8_MMA(1, 1, At, B1); PG8_BAR;
            PG8_LDB(B0, 1, 0); PG8_SCHED; PG8_LDA(At, 1, 0); PG8_STAGE(PG8_SA(0, 1), a2 + hstep, voffA);
            PG8_WAIT_L(8); PG8_BAR; PG8_WAIT_L(0); PG8_MMA(0, 0, At, B0); PG8_BAR; PG8_SCHED;
            PG8_LDB(B1, 1, 1); PG8_STAGE(PG8_SB(1, 0), b3, voffB);
            PG8_BAR; PG8_WAIT_L(0); PG8_MMA(0, 1, At, B1); PG8_BAR;
            PG8_LDA(At, 1, 1); PG8_STAGE(PG8_SA(1, 0), a3, voffA);
            PG8_BAR; PG8_WAIT_L(0); PG8_MMA(1, 0, At, B0); PG8_BAR; PG8_SCHED;
            PG8_STAGE(PG8_SB(1, 1), b3 + hstep, voffB);
            PG8_WAIT_V(6); PG8_BAR; PG8_MMA(1, 1, At, B1); PG8_BAR;
            }
        }
        if constexpr (ALIGN_EPI) { if (wr == 0) PG8_BAR; }
        E(acc, cur, wr, wc, fr, fq);
        if (!has_next) break;
#pragma unroll
        for (int a = 0; a < 2; ++a)
#pragma unroll
            for (int b = 0; b < 2; ++b)
#pragma unroll
                for (int m = 0; m < 4; ++m)
#pragma unroll
                    for (int n = 0; n < 2; ++n) acc[a][b][m][n] = (f32x4){0.f, 0.f, 0.f, 0.f};
        cur = nxt; cA = nA; cB = nB; ++ui;
        if constexpr (ALIGN_EPI) { if (wr == 1) PG8_BAR; }
    }
    PG8_WAIT_V(0);
    if constexpr (!ALIGN_EPI) { if (wr == 0) PG8_BAR; }
    PG8_BAR;
#undef PG8_SA
#undef PG8_SB
#undef PG8_STAGE
#undef PG8_LDA
#undef PG8_LDB
#undef PG8_MMA
#undef PG8_WAIT_V
#undef PG8_WAIT_L
#undef PG8_BAR
#undef PG8_SCHED
}
}
typedef GAS unsigned gu32;
#define RLX_AGENT __ATOMIC_RELAXED, __HIP_MEMORY_SCOPE_AGENT
#define XB_TMO      128
#define XB_XCNT(j)  (256  + 64 * (j))
#define XB_XSUB(j)  (1280 + 64 * (j))
#define XB_XGEN(j)  (2304 + 64 * (j))
#define XB_TOP      3328
#define XB_TOPGEN   3392
#define XCD_BAR_WORDS 3456
#define XB_SPIN_CAP (1u << 18)

__device__ __forceinline__ unsigned xb_ld(unsigned* p)              { return __hip_atomic_load(p, __ATOMIC_RELAXED, __HIP_MEMORY_SCOPE_AGENT); }
__device__ __forceinline__ unsigned xb_add(unsigned* p, unsigned v) { return __hip_atomic_fetch_add(p, v, __ATOMIC_RELAXED, __HIP_MEMORY_SCOPE_AGENT); }
__device__ __forceinline__ unsigned xb_xcc_id() { return (unsigned)__builtin_amdgcn_s_getreg((3 << 11) | 20) & 0xFu; }
#define XB_SPIN(cond, bar) do { unsigned _sp = 0; while (cond) { __builtin_amdgcn_s_sleep(1); \
    if ((++_sp & 255u) == 0u) { if (xb_ld(&(bar)[XB_TMO])) break; if (_sp > XB_SPIN_CAP) { atomicAdd(&(bar)[XB_TMO], 1u); break; } } } } while (0)

struct XcdBarrier {
    unsigned* bar; unsigned x;
    volatile LAS unsigned* st;
};
__device__ __forceinline__ XcdBarrier xcd_barrier_post(unsigned* bar, volatile LAS unsigned* st) {
    XcdBarrier b; b.bar = bar; b.x = xb_xcc_id(); b.st = st;
    if (threadIdx.x == 0) (void)xb_add(&bar[XB_XCNT(b.x)], 1u);
    return b;
}
__device__ __forceinline__ void xcd_barrier_complete(unsigned* bar, unsigned x, unsigned& nloc, unsigned& nx) {
    const unsigned G = gridDim.x * gridDim.y * gridDim.z;
    unsigned sum, cnt, mine, sp = 0u;
    for (;;) {
        sum = 0u; cnt = 0u; mine = 0u;
#pragma unroll
        for (unsigned j = 0; j < 16; ++j) { const unsigned c = xb_ld(&bar[XB_XCNT(j)]); sum += c; cnt += (c > 0u) ? 1u : 0u; mine = (j == x) ? c : mine; }
        if (sum == G) break;
        __builtin_amdgcn_s_sleep(1);
        if ((++sp & 255u) == 0u) { if (xb_ld(&bar[XB_TMO])) break; if (sp > XB_SPIN_CAP) { atomicAdd(&bar[XB_TMO], 1u); break; } }
    }
    nloc = mine > 0u ? mine : 1u; nx = cnt > 0u ? cnt : 1u;
}
__device__ __forceinline__ void xcd_barrier(const XcdBarrier& b) {
    asm volatile("s_waitcnt vmcnt(0)" ::: "memory");
    __syncthreads();
    if (threadIdx.x == 0) {
        unsigned* bar = b.bar;
        __builtin_amdgcn_s_waitcnt(0);
        unsigned nloc = b.st[0], nx = b.st[1];
        if (nloc == 0u) { xcd_barrier_complete(bar, b.x, nloc, nx); b.st[0] = nloc; b.st[1] = nx; }
        const unsigned old = xb_add(&bar[XB_XSUB(b.x)], 1u);
        const unsigned gen = old / nloc;
        if (old + 1u == (gen + 1u) * nloc) {
            __builtin_amdgcn_fence(__ATOMIC_RELEASE, "agent");
            asm volatile("s_waitcnt vmcnt(0)" ::: "memory");
            const unsigned og = xb_add(&bar[XB_TOP], 1u);
            const unsigned tg = og / nx;
            if (og + 1u == (tg + 1u) * nx) xb_add(&bar[XB_TOPGEN], 1u);
            else XB_SPIN(xb_ld(&bar[XB_TOPGEN]) == tg, bar);
            __builtin_amdgcn_fence(__ATOMIC_ACQUIRE, "agent");
            xb_add(&bar[XB_XGEN(b.x)], 1u);
            asm volatile("s_waitcnt vmcnt(0)" ::: "memory");
        } else {
            XB_SPIN(xb_ld(&bar[XB_XGEN(b.x)]) == gen, bar);
            __builtin_amdgcn_fence(__ATOMIC_ACQUIRE, "agent");
            asm volatile("s_waitcnt vmcnt(0)" ::: "memory");
        }
    }
    __syncthreads();
}

namespace att {
__device__ __forceinline__ int crow(int r, int hi) { return (r & 3) + 8 * (r >> 2) + 4 * hi; }
__device__ __forceinline__ void glds16(const void* gsrc, unsigned lds_dst) { unsigned keep;
    asm volatile("s_mov_b32 %0, m0\n\ts_mov_b32 m0, %2\n\ts_nop 0\n\tglobal_load_lds_dwordx4 %1, off\n\ts_mov_b32 m0, %0" : "=&s"(keep) : "v"(gsrc), "s"(lds_dst) : "memory"); }
#define ATT_WAIT_BAR(N) asm volatile("s_waitcnt vmcnt(" #N ") lgkmcnt(0)\n\ts_barrier" ::: "memory")
#define ATT_MX3(a, b, c) __builtin_fmaxf(__builtin_fmaxf((a), (b)), (c))
typedef LAS const unsigned char* lcp;
typedef short v4i16_t __attribute__((ext_vector_type(4)));
__device__ __forceinline__ s16x4 vtr(lcp p) { return __builtin_bit_cast(s16x4, __builtin_amdgcn_ds_read_tr16_b64_v4i16((LAS v4i16_t*)p)); }
__device__ __forceinline__ float rowmax(const f32x16& p0, const f32x16& p1) {
    float a = ATT_MX3(p0[0], p0[1], p1[0]), b = ATT_MX3(p0[2], p0[3], p1[1]); a = ATT_MX3(a, p1[2], p1[3]);
#pragma unroll
    for (int r = 4; r < 16; r += 4) { a = ATT_MX3(a, p0[r], p0[r + 1]); b = ATT_MX3(b, p0[r + 2], p0[r + 3]); a = ATT_MX3(a, p1[r], p1[r + 1]); b = ATT_MX3(b, p1[r + 2], p1[r + 3]); }
    float m = __builtin_fmaxf(a, b); auto rr = __builtin_amdgcn_permlane32_swap(__float_as_uint(m), __float_as_uint(m), false, false);
    return __builtin_fmaxf(__uint_as_float(rr[0]), __uint_as_float(rr[1])); }
template <bool FAKEV = false> __device__ __forceinline__ void pv(f32x16* o, lcp vp, const u32x4 pw0, const u32x4 pw1, const u32x4 pw2, const u32x4 pw3) {
#pragma unroll
    for (int ks = 0; ks < 4; ++ks) {
        const u32x4 pw = ks == 0 ? pw0 : ks == 1 ? pw1 : ks == 2 ? pw2 : pw3;
#pragma unroll
        for (int d0 = 0; d0 < 2; ++d0) {
            bf16x8 vf;
            if (FAKEV) vf = __builtin_bit_cast(bf16x8, ks & 1 ? pw0 : pw2);
            else { const s16x4 lo = vtr(vp + d0 * 4096 + ks * 1024), hi = vtr(vp + d0 * 4096 + ks * 1024 + 512); vf = (bf16x8){lo[0], lo[1], lo[2], lo[3], hi[0], hi[1], hi[2], hi[3]}; }
            o[d0] = __builtin_amdgcn_mfma_f32_32x32x16_bf16(__builtin_bit_cast(bf16x8, pw), vf, o[d0], 0, 0, 0);
        }
    }
}
__device__ __forceinline__ void store_o(const f32x16* o, const float* rsc  , LAS unsigned char* stage, bf16_t* Ow, int pitch, int lane, int r32, int hi) {
    LAS bf16_t* stg = (LAS bf16_t*)stage;
#pragma unroll
    for (int r = 0; r < 16; ++r) { const int orow = crow(r, hi);
#pragma unroll
        for (int d0 = 0; d0 < 2; ++d0) stg[orow * 64 + d0 * 32 + r32] = (bf16_t)(pk_bf16(o[d0][r] * rsc[r], 0.f) & 0xffffu); }
    asm volatile("s_waitcnt lgkmcnt(0)" ::: "memory");
#pragma unroll
    for (int i = 0; i < 4; ++i) { const int row = i * 8 + (lane >> 3), ch = lane & 7; const u32x4 v = *(const LAS u32x4*)(stg + row * 64 + ch * 8); *(u32x4*)(Ow + (size_t)row * pitch + ch * 8) = v; }
}

namespace mla {
constexpr int KSLOT = 12288, VSLOT = 8192, NS = 3;
constexpr int L_K = 0, L_V = NS * KSLOT, L_WS = L_V + NS * VSLOT, L_OST = L_WS + 2048, L_END = L_OST + 8 * 4096;
#define MLA_BAR_L() asm volatile("s_waitcnt lgkmcnt(0)\n\ts_barrier" ::: "memory")
template <int ABL> __device__ __forceinline__ void unit(int b, int h, int qb, const bf16_t* Q, const bf16_t* KT, const bf16_t* VT, bf16_t* O, LAS unsigned char* shm) {
    int tid_ = threadIdx.x; asm volatile("" : "+v"(tid_));
    const int tid = tid_, lane = tid & 63, r32 = lane & 31, hi = lane >> 5; const int wid = __builtin_amdgcn_readfirstlane(tid >> 6);
    const int grp = wid >> 2;
    const long rowbase = (long)b * SEQL; const int q0 = qb * 256;
    const bf16_t* Qw = Q + (size_t)(rowbase + q0 + wid * 32) * 768 + h * 96;
    const bf16_t* Kh = KT + (size_t)((b * 8 + h) * 128) * 6144 + lane * 8;
    const bf16_t* Vh = VT + (size_t)((b * 8 + h) * 128) * 4096 + lane * 8;
    const unsigned lds0 = (unsigned)(uintptr_t)shm;
    LAS float* wsf = (LAS float*)(shm + L_WS) + wid * 64;
    const int NT = (q0 + 256) / 64;
    const int kc2 = 8 + (wid & 3);
    bf16x8 qr[6];
#pragma unroll
    for (int d0 = 0; d0 < 6; ++d0) qr[d0] = *(const bf16x8*)(Qw + (size_t)r32 * 768 + d0 * 16 + hi * 8);
#define MLA_DMA_K(t, sl) do { const bf16_t* kt_ = Kh + (size_t)(t) * 6144; \
        glds16(kt_ + wid * 512, (unsigned)__builtin_amdgcn_readfirstlane(lds0 + L_K + (sl) * KSLOT + wid * 1024)); \
        glds16(kt_ + kc2 * 512, (unsigned)__builtin_amdgcn_readfirstlane(lds0 + L_K + (sl) * KSLOT + kc2 * 1024)); } while (0)
#define MLA_DMA_V(t, sl) glds16(Vh + (size_t)(t) * 4096 + wid * 512, (unsigned)__builtin_amdgcn_readfirstlane(lds0 + L_V + (sl) * VSLOT + wid * 1024))
#define MLA_GROUP(g, s0, s2) do { if ((g) + 3 < NT) MLA_DMA_K((g) + 3, s0); if ((g) + 2 < NT) MLA_DMA_V((g) + 2, s2); } while (0)
#define MLA_LOADK(sl) do { const lcp kb_ = (lcp)shm + L_K + (sl) * KSLOT + hi * 1024 + r32 * 16; _Pragma("unroll") for (int d0 = 0; d0 < 6; ++d0) { kf[2 * d0] = *(const LAS bf16x8*)(kb_ + d0 * 2048); kf[2 * d0 + 1] = *(const LAS bf16x8*)(kb_ + d0 * 2048 + 512); } } while (0)
    MLA_DMA_K(0, 0); MLA_DMA_K(1, 1); MLA_DMA_V(0, 0); MLA_DMA_K(2, 2); MLA_DMA_V(1, 1);
    float m = 0.f, l = 0.f; f32x16 o[2], negm;
#pragma unroll
    for (int r = 0; r < 16; ++r) { o[0][r] = 0.f; o[1][r] = 0.f; negm[r] = 0.f; }
    const int qrel = wid * 32 + r32;
    bf16x8 kf[12], vf[8]; u32x4 pw0 = {0u, 0u, 0u, 0u}, pw1 = pw0, pw2 = pw0, pw3 = pw0;
    ATT_WAIT_BAR(6);
    MLA_LOADK(0);
    if (grp == 1) ATT_WAIT_BAR(3);
    int s0 = 0, s1 = 1, s2 = 2;
    bool act_prev = false;
    for (int t = 0; t < NT; ++t) {
        if (grp == 1) MLA_GROUP(t, s0, s2);
        const int jb = t - (NT - 4);
        const bool act = ABL != 5 && (jb <= 0 || 64 * jb <= wid * 32 + 31);
        f32x16 p0 = negm, p1 = negm;
        if (act) {
#pragma unroll
            for (int d0 = 0; d0 < 6; ++d0) { p0 = __builtin_amdgcn_mfma_f32_32x32x16_bf16(kf[2 * d0], qr[d0], p0, 0, 0, 0); p1 = __builtin_amdgcn_mfma_f32_32x32x16_bf16(kf[2 * d0 + 1], qr[d0], p1, 0, 0, 0); }
        }
        if (act_prev) {
#pragma unroll
            for (int ks = 0; ks < 4; ++ks) { const u32x4 pw = ks == 0 ? pw0 : ks == 1 ? pw1 : ks == 2 ? pw2 : pw3;
                o[0] = __builtin_amdgcn_mfma_f32_32x32x16_bf16(__builtin_bit_cast(bf16x8, pw), vf[ks], o[0], 0, 0, 0);
                o[1] = __builtin_amdgcn_mfma_f32_32x32x16_bf16(__builtin_bit_cast(bf16x8, pw), vf[4 + ks], o[1], 0, 0, 0); }
        }
        if (grp == 0) { if (t + 2 < NT) ATT_WAIT_BAR(3); else ATT_WAIT_BAR(0); MLA_GROUP(t, s0, s2); }
        else MLA_BAR_L();
        if (act) {
            { const lcp vp = (lcp)shm + L_V + s0 * VSLOT + ((lane >> 4) & 1) * 32 + (lane & 3) * 8 + (4 * hi + ((lane & 15) >> 2)) * 64;
#pragma unroll
                for (int d0 = 0; d0 < 2; ++d0)
#pragma unroll
                    for (int ks = 0; ks < 4; ++ks) { const s16x4 lo = vtr(vp + d0 * 4096 + ks * 1024), hh = vtr(vp + d0 * 4096 + ks * 1024 + 512);
                        vf[d0 * 4 + ks] = (bf16x8){lo[0], lo[1], lo[2], lo[3], hh[0], hh[1], hh[2], hh[3]}; } }
        }
        if (t + 1 < NT) MLA_LOADK(s1);
        if (act) {
            if (jb >= 0) {
#pragma unroll
                for (int r = 0; r < 16; ++r) { const int kv = 64 * jb + crow(r, hi); if (kv > qrel) p0[r] = -INFINITY; if (kv + 32 > qrel) p1[r] = -INFINITY; }
            }
            const float rm = rowmax(p0, p1);
            if (t == 0 || __any(rm > 8.0f)) {
                const float dl = t == 0 ? rm : __builtin_fmaxf(rm, 0.f); m += dl;
#pragma unroll
                for (int r = 0; r < 16; ++r) { p0[r] -= dl; p1[r] -= dl; negm[r] = -m; }
                const float alpha = fast_exp2(-dl); l *= alpha; if (hi == 0) wsf[r32] = alpha;
#pragma unroll
                for (int r = 0; r < 16; ++r) { const float a = wsf[crow(r, hi)]; o[0][r] *= a; o[1][r] *= a; }
            }
            float sa = 0.f, sb = 0.f;
#pragma unroll
            for (int r = 0; r < 16; ++r) { if (ABL != 1) { p0[r] = fast_exp2(p0[r]); p1[r] = fast_exp2(p1[r]); } sa += p0[r]; sb += p1[r]; }
            l += sa + sb;
            pw0 = (u32x4){pk_bf16(p0[0], p0[1]), pk_bf16(p0[2], p0[3]), pk_bf16(p0[4], p0[5]), pk_bf16(p0[6], p0[7])};
            pw1 = (u32x4){pk_bf16(p0[8], p0[9]), pk_bf16(p0[10], p0[11]), pk_bf16(p0[12], p0[13]), pk_bf16(p0[14], p0[15])};
            pw2 = (u32x4){pk_bf16(p1[0], p1[1]), pk_bf16(p1[2], p1[3]), pk_bf16(p1[4], p1[5]), pk_bf16(p1[6], p1[7])};
            pw3 = (u32x4){pk_bf16(p1[8], p1[9]), pk_bf16(p1[10], p1[11]), pk_bf16(p1[12], p1[13]), pk_bf16(p1[14], p1[15])};
        }
        act_prev = act;
        if (grp == 0) MLA_BAR_L();
        else { if (t + 3 < NT) ATT_WAIT_BAR(3); else ATT_WAIT_BAR(0); }
        { const int tmp = s0; s0 = s1; s1 = s2; s2 = tmp; }
    }
#undef MLA_DMA_K
#undef MLA_DMA_V
#undef MLA_GROUP
#undef MLA_LOADK
    if (act_prev) {
#pragma unroll
        for (int ks = 0; ks < 4; ++ks) { const u32x4 pw = ks == 0 ? pw0 : ks == 1 ? pw1 : ks == 2 ? pw2 : pw3;
            o[0] = __builtin_amdgcn_mfma_f32_32x32x16_bf16(__builtin_bit_cast(bf16x8, pw), vf[ks], o[0], 0, 0, 0);
            o[1] = __builtin_amdgcn_mfma_f32_32x32x16_bf16(__builtin_bit_cast(bf16x8, pw), vf[4 + ks], o[1], 0, 0, 0); }
    }
    if (grp == 0) MLA_BAR_L();
    { auto rr = __builtin_amdgcn_permlane32_swap(__float_as_uint(l), __float_as_uint(l), false, false); l = __uint_as_float(rr[0]) + __uint_as_float(rr[1]); }
    if (hi == 0) wsf[32 + r32] = l;
    float rli[16];
#pragma unroll
    for (int r = 0; r < 16; ++r) rli[r] = fast_rcp(wsf[32 + crow(r, hi)]);
    store_o(o, rli, shm + L_OST + wid * 4096, O + (size_t)(rowbase + q0 + wid * 32) * 512 + h * 64, 512, lane, r32, hi);
    MLA_BAR_L();
}
template <int ABL> __device__ __forceinline__ void phase(int vcu, int G, const bf16_t* Q, const bf16_t* KT, const bf16_t* VT, bf16_t* O, LAS unsigned char* shm) {
    for (int v = vcu; v < 256; v += G) { const int bh = v >> 4, s = v & 15;
        unit<ABL>(bh >> 3, bh & 7, 31 - s, Q, KT, VT, O, shm);
        unit<ABL>(bh >> 3, bh & 7, s, Q, KT, VT, O, shm); }
}
}

namespace sba {
constexpr int KSLOT = 8192, VSLOT = 8192, NS = 3;
constexpr int L_K = 0, L_V = NS * KSLOT, L_WS = L_V + NS * VSLOT, L_FLAG = L_WS + 2048, L_OST = L_FLAG + 256, L_END = L_OST + 8 * 4096;
constexpr float SB_EXIT = -160.0f;
__device__ __forceinline__ void unit(int b, int kh, int qb64, const bf16_t* Q, const bf16_t* KT, const bf16_t* VT, bf16_t* O, LAS unsigned char* shm) {
    int tid_ = threadIdx.x; asm volatile("" : "+v"(tid_));
    const int tid = tid_, lane = tid & 63, r32 = lane & 31, hi = lane >> 5; const int wid = __builtin_amdgcn_readfirstlane(tid >> 6);
    const int h = kh * 4 + (wid >> 1), half = wid & 1;
    const long rowbase = (long)b * SEQL; const int q0 = qb64 * 64;
    const bf16_t* Qw = Q + (size_t)(rowbase + q0 + half * 32) * 1024 + h * 64;
    const bf16_t* Kh = KT + (size_t)((b * 4 + kh) * 128) * 4096 + wid * 512 + lane * 8;
    const bf16_t* Vh = VT + (size_t)((b * 4 + kh) * 128) * 4096 + wid * 512 + lane * 8;
    const unsigned lds0 = (unsigned)(uintptr_t)shm;
    LAS int* flags = (LAS int*)(shm + L_FLAG);
    const int NT = qb64 + 1;
#define SBA_DMA(k, sl) do { const int tile_ = qb64 - (k); \
        glds16(Kh + (size_t)tile_ * 4096, (unsigned)__builtin_amdgcn_readfirstlane(lds0 + L_K + (sl) * KSLOT + wid * 1024)); \
        glds16(Vh + (size_t)tile_ * 4096, (unsigned)__builtin_amdgcn_readfirstlane(lds0 + L_V + (sl) * VSLOT + wid * 1024)); } while (0)
    SBA_DMA(0, 0); if (NT > 1) SBA_DMA(1, 1);
    bf16x8 qr[4];
#pragma unroll
    for (int d0 = 0; d0 < 4; ++d0) qr[d0] = *(const bf16x8*)(Qw + (size_t)r32 * 1024 + d0 * 16 + hi * 8);
    float R = 0.f; f32x16 o[2];
#pragma unroll
    for (int r = 0; r < 16; ++r) { o[0][r] = 0.f; o[1][r] = 0.f; }
    const int qrel = half * 32 + r32;
    int slot = 0;
    for (int k = 0; k < NT; ++k) {
        if (k + 1 < NT) ATT_WAIT_BAR(2); else ATT_WAIT_BAR(0);
        if (k > 0) { const LAS int* f = flags + ((k - 1) & 1) * 8; int all = 1;
#pragma unroll
            for (int w = 0; w < 8; ++w) all &= f[w];
            if (all) break; }
        if (k + 2 < NT) { const int s2 = slot == 0 ? 2 : slot - 1; SBA_DMA(k + 2, s2); }
        {
            const lcp kb = (lcp)shm + L_K + slot * KSLOT + hi * 1024 + r32 * 16;
            f32x16 p0, p1;
#pragma unroll
            for (int r = 0; r < 16; ++r) { p0[r] = 0.f; p1[r] = 0.f; }
#pragma unroll
            for (int d0 = 0; d0 < 4; ++d0) { const bf16x8 b0 = *(const LAS bf16x8*)(kb + d0 * 2048), b1 = *(const LAS bf16x8*)(kb + d0 * 2048 + 512);
                p0 = __builtin_amdgcn_mfma_f32_32x32x16_bf16(b0, qr[d0], p0, 0, 0, 0); p1 = __builtin_amdgcn_mfma_f32_32x32x16_bf16(b1, qr[d0], p1, 0, 0, 0); }
            f32x16 L0, L1;
#pragma unroll
            for (int r = 0; r < 16; ++r) {
                const float z0 = p0[r], z1 = p1[r];
                float s0 = -(__builtin_fmaxf(z0, 0.f) + fast_log2(1.0f + fast_exp2(-__builtin_fabsf(z0))));
                float s1 = -(__builtin_fmaxf(z1, 0.f) + fast_log2(1.0f + fast_exp2(-__builtin_fabsf(z1))));
                if (k == 0) { const int kv = crow(r, hi); if (kv >= qrel) s0 = 0.f; if (kv + 32 >= qrel) s1 = 0.f; }
                L0[r] = s0; L1[r] = s1; }
            float G[16];
#pragma unroll
            for (int j = 0; j < 8; ++j) { const f32x16& LL = j < 4 ? L0 : L1; const int rb = 4 * (j & 3);
                const float gsum = (LL[rb] + LL[rb + 1]) + (LL[rb + 2] + LL[rb + 3]);
                auto rr = __builtin_amdgcn_permlane32_swap(__float_as_uint(gsum), __float_as_uint(gsum), false, false);
                G[2 * j] = __uint_as_float(rr[0]); G[2 * j + 1] = __uint_as_float(rr[1]); }
            float SG[16]; SG[15] = 0.f;
#pragma unroll
            for (int g = 14; g >= 0; --g) SG[g] = SG[g + 1] + G[g + 1];
            const float T = SG[0] + G[0];
#pragma unroll
            for (int j = 0; j < 8; ++j) { f32x16& LL = j < 4 ? L0 : L1; f32x16& PP = j < 4 ? p0 : p1; const int rb = 4 * (j & 3);
                const float base = (R + SG[2 * j + 1]) + (hi ? 0.f : G[2 * j + 1]);
                const float r3 = base, r2 = r3 + LL[rb + 3], r1 = r2 + LL[rb + 2], r0 = r1 + LL[rb + 1];
                PP[rb + 3] = fast_exp2(PP[rb + 3] + LL[rb + 3] + r3); PP[rb + 2] = fast_exp2(PP[rb + 2] + LL[rb + 2] + r2);
                PP[rb + 1] = fast_exp2(PP[rb + 1] + LL[rb + 1] + r1); PP[rb] = fast_exp2(PP[rb] + LL[rb] + r0); }
            if (k == 0) {
#pragma unroll
                for (int r = 0; r < 16; ++r) { const int kv = crow(r, hi); if (kv >= qrel) p0[r] = 0.f; if (kv + 32 >= qrel) p1[r] = 0.f; }
            }
            R += T;
            const u32x4 pw0 = {pk_bf16(p0[0], p0[1]), pk_bf16(p0[2], p0[3]), pk_bf16(p0[4], p0[5]), pk_bf16(p0[6], p0[7])};
            const u32x4 pw1 = {pk_bf16(p0[8], p0[9]), pk_bf16(p0[10], p0[11]), pk_bf16(p0[12], p0[13]), pk_bf16(p0[14], p0[15])};
            const u32x4 pw2 = {pk_bf16(p1[0], p1[1]), pk_bf16(p1[2], p1[3]), pk_bf16(p1[4], p1[5]), pk_bf16(p1[6], p1[7])};
            const u32x4 pw3 = {pk_bf16(p1[8], p1[9]), pk_bf16(p1[10], p1[11]), pk_bf16(p1[12], p1[13]), pk_bf16(p1[14], p1[15])};
            const lcp vp = (lcp)shm + L_V + slot * VSLOT + ((lane >> 4) & 1) * 32 + (lane & 3) * 8 + (4 * hi + ((lane & 15) >> 2)) * 64;
            pv(o, vp, pw0, pw1, pw2, pw3);
            const int dn = __all(R < SB_EXIT) ? 1 : 0;
            if (lane == 0) flags[(k & 1) * 8 + wid] = dn;
        }
        slot = slot == 2 ? 0 : slot + 1;
    }
#undef SBA_DMA
    ATT_WAIT_BAR(0);
    float one[16];
#pragma unroll
    for (int r = 0; r < 16; ++r) one[r] = 1.0f;
    store_o(o, one, shm + L_OST + wid * 4096, O + (size_t)(rowbase + q0 + half * 32) * 1024 + h * 64, 1024, lane, r32, hi);
    asm volatile("s_waitcnt lgkmcnt(0)\n\ts_barrier" ::: "memory");
}
__device__ __forceinline__ void phase(int vcu, int G, const bf16_t* Q, const bf16_t* KT, const bf16_t* VT, bf16_t* O, LAS unsigned char* shm) {
    for (int u = vcu * 4; u < 1024; u += G * 4)
        for (int i = 0; i < 4; ++i) { const int uu = u + i, qb64 = uu & 127, bk = uu >> 7; unit(bk >> 2, bk & 3, qb64, Q, KT, VT, O, shm); }
}
}
}
namespace fw {
constexpr size_t MiB = 1u << 20;
constexpr int NWAVES = 8, NTHR = 512;
constexpr int MAXSLOT = 34816;
constexpr size_t WS_CTL = 0, CTL_ZERO_BYTES = 64 * 1024;
constexpr size_t WS_TOKE = 1 * MiB;
constexpr size_t WS_TOKG = WS_TOKE + 64 * 1024;
constexpr size_t WS_TOKRS = WS_TOKG + 128 * 1024;
constexpr size_t WS_SLOT12 = WS_TOKRS + 64 * 1024;
constexpr size_t WS_SLOTG = WS_SLOT12 + 128 * 1024;
constexpr size_t WS_SLOTRS = WS_SLOTG + 256 * 1024;
constexpr size_t WS_CNT = WS_SLOTRS + 256 * 1024;
constexpr size_t WS_PSTART = WS_CNT + 16 * 1024;
constexpr size_t WS_CS = 4 * MiB;
constexpr size_t WS_SSQ = 6 * MiB;
constexpr size_t WS_SSQQ = 8 * MiB;
constexpr size_t WS_SSQKV = WS_SSQQ + 512 * 1024;
constexpr size_t WS_KPE = 9 * MiB;
constexpr size_t WS_W = 16 * MiB;
constexpr size_t W_AIN = WS_W, W_QUP = W_AIN + 3 * MiB, W_KVUP = W_QUP + 2 * MiB, W_AOUT = W_KVUP + 1 * MiB, W_KVS = W_AOUT + 2 * MiB, W_QB = W_KVS + 1 * MiB,
                 W_OB = W_QB + 4 * MiB, W_PG = W_OB + 4 * MiB, W_PU = W_PG + 8 * MiB, W_FGU = W_PU + 2 * MiB, W_FDN = W_FGU + 22 * MiB, W_EGU = W_FDN + 11 * MiB,
                 W_EDN = W_EGU + 176 * MiB, W_END = W_EDN + 88 * MiB;
constexpr size_t WS_PB = W_END;
constexpr size_t WS_HB = WS_PB + 32 * MiB;
constexpr size_t WS_U = WS_HB + 64 * MiB;
constexpr size_t WS_SKT = WS_U + 128 * MiB, WS_SVT = WS_SKT + 8 * MiB;
constexpr size_t WS_X = WS_SVT + 8 * MiB;
constexpr size_t X_AQ = WS_X, X_AKV = X_AQ + 12 * MiB, X_QRAW = X_AKV + 8 * MiB, X_KVRAW = X_QRAW + 24 * MiB, X_Q = X_KVRAW + 32 * MiB, X_KT = X_Q + 24 * MiB, X_VT = X_KT + 24 * MiB, X_O = X_VT + 16 * MiB;
constexpr size_t X_SQ = WS_X, X_SO = X_SQ + 32 * MiB;
constexpr size_t X_HID = WS_X;
constexpr size_t X_XG = WS_X, X_HG = X_XG + 68 * MiB, X_YG = X_HG + 187 * MiB, X_END = X_YG + 68 * MiB;
constexpr size_t WS_END = X_END;
static_assert(X_O + 16 * MiB <= X_END && (size_t)MAXSLOT * 2816 * 2 <= 187 * MiB && (size_t)MAXSLOT * 1024 * 2 <= 68 * MiB, "ws map");
constexpr int CW_BAR = 1024;
constexpr int RING_OFF = 0, RING_BYTES = 131072, LDSCTL_OFF = RING_BYTES, MISC_OFF = LDSCTL_OFF + 320, LDS_BYTES = 147456;
static_assert(att::mla::L_END <= RING_BYTES && att::sba::L_END <= RING_BYTES, "attention LDS");
constexpr float QSCALE_MLA = 0.10206207261596577f * LOG2E;
constexpr float QSCALE_SB = 0.125f * LOG2E;

constexpr int PH_PER_LAYER = 12, PH_TOTAL = 2 + 4 * PH_PER_LAYER;
__host__ __device__ inline bool phase_active(int idx) {
    if (idx < 2) return true;
    const int l = (idx - 2) / PH_PER_LAYER, s = (idx - 2) % PH_PER_LAYER; const bool mla = l < 2, moe = (l & 1) != 0;
    if (s == 1 || s == 2) return mla;
    if (s >= 7 && s <= 9) return moe;
    if (s == 11) return l == 1;
    return true;
}

struct Args { const float* in[26]; float* out; unsigned char* ws; int ph_lo, ph_hi; };

struct Frame { LAS unsigned char* lds; int tid, lane, wave, vcu, G; };

__device__ __forceinline__ float wave_sum(float v) {
#pragma unroll
    for (int o = 1; o < 64; o <<= 1) v += __shfl_xor(v, o);
    return v;
}
template <bool NT> __device__ __forceinline__ void transpose_item(const float* W, int ldw, int sca, int scb, const float* gain, bf16_t* WT, int K, int drow0, int k0, LAS float* scr, int lane) {
    const int r8 = lane >> 3, pc = lane & 7, c = lane & 7;
    f32x4 va[8], vb[8]; float g[8];
    const f32x4 z4 = {0.f, 0.f, 0.f, 0.f};
#pragma unroll
    for (int i = 0; i < 8; ++i) { const float* rp = W + (size_t)(k0 + i * 8 + r8) * ldw + 4 * pc;
        if (NT) { va[i] = sca >= 0 ? __builtin_nontemporal_load((const f32x4*)(rp + sca)) : z4; vb[i] = scb >= 0 ? __builtin_nontemporal_load((const f32x4*)(rp + scb)) : z4; }
        else { va[i] = sca >= 0 ? *(const f32x4*)(rp + sca) : z4; vb[i] = scb >= 0 ? *(const f32x4*)(rp + scb) : z4; }
        g[i] = gain ? gain[k0 + i * 8 + r8] : 1.0f; }
#pragma unroll
    for (int hf = 0; hf < 2; ++hf) {
#pragma unroll
        for (int i = 0; i < 8; ++i) { const f32x4 v = (hf == 0 ? va[i] : vb[i]) * g[i]; LAS float* d = scr + (i * 8 + r8) * 33 + 4 * pc; d[0] = v[0]; d[1] = v[1]; d[2] = v[2]; d[3] = v[3]; }
        asm volatile("s_waitcnt lgkmcnt(0)" ::: "memory");
#pragma unroll
        for (int j = 0; j < 4; ++j) { const int n = (lane >> 3) + 8 * j; const LAS float* s = scr + (8 * c) * 33 + n;
            u32x4 o; o.x = pk_bf16(s[0 * 33], s[1 * 33]); o.y = pk_bf16(s[2 * 33], s[3 * 33]); o.z = pk_bf16(s[4 * 33], s[5 * 33]); o.w = pk_bf16(s[6 * 33], s[7 * 33]);
            if (NT) __builtin_nontemporal_store(o, (u32x4*)(WT + (size_t)(drow0 + hf * 32 + n) * K + k0 + 8 * c)); else *(u32x4*)(WT + (size_t)(drow0 + hf * 32 + n) * K + k0 + 8 * c) = o; }
        asm volatile("s_waitcnt lgkmcnt(0)" ::: "memory");
    }
}
struct Fam { int src, count, K, Nd, ldw, map, gain, gstride; size_t sstride, dst, dstride; };
__device__ __forceinline__ int fam_items(const Fam& f) { return f.count * (f.K / 64) * (f.Nd / 64); }
__device__ __forceinline__ int fam_src_col(int map, int n0) {
    if (map == 1) return n0 < 384 ? n0 : (n0 < 416 ? 640 + (n0 - 384) : (n0 < 512 ? -1 : 384 + (n0 - 512)));
    if (map == 2) { const int pn = n0 >> 8, jj = n0 & 255; return jj < 128 ? pn * 128 + jj : 2816 + pn * 128 + (jj - 128); }
    return n0;
}
template <bool NT = false> __device__ __forceinline__ void fam_item(const Args& a, const Fam& f, int fid, int it, LAS float* scr, int lane, int mi_off = 0) {
    const int per = (f.K / 64) * (f.Nd / 64), mi = it / per + mi_off, r = it % per, nblk = f.Nd / 64, kb = r / nblk, nb = r % nblk, n0 = nb * 64;
    const float* gain = nullptr;
    if (f.gain >= 0) gain = a.in[f.gain] + (fid == 11 ? (size_t)(2 * (mi >> 3) + 1) * 1024 : (size_t)mi * f.gstride);
    transpose_item<NT>(a.in[f.src] + (size_t)mi * f.sstride, f.ldw, fam_src_col(f.map, n0), fam_src_col(f.map, n0 + 32), gain, (bf16_t*)(a.ws + f.dst + (size_t)mi * f.dstride), f.K, n0, kb * 64, scr, lane);
}
__constant__ const Fam FAMS[13] = {
        {4, 2, 1024, 768, 672, 1, 3, 1024, (size_t)1024 * 672, W_AIN, (size_t)768 * 1024 * 2},
        {7, 2, 384, 768, 768, 0, 5, 384, (size_t)384 * 768, W_QUP, (size_t)768 * 384 * 2},
        {8, 2, 256, 1024, 1024, 0, 6, 256, (size_t)256 * 1024, W_KVUP, (size_t)1024 * 256 * 2},
        {11, 2, 512, 1024, 1024, 0, -1, 0, (size_t)512 * 1024, W_AOUT, (size_t)1024 * 512 * 2},
        {13, 1, 1024, 512, 512, 0, 12, 0, 0, W_KVS, 0},
        {15, 2, 1024, 1024, 1024, 0, 14, 1024, (size_t)1024 * 1024, W_QB, (size_t)1024 * 1024 * 2},
        {16, 2, 1024, 1024, 1024, 0, -1, 0, (size_t)1024 * 1024, W_OB, (size_t)1024 * 1024 * 2},
        {24, 4, 1024, 1024, 1024, 0, 23, 1024, (size_t)1024 * 1024, W_PG, (size_t)1024 * 1024 * 2},
        {25, 4, 256, 1024, 1024, 0, -1, 0, (size_t)256 * 1024, W_PU, (size_t)1024 * 256 * 2},
        {18, 1, 1024, 5632, 5632, 2, 17, 2048, (size_t)1024 * 5632, W_FGU, (size_t)5632 * 1024 * 2},
        {19, 1, 2816, 1024, 1024, 0, -1, 0, (size_t)2816 * 1024, W_FDN, (size_t)1024 * 2816 * 2},
        {21, 8, 1024, 5632, 5632, 2, 17, 0, (size_t)1024 * 5632, W_EGU, (size_t)5632 * 1024 * 2},
        {22, 8, 2816, 1024, 1024, 0, -1, 0, (size_t)2816 * 1024, W_EDN, (size_t)1024 * 2816 * 2}};
constexpr int DEF_N0 = 1408, DEF_N1 = DEF_N0 + 704, DEF_N2 = DEF_N1 + 11264, DEF_N3 = DEF_N2 + 5632;
#ifndef FILL_A
#define FILL_A 0
#define FILL_B 0
#define FILL_C 0
#define FILL_D 0
#endif
constexpr int DEF_QA = FILL_A, DEF_QB = DEF_QA + FILL_B, DEF_QC = DEF_QB + FILL_C, DEF_QD = DEF_QC + FILL_D;
constexpr int CW_FILL = 512;
__device__ __forceinline__ void prologue(const Args& a, Frame& F) {
    LAS float* scr = (LAS float*)(F.lds + RING_OFF + F.wave * 16384);
    const int gw = F.vcu * NWAVES + F.wave, NGW = F.G * NWAVES;
    int base = 0;
#pragma unroll 1
    for (int fid = 0; fid < 13; ++fid) { const Fam f = FAMS[fid]; const int n = fam_items(f);
        int it = gw - (base % NGW); if (it < 0) it += NGW;
#pragma unroll 1
        for (; it < n; it += NGW) fam_item(a, f, fid, it, scr, F.lane);
        base += n; }
    for (int id = DEF_QD + gw; id < DEF_N3; id += NGW) {
        if (id < DEF_N0) fam_item(a, FAMS[9], 9, id, scr, F.lane, 1);
        else if (id < DEF_N1) fam_item(a, FAMS[10], 10, id - DEF_N0, scr, F.lane, 1);
        else if (id < DEF_N2) fam_item(a, FAMS[11], 11, id - DEF_N1, scr, F.lane, 8);
        else fam_item(a, FAMS[12], 12, id - DEF_N2, scr, F.lane, 8);
    }
    { const f32x4* src = (const f32x4*)a.in[1]; u32x2* dst = (u32x2*)(a.ws + WS_PB); const size_t n4 = (size_t)4 * MT * 256 / 4, S = (size_t)NGW * 64;
        for (size_t i = (size_t)gw * 64 + F.lane; i < n4; i += 4 * S) { f32x4 v[4];
#pragma unroll
            for (int q = 0; q < 4; ++q) v[q] = (i + q * S < n4) ? src[i + q * S] : (f32x4){0.f, 0.f, 0.f, 0.f};
#pragma unroll
            for (int q = 0; q < 4; ++q) if (i + q * S < n4) { u32x2 o; o.x = pk_bf16(v[q][0], v[q][1]); o.y = pk_bf16(v[q][2], v[q][3]); dst[i + q * S] = o; } } }
    { bf16_t* HB = (bf16_t*)(a.ws + WS_HB); float* SSQ = (float*)(a.ws + WS_SSQ);
        for (int row = gw; row < MT; row += NGW) { const f32x4* xr = (const f32x4*)(a.in[0] + (size_t)row * DMODEL) + F.lane;
            u32x2* hb = (u32x2*)(HB + (size_t)row * DMODEL) + F.lane; float s = 0.f; f32x4 v4[4];
#pragma unroll
            for (int j = 0; j < 4; ++j) v4[j] = xr[64 * j];
#pragma unroll
            for (int j = 0; j < 4; ++j) { const f32x4 v = v4[j]; u32x2 o; o.x = pk_bf16(v[0], v[1]); o.y = pk_bf16(v[2], v[3]); hb[64 * j] = o; s += (v[0] * v[0] + v[1] * v[1]) + (v[2] * v[2] + v[3] * v[3]); }
            s = wave_sum(s); if (F.lane < 16) SSQ[(size_t)row * 16 + F.lane] = F.lane == 0 ? s : 0.f; } }
    { float* cs = (float*)(a.ws + WS_CS); const int* pos = (const int*)a.in[2];
        for (int i = gw * 64 + F.lane; i < MT * 16; i += NGW * 64) { const int row = i >> 4, f = i & 15;
            const float invf = (float)exp(-9.210340371976184 * (double)f / 16.0);
            const double ang = (double)((float)pos[row] * invf);
            const double rev = ang * 0.15915494309189535, fr = rev - rint(rev); const float x = (float)(fr * 6.283185307179586);
            cs[(size_t)row * 32 + f] = cosf(x); cs[(size_t)row * 32 + 16 + f] = sinf(x); } }
}
#define THIN_LAUNDER() Frame F = F_; unsigned char* wsl = a.ws; asm volatile("" : "+v"(F.tid), "+v"(F.lane), "+s"(F.wave), "+s"(F.vcu), "+s"(F.G), "+s"(wsl))
__device__ __forceinline__ void filler(const Args& a, const Frame& F_, int qi, int start, int end) {
    Frame F = F_; { int t_ = threadIdx.x; asm volatile("" : "+v"(t_)); F.tid = t_; F.lane = t_ & 63; F.wave = __builtin_amdgcn_readfirstlane(t_ >> 6); }
    unsigned char* wsl = a.ws; asm volatile("" : "+s"(wsl));
    LAS float* scr = (LAS float*)(F.lds + RING_OFF + F.wave * 16384);
    unsigned* ctr = (unsigned*)(wsl + WS_CTL) + CW_FILL + qi;
    for (;;) {
        int id = 0; if (F.lane == 0) id = (int)__hip_atomic_fetch_add(ctr, 1u, __ATOMIC_RELAXED, __HIP_MEMORY_SCOPE_AGENT) + start;
        id = __builtin_amdgcn_readfirstlane(id);
        if (id >= end) break;
        if (id < DEF_N0) fam_item<true>(a, FAMS[9], 9, id, scr, F.lane, 1);
        else if (id < DEF_N1) fam_item<true>(a, FAMS[10], 10, id - DEF_N0, scr, F.lane, 1);
        else if (id < DEF_N2) fam_item<true>(a, FAMS[11], 11, id - DEF_N1, scr, F.lane, 8);
        else fam_item<true>(a, FAMS[12], 12, id - DEF_N2, scr, F.lane, 8);
    }
}
__device__ __forceinline__ void norm_rope_8(f32x4& n0, f32x4& n1, f32x4& r0, f32x4& r1, const float* gain, const float* cs, int sub, float outscale) {
    float ss = pg8::sumsq8(n0, n1) + pg8::sumsq8(r0, r1);
    ss += __shfl_xor(ss, 1); ss += __shfl_xor(ss, 2); ss += __shfl_xor(ss, 4);
    const float rq = (1.0f / sqrtf(ss * (1.0f / 96.0f) + RMS_EPS));
    const f32x4 g0 = *(const f32x4*)(gain + 8 * sub), g1 = *(const f32x4*)(gain + 8 * sub + 4);
    n0 = n0 * g0 * (rq * outscale); n1 = n1 * g1 * (rq * outscale);
    const int s4 = sub & 3;
    const f32x4 h0 = *(const f32x4*)(gain + 64 + 8 * s4), h1 = *(const f32x4*)(gain + 64 + 8 * s4 + 4);
    r0 = r0 * h0 * (rq * outscale); r1 = r1 * h1 * (rq * outscale);
    f32x4 p0, p1;
#pragma unroll
    for (int j = 0; j < 4; ++j) { p0[j] = __shfl_xor(r0[j], 2); p1[j] = __shfl_xor(r1[j], 2); }
    const f32x4 c0 = *(const f32x4*)(cs + 8 * (sub & 1)), c1 = *(const f32x4*)(cs + 8 * (sub & 1) + 4), s0 = *(const f32x4*)(cs + 16 + 8 * (sub & 1)), s1 = *(const f32x4*)(cs + 16 + 8 * (sub & 1) + 4);
    if (s4 < 2) { r0 = r0 * c0 - p0 * s0; r1 = r1 * c1 - p1 * s1; }
    else { r0 = r0 * c0 + p0 * s0; r1 = r1 * c1 + p1 * s1; }
}
__device__ __forceinline__ void mla_prep(const Args& a, const Frame& F_, int layer) { THIN_LAUNDER();
    const bf16_t* QRAW = (const bf16_t*)(wsl + X_QRAW); const bf16_t* KVRAW = (const bf16_t*)(wsl + X_KVRAW); const float* KPE = (const float*)(wsl + WS_KPE);
    const float* CS = (const float*)(wsl + WS_CS); const float* gq = a.in[9] + layer * 96; const float* gk = a.in[10] + layer * 96;
    bf16_t* Q = (bf16_t*)(wsl + X_Q); bf16_t* KT = (bf16_t*)(wsl + X_KT); bf16_t* VT = (bf16_t*)(wsl + X_VT);
    const int gw = F.vcu * NWAVES + F.wave, NGW = F.G * NWAVES, h = F.lane >> 3, sub = F.lane & 7;
    const f32x4 z4 = {0.f, 0.f, 0.f, 0.f};
    for (int row = gw; row < MT; row += NGW) {
        const int b = row >> 13, sq = row & 8191, tile = sq >> 6, rr = sq & 63; const float* cs = CS + (size_t)row * 32;
        { const bf16_t* qrow = QRAW + (size_t)row * 768 + h * 96; f32x4 n0, n1, r0 = z4, r1 = z4;
            unpack8(*(const u32x4*)(qrow + 8 * sub), n0, n1); if (sub < 4) unpack8(*(const u32x4*)(qrow + 64 + 8 * sub), r0, r1);
            norm_rope_8(n0, n1, r0, r1, gq, cs, sub, QSCALE_MLA);
            bf16_t* qo = Q + (size_t)row * 768 + h * 96; *(u32x4*)(qo + 8 * sub) = pack8(n0, n1); if (sub < 4) *(u32x4*)(qo + 64 + 8 * sub) = pack8(r0, r1); }
        { const bf16_t* krow = KVRAW + (size_t)row * 1024 + h * 128; f32x4 n0, n1, r0 = z4, r1 = z4;
            unpack8(*(const u32x4*)(krow + 8 * sub), n0, n1); if (sub < 4) { r0 = *(const f32x4*)(KPE + (size_t)row * 32 + 8 * sub); r1 = *(const f32x4*)(KPE + (size_t)row * 32 + 8 * sub + 4); }
            norm_rope_8(n0, n1, r0, r1, gk, cs, sub, 1.0f);
            bf16_t* kt = KT + (size_t)((b * 8 + h) * 128 + tile) * 6144 + rr * 8; *(u32x4*)(kt + sub * 512) = pack8(n0, n1); if (sub < 4) *(u32x4*)(kt + (8 + sub) * 512) = pack8(r0, r1);
            const u32x4 v = *(const u32x4*)(krow + 64 + 8 * sub);
            *(u32x4*)(VT + (size_t)((b * 8 + h) * 128 + tile) * 4096 + (sub >> 2) * 2048 + rr * 32 + (sub & 3) * 8) = v; }
    }
}
__device__ __forceinline__ void moe_route(const Args& a, const Frame& F_, int layer, int cur) { THIN_LAUNDER();
    const bf16_t* HB = (const bf16_t*)(wsl + WS_HB) + (size_t)cur * MT * DMODEL; const float* gain = a.in[17] + (size_t)layer * 1024; const float* wr = a.in[20] + (size_t)(layer >> 1) * 1024 * 8;
    int* TOKE = (int*)(wsl + WS_TOKE); float* TOKG = (float*)(wsl + WS_TOKG); float* TOKRS = (float*)(wsl + WS_TOKRS); int* CNT = (int*)(wsl + WS_CNT);
    LAS float* wg = (LAS float*)(F.lds + RING_OFF);
    LAS int* lcnt = (LAS int*)(F.lds + RING_OFF + 32768);
    for (int i = F.tid; i < 1024 * 8; i += NTHR) wg[i] = wr[i] * gain[i >> 3];
    for (int chunk = F.vcu; chunk < MT / 64; chunk += F.G) {
        if (F.tid < 8) lcnt[F.tid] = 0;
        __syncthreads();
        for (int tt = 0; tt < 8; ++tt) { const int tok = chunk * 64 + F.wave * 8 + tt;
            const u32x2* hr = (const u32x2*)(HB + (size_t)tok * DMODEL) + F.lane; float lg[8], ss = 0.f;
#pragma unroll
            for (int e = 0; e < 8; ++e) lg[e] = 0.f;
#pragma unroll
            for (int j = 0; j < 4; ++j) { const u32x2 hv = hr[64 * j]; const f32x4 v = {bf_lo(hv.x), bf_hi(hv.x), bf_lo(hv.y), bf_hi(hv.y)}; ss += (v[0] * v[0] + v[1] * v[1]) + (v[2] * v[2] + v[3] * v[3]);
#pragma unroll
                for (int i = 0; i < 4; ++i) { const LAS f32x4* w = (const LAS f32x4*)(wg + (size_t)(256 * j + 4 * F.lane + i) * 8); const f32x4 w0 = w[0], w1 = w[1];
                    lg[0] += v[i] * w0[0]; lg[1] += v[i] * w0[1]; lg[2] += v[i] * w0[2]; lg[3] += v[i] * w0[3]; lg[4] += v[i] * w1[0]; lg[5] += v[i] * w1[1]; lg[6] += v[i] * w1[2]; lg[7] += v[i] * w1[3]; } }
            ss = wave_sum(ss);
#pragma unroll
            for (int e = 0; e < 8; ++e) lg[e] = wave_sum(lg[e]);
            const float r = 1.0f / sqrtf(ss * (1.0f / 1024.0f) + RMS_EPS);
            int e1 = 0; float v1 = lg[0];
#pragma unroll
            for (int e = 1; e < 8; ++e) if (lg[e] > v1) { v1 = lg[e]; e1 = e; }
            int e2 = 0; float v2 = -3.0e38f;
#pragma unroll
            for (int e = 0; e < 8; ++e) if (e != e1 && lg[e] > v2) { v2 = lg[e]; e2 = e; }
            const float p2 = __expf((v2 - v1) * r), g1 = 1.0f / (1.0f + p2), g2 = p2 / (1.0f + p2);
            if (F.lane == 0) { TOKE[tok] = e1 | (e2 << 8); TOKG[tok * 2] = g1; TOKG[tok * 2 + 1] = g2; TOKRS[tok] = r; __hip_atomic_fetch_add(lcnt + e1, 1, __ATOMIC_RELAXED, __HIP_MEMORY_SCOPE_WORKGROUP); __hip_atomic_fetch_add(lcnt + e2, 1, __ATOMIC_RELAXED, __HIP_MEMORY_SCOPE_WORKGROUP); }
        }
        __syncthreads();
        if (F.tid < 8) CNT[chunk * 8 + F.tid] = lcnt[F.tid];
        __syncthreads();
    }
}
__device__ __forceinline__ void moe_scatter(const Args& a, const Frame& F_, int cur) { THIN_LAUNDER();
    const int* TOKE = (const int*)(wsl + WS_TOKE); const float* TOKG = (const float*)(wsl + WS_TOKG); const float* TOKRS = (const float*)(wsl + WS_TOKRS); const int* CNT = (const int*)(wsl + WS_CNT);
    int* SLOT12 = (int*)(wsl + WS_SLOT12); float* SLOTG = (float*)(wsl + WS_SLOTG); float* SLOTRS = (float*)(wsl + WS_SLOTRS); int* PSTART = (int*)(wsl + WS_PSTART);
    const bf16_t* HB = (const bf16_t*)(wsl + WS_HB) + (size_t)cur * MT * DMODEL; bf16_t* XG = (bf16_t*)(wsl + X_XG);
    LAS int* sm = (LAS int*)(F.lds + RING_OFF);
    for (int chunk = F.vcu; chunk < MT / 64; chunk += F.G) {
        { const int e = F.wave; int c4[4]; int s = 0;
#pragma unroll
            for (int i = 0; i < 4; ++i) { c4[i] = CNT[(4 * F.lane + i) * 8 + e]; s += c4[i]; }
            int inc = s;
#pragma unroll
            for (int o = 1; o < 64; o <<= 1) { const int t = __shfl_up(inc, o); if (F.lane >= o) inc += t; }
            const int total = __shfl(inc, 63); int pre = inc - s;
            if (F.lane == (chunk >> 2)) { const int cm = chunk & 3; pre += (cm > 0 ? c4[0] : 0) + (cm > 1 ? c4[1] : 0) + (cm > 2 ? c4[2] : 0); sm[8 + e] = pre; }
            if (F.lane == 0) sm[e] = total; }
        __syncthreads();
        if (F.tid == 0) { int p = 0; for (int e = 0; e < 8; ++e) { sm[16 + e] = p; p += (sm[e] + 255) >> 8; } sm[24] = p; }
        __syncthreads();
        if (F.tid < 9) PSTART[F.tid] = sm[16 + F.tid];
        if (F.wave == 0) { const int tok = chunk * 64 + F.lane; const int ev = TOKE[tok], e1 = ev & 255, e2 = ev >> 8; int s1 = 0, s2 = 0;
            const unsigned long long below = (1ull << F.lane) - 1ull;
#pragma unroll
            for (int e = 0; e < 8; ++e) { const unsigned long long m1 = __ballot(e1 == e), m2 = __ballot(e2 == e);
                const int rank = __popcll(m1 & below) + __popcll(m2 & below), slot = sm[16 + e] * 256 + sm[8 + e] + rank;
                if (e1 == e) s1 = slot; if (e2 == e) s2 = slot; }
            SLOT12[tok * 2] = s1; SLOT12[tok * 2 + 1] = s2; const float r = TOKRS[tok];
            SLOTG[s1] = TOKG[tok * 2]; SLOTG[s2] = TOKG[tok * 2 + 1]; SLOTRS[s1] = r; SLOTRS[s2] = r;
            sm[32 + 2 * F.lane] = s1; sm[32 + 2 * F.lane + 1] = s2; }
        __syncthreads();
        for (int i = 0; i < 16; ++i) { const int pr = F.wave * 16 + i, tok = chunk * 64 + (pr >> 1), slot = sm[32 + pr];
            const u32x4* src = (const u32x4*)(HB + (size_t)tok * DMODEL) + F.lane; u32x4* dst = (u32x4*)(XG + (size_t)slot * DMODEL) + F.lane;
            dst[0] = src[0]; dst[64] = src[64]; }
        __syncthreads();
    }
}
__device__ __forceinline__ void moe_combine(const Args& a, const Frame& F_, int cur, bool dummy) { THIN_LAUNDER();
    const int* SLOT12 = (const int*)(wsl + WS_SLOT12); const bf16_t* YG = (const bf16_t*)(wsl + X_YG);
    const bf16_t* HBi = (const bf16_t*)(wsl + WS_HB) + (size_t)cur * MT * DMODEL;
    bf16_t* HB = dummy ? (bf16_t*)(wsl + WS_END + 66 * MiB) : (bf16_t*)(wsl + WS_HB) + (size_t)cur * MT * DMODEL; float* SSQ = dummy ? (float*)(wsl + WS_END + 99 * MiB) : (float*)(wsl + WS_SSQ) + (size_t)cur * MT * 16;
    const int gw = F.vcu * NWAVES + F.wave, NGW = F.G * NWAVES;
    for (int row = gw; row < MT; row += NGW) { const int s1 = SLOT12[row * 2], s2 = SLOT12[row * 2 + 1];
        const u32x2* hr = (const u32x2*)(HBi + (size_t)row * DMODEL) + F.lane; u32x2* hb = (u32x2*)(HB + (size_t)row * DMODEL) + F.lane;
        const u32x2* y1 = (const u32x2*)(YG + (size_t)s1 * DMODEL) + F.lane; const u32x2* y2 = (const u32x2*)(YG + (size_t)s2 * DMODEL) + F.lane; float s = 0.f;
        u32x2 hv[4], pv_[4], qv[4];
#pragma unroll
        for (int j = 0; j < 4; ++j) { hv[j] = hr[64 * j]; pv_[j] = y1[64 * j]; qv[j] = y2[64 * j]; }
#pragma unroll
        for (int j = 0; j < 4; ++j) { const u32x2 h = hv[j], p = pv_[j], q = qv[j]; f32x4 v;
            v[0] = bf_lo(h.x) + (bf_lo(p.x) + bf_lo(q.x)); v[1] = bf_hi(h.x) + (bf_hi(p.x) + bf_hi(q.x)); v[2] = bf_lo(h.y) + (bf_lo(p.y) + bf_lo(q.y)); v[3] = bf_hi(h.y) + (bf_hi(p.y) + bf_hi(q.y));
            u32x2 o; o.x = pk_bf16(v[0], v[1]); o.y = pk_bf16(v[2], v[3]); hb[64 * j] = o; s += (v[0] * v[0] + v[1] * v[1]) + (v[2] * v[2] + v[3] * v[3]); }
        s = wave_sum(s); if (F.lane < 16) SSQ[(size_t)row * 16 + F.lane] = F.lane == 0 ? s : 0.f; }
}

__global__ void __launch_bounds__(NTHR, 2) yoco_fwd(Args args) {
    extern __shared__ __attribute__((aligned(16))) unsigned char lds_raw[];
    Frame F; F.lds = (LAS unsigned char*)lds_raw;
    volatile LAS unsigned* MISC = (volatile LAS unsigned*)(F.lds + MISC_OFF);
    F.tid = threadIdx.x; F.lane = F.tid & 63; F.wave = __builtin_amdgcn_readfirstlane(F.tid >> 6);
    F.G = gridDim.x; { const int bx = blockIdx.x; F.vcu = (F.G % 8 == 0) ? (bx % 8) * (F.G / 8) + bx / 8 : bx; }
    for (int u = F.tid; u < (LDS_BYTES - LDSCTL_OFF) / 4; u += NTHR) ((LAS unsigned*)(F.lds + LDSCTL_OFF))[u] = 0u;
    __syncthreads();
    unsigned char* ws = args.ws;
#define WS_LAUNDER() asm volatile("" : "+s"(ws), "+s"(bx), "+s"(F.G), "+s"(F.vcu))
    const bool single = (args.ph_hi - args.ph_lo) > 1;
    XcdBarrier bar; bar.bar = (unsigned*)(ws + WS_CTL) + CW_BAR; bar.x = 0; bar.st = nullptr;
    if (single) bar = xcd_barrier_post((unsigned*)(ws + WS_CTL) + CW_BAR, MISC + 8);
    const int lo = args.ph_lo, hi = args.ph_hi;
#ifndef EN_MASK
#define EN_MASK 0xFFFFFFFFu
#endif
#define EN(b) (((EN_MASK) >> (b)) & 1u)
#define IN(k) (lo <= (k) && (k) < hi)
#ifdef REP_MASK
#define NREPS(k) ((((unsigned long long)(REP_MASK) >> (k)) & 1ull) ? (REP_N) + 1 : 1)
#else
#define NREPS(k) 1
#endif
#define REPLOOP(k) for (int rep_ = 0, nrep_ = NREPS(k); rep_ < nrep_; ++rep_)
#define DUMMY (rep_ + 1 < nrep_)
#define OUT_HB(set) (DUMMY ? (bf16_t*)(ws + WS_END + 66 * MiB) : (bf16_t*)(ws + WS_HB) + (size_t)(set) * MT * DMODEL)
#define OUT_SSQ(set) (DUMMY ? (float*)(ws + WS_END + 99 * MiB) : (float*)(ws + WS_SSQ) + (size_t)(set) * MT * 16)
#define SEAM(k) do { if (single && (k) + 1 < hi) { XcdBarrier b_ = bar; asm volatile("" : "+s"(b_.bar), "+s"(b_.x)); xcd_barrier(b_); } } while (0)

    LAS unsigned char* ring = F.lds + RING_OFF;
    int bx = (int)blockIdx.x;

    if (EN(0) && IN(0)) REPLOOP(0) { prologue(args, F); SEAM(0); }
    if (EN(1) && IN(1)) REPLOOP(1) { WS_LAUNDER();
#pragma unroll 1
        for (int i = 0; i < 4; ++i) {
            pg8::Gemm g{(const bf16_t*)(ws + WS_PB) + (size_t)i * MT * 256, (const bf16_t*)(ws + W_PU) + (size_t)i * 1024 * 256, MT, 1024, 256};
            pg8::StaticOrder S; S.init(MT, 1024, F.G, bx);
            pg8::EpiScale E{(bf16_t*)(ws + WS_U) + (size_t)i * MT * DMODEL, 1024, pg8::RowScale{nullptr, 0}, 1.0f};
            pg8::gemm_phase<pg8::EpiScale, pg8::StaticOrder, true, true>(ring, g, S, E);
        }
        SEAM(1);
    }
#pragma unroll 1
    for (int l = 0; l < 4; ++l) {
        const int base = 2 + PH_PER_LAYER * l; const bool is_mla = l < 2, is_moe = (l & 1) != 0; const int cur = l & 1, j = l & 1;
#define HBc ((const bf16_t*)(ws + WS_HB) + (size_t)cur * MT * DMODEL)
#define HBw ((bf16_t*)(ws + WS_HB) + (size_t)cur * MT * DMODEL)
#define SSQc ((float*)(ws + WS_SSQ) + (size_t)cur * MT * 16)
        if (IN(base + 0)) REPLOOP(base + 0) { WS_LAUNDER();
            if (EN(2) && is_mla) {
                pg8::Gemm g{HBc, (const bf16_t*)(ws + W_AIN) + (size_t)l * 768 * 1024, MT, 768, 1024};
                pg8::StaticOrder S; S.init(MT, 768, F.G, bx);
                pg8::EpiAin E{(bf16_t*)(ws + X_AQ), (bf16_t*)(ws + X_AKV), (float*)(ws + WS_KPE), (float*)(ws + WS_SSQQ), (float*)(ws + WS_SSQKV), pg8::RowScale{SSQc, 1}};
                pg8::gemm_phase<pg8::EpiAin, pg8::StaticOrder, true, true>(ring, g, S, E);
            } else if (EN(3) && !is_mla) {
                pg8::Gemm g{HBc, (const bf16_t*)(ws + W_QB) + (size_t)j * 1024 * 1024, MT, 1024, 1024};
                pg8::StaticOrder S; S.init(MT, 1024, F.G, bx);
                pg8::EpiScale E{(bf16_t*)(ws + X_SQ), 1024, pg8::RowScale{SSQc, 1}, QSCALE_SB};
                pg8::gemm_phase<pg8::EpiScale, pg8::StaticOrder, true, true>(ring, g, S, E);
            }
            SEAM(base + 0);
        }
        if (EN(4) && is_mla && IN(base + 1)) REPLOOP(base + 1) { WS_LAUNDER();
            { pg8::Gemm g{(const bf16_t*)(ws + X_AQ), (const bf16_t*)(ws + W_QUP) + (size_t)l * 768 * 384, MT, 768, 384};
              pg8::StaticOrder S; S.init(MT, 768, F.G, bx);
              pg8::EpiScale E{(bf16_t*)(ws + X_QRAW), 768, pg8::RowScale{(const float*)(ws + WS_SSQQ), 3}, 1.0f};
              pg8::gemm_phase<pg8::EpiScale, pg8::StaticOrder, true, true>(ring, g, S, E); }
            { pg8::Gemm g{(const bf16_t*)(ws + X_AKV), (const bf16_t*)(ws + W_KVUP) + (size_t)l * 1024 * 256, MT, 1024, 256};
              pg8::StaticOrder S; S.init(MT, 1024, F.G, bx);
              pg8::EpiScale E{(bf16_t*)(ws + X_KVRAW), 1024, pg8::RowScale{(const float*)(ws + WS_SSQKV), 4}, 1.0f};
              pg8::gemm_phase<pg8::EpiScale, pg8::StaticOrder, true, true>(ring, g, S, E); }
            SEAM(base + 1);
        }
        if (EN(5) && is_mla && IN(base + 2)) REPLOOP(base + 2) { mla_prep(args, F, l); SEAM(base + 2); }
        if (IN(base + 3)) REPLOOP(base + 3) { WS_LAUNDER();
#if defined(MLA_ABL)
            if (EN(6) && is_mla && DUMMY) att::mla::phase<MLA_ABL>(F.vcu, F.G, (const bf16_t*)(ws + X_Q), (const bf16_t*)(ws + X_KT), (const bf16_t*)(ws + X_VT), (bf16_t*)(ws + WS_END + 66 * MiB), ring);
            else
#endif
            if (EN(6) && is_mla) att::mla::phase<0>(F.vcu, F.G, (const bf16_t*)(ws + X_Q), (const bf16_t*)(ws + X_KT), (const bf16_t*)(ws + X_VT), (bf16_t*)(ws + X_O), ring);
            else if (EN(7) && !is_mla) att::sba::phase(F.vcu, F.G, (const bf16_t*)(ws + X_SQ), (const bf16_t*)(ws + WS_SKT), (const bf16_t*)(ws + WS_SVT), (bf16_t*)(ws + X_SO), ring);
            SEAM(base + 3);
        }
        if (EN(8) && IN(base + 4)) REPLOOP(base + 4) { WS_LAUNDER();
            pg8::Gemm g = is_mla ? pg8::Gemm{(const bf16_t*)(ws + X_O), (const bf16_t*)(ws + W_AOUT) + (size_t)l * 1024 * 512, MT, 1024, 512}
                                 : pg8::Gemm{(const bf16_t*)(ws + X_SO), (const bf16_t*)(ws + W_OB) + (size_t)j * 1024 * 1024, MT, 1024, 1024};
            pg8::StaticOrder S; S.init(MT, 1024, F.G, bx);
            pg8::EpiRes<false> E{HBc, OUT_HB(cur), OUT_SSQ(cur), nullptr, pg8::RowScale{nullptr, 0}, nullptr};
            pg8::gemm_phase<pg8::EpiRes<false>, pg8::StaticOrder, true, true>(ring, g, S, E);
            SEAM(base + 4);
        }
        if (!is_moe) {
            if (EN(9) && IN(base + 5)) REPLOOP(base + 5) { WS_LAUNDER();
                pg8::Gemm g{HBc, (const bf16_t*)(ws + W_FGU) + (size_t)(l >> 1) * 5632 * 1024, MT, 5632, 1024};
                pg8::GroupOrder S; S.init_dense(MT, 5632, F.G, bx);
                pg8::EpiSwiglu E{(bf16_t*)(ws + X_HID), pg8::RowScale{SSQc, 1}};
                pg8::gemm_phase<pg8::EpiSwiglu, pg8::GroupOrder, true, true>(ring, g, S, E);
#if FILL_A + FILL_D > 0
                filler(args, F, l == 0 ? 0 : 3, l == 0 ? 0 : DEF_QC, l == 0 ? DEF_QA : DEF_QD);
#endif
                SEAM(base + 5);
            }
            if (EN(10) && IN(base + 6)) REPLOOP(base + 6) { WS_LAUNDER();
                pg8::Gemm g{(const bf16_t*)(ws + X_HID), (const bf16_t*)(ws + W_FDN) + (size_t)(l >> 1) * 1024 * 2816, MT, 1024, 2816};
                pg8::StaticOrder S; S.init(MT, 1024, F.G, bx);
                pg8::EpiRes<false> E{HBc, OUT_HB(cur), OUT_SSQ(cur), nullptr, pg8::RowScale{nullptr, 0}, nullptr};
                pg8::gemm_phase<pg8::EpiRes<false>, pg8::StaticOrder, true, true>(ring, g, S, E);
                SEAM(base + 6);
            }
        } else {
            if (EN(11) && IN(base + 5)) REPLOOP(base + 5) { WS_LAUNDER(); moe_route(args, F, l, cur); SEAM(base + 5); }
            if (EN(12) && IN(base + 6)) REPLOOP(base + 6) { WS_LAUNDER(); moe_scatter(args, F, cur); SEAM(base + 6); }
            if (EN(13) && IN(base + 7)) REPLOOP(base + 7) { WS_LAUNDER();
                pg8::Gemm g{(const bf16_t*)(ws + X_XG), (const bf16_t*)(ws + W_EGU) + (size_t)(l >> 1) * 8 * 5632 * 1024, MAXSLOT, 5632, 1024};
                pg8::GroupOrder S; S.init((const int*)(ws + WS_PSTART), 5632, F.G, bx, (size_t)5632 * 1024 * 2);
                pg8::EpiSwiglu E{(bf16_t*)(ws + X_HG), pg8::RowScale{(const float*)(ws + WS_SLOTRS), 2}};
                pg8::gemm_phase<pg8::EpiSwiglu, pg8::GroupOrder, true, true>(ring, g, S, E);
#if FILL_B > 0
                if (l == 1) filler(args, F, 1, DEF_QA, DEF_QB);
#endif
                SEAM(base + 7);
            }
            if (EN(14) && IN(base + 8)) REPLOOP(base + 8) { WS_LAUNDER();
                pg8::Gemm g{(const bf16_t*)(ws + X_HG), (const bf16_t*)(ws + W_EDN) + (size_t)(l >> 1) * 8 * 1024 * 2816, MAXSLOT, 1024, 2816};
                pg8::GroupOrder S; S.init((const int*)(ws + WS_PSTART), 1024, F.G, bx, (size_t)1024 * 2816 * 2);
                pg8::EpiScale E{(bf16_t*)(ws + X_YG), 1024, pg8::RowScale{(const float*)(ws + WS_SLOTG), 2}, 1.0f};
                pg8::gemm_phase<pg8::EpiScale, pg8::GroupOrder, true, true>(ring, g, S, E);
#if FILL_C > 0
                if (l == 1) filler(args, F, 2, DEF_QB, DEF_QC);
#endif
                SEAM(base + 8);
            }
            if (EN(15) && IN(base + 9)) REPLOOP(base + 9) { WS_LAUNDER(); moe_combine(args, F, cur, DUMMY); SEAM(base + 9); }
        }
        if (EN(16) && IN(base + 10)) REPLOOP(base + 10) { WS_LAUNDER();
            pg8::Gemm g{HBc, (const bf16_t*)(ws + W_PG) + (size_t)l * 1024 * 1024, MT, 1024, 1024};
            pg8::StaticOrder S; S.init(MT, 1024, F.G, bx);
            pg8::EpiRes<true> E{HBc, OUT_HB(cur ^ 1), OUT_SSQ(cur ^ 1),
                                (const bf16_t*)(ws + WS_U) + (size_t)l * MT * DMODEL, pg8::RowScale{SSQc, 1}, (l == 3 && !DUMMY) ? args.out : nullptr};
            pg8::gemm_phase<pg8::EpiRes<true>, pg8::StaticOrder, true, true>(ring, g, S, E);
            SEAM(base + 10);
        }
        if (EN(17) && l == 1 && IN(base + 11)) REPLOOP(base + 11) { WS_LAUNDER();
            pg8::Gemm g{(const bf16_t*)(ws + WS_HB) + (size_t)(cur ^ 1) * MT * DMODEL, (const bf16_t*)(ws + W_KVS), MT, 512, 1024};
            pg8::StaticOrder S; S.init(MT, 512, F.G, bx);
            pg8::EpiKvs E{(bf16_t*)(ws + WS_SKT), (bf16_t*)(ws + WS_SVT), pg8::RowScale{(const float*)(ws + WS_SSQ) + (size_t)(cur ^ 1) * MT * 16, 1}};
            pg8::gemm_phase<pg8::EpiKvs, pg8::StaticOrder, true, true>(ring, g, S, E);
            SEAM(base + 11);
        }
    }
#undef IN
#undef SEAM
}
}
#define MULTI_LAUNCH 0
extern "C" void kernel_launch(void* const* d_in, const int* in_sizes, int n_in, void* d_out, int out_size, void* d_ws, size_t ws_size, hipStream_t stream) {
    using namespace fw;
    static int grid = 0;
    if (grid == 0) {
        if (n_in != 26 || out_size != MT * DMODEL || ws_size < WS_END) { fprintf(stderr, "kernel_launch: unexpected n_in %d / out %d / ws %zu\n", n_in, out_size, ws_size); grid = -1; return; }
        if (hipFuncSetAttribute((const void*)yoco_fwd, hipFuncAttributeMaxDynamicSharedMemorySize, LDS_BYTES) != hipSuccess) { fprintf(stderr, "kernel_launch: hipFuncSetAttribute failed\n"); grid = -1; return; }
        int dev = 0, cus = 0, per_cu = 0;
        (void)hipGetDevice(&dev); (void)hipDeviceGetAttribute(&cus, hipDeviceAttributeMultiprocessorCount, dev);
        (void)hipOccupancyMaxActiveBlocksPerMultiprocessor(&per_cu, (const void*)yoco_fwd, NTHR, LDS_BYTES);
        (void)hipGetLastError();
        grid = (cus > 0 && per_cu >= 1) ? cus : 256;
        if (grid > 256) grid = 256;
    }
    if (grid < 0) return;
    (void)hipMemsetAsync((unsigned char*)d_ws + WS_CTL, 0, CTL_ZERO_BYTES, stream);
    Args a{};
    for (int i = 0; i < 26; ++i) a.in[i] = (const float*)d_in[i];
    a.out = (float*)d_out; a.ws = (unsigned char*)d_ws;
#if MULTI_LAUNCH
    for (int k = 0; k < PH_TOTAL; ++k) { if (!phase_active(k)) continue; a.ph_lo = k; a.ph_hi = k + 1; hipLaunchKernelGGL(yoco_fwd, dim3(grid), dim3(NTHR), LDS_BYTES, stream, a); }
#else
#ifdef PROBE_MASK
    a.ph_lo = 0; a.ph_hi = PH_TOTAL;
#else
    a.ph_lo = 0; a.ph_hi = PH_TOTAL - 1;
#endif
    hipLaunchKernelGGL(yoco_fwd, dim3(grid), dim3(NTHR), LDS_BYTES, stream, a);
#endif
}
```

```cpp
#include <hip/hip_runtime.h>
#include <cstdio>
#include <cstdint>
#include <cmath>
#define LAS __attribute__((address_space(3)))
#define GAS __attribute__((address_space(1)))
typedef unsigned short bf16_t;
typedef short bf16x8 __attribute__((ext_vector_type(8)));
typedef float f32x4 __attribute__((ext_vector_type(4)));
typedef float f32x2 __attribute__((ext_vector_type(2)));
typedef float f32x16 __attribute__((ext_vector_type(16)));
typedef unsigned u32x4 __attribute__((ext_vector_type(4)));
typedef unsigned u32x2 __attribute__((ext_vector_type(2)));
typedef short s16x4 __attribute__((ext_vector_type(4)));
typedef __bf16 bf16x2_t __attribute__((ext_vector_type(2)));

constexpr int MT = 16384, DMODEL = 1024, SEQL = 8192;
constexpr float RMS_EPS = 1e-6f;
constexpr float LOG2E = 1.4426950408889634f;

__device__ __forceinline__ unsigned pk_bf16(float lo, float hi) { f32x2 v = {lo, hi}; bf16x2_t b = __builtin_convertvector(v, bf16x2_t); return __builtin_bit_cast(unsigned, b); }
__device__ __forceinline__ float bf_lo(unsigned w) { return __uint_as_float(w << 16); }
__device__ __forceinline__ float bf_hi(unsigned w) { return __uint_as_float(w & 0xffff0000u); }
__device__ __forceinline__ unsigned cvt_pk_bf16(float lo, float hi) { unsigned r; asm volatile("v_cvt_pk_bf16_f32 %0, %1, %2" : "=v"(r) : "v"(lo), "v"(hi)); return r; }
__device__ __forceinline__ u32x4 pack8(const f32x4 a, const f32x4 b) { u32x4 w; w.x = cvt_pk_bf16(a[0], a[1]); w.y = cvt_pk_bf16(a[2], a[3]); w.z = cvt_pk_bf16(b[0], b[1]); w.w = cvt_pk_bf16(b[2], b[3]); return w; }
__device__ __forceinline__ void unpack8(const u32x4 w, f32x4& a, f32x4& b) { a = (f32x4){bf_lo(w.x), bf_hi(w.x), bf_lo(w.y), bf_hi(w.y)}; b = (f32x4){bf_lo(w.z), bf_hi(w.z), bf_lo(w.w), bf_hi(w.w)}; }
__device__ __forceinline__ float fast_rcp(float x) { return __builtin_amdgcn_rcpf(x); }
__device__ __forceinline__ float fast_exp2(float x) { return __builtin_amdgcn_exp2f(x); }
__device__ __forceinline__ float fast_log2(float x) { return __builtin_amdgcn_logf(x); }
__device__ __forceinline__ float sigmoidf_(float x) { return fast_rcp(1.0f + fast_exp2(-x * LOG2E)); }

namespace pg8 {
constexpr int BM = 256, BK = 64, HALF = 128, HTB = HALF * BK * 2, STAGE_BYTES = 8 * HTB, NXCD = 8, WGM = 8;
__host__ __device__ __forceinline__ int lds_byte(int r, int c) { const int st = (r >> 4) * 2 + (c >> 5), rr = r & 15, cc = c & 31, ob = rr * 64 + cc * 2; return st * 1024 + (ob ^ (((ob >> 9) & 1) << 5)); }
__host__ __device__ __forceinline__ void stage_rc(int b, int& R, int& C) { const int st = b / 1024, sb = b % 1024, swz = sb ^ (((sb >> 9) & 1) << 5); R = (st >> 1) * 16 + swz / 64; C = (st & 1) * 32 + (swz % 64) / 2; }
__host__ __device__ __forceinline__ int perm32(int rho) { const int n = rho >> 4, i = rho & 15; return 8 * (i >> 2) + 4 * n + (i & 3); }

struct Unit { int pm, pn; size_t boff; };
struct Gemm { const bf16_t* A; const bf16_t* Bt; int M, N, K; };

struct StaticOrder {
    int nM, nN, nwg, G, c;
    __device__ void init(int M, int N, int G_, int c_) { nM = M / BM; nN = N / BM; nwg = nM * nN; G = G_; c = c_; }
    __device__ bool next(int i, Unit& u) const {
        const long L = (long)i * G + c; if (L >= nwg) return false;
        int wgid = (int)L; { const int q = nwg / NXCD, r = nwg % NXCD, xcd = wgid % NXCD, off = wgid / NXCD; wgid = (xcd < r ? xcd * (q + 1) : r * (q + 1) + (xcd - r) * q) + off; }
        const int nig = WGM * nN, gid = wgid / nig, fm = gid * WGM, gsz = (nM - fm) < WGM ? (nM - fm) : WGM;
        u.pm = fm + ((wgid % nig) % gsz); u.pn = (wgid % nig) / gsz; u.boff = 0; return true;
    }
};
struct GroupOrder {
    int ps[9]; int nN, nwg, G, c; size_t estride;
    __device__ void init(const int* pstart, int N, int G_, int c_, size_t estride_) {
#pragma unroll
        for (int e = 0; e < 9; ++e) ps[e] = __builtin_amdgcn_readfirstlane(pstart[e]);
        nN = N / BM; nwg = ps[8] * nN; G = G_; c = c_; estride = estride_; }
    __device__ void init_dense(int M, int N, int G_, int c_) {
        ps[0] = 0;
#pragma unroll
        for (int e = 1; e < 9; ++e) ps[e] = M / BM;
        nN = N / BM; nwg = ps[8] * nN; G = G_; c = c_; estride = 0; }
    __device__ bool next(int i, Unit& u) const {
        const long L = (long)i * G + c; if (L >= nwg) return false;
        int wgid = (int)L; { const int q = nwg / NXCD, r = nwg % NXCD, xcd = wgid % NXCD, off = wgid / NXCD; wgid = (xcd < r ? xcd * (q + 1) : r * (q + 1) + (xcd - r) * q) + off; }
        int e = 0;
#pragma unroll
        for (int k = 1; k < 8; ++k) if (wgid >= ps[k] * nN) e = k;
        int p0 = ps[0], p1 = ps[1];
#pragma unroll
        for (int k = 1; k < 8; ++k) if (e == k) { p0 = ps[k]; p1 = ps[k + 1]; }
        const int local = wgid - p0 * nN, np = p1 - p0;
        u.pn = local / np; u.pm = p0 + (local % np); u.boff = (size_t)e * estride; return true;
    }
};


__device__ __forceinline__ float sumsq8(const f32x4 a, const f32x4 b) { return ((a[0] * a[0] + a[1] * a[1]) + (a[2] * a[2] + a[3] * a[3])) + ((b[0] * b[0] + b[1] * b[1]) + (b[2] * b[2] + b[3] * b[3])); }
__device__ __forceinline__ float red_fq(float s) { s += __shfl_xor(s, 16); s += __shfl_xor(s, 32); return s; }
struct RowScale {
    const float* p; int mode;
    __device__ __forceinline__ float get(int row, int fq) const {
        if (mode == 0) return 1.0f;
        if (mode == 2) return p[row];
        if (mode == 1) { const f32x4 a = *(const f32x4*)(p + (size_t)row * 16 + 4 * fq); const float s = red_fq((a[0] + a[1]) + (a[2] + a[3])); return 1.0f / sqrtf(s * (1.0f / 1024.0f) + RMS_EPS); }
        if (mode == 3) { const f32x4 a = *(const f32x4*)(p + (size_t)row * 8 + 4 * (fq & 1)); const float s = red_fq(fq < 2 ? (a[0] + a[1]) + (a[2] + a[3]) : 0.f); return 1.0f / sqrtf(s * (1.0f / 384.0f) + RMS_EPS); }
        { const float s = red_fq(p[(size_t)row * 4 + fq]); return 1.0f / sqrtf(s * (1.0f / 256.0f) + RMS_EPS); }
    }
    __device__ __forceinline__ void get8(float (&rsv)[2][4], int row0, int fq) const {
#pragma unroll
        for (int ai = 0; ai < 2; ++ai)
#pragma unroll
            for (int m = 0; m < 4; ++m) rsv[ai][m] = get(row0 + ai * 128 + m * 16, fq);
        asm volatile("" ::: "memory");
    }
};

struct EpiScale {
    static constexpr bool PERM = true, AFTER_DRAIN = false;
    bf16_t* O; int ldc; RowScale rs; float cs;
    __device__ __forceinline__ void operator()(const f32x4 (&acc)[2][2][4][2], const Unit& u, int wr, int wc, int fr, int fq) const {
        const int row0 = u.pm * BM + wr * 64 + fr, col0 = u.pn * BM + wc * 32 + 8 * fq;
        float rsv[2][4]; rs.get8(rsv, row0, fq);
#pragma unroll
        for (int ai = 0; ai < 2; ++ai)
#pragma unroll
            for (int m = 0; m < 4; ++m) { const int row = row0 + ai * HALF + m * 16; const float s = rsv[ai][m] * cs; bf16_t* rowp = O + (size_t)row * ldc + col0;
#pragma unroll
                for (int bj = 0; bj < 2; ++bj) *(u32x4*)(rowp + bj * HALF) = pack8(acc[ai][bj][m][0] * s, acc[ai][bj][m][1] * s); }
    }
};
struct EpiAin {
    static constexpr bool PERM = true, AFTER_DRAIN = false;
    bf16_t* AQ; bf16_t* AKV; float* KPE; float* SSQQ; float* SSQKV; RowScale rs;
    __device__ __forceinline__ void operator()(const f32x4 (&acc)[2][2][4][2], const Unit& u, int wr, int wc, int fr, int fq) const {
        const int row0 = u.pm * BM + wr * 64 + fr, c8 = wc * 32 + 8 * fq;
        float rsv[2][4]; rs.get8(rsv, row0, fq);
#pragma unroll
        for (int ai = 0; ai < 2; ++ai)
#pragma unroll
            for (int m = 0; m < 4; ++m) { const int row = row0 + ai * HALF + m * 16; const float s = rsv[ai][m];
                const f32x4 a0 = acc[ai][0][m][0] * s, a1 = acc[ai][0][m][1] * s, b0 = acc[ai][1][m][0] * s, b1 = acc[ai][1][m][1] * s;
                if (u.pn == 0) {
                    *(u32x4*)(AQ + (size_t)row * 384 + c8) = pack8(a0, a1); *(u32x4*)(AQ + (size_t)row * 384 + 128 + c8) = pack8(b0, b1);
                    const float q = red_fq(sumsq8(a0, a1) + sumsq8(b0, b1)); if (fq == 0) SSQQ[(size_t)row * 8 + wc] = q;
                } else if (u.pn == 1) {
                    *(u32x4*)(AQ + (size_t)row * 384 + 256 + c8) = pack8(a0, a1);
                    const float q = red_fq(sumsq8(a0, a1)); if (fq == 0) SSQQ[(size_t)row * 8 + 4 + wc] = q;
                    if (wc == 0) { *(f32x4*)(KPE + (size_t)row * 32 + 8 * fq) = b0; *(f32x4*)(KPE + (size_t)row * 32 + 8 * fq + 4) = b1; }
                } else {
                    *(u32x4*)(AKV + (size_t)row * 256 + c8) = pack8(a0, a1); *(u32x4*)(AKV + (size_t)row * 256 + 128 + c8) = pack8(b0, b1);
                    const float q = red_fq(sumsq8(a0, a1) + sumsq8(b0, b1)); if (fq == 0) SSQKV[(size_t)row * 4 + wc] = q;
                } }
    }
};
struct EpiSwiglu {
    static constexpr bool PERM = true, AFTER_DRAIN = false;
    bf16_t* HID; RowScale rs;
    __device__ __forceinline__ void operator()(const f32x4 (&acc)[2][2][4][2], const Unit& u, int wr, int wc, int fr, int fq) const {
        const int row0 = u.pm * BM + wr * 64 + fr, col0 = u.pn * 128 + wc * 32 + 8 * fq;
        float rsv[2][4]; rs.get8(rsv, row0, fq);
#pragma unroll
        for (int ai = 0; ai < 2; ++ai)
#pragma unroll
            for (int m = 0; m < 4; ++m) { const int row = row0 + ai * HALF + m * 16; const float s = rsv[ai][m];
                f32x4 o[2];
#pragma unroll
                for (int n = 0; n < 2; ++n) { const f32x4 g = acc[ai][0][m][n] * s, up = acc[ai][1][m][n] * s;
#pragma unroll
                    for (int j = 0; j < 4; ++j) o[n][j] = g[j] * sigmoidf_(g[j]) * up[j]; }
                *(u32x4*)(HID + (size_t)row * 2816 + col0) = pack8(o[0], o[1]); }
    }
};
template <bool GATED> struct EpiRes {
    static constexpr bool PERM = true, AFTER_DRAIN = false;
    const bf16_t* HBi; bf16_t* HBo; float* SSQo; const bf16_t* U; RowScale rs; float* OUTF;
    __device__ __forceinline__ void operator()(const f32x4 (&acc)[2][2][4][2], const Unit& u, int wr, int wc, int fr, int fq) const {
        const int row0 = u.pm * BM + wr * 64 + fr, col0 = u.pn * BM + wc * 32 + 8 * fq;
        float rsv[2][4]; if (GATED) rs.get8(rsv, row0, fq);
#pragma unroll
        for (int ai = 0; ai < 2; ++ai)
#pragma unroll
            for (int m = 0; m < 4; ++m) { const int row = row0 + ai * HALF + m * 16; const size_t off = (size_t)row * DMODEL + col0;
                float s = 1.0f; if (GATED) s = rsv[ai][m];
                float q = 0.f;
#pragma unroll
                for (int bj = 0; bj < 2; ++bj) { f32x4 a0 = acc[ai][bj][m][0], a1 = acc[ai][bj][m][1];
                    f32x4 h0, h1; unpack8(*(const u32x4*)(HBi + off + bj * HALF), h0, h1);
                    if (GATED) { f32x4 u0, u1; unpack8(*(const u32x4*)(U + off + bj * HALF), u0, u1);
#pragma unroll
                        for (int j = 0; j < 4; ++j) { a0[j] = sigmoidf_(a0[j] * s) * u0[j]; a1[j] = sigmoidf_(a1[j] * s) * u1[j]; } }
                    h0 += a0; h1 += a1;
                    if (GATED) { if (OUTF) { *(f32x4*)(OUTF + off + bj * HALF) = h0; *(f32x4*)(OUTF + off + bj * HALF + 4) = h1; } }
                    *(u32x4*)(HBo + off + bj * HALF) = pack8(h0, h1);
                    q += sumsq8(h0, h1); }
                q = red_fq(q); if (fq == 0) SSQo[(size_t)row * 16 + u.pn * 4 + wc] = q;
                asm volatile("" ::: "memory"); }
    }
};
struct EpiKvs {
    static constexpr bool PERM = true, AFTER_DRAIN = false;
    bf16_t* KT; bf16_t* VT; RowScale rs;
    __device__ __forceinline__ void operator()(const f32x4 (&acc)[2][2][4][2], const Unit& u, int wr, int wc, int fr, int fq) const {
        const int row0 = u.pm * BM + wr * 64 + fr;
        float rsv[2][4]; rs.get8(rsv, row0, fq);
#pragma unroll
        for (int ai = 0; ai < 2; ++ai)
#pragma unroll
            for (int m = 0; m < 4; ++m) { const int row = row0 + ai * HALF + m * 16; const float s = rsv[ai][m];
                const int b = row >> 13, sq = row & 8191, tile = sq >> 6, rr = sq & 63;
#pragma unroll
                for (int bj = 0; bj < 2; ++bj) { const int c = bj * HALF + wc * 32 + 8 * fq, kh = c >> 6, d = c & 63;
                    const size_t tb = (size_t)((b * 4 + kh) * 128 + tile) * 4096;
                    const u32x4 w = pack8(acc[ai][bj][m][0] * s, acc[ai][bj][m][1] * s);
                    if (u.pn == 0) *(u32x4*)(KT + tb + (d >> 3) * 512 + rr * 8) = w;
                    else *(u32x4*)(VT + tb + (d >> 5) * 2048 + rr * 32 + (d & 31)) = w; } }
    }
};

#define PG8_LAS LAS
template <class Epi, class Sched, bool ALIGN_EPI = false, bool SP2 = false>
__device__ __forceinline__ void gemm_phase(PG8_LAS unsigned char* lds, const Gemm g, const Sched& S, const Epi& E) {
    int tid_ = threadIdx.x; asm volatile("" : "+v"(tid_));
    const int tid = tid_, wid = __builtin_amdgcn_readfirstlane(tid >> 6), lane = tid & 63, wr = wid >> 2, wc = wid & 3, fr = lane & 15, fq = lane >> 4;
    const int K = g.K, nt = K / BK;
    unsigned voffA[2], voffB[2];
#pragma unroll
    for (int i = 0; i < 2; ++i) { int R, C; stage_rc(tid * 16 + i * 8192, R, C); const int Rb = Epi::PERM ? ((R & ~31) + perm32(R & 31)) : R;
        voffA[i] = (unsigned)(R * K + C) * 2u; voffB[i] = (unsigned)(Rb * K + C) * 2u; }
    const size_t kstep = (size_t)(BK * 2);
    const size_t hstep = (size_t)HALF * K * 2;
    const size_t tstep = 2 * hstep;
    const unsigned ldsw = (unsigned)wid * 1024u;
    const int aoff = lds_byte(wr * 64 + fr, fq * 8), boff = lds_byte(wc * 32 + fr, fq * 8);
#define PG8_SA(b, h) (((b) * 2 + (h)) * HTB)
#define PG8_SB(b, h) ((4 + (b) * 2 + (h)) * HTB)
#define PG8_STAGE(bufoff, gbase, voff) do { _Pragma("unroll") for (int _i = 0; _i < 2; ++_i) \
        __builtin_amdgcn_global_load_lds((const unsigned*)((const char*)(gbase) + (voff)[_i]), (PG8_LAS unsigned*)(lds + (bufoff) + ldsw + _i * 8192), 16, 0, 0); } while (0)
#define PG8_LDA(dst, b, h) do { _Pragma("unroll") for (int m = 0; m < 4; ++m) _Pragma("unroll") for (int k = 0; k < 2; ++k) dst[m][k] = *(const PG8_LAS bf16x8*)(lds + PG8_SA(b, h) + aoff + m * 2048 + k * 1024); } while (0)
#define PG8_LDB(dst, b, h) do { _Pragma("unroll") for (int n = 0; n < 2; ++n) _Pragma("unroll") for (int k = 0; k < 2; ++k) dst[n][k] = *(const PG8_LAS bf16x8*)(lds + PG8_SB(b, h) + boff + n * 2048 + k * 1024); } while (0)
#define PG8_MMA(ai, bj, At, Bt) do { __builtin_amdgcn_s_setprio(1); _Pragma("unroll") for (int m = 0; m < 4; ++m) _Pragma("unroll") for (int n = 0; n < 2; ++n) _Pragma("unroll") for (int k = 0; k < 2; ++k) \
        acc[ai][bj][m][n] = __builtin_amdgcn_mfma_f32_16x16x32_bf16(Bt[n][k], At[m][k], acc[ai][bj][m][n], 0, 0, 0); __builtin_amdgcn_s_setprio(0); } while (0)
#define PG8_WAIT_V(n) asm volatile("s_waitcnt vmcnt(" #n ")" ::: "memory")
#define PG8_WAIT_L(n) asm volatile("s_waitcnt lgkmcnt(" #n ")" ::: "memory")
#define PG8_BAR __builtin_amdgcn_s_barrier()
#define PG8_SCHED __builtin_amdgcn_sched_barrier(0)
    Unit cur, nxt; int ui = 0;
    if (!S.next(0, cur)) return;
    f32x4 acc[2][2][4][2];
#pragma unroll
    for (int a = 0; a < 2; ++a)
#pragma unroll
        for (int b = 0; b < 2; ++b)
#pragma unroll
            for (int m = 0; m < 4; ++m)
#pragma unroll
                for (int n = 0; n < 2; ++n) acc[a][b][m][n] = (f32x4){0.f, 0.f, 0.f, 0.f};
    bf16x8 At[4][2], B0[2][2], B1[2][2];
    const char* cA = (const char*)g.A + (size_t)cur.pm * tstep; const char* cB = (const char*)g.Bt + cur.boff + (size_t)cur.pn * tstep;
    if constexpr (SP2) {
        PG8_STAGE(PG8_SB(0, 0), cB, voffB); PG8_STAGE(PG8_SB(0, 1), cB + hstep, voffB); PG8_STAGE(PG8_SA(0, 0), cA, voffA); PG8_STAGE(PG8_SA(0, 1), cA + hstep, voffA);
        if (wr == 1) PG8_BAR;
        PG8_WAIT_V(2); PG8_BAR;
        PG8_STAGE(PG8_SB(1, 0), cB + kstep, voffB); PG8_STAGE(PG8_SA(1, 0), cA + kstep, voffA); PG8_STAGE(PG8_SB(1, 1), cB + hstep + kstep, voffB);
        PG8_WAIT_V(6); PG8_BAR;
    } else {
        PG8_STAGE(PG8_SB(0, 0), cB, voffB); PG8_STAGE(PG8_SA(0, 0), cA, voffA); PG8_STAGE(PG8_SB(0, 1), cB + hstep, voffB); PG8_STAGE(PG8_SA(0, 1), cA + hstep, voffA);
        if (wr == 1) PG8_BAR;
        PG8_WAIT_V(4); PG8_BAR;
        PG8_STAGE(PG8_SB(1, 0), cB + kstep, voffB); PG8_STAGE(PG8_SA(1, 0), cA + kstep, voffA); PG8_STAGE(PG8_SB(1, 1), cB + hstep + kstep, voffB);
        PG8_WAIT_V(6); PG8_BAR;
    }
    for (;;) {
        const bool has_next = S.next(ui + 1, nxt);
        const char* nA = has_next ? (const char*)g.A + (size_t)nxt.pm * tstep : cA; const char* nB = has_next ? (const char*)g.Bt + nxt.boff + (size_t)nxt.pn * tstep : cB;
        for (int t = 0; t < nt; t += 2) {
            const bool last = (t == nt - 2);
            const char* a1 = cA + (size_t)(t + 1) * kstep;
            const char* a2 = last ? nA : cA + (size_t)(t + 2) * kstep; const char* b2 = last ? nB : cB + (size_t)(t + 2) * kstep;
            const char* a3 = a2 + kstep; const char* b3 = b2 + kstep;
            if constexpr (SP2) {
            PG8_LDB(B0, 0, 0); PG8_LDB(B1, 0, 1); PG8_SCHED; PG8_LDA(At, 0, 0); PG8_STAGE(PG8_SA(1, 1), a1 + hstep, voffA);
            PG8_WAIT_V(8); PG8_WAIT_L(0); PG8_BAR; PG8_MMA(0, 0, At, B0); PG8_MMA(0, 1, At, B1); PG8_BAR; PG8_SCHED;
            PG8_LDA(At, 0, 1); PG8_STAGE(PG8_SB(0, 0), b2, voffB); PG8_STAGE(PG8_SB(0, 1), b2 + hstep, voffB); PG8_STAGE(PG8_SA(0, 0), a2, voffA);
            PG8_WAIT_V(8); PG8_WAIT_L(0); PG8_BAR; PG8_MMA(1, 0, At, B0); PG8_MMA(1, 1, At, B1); PG8_BAR; PG8_SCHED;
            PG8_LDB(B0, 1, 0); PG8_LDB(B1, 1, 1); PG8_SCHED; PG8_LDA(At, 1, 0); PG8_STAGE(PG8_SA(0, 1), a2 + hstep, voffA);
            PG8_WAIT_V(8); PG8_WAIT_L(0); PG8_BAR; PG8_MMA(0, 0, At, B0); PG8_MMA(0, 1, At, B1); PG8_BAR; PG8_SCHED;
            PG8_LDA(At, 1, 1); PG8_STAGE(PG8_SB(1, 0), b3, voffB); PG8_STAGE(PG8_SB(1, 1), b3 + hstep, voffB); PG8_STAGE(PG8_SA(1, 0), a3, voffA);
            PG8_WAIT_V(8); PG8_WAIT_L(0); PG8_BAR; PG8_MMA(1, 0, At, B0); PG8_MMA(1, 1, At, B1); PG8_BAR; PG8_SCHED;
            } else {
            PG8_LDB(B0, 0, 0); PG8_SCHED; PG8_LDA(At, 0, 0); PG8_STAGE(PG8_SA(1, 1), a1 + hstep, voffA);
            PG8_WAIT_L(8); PG8_BAR; PG8_WAIT_L(0); PG8_MMA(0, 0, At, B0); PG8_BAR; PG8_SCHED;
            PG8_LDB(B1, 0, 1); PG8_STAGE(PG8_SB(0, 0), b2, voffB);
            PG8_BAR; PG8_WAIT_L(0); PG8_MMA(0, 1, At, B1); PG8_BAR;
            PG8_LDA(At, 0, 1); PG8_STAGE(PG8_SA(0, 0), a2, voffA);
            PG8_BAR; PG8_WAIT_L(0); PG8_MMA(1, 0, At, B0); PG8_BAR; PG8_SCHED;
            PG8_STAGE(PG8_SB(0, 1), b2 + hstep, voffB);
            PG8_WAIT_V(6); PG8_BAR; PG8_MMA(1, 1, At, B1); PG8_BAR;
            PG8_LDB(B0, 1, 0); PG8_SCHED; PG8_LDA(At, 1, 0); PG8_STAGE(PG8_SA(0, 1), a2 + hstep, voffA);
            PG8_WAIT_L(8); PG8_BAR; PG8_WAIT_L(0); PG8_MMA(0, 0, At, B0); PG8_BAR; PG8_SCHED;
            PG8_LDB(B1, 1, 1); PG8_STAGE(PG8_SB(1, 0), b3, voffB);
            PG8_BAR; PG8_WAIT_L(0); PG8_MMA(0, 1, At, B1); PG8_BAR;
            PG8_LDA(At, 1, 1); PG8_STAGE(PG8_SA(1, 0), a3, voffA);
            PG8_BAR; PG8_WAIT_L(0); PG8_MMA(1, 0, At, B0); PG8_BAR; PG8_SCHED;
            PG8_STAGE(PG8_SB(1, 1), b3 + hstep, voffB);
            PG8_WAIT_V(6); PG8_BAR; PG8_MMA(1, 1, At, B1); PG8_BAR;
            }
        }
        if constexpr (ALIGN_EPI) { if (wr == 0) PG8_BAR; }
        E(acc, cur, wr, wc, fr, fq);
        if (!has_next) break;
#pragma unroll
        for (int a = 0; a < 2; ++a)
#pragma unroll
            for (int b = 0; b < 2; ++b)
#pragma unroll
                for (int m = 0; m < 4; ++m)
#pragma unroll
                    for (int n = 0; n < 2; ++n) acc[a][b][m][n] = (f32x4){0.f, 0.f, 0.f, 0.f};
        cur = nxt; cA = nA; cB = nB; ++ui;
        if constexpr (ALIGN_EPI) { if (wr == 1) PG8_BAR; }
    }
    PG8_WAIT_V(0);
    if constexpr (!ALIGN_EPI) { if (wr == 0) PG8_BAR; }
    PG8_BAR;
#undef PG8_SA
#undef PG8_SB
#undef PG8_STAGE
#undef PG8_LDA
#undef PG8_LDB
#undef PG8_MMA
#undef PG8_WAIT_V
#undef PG8_WAIT_L
#undef PG8_BAR
#undef PG8_SCHED
}
}
typedef GAS unsigned gu32;
#define RLX_AGENT __ATOMIC_RELAXED, __HIP_MEMORY_SCOPE_AGENT
#define XB_TMO      128
#define XB_XCNT(j)  (256  + 64 * (j))
#define XB_XSUB(j)  (1280 + 64 * (j))
#define XB_XGEN(j)  (2304 + 64 * (j))
#define XB_TOP      3328
#define XB_TOPGEN   3392
#define XCD_BAR_WORDS 3456
#define XB_SPIN_CAP (1u << 18)

__device__ __forceinline__ unsigned xb_ld(unsigned* p)              { return __hip_atomic_load(p, __ATOMIC_RELAXED, __HIP_MEMORY_SCOPE_AGENT); }
__device__ __forceinline__ unsigned xb_add(unsigned* p, unsigned v) { return __hip_atomic_fetch_add(p, v, __ATOMIC_RELAXED, __HIP_MEMORY_SCOPE_AGENT); }
__device__ __forceinline__ unsigned xb_xcc_id() { return (unsigned)__builtin_amdgcn_s_getreg((3 << 11) | 20) & 0xFu; }
#define XB_SPIN(cond, bar) do { unsigned _sp = 0; while (cond) { __builtin_amdgcn_s_sleep(1); \
    if ((++_sp & 255u) == 0u) { if (xb_ld(&(bar)[XB_TMO])) break; if (_sp > XB_SPIN_CAP) { atomicAdd(&(bar)[XB_TMO], 1u); break; } } } } while (0)

struct XcdBarrier {
    unsigned* bar; unsigned x;
    volatile LAS unsigned* st;
};
__device__ __forceinline__ XcdBarrier xcd_barrier_post(unsigned* bar, volatile LAS unsigned* st) {
    XcdBarrier b; b.bar = bar; b.x = xb_xcc_id(); b.st = st;
    if (threadIdx.x == 0) (void)xb_add(&bar[XB_XCNT(b.x)], 1u);
    return b;
}
__device__ __forceinline__ void xcd_barrier_complete(unsigned* bar, unsigned x, unsigned& nloc, unsigned& nx) {
    const unsigned G = gridDim.x * gridDim.y * gridDim.z;
    unsigned sum, cnt, mine, sp = 0u;
    for (;;) {
        sum = 0u; cnt = 0u; mine = 0u;
#pragma unroll
        for (unsigned j = 0; j < 16; ++j) { const unsigned c = xb_ld(&bar[XB_XCNT(j)]); sum += c; cnt += (c > 0u) ? 1u : 0u; mine = (j == x) ? c : mine; }
        if (sum == G) break;
        __builtin_amdgcn_s_sleep(1);
        if ((++sp & 255u) == 0u) { if (xb_ld(&bar[XB_TMO])) break; if (sp > XB_SPIN_CAP) { atomicAdd(&bar[XB_TMO], 1u); break; } }
    }
    nloc = mine > 0u ? mine : 1u; nx = cnt > 0u ? cnt : 1u;
}
__device__ __forceinline__ void xcd_barrier(const XcdBarrier& b) {
    asm volatile("s_waitcnt vmcnt(0)" ::: "memory");
    __syncthreads();
    if (threadIdx.x == 0) {
        unsigned* bar = b.bar;
        __builtin_amdgcn_s_waitcnt(0);
        unsigned nloc = b.st[0], nx = b.st[1];
        if (nloc == 0u) { xcd_barrier_complete(bar, b.x, nloc, nx); b.st[0] = nloc; b.st[1] = nx; }
        const unsigned old = xb_add(&bar[XB_XSUB(b.x)], 1u);
        const unsigned gen = old / nloc;
        if (old + 1u == (gen + 1u) * nloc) {
            __builtin_amdgcn_fence(__ATOMIC_RELEASE, "agent");
            asm volatile("s_waitcnt vmcnt(0)" ::: "memory");
            const unsigned og = xb_add(&bar[XB_TOP], 1u);
            const unsigned tg = og / nx;
            if (og + 1u == (tg + 1u) * nx) xb_add(&bar[XB_TOPGEN], 1u);
            else XB_SPIN(xb_ld(&bar[XB_TOPGEN]) == tg, bar);
            __builtin_amdgcn_fence(__ATOMIC_ACQUIRE, "agent");
            xb_add(&bar[XB_XGEN(b.x)], 1u);
            asm volatile("s_waitcnt vmcnt(0)" ::: "memory");
        } else {
            XB_SPIN(xb_ld(&bar[XB_XGEN(b.x)]) == gen, bar);
            __builtin_amdgcn_fence(__ATOMIC_ACQUIRE, "agent");
            asm volatile("s_waitcnt vmcnt(0)" ::: "memory");
        }
    }
    __syncthreads();
}

namespace att {
__device__ __forceinline__ int crow(int r, int hi) { return (r & 3) + 8 * (r >> 2) + 4 * hi; }
__device__ __forceinline__ void glds16(const void* gsrc, unsigned lds_dst) { unsigned keep;
    asm volatile("s_mov_b32 %0, m0\n\ts_mov_b32 m0, %2\n\ts_nop 0\n\tglobal_load_lds_dwordx4 %1, off\n\ts_mov_b32 m0, %0" : "=&s"(keep) : "v"(gsrc), "s"(lds_dst) : "memory"); }
#define ATT_WAIT_BAR(N) asm volatile("s_waitcnt vmcnt(" #N ") lgkmcnt(0)\n\ts_barrier" ::: "memory")
#define ATT_MX3(a, b, c) __builtin_fmaxf(__builtin_fmaxf((a), (b)), (c))
typedef LAS const unsigned char* lcp;
typedef short v4i16_t __attribute__((ext_vector_type(4)));
__device__ __forceinline__ s16x4 vtr(lcp p) { return __builtin_bit_cast(s16x4, __builtin_amdgcn_ds_read_tr16_b64_v4i16((LAS v4i16_t*)p)); }
__device__ __forceinline__ float rowmax(const f32x16& p0, const f32x16& p1) {
    float a = ATT_MX3(p0[0], p0[1], p1[0]), b = ATT_MX3(p0[2], p0[3], p1[1]); a = ATT_MX3(a, p1[2], p1[3]);
#pragma unroll
    for (int r = 4; r < 16; r += 4) { a = ATT_MX3(a, p0[r], p0[r + 1]); b = ATT_MX3(b, p0[r + 2], p0[r + 3]); a = ATT_MX3(a, p1[r], p1[r + 1]); b = ATT_MX3(b, p1[r + 2], p1[r + 3]); }
    float m = __builtin_fmaxf(a, b); auto rr = __builtin_amdgcn_permlane32_swap(__float_as_uint(m), __float_as_uint(m), false, false);
    return __builtin_fmaxf(__uint_as_float(rr[0]), __uint_as_float(rr[1])); }
template <bool FAKEV = false> __device__ __forceinline__ void pv(f32x16* o, lcp vp, const u32x4 pw0, const u32x4 pw1, const u32x4 pw2, const u32x4 pw3) {
#pragma unroll
    for (int ks = 0; ks < 4; ++ks) {
        const u32x4 pw = ks == 0 ? pw0 : ks == 1 ? pw1 : ks == 2 ? pw2 : pw3;
#pragma unroll
        for (int d0 = 0; d0 < 2; ++d0) {
            bf16x8 vf;
            if (FAKEV) vf = __builtin_bit_cast(bf16x8, ks & 1 ? pw0 : pw2);
            else { const s16x4 lo = vtr(vp + d0 * 4096 + ks * 1024), hi = vtr(vp + d0 * 4096 + ks * 1024 + 512); vf = (bf16x8){lo[0], lo[1], lo[2], lo[3], hi[0], hi[1], hi[2], hi[3]}; }
            o[d0] = __builtin_amdgcn_mfma_f32_32x32x16_bf16(__builtin_bit_cast(bf16x8, pw), vf, o[d0], 0, 0, 0);
        }
    }
}
__device__ __forceinline__ void store_o(const f32x16* o, const float* rsc  , LAS unsigned char* stage, bf16_t* Ow, int pitch, int lane, int r32, int hi) {
    LAS bf16_t* stg = (LAS bf16_t*)stage;
#pragma unroll
    for (int r = 0; r < 16; ++r) { const int orow = crow(r, hi);
#pragma unroll
        for (int d0 = 0; d0 < 2; ++d0) stg[orow * 64 + d0 * 32 + r32] = (bf16_t)(pk_bf16(o[d0][r] * rsc[r], 0.f) & 0xffffu); }
    asm volatile("s_waitcnt lgkmcnt(0)" ::: "memory");
#pragma unroll
    for (int i = 0; i < 4; ++i) { const int row = i * 8 + (lane >> 3), ch = lane & 7; const u32x4 v = *(const LAS u32x4*)(stg + row * 64 + ch * 8); *(u32x4*)(Ow + (size_t)row * pitch + ch * 8) = v; }
}

namespace mla {
constexpr int KSLOT = 12288, VSLOT = 8192, NS = 3;
constexpr int L_K = 0, L_V = NS * KSLOT, L_WS = L_V + NS * VSLOT, L_OST = L_WS + 2048, L_END = L_OST + 8 * 4096;
#define MLA_BAR_L() asm volatile("s_waitcnt lgkmcnt(0)\n\ts_barrier" ::: "memory")
template <int ABL> __device__ __forceinline__ void unit(int b, int h, int qb, const bf16_t* Q, const bf16_t* KT, const bf16_t* VT, bf16_t* O, LAS unsigned char* shm) {
    int tid_ = threadIdx.x; asm volatile("" : "+v"(tid_));
    const int tid = tid_, lane = tid & 63, r32 = lane & 31, hi = lane >> 5; const int wid = __builtin_amdgcn_readfirstlane(tid >> 6);
    const int grp = wid >> 2;
    const long rowbase = (long)b * SEQL; const int q0 = qb * 256;
    const bf16_t* Qw = Q + (size_t)(rowbase + q0 + wid * 32) * 768 + h * 96;
    const bf16_t* Kh = KT + (size_t)((b * 8 + h) * 128) * 6144 + lane * 8;
    const bf16_t* Vh = VT + (size_t)((b * 8 + h) * 128) * 4096 + lane * 8;
    const unsigned lds0 = (unsigned)(uintptr_t)shm;
    LAS float* wsf = (LAS float*)(shm + L_WS) + wid * 64;
    const int NT = (q0 + 256) / 64;
    const int kc2 = 8 + (wid & 3);
    bf16x8 qr[6];
#pragma unroll
    for (int d0 = 0; d0 < 6; ++d0) qr[d0] = *(const bf16x8*)(Qw + (size_t)r32 * 768 + d0 * 16 + hi * 8);
#define MLA_DMA_K(t, sl) do { const bf16_t* kt_ = Kh + (size_t)(t) * 6144; \
        glds16(kt_ + wid * 512, (unsigned)__builtin_amdgcn_readfirstlane(lds0 + L_K + (sl) * KSLOT + wid * 1024)); \
        glds16(kt_ + kc2 * 512, (unsigned)__builtin_amdgcn_readfirstlane(lds0 + L_K + (sl) * KSLOT + kc2 * 1024)); } while (0)
#define MLA_DMA_V(t, sl) glds16(Vh + (size_t)(t) * 4096 + wid * 512, (unsigned)__builtin_amdgcn_readfirstlane(lds0 + L_V + (sl) * VSLOT + wid * 1024))
#define MLA_GROUP(g, s0, s2) do { if ((g) + 3 < NT) MLA_DMA_K((g) + 3, s0); if ((g) + 2 < NT) MLA_DMA_V((g) + 2, s2); } while (0)
#define MLA_LOADK(sl) do { const lcp kb_ = (lcp)shm + L_K + (sl) * KSLOT + hi * 1024 + r32 * 16; _Pragma("unroll") for (int d0 = 0; d0 < 6; ++d0) { kf[2 * d0] = *(const LAS bf16x8*)(kb_ + d0 * 2048); kf[2 * d0 + 1] = *(const LAS bf16x8*)(kb_ + d0 * 2048 + 512); } } while (0)
    MLA_DMA_K(0, 0); MLA_DMA_K(1, 1); MLA_DMA_V(0, 0); MLA_DMA_K(2, 2); MLA_DMA_V(1, 1);
    float m = 0.f, l = 0.f; f32x16 o[2], negm;
#pragma unroll
    for (int r = 0; r < 16; ++r) { o[0][r] = 0.f; o[1][r] = 0.f; negm[r] = 0.f; }
    const int qrel = wid * 32 + r32;
    bf16x8 kf[12], vf[8]; u32x4 pw0 = {0u, 0u, 0u, 0u}, pw1 = pw0, pw2 = pw0, pw3 = pw0;
    ATT_WAIT_BAR(6);
    MLA_LOADK(0);
    if (grp == 1) ATT_WAIT_BAR(3);
    int s0 = 0, s1 = 1, s2 = 2;
    bool act_prev = false;
    for (int t = 0; t < NT; ++t) {
        if (grp == 1) MLA_GROUP(t, s0, s2);
        const int jb = t - (NT - 4);
        const bool act = ABL != 5 && (jb <= 0 || 64 * jb <= wid * 32 + 31);
        f32x16 p0 = negm, p1 = negm;
        if (act) {
#pragma unroll
            for (int d0 = 0; d0 < 6; ++d0) { p0 = __builtin_amdgcn_mfma_f32_32x32x16_bf16(kf[2 * d0], qr[d0], p0, 0, 0, 0); p1 = __builtin_amdgcn_mfma_f32_32x32x16_bf16(kf[2 * d0 + 1], qr[d0], p1, 0, 0, 0); }
        }
        if (act_prev) {
#pragma unroll
            for (int ks = 0; ks < 4; ++ks) { const u32x4 pw = ks == 0 ? pw0 : ks == 1 ? pw1 : ks == 2 ? pw2 : pw3;
                o[0] = __builtin_amdgcn_mfma_f32_32x32x16_bf16(__builtin_bit_cast(bf16x8, pw), vf[ks], o[0], 0, 0, 0);
                o[1] = __builtin_amdgcn_mfma_f32_32x32x16_bf16(__builtin_bit_cast(bf16x8, pw), vf[4 + ks], o[1], 0, 0, 0); }
        }
        if (grp == 0) { if (t + 2 < NT) ATT_WAIT_BAR(3); else ATT_WAIT_BAR(0); MLA_GROUP(t, s0, s2); }
        else MLA_BAR_L();
        if (act) {
            { const lcp vp = (lcp)shm + L_V + s0 * VSLOT + ((lane >> 4) & 1) * 32 + (lane & 3) * 8 + (4 * hi + ((lane & 15) >> 2)) * 64;
#pragma unroll
                for (int d0 = 0; d0 < 2; ++d0)
#pragma unroll
                    for (int ks = 0; ks < 4; ++ks) { const s16x4 lo = vtr(vp + d0 * 4096 + ks * 1024), hh = vtr(vp + d0 * 4096 + ks * 1024 + 512);
                        vf[d0 * 4 + ks] = (bf16x8){lo[0], lo[1], lo[2], lo[3], hh[0], hh[1], hh[2], hh[3]}; } }
        }
        if (t + 1 < NT) MLA_LOADK(s1);
        if (act) {
            if (jb >= 0) {
#pragma unroll
                for (int r = 0; r < 16; ++r) { const int kv = 64 * jb + crow(r, hi); if (kv > qrel) p0[r] = -INFINITY; if (kv + 32 > qrel) p1[r] = -INFINITY; }
            }
            const float rm = rowmax(p0, p1);
            if (t == 0 || __any(rm > 8.0f)) {
                const float dl = t == 0 ? rm : __builtin_fmaxf(rm, 0.f); m += dl;
#pragma unroll
                for (int r = 0; r < 16; ++r) { p0[r] -= dl; p1[r] -= dl; negm[r] = -m; }
                const float alpha = fast_exp2(-dl); l *= alpha; if (hi == 0) wsf[r32] = alpha;
#pragma unroll
                for (int r = 0; r < 16; ++r) { const float a = wsf[crow(r, hi)]; o[0][r] *= a; o[1][r] *= a; }
            }
            float sa = 0.f, sb = 0.f;
#pragma unroll
            for (int r = 0; r < 16; ++r) { if (ABL != 1) { p0[r] = fast_exp2(p0[r]); p1[r] = fast_exp2(p1[r]); } sa += p0[r]; sb += p1[r]; }
            l += sa + sb;
            pw0 = (u32x4){pk_bf16(p0[0], p0[1]), pk_bf16(p0[2], p0[3]), pk_bf16(p0[4], p0[5]), pk_bf16(p0[6], p0[7])};
            pw1 = (u32x4){pk_bf16(p0[8], p0[9]), pk_bf16(p0[10], p0[11]), pk_bf16(p0[12], p0[13]), pk_bf16(p0[14], p0[15])};
            pw2 = (u32x4){pk_bf16(p1[0], p1[1]), pk_bf16(p1[2], p1[3]), pk_bf16(p1[4], p1[5]), pk_bf16(p1[6], p1[7])};
            pw3 = (u32x4){pk_bf16(p1[8], p1[9]), pk_bf16(p1[10], p1[11]), pk_bf16(p1[12], p1[13]), pk_bf16(p1[14], p1[15])};
        }
        act_prev = act;
        if (grp == 0) MLA_BAR_L();
        else { if (t + 3 < NT) ATT_WAIT_BAR(3); else ATT_WAIT_BAR(0); }
        { const int tmp = s0; s0 = s1; s1 = s2; s2 = tmp; }
    }
#undef MLA_DMA_K
#undef MLA_DMA_V
#undef MLA_GROUP
#undef MLA_LOADK
    if (act_prev) {
#pragma unroll
        for (int ks = 0; ks < 4; ++ks) { const u32x4 pw = ks == 0 ? pw0 : ks == 1 ? pw1 : ks == 2 ? pw2 : pw3;
            o[0] = __builtin_amdgcn_mfma_f32_32x32x16_bf16(__builtin_bit_cast(bf16x8, pw), vf[ks], o[0], 0, 0, 0);
            o[1] = __builtin_amdgcn_mfma_f32_32x32x16_bf16(__builtin_bit_cast(bf16x8, pw), vf[4 + ks], o[1], 0, 0, 0); }
    }
    if (grp == 0) MLA_BAR_L();
    { auto rr = __builtin_amdgcn_permlane32_swap(__float_as_uint(l), __float_as_uint(l), false, false); l = __uint_as_float(rr[0]) + __uint_as_float(rr[1]); }
    if (hi == 0) wsf[32 + r32] = l;
    float rli[16];
#pragma unroll
    for (int r = 0; r < 16; ++r) rli[r] = fast_rcp(wsf[32 + crow(r, hi)]);
    store_o(o, rli, shm + L_OST + wid * 4096, O + (size_t)(rowbase + q0 + wid * 32) * 512 + h * 64, 512, lane, r32, hi);
    MLA_BAR_L();
}
template <int ABL> __device__ __forceinline__ void phase(int vcu, int G, const bf16_t* Q, const bf16_t* KT, const bf16_t* VT, bf16_t* O, LAS unsigned char* shm) {
    for (int v = vcu; v < 256; v += G) { const int bh = v >> 4, s = v & 15;
        unit<ABL>(bh >> 3, bh & 7, 31 - s, Q, KT, VT, O, shm);
        unit<ABL>(bh >> 3, bh & 7, s, Q, KT, VT, O, shm); }
}
}

namespace sba {
constexpr int KSLOT = 8192, VSLOT = 8192, NS = 3;
constexpr int L_K = 0, L_V = NS * KSLOT, L_WS = L_V + NS * VSLOT, L_FLAG = L_WS + 2048, L_OST = L_FLAG + 256, L_END = L_OST + 8 * 4096;
constexpr float SB_EXIT = 1.0e-42f;
__device__ __forceinline__ void unit(int b, int kh, int qb64, const bf16_t* Q, const bf16_t* KT, const bf16_t* VT, bf16_t* O, LAS unsigned char* shm) {
    int tid_ = threadIdx.x; asm volatile("" : "+v"(tid_));
    const int tid = tid_, lane = tid & 63, r32 = lane & 31, hi = lane >> 5; const int wid = __builtin_amdgcn_readfirstlane(tid >> 6);
    const int h = kh * 4 + (wid >> 1), half = wid & 1;
    const long rowbase = (long)b * SEQL; const int q0 = qb64 * 64;
    const bf16_t* Qw = Q + (size_t)(rowbase + q0 + half * 32) * 1024 + h * 64;
    const bf16_t* Kh = KT + (size_t)((b * 4 + kh) * 128) * 4096 + wid * 512 + lane * 8;
    const bf16_t* Vh = VT + (size_t)((b * 4 + kh) * 128) * 4096 + wid * 512 + lane * 8;
    const unsigned lds0 = (unsigned)(uintptr_t)shm;
    LAS int* flags = (LAS int*)(shm + L_FLAG);
    const int NT = qb64 + 1;
#define SBA_DMA(k, sl) do { const int tile_ = qb64 - (k); \
        glds16(Kh + (size_t)tile_ * 4096, (unsigned)__builtin_amdgcn_readfirstlane(lds0 + L_K + (sl) * KSLOT + wid * 1024)); \
        glds16(Vh + (size_t)tile_ * 4096, (unsigned)__builtin_amdgcn_readfirstlane(lds0 + L_V + (sl) * VSLOT + wid * 1024)); } while (0)
    SBA_DMA(0, 0); if (NT > 1) SBA_DMA(1, 1);
    bf16x8 qr[4];
#pragma unroll
    for (int d0 = 0; d0 < 4; ++d0) qr[d0] = *(const bf16x8*)(Qw + (size_t)r32 * 1024 + d0 * 16 + hi * 8);
    float R = 1.f; f32x16 o[2];
#pragma unroll
    for (int r = 0; r < 16; ++r) { o[0][r] = 0.f; o[1][r] = 0.f; }
    const int qrel = half * 32 + r32;
    int slot = 0;
    for (int k = 0; k < NT; ++k) {
        if (k + 1 < NT) ATT_WAIT_BAR(2); else ATT_WAIT_BAR(0);
        if (k > 0) { const LAS int* f = flags + ((k - 1) & 1) * 8; int all = 1;
#pragma unroll
            for (int w = 0; w < 8; ++w) all &= f[w];
            if (all) break; }
        if (k + 2 < NT) { const int s2 = slot == 0 ? 2 : slot - 1; SBA_DMA(k + 2, s2); }
        {
            const lcp kb = (lcp)shm + L_K + slot * KSLOT + hi * 1024 + r32 * 16;
            f32x16 p0, p1;
#pragma unroll
            for (int r = 0; r < 16; ++r) { p0[r] = 0.f; p1[r] = 0.f; }
#pragma unroll
            for (int d0 = 0; d0 < 4; ++d0) { const bf16x8 b0 = *(const LAS bf16x8*)(kb + d0 * 2048), b1 = *(const LAS bf16x8*)(kb + d0 * 2048 + 512);
                p0 = __builtin_amdgcn_mfma_f32_32x32x16_bf16(b0, qr[d0], p0, 0, 0, 0); p1 = __builtin_amdgcn_mfma_f32_32x32x16_bf16(b1, qr[d0], p1, 0, 0, 0); }
            f32x16 N0, N1;
#pragma unroll
            for (int r = 0; r < 16; ++r) {
                const float e0 = fast_exp2(-__builtin_amdgcn_fmed3f(p0[r], -100.f, 100.f)), e1 = fast_exp2(-__builtin_amdgcn_fmed3f(p1[r], -100.f, 100.f));
                float b0 = fast_rcp(1.0f + e0), b1 = fast_rcp(1.0f + e1); float n0 = e0 * b0, n1 = e1 * b1;
                if (k == 0) { const int kv = crow(r, hi); if (kv >= qrel) { b0 = 0.f; n0 = 1.f; } if (kv + 32 >= qrel) { b1 = 0.f; n1 = 1.f; } }
                p0[r] = b0; p1[r] = b1; N0[r] = n0; N1[r] = n1; }
            float G[16];
#pragma unroll
            for (int j = 0; j < 8; ++j) { const f32x16& NN = j < 4 ? N0 : N1; const int rb = 4 * (j & 3);
                const float gp = (NN[rb] * NN[rb + 1]) * (NN[rb + 2] * NN[rb + 3]);
                auto rr = __builtin_amdgcn_permlane32_swap(__float_as_uint(gp), __float_as_uint(gp), false, false);
                G[2 * j] = __uint_as_float(rr[0]); G[2 * j + 1] = __uint_as_float(rr[1]); }
            float SG[16]; SG[15] = 1.f;
#pragma unroll
            for (int g = 14; g >= 0; --g) SG[g] = SG[g + 1] * G[g + 1];
            const float T = SG[0] * G[0];
#pragma unroll
            for (int j = 0; j < 8; ++j) { f32x16& NN = j < 4 ? N0 : N1; f32x16& PP = j < 4 ? p0 : p1; const int rb = 4 * (j & 3);
                const float base = (R * SG[2 * j + 1]) * (hi ? 1.f : G[2 * j + 1]);
                const float r3 = base, r2 = r3 * NN[rb + 3], r1 = r2 * NN[rb + 2], r0 = r1 * NN[rb + 1];
                PP[rb + 3] *= r3; PP[rb + 2] *= r2; PP[rb + 1] *= r1; PP[rb] *= r0; }
            R *= T;
            const u32x4 pw0 = {pk_bf16(p0[0], p0[1]), pk_bf16(p0[2], p0[3]), pk_bf16(p0[4], p0[5]), pk_bf16(p0[6], p0[7])};
            const u32x4 pw1 = {pk_bf16(p0[8], p0[9]), pk_bf16(p0[10], p0[11]), pk_bf16(p0[12], p0[13]), pk_bf16(p0[14], p0[15])};
            const u32x4 pw2 = {pk_bf16(p1[0], p1[1]), pk_bf16(p1[2], p1[3]), pk_bf16(p1[4], p1[5]), pk_bf16(p1[6], p1[7])};
            const u32x4 pw3 = {pk_bf16(p1[8], p1[9]), pk_bf16(p1[10], p1[11]), pk_bf16(p1[12], p1[13]), pk_bf16(p1[14], p1[15])};
            const lcp vp = (lcp)shm + L_V + slot * VSLOT + ((lane >> 4) & 1) * 32 + (lane & 3) * 8 + (4 * hi + ((lane & 15) >> 2)) * 64;
            pv(o, vp, pw0, pw1, pw2, pw3);
            const int dn = __all(R < SB_EXIT) ? 1 : 0;
            if (lane == 0) flags[(k & 1) * 8 + wid] = dn;
        }
        slot = slot == 2 ? 0 : slot + 1;
    }
#undef SBA_DMA
    ATT_WAIT_BAR(0);
    float one[16];
#pragma unroll
    for (int r = 0; r < 16; ++r) one[r] = 1.0f;
    store_o(o, one, shm + L_OST + wid * 4096, O + (size_t)(rowbase + q0 + half * 32) * 1024 + h * 64, 1024, lane, r32, hi);
    asm volatile("s_waitcnt lgkmcnt(0)\n\ts_barrier" ::: "memory");
}
__device__ __forceinline__ void phase(int vcu, int G, const bf16_t* Q, const bf16_t* KT, const bf16_t* VT, bf16_t* O, LAS unsigned char* shm) {
    for (int u = vcu * 4; u < 1024; u += G * 4)
        for (int i = 0; i < 4; ++i) { const int uu = u + i, qb64 = uu & 127, bk = uu >> 7; unit(bk >> 2, bk & 3, qb64, Q, KT, VT, O, shm); }
}
}
}
namespace fw {
constexpr size_t MiB = 1u << 20;
constexpr int NWAVES = 8, NTHR = 512;
constexpr int MAXSLOT = 34816;
constexpr size_t WS_CTL = 0, CTL_ZERO_BYTES = 64 * 1024;
constexpr size_t WS_TOKE = 1 * MiB;
constexpr size_t WS_TOKG = WS_TOKE + 64 * 1024;
constexpr size_t WS_TOKRS = WS_TOKG + 128 * 1024;
constexpr size_t WS_SLOT12 = WS_TOKRS + 64 * 1024;
constexpr size_t WS_SLOTG = WS_SLOT12 + 128 * 1024;
constexpr size_t WS_SLOTRS = WS_SLOTG + 256 * 1024;
constexpr size_t WS_CNT = WS_SLOTRS + 256 * 1024;
constexpr size_t WS_PSTART = WS_CNT + 16 * 1024;
constexpr size_t WS_CS = 4 * MiB;
constexpr size_t WS_SSQ = 6 * MiB;
constexpr size_t WS_SSQQ = 8 * MiB;
constexpr size_t WS_SSQKV = WS_SSQQ + 512 * 1024;
constexpr size_t WS_KPE = 9 * MiB;
constexpr size_t WS_W = 16 * MiB;
constexpr size_t W_AIN = WS_W, W_QUP = W_AIN + 3 * MiB, W_KVUP = W_QUP + 2 * MiB, W_AOUT = W_KVUP + 1 * MiB, W_KVS = W_AOUT + 2 * MiB, W_QB = W_KVS + 1 * MiB,
                 W_OB = W_QB + 4 * MiB, W_PG = W_OB + 4 * MiB, W_PU = W_PG + 8 * MiB, W_FGU = W_PU + 2 * MiB, W_FDN = W_FGU + 22 * MiB, W_EGU = W_FDN + 11 * MiB,
                 W_EDN = W_EGU + 176 * MiB, W_END = W_EDN + 88 * MiB;
constexpr size_t WS_PB = W_END;
constexpr size_t WS_HB = WS_PB + 32 * MiB;
constexpr size_t WS_U = WS_HB + 64 * MiB;
constexpr size_t WS_SKT = WS_U + 128 * MiB, WS_SVT = WS_SKT + 8 * MiB;
constexpr size_t WS_X = WS_SVT + 8 * MiB;
constexpr size_t X_AQ = WS_X, X_AKV = X_AQ + 12 * MiB, X_QRAW = X_AKV + 8 * MiB, X_KVRAW = X_QRAW + 24 * MiB, X_Q = X_KVRAW + 32 * MiB, X_KT = X_Q + 24 * MiB, X_VT = X_KT + 24 * MiB, X_O = X_VT + 16 * MiB;
constexpr size_t X_SQ = WS_X, X_SO = X_SQ + 32 * MiB;
constexpr size_t X_HID = WS_X;
constexpr size_t X_XG = WS_X, X_HG = X_XG + 68 * MiB, X_YG = X_HG + 187 * MiB, X_END = X_YG + 68 * MiB;
constexpr size_t WS_END = X_END;
static_assert(X_O + 16 * MiB <= X_END && (size_t)MAXSLOT * 2816 * 2 <= 187 * MiB && (size_t)MAXSLOT * 1024 * 2 <= 68 * MiB, "ws map");
constexpr int CW_BAR = 1024;
constexpr int RING_OFF = 0, RING_BYTES = 131072, LDSCTL_OFF = RING_BYTES, MISC_OFF = LDSCTL_OFF + 320, LDS_BYTES = 147456;
static_assert(att::mla::L_END <= RING_BYTES && att::sba::L_END <= RING_BYTES, "attention LDS");
constexpr float QSCALE_MLA = 0.10206207261596577f * LOG2E;
constexpr float QSCALE_SB = 0.125f * LOG2E;

constexpr int PH_PER_LAYER = 12, PH_TOTAL = 2 + 4 * PH_PER_LAYER;
__host__ __device__ inline bool phase_active(int idx) {
    if (idx < 2) return true;
    const int l = (idx - 2) / PH_PER_LAYER, s = (idx - 2) % PH_PER_LAYER; const bool mla = l < 2, moe = (l & 1) != 0;
    if (s == 1 || s == 2) return mla;
    if (s >= 7 && s <= 9) return moe;
    if (s == 11) return l == 1;
    return true;
}

struct Args { const float* in[26]; float* out; unsigned char* ws; int ph_lo, ph_hi; };

struct Frame { LAS unsigned char* lds; int tid, lane, wave, vcu, G; };

__device__ __forceinline__ float wave_sum(float v) {
#pragma unroll
    for (int o = 1; o < 64; o <<= 1) v += __shfl_xor(v, o);
    return v;
}
template <bool NT> __device__ __forceinline__ void transpose_item(const float* W, int ldw, int sca, int scb, const float* gain, bf16_t* WT, int K, int drow0, int k0, LAS float* scr, int lane) {
    const int r8 = lane >> 3, pc = lane & 7, c = lane & 7;
    f32x4 va[8], vb[8]; float g[8];
    const f32x4 z4 = {0.f, 0.f, 0.f, 0.f};
#pragma unroll
    for (int i = 0; i < 8; ++i) { const float* rp = W + (size_t)(k0 + i * 8 + r8) * ldw + 4 * pc;
        if (NT) { va[i] = sca >= 0 ? __builtin_nontemporal_load((const f32x4*)(rp + sca)) : z4; vb[i] = scb >= 0 ? __builtin_nontemporal_load((const f32x4*)(rp + scb)) : z4; }
        else { va[i] = sca >= 0 ? *(const f32x4*)(rp + sca) : z4; vb[i] = scb >= 0 ? *(const f32x4*)(rp + scb) : z4; }
        g[i] = gain ? gain[k0 + i * 8 + r8] : 1.0f; }
#pragma unroll
    for (int hf = 0; hf < 2; ++hf) {
#pragma unroll
        for (int i = 0; i < 8; ++i) { const f32x4 v = (hf == 0 ? va[i] : vb[i]) * g[i]; LAS float* d = scr + (i * 8 + r8) * 33 + 4 * pc; d[0] = v[0]; d[1] = v[1]; d[2] = v[2]; d[3] = v[3]; }
        asm volatile("s_waitcnt lgkmcnt(0)" ::: "memory");
#pragma unroll
        for (int j = 0; j < 4; ++j) { const int n = (lane >> 3) + 8 * j; const LAS float* s = scr + (8 * c) * 33 + n;
            u32x4 o; o.x = pk_bf16(s[0 * 33], s[1 * 33]); o.y = pk_bf16(s[2 * 33], s[3 * 33]); o.z = pk_bf16(s[4 * 33], s[5 * 33]); o.w = pk_bf16(s[6 * 33], s[7 * 33]);
            if (NT) __builtin_nontemporal_store(o, (u32x4*)(WT + (size_t)(drow0 + hf * 32 + n) * K + k0 + 8 * c)); else *(u32x4*)(WT + (size_t)(drow0 + hf * 32 + n) * K + k0 + 8 * c) = o; }
        asm volatile("s_waitcnt lgkmcnt(0)" ::: "memory");
    }
}
struct Fam { int src, count, K, Nd, ldw, map, gain, gstride; size_t sstride, dst, dstride; };
__device__ __forceinline__ int fam_items(const Fam& f) { return f.count * (f.K / 64) * (f.Nd / 64); }
__device__ __forceinline__ int fam_src_col(int map, int n0) {
    if (map == 1) return n0 < 384 ? n0 : (n0 < 416 ? 640 + (n0 - 384) : (n0 < 512 ? -1 : 384 + (n0 - 512)));
    if (map == 2) { const int pn = n0 >> 8, jj = n0 & 255; return jj < 128 ? pn * 128 + jj : 2816 + pn * 128 + (jj - 128); }
    return n0;
}
template <bool NT = false> __device__ __forceinline__ void fam_item(const Args& a, const Fam& f, int fid, int it, LAS float* scr, int lane, int mi_off = 0) {
    const int per = (f.K / 64) * (f.Nd / 64), mi = it / per + mi_off, r = it % per, nblk = f.Nd / 64, kb = r / nblk, nb = r % nblk, n0 = nb * 64;
    const float* gain = nullptr;
    if (f.gain >= 0) gain = a.in[f.gain] + (fid == 11 ? (size_t)(2 * (mi >> 3) + 1) * 1024 : (size_t)mi * f.gstride);
    transpose_item<NT>(a.in[f.src] + (size_t)mi * f.sstride, f.ldw, fam_src_col(f.map, n0), fam_src_col(f.map, n0 + 32), gain, (bf16_t*)(a.ws + f.dst + (size_t)mi * f.dstride), f.K, n0, kb * 64, scr, lane);
}
__constant__ const Fam FAMS[13] = {
        {4, 2, 1024, 768, 672, 1, 3, 1024, (size_t)1024 * 672, W_AIN, (size_t)768 * 1024 * 2},
        {7, 2, 384, 768, 768, 0, 5, 384, (size_t)384 * 768, W_QUP, (size_t)768 * 384 * 2},
        {8, 2, 256, 1024, 1024, 0, 6, 256, (size_t)256 * 1024, W_KVUP, (size_t)1024 * 256 * 2},
        {11, 2, 512, 1024, 1024, 0, -1, 0, (size_t)512 * 1024, W_AOUT, (size_t)1024 * 512 * 2},
        {13, 1, 1024, 512, 512, 0, 12, 0, 0, W_KVS, 0},
        {15, 2, 1024, 1024, 1024, 0, 14, 1024, (size_t)1024 * 1024, W_QB, (size_t)1024 * 1024 * 2},
        {16, 2, 1024, 1024, 1024, 0, -1, 0, (size_t)1024 * 1024, W_OB, (size_t)1024 * 1024 * 2},
        {24, 4, 1024, 1024, 1024, 0, 23, 1024, (size_t)1024 * 1024, W_PG, (size_t)1024 * 1024 * 2},
        {25, 4, 256, 1024, 1024, 0, -1, 0, (size_t)256 * 1024, W_PU, (size_t)1024 * 256 * 2},
        {18, 1, 1024, 5632, 5632, 2, 17, 2048, (size_t)1024 * 5632, W_FGU, (size_t)5632 * 1024 * 2},
        {19, 1, 2816, 1024, 1024, 0, -1, 0, (size_t)2816 * 1024, W_FDN, (size_t)1024 * 2816 * 2},
        {21, 8, 1024, 5632, 5632, 2, 17, 0, (size_t)1024 * 5632, W_EGU, (size_t)5632 * 1024 * 2},
        {22, 8, 2816, 1024, 1024, 0, -1, 0, (size_t)2816 * 1024, W_EDN, (size_t)1024 * 2816 * 2}};
constexpr int DEF_N0 = 1408, DEF_N1 = DEF_N0 + 704, DEF_N2 = DEF_N1 + 11264, DEF_N3 = DEF_N2 + 5632;
#ifndef FILL_A
#define FILL_A 0
#define FILL_B 0
#define FILL_C 0
#define FILL_D 0
#endif
constexpr int DEF_QA = FILL_A, DEF_QB = DEF_QA + FILL_B, DEF_QC = DEF_QB + FILL_C, DEF_QD = DEF_QC + FILL_D;
constexpr int CW_FILL = 512;
__device__ __forceinline__ void prologue(const Args& a, Frame& F) {
    LAS float* scr = (LAS float*)(F.lds + RING_OFF + F.wave * 16384);
    const int gw = F.vcu * NWAVES + F.wave, NGW = F.G * NWAVES;
    int base = 0;
#pragma unroll 1
    for (int fid = 0; fid < 13; ++fid) { const Fam f = FAMS[fid]; const int n = fam_items(f);
        int it = gw - (base % NGW); if (it < 0) it += NGW;
#pragma unroll 1
        for (; it < n; it += NGW) fam_item(a, f, fid, it, scr, F.lane);
        base += n; }
    for (int id = DEF_QD + gw; id < DEF_N3; id += NGW) {
        if (id < DEF_N0) fam_item(a, FAMS[9], 9, id, scr, F.lane, 1);
        else if (id < DEF_N1) fam_item(a, FAMS[10], 10, id - DEF_N0, scr, F.lane, 1);
        else if (id < DEF_N2) fam_item(a, FAMS[11], 11, id - DEF_N1, scr, F.lane, 8);
        else fam_item(a, FAMS[12], 12, id - DEF_N2, scr, F.lane, 8);
    }
    { const f32x4* src = (const f32x4*)a.in[1]; u32x2* dst = (u32x2*)(a.ws + WS_PB); const size_t n4 = (size_t)4 * MT * 256 / 4, S = (size_t)NGW * 64;
        for (size_t i = (size_t)gw * 64 + F.lane; i < n4; i += 4 * S) { f32x4 v[4];
#pragma unroll
            for (int q = 0; q < 4; ++q) v[q] = (i + q * S < n4) ? src[i + q * S] : (f32x4){0.f, 0.f, 0.f, 0.f};
#pragma unroll
            for (int q = 0; q < 4; ++q) if (i + q * S < n4) { u32x2 o; o.x = pk_bf16(v[q][0], v[q][1]); o.y = pk_bf16(v[q][2], v[q][3]); dst[i + q * S] = o; } } }
    { bf16_t* HB = (bf16_t*)(a.ws + WS_HB); float* SSQ = (float*)(a.ws + WS_SSQ);
        for (int row = gw; row < MT; row += NGW) { const f32x4* xr = (const f32x4*)(a.in[0] + (size_t)row * DMODEL) + F.lane;
            u32x2* hb = (u32x2*)(HB + (size_t)row * DMODEL) + F.lane; float s = 0.f; f32x4 v4[4];
#pragma unroll
            for (int j = 0; j < 4; ++j) v4[j] = xr[64 * j];
#pragma unroll
            for (int j = 0; j < 4; ++j) { const f32x4 v = v4[j]; u32x2 o; o.x = pk_bf16(v[0], v[1]); o.y = pk_bf16(v[2], v[3]); hb[64 * j] = o; s += (v[0] * v[0] + v[1] * v[1]) + (v[2] * v[2] + v[3] * v[3]); }
            s = wave_sum(s); if (F.lane < 16) SSQ[(size_t)row * 16 + F.lane] = F.lane == 0 ? s : 0.f; } }
    { float* cs = (float*)(a.ws + WS_CS); const int* pos = (const int*)a.in[2];
        for (int i = gw * 64 + F.lane; i < MT * 16; i += NGW * 64) { const int row = i >> 4, f = i & 15;
            const float invf = (float)exp(-9.210340371976184 * (double)f / 16.0);
            const double ang = (double)((float)pos[row] * invf);
            const double rev = ang * 0.15915494309189535, fr = rev - rint(rev); const float x = (float)(fr * 6.283185307179586);
            cs[(size_t)row * 32 + f] = cosf(x); cs[(size_t)row * 32 + 16 + f] = sinf(x); } }
}
#define THIN_LAUNDER() Frame F = F_; unsigned char* wsl = a.ws; asm volatile("" : "+v"(F.tid), "+v"(F.lane), "+s"(F.wave), "+s"(F.vcu), "+s"(F.G), "+s"(wsl))
__device__ __forceinline__ void filler(const Args& a, const Frame& F_, int qi, int start, int end) {
    Frame F = F_; { int t_ = threadIdx.x; asm volatile("" : "+v"(t_)); F.tid = t_; F.lane = t_ & 63; F.wave = __builtin_amdgcn_readfirstlane(t_ >> 6); }
    unsigned char* wsl = a.ws; asm volatile("" : "+s"(wsl));
    LAS float* scr = (LAS float*)(F.lds + RING_OFF + F.wave * 16384);
    unsigned* ctr = (unsigned*)(wsl + WS_CTL) + CW_FILL + qi;
    for (;;) {
        int id = 0; if (F.lane == 0) id = (int)__hip_atomic_fetch_add(ctr, 1u, __ATOMIC_RELAXED, __HIP_MEMORY_SCOPE_AGENT) + start;
        id = __builtin_amdgcn_readfirstlane(id);
        if (id >= end) break;
        if (id < DEF_N0) fam_item<true>(a, FAMS[9], 9, id, scr, F.lane, 1);
        else if (id < DEF_N1) fam_item<true>(a, FAMS[10], 10, id - DEF_N0, scr, F.lane, 1);
        else if (id < DEF_N2) fam_item<true>(a, FAMS[11], 11, id - DEF_N1, scr, F.lane, 8);
        else fam_item<true>(a, FAMS[12], 12, id - DEF_N2, scr, F.lane, 8);
    }
}
__device__ __forceinline__ void norm_rope_8(f32x4& n0, f32x4& n1, f32x4& r0, f32x4& r1, const float* gain, const float* cs, int sub, float outscale) {
    float ss = pg8::sumsq8(n0, n1) + pg8::sumsq8(r0, r1);
    ss += __shfl_xor(ss, 1); ss += __shfl_xor(ss, 2); ss += __shfl_xor(ss, 4);
    const float rq = (1.0f / sqrtf(ss * (1.0f / 96.0f) + RMS_EPS));
    const f32x4 g0 = *(const f32x4*)(gain + 8 * sub), g1 = *(const f32x4*)(gain + 8 * sub + 4);
    n0 = n0 * g0 * (rq * outscale); n1 = n1 * g1 * (rq * outscale);
    const int s4 = sub & 3;
    const f32x4 h0 = *(const f32x4*)(gain + 64 + 8 * s4), h1 = *(const f32x4*)(gain + 64 + 8 * s4 + 4);
    r0 = r0 * h0 * (rq * outscale); r1 = r1 * h1 * (rq * outscale);
    f32x4 p0, p1;
#pragma unroll
    for (int j = 0; j < 4; ++j) { p0[j] = __shfl_xor(r0[j], 2); p1[j] = __shfl_xor(r1[j], 2); }
    const f32x4 c0 = *(const f32x4*)(cs + 8 * (sub & 1)), c1 = *(const f32x4*)(cs + 8 * (sub & 1) + 4), s0 = *(const f32x4*)(cs + 16 + 8 * (sub & 1)), s1 = *(const f32x4*)(cs + 16 + 8 * (sub & 1) + 4);
    if (s4 < 2) { r0 = r0 * c0 - p0 * s0; r1 = r1 * c1 - p1 * s1; }
    else { r0 = r0 * c0 + p0 * s0; r1 = r1 * c1 + p1 * s1; }
}
__device__ __forceinline__ void mla_prep(const Args& a, const Frame& F_, int layer) { THIN_LAUNDER();
    const bf16_t* QRAW = (const bf16_t*)(wsl + X_QRAW); const bf16_t* KVRAW = (const bf16_t*)(wsl + X_KVRAW); const float* KPE = (const float*)(wsl + WS_KPE);
    const float* CS = (const float*)(wsl + WS_CS); const float* gq = a.in[9] + layer * 96; const float* gk = a.in[10] + layer * 96;
    bf16_t* Q = (bf16_t*)(wsl + X_Q); bf16_t* KT = (bf16_t*)(wsl + X_KT); bf16_t* VT = (bf16_t*)(wsl + X_VT);
    const int gw = F.vcu * NWAVES + F.wave, NGW = F.G * NWAVES, h = F.lane >> 3, sub = F.lane & 7;
    const f32x4 z4 = {0.f, 0.f, 0.f, 0.f};
    for (int row = gw; row < MT; row += NGW) {
        const int b = row >> 13, sq = row & 8191, tile = sq >> 6, rr = sq & 63; const float* cs = CS + (size_t)row * 32;
        { const bf16_t* qrow = QRAW + (size_t)row * 768 + h * 96; f32x4 n0, n1, r0 = z4, r1 = z4;
            unpack8(*(const u32x4*)(qrow + 8 * sub), n0, n1); if (sub < 4) unpack8(*(const u32x4*)(qrow + 64 + 8 * sub), r0, r1);
            norm_rope_8(n0, n1, r0, r1, gq, cs, sub, QSCALE_MLA);
            bf16_t* qo = Q + (size_t)row * 768 + h * 96; *(u32x4*)(qo + 8 * sub) = pack8(n0, n1); if (sub < 4) *(u32x4*)(qo + 64 + 8 * sub) = pack8(r0, r1); }
        { const bf16_t* krow = KVRAW + (size_t)row * 1024 + h * 128; f32x4 n0, n1, r0 = z4, r1 = z4;
            unpack8(*(const u32x4*)(krow + 8 * sub), n0, n1); if (sub < 4) { r0 = *(const f32x4*)(KPE + (size_t)row * 32 + 8 * sub); r1 = *(const f32x4*)(KPE + (size_t)row * 32 + 8 * sub + 4); }
            norm_rope_8(n0, n1, r0, r1, gk, cs, sub, 1.0f);
            bf16_t* kt = KT + (size_t)((b * 8 + h) * 128 + tile) * 6144 + rr * 8; *(u32x4*)(kt + sub * 512) = pack8(n0, n1); if (sub < 4) *(u32x4*)(kt + (8 + sub) * 512) = pack8(r0, r1);
            const u32x4 v = *(const u32x4*)(krow + 64 + 8 * sub);
            *(u32x4*)(VT + (size_t)((b * 8 + h) * 128 + tile) * 4096 + (sub >> 2) * 2048 + rr * 32 + (sub & 3) * 8) = v; }
    }
}
__device__ __forceinline__ void moe_route(const Args& a, const Frame& F_, int layer, int cur) { THIN_LAUNDER();
    const bf16_t* HB = (const bf16_t*)(wsl + WS_HB) + (size_t)cur * MT * DMODEL; const float* gain = a.in[17] + (size_t)layer * 1024; const float* wr = a.in[20] + (size_t)(layer >> 1) * 1024 * 8;
    int* TOKE = (int*)(wsl + WS_TOKE); float* TOKG = (float*)(wsl + WS_TOKG); float* TOKRS = (float*)(wsl + WS_TOKRS); int* CNT = (int*)(wsl + WS_CNT);
    constexpr int LDW = 1032;
    LAS bf16_t* WB = (LAS bf16_t*)(F.lds + RING_OFF);
    LAS int* lcnt = (LAS int*)(F.lds + RING_OFF + 36864);
    LAS float* LG = (LAS float*)(F.lds + RING_OFF + 37888) + F.wave * 128;
    for (int i = F.tid; i < 1024 * 8; i += NTHR) { const int k = i >> 3, e = i & 7; const float x = wr[i] * gain[k];
        const unsigned hi = pk_bf16(x, 0.f) & 0xffffu; const float lo = x - __uint_as_float(hi << 16);
        WB[e * LDW + k] = (bf16_t)hi; WB[(8 + e) * LDW + k] = (bf16_t)(pk_bf16(lo, 0.f) & 0xffffu); }
    const int n = F.lane & 15, q = F.lane >> 4;
    for (int chunk = F.vcu; chunk < MT / 64; chunk += F.G) {
        if (F.tid < 8) lcnt[F.tid] = 0;
        __syncthreads();
        if (F.wave < 4) {
            const int tok0 = chunk * 64 + F.wave * 16;
            const bf16_t* arow = HB + (size_t)(tok0 + n) * DMODEL + 8 * q; const LAS bf16_t* brow = WB + n * LDW + 8 * q;
            f32x4 acc = {0.f, 0.f, 0.f, 0.f}; float ss = 0.f;
#pragma unroll 8
            for (int s = 0; s < 32; ++s) { const u32x4 av = *(const u32x4*)(arow + 32 * s); const bf16x8 bv = *(const LAS bf16x8*)(brow + 32 * s);
                acc = __builtin_amdgcn_mfma_f32_16x16x32_bf16(__builtin_bit_cast(bf16x8, av), bv, acc, 0, 0, 0);
                f32x4 x0, x1; unpack8(av, x0, x1); ss += pg8::sumsq8(x0, x1); }
            ss += __shfl_xor(ss, 16); ss += __shfl_xor(ss, 32);
#pragma unroll
            for (int i = 0; i < 4; ++i) { const float v = acc[i] + __shfl_xor(acc[i], 8); if (n < 8) LG[(4 * q + i) * 8 + n] = v; }
            asm volatile("s_waitcnt lgkmcnt(0)" ::: "memory");
            if (F.lane < 16) { const int tok = tok0 + F.lane; const LAS f32x4* lp = (const LAS f32x4*)(LG + F.lane * 8); const f32x4 l0 = lp[0], l1 = lp[1];
                const float lg[8] = {l0[0], l0[1], l0[2], l0[3], l1[0], l1[1], l1[2], l1[3]};
                const float r = 1.0f / sqrtf(ss * (1.0f / 1024.0f) + RMS_EPS);
                int e1 = 0; float v1 = lg[0];
#pragma unroll
                for (int e = 1; e < 8; ++e) if (lg[e] > v1) { v1 = lg[e]; e1 = e; }
                int e2 = 0; float v2 = -3.0e38f;
#pragma unroll
                for (int e = 0; e < 8; ++e) if (e != e1 && lg[e] > v2) { v2 = lg[e]; e2 = e; }
                const float p2 = __expf((v2 - v1) * r), g1 = 1.0f / (1.0f + p2), g2 = p2 / (1.0f + p2);
                TOKE[tok] = e1 | (e2 << 8); TOKG[tok * 2] = g1; TOKG[tok * 2 + 1] = g2; TOKRS[tok] = r;
                __hip_atomic_fetch_add(lcnt + e1, 1, __ATOMIC_RELAXED, __HIP_MEMORY_SCOPE_WORKGROUP); __hip_atomic_fetch_add(lcnt + e2, 1, __ATOMIC_RELAXED, __HIP_MEMORY_SCOPE_WORKGROUP); }
        }
        __syncthreads();
        if (F.tid < 8) CNT[chunk * 8 + F.tid] = lcnt[F.tid];
        __syncthreads();
    }
}
__device__ __forceinline__ void moe_scatter(const Args& a, const Frame& F_, int cur) { THIN_LAUNDER();
    const int* TOKE = (const int*)(wsl + WS_TOKE); const float* TOKG = (const float*)(wsl + WS_TOKG); const float* TOKRS = (const float*)(wsl + WS_TOKRS); const int* CNT = (const int*)(wsl + WS_CNT);
    int* SLOT12 = (int*)(wsl + WS_SLOT12); float* SLOTG = (float*)(wsl + WS_SLOTG); float* SLOTRS = (float*)(wsl + WS_SLOTRS); int* PSTART = (int*)(wsl + WS_PSTART);
    const bf16_t* HB = (const bf16_t*)(wsl + WS_HB) + (size_t)cur * MT * DMODEL; bf16_t* XG = (bf16_t*)(wsl + X_XG);
    LAS int* sm = (LAS int*)(F.lds + RING_OFF);
    for (int chunk = F.vcu; chunk < MT / 64; chunk += F.G) {
        { const int e = F.wave; int c4[4]; int s = 0;
#pragma unroll
            for (int i = 0; i < 4; ++i) { c4[i] = CNT[(4 * F.lane + i) * 8 + e]; s += c4[i]; }
            int inc = s;
#pragma unroll
            for (int o = 1; o < 64; o <<= 1) { const int t = __shfl_up(inc, o); if (F.lane >= o) inc += t; }
            const int total = __shfl(inc, 63); int pre = inc - s;
            if (F.lane == (chunk >> 2)) { const int cm = chunk & 3; pre += (cm > 0 ? c4[0] : 0) + (cm > 1 ? c4[1] : 0) + (cm > 2 ? c4[2] : 0); sm[8 + e] = pre; }
            if (F.lane == 0) sm[e] = total; }
        __syncthreads();
        if (F.tid == 0) { int p = 0; for (int e = 0; e < 8; ++e) { sm[16 + e] = p; p += (sm[e] + 255) >> 8; } sm[24] = p; }
        __syncthreads();
        if (F.tid < 9) PSTART[F.tid] = sm[16 + F.tid];
        if (F.wave == 0) { const int tok = chunk * 64 + F.lane; const int ev = TOKE[tok], e1 = ev & 255, e2 = ev >> 8; int s1 = 0, s2 = 0;
            const unsigned long long below = (1ull << F.lane) - 1ull;
#pragma unroll
            for (int e = 0; e < 8; ++e) { const unsigned long long m1 = __ballot(e1 == e), m2 = __ballot(e2 == e);
                const int rank = __popcll(m1 & below) + __popcll(m2 & below), slot = sm[16 + e] * 256 + sm[8 + e] + rank;
                if (e1 == e) s1 = slot; if (e2 == e) s2 = slot; }
            SLOT12[tok * 2] = s1; SLOT12[tok * 2 + 1] = s2; const float r = TOKRS[tok];
            SLOTG[s1] = TOKG[tok * 2]; SLOTG[s2] = TOKG[tok * 2 + 1]; SLOTRS[s1] = r; SLOTRS[s2] = r;
            sm[32 + 2 * F.lane] = s1; sm[32 + 2 * F.lane + 1] = s2; }
        __syncthreads();
        for (int i = 0; i < 16; ++i) { const int pr = F.wave * 16 + i, tok = chunk * 64 + (pr >> 1), slot = sm[32 + pr];
            const u32x4* src = (const u32x4*)(HB + (size_t)tok * DMODEL) + F.lane; u32x4* dst = (u32x4*)(XG + (size_t)slot * DMODEL) + F.lane;
            dst[0] = src[0]; dst[64] = src[64]; }
        __syncthreads();
    }
}
__device__ __forceinline__ void moe_combine(const Args& a, const Frame& F_, int cur, bool dummy) { THIN_LAUNDER();
    const int* SLOT12 = (const int*)(wsl + WS_SLOT12); const bf16_t* YG = (const bf16_t*)(wsl + X_YG);
    const bf16_t* HBi = (const bf16_t*)(wsl + WS_HB) + (size_t)cur * MT * DMODEL;
    bf16_t* HB = dummy ? (bf16_t*)(wsl + WS_END + 66 * MiB) : (bf16_t*)(wsl + WS_HB) + (size_t)cur * MT * DMODEL; float* SSQ = dummy ? (float*)(wsl + WS_END + 99 * MiB) : (float*)(wsl + WS_SSQ) + (size_t)cur * MT * 16;
    const int gw = F.vcu * NWAVES + F.wave, NGW = F.G * NWAVES;
    for (int row = gw; row < MT; row += NGW) { const int s1 = SLOT12[row * 2], s2 = SLOT12[row * 2 + 1];
        const u32x2* hr = (const u32x2*)(HBi + (size_t)row * DMODEL) + F.lane; u32x2* hb = (u32x2*)(HB + (size_t)row * DMODEL) + F.lane;
        const u32x2* y1 = (const u32x2*)(YG + (size_t)s1 * DMODEL) + F.lane; const u32x2* y2 = (const u32x2*)(YG + (size_t)s2 * DMODEL) + F.lane; float s = 0.f;
        u32x2 hv[4], pv_[4], qv[4];
#pragma unroll
        for (int j = 0; j < 4; ++j) { hv[j] = hr[64 * j]; pv_[j] = y1[64 * j]; qv[j] = y2[64 * j]; }
#pragma unroll
        for (int j = 0; j < 4; ++j) { const u32x2 h = hv[j], p = pv_[j], q = qv[j]; f32x4 v;
            v[0] = bf_lo(h.x) + (bf_lo(p.x) + bf_lo(q.x)); v[1] = bf_hi(h.x) + (bf_hi(p.x) + bf_hi(q.x)); v[2] = bf_lo(h.y) + (bf_lo(p.y) + bf_lo(q.y)); v[3] = bf_hi(h.y) + (bf_hi(p.y) + bf_hi(q.y));
            u32x2 o; o.x = pk_bf16(v[0], v[1]); o.y = pk_bf16(v[2], v[3]); hb[64 * j] = o; s += (v[0] * v[0] + v[1] * v[1]) + (v[2] * v[2] + v[3] * v[3]); }
        s = wave_sum(s); if (F.lane < 16) SSQ[(size_t)row * 16 + F.lane] = F.lane == 0 ? s : 0.f; }
}

__global__ void __launch_bounds__(NTHR, 2) yoco_fwd(Args args) {
    extern __shared__ __attribute__((aligned(16))) unsigned char lds_raw[];
    Frame F; F.lds = (LAS unsigned char*)lds_raw;
    volatile LAS unsigned* MISC = (volatile LAS unsigned*)(F.lds + MISC_OFF);
    F.tid = threadIdx.x; F.lane = F.tid & 63; F.wave = __builtin_amdgcn_readfirstlane(F.tid >> 6);
    F.G = gridDim.x; { const int bx = blockIdx.x; F.vcu = (F.G % 8 == 0) ? (bx % 8) * (F.G / 8) + bx / 8 : bx; }
    for (int u = F.tid; u < (LDS_BYTES - LDSCTL_OFF) / 4; u += NTHR) ((LAS unsigned*)(F.lds + LDSCTL_OFF))[u] = 0u;
    __syncthreads();
    unsigned char* ws = args.ws;
#define WS_LAUNDER() asm volatile("" : "+s"(ws), "+s"(bx), "+s"(F.G), "+s"(F.vcu))
    const bool single = (args.ph_hi - args.ph_lo) > 1;
    XcdBarrier bar; bar.bar = (unsigned*)(ws + WS_CTL) + CW_BAR; bar.x = 0; bar.st = nullptr;
    if (single) bar = xcd_barrier_post((unsigned*)(ws + WS_CTL) + CW_BAR, MISC + 8);
    const int lo = args.ph_lo, hi = args.ph_hi;
#ifndef GU_ALIGN
#define GU_ALIGN true
#endif
#ifndef EN_MASK
#define EN_MASK 0xFFFFFFFFu
#endif
#define EN(b) (((EN_MASK) >> (b)) & 1u)
#define IN(k) (lo <= (k) && (k) < hi)
#ifdef REP_MASK
#define NREPS(k) ((((unsigned long long)(REP_MASK) >> (k)) & 1ull) ? (REP_N) + 1 : 1)
#else
#define NREPS(k) 1
#endif
#define REPLOOP(k) for (int rep_ = 0, nrep_ = NREPS(k); rep_ < nrep_; ++rep_)
#define DUMMY (rep_ + 1 < nrep_)
#define OUT_HB(set) (DUMMY ? (bf16_t*)(ws + WS_END + 66 * MiB) : (bf16_t*)(ws + WS_HB) + (size_t)(set) * MT * DMODEL)
#define OUT_SSQ(set) (DUMMY ? (float*)(ws + WS_END + 99 * MiB) : (float*)(ws + WS_SSQ) + (size_t)(set) * MT * 16)
#define SEAM(k) do { if (single && (k) + 1 < hi) { XcdBarrier b_ = bar; asm volatile("" : "+s"(b_.bar), "+s"(b_.x)); xcd_barrier(b_); } } while (0)

    LAS unsigned char* ring = F.lds + RING_OFF;
    int bx = (int)blockIdx.x;

    if (EN(0) && IN(0)) REPLOOP(0) { prologue(args, F); SEAM(0); }
    if (EN(1) && IN(1)) REPLOOP(1) { WS_LAUNDER();
#pragma unroll 1
        for (int i = 0; i < 4; ++i) {
            pg8::Gemm g{(const bf16_t*)(ws + WS_PB) + (size_t)i * MT * 256, (const bf16_t*)(ws + W_PU) + (size_t)i * 1024 * 256, MT, 1024, 256};
            pg8::StaticOrder S; S.init(MT, 1024, F.G, bx);
            pg8::EpiScale E{(bf16_t*)(ws + WS_U) + (size_t)i * MT * DMODEL, 1024, pg8::RowScale{nullptr, 0}, 1.0f};
            pg8::gemm_phase<pg8::EpiScale, pg8::StaticOrder, true, true>(ring, g, S, E);
        }
        SEAM(1);
    }
#pragma unroll 1
    for (int l = 0; l < 4; ++l) {
        const int base = 2 + PH_PER_LAYER * l; const bool is_mla = l < 2, is_moe = (l & 1) != 0; const int cur = l & 1, j = l & 1;
#define HBc ((const bf16_t*)(ws + WS_HB) + (size_t)cur * MT * DMODEL)
#define HBw ((bf16_t*)(ws + WS_HB) + (size_t)cur * MT * DMODEL)
#define SSQc ((float*)(ws + WS_SSQ) + (size_t)cur * MT * 16)
        if (IN(base + 0)) REPLOOP(base + 0) { WS_LAUNDER();
            if (EN(2) && is_mla) {
                pg8::Gemm g{HBc, (const bf16_t*)(ws + W_AIN) + (size_t)l * 768 * 1024, MT, 768, 1024};
                pg8::StaticOrder S; S.init(MT, 768, F.G, bx);
                pg8::EpiAin E{(bf16_t*)(ws + X_AQ), (bf16_t*)(ws + X_AKV), (float*)(ws + WS_KPE), (float*)(ws + WS_SSQQ), (float*)(ws + WS_SSQKV), pg8::RowScale{SSQc, 1}};
                pg8::gemm_phase<pg8::EpiAin, pg8::StaticOrder, true, true>(ring, g, S, E);
            } else if (EN(3) && !is_mla) {
                pg8::Gemm g{HBc, (const bf16_t*)(ws + W_QB) + (size_t)j * 1024 * 1024, MT, 1024, 1024};
                pg8::StaticOrder S; S.init(MT, 1024, F.G, bx);
                pg8::EpiScale E{(bf16_t*)(ws + X_SQ), 1024, pg8::RowScale{SSQc, 1}, QSCALE_SB};
                pg8::gemm_phase<pg8::EpiScale, pg8::StaticOrder, true, true>(ring, g, S, E);
            }
            SEAM(base + 0);
        }
        if (EN(4) && is_mla && IN(base + 1)) REPLOOP(base + 1) { WS_LAUNDER();
            { pg8::Gemm g{(const bf16_t*)(ws + X_AQ), (const bf16_t*)(ws + W_QUP) + (size_t)l * 768 * 384, MT, 768, 384};
              pg8::StaticOrder S; S.init(MT, 768, F.G, bx);
              pg8::EpiScale E{(bf16_t*)(ws + X_QRAW), 768, pg8::RowScale{(const float*)(ws + WS_SSQQ), 3}, 1.0f};
              pg8::gemm_phase<pg8::EpiScale, pg8::StaticOrder, true, true>(ring, g, S, E); }
            { pg8::Gemm g{(const bf16_t*)(ws + X_AKV), (const bf16_t*)(ws + W_KVUP) + (size_t)l * 1024 * 256, MT, 1024, 256};
              pg8::StaticOrder S; S.init(MT, 1024, F.G, bx);
              pg8::EpiScale E{(bf16_t*)(ws + X_KVRAW), 1024, pg8::RowScale{(const float*)(ws + WS_SSQKV), 4}, 1.0f};
              pg8::gemm_phase<pg8::EpiScale, pg8::StaticOrder, true, true>(ring, g, S, E); }
            SEAM(base + 1);
        }
        if (EN(5) && is_mla && IN(base + 2)) REPLOOP(base + 2) { mla_prep(args, F, l); SEAM(base + 2); }
        if (IN(base + 3)) REPLOOP(base + 3) { WS_LAUNDER();
#if defined(MLA_ABL)
            if (EN(6) && is_mla && DUMMY) att::mla::phase<MLA_ABL>(F.vcu, F.G, (const bf16_t*)(ws + X_Q), (const bf16_t*)(ws + X_KT), (const bf16_t*)(ws + X_VT), (bf16_t*)(ws + WS_END + 66 * MiB), ring);
            else
#endif
            if (EN(6) && is_mla) att::mla::phase<0>(F.vcu, F.G, (const bf16_t*)(ws + X_Q), (const bf16_t*)(ws + X_KT), (const bf16_t*)(ws + X_VT), (bf16_t*)(ws + X_O), ring);
            else if (EN(7) && !is_mla) att::sba::phase(F.vcu, F.G, (const bf16_t*)(ws + X_SQ), (const bf16_t*)(ws + WS_SKT), (const bf16_t*)(ws + WS_SVT), (bf16_t*)(ws + X_SO), ring);
            SEAM(base + 3);
        }
        if (EN(8) && IN(base + 4)) REPLOOP(base + 4) { WS_LAUNDER();
            pg8::Gemm g = is_mla ? pg8::Gemm{(const bf16_t*)(ws + X_O), (const bf16_t*)(ws + W_AOUT) + (size_t)l * 1024 * 512, MT, 1024, 512}
                                 : pg8::Gemm{(const bf16_t*)(ws + X_SO), (const bf16_t*)(ws + W_OB) + (size_t)j * 1024 * 1024, MT, 1024, 1024};
            pg8::StaticOrder S; S.init(MT, 1024, F.G, bx);
            pg8::EpiRes<false> E{HBc, OUT_HB(cur), OUT_SSQ(cur), nullptr, pg8::RowScale{nullptr, 0}, nullptr};
            pg8::gemm_phase<pg8::EpiRes<false>, pg8::StaticOrder, true, true>(ring, g, S, E);
            SEAM(base + 4);
        }
        if (!is_moe) {
            if (EN(9) && IN(base + 5)) REPLOOP(base + 5) { WS_LAUNDER();
                pg8::Gemm g{HBc, (const bf16_t*)(ws + W_FGU) + (size_t)(l >> 1) * 5632 * 1024, MT, 5632, 1024};
                pg8::GroupOrder S; S.init_dense(MT, 5632, F.G, bx);
                pg8::EpiSwiglu E{(bf16_t*)(ws + X_HID), pg8::RowScale{SSQc, 1}};
                pg8::gemm_phase<pg8::EpiSwiglu, pg8::GroupOrder, GU_ALIGN, true>(ring, g, S, E);
#if FILL_A + FILL_D > 0
                filler(args, F, l == 0 ? 0 : 3, l == 0 ? 0 : DEF_QC, l == 0 ? DEF_QA : DEF_QD);
#endif
                SEAM(base + 5);
            }
            if (EN(10) && IN(base + 6)) REPLOOP(base + 6) { WS_LAUNDER();
                pg8::Gemm g{(const bf16_t*)(ws + X_HID), (const bf16_t*)(ws + W_FDN) + (size_t)(l >> 1) * 1024 * 2816, MT, 1024, 2816};
                pg8::StaticOrder S; S.init(MT, 1024, F.G, bx);
                pg8::EpiRes<false> E{HBc, OUT_HB(cur), OUT_SSQ(cur), nullptr, pg8::RowScale{nullptr, 0}, nullptr};
                pg8::gemm_phase<pg8::EpiRes<false>, pg8::StaticOrder, true, true>(ring, g, S, E);
                SEAM(base + 6);
            }
        } else {
            if (EN(11) && IN(base + 5)) REPLOOP(base + 5) { WS_LAUNDER(); moe_route(args, F, l, cur); SEAM(base + 5); }
            if (EN(12) && IN(base + 6)) REPLOOP(base + 6) { WS_LAUNDER(); moe_scatter(args, F, cur); SEAM(base + 6); }
            if (EN(13) && IN(base + 7)) REPLOOP(base + 7) { WS_LAUNDER();
                pg8::Gemm g{(const bf16_t*)(ws + X_XG), (const bf16_t*)(ws + W_EGU) + (size_t)(l >> 1) * 8 * 5632 * 1024, MAXSLOT, 5632, 1024};
                pg8::GroupOrder S; S.init((const int*)(ws + WS_PSTART), 5632, F.G, bx, (size_t)5632 * 1024 * 2);
                pg8::EpiSwiglu E{(bf16_t*)(ws + X_HG), pg8::RowScale{(const float*)(ws + WS_SLOTRS), 2}};
                pg8::gemm_phase<pg8::EpiSwiglu, pg8::GroupOrder, GU_ALIGN, true>(ring, g, S, E);
#if FILL_B > 0
                if (l == 1) filler(args, F, 1, DEF_QA, DEF_QB);
#endif
                SEAM(base + 7);
            }
            if (EN(14) && IN(base + 8)) REPLOOP(base + 8) { WS_LAUNDER();
                pg8::Gemm g{(const bf16_t*)(ws + X_HG), (const bf16_t*)(ws + W_EDN) + (size_t)(l >> 1) * 8 * 1024 * 2816, MAXSLOT, 1024, 2816};
                pg8::GroupOrder S; S.init((const int*)(ws + WS_PSTART), 1024, F.G, bx, (size_t)1024 * 2816 * 2);
                pg8::EpiScale E{(bf16_t*)(ws + X_YG), 1024, pg8::RowScale{(const float*)(ws + WS_SLOTG), 2}, 1.0f};
                pg8::gemm_phase<pg8::EpiScale, pg8::GroupOrder, true, true>(ring, g, S, E);
#if FILL_C > 0
                if (l == 1) filler(args, F, 2, DEF_QB, DEF_QC);
#endif
                SEAM(base + 8);
            }
            if (EN(15) && IN(base + 9)) REPLOOP(base + 9) { WS_LAUNDER(); moe_combine(args, F, cur, DUMMY); SEAM(base + 9); }
        }
        if (EN(16) && IN(base + 10)) REPLOOP(base + 10) { WS_LAUNDER();
            pg8::Gemm g{HBc, (const bf16_t*)(ws + W_PG) + (size_t)l * 1024 * 1024, MT, 1024, 1024};
            pg8::StaticOrder S; S.init(MT, 1024, F.G, bx);
            pg8::EpiRes<true> E{HBc, OUT_HB(cur ^ 1), OUT_SSQ(cur ^ 1),
                                (const bf16_t*)(ws + WS_U) + (size_t)l * MT * DMODEL, pg8::RowScale{SSQc, 1}, (l == 3 && !DUMMY) ? args.out : nullptr};
            pg8::gemm_phase<pg8::EpiRes<true>, pg8::StaticOrder, true, true>(ring, g, S, E);
            SEAM(base + 10);
        }
        if (EN(17) && l == 1 && IN(base + 11)) REPLOOP(base + 11) { WS_LAUNDER();
            pg8::Gemm g{(const bf16_t*)(ws + WS_HB) + (size_t)(cur ^ 1) * MT * DMODEL, (const bf16_t*)(ws + W_KVS), MT, 512, 1024};
            pg8::StaticOrder S; S.init(MT, 512, F.G, bx);
            pg8::EpiKvs E{(bf16_t*)(ws + WS_SKT), (bf16_t*)(ws + WS_SVT), pg8::RowScale{(const float*)(ws + WS_SSQ) + (size_t)(cur ^ 1) * MT * 16, 1}};
            pg8::gemm_phase<pg8::EpiKvs, pg8::StaticOrder, true, true>(ring, g, S, E);
            SEAM(base + 11);
        }
    }
#undef IN
#undef SEAM
}
}
#define MULTI_LAUNCH 0
extern "C" void kernel_launch(void* const* d_in, const int* in_sizes, int n_in, void* d_out, int out_size, void* d_ws, size_t ws_size, hipStream_t stream) {
    using namespace fw;
    static int grid = 0;
    if (grid == 0) {
        if (n_in != 26 || out_size != MT * DMODEL || ws_size < WS_END) { fprintf(stderr, "kernel_launch: unexpected n_in %d / out %d / ws %zu\n", n_in, out_size, ws_size); grid = -1; return; }
        if (hipFuncSetAttribute((const void*)yoco_fwd, hipFuncAttributeMaxDynamicSharedMemorySize, LDS_BYTES) != hipSuccess) { fprintf(stderr, "kernel_launch: hipFuncSetAttribute failed\n"); grid = -1; return; }
        int dev = 0, cus = 0, per_cu = 0;
        (void)hipGetDevice(&dev); (void)hipDeviceGetAttribute(&cus, hipDeviceAttributeMultiprocessorCount, dev);
        (void)hipOccupancyMaxActiveBlocksPerMultiprocessor(&per_cu, (const void*)yoco_fwd, NTHR, LDS_BYTES);
        (void)hipGetLastError();
        grid = (cus > 0 && per_cu >= 1) ? cus : 256;
        if (grid > 256) grid = 256;
    }
    if (grid < 0) return;
    (void)hipMemsetAsync((unsigned char*)d_ws + WS_CTL, 0, CTL_ZERO_BYTES, stream);
    Args a{};
    for (int i = 0; i < 26; ++i) a.in[i] = (const float*)d_in[i];
    a.out = (float*)d_out; a.ws = (unsigned char*)d_ws;
#if MULTI_LAUNCH
    for (int k = 0; k < PH_TOTAL; ++k) { if (!phase_active(k)) continue; a.ph_lo = k; a.ph_hi = k + 1; hipLaunchKernelGGL(yoco_fwd, dim3(grid), dim3(NTHR), LDS_BYTES, stream, a); }
#else
#ifdef PROBE_MASK
    a.ph_lo = 0; a.ph_hi = PH_TOTAL;
#else
    a.ph_lo = 0; a.ph_hi = PH_TOTAL - 1;
#endif
    hipLaunchKernelGGL(yoco_fwd, dim3(grid), dim3(NTHR), LDS_BYTES, stream, a);
#endif
}
```

```cpp
#include <hip/hip_runtime.h>
#include <cstdio>
#include <cstdint>
#include <cmath>
#define LAS __attribute__((address_space(3)))
#define GAS __attribute__((address_space(1)))
typedef unsigned short bf16_t;
typedef short bf16x8 __attribute__((ext_vector_type(8)));
typedef float f32x4 __attribute__((ext_vector_type(4)));
typedef float f32x2 __attribute__((ext_vector_type(2)));
typedef float f32x16 __attribute__((ext_vector_type(16)));
typedef unsigned u32x4 __attribute__((ext_vector_type(4)));
typedef unsigned u32x2 __attribute__((ext_vector_type(2)));
typedef short s16x4 __attribute__((ext_vector_type(4)));
typedef __bf16 bf16x2_t __attribute__((ext_vector_type(2)));

constexpr int MT = 16384, DMODEL = 1024, SEQL = 8192;
constexpr float RMS_EPS = 1e-6f;
constexpr float LOG2E = 1.4426950408889634f;

__device__ __forceinline__ unsigned pk_bf16(float lo, float hi) { f32x2 v = {lo, hi}; bf16x2_t b = __builtin_convertvector(v, bf16x2_t); return __builtin_bit_cast(unsigned, b); }
__device__ __forceinline__ float bf_lo(unsigned w) { return __uint_as_float(w << 16); }
__device__ __forceinline__ float bf_hi(unsigned w) { return __uint_as_float(w & 0xffff0000u); }
__device__ __forceinline__ unsigned cvt_pk_bf16(float lo, float hi) { unsigned r; asm volatile("v_cvt_pk_bf16_f32 %0, %1, %2" : "=v"(r) : "v"(lo), "v"(hi)); return r; }
__device__ __forceinline__ u32x4 pack8(const f32x4 a, const f32x4 b) { u32x4 w; w.x = cvt_pk_bf16(a[0], a[1]); w.y = cvt_pk_bf16(a[2], a[3]); w.z = cvt_pk_bf16(b[0], b[1]); w.w = cvt_pk_bf16(b[2], b[3]); return w; }
__device__ __forceinline__ void unpack8(const u32x4 w, f32x4& a, f32x4& b) { a = (f32x4){bf_lo(w.x), bf_hi(w.x), bf_lo(w.y), bf_hi(w.y)}; b = (f32x4){bf_lo(w.z), bf_hi(w.z), bf_lo(w.w), bf_hi(w.w)}; }
__device__ __forceinline__ float fast_rcp(float x) { return __builtin_amdgcn_rcpf(x); }
__device__ __forceinline__ float fast_exp2(float x) { return __builtin_amdgcn_exp2f(x); }
__device__ __forceinline__ float fast_log2(float x) { return __builtin_amdgcn_logf(x); }
__device__ __forceinline__ int lane_id() { int l; asm volatile("v_mbcnt_lo_u32_b32 %0, -1, 0\n\tv_mbcnt_hi_u32_b32 %0, -1, %0" : "=v"(l)); return l; }
__device__ __forceinline__ float sigmoidf_(float x) { return fast_rcp(1.0f + fast_exp2(-x * LOG2E)); }

namespace pg8 {
constexpr int BM = 256, BK = 64, HALF = 128, HTB = HALF * BK * 2, STAGE_BYTES = 8 * HTB, NXCD = 8, WGM = 8;
__host__ __device__ __forceinline__ int lds_byte(int r, int c) { const int st = (r >> 4) * 2 + (c >> 5), rr = r & 15, cc = c & 31, ob = rr * 64 + cc * 2; return st * 1024 + (ob ^ (((ob >> 9) & 1) << 5)); }
__host__ __device__ __forceinline__ void stage_rc(int b, int& R, int& C) { const int st = b / 1024, sb = b % 1024, swz = sb ^ (((sb >> 9) & 1) << 5); R = (st >> 1) * 16 + swz / 64; C = (st & 1) * 32 + (swz % 64) / 2; }
__host__ __device__ __forceinline__ int perm32(int rho) { const int n = rho >> 4, i = rho & 15; return 8 * (i >> 2) + 4 * n + (i & 3); }

struct Unit { int pm, pn; size_t boff; };
struct Gemm { const bf16_t* A; const bf16_t* Bt; int M, N, K; };

struct StaticOrder {
    int nM, nN, nwg, G, c;
    __device__ void init(int M, int N, int G_, int c_) { nM = M / BM; nN = N / BM; nwg = nM * nN; G = G_; c = c_; }
    __device__ bool next(int i, Unit& u) const {
        const long L = (long)i * G + c; if (L >= nwg) return false;
        int wgid = (int)L; { const int q = nwg / NXCD, r = nwg % NXCD, xcd = wgid % NXCD, off = wgid / NXCD; wgid = (xcd < r ? xcd * (q + 1) : r * (q + 1) + (xcd - r) * q) + off; }
        const int nig = WGM * nN, gid = wgid / nig, fm = gid * WGM, gsz = (nM - fm) < WGM ? (nM - fm) : WGM;
        u.pm = fm + ((wgid % nig) % gsz); u.pn = (wgid % nig) / gsz; u.boff = 0; return true;
    }
};
struct GroupOrder {
    int ps[9]; int nN, nwg, G, c; size_t estride;
    __device__ void init(const int* pstart, int N, int G_, int c_, size_t estride_) {
#pragma unroll
        for (int e = 0; e < 9; ++e) ps[e] = __builtin_amdgcn_readfirstlane(pstart[e]);
        nN = N / BM; nwg = ps[8] * nN; G = G_; c = c_; estride = estride_; }
    __device__ void init_dense(int M, int N, int G_, int c_) {
        ps[0] = 0;
#pragma unroll
        for (int e = 1; e < 9; ++e) ps[e] = M / BM;
        nN = N / BM; nwg = ps[8] * nN; G = G_; c = c_; estride = 0; }
    __device__ bool next(int i, Unit& u) const {
        const long L = (long)i * G + c; if (L >= nwg) return false;
        int wgid = (int)L; { const int q = nwg / NXCD, r = nwg % NXCD, xcd = wgid % NXCD, off = wgid / NXCD; wgid = (xcd < r ? xcd * (q + 1) : r * (q + 1) + (xcd - r) * q) + off; }
        int e = 0;
#pragma unroll
        for (int k = 1; k < 8; ++k) if (wgid >= ps[k] * nN) e = k;
        int p0 = ps[0], p1 = ps[1];
#pragma unroll
        for (int k = 1; k < 8; ++k) if (e == k) { p0 = ps[k]; p1 = ps[k + 1]; }
        const int local = wgid - p0 * nN, np = p1 - p0;
        u.pn = local / np; u.pm = p0 + (local % np); u.boff = (size_t)e * estride; return true;
    }
};


__device__ __forceinline__ float sumsq8(const f32x4 a, const f32x4 b) { return ((a[0] * a[0] + a[1] * a[1]) + (a[2] * a[2] + a[3] * a[3])) + ((b[0] * b[0] + b[1] * b[1]) + (b[2] * b[2] + b[3] * b[3])); }
__device__ __forceinline__ float red_fq(float s) {
    { auto rr = __builtin_amdgcn_permlane16_swap(__float_as_uint(s), __float_as_uint(s), false, false); s = __uint_as_float(rr[0]) + __uint_as_float(rr[1]); }
    { auto rr = __builtin_amdgcn_permlane32_swap(__float_as_uint(s), __float_as_uint(s), false, false); s = __uint_as_float(rr[0]) + __uint_as_float(rr[1]); }
    return s; }
__device__ __forceinline__ float xor32(float v, int upper) {
    auto rr = __builtin_amdgcn_permlane32_swap(__float_as_uint(v), __float_as_uint(v), false, false); return __uint_as_float(upper ? rr[0] : rr[1]); }
struct RowScale {
    const float* p; int mode;
    __device__ __forceinline__ float get(int row, int fq) const {
        if (mode == 0) return 1.0f;
        if (mode == 2) return p[row];
        if (mode == 1) { const f32x4 a = *(const f32x4*)(p + (size_t)row * 16 + 4 * fq); const float s = red_fq((a[0] + a[1]) + (a[2] + a[3])); return 1.0f / sqrtf(s * (1.0f / 1024.0f) + RMS_EPS); }
        if (mode == 3) { const f32x4 a = *(const f32x4*)(p + (size_t)row * 8 + 4 * (fq & 1)); const float s = red_fq(fq < 2 ? (a[0] + a[1]) + (a[2] + a[3]) : 0.f); return 1.0f / sqrtf(s * (1.0f / 384.0f) + RMS_EPS); }
        { const float s = red_fq(p[(size_t)row * 4 + fq]); return 1.0f / sqrtf(s * (1.0f / 256.0f) + RMS_EPS); }
    }
    __device__ __forceinline__ void get8(float (&rsv)[2][4], int row0, int fq) const {
#pragma unroll
        for (int ai = 0; ai < 2; ++ai)
#pragma unroll
            for (int m = 0; m < 4; ++m) rsv[ai][m] = get(row0 + ai * 128 + m * 16, fq);
        asm volatile("" ::: "memory");
    }
};

struct EpiScale {
    static constexpr bool PERM = true, AFTER_DRAIN = false;
    bf16_t* O; int ldc; RowScale rs; float cs;
    __device__ __forceinline__ void operator()(const f32x4 (&acc)[2][2][4][2], const Unit& u, int wr, int wc, int fr_, int fq_) const {
        const int ln_ = lane_id(), fr = ln_ & 15, fq = ln_ >> 4; (void)fr_; (void)fq_;
        const int row0 = u.pm * BM + wr * 64 + fr, col0 = u.pn * BM + wc * 32 + 8 * fq;
        float rsv[2][4]; rs.get8(rsv, row0, fq);
#pragma unroll
        for (int ai = 0; ai < 2; ++ai)
#pragma unroll
            for (int m = 0; m < 4; ++m) { const int row = row0 + ai * HALF + m * 16; const float s = rsv[ai][m] * cs; bf16_t* rowp = O + (size_t)row * ldc + col0;
#pragma unroll
                for (int bj = 0; bj < 2; ++bj) *(u32x4*)(rowp + bj * HALF) = pack8(acc[ai][bj][m][0] * s, acc[ai][bj][m][1] * s); }
    }
};
__device__ __forceinline__ void rope8(f32x4& v0, f32x4& v1, const float* cs_row, int fq) {
    f32x4 p0, p1;
#pragma unroll
    for (int j = 0; j < 4; ++j) { p0[j] = xor32(v0[j], fq >> 1); p1[j] = xor32(v1[j], fq >> 1); }
    const int f0 = 8 * (fq & 1);
    const f32x4 c0 = *(const f32x4*)(cs_row + f0), c1 = *(const f32x4*)(cs_row + f0 + 4), s0 = *(const f32x4*)(cs_row + 16 + f0), s1 = *(const f32x4*)(cs_row + 16 + f0 + 4);
    if (fq < 2) { v0 = v0 * c0 - p0 * s0; v1 = v1 * c1 - p1 * s1; } else { v0 = v0 * c0 + p0 * s0; v1 = v1 * c1 + p1 * s1; }
}
struct EpiAin {
    static constexpr bool PERM = true, AFTER_DRAIN = false;
    bf16_t* AQ; bf16_t* AKV; float* KPE; float* SSQQ; float* SSQKV; RowScale rs; const float* gk; const float* CS; float* SSPE;
    __device__ __forceinline__ void operator()(const f32x4 (&acc)[2][2][4][2], const Unit& u, int wr, int wc, int fr_, int fq_) const {
        const int ln_ = lane_id(), fr = ln_ & 15, fq = ln_ >> 4; (void)fr_; (void)fq_;
        const int row0 = u.pm * BM + wr * 64 + fr, c8 = wc * 32 + 8 * fq;
        float rsv[2][4]; rs.get8(rsv, row0, fq);
#pragma unroll
        for (int ai = 0; ai < 2; ++ai)
#pragma unroll
            for (int m = 0; m < 4; ++m) { const int row = row0 + ai * HALF + m * 16; const float s = rsv[ai][m];
                const f32x4 a0 = acc[ai][0][m][0] * s, a1 = acc[ai][0][m][1] * s, b0 = acc[ai][1][m][0] * s, b1 = acc[ai][1][m][1] * s;
                if (u.pn == 0) {
                    *(u32x4*)(AQ + (size_t)row * 384 + c8) = pack8(a0, a1); *(u32x4*)(AQ + (size_t)row * 384 + 128 + c8) = pack8(b0, b1);
                    const float q = red_fq(sumsq8(a0, a1) + sumsq8(b0, b1)); if (fq == 0) SSQQ[(size_t)row * 8 + wc] = q;
                } else if (u.pn == 1) {
                    *(u32x4*)(AQ + (size_t)row * 384 + 256 + c8) = pack8(a0, a1);
                    const float q = red_fq(sumsq8(a0, a1)); if (fq == 0) SSQQ[(size_t)row * 8 + 4 + wc] = q;
                    if (wc == 0) { const float qp = red_fq(sumsq8(b0, b1)); if (fq == 0) SSPE[row] = qp;
                        f32x4 y0 = b0 * *(const f32x4*)(gk + 64 + 8 * fq), y1 = b1 * *(const f32x4*)(gk + 64 + 8 * fq + 4); rope8(y0, y1, CS + (size_t)row * 32, fq);
                        *(f32x4*)(KPE + (size_t)row * 32 + 8 * fq) = y0; *(f32x4*)(KPE + (size_t)row * 32 + 8 * fq + 4) = y1; }
                } else {
                    *(u32x4*)(AKV + (size_t)row * 256 + c8) = pack8(a0, a1); *(u32x4*)(AKV + (size_t)row * 256 + 128 + c8) = pack8(b0, b1);
                    const float q = red_fq(sumsq8(a0, a1) + sumsq8(b0, b1)); if (fq == 0) SSQKV[(size_t)row * 4 + wc] = q;
                } }
    }
};
struct EpiSwiglu {
    static constexpr bool PERM = true, AFTER_DRAIN = false;
    bf16_t* HID; RowScale rs;
    __device__ __forceinline__ void operator()(const f32x4 (&acc)[2][2][4][2], const Unit& u, int wr, int wc, int fr_, int fq_) const {
        const int ln_ = lane_id(), fr = ln_ & 15, fq = ln_ >> 4; (void)fr_; (void)fq_;
        const int row0 = u.pm * BM + wr * 64 + fr, col0 = u.pn * 128 + wc * 32 + 8 * fq;
        float rsv[2][4]; rs.get8(rsv, row0, fq);
#pragma unroll
        for (int ai = 0; ai < 2; ++ai)
#pragma unroll
            for (int m = 0; m < 4; ++m) { const int row = row0 + ai * HALF + m * 16; const float s = rsv[ai][m];
                f32x4 o[2];
#pragma unroll
                for (int n = 0; n < 2; ++n) { const f32x4 g = acc[ai][0][m][n] * s, up = acc[ai][1][m][n] * s;
#pragma unroll
                    for (int j = 0; j < 4; ++j) o[n][j] = g[j] * sigmoidf_(g[j]) * up[j]; }
                *(u32x4*)(HID + (size_t)row * 2816 + col0) = pack8(o[0], o[1]); }
    }
};
template <bool GATED> struct EpiRes {
    static constexpr bool PERM = true, AFTER_DRAIN = false;
    const bf16_t* HBi; bf16_t* HBo; float* SSQo; const bf16_t* U; RowScale rs; float* OUTF;
    __device__ __forceinline__ void operator()(const f32x4 (&acc)[2][2][4][2], const Unit& u, int wr, int wc, int fr_, int fq_) const {
        const int ln_ = lane_id(), fr = ln_ & 15, fq = ln_ >> 4; (void)fr_; (void)fq_;
        const int row0 = u.pm * BM + wr * 64 + fr, col0 = u.pn * BM + wc * 32 + 8 * fq;
        float rsv[2][4]; if (GATED) rs.get8(rsv, row0, fq);
#pragma unroll
        for (int ai = 0; ai < 2; ++ai)
#pragma unroll
            for (int m = 0; m < 4; ++m) { const int row = row0 + ai * HALF + m * 16; const size_t off = (size_t)row * DMODEL + col0;
                float s = 1.0f; if (GATED) s = rsv[ai][m];
                float q = 0.f;
#pragma unroll
                for (int bj = 0; bj < 2; ++bj) { f32x4 a0 = acc[ai][bj][m][0], a1 = acc[ai][bj][m][1];
                    f32x4 h0, h1; unpack8(*(const u32x4*)(HBi + off + bj * HALF), h0, h1);
                    if (GATED) { f32x4 u0, u1; unpack8(*(const u32x4*)(U + off + bj * HALF), u0, u1);
#pragma unroll
                        for (int j = 0; j < 4; ++j) { a0[j] = sigmoidf_(a0[j] * s) * u0[j]; a1[j] = sigmoidf_(a1[j] * s) * u1[j]; } }
                    h0 += a0; h1 += a1;
                    if (GATED) { if (OUTF) { *(f32x4*)(OUTF + off + bj * HALF) = h0; *(f32x4*)(OUTF + off + bj * HALF + 4) = h1; } }
                    *(u32x4*)(HBo + off + bj * HALF) = pack8(h0, h1);
                    q += sumsq8(h0, h1); }
                q = red_fq(q); if (fq == 0) SSQo[(size_t)row * 16 + u.pn * 4 + wc] = q;
                asm volatile("" ::: "memory"); }
    }
};
struct EpiKvs {
    static constexpr bool PERM = true, AFTER_DRAIN = false;
    bf16_t* KT; bf16_t* VT; RowScale rs;
    __device__ __forceinline__ void operator()(const f32x4 (&acc)[2][2][4][2], const Unit& u, int wr, int wc, int fr_, int fq_) const {
        const int ln_ = lane_id(), fr = ln_ & 15, fq = ln_ >> 4; (void)fr_; (void)fq_;
        const int row0 = u.pm * BM + wr * 64 + fr;
        float rsv[2][4]; rs.get8(rsv, row0, fq);
#pragma unroll
        for (int ai = 0; ai < 2; ++ai)
#pragma unroll
            for (int m = 0; m < 4; ++m) { const int row = row0 + ai * HALF + m * 16; const float s = rsv[ai][m];
                const int b = row >> 13, sq = row & 8191, tile = sq >> 6, rr = sq & 63;
#pragma unroll
                for (int bj = 0; bj < 2; ++bj) { const int c = bj * HALF + wc * 32 + 8 * fq, kh = c >> 6, d = c & 63;
                    const size_t tb = (size_t)((b * 4 + kh) * 128 + tile) * 4096;
                    const u32x4 w = pack8(acc[ai][bj][m][0] * s, acc[ai][bj][m][1] * s);
                    if (u.pn == 0) *(u32x4*)(KT + tb + (d >> 3) * 512 + rr * 8) = w;
                    else *(u32x4*)(VT + tb + (d >> 5) * 2048 + rr * 32 + (d & 31)) = w; } }
    }
};

#define PG8_LAS LAS
template <class Epi, class Sched, bool ALIGN_EPI = false, bool SP2 = false>
__device__ __forceinline__ void gemm_phase(PG8_LAS unsigned char* lds, const Gemm g, const Sched& S, const Epi& E, int wv  ) {
    int tid_ = wv * 64 + lane_id(); asm volatile("" : "+v"(tid_));
    const int tid = tid_, wid = __builtin_amdgcn_readfirstlane(tid >> 6), lane = tid & 63, wr = wid >> 2, wc = wid & 3, fr = lane & 15, fq = lane >> 4;
    const int K = g.K, nt = K / BK;
    unsigned voffA[2], voffB[2];
#pragma unroll
    for (int i = 0; i < 2; ++i) { int R, C; stage_rc(tid * 16 + i * 8192, R, C); const int Rb = Epi::PERM ? ((R & ~31) + perm32(R & 31)) : R;
        voffA[i] = (unsigned)(R * K + C) * 2u; voffB[i] = (unsigned)(Rb * K + C) * 2u; }
    const size_t kstep = (size_t)(BK * 2);
    const size_t hstep = (size_t)HALF * K * 2;
    const size_t tstep = 2 * hstep;
    const unsigned ldsw = (unsigned)wid * 1024u;
    const int aoff = lds_byte(wr * 64 + fr, fq * 8), boff = lds_byte(wc * 32 + fr, fq * 8);
#define PG8_SA(b, h) (((b) * 2 + (h)) * HTB)
#define PG8_SB(b, h) ((4 + (b) * 2 + (h)) * HTB)
#define PG8_STAGE(bufoff, gbase, voff) do { _Pragma("unroll") for (int _i = 0; _i < 2; ++_i) \
        __builtin_amdgcn_global_load_lds((const unsigned*)((const char*)(gbase) + (voff)[_i]), (PG8_LAS unsigned*)(lds + (bufoff) + ldsw + _i * 8192), 16, 0, 0); } while (0)
#define PG8_LDA(dst, b, h) do { _Pragma("unroll") for (int m = 0; m < 4; ++m) _Pragma("unroll") for (int k = 0; k < 2; ++k) dst[m][k] = *(const PG8_LAS bf16x8*)(lds + PG8_SA(b, h) + aoff + m * 2048 + k * 1024); } while (0)
#define PG8_LDB(dst, b, h) do { _Pragma("unroll") for (int n = 0; n < 2; ++n) _Pragma("unroll") for (int k = 0; k < 2; ++k) dst[n][k] = *(const PG8_LAS bf16x8*)(lds + PG8_SB(b, h) + boff + n * 2048 + k * 1024); } while (0)
#define PG8_MMA(ai, bj, At, Bt) do { __builtin_amdgcn_s_setprio(1); _Pragma("unroll") for (int m = 0; m < 4; ++m) _Pragma("unroll") for (int n = 0; n < 2; ++n) _Pragma("unroll") for (int k = 0; k < 2; ++k) \
        acc[ai][bj][m][n] = __builtin_amdgcn_mfma_f32_16x16x32_bf16(Bt[n][k], At[m][k], acc[ai][bj][m][n], 0, 0, 0); __builtin_amdgcn_s_setprio(0); } while (0)
#define PG8_WAIT_V(n) asm volatile("s_waitcnt vmcnt(" #n ")" ::: "memory")
#define PG8_WAIT_L(n) asm volatile("s_waitcnt lgkmcnt(" #n ")" ::: "memory")
#define PG8_BAR __builtin_amdgcn_s_barrier()
#define PG8_SCHED __builtin_amdgcn_sched_barrier(0)
    Unit cur, nxt; int ui = 0;
    if (!S.next(0, cur)) return;
    f32x4 acc[2][2][4][2];
#pragma unroll
    for (int a = 0; a < 2; ++a)
#pragma unroll
        for (int b = 0; b < 2; ++b)
#pragma unroll
            for (int m = 0; m < 4; ++m)
#pragma unroll
                for (int n = 0; n < 2; ++n) acc[a][b][m][n] = (f32x4){0.f, 0.f, 0.f, 0.f};
    bf16x8 At[4][2], B0[2][2], B1[2][2];
    const char* cA = (const char*)g.A + (size_t)cur.pm * tstep; const char* cB = (const char*)g.Bt + cur.boff + (size_t)cur.pn * tstep;
    if constexpr (SP2) {
        PG8_STAGE(PG8_SB(0, 0), cB, voffB); PG8_STAGE(PG8_SB(0, 1), cB + hstep, voffB); PG8_STAGE(PG8_SA(0, 0), cA, voffA); PG8_STAGE(PG8_SA(0, 1), cA + hstep, voffA);
        if (wr == 1) PG8_BAR;
        PG8_WAIT_V(2); PG8_BAR;
        PG8_STAGE(PG8_SB(1, 0), cB + kstep, voffB); PG8_STAGE(PG8_SA(1, 0), cA + kstep, voffA); PG8_STAGE(PG8_SB(1, 1), cB + hstep + kstep, voffB);
        PG8_WAIT_V(6); PG8_BAR;
    } else {
        PG8_STAGE(PG8_SB(0, 0), cB, voffB); PG8_STAGE(PG8_SA(0, 0), cA, voffA); PG8_STAGE(PG8_SB(0, 1), cB + hstep, voffB); PG8_STAGE(PG8_SA(0, 1), cA + hstep, voffA);
        if (wr == 1) PG8_BAR;
        PG8_WAIT_V(4); PG8_BAR;
        PG8_STAGE(PG8_SB(1, 0), cB + kstep, voffB); PG8_STAGE(PG8_SA(1, 0), cA + kstep, voffA); PG8_STAGE(PG8_SB(1, 1), cB + hstep + kstep, voffB);
        PG8_WAIT_V(6); PG8_BAR;
    }
    for (;;) {
        const bool has_next = S.next(ui + 1, nxt);
        const char* nA = has_next ? (const char*)g.A + (size_t)nxt.pm * tstep : cA; const char* nB = has_next ? (const char*)g.Bt + nxt.boff + (size_t)nxt.pn * tstep : cB;
        for (int t = 0; t < nt; t += 2) {
            const bool last = (t == nt - 2);
            const char* a1 = cA + (size_t)(t + 1) * kstep;
            const char* a2 = last ? nA : cA + (size_t)(t + 2) * kstep; const char* b2 = last ? nB : cB + (size_t)(t + 2) * kstep;
            const char* a3 = a2 + kstep; const char* b3 = b2 + kstep;
            if constexpr (SP2) {
            PG8_LDB(B0, 0, 0); PG8_LDB(B1, 0, 1); PG8_SCHED; PG8_LDA(At, 0, 0); PG8_STAGE(PG8_SA(1, 1), a1 + hstep, voffA);
            PG8_WAIT_V(8); PG8_WAIT_L(0); PG8_BAR; PG8_MMA(0, 0, At, B0); PG8_MMA(0, 1, At, B1); PG8_BAR; PG8_SCHED;
            PG8_LDA(At, 0, 1); PG8_STAGE(PG8_SB(0, 0), b2, voffB); PG8_STAGE(PG8_SB(0, 1), b2 + hstep, voffB); PG8_STAGE(PG8_SA(0, 0), a2, voffA);
            PG8_WAIT_V(8); PG8_WAIT_L(0); PG8_BAR; PG8_MMA(1, 0, At, B0); PG8_MMA(1, 1, At, B1); PG8_BAR; PG8_SCHED;
            PG8_LDB(B0, 1, 0); PG8_LDB(B1, 1, 1); PG8_SCHED; PG8_LDA(At, 1, 0); PG8_STAGE(PG8_SA(0, 1), a2 + hstep, voffA);
            PG8_WAIT_V(8); PG8_WAIT_L(0); PG8_BAR; PG8_MMA(0, 0, At, B0); PG8_MMA(0, 1, At, B1); PG8_BAR; PG8_SCHED;
            PG8_LDA(At, 1, 1); PG8_STAGE(PG8_SB(1, 0), b3, voffB); PG8_STAGE(PG8_SB(1, 1), b3 + hstep, voffB); PG8_STAGE(PG8_SA(1, 0), a3, voffA);
            PG8_WAIT_V(8); PG8_WAIT_L(0); PG8_BAR; PG8_MMA(1, 0, At, B0); PG8_MMA(1, 1, At, B1); PG8_BAR; PG8_SCHED;
            } else {
            PG8_LDB(B0, 0, 0); PG8_SCHED; PG8_LDA(At, 0, 0); PG8_STAGE(PG8_SA(1, 1), a1 + hstep, voffA);
            PG8_WAIT_L(8); PG8_BAR; PG8_WAIT_L(0); PG8_MMA(0, 0, At, B0); PG8_BAR; PG8_SCHED;
            PG8_LDB(B1, 0, 1); PG8_STAGE(PG8_SB(0, 0), b2, voffB);
            PG8_BAR; PG8_WAIT_L(0); PG8_MMA(0, 1, At, B1); PG8_BAR;
            PG8_LDA(At, 0, 1); PG8_STAGE(PG8_SA(0, 0), a2, voffA);
            PG8_BAR; PG8_WAIT_L(0); PG8_MMA(1, 0, At, B0); PG8_BAR; PG8_SCHED;
            PG8_STAGE(PG8_SB(0, 1), b2 + hstep, voffB);
            PG8_WAIT_V(6); PG8_BAR; PG8_MMA(1, 1, At, B1); PG8_BAR;
            PG8_LDB(B0, 1, 0); PG8_SCHED; PG8_LDA(At, 1, 0); PG8_STAGE(PG8_SA(0, 1), a2 + hstep, voffA);
            PG8_WAIT_L(8); PG8_BAR; PG8_WAIT_L(0); PG8_MMA(0, 0, At, B0); PG8_BAR; PG8_SCHED;
            PG8_LDB(B1, 1, 1); PG8_STAGE(PG8_SB(1, 0), b3, voffB);
            PG8_BAR; PG8_WAIT_L(0); PG8_MMA(0, 1, At, B1); PG8_BAR;
            PG8_LDA(At, 1, 1); PG8_STAGE(PG8_SA(1, 0), a3, voffA);
            PG8_BAR; PG8_WAIT_L(0); PG8_MMA(1, 0, At, B0); PG8_BAR; PG8_SCHED;
            PG8_STAGE(PG8_SB(1, 1), b3 + hstep, voffB);
            PG8_WAIT_V(6); PG8_BAR; PG8_MMA(1, 1, At, B1); PG8_BAR;
            }
        }
        if constexpr (ALIGN_EPI) { if (wr == 0) PG8_BAR; }
        E(acc, cur, wr, wc, fr, fq);
        if (!has_next) break;
#pragma unroll
        for (int a = 0; a < 2; ++a)
#pragma unroll
            for (int b = 0; b < 2; ++b)
#pragma unroll
                for (int m = 0; m < 4; ++m)
#pragma unroll
                    for (int n = 0; n < 2; ++n) acc[a][b][m][n] = (f32x4){0.f, 0.f, 0.f, 0.f};
        cur = nxt; cA = nA; cB = nB; ++ui;
        if constexpr (ALIGN_EPI) { if (wr == 1) PG8_BAR; }
    }
    PG8_WAIT_V(0);
    if constexpr (!ALIGN_EPI) { if (wr == 0) PG8_BAR; }
    PG8_BAR;
#undef PG8_SA
#undef PG8_SB
#undef PG8_STAGE
#undef PG8_LDA
#undef PG8_LDB
#undef PG8_MMA
#undef PG8_WAIT_V
#undef PG8_WAIT_L
#undef PG8_BAR
#undef PG8_SCHED
}
}
typedef GAS unsigned gu32;
#define RLX_AGENT __ATOMIC_RELAXED, __HIP_MEMORY_SCOPE_AGENT
#define XB_TMO      128
#define XB_XCNT(j)  (256  + 64 * (j))
#define XB_XSUB(j)  (1280 + 64 * (j))
#define XB_XGEN(j)  (2304 + 64 * (j))
#define XB_TOP      3328
#define XB_TOPGEN   3392
#define XCD_BAR_WORDS 3456
#define XB_SPIN_CAP (1u << 18)

__device__ __forceinline__ unsigned xb_ld(unsigned* p)              { return __hip_atomic_load(p, __ATOMIC_RELAXED, __HIP_MEMORY_SCOPE_AGENT); }
__device__ __forceinline__ unsigned xb_add(unsigned* p, unsigned v) { return __hip_atomic_fetch_add(p, v, __ATOMIC_RELAXED, __HIP_MEMORY_SCOPE_AGENT); }
__device__ __forceinline__ unsigned xb_xcc_id() { return (unsigned)__builtin_amdgcn_s_getreg((3 << 11) | 20) & 0xFu; }
#define XB_SPIN(cond, bar) do { unsigned _sp = 0; while (cond) { __builtin_amdgcn_s_sleep(1); \
    if ((++_sp & 255u) == 0u) { if (xb_ld(&(bar)[XB_TMO])) break; if (_sp > XB_SPIN_CAP) { atomicAdd(&(bar)[XB_TMO], 1u); break; } } } } while (0)

struct XcdBarrier {
    unsigned* bar; unsigned x; int wv;
    volatile LAS unsigned* st;
};
__device__ __forceinline__ XcdBarrier xcd_barrier_post(unsigned* bar, volatile LAS unsigned* st, int wv) {
    XcdBarrier b; b.bar = bar; b.x = xb_xcc_id(); b.st = st; b.wv = wv;
    if (wv == 0 && lane_id() == 0) (void)xb_add(&bar[XB_XCNT(b.x)], 1u);
    return b;
}
__device__ __forceinline__ void xcd_barrier_complete(unsigned* bar, unsigned x, unsigned& nloc, unsigned& nx) {
    const unsigned G = gridDim.x * gridDim.y * gridDim.z;
    unsigned sum, cnt, mine, sp = 0u;
    for (;;) {
        sum = 0u; cnt = 0u; mine = 0u;
#pragma unroll
        for (unsigned j = 0; j < 16; ++j) { const unsigned c = xb_ld(&bar[XB_XCNT(j)]); sum += c; cnt += (c > 0u) ? 1u : 0u; mine = (j == x) ? c : mine; }
        if (sum == G) break;
        __builtin_amdgcn_s_sleep(1);
        if ((++sp & 255u) == 0u) { if (xb_ld(&bar[XB_TMO])) break; if (sp > XB_SPIN_CAP) { atomicAdd(&bar[XB_TMO], 1u); break; } }
    }
    nloc = mine > 0u ? mine : 1u; nx = cnt > 0u ? cnt : 1u;
}
__device__ __forceinline__ void xcd_barrier(const XcdBarrier& b) {
    asm volatile("s_waitcnt vmcnt(0)" ::: "memory");
    __syncthreads();
    if (b.wv == 0 && lane_id() == 0) {
        unsigned* bar = b.bar;
        __builtin_amdgcn_s_waitcnt(0);
        unsigned nloc = b.st[0], nx = b.st[1];
        if (nloc == 0u) { xcd_barrier_complete(bar, b.x, nloc, nx); b.st[0] = nloc; b.st[1] = nx; }
        const unsigned old = xb_add(&bar[XB_XSUB(b.x)], 1u);
        const unsigned gen = old / nloc;
        if (old + 1u == (gen + 1u) * nloc) {
            __builtin_amdgcn_fence(__ATOMIC_RELEASE, "agent");
            asm volatile("s_waitcnt vmcnt(0)" ::: "memory");
            const unsigned og = xb_add(&bar[XB_TOP], 1u);
            const unsigned tg = og / nx;
            if (og + 1u == (tg + 1u) * nx) xb_add(&bar[XB_TOPGEN], 1u);
            else XB_SPIN(xb_ld(&bar[XB_TOPGEN]) == tg, bar);
            __builtin_amdgcn_fence(__ATOMIC_ACQUIRE, "agent");
            xb_add(&bar[XB_XGEN(b.x)], 1u);
            asm volatile("s_waitcnt vmcnt(0)" ::: "memory");
        } else {
            XB_SPIN(xb_ld(&bar[XB_XGEN(b.x)]) == gen, bar);
            __builtin_amdgcn_fence(__ATOMIC_ACQUIRE, "agent");
            asm volatile("s_waitcnt vmcnt(0)" ::: "memory");
        }
    }
    __syncthreads();
}

namespace att {
__device__ __forceinline__ int crow(int r, int hi) { return (r & 3) + 8 * (r >> 2) + 4 * hi; }
__device__ __forceinline__ void glds16(const void* gsrc, unsigned lds_dst) { unsigned keep;
    asm volatile("s_mov_b32 %0, m0\n\ts_mov_b32 m0, %2\n\ts_nop 0\n\tglobal_load_lds_dwordx4 %1, off\n\ts_mov_b32 m0, %0" : "=&s"(keep) : "v"(gsrc), "s"(lds_dst) : "memory"); }
#define ATT_WAIT_BAR(N) asm volatile("s_waitcnt vmcnt(" #N ") lgkmcnt(0)\n\ts_barrier" ::: "memory")
#define ATT_MX3(a, b, c) __builtin_fmaxf(__builtin_fmaxf((a), (b)), (c))
typedef LAS const unsigned char* lcp;
typedef short v4i16_t __attribute__((ext_vector_type(4)));
__device__ __forceinline__ s16x4 vtr(lcp p) { return __builtin_bit_cast(s16x4, __builtin_amdgcn_ds_read_tr16_b64_v4i16((LAS v4i16_t*)p)); }
__device__ __forceinline__ float rowmax(const f32x16& p0, const f32x16& p1) {
    float a = ATT_MX3(p0[0], p0[1], p1[0]), b = ATT_MX3(p0[2], p0[3], p1[1]); a = ATT_MX3(a, p1[2], p1[3]);
#pragma unroll
    for (int r = 4; r < 16; r += 4) { a = ATT_MX3(a, p0[r], p0[r + 1]); b = ATT_MX3(b, p0[r + 2], p0[r + 3]); a = ATT_MX3(a, p1[r], p1[r + 1]); b = ATT_MX3(b, p1[r + 2], p1[r + 3]); }
    float m = __builtin_fmaxf(a, b); auto rr = __builtin_amdgcn_permlane32_swap(__float_as_uint(m), __float_as_uint(m), false, false);
    return __builtin_fmaxf(__uint_as_float(rr[0]), __uint_as_float(rr[1])); }
template <bool FAKEV = false> __device__ __forceinline__ void pv(f32x16* o, lcp vp, const u32x4 pw0, const u32x4 pw1, const u32x4 pw2, const u32x4 pw3) {
#pragma unroll
    for (int ks = 0; ks < 4; ++ks) {
        const u32x4 pw = ks == 0 ? pw0 : ks == 1 ? pw1 : ks == 2 ? pw2 : pw3;
#pragma unroll
        for (int d0 = 0; d0 < 2; ++d0) {
            bf16x8 vf;
            if (FAKEV) vf = __builtin_bit_cast(bf16x8, ks & 1 ? pw0 : pw2);
            else { const s16x4 lo = vtr(vp + d0 * 4096 + ks * 1024), hi = vtr(vp + d0 * 4096 + ks * 1024 + 512); vf = (bf16x8){lo[0], lo[1], lo[2], lo[3], hi[0], hi[1], hi[2], hi[3]}; }
            o[d0] = __builtin_amdgcn_mfma_f32_32x32x16_bf16(__builtin_bit_cast(bf16x8, pw), vf, o[d0], 0, 0, 0);
        }
    }
}
__device__ __forceinline__ void store_o(const f32x16* o, const float* rsc  , LAS unsigned char* stage, bf16_t* Ow, int pitch, int lane, int r32, int hi) {
    LAS bf16_t* stg = (LAS bf16_t*)stage;
#pragma unroll
    for (int r = 0; r < 16; ++r) { const int orow = crow(r, hi);
#pragma unroll
        for (int d0 = 0; d0 < 2; ++d0) stg[orow * 64 + d0 * 32 + r32] = (bf16_t)(pk_bf16(o[d0][r] * rsc[r], 0.f) & 0xffffu); }
    asm volatile("s_waitcnt lgkmcnt(0)" ::: "memory");
#pragma unroll
    for (int i = 0; i < 4; ++i) { const int row = i * 8 + (lane >> 3), ch = lane & 7; const u32x4 v = *(const LAS u32x4*)(stg + row * 64 + ch * 8); *(u32x4*)(Ow + (size_t)row * pitch + ch * 8) = v; }
}

namespace mla {
constexpr int KSLOT = 12288, VSLOT = 8192, NS = 3;
constexpr int L_K = 0, L_V = NS * KSLOT, L_WS = L_V + NS * VSLOT, L_OST = L_WS + 2048, L_END = L_OST + 8 * 4096;
#define MLA_BAR_L() asm volatile("s_waitcnt lgkmcnt(0)\n\ts_barrier" ::: "memory")
template <int ABL> __device__ __forceinline__ void unit(int b, int h, int qb, const bf16_t* Q, const bf16_t* KT, const bf16_t* VT, bf16_t* O, LAS unsigned char* shm, int wv) {
    int tid_ = wv * 64 + lane_id(); asm volatile("" : "+v"(tid_));
    const int tid = tid_, lane = tid & 63, r32 = lane & 31, hi = lane >> 5; const int wid = __builtin_amdgcn_readfirstlane(tid >> 6);
    const int grp = wid >> 2;
    const long rowbase = (long)b * SEQL; const int q0 = qb * 256;
    const bf16_t* Qw = Q + (size_t)(rowbase + q0 + wid * 32) * 768 + h * 96;
    const bf16_t* Kh = KT + (size_t)((b * 8 + h) * 128) * 6144 + lane * 8;
    const bf16_t* Vh = VT + (size_t)((b * 8 + h) * 128) * 4096 + lane * 8;
    const unsigned lds0 = (unsigned)(uintptr_t)shm;
    LAS float* wsf = (LAS float*)(shm + L_WS) + wid * 64;
    const int NT = (q0 + 256) / 64;
    const int kc2 = 8 + (wid & 3);
    bf16x8 qr[6];
#pragma unroll
    for (int d0 = 0; d0 < 6; ++d0) qr[d0] = *(const bf16x8*)(Qw + (size_t)r32 * 768 + d0 * 16 + hi * 8);
#define MLA_DMA_K(t, sl) do { const bf16_t* kt_ = Kh + (size_t)(t) * 6144; \
        glds16(kt_ + wid * 512, (unsigned)__builtin_amdgcn_readfirstlane(lds0 + L_K + (sl) * KSLOT + wid * 1024)); \
        glds16(kt_ + kc2 * 512, (unsigned)__builtin_amdgcn_readfirstlane(lds0 + L_K + (sl) * KSLOT + kc2 * 1024)); } while (0)
#define MLA_DMA_V(t, sl) glds16(Vh + (size_t)(t) * 4096 + wid * 512, (unsigned)__builtin_amdgcn_readfirstlane(lds0 + L_V + (sl) * VSLOT + wid * 1024))
#define MLA_GROUP(g, s0, s2) do { if ((g) + 3 < NT) MLA_DMA_K((g) + 3, s0); if ((g) + 2 < NT) MLA_DMA_V((g) + 2, s2); } while (0)
#define MLA_LOADK(sl) do { const lcp kb_ = (lcp)shm + L_K + (sl) * KSLOT + hi * 1024 + r32 * 16; _Pragma("unroll") for (int d0 = 0; d0 < 6; ++d0) { kf[2 * d0] = *(const LAS bf16x8*)(kb_ + d0 * 2048); kf[2 * d0 + 1] = *(const LAS bf16x8*)(kb_ + d0 * 2048 + 512); } } while (0)
    MLA_DMA_K(0, 0); MLA_DMA_K(1, 1); MLA_DMA_V(0, 0); MLA_DMA_K(2, 2); MLA_DMA_V(1, 1);
    float m = 0.f, l = 0.f; f32x16 o[2], negm;
#pragma unroll
    for (int r = 0; r < 16; ++r) { o[0][r] = 0.f; o[1][r] = 0.f; negm[r] = 0.f; }
    const int qrel = wid * 32 + r32;
    bf16x8 kf[12], vf[8]; u32x4 pw0 = {0u, 0u, 0u, 0u}, pw1 = pw0, pw2 = pw0, pw3 = pw0;
    ATT_WAIT_BAR(6);
    MLA_LOADK(0);
    if (grp == 1) ATT_WAIT_BAR(3);
    int s0 = 0, s1 = 1, s2 = 2;
    bool act_prev = false;
    for (int t = 0; t < NT; ++t) {
        if (grp == 1) MLA_GROUP(t, s0, s2);
        const int jb = t - (NT - 4);
        const bool act = ABL != 5 && (jb <= 0 || 64 * jb <= wid * 32 + 31);
        f32x16 p0 = negm, p1 = negm;
        if (act) {
#pragma unroll
            for (int d0 = 0; d0 < 6; ++d0) { p0 = __builtin_amdgcn_mfma_f32_32x32x16_bf16(kf[2 * d0], qr[d0], p0, 0, 0, 0); p1 = __builtin_amdgcn_mfma_f32_32x32x16_bf16(kf[2 * d0 + 1], qr[d0], p1, 0, 0, 0); }
        }
        if (act_prev) {
#pragma unroll
            for (int ks = 0; ks < 4; ++ks) { const u32x4 pw = ks == 0 ? pw0 : ks == 1 ? pw1 : ks == 2 ? pw2 : pw3;
                o[0] = __builtin_amdgcn_mfma_f32_32x32x16_bf16(__builtin_bit_cast(bf16x8, pw), vf[ks], o[0], 0, 0, 0);
                o[1] = __builtin_amdgcn_mfma_f32_32x32x16_bf16(__builtin_bit_cast(bf16x8, pw), vf[4 + ks], o[1], 0, 0, 0); }
        }
        if (grp == 0) { if (t + 2 < NT) ATT_WAIT_BAR(3); else ATT_WAIT_BAR(0); MLA_GROUP(t, s0, s2); }
        else MLA_BAR_L();
        if (act) {
            { const lcp vp = (lcp)shm + L_V + s0 * VSLOT + ((lane >> 4) & 1) * 32 + (lane & 3) * 8 + (4 * hi + ((lane & 15) >> 2)) * 64;
#pragma unroll
                for (int d0 = 0; d0 < 2; ++d0)
#pragma unroll
                    for (int ks = 0; ks < 4; ++ks) { const s16x4 lo = vtr(vp + d0 * 4096 + ks * 1024), hh = vtr(vp + d0 * 4096 + ks * 1024 + 512);
                        vf[d0 * 4 + ks] = (bf16x8){lo[0], lo[1], lo[2], lo[3], hh[0], hh[1], hh[2], hh[3]}; } }
        }
        if (t + 1 < NT) MLA_LOADK(s1);
        if (act) {
            if (jb >= 0) {
#pragma unroll
                for (int r = 0; r < 16; ++r) { const int kv = 64 * jb + crow(r, hi); if (kv > qrel) p0[r] = -INFINITY; if (kv + 32 > qrel) p1[r] = -INFINITY; }
            }
            const float rm = rowmax(p0, p1);
            if (t == 0 || __any(rm > 8.0f)) {
                const float dl = t == 0 ? rm : __builtin_fmaxf(rm, 0.f); m += dl;
#pragma unroll
                for (int r = 0; r < 16; ++r) { p0[r] -= dl; p1[r] -= dl; negm[r] = -m; }
                const float alpha = fast_exp2(-dl); l *= alpha; if (hi == 0) wsf[r32] = alpha;
#pragma unroll
                for (int r = 0; r < 16; ++r) { const float a = wsf[crow(r, hi)]; o[0][r] *= a; o[1][r] *= a; }
            }
            float sa = 0.f, sb = 0.f;
#pragma unroll
            for (int r = 0; r < 16; ++r) { if (ABL != 1) { p0[r] = fast_exp2(p0[r]); p1[r] = fast_exp2(p1[r]); } sa += p0[r]; sb += p1[r]; }
            l += sa + sb;
            pw0 = (u32x4){pk_bf16(p0[0], p0[1]), pk_bf16(p0[2], p0[3]), pk_bf16(p0[4], p0[5]), pk_bf16(p0[6], p0[7])};
            pw1 = (u32x4){pk_bf16(p0[8], p0[9]), pk_bf16(p0[10], p0[11]), pk_bf16(p0[12], p0[13]), pk_bf16(p0[14], p0[15])};
            pw2 = (u32x4){pk_bf16(p1[0], p1[1]), pk_bf16(p1[2], p1[3]), pk_bf16(p1[4], p1[5]), pk_bf16(p1[6], p1[7])};
            pw3 = (u32x4){pk_bf16(p1[8], p1[9]), pk_bf16(p1[10], p1[11]), pk_bf16(p1[12], p1[13]), pk_bf16(p1[14], p1[15])};
        }
        act_prev = act;
        if (grp == 0) MLA_BAR_L();
        else { if (t + 3 < NT) ATT_WAIT_BAR(3); else ATT_WAIT_BAR(0); }
        { const int tmp = s0; s0 = s1; s1 = s2; s2 = tmp; }
    }
#undef MLA_DMA_K
#undef MLA_DMA_V
#undef MLA_GROUP
#undef MLA_LOADK
    if (act_prev) {
#pragma unroll
        for (int ks = 0; ks < 4; ++ks) { const u32x4 pw = ks == 0 ? pw0 : ks == 1 ? pw1 : ks == 2 ? pw2 : pw3;
            o[0] = __builtin_amdgcn_mfma_f32_32x32x16_bf16(__builtin_bit_cast(bf16x8, pw), vf[ks], o[0], 0, 0, 0);
            o[1] = __builtin_amdgcn_mfma_f32_32x32x16_bf16(__builtin_bit_cast(bf16x8, pw), vf[4 + ks], o[1], 0, 0, 0); }
    }
    if (grp == 0) MLA_BAR_L();
    { auto rr = __builtin_amdgcn_permlane32_swap(__float_as_uint(l), __float_as_uint(l), false, false); l = __uint_as_float(rr[0]) + __uint_as_float(rr[1]); }
    if (hi == 0) wsf[32 + r32] = l;
    float rli[16];
#pragma unroll
    for (int r = 0; r < 16; ++r) rli[r] = fast_rcp(wsf[32 + crow(r, hi)]);
    store_o(o, rli, shm + L_OST + wid * 4096, O + (size_t)(rowbase + q0 + wid * 32) * 512 + h * 64, 512, lane, r32, hi);
    MLA_BAR_L();
}
template <int ABL> __device__ __forceinline__ void phase(int vcu, int G, const bf16_t* Q, const bf16_t* KT, const bf16_t* VT, bf16_t* O, LAS unsigned char* shm, int wv) {
    for (int v = vcu; v < 256; v += G) { const int bh = v >> 4, s = v & 15;
        unit<ABL>(bh >> 3, bh & 7, 31 - s, Q, KT, VT, O, shm, wv);
        unit<ABL>(bh >> 3, bh & 7, s, Q, KT, VT, O, shm, wv); }
}
}

namespace sba {
constexpr int KSLOT = 8192, VSLOT = 8192, NS = 3;
constexpr int L_K = 0, L_V = NS * KSLOT, L_WS = L_V + NS * VSLOT, L_FLAG = L_WS + 2048, L_OST = L_FLAG + 256, L_END = L_OST + 8 * 4096;
constexpr float SB_EXIT = 1.0e-42f;
__device__ __forceinline__ void unit(int b, int kh, int qb64, const bf16_t* Q, const bf16_t* KT, const bf16_t* VT, bf16_t* O, LAS unsigned char* shm, int wv) {
    int tid_ = wv * 64 + lane_id(); asm volatile("" : "+v"(tid_));
    const int tid = tid_, lane = tid & 63, r32 = lane & 31, hi = lane >> 5; const int wid = __builtin_amdgcn_readfirstlane(tid >> 6);
    const int h = kh * 4 + (wid >> 1), half = wid & 1;
    const long rowbase = (long)b * SEQL; const int q0 = qb64 * 64;
    const bf16_t* Qw = Q + (size_t)(rowbase + q0 + half * 32) * 1024 + h * 64;
    const bf16_t* Kh = KT + (size_t)((b * 4 + kh) * 128) * 4096 + wid * 512 + lane * 8;
    const bf16_t* Vh = VT + (size_t)((b * 4 + kh) * 128) * 4096 + wid * 512 + lane * 8;
    const unsigned lds0 = (unsigned)(uintptr_t)shm;
    LAS int* flags = (LAS int*)(shm + L_FLAG);
    const int NT = qb64 + 1;
#define SBA_DMA(k, sl) do { const int tile_ = qb64 - (k); \
        glds16(Kh + (size_t)tile_ * 4096, (unsigned)__builtin_amdgcn_readfirstlane(lds0 + L_K + (sl) * KSLOT + wid * 1024)); \
        glds16(Vh + (size_t)tile_ * 4096, (unsigned)__builtin_amdgcn_readfirstlane(lds0 + L_V + (sl) * VSLOT + wid * 1024)); } while (0)
    SBA_DMA(0, 0); if (NT > 1) SBA_DMA(1, 1);
    bf16x8 qr[4];
#pragma unroll
    for (int d0 = 0; d0 < 4; ++d0) qr[d0] = *(const bf16x8*)(Qw + (size_t)r32 * 1024 + d0 * 16 + hi * 8);
    float R = 1.f; f32x16 o[2];
#pragma unroll
    for (int r = 0; r < 16; ++r) { o[0][r] = 0.f; o[1][r] = 0.f; }
    const int qrel = half * 32 + r32;
    int slot = 0;
    for (int k = 0; k < NT; ++k) {
        if (k + 1 < NT) ATT_WAIT_BAR(2); else ATT_WAIT_BAR(0);
        if (k > 0) { const LAS int* f = flags + ((k - 1) & 1) * 8; int all = 1;
#pragma unroll
            for (int w = 0; w < 8; ++w) all &= f[w];
            if (all) break; }
        if (k + 2 < NT) { const int s2 = slot == 0 ? 2 : slot - 1; SBA_DMA(k + 2, s2); }
        {
            const lcp kb = (lcp)shm + L_K + slot * KSLOT + hi * 1024 + r32 * 16;
            f32x16 p0, p1;
#pragma unroll
            for (int r = 0; r < 16; ++r) { p0[r] = 0.f; p1[r] = 0.f; }
#pragma unroll
            for (int d0 = 0; d0 < 4; ++d0) { const bf16x8 b0 = *(const LAS bf16x8*)(kb + d0 * 2048), b1 = *(const LAS bf16x8*)(kb + d0 * 2048 + 512);
                p0 = __builtin_amdgcn_mfma_f32_32x32x16_bf16(b0, qr[d0], p0, 0, 0, 0); p1 = __builtin_amdgcn_mfma_f32_32x32x16_bf16(b1, qr[d0], p1, 0, 0, 0); }
            f32x16 N0, N1;
#pragma unroll
            for (int r = 0; r < 16; ++r) {
                const float e0 = fast_exp2(-__builtin_amdgcn_fmed3f(p0[r], -100.f, 100.f)), e1 = fast_exp2(-__builtin_amdgcn_fmed3f(p1[r], -100.f, 100.f));
                float b0 = fast_rcp(1.0f + e0), b1 = fast_rcp(1.0f + e1); float n0 = e0 * b0, n1 = e1 * b1;
                if (k == 0) { const int kv = crow(r, hi); if (kv >= qrel) { b0 = 0.f; n0 = 1.f; } if (kv + 32 >= qrel) { b1 = 0.f; n1 = 1.f; } }
                p0[r] = b0; p1[r] = b1; N0[r] = n0; N1[r] = n1; }
            float G[16];
#pragma unroll
            for (int j = 0; j < 8; ++j) { const f32x16& NN = j < 4 ? N0 : N1; const int rb = 4 * (j & 3);
                const float gp = (NN[rb] * NN[rb + 1]) * (NN[rb + 2] * NN[rb + 3]);
                auto rr = __builtin_amdgcn_permlane32_swap(__float_as_uint(gp), __float_as_uint(gp), false, false);
                G[2 * j] = __uint_as_float(rr[0]); G[2 * j + 1] = __uint_as_float(rr[1]); }
            float SG[16]; SG[15] = 1.f;
#pragma unroll
            for (int g = 14; g >= 0; --g) SG[g] = SG[g + 1] * G[g + 1];
            const float T = SG[0] * G[0];
#pragma unroll
            for (int j = 0; j < 8; ++j) { f32x16& NN = j < 4 ? N0 : N1; f32x16& PP = j < 4 ? p0 : p1; const int rb = 4 * (j & 3);
                const float base = (R * SG[2 * j + 1]) * (hi ? 1.f : G[2 * j + 1]);
                const float r3 = base, r2 = r3 * NN[rb + 3], r1 = r2 * NN[rb + 2], r0 = r1 * NN[rb + 1];
                PP[rb + 3] *= r3; PP[rb + 2] *= r2; PP[rb + 1] *= r1; PP[rb] *= r0; }
            R *= T;
            const u32x4 pw0 = {pk_bf16(p0[0], p0[1]), pk_bf16(p0[2], p0[3]), pk_bf16(p0[4], p0[5]), pk_bf16(p0[6], p0[7])};
            const u32x4 pw1 = {pk_bf16(p0[8], p0[9]), pk_bf16(p0[10], p0[11]), pk_bf16(p0[12], p0[13]), pk_bf16(p0[14], p0[15])};
            const u32x4 pw2 = {pk_bf16(p1[0], p1[1]), pk_bf16(p1[2], p1[3]), pk_bf16(p1[4], p1[5]), pk_bf16(p1[6], p1[7])};
            const u32x4 pw3 = {pk_bf16(p1[8], p1[9]), pk_bf16(p1[10], p1[11]), pk_bf16(p1[12], p1[13]), pk_bf16(p1[14], p1[15])};
            const lcp vp = (lcp)shm + L_V + slot * VSLOT + ((lane >> 4) & 1) * 32 + (lane & 3) * 8 + (4 * hi + ((lane & 15) >> 2)) * 64;
            pv(o, vp, pw0, pw1, pw2, pw3);
            const int dn = __all(R < SB_EXIT) ? 1 : 0;
            if (lane == 0) flags[(k & 1) * 8 + wid] = dn;
        }
        slot = slot == 2 ? 0 : slot + 1;
    }
#undef SBA_DMA
    ATT_WAIT_BAR(0);
    float one[16];
#pragma unroll
    for (int r = 0; r < 16; ++r) one[r] = 1.0f;
    store_o(o, one, shm + L_OST + wid * 4096, O + (size_t)(rowbase + q0 + half * 32) * 1024 + h * 64, 1024, lane, r32, hi);
    asm volatile("s_waitcnt lgkmcnt(0)\n\ts_barrier" ::: "memory");
}
__device__ __forceinline__ void phase(int vcu, int G, const bf16_t* Q, const bf16_t* KT, const bf16_t* VT, bf16_t* O, LAS unsigned char* shm, int wv) {
    for (int u = vcu * 4; u < 1024; u += G * 4)
        for (int i = 0; i < 4; ++i) { const int uu = u + i, qb64 = uu & 127, bk = uu >> 7; unit(bk >> 2, bk & 3, qb64, Q, KT, VT, O, shm, wv); }
}
}
}
namespace fw {
constexpr size_t MiB = 1u << 20;
constexpr int NWAVES = 8, NTHR = 512;
constexpr int MAXSLOT = 34816;
constexpr size_t WS_CTL = 0, CTL_ZERO_BYTES = 64 * 1024;
constexpr size_t WS_TOKE = 1 * MiB;
constexpr size_t WS_TOKG = WS_TOKE + 64 * 1024;
constexpr size_t WS_TOKRS = WS_TOKG + 128 * 1024;
constexpr size_t WS_SLOT12 = WS_TOKRS + 64 * 1024;
constexpr size_t WS_SLOTG = WS_SLOT12 + 128 * 1024;
constexpr size_t WS_SLOTRS = WS_SLOTG + 256 * 1024;
constexpr size_t WS_CNT = WS_SLOTRS + 256 * 1024;
constexpr size_t WS_PSTART = WS_CNT + 16 * 1024;
constexpr size_t WS_CS = 4 * MiB;
constexpr size_t WS_SSQ = 6 * MiB;
constexpr size_t WS_SSQQ = 8 * MiB;
constexpr size_t WS_SSQKV = WS_SSQQ + 512 * 1024;
constexpr size_t WS_KPE = 9 * MiB;
constexpr size_t WS_SSPE = 11 * MiB;
constexpr size_t WS_W = 16 * MiB;
constexpr size_t W_AIN = WS_W, W_QUP = W_AIN + 3 * MiB, W_KVUP = W_QUP + 2 * MiB, W_AOUT = W_KVUP + 1 * MiB, W_KVS = W_AOUT + 2 * MiB, W_QB = W_KVS + 1 * MiB,
                 W_OB = W_QB + 4 * MiB, W_PG = W_OB + 4 * MiB, W_PU = W_PG + 8 * MiB, W_FGU = W_PU + 2 * MiB, W_FDN = W_FGU + 22 * MiB, W_EGU = W_FDN + 11 * MiB,
                 W_EDN = W_EGU + 176 * MiB, W_END = W_EDN + 88 * MiB;
constexpr size_t WS_PB = W_END;
constexpr size_t WS_HB = WS_PB + 32 * MiB;
constexpr size_t WS_U = WS_HB + 64 * MiB;
constexpr size_t WS_SKT = WS_U + 128 * MiB, WS_SVT = WS_SKT + 8 * MiB;
constexpr size_t WS_X = WS_SVT + 8 * MiB;
constexpr size_t X_AQ = WS_X, X_AKV = X_AQ + 12 * MiB, X_QRAW = X_AKV + 8 * MiB, X_KVRAW = X_QRAW + 24 * MiB, X_Q = X_KVRAW + 32 * MiB, X_KT = X_Q + 24 * MiB, X_VT = X_KT + 24 * MiB, X_O = X_VT + 16 * MiB;
constexpr size_t X_SQ = WS_X, X_SO = X_SQ + 32 * MiB;
constexpr size_t X_HID = WS_X;
constexpr size_t X_XG = WS_X, X_HG = X_XG + 68 * MiB, X_YG = X_HG + 187 * MiB, X_END = X_YG + 68 * MiB;
constexpr size_t WS_END = X_END;
static_assert(X_O + 16 * MiB <= X_END && (size_t)MAXSLOT * 2816 * 2 <= 187 * MiB && (size_t)MAXSLOT * 1024 * 2 <= 68 * MiB, "ws map");
constexpr int CW_BAR = 1024;
constexpr int RING_OFF = 0, RING_BYTES = 131072, LDSCTL_OFF = RING_BYTES, MISC_OFF = LDSCTL_OFF + 320, XS_OFF = LDSCTL_OFF + 1024  , LDS_BYTES = 147456;
static_assert(att::mla::L_END <= RING_BYTES && att::sba::L_END <= RING_BYTES, "attention LDS");
constexpr float QSCALE_MLA = 0.10206207261596577f * LOG2E;
constexpr float QSCALE_SB = 0.125f * LOG2E;

struct EpiQ {
    static constexpr bool PERM = true, AFTER_DRAIN = false;
    unsigned char* ws; const float* gq;
    __device__ __forceinline__ void operator()(const f32x4 (&acc)[2][2][4][2], const pg8::Unit& u, int wr, int wc, int fr_, int fq_) const {
        const int ln_ = lane_id(), fr = ln_ & 15, fq = ln_ >> 4; (void)fr_; (void)fq_;
        const int row0 = u.pm * pg8::BM + wr * 64 + fr, c = wc * 32 + 8 * fq;
        LAS float* xs = (LAS float*)(uintptr_t)XS_OFF;
        bf16_t* Q = (bf16_t*)(ws + X_Q); const float* CS = (const float*)(ws + WS_CS); const pg8::RowScale rs{(const float*)(ws + WS_SSQQ), 3}; const float qscale = QSCALE_MLA;
        float rsv[2][4]; rs.get8(rsv, row0, fq);
#pragma unroll
        for (int ai = 0; ai < 2; ++ai)
#pragma unroll
            for (int m = 0; m < 4; ++m) { const int rl = ai * pg8::HALF + wr * 64 + m * 16 + fr; const float s = rsv[ai][m];
#pragma unroll
                for (int bj = 0; bj < 2; ++bj) { const float q = pg8::red_fq(pg8::sumsq8(acc[ai][bj][m][0], acc[ai][bj][m][1])) * (s * s); if (fq == 0) xs[(rl * 2 + bj) * 4 + wc] = q; }
                asm volatile("" ::: "memory"); }
        asm volatile("s_waitcnt lgkmcnt(0)" ::: "memory"); __builtin_amdgcn_s_barrier(); asm volatile("" ::: "memory");
        const int cg = wc < 3 ? c : 0;
#pragma unroll
        for (int ai = 0; ai < 2; ++ai)
#pragma unroll
            for (int m = 0; m < 4; ++m) { const int rl = ai * pg8::HALF + wr * 64 + m * 16 + fr, row = row0 + ai * pg8::HALF + m * 16;
                const f32x4 g0 = *(const f32x4*)(gq + cg), g1 = *(const f32x4*)(gq + cg + 4);
#pragma unroll
                for (int bj = 0; bj < 2; ++bj) { const f32x4 p4 = *(const LAS f32x4*)(xs + (rl * 2 + bj) * 4);
                    const float ss = (p4[0] + p4[1]) + (p4[2] + p4[3]); const float sc = rsv[ai][m] * (1.0f / sqrtf(ss * (1.0f / 96.0f) + RMS_EPS)) * qscale;
                    f32x4 v0 = acc[ai][bj][m][0] * g0 * sc, v1 = acc[ai][bj][m][1] * g1 * sc;
                    if (wc == 2) pg8::rope8(v0, v1, CS + (size_t)row * 32, fq);
                    if (wc < 3) *(u32x4*)(Q + (size_t)row * 768 + (2 * u.pn + bj) * 96 + c) = pack8(v0, v1); }
                asm volatile("" ::: "memory"); }
    }
};
struct EpiKV {
    static constexpr bool PERM = true, AFTER_DRAIN = false;
    unsigned char* ws; const float* gk;
    __device__ __forceinline__ void operator()(const f32x4 (&acc)[2][2][4][2], const pg8::Unit& u, int wr, int wc, int fr_, int fq_) const {
        const int ln_ = lane_id(), fr = ln_ & 15, fq = ln_ >> 4; (void)fr_; (void)fq_;
        const int row0 = u.pm * pg8::BM + wr * 64 + fr, c = (wc & 1) * 32 + 8 * fq;
        LAS float* xs = (LAS float*)(uintptr_t)XS_OFF;
        bf16_t* KT = (bf16_t*)(ws + X_KT); bf16_t* VT = (bf16_t*)(ws + X_VT); const float* KPE = (const float*)(ws + WS_KPE); const float* SSPE = (const float*)(ws + WS_SSPE); const pg8::RowScale rs{(const float*)(ws + WS_SSQKV), 4};
        float rsv[2][4]; rs.get8(rsv, row0, fq);
#pragma unroll
        for (int ai = 0; ai < 2; ++ai)
#pragma unroll
            for (int m = 0; m < 4; ++m) { const int rl = ai * pg8::HALF + wr * 64 + m * 16 + fr; const float s = rsv[ai][m];
#pragma unroll
                for (int bj = 0; bj < 2; ++bj) { const float q = pg8::red_fq(pg8::sumsq8(acc[ai][bj][m][0], acc[ai][bj][m][1])) * (s * s); if (fq == 0 && wc < 2) xs[(rl * 2 + bj) * 2 + wc] = q; }
                asm volatile("" ::: "memory"); }
        asm volatile("s_waitcnt lgkmcnt(0)" ::: "memory"); __builtin_amdgcn_s_barrier(); asm volatile("" ::: "memory");
#pragma unroll
        for (int ai = 0; ai < 2; ++ai)
#pragma unroll
            for (int m = 0; m < 4; ++m) { const int rl = ai * pg8::HALF + wr * 64 + m * 16 + fr, row = row0 + ai * pg8::HALF + m * 16; const float s = rsv[ai][m];
                const f32x4 g0 = *(const f32x4*)(gk + c), g1 = *(const f32x4*)(gk + c + 4);
                const int b = row >> 13, sq = row & 8191, tile = sq >> 6, rr = sq & 63;
                const f32x4 k0 = *(const f32x4*)(KPE + (size_t)row * 32 + 8 * fq), k1 = *(const f32x4*)(KPE + (size_t)row * 32 + 8 * fq + 4);
                const float sspe = SSPE[row];
#pragma unroll
                for (int bj = 0; bj < 2; ++bj) { const int h = 2 * u.pn + bj; const size_t tb = (size_t)((b * 8 + h) * 128 + tile);
                    const float ssn = xs[(rl * 2 + bj) * 2] + xs[(rl * 2 + bj) * 2 + 1];
                    const float rk = 1.0f / sqrtf((ssn + sspe) * (1.0f / 96.0f) + RMS_EPS);
                    if (wc < 2) *(u32x4*)(KT + tb * 6144 + (c >> 3) * 512 + rr * 8) = pack8(acc[ai][bj][m][0] * g0 * (s * rk), acc[ai][bj][m][1] * g1 * (s * rk));
                    else *(u32x4*)(VT + tb * 4096 + (wc - 2) * 2048 + rr * 32 + 8 * fq) = pack8(acc[ai][bj][m][0] * s, acc[ai][bj][m][1] * s);
                    if (wc == 2) *(u32x4*)(KT + tb * 6144 + (8 + fq) * 512 + rr * 8) = pack8(k0 * rk, k1 * rk); }
                asm volatile("" ::: "memory"); }
    }
};
constexpr int PH_PER_LAYER = 12, PH_TOTAL = 2 + 4 * PH_PER_LAYER;
__host__ __device__ inline bool phase_active(int idx) {
    if (idx < 2) return true;
    const int l = (idx - 2) / PH_PER_LAYER, s = (idx - 2) % PH_PER_LAYER; const bool mla = l < 2, moe = (l & 1) != 0;
    if (s == 1) return mla;
    if (s == 2) return false;
    if (s >= 7 && s <= 9) return moe;
    if (s == 11) return l == 1;
    return true;
}

struct Args { const float* in[26]; float* out; unsigned char* ws; int ph_lo, ph_hi; };

struct Frame { LAS unsigned char* lds; int tid, lane, wave, vcu, G; };

__device__ __forceinline__ float shx(float v, int k, int lane) { return __uint_as_float((unsigned)__builtin_amdgcn_ds_bpermute((lane ^ k) << 2, (int)__float_as_uint(v))); }
__device__ __forceinline__ int shi(int v, int src, int lane) { (void)lane; return __builtin_amdgcn_ds_bpermute(src << 2, v); }
__device__ __forceinline__ float wave_sum(float v, int lane) {
#pragma unroll
    for (int o = 1; o < 64; o <<= 1) v += shx(v, o, lane);
    return v;
}
template <bool NT> __device__ __forceinline__ void transpose_item(const float* W, int ldw, int sca, int scb, const float* gain, bf16_t* WT, int K, int drow0, int k0, LAS float* scr, int lane) {
    const int r8 = lane >> 3, pc = lane & 7, c = lane & 7;
    f32x4 va[8], vb[8]; float g[8];
    const f32x4 z4 = {0.f, 0.f, 0.f, 0.f};
#pragma unroll
    for (int i = 0; i < 8; ++i) { const float* rp = W + (size_t)(k0 + i * 8 + r8) * ldw + 4 * pc;
        if (NT) { va[i] = sca >= 0 ? __builtin_nontemporal_load((const f32x4*)(rp + sca)) : z4; vb[i] = scb >= 0 ? __builtin_nontemporal_load((const f32x4*)(rp + scb)) : z4; }
        else { va[i] = sca >= 0 ? *(const f32x4*)(rp + sca) : z4; vb[i] = scb >= 0 ? *(const f32x4*)(rp + scb) : z4; }
        g[i] = gain ? gain[k0 + i * 8 + r8] : 1.0f; }
#pragma unroll
    for (int hf = 0; hf < 2; ++hf) {
#pragma unroll
        for (int i = 0; i < 8; ++i) { const f32x4 v = (hf == 0 ? va[i] : vb[i]) * g[i]; LAS float* d = scr + (i * 8 + r8) * 33 + 4 * pc; d[0] = v[0]; d[1] = v[1]; d[2] = v[2]; d[3] = v[3]; }
        asm volatile("s_waitcnt lgkmcnt(0)" ::: "memory");
#pragma unroll
        for (int j = 0; j < 4; ++j) { const int n = (lane >> 3) + 8 * j; const LAS float* s = scr + (8 * c) * 33 + n;
            u32x4 o; o.x = pk_bf16(s[0 * 33], s[1 * 33]); o.y = pk_bf16(s[2 * 33], s[3 * 33]); o.z = pk_bf16(s[4 * 33], s[5 * 33]); o.w = pk_bf16(s[6 * 33], s[7 * 33]);
            if (NT) __builtin_nontemporal_store(o, (u32x4*)(WT + (size_t)(drow0 + hf * 32 + n) * K + k0 + 8 * c)); else *(u32x4*)(WT + (size_t)(drow0 + hf * 32 + n) * K + k0 + 8 * c) = o; }
        asm volatile("s_waitcnt lgkmcnt(0)" ::: "memory");
    }
}
struct Fam { int src, count, K, Nd, ldw, map, gain, gstride; size_t sstride, dst, dstride; };
__device__ __forceinline__ int fam_items(const Fam& f) { return f.count * (f.K / 64) * (f.Nd / 64); }
__device__ __forceinline__ int fam_src_col(int map, int n0) {
    if (map == 1) return n0 < 384 ? n0 : (n0 < 416 ? 640 + (n0 - 384) : (n0 < 512 ? -1 : 384 + (n0 - 512)));
    if (map == 2) { const int pn = n0 >> 8, jj = n0 & 255; return jj < 128 ? pn * 128 + jj : 2816 + pn * 128 + (jj - 128); }
    if (map == 3) { const int h = n0 >> 7, off = n0 & 127; return off < 96 ? 96 * h + off : -1; }
    return n0;
}
template <bool NT = false> __device__ __forceinline__ void fam_item(const Args& a, const Fam& f, int fid, int it, LAS float* scr, int lane, int mi_off = 0) {
    const int per = (f.K / 64) * (f.Nd / 64), mi = it / per + mi_off, r = it % per, nblk = f.Nd / 64, kb = r / nblk, nb = r % nblk, n0 = nb * 64;
    const float* gain = nullptr;
    if (f.gain >= 0) gain = a.in[f.gain] + (fid == 11 ? (size_t)(2 * (mi >> 3) + 1) * 1024 : (size_t)mi * f.gstride);
    transpose_item<NT>(a.in[f.src] + (size_t)mi * f.sstride, f.ldw, fam_src_col(f.map, n0), fam_src_col(f.map, n0 + 32), gain, (bf16_t*)(a.ws + f.dst + (size_t)mi * f.dstride), f.K, n0, kb * 64, scr, lane);
}
__constant__ const Fam FAMS[13] = {
        {4, 2, 1024, 768, 672, 1, 3, 1024, (size_t)1024 * 672, W_AIN, (size_t)768 * 1024 * 2},
        {7, 2, 384, 1024, 768, 3, 5, 384, (size_t)384 * 768, W_QUP, (size_t)1024 * 384 * 2},
        {8, 2, 256, 1024, 1024, 0, 6, 256, (size_t)256 * 1024, W_KVUP, (size_t)1024 * 256 * 2},
        {11, 2, 512, 1024, 1024, 0, -1, 0, (size_t)512 * 1024, W_AOUT, (size_t)1024 * 512 * 2},
        {13, 1, 1024, 512, 512, 0, 12, 0, 0, W_KVS, 0},
        {15, 2, 1024, 1024, 1024, 0, 14, 1024, (size_t)1024 * 1024, W_QB, (size_t)1024 * 1024 * 2},
        {16, 2, 1024, 1024, 1024, 0, -1, 0, (size_t)1024 * 1024, W_OB, (size_t)1024 * 1024 * 2},
        {24, 4, 1024, 1024, 1024, 0, 23, 1024, (size_t)1024 * 1024, W_PG, (size_t)1024 * 1024 * 2},
        {25, 4, 256, 1024, 1024, 0, -1, 0, (size_t)256 * 1024, W_PU, (size_t)1024 * 256 * 2},
        {18, 1, 1024, 5632, 5632, 2, 17, 2048, (size_t)1024 * 5632, W_FGU, (size_t)5632 * 1024 * 2},
        {19, 1, 2816, 1024, 1024, 0, -1, 0, (size_t)2816 * 1024, W_FDN, (size_t)1024 * 2816 * 2},
        {21, 8, 1024, 5632, 5632, 2, 17, 0, (size_t)1024 * 5632, W_EGU, (size_t)5632 * 1024 * 2},
        {22, 8, 2816, 1024, 1024, 0, -1, 0, (size_t)2816 * 1024, W_EDN, (size_t)1024 * 2816 * 2}};
constexpr int DEF_N0 = 1408, DEF_N1 = DEF_N0 + 704, DEF_N2 = DEF_N1 + 11264, DEF_N3 = DEF_N2 + 5632;
#ifndef FILL_A
#define FILL_A 0
#define FILL_B 0
#define FILL_C 0
#define FILL_D 0
#endif
constexpr int DEF_QA = FILL_A, DEF_QB = DEF_QA + FILL_B, DEF_QC = DEF_QB + FILL_C, DEF_QD = DEF_QC + FILL_D;
constexpr int CW_FILL = 512;
__device__ __forceinline__ void prologue(const Args& a, Frame& F) {
    LAS float* scr = (LAS float*)(F.lds + RING_OFF + F.wave * 16384);
    const int gw = F.vcu * NWAVES + F.wave, NGW = F.G * NWAVES;
    int base = 0;
#pragma unroll 1
    for (int fid = 0; fid < 13; ++fid) { const Fam f = FAMS[fid]; const int n = fam_items(f);
        int it = gw - (base % NGW); if (it < 0) it += NGW;
#pragma unroll 1
        for (; it < n; it += NGW) fam_item(a, f, fid, it, scr, F.lane);
        base += n; }
    for (int id = DEF_QD + gw; id < DEF_N3; id += NGW) {
        if (id < DEF_N0) fam_item(a, FAMS[9], 9, id, scr, F.lane, 1);
        else if (id < DEF_N1) fam_item(a, FAMS[10], 10, id - DEF_N0, scr, F.lane, 1);
        else if (id < DEF_N2) fam_item(a, FAMS[11], 11, id - DEF_N1, scr, F.lane, 8);
        else fam_item(a, FAMS[12], 12, id - DEF_N2, scr, F.lane, 8);
    }
    { const f32x4* src = (const f32x4*)a.in[1]; u32x2* dst = (u32x2*)(a.ws + WS_PB); const size_t n4 = (size_t)4 * MT * 256 / 4, S = (size_t)NGW * 64;
        for (size_t i = (size_t)gw * 64 + F.lane; i < n4; i += 4 * S) { f32x4 v[4];
#pragma unroll
            for (int q = 0; q < 4; ++q) v[q] = (i + q * S < n4) ? src[i + q * S] : (f32x4){0.f, 0.f, 0.f, 0.f};
#pragma unroll
            for (int q = 0; q < 4; ++q) if (i + q * S < n4) { u32x2 o; o.x = pk_bf16(v[q][0], v[q][1]); o.y = pk_bf16(v[q][2], v[q][3]); dst[i + q * S] = o; } } }
    { bf16_t* HB = (bf16_t*)(a.ws + WS_HB); float* SSQ = (float*)(a.ws + WS_SSQ);
        for (int row = gw; row < MT; row += NGW) { const f32x4* xr = (const f32x4*)(a.in[0] + (size_t)row * DMODEL) + F.lane;
            u32x2* hb = (u32x2*)(HB + (size_t)row * DMODEL) + F.lane; float s = 0.f; f32x4 v4[4];
#pragma unroll
            for (int j = 0; j < 4; ++j) v4[j] = xr[64 * j];
#pragma unroll
            for (int j = 0; j < 4; ++j) { const f32x4 v = v4[j]; u32x2 o; o.x = pk_bf16(v[0], v[1]); o.y = pk_bf16(v[2], v[3]); hb[64 * j] = o; s += (v[0] * v[0] + v[1] * v[1]) + (v[2] * v[2] + v[3] * v[3]); }
            s = wave_sum(s, F.lane); if (F.lane < 16) SSQ[(size_t)row * 16 + F.lane] = F.lane == 0 ? s : 0.f; } }
    { float* cs = (float*)(a.ws + WS_CS); const int* pos = (const int*)a.in[2];
        for (int i = gw * 64 + F.lane; i < MT * 16; i += NGW * 64) { const int row = i >> 4, f = i & 15;
            const float invf = (float)exp(-9.210340371976184 * (double)f / 16.0);
            const double ang = (double)((float)pos[row] * invf);
            const double rev = ang * 0.15915494309189535, fr = rev - rint(rev); const float x = (float)(fr * 6.283185307179586);
            cs[(size_t)row * 32 + f] = cosf(x); cs[(size_t)row * 32 + 16 + f] = sinf(x); } }
}
#define THIN_LAUNDER() Frame F = F_; unsigned char* wsl = a.ws; F.lane = lane_id(); F.tid = F.wave * 64 + F.lane; asm volatile("" : "+v"(F.tid), "+v"(F.lane), "+s"(F.vcu), "+s"(F.G), "+s"(wsl))
__device__ __forceinline__ void filler(const Args& a, const Frame& F_, int qi, int start, int end) {
    Frame F = F_; { int t_ = F_.wave * 64 + lane_id(); asm volatile("" : "+v"(t_)); F.tid = t_; F.lane = t_ & 63; }
    unsigned char* wsl = a.ws; asm volatile("" : "+s"(wsl));
    LAS float* scr = (LAS float*)(F.lds + RING_OFF + F.wave * 16384);
    unsigned* ctr = (unsigned*)(wsl + WS_CTL) + CW_FILL + qi;
    for (;;) {
        int id = 0; if (F.lane == 0) id = (int)__hip_atomic_fetch_add(ctr, 1u, __ATOMIC_RELAXED, __HIP_MEMORY_SCOPE_AGENT) + start;
        id = __builtin_amdgcn_readfirstlane(id);
        if (id >= end) break;
        if (id < DEF_N0) fam_item<true>(a, FAMS[9], 9, id, scr, F.lane, 1);
        else if (id < DEF_N1) fam_item<true>(a, FAMS[10], 10, id - DEF_N0, scr, F.lane, 1);
        else if (id < DEF_N2) fam_item<true>(a, FAMS[11], 11, id - DEF_N1, scr, F.lane, 8);
        else fam_item<true>(a, FAMS[12], 12, id - DEF_N2, scr, F.lane, 8);
    }
}
__device__ __forceinline__ void moe_route(const Args& a, const Frame& F_, int layer, int cur) { THIN_LAUNDER();
    const bf16_t* HB = (const bf16_t*)(wsl + WS_HB) + (size_t)cur * MT * DMODEL; const float* gain = a.in[17] + (size_t)layer * 1024; const float* wr = a.in[20] + (size_t)(layer >> 1) * 1024 * 8;
    int* TOKE = (int*)(wsl + WS_TOKE); float* TOKG = (float*)(wsl + WS_TOKG); float* TOKRS = (float*)(wsl + WS_TOKRS); int* CNT = (int*)(wsl + WS_CNT);
    constexpr int LDW = 1032;
    LAS bf16_t* WB = (LAS bf16_t*)(F.lds + RING_OFF);
    LAS int* lcnt = (LAS int*)(F.lds + RING_OFF + 36864);
    LAS float* LG = (LAS float*)(F.lds + RING_OFF + 37888) + F.wave * 128;
    for (int i = F.tid; i < 1024 * 8; i += NTHR) { const int k = i >> 3, e = i & 7; const float x = wr[i] * gain[k];
        const unsigned hi = pk_bf16(x, 0.f) & 0xffffu; const float lo = x - __uint_as_float(hi << 16);
        WB[e * LDW + k] = (bf16_t)hi; WB[(8 + e) * LDW + k] = (bf16_t)(pk_bf16(lo, 0.f) & 0xffffu); }
    const int n = F.lane & 15, q = F.lane >> 4;
    for (int chunk = F.vcu; chunk < MT / 64; chunk += F.G) {
        if (F.tid < 8) lcnt[F.tid] = 0;
        __syncthreads();
        if (F.wave < 4) {
            const int tok0 = chunk * 64 + F.wave * 16;
            const bf16_t* arow = HB + (size_t)(tok0 + n) * DMODEL + 8 * q; const LAS bf16_t* brow = WB + n * LDW + 8 * q;
            f32x4 acc = {0.f, 0.f, 0.f, 0.f}; float ss = 0.f;
#pragma unroll 8
            for (int s = 0; s < 32; ++s) { const u32x4 av = *(const u32x4*)(arow + 32 * s); const bf16x8 bv = *(const LAS bf16x8*)(brow + 32 * s);
                acc = __builtin_amdgcn_mfma_f32_16x16x32_bf16(__builtin_bit_cast(bf16x8, av), bv, acc, 0, 0, 0);
                f32x4 x0, x1; unpack8(av, x0, x1); ss += pg8::sumsq8(x0, x1); }
            ss = pg8::red_fq(ss);
#pragma unroll
            for (int i = 0; i < 4; ++i) { const float v = acc[i] + shx(acc[i], 8, F.lane); if (n < 8) LG[(4 * q + i) * 8 + n] = v; }
            asm volatile("s_waitcnt lgkmcnt(0)" ::: "memory");
            if (F.lane < 16) { const int tok = tok0 + F.lane; const LAS f32x4* lp = (const LAS f32x4*)(LG + F.lane * 8); const f32x4 l0 = lp[0], l1 = lp[1];
                const float lg[8] = {l0[0], l0[1], l0[2], l0[3], l1[0], l1[1], l1[2], l1[3]};
                const float r = 1.0f / sqrtf(ss * (1.0f / 1024.0f) + RMS_EPS);
                int e1 = 0; float v1 = lg[0];
#pragma unroll
                for (int e = 1; e < 8; ++e) if (lg[e] > v1) { v1 = lg[e]; e1 = e; }
                int e2 = 0; float v2 = -3.0e38f;
#pragma unroll
                for (int e = 0; e < 8; ++e) if (e != e1 && lg[e] > v2) { v2 = lg[e]; e2 = e; }
                const float p2 = __expf((v2 - v1) * r), g1 = 1.0f / (1.0f + p2), g2 = p2 / (1.0f + p2);
                TOKE[tok] = e1 | (e2 << 8); TOKG[tok * 2] = g1; TOKG[tok * 2 + 1] = g2; TOKRS[tok] = r;
                __hip_atomic_fetch_add(lcnt + e1, 1, __ATOMIC_RELAXED, __HIP_MEMORY_SCOPE_WORKGROUP); __hip_atomic_fetch_add(lcnt + e2, 1, __ATOMIC_RELAXED, __HIP_MEMORY_SCOPE_WORKGROUP); }
        }
        __syncthreads();
        if (F.tid < 8) CNT[chunk * 8 + F.tid] = lcnt[F.tid];
        __syncthreads();
    }
}
__device__ __forceinline__ void moe_scatter(const Args& a, const Frame& F_, int cur) { THIN_LAUNDER();
    const int* TOKE = (const int*)(wsl + WS_TOKE); const float* TOKG = (const float*)(wsl + WS_TOKG); const float* TOKRS = (const float*)(wsl + WS_TOKRS); const int* CNT = (const int*)(wsl + WS_CNT);
    int* SLOT12 = (int*)(wsl + WS_SLOT12); float* SLOTG = (float*)(wsl + WS_SLOTG); float* SLOTRS = (float*)(wsl + WS_SLOTRS); int* PSTART = (int*)(wsl + WS_PSTART);
    const bf16_t* HB = (const bf16_t*)(wsl + WS_HB) + (size_t)cur * MT * DMODEL; bf16_t* XG = (bf16_t*)(wsl + X_XG);
    LAS int* sm = (LAS int*)(F.lds + RING_OFF);
    for (int chunk = F.vcu; chunk < MT / 64; chunk += F.G) {
        { const int e = F.wave; int c4[4]; int s = 0;
#pragma unroll
            for (int i = 0; i < 4; ++i) { c4[i] = CNT[(4 * F.lane + i) * 8 + e]; s += c4[i]; }
            int inc = s;
#pragma unroll
            for (int o = 1; o < 64; o <<= 1) { const int t = shi(inc, F.lane >= o ? F.lane - o : F.lane, F.lane); if (F.lane >= o) inc += t; }
            const int total = shi(inc, 63, F.lane); int pre = inc - s;
            if (F.lane == (chunk >> 2)) { const int cm = chunk & 3; pre += (cm > 0 ? c4[0] : 0) + (cm > 1 ? c4[1] : 0) + (cm > 2 ? c4[2] : 0); sm[8 + e] = pre; }
            if (F.lane == 0) sm[e] = total; }
        __syncthreads();
        if (F.tid == 0) { int p = 0; for (int e = 0; e < 8; ++e) { sm[16 + e] = p; p += (sm[e] + 255) >> 8; } sm[24] = p; }
        __syncthreads();
        if (F.tid < 9) PSTART[F.tid] = sm[16 + F.tid];
        if (F.wave == 0) { const int tok = chunk * 64 + F.lane; const int ev = TOKE[tok], e1 = ev & 255, e2 = ev >> 8; int s1 = 0, s2 = 0;
            const unsigned long long below = (1ull << F.lane) - 1ull;
#pragma unroll
            for (int e = 0; e < 8; ++e) { const unsigned long long m1 = __ballot(e1 == e), m2 = __ballot(e2 == e);
                const int rank = __popcll(m1 & below) + __popcll(m2 & below), slot = sm[16 + e] * 256 + sm[8 + e] + rank;
                if (e1 == e) s1 = slot; if (e2 == e) s2 = slot; }
            SLOT12[tok * 2] = s1; SLOT12[tok * 2 + 1] = s2; const float r = TOKRS[tok];
            SLOTG[s1] = TOKG[tok * 2]; SLOTG[s2] = TOKG[tok * 2 + 1]; SLOTRS[s1] = r; SLOTRS[s2] = r;
            sm[32 + 2 * F.lane] = s1; sm[32 + 2 * F.lane + 1] = s2; }
        __syncthreads();
        for (int i = 0; i < 16; ++i) { const int pr = F.wave * 16 + i, tok = chunk * 64 + (pr >> 1), slot = sm[32 + pr];
            const u32x4* src = (const u32x4*)(HB + (size_t)tok * DMODEL) + F.lane; u32x4* dst = (u32x4*)(XG + (size_t)slot * DMODEL) + F.lane;
            dst[0] = src[0]; dst[64] = src[64]; }
        __syncthreads();
    }
}
__device__ __forceinline__ void moe_combine(const Args& a, const Frame& F_, int cur, bool dummy) { THIN_LAUNDER();
    const int* SLOT12 = (const int*)(wsl + WS_SLOT12); const bf16_t* YG = (const bf16_t*)(wsl + X_YG);
    const bf16_t* HBi = (const bf16_t*)(wsl + WS_HB) + (size_t)cur * MT * DMODEL;
    bf16_t* HB = dummy ? (bf16_t*)(wsl + WS_END + 66 * MiB) : (bf16_t*)(wsl + WS_HB) + (size_t)cur * MT * DMODEL; float* SSQ = dummy ? (float*)(wsl + WS_END + 99 * MiB) : (float*)(wsl + WS_SSQ) + (size_t)cur * MT * 16;
    const int gw = F.vcu * NWAVES + F.wave, NGW = F.G * NWAVES;
    for (int row = gw; row < MT; row += NGW) { const int s1 = SLOT12[row * 2], s2 = SLOT12[row * 2 + 1];
        const u32x2* hr = (const u32x2*)(HBi + (size_t)row * DMODEL) + F.lane; u32x2* hb = (u32x2*)(HB + (size_t)row * DMODEL) + F.lane;
        const u32x2* y1 = (const u32x2*)(YG + (size_t)s1 * DMODEL) + F.lane; const u32x2* y2 = (const u32x2*)(YG + (size_t)s2 * DMODEL) + F.lane; float s = 0.f;
        u32x2 hv[4], pv_[4], qv[4];
#pragma unroll
        for (int j = 0; j < 4; ++j) { hv[j] = hr[64 * j]; pv_[j] = y1[64 * j]; qv[j] = y2[64 * j]; }
#pragma unroll
        for (int j = 0; j < 4; ++j) { const u32x2 h = hv[j], p = pv_[j], q = qv[j]; f32x4 v;
            v[0] = bf_lo(h.x) + (bf_lo(p.x) + bf_lo(q.x)); v[1] = bf_hi(h.x) + (bf_hi(p.x) + bf_hi(q.x)); v[2] = bf_lo(h.y) + (bf_lo(p.y) + bf_lo(q.y)); v[3] = bf_hi(h.y) + (bf_hi(p.y) + bf_hi(q.y));
            u32x2 o; o.x = pk_bf16(v[0], v[1]); o.y = pk_bf16(v[2], v[3]); hb[64 * j] = o; s += (v[0] * v[0] + v[1] * v[1]) + (v[2] * v[2] + v[3] * v[3]); }
        s = wave_sum(s, F.lane); if (F.lane < 16) SSQ[(size_t)row * 16 + F.lane] = F.lane == 0 ? s : 0.f; }
}

__global__ void __launch_bounds__(NTHR, 2) yoco_fwd(Args args) {
    extern __shared__ __attribute__((aligned(16))) unsigned char lds_raw[];
    Frame F; F.lds = (LAS unsigned char*)lds_raw;
    volatile LAS unsigned* MISC = (volatile LAS unsigned*)(F.lds + MISC_OFF);
    F.wave = __builtin_amdgcn_readfirstlane((int)threadIdx.x >> 6); F.lane = lane_id(); F.tid = F.wave * 64 + F.lane;
    F.G = gridDim.x; { const int bx = blockIdx.x; F.vcu = (F.G % 8 == 0) ? (bx % 8) * (F.G / 8) + bx / 8 : bx; }
    for (int u = F.tid; u < (LDS_BYTES - LDSCTL_OFF) / 4; u += NTHR) ((LAS unsigned*)(F.lds + LDSCTL_OFF))[u] = 0u;
    __syncthreads();
    unsigned char* ws = args.ws;
#define WS_LAUNDER() do { F.lane = lane_id(); F.tid = F.wave * 64 + F.lane; asm volatile("" : "+s"(ws), "+s"(bx), "+s"(F.G), "+s"(F.vcu), "+v"(F.tid), "+v"(F.lane)); } while (0)
    const bool single = (args.ph_hi - args.ph_lo) > 1;
    XcdBarrier bar; bar.bar = (unsigned*)(ws + WS_CTL) + CW_BAR; bar.x = 0; bar.st = nullptr; bar.wv = F.wave;
    if (single) bar = xcd_barrier_post((unsigned*)(ws + WS_CTL) + CW_BAR, MISC + 8, F.wave);
    const int lo = args.ph_lo, hi = args.ph_hi;
#ifndef GU_ALIGN
#define GU_ALIGN true
#endif
#ifndef EN_MASK
#define EN_MASK 0xFFFFFFFFu
#endif
#define EN(b) (((EN_MASK) >> (b)) & 1u)
#define IN(k) (lo <= (k) && (k) < hi)
#ifdef REP_MASK
#define NREPS(k) ((((unsigned long long)(REP_MASK) >> (k)) & 1ull) ? (REP_N) + 1 : 1)
#else
#define NREPS(k) 1
#endif
#define REPLOOP(k) for (int rep_ = 0, nrep_ = NREPS(k); rep_ < nrep_; ++rep_)
#define DUMMY (rep_ + 1 < nrep_)
#define OUT_HB(set) (DUMMY ? (bf16_t*)(ws + WS_END + 66 * MiB) : (bf16_t*)(ws + WS_HB) + (size_t)(set) * MT * DMODEL)
#define OUT_SSQ(set) (DUMMY ? (float*)(ws + WS_END + 99 * MiB) : (float*)(ws + WS_SSQ) + (size_t)(set) * MT * 16)
#define SEAM(k) do { if (single && (k) + 1 < hi) { XcdBarrier b_ = bar; asm volatile("" : "+s"(b_.bar), "+s"(b_.x)); xcd_barrier(b_); } } while (0)

    LAS unsigned char* ring = F.lds + RING_OFF;
    int bx = (int)blockIdx.x;

    if (EN(0) && IN(0)) REPLOOP(0) { WS_LAUNDER(); prologue(args, F); SEAM(0); }
    if (EN(1) && IN(1)) REPLOOP(1) { WS_LAUNDER();
#pragma unroll 1
        for (int i = 0; i < 4; ++i) {
            pg8::Gemm g{(const bf16_t*)(ws + WS_PB) + (size_t)i * MT * 256, (const bf16_t*)(ws + W_PU) + (size_t)i * 1024 * 256, MT, 1024, 256};
            pg8::StaticOrder S; S.init(MT, 1024, F.G, bx);
            pg8::EpiScale E{(bf16_t*)(ws + WS_U) + (size_t)i * MT * DMODEL, 1024, pg8::RowScale{nullptr, 0}, 1.0f};
            pg8::gemm_phase<pg8::EpiScale, pg8::StaticOrder, true, true>(ring, g, S, E, F.wave);
        }
        SEAM(1);
    }
#pragma unroll 1
    for (int l = 0; l < 4; ++l) {
        const int base = 2 + PH_PER_LAYER * l; const bool is_mla = l < 2, is_moe = (l & 1) != 0; const int cur = l & 1, j = l & 1;
#define HBc ((const bf16_t*)(ws + WS_HB) + (size_t)cur * MT * DMODEL)
#define HBw ((bf16_t*)(ws + WS_HB) + (size_t)cur * MT * DMODEL)
#define SSQc ((float*)(ws + WS_SSQ) + (size_t)cur * MT * 16)
        if (IN(base + 0)) REPLOOP(base + 0) { WS_LAUNDER();
            if (EN(2) && is_mla) {
                pg8::Gemm g{HBc, (const bf16_t*)(ws + W_AIN) + (size_t)l * 768 * 1024, MT, 768, 1024};
                pg8::StaticOrder S; S.init(MT, 768, F.G, bx);
                pg8::EpiAin E{(bf16_t*)(ws + X_AQ), (bf16_t*)(ws + X_AKV), (float*)(ws + WS_KPE), (float*)(ws + WS_SSQQ), (float*)(ws + WS_SSQKV), pg8::RowScale{SSQc, 1}, args.in[10] + l * 96, (const float*)(ws + WS_CS), (float*)(ws + WS_SSPE)};
                pg8::gemm_phase<pg8::EpiAin, pg8::StaticOrder, true, true>(ring, g, S, E, F.wave);
            } else if (EN(3) && !is_mla) {
                pg8::Gemm g{HBc, (const bf16_t*)(ws + W_QB) + (size_t)j * 1024 * 1024, MT, 1024, 1024};
                pg8::StaticOrder S; S.init(MT, 1024, F.G, bx);
                pg8::EpiScale E{(bf16_t*)(ws + X_SQ), 1024, pg8::RowScale{SSQc, 1}, QSCALE_SB};
                pg8::gemm_phase<pg8::EpiScale, pg8::StaticOrder, true, true>(ring, g, S, E, F.wave);
            }
            SEAM(base + 0);
        }
        if (EN(4) && is_mla && IN(base + 1)) REPLOOP(base + 1) { WS_LAUNDER();
            { pg8::Gemm g{(const bf16_t*)(ws + X_AQ), (const bf16_t*)(ws + W_QUP) + (size_t)l * 1024 * 384, MT, 1024, 384};
              pg8::StaticOrder S; S.init(MT, 1024, F.G, bx);
              EpiQ E{ws, args.in[9] + l * 96};
              pg8::gemm_phase<EpiQ, pg8::StaticOrder, true, true>(ring, g, S, E, F.wave); }
            { pg8::Gemm g{(const bf16_t*)(ws + X_AKV), (const bf16_t*)(ws + W_KVUP) + (size_t)l * 1024 * 256, MT, 1024, 256};
              pg8::StaticOrder S; S.init(MT, 1024, F.G, bx);
              EpiKV E{ws, args.in[10] + l * 96};
              pg8::gemm_phase<EpiKV, pg8::StaticOrder, true, true>(ring, g, S, E, F.wave); }
            SEAM(base + 1);
        }
        if (IN(base + 3)) REPLOOP(base + 3) { WS_LAUNDER();
#if defined(MLA_ABL)
            if (EN(6) && is_mla && DUMMY) att::mla::phase<MLA_ABL>(F.vcu, F.G, (const bf16_t*)(ws + X_Q), (const bf16_t*)(ws + X_KT), (const bf16_t*)(ws + X_VT), (bf16_t*)(ws + WS_END + 66 * MiB), ring, F.wave);
            else
#endif
            if (EN(6) && is_mla) att::mla::phase<0>(F.vcu, F.G, (const bf16_t*)(ws + X_Q), (const bf16_t*)(ws + X_KT), (const bf16_t*)(ws + X_VT), (bf16_t*)(ws + X_O), ring, F.wave);
            else if (EN(7) && !is_mla) att::sba::phase(F.vcu, F.G, (const bf16_t*)(ws + X_SQ), (const bf16_t*)(ws + WS_SKT), (const bf16_t*)(ws + WS_SVT), (bf16_t*)(ws + X_SO), ring, F.wave);
            SEAM(base + 3);
        }
        if (EN(8) && IN(base + 4)) REPLOOP(base + 4) { WS_LAUNDER();
            pg8::Gemm g = is_mla ? pg8::Gemm{(const bf16_t*)(ws + X_O), (const bf16_t*)(ws + W_AOUT) + (size_t)l * 1024 * 512, MT, 1024, 512}
                                 : pg8::Gemm{(const bf16_t*)(ws + X_SO), (const bf16_t*)(ws + W_OB) + (size_t)j * 1024 * 1024, MT, 1024, 1024};
            pg8::StaticOrder S; S.init(MT, 1024, F.G, bx);
            pg8::EpiRes<false> E{HBc, OUT_HB(cur), OUT_SSQ(cur), nullptr, pg8::RowScale{nullptr, 0}, nullptr};
            pg8::gemm_phase<pg8::EpiRes<false>, pg8::StaticOrder, true, true>(ring, g, S, E, F.wave);
            SEAM(base + 4);
        }
        if (!is_moe) {
            if (EN(9) && IN(base + 5)) REPLOOP(base + 5) { WS_LAUNDER();
                pg8::Gemm g{HBc, (const bf16_t*)(ws + W_FGU) + (size_t)(l >> 1) * 5632 * 1024, MT, 5632, 1024};
                pg8::GroupOrder S; S.init_dense(MT, 5632, F.G, bx);
                pg8::EpiSwiglu E{(bf16_t*)(ws + X_HID), pg8::RowScale{SSQc, 1}};
                pg8::gemm_phase<pg8::EpiSwiglu, pg8::GroupOrder, GU_ALIGN, true>(ring, g, S, E, F.wave);
#if FILL_A + FILL_D > 0
                filler(args, F, l == 0 ? 0 : 3, l == 0 ? 0 : DEF_QC, l == 0 ? DEF_QA : DEF_QD);
#endif
                SEAM(base + 5);
            }
            if (EN(10) && IN(base + 6)) REPLOOP(base + 6) { WS_LAUNDER();
                pg8::Gemm g{(const bf16_t*)(ws + X_HID), (const bf16_t*)(ws + W_FDN) + (size_t)(l >> 1) * 1024 * 2816, MT, 1024, 2816};
                pg8::StaticOrder S; S.init(MT, 1024, F.G, bx);
                pg8::EpiRes<false> E{HBc, OUT_HB(cur), OUT_SSQ(cur), nullptr, pg8::RowScale{nullptr, 0}, nullptr};
                pg8::gemm_phase<pg8::EpiRes<false>, pg8::StaticOrder, true, true>(ring, g, S, E, F.wave);
                SEAM(base + 6);
            }
        } else {
            if (EN(11) && IN(base + 5)) REPLOOP(base + 5) { WS_LAUNDER(); moe_route(args, F, l, cur); SEAM(base + 5); }
            if (EN(12) && IN(base + 6)) REPLOOP(base + 6) { WS_LAUNDER(); moe_scatter(args, F, cur); SEAM(base + 6); }
            if (EN(13) && IN(base + 7)) REPLOOP(base + 7) { WS_LAUNDER();
                pg8::Gemm g{(const bf16_t*)(ws + X_XG), (const bf16_t*)(ws + W_EGU) + (size_t)(l >> 1) * 8 * 5632 * 1024, MAXSLOT, 5632, 1024};
                pg8::GroupOrder S; S.init((const int*)(ws + WS_PSTART), 5632, F.G, bx, (size_t)5632 * 1024 * 2);
                pg8::EpiSwiglu E{(bf16_t*)(ws + X_HG), pg8::RowScale{(const float*)(ws + WS_SLOTRS), 2}};
                pg8::gemm_phase<pg8::EpiSwiglu, pg8::GroupOrder, GU_ALIGN, true>(ring, g, S, E, F.wave);
#if FILL_B > 0
                if (l == 1) filler(args, F, 1, DEF_QA, DEF_QB);
#endif
                SEAM(base + 7);
            }
            if (EN(14) && IN(base + 8)) REPLOOP(base + 8) { WS_LAUNDER();
                pg8::Gemm g{(const bf16_t*)(ws + X_HG), (const bf16_t*)(ws + W_EDN) + (size_t)(l >> 1) * 8 * 1024 * 2816, MAXSLOT, 1024, 2816};
                pg8::GroupOrder S; S.init((const int*)(ws + WS_PSTART), 1024, F.G, bx, (size_t)1024 * 2816 * 2);
                pg8::EpiScale E{(bf16_t*)(ws + X_YG), 1024, pg8::RowScale{(const float*)(ws + WS_SLOTG), 2}, 1.0f};
                pg8::gemm_phase<pg8::EpiScale, pg8::GroupOrder, true, true>(ring, g, S, E, F.wave);
#if FILL_C > 0
                if (l == 1) filler(args, F, 2, DEF_QB, DEF_QC);
#endif
                SEAM(base + 8);
            }
            if (EN(15) && IN(base + 9)) REPLOOP(base + 9) { WS_LAUNDER(); moe_combine(args, F, cur, DUMMY); SEAM(base + 9); }
        }
        if (EN(16) && IN(base + 10)) REPLOOP(base + 10) { WS_LAUNDER();
            pg8::Gemm g{HBc, (const bf16_t*)(ws + W_PG) + (size_t)l * 1024 * 1024, MT, 1024, 1024};
            pg8::StaticOrder S; S.init(MT, 1024, F.G, bx);
            pg8::EpiRes<true> E{HBc, OUT_HB(cur ^ 1), OUT_SSQ(cur ^ 1),
                                (const bf16_t*)(ws + WS_U) + (size_t)l * MT * DMODEL, pg8::RowScale{SSQc, 1}, (l == 3 && !DUMMY) ? args.out : nullptr};
            pg8::gemm_phase<pg8::EpiRes<true>, pg8::StaticOrder, true, true>(ring, g, S, E, F.wave);
            SEAM(base + 10);
        }
        if (EN(17) && l == 1 && IN(base + 11)) REPLOOP(base + 11) { WS_LAUNDER();
            pg8::Gemm g{(const bf16_t*)(ws + WS_HB) + (size_t)(cur ^ 1) * MT * DMODEL, (const bf16_t*)(ws + W_KVS), MT, 512, 1024};
            pg8::StaticOrder S; S.init(MT, 512, F.G, bx);
            pg8::EpiKvs E{(bf16_t*)(ws + WS_SKT), (bf16_t*)(ws + WS_SVT), pg8::RowScale{(const float*)(ws + WS_SSQ) + (size_t)(cur ^ 1) * MT * 16, 1}};
            pg8::gemm_phase<pg8::EpiKvs, pg8::StaticOrder, true, true>(ring, g, S, E, F.wave);
            SEAM(base + 11);
        }
    }
#undef IN
#undef SEAM
}
}
#define MULTI_LAUNCH 0
extern "C" void kernel_launch(void* const* d_in, const int* in_sizes, int n_in, void* d_out, int out_size, void* d_ws, size_t ws_size, hipStream_t stream) {
    using namespace fw;
    static int grid = 0;
    if (grid == 0) {
        if (n_in != 26 || out_size != MT * DMODEL || ws_size < WS_END) { fprintf(stderr, "kernel_launch: unexpected n_in %d / out %d / ws %zu\n", n_in, out_size, ws_size); grid = -1; return; }
        if (hipFuncSetAttribute((const void*)yoco_fwd, hipFuncAttributeMaxDynamicSharedMemorySize, LDS_BYTES) != hipSuccess) { fprintf(stderr, "kernel_launch: hipFuncSetAttribute failed\n"); grid = -1; return; }
        int dev = 0, cus = 0, per_cu = 0;
        (void)hipGetDevice(&dev); (void)hipDeviceGetAttribute(&cus, hipDeviceAttributeMultiprocessorCount, dev);
        (void)hipOccupancyMaxActiveBlocksPerMultiprocessor(&per_cu, (const void*)yoco_fwd, NTHR, LDS_BYTES);
        (void)hipGetLastError();
        grid = (cus > 0 && per_cu >= 1) ? cus : 256;
        if (grid > 256) grid = 256;
    }
    if (grid < 0) return;
    (void)hipMemsetAsync((unsigned char*)d_ws + WS_CTL, 0, CTL_ZERO_BYTES, stream);
    Args a{};
    for (int i = 0; i < 26; ++i) a.in[i] = (const float*)d_in[i];
    a.out = (float*)d_out; a.ws = (unsigned char*)d_ws;
#if MULTI_LAUNCH
    for (int k = 0; k < PH_TOTAL; ++k) { if (!phase_active(k)) continue; a.ph_lo = k; a.ph_hi = k + 1; hipLaunchKernelGGL(yoco_fwd, dim3(grid), dim3(NTHR), LDS_BYTES, stream, a); }
#else
#ifdef PROBE_MASK
    a.ph_lo = 0; a.ph_hi = PH_TOTAL;
#else
    a.ph_lo = 0; a.ph_hi = PH_TOTAL - 1;
#endif
    hipLaunchKernelGGL(yoco_fwd, dim3(grid), dim3(NTHR), LDS_BYTES, stream, a);
#endif
}
```

```cpp
#include <hip/hip_runtime.h>
#include <cstdio>
#include <cstdint>
#include <cmath>
#define LAS __attribute__((address_space(3)))
#define GAS __attribute__((address_space(1)))
typedef unsigned short bf16_t;
typedef short bf16x8 __attribute__((ext_vector_type(8)));
typedef float f32x4 __attribute__((ext_vector_type(4)));
typedef float f32x2 __attribute__((ext_vector_type(2)));
typedef float f32x16 __attribute__((ext_vector_type(16)));
typedef unsigned u32x4 __attribute__((ext_vector_type(4)));
typedef unsigned u32x2 __attribute__((ext_vector_type(2)));
typedef short s16x4 __attribute__((ext_vector_type(4)));
typedef __bf16 bf16x2_t __attribute__((ext_vector_type(2)));

constexpr int MT = 16384, DMODEL = 1024, SEQL = 8192;
constexpr float RMS_EPS = 1e-6f;
constexpr float LOG2E = 1.4426950408889634f;

__device__ __forceinline__ unsigned pk_bf16(float lo, float hi) { f32x2 v = {lo, hi}; bf16x2_t b = __builtin_convertvector(v, bf16x2_t); return __builtin_bit_cast(unsigned, b); }
__device__ __forceinline__ float bf_lo(unsigned w) { return __uint_as_float(w << 16); }
__device__ __forceinline__ float bf_hi(unsigned w) { return __uint_as_float(w & 0xffff0000u); }
__device__ __forceinline__ unsigned cvt_pk_bf16(float lo, float hi) { unsigned r; asm volatile("v_cvt_pk_bf16_f32 %0, %1, %2" : "=v"(r) : "v"(lo), "v"(hi)); return r; }
__device__ __forceinline__ u32x4 pack8(const f32x4 a, const f32x4 b) { u32x4 w; w.x = cvt_pk_bf16(a[0], a[1]); w.y = cvt_pk_bf16(a[2], a[3]); w.z = cvt_pk_bf16(b[0], b[1]); w.w = cvt_pk_bf16(b[2], b[3]); return w; }
__device__ __forceinline__ void unpack8(const u32x4 w, f32x4& a, f32x4& b) { a = (f32x4){bf_lo(w.x), bf_hi(w.x), bf_lo(w.y), bf_hi(w.y)}; b = (f32x4){bf_lo(w.z), bf_hi(w.z), bf_lo(w.w), bf_hi(w.w)}; }
__device__ __forceinline__ float fast_rcp(float x) { return __builtin_amdgcn_rcpf(x); }
__device__ __forceinline__ float fast_exp2(float x) { return __builtin_amdgcn_exp2f(x); }
__device__ __forceinline__ float fast_log2(float x) { return __builtin_amdgcn_logf(x); }
__device__ __forceinline__ int lane_id() { int l; asm volatile("v_mbcnt_lo_u32_b32 %0, -1, 0\n\tv_mbcnt_hi_u32_b32 %0, -1, %0" : "=v"(l)); return l; }
__device__ __forceinline__ float sigmoidf_(float x) { return fast_rcp(1.0f + fast_exp2(-x * LOG2E)); }

namespace pg8 {
constexpr int BM = 256, BK = 64, HALF = 128, HTB = HALF * BK * 2, STAGE_BYTES = 8 * HTB, NXCD = 8, WGM = 8;
__host__ __device__ __forceinline__ int lds_byte(int r, int c) { const int st = (r >> 4) * 2 + (c >> 5), rr = r & 15, cc = c & 31, ob = rr * 64 + cc * 2; return st * 1024 + (ob ^ (((ob >> 9) & 1) << 5)); }
__host__ __device__ __forceinline__ void stage_rc(int b, int& R, int& C) { const int st = b / 1024, sb = b % 1024, swz = sb ^ (((sb >> 9) & 1) << 5); R = (st >> 1) * 16 + swz / 64; C = (st & 1) * 32 + (swz % 64) / 2; }
__host__ __device__ __forceinline__ int perm32(int rho) { const int n = rho >> 4, i = rho & 15; return 8 * (i >> 2) + 4 * n + (i & 3); }

struct Unit { int pm, pn; size_t boff; };
struct Gemm { const bf16_t* A; const bf16_t* Bt; int M, N, K; };

struct StaticOrder {
    int nM, nN, nwg, G, c;
    __device__ __forceinline__ void init(int M, int N, int G_, int c_) { nM = M / BM; nN = N / BM; nwg = nM * nN; G = G_; c = c_; }
    __device__ __forceinline__ bool next(int i, Unit& u) const {
        const long L = (long)i * G + c; if (L >= nwg) return false;
        int wgid = (int)L; { const int q = nwg / NXCD, r = nwg % NXCD, xcd = wgid % NXCD, off = wgid / NXCD; wgid = (xcd < r ? xcd * (q + 1) : r * (q + 1) + (xcd - r) * q) + off; }
        const int nig = WGM * nN, gid = wgid / nig, fm = gid * WGM, gsz = (nM - fm) < WGM ? (nM - fm) : WGM;
        u.pm = fm + ((wgid % nig) % gsz); u.pn = (wgid % nig) / gsz; u.boff = 0; return true;
    }
};
struct GroupOrder {
    int ps[9]; int nN, nwg, G, c; size_t estride;
    __device__ __forceinline__ void init(const int* pstart, int N, int G_, int c_, size_t estride_) {
#pragma unroll
        for (int e = 0; e < 9; ++e) ps[e] = __builtin_amdgcn_readfirstlane(pstart[e]);
        nN = N / BM; nwg = ps[8] * nN; G = G_; c = c_; estride = estride_; }
    __device__ __forceinline__ void init_dense(int M, int N, int G_, int c_) {
        ps[0] = 0;
#pragma unroll
        for (int e = 1; e < 9; ++e) ps[e] = M / BM;
        nN = N / BM; nwg = ps[8] * nN; G = G_; c = c_; estride = 0; }
    __device__ __forceinline__ bool next(int i, Unit& u) const {
        const long L = (long)i * G + c; if (L >= nwg) return false;
        int wgid = (int)L; { const int q = nwg / NXCD, r = nwg % NXCD, xcd = wgid % NXCD, off = wgid / NXCD; wgid = (xcd < r ? xcd * (q + 1) : r * (q + 1) + (xcd - r) * q) + off; }
        int e = 0;
#pragma unroll
        for (int k = 1; k < 8; ++k) if (wgid >= ps[k] * nN) e = k;
        int p0 = ps[0], p1 = ps[1];
#pragma unroll
        for (int k = 1; k < 8; ++k) if (e == k) { p0 = ps[k]; p1 = ps[k + 1]; }
        const int local = wgid - p0 * nN, np = p1 - p0;
        const int nig = WGM * nN, gid = local / nig, fm = gid * WGM, gsz = (np - fm) < WGM ? (np - fm) : WGM;
        u.pm = p0 + fm + ((local % nig) % gsz); u.pn = (local % nig) / gsz; u.boff = (size_t)e * estride; return true;
    }
};


__device__ __forceinline__ float sumsq8(const f32x4 a, const f32x4 b) { return ((a[0] * a[0] + a[1] * a[1]) + (a[2] * a[2] + a[3] * a[3])) + ((b[0] * b[0] + b[1] * b[1]) + (b[2] * b[2] + b[3] * b[3])); }
__device__ __forceinline__ float red_fq(float s) {
    { auto rr = __builtin_amdgcn_permlane16_swap(__float_as_uint(s), __float_as_uint(s), false, false); s = __uint_as_float(rr[0]) + __uint_as_float(rr[1]); }
    { auto rr = __builtin_amdgcn_permlane32_swap(__float_as_uint(s), __float_as_uint(s), false, false); s = __uint_as_float(rr[0]) + __uint_as_float(rr[1]); }
    return s; }
__device__ __forceinline__ float xor32(float v, int upper) {
    auto rr = __builtin_amdgcn_permlane32_swap(__float_as_uint(v), __float_as_uint(v), false, false); return __uint_as_float(upper ? rr[0] : rr[1]); }
struct RowScale {
    const float* p; int mode;
    __device__ __forceinline__ float get(int row, int fq) const {
        if (mode == 0) return 1.0f;
        if (mode == 2) return p[row];
        if (mode == 1) { const f32x4 a = *(const f32x4*)(p + (size_t)row * 16 + 4 * fq); const float s = red_fq((a[0] + a[1]) + (a[2] + a[3])); return 1.0f / sqrtf(s * (1.0f / 1024.0f) + RMS_EPS); }
        if (mode == 3) { const f32x4 a = *(const f32x4*)(p + (size_t)row * 8 + 4 * (fq & 1)); const float s = red_fq(fq < 2 ? (a[0] + a[1]) + (a[2] + a[3]) : 0.f); return 1.0f / sqrtf(s * (1.0f / 384.0f) + RMS_EPS); }
        { const float s = red_fq(p[(size_t)row * 4 + fq]); return 1.0f / sqrtf(s * (1.0f / 256.0f) + RMS_EPS); }
    }
    __device__ __forceinline__ void get8(float (&rsv)[2][4], int row0, int fq) const {
#pragma unroll
        for (int ai = 0; ai < 2; ++ai)
#pragma unroll
            for (int m = 0; m < 4; ++m) rsv[ai][m] = get(row0 + ai * 128 + m * 16, fq);
        asm volatile("" ::: "memory");
    }
};

struct EpiScale {
    static constexpr bool PERM = true, AFTER_DRAIN = false;
    bf16_t* O; int ldc; RowScale rs; float cs;
    __device__ __forceinline__ void operator()(const f32x4 (&acc)[2][2][4][2], const Unit& u, int wr, int wc, int fr_, int fq_) const {
        const int ln_ = lane_id(), fr = ln_ & 15, fq = ln_ >> 4; (void)fr_; (void)fq_;
        const int row0 = u.pm * BM + wr * 64 + fr, col0 = u.pn * BM + wc * 32 + 8 * fq;
        float rsv[2][4]; rs.get8(rsv, row0, fq);
#pragma unroll
        for (int ai = 0; ai < 2; ++ai)
#pragma unroll
            for (int m = 0; m < 4; ++m) { const int row = row0 + ai * HALF + m * 16; const float s = rsv[ai][m] * cs; bf16_t* rowp = O + (size_t)row * ldc + col0;
#pragma unroll
                for (int bj = 0; bj < 2; ++bj) *(u32x4*)(rowp + bj * HALF) = pack8(acc[ai][bj][m][0] * s, acc[ai][bj][m][1] * s); }
    }
};
__device__ __forceinline__ void rope8(f32x4& v0, f32x4& v1, const float* cs_row, int fq) {
    f32x4 p0, p1;
#pragma unroll
    for (int j = 0; j < 4; ++j) { p0[j] = xor32(v0[j], fq >> 1); p1[j] = xor32(v1[j], fq >> 1); }
    const int f0 = 8 * (fq & 1);
    const f32x4 c0 = *(const f32x4*)(cs_row + f0), c1 = *(const f32x4*)(cs_row + f0 + 4), s0 = *(const f32x4*)(cs_row + 16 + f0), s1 = *(const f32x4*)(cs_row + 16 + f0 + 4);
    if (fq < 2) { v0 = v0 * c0 - p0 * s0; v1 = v1 * c1 - p1 * s1; } else { v0 = v0 * c0 + p0 * s0; v1 = v1 * c1 + p1 * s1; }
}
struct EpiAin {
    static constexpr bool PERM = true, AFTER_DRAIN = false;
    bf16_t* AQ; bf16_t* AKV; float* KPE; float* SSQQ; float* SSQKV; RowScale rs; const float* gk; const float* CS; float* SSPE;
    __device__ __forceinline__ void operator()(const f32x4 (&acc)[2][2][4][2], const Unit& u, int wr, int wc, int fr_, int fq_) const {
        const int ln_ = lane_id(), fr = ln_ & 15, fq = ln_ >> 4; (void)fr_; (void)fq_;
        const int row0 = u.pm * BM + wr * 64 + fr, c8 = wc * 32 + 8 * fq;
        float rsv[2][4]; rs.get8(rsv, row0, fq);
#pragma unroll
        for (int ai = 0; ai < 2; ++ai)
#pragma unroll
            for (int m = 0; m < 4; ++m) { const int row = row0 + ai * HALF + m * 16; const float s = rsv[ai][m];
                const f32x4 a0 = acc[ai][0][m][0] * s, a1 = acc[ai][0][m][1] * s, b0 = acc[ai][1][m][0] * s, b1 = acc[ai][1][m][1] * s;
                if (u.pn == 0) {
                    *(u32x4*)(AQ + (size_t)row * 384 + c8) = pack8(a0, a1); *(u32x4*)(AQ + (size_t)row * 384 + 128 + c8) = pack8(b0, b1);
                    const float q = red_fq(sumsq8(a0, a1) + sumsq8(b0, b1)); if (fq == 0) SSQQ[(size_t)row * 8 + wc] = q;
                } else if (u.pn == 1) {
                    *(u32x4*)(AQ + (size_t)row * 384 + 256 + c8) = pack8(a0, a1);
                    const float q = red_fq(sumsq8(a0, a1)); if (fq == 0) SSQQ[(size_t)row * 8 + 4 + wc] = q;
                    if (wc == 0) { const float qp = red_fq(sumsq8(b0, b1)); if (fq == 0) SSPE[row] = qp;
                        f32x4 y0 = b0 * *(const f32x4*)(gk + 64 + 8 * fq), y1 = b1 * *(const f32x4*)(gk + 64 + 8 * fq + 4); rope8(y0, y1, CS + (size_t)row * 32, fq);
                        *(f32x4*)(KPE + (size_t)row * 32 + 8 * fq) = y0; *(f32x4*)(KPE + (size_t)row * 32 + 8 * fq + 4) = y1; }
                } else {
                    *(u32x4*)(AKV + (size_t)row * 256 + c8) = pack8(a0, a1); *(u32x4*)(AKV + (size_t)row * 256 + 128 + c8) = pack8(b0, b1);
                    const float q = red_fq(sumsq8(a0, a1) + sumsq8(b0, b1)); if (fq == 0) SSQKV[(size_t)row * 4 + wc] = q;
                } }
    }
};
struct EpiSwiglu {
    static constexpr bool PERM = true, AFTER_DRAIN = false;
    bf16_t* HID; RowScale rs;
    __device__ __forceinline__ void operator()(const f32x4 (&acc)[2][2][4][2], const Unit& u, int wr, int wc, int fr_, int fq_) const {
        const int ln_ = lane_id(), fr = ln_ & 15, fq = ln_ >> 4; (void)fr_; (void)fq_;
        const int row0 = u.pm * BM + wr * 64 + fr, col0 = u.pn * 128 + wc * 32 + 8 * fq;
        float rsv[2][4]; rs.get8(rsv, row0, fq);
#pragma unroll
        for (int ai = 0; ai < 2; ++ai)
#pragma unroll
            for (int m = 0; m < 4; ++m) { const int row = row0 + ai * HALF + m * 16; const float s = rsv[ai][m];
                f32x4 o[2];
#pragma unroll
                for (int n = 0; n < 2; ++n) { const f32x4 g = acc[ai][0][m][n] * s, up = acc[ai][1][m][n] * s;
#pragma unroll
                    for (int j = 0; j < 4; ++j) o[n][j] = g[j] * sigmoidf_(g[j]) * up[j]; }
                *(u32x4*)(HID + (size_t)row * 2816 + col0) = pack8(o[0], o[1]); }
    }
};
template <bool GATED> struct EpiRes {
    static constexpr bool PERM = true, AFTER_DRAIN = false;
    const bf16_t* HBi; bf16_t* HBo; float* SSQo; const bf16_t* U; RowScale rs; float* OUTF;
    __device__ __forceinline__ void operator()(const f32x4 (&acc)[2][2][4][2], const Unit& u, int wr, int wc, int fr_, int fq_) const {
        const int ln_ = lane_id(), fr = ln_ & 15, fq = ln_ >> 4; (void)fr_; (void)fq_;
        const int row0 = u.pm * BM + wr * 64 + fr, col0 = u.pn * BM + wc * 32 + 8 * fq;
        float rsv[2][4]; if (GATED) rs.get8(rsv, row0, fq);
#pragma unroll
        for (int ai = 0; ai < 2; ++ai)
#pragma unroll
            for (int m = 0; m < 4; ++m) { const int row = row0 + ai * HALF + m * 16; const size_t off = (size_t)row * DMODEL + col0;
                float s = 1.0f; if (GATED) s = rsv[ai][m];
                float q = 0.f;
#pragma unroll
                for (int bj = 0; bj < 2; ++bj) { f32x4 a0 = acc[ai][bj][m][0], a1 = acc[ai][bj][m][1];
                    f32x4 h0, h1; unpack8(*(const u32x4*)(HBi + off + bj * HALF), h0, h1);
                    if (GATED) { f32x4 u0, u1; unpack8(*(const u32x4*)(U + off + bj * HALF), u0, u1);
#pragma unroll
                        for (int j = 0; j < 4; ++j) { a0[j] = sigmoidf_(a0[j] * s) * u0[j]; a1[j] = sigmoidf_(a1[j] * s) * u1[j]; } }
                    h0 += a0; h1 += a1;
                    if (GATED) { if (OUTF) { *(f32x4*)(OUTF + off + bj * HALF) = h0; *(f32x4*)(OUTF + off + bj * HALF + 4) = h1; } }
                    *(u32x4*)(HBo + off + bj * HALF) = pack8(h0, h1);
                    q += sumsq8(h0, h1); }
                q = red_fq(q); if (fq == 0) SSQo[(size_t)row * 16 + u.pn * 4 + wc] = q;
                asm volatile("" ::: "memory"); }
    }
};
struct EpiKvs {
    static constexpr bool PERM = true, AFTER_DRAIN = false;
    bf16_t* KT; bf16_t* VT; RowScale rs;
    __device__ __forceinline__ void operator()(const f32x4 (&acc)[2][2][4][2], const Unit& u, int wr, int wc, int fr_, int fq_) const {
        const int ln_ = lane_id(), fr = ln_ & 15, fq = ln_ >> 4; (void)fr_; (void)fq_;
        const int row0 = u.pm * BM + wr * 64 + fr;
        float rsv[2][4]; rs.get8(rsv, row0, fq);
#pragma unroll
        for (int ai = 0; ai < 2; ++ai)
#pragma unroll
            for (int m = 0; m < 4; ++m) { const int row = row0 + ai * HALF + m * 16; const float s = rsv[ai][m];
                const int b = row >> 13, sq = row & 8191, tile = sq >> 6, rr = sq & 63;
#pragma unroll
                for (int bj = 0; bj < 2; ++bj) { const int c = bj * HALF + wc * 32 + 8 * fq, kh = c >> 6, d = c & 63;
                    const size_t tb = (size_t)((b * 4 + kh) * 128 + tile) * 4096;
                    const u32x4 w = pack8(acc[ai][bj][m][0] * s, acc[ai][bj][m][1] * s);
                    if (u.pn == 0) *(u32x4*)(KT + tb + (d >> 3) * 512 + rr * 8) = w;
                    else *(u32x4*)(VT + tb + (d >> 5) * 2048 + rr * 32 + (d & 31)) = w; } }
    }
};

#define PG8_LAS LAS
template <class Epi, class Sched, bool ALIGN_EPI = false, bool SP2 = false>
__device__ __forceinline__ void gemm_phase(PG8_LAS unsigned char* lds, const Gemm g, const Sched& S, const Epi& E, int wv  ) {
    int tid_ = wv * 64 + lane_id(); asm volatile("" : "+v"(tid_));
    const int tid = tid_, wid = __builtin_amdgcn_readfirstlane(tid >> 6), lane = tid & 63, wr = wid >> 2, wc = wid & 3, fr = lane & 15, fq = lane >> 4;
    const int K = g.K, nt = K / BK;
    unsigned voffA[2], voffB[2];
#pragma unroll
    for (int i = 0; i < 2; ++i) { int R, C; stage_rc(tid * 16 + i * 8192, R, C); const int Rb = Epi::PERM ? ((R & ~31) + perm32(R & 31)) : R;
        voffA[i] = (unsigned)(R * K + C) * 2u; voffB[i] = (unsigned)(Rb * K + C) * 2u; }
    const size_t kstep = (size_t)(BK * 2);
    const size_t hstep = (size_t)HALF * K * 2;
    const size_t tstep = 2 * hstep;
    const unsigned ldsw = (unsigned)wid * 1024u;
    const int aoff = lds_byte(wr * 64 + fr, fq * 8), boff = lds_byte(wc * 32 + fr, fq * 8);
#define PG8_SA(b, h) (((b) * 2 + (h)) * HTB)
#define PG8_SB(b, h) ((4 + (b) * 2 + (h)) * HTB)
#define PG8_STAGE(bufoff, gbase, voff) do { _Pragma("unroll") for (int _i = 0; _i < 2; ++_i) \
        __builtin_amdgcn_global_load_lds((const unsigned*)((const char*)(gbase) + (voff)[_i]), (PG8_LAS unsigned*)(lds + (bufoff) + ldsw + _i * 8192), 16, 0, 0); } while (0)
#define PG8_LDA(dst, b, h) do { _Pragma("unroll") for (int m = 0; m < 4; ++m) _Pragma("unroll") for (int k = 0; k < 2; ++k) dst[m][k] = *(const PG8_LAS bf16x8*)(lds + PG8_SA(b, h) + aoff + m * 2048 + k * 1024); } while (0)
#define PG8_LDB(dst, b, h) do { _Pragma("unroll") for (int n = 0; n < 2; ++n) _Pragma("unroll") for (int k = 0; k < 2; ++k) dst[n][k] = *(const PG8_LAS bf16x8*)(lds + PG8_SB(b, h) + boff + n * 2048 + k * 1024); } while (0)
#define PG8_MMA(ai, bj, At, Bt) do { __builtin_amdgcn_s_setprio(1); _Pragma("unroll") for (int m = 0; m < 4; ++m) _Pragma("unroll") for (int n = 0; n < 2; ++n) _Pragma("unroll") for (int k = 0; k < 2; ++k) \
        acc[ai][bj][m][n] = __builtin_amdgcn_mfma_f32_16x16x32_bf16(Bt[n][k], At[m][k], acc[ai][bj][m][n], 0, 0, 0); __builtin_amdgcn_s_setprio(0); } while (0)
#define PG8_WAIT_V(n) asm volatile("s_waitcnt vmcnt(" #n ")" ::: "memory")
#define PG8_WAIT_L(n) asm volatile("s_waitcnt lgkmcnt(" #n ")" ::: "memory")
#define PG8_BAR __builtin_amdgcn_s_barrier()
#define PG8_SCHED __builtin_amdgcn_sched_barrier(0)
    Unit cur, nxt; int ui = 0;
    if (!S.next(0, cur)) return;
    f32x4 acc[2][2][4][2];
#pragma unroll
    for (int a = 0; a < 2; ++a)
#pragma unroll
        for (int b = 0; b < 2; ++b)
#pragma unroll
            for (int m = 0; m < 4; ++m)
#pragma unroll
                for (int n = 0; n < 2; ++n) acc[a][b][m][n] = (f32x4){0.f, 0.f, 0.f, 0.f};
    bf16x8 At[4][2], B0[2][2], B1[2][2];
    const char* cA = (const char*)g.A + (size_t)cur.pm * tstep; const char* cB = (const char*)g.Bt + cur.boff + (size_t)cur.pn * tstep;
    if constexpr (SP2) {
        PG8_STAGE(PG8_SB(0, 0), cB, voffB); PG8_STAGE(PG8_SB(0, 1), cB + hstep, voffB); PG8_STAGE(PG8_SA(0, 0), cA, voffA); PG8_STAGE(PG8_SA(0, 1), cA + hstep, voffA);
        if (wr == 1) PG8_BAR;
        PG8_WAIT_V(2); PG8_BAR;
        PG8_STAGE(PG8_SB(1, 0), cB + kstep, voffB); PG8_STAGE(PG8_SA(1, 0), cA + kstep, voffA); PG8_STAGE(PG8_SB(1, 1), cB + hstep + kstep, voffB);
        PG8_WAIT_V(6); PG8_BAR;
    } else {
        PG8_STAGE(PG8_SB(0, 0), cB, voffB); PG8_STAGE(PG8_SA(0, 0), cA, voffA); PG8_STAGE(PG8_SB(0, 1), cB + hstep, voffB); PG8_STAGE(PG8_SA(0, 1), cA + hstep, voffA);
        if (wr == 1) PG8_BAR;
        PG8_WAIT_V(4); PG8_BAR;
        PG8_STAGE(PG8_SB(1, 0), cB + kstep, voffB); PG8_STAGE(PG8_SA(1, 0), cA + kstep, voffA); PG8_STAGE(PG8_SB(1, 1), cB + hstep + kstep, voffB);
        PG8_WAIT_V(6); PG8_BAR;
    }
    for (;;) {
        const bool has_next = S.next(ui + 1, nxt);
        const char* nA = has_next ? (const char*)g.A + (size_t)nxt.pm * tstep : cA; const char* nB = has_next ? (const char*)g.Bt + nxt.boff + (size_t)nxt.pn * tstep : cB;
        for (int t = 0; t < nt; t += 2) {
            const bool last = (t == nt - 2);
            const char* a1 = cA + (size_t)(t + 1) * kstep;
            const char* a2 = last ? nA : cA + (size_t)(t + 2) * kstep; const char* b2 = last ? nB : cB + (size_t)(t + 2) * kstep;
            const char* a3 = a2 + kstep; const char* b3 = b2 + kstep;
            if constexpr (SP2) {
            PG8_LDB(B0, 0, 0); PG8_LDB(B1, 0, 1); PG8_SCHED; PG8_LDA(At, 0, 0); PG8_STAGE(PG8_SA(1, 1), a1 + hstep, voffA);
            PG8_WAIT_V(8); PG8_WAIT_L(0); PG8_BAR; PG8_MMA(0, 0, At, B0); PG8_MMA(0, 1, At, B1); PG8_BAR; PG8_SCHED;
            PG8_LDA(At, 0, 1); PG8_STAGE(PG8_SB(0, 0), b2, voffB); PG8_STAGE(PG8_SB(0, 1), b2 + hstep, voffB); PG8_STAGE(PG8_SA(0, 0), a2, voffA);
            PG8_WAIT_V(8); PG8_WAIT_L(0); PG8_BAR; PG8_MMA(1, 0, At, B0); PG8_MMA(1, 1, At, B1); PG8_BAR; PG8_SCHED;
            PG8_LDB(B0, 1, 0); PG8_LDB(B1, 1, 1); PG8_SCHED; PG8_LDA(At, 1, 0); PG8_STAGE(PG8_SA(0, 1), a2 + hstep, voffA);
            PG8_WAIT_V(8); PG8_WAIT_L(0); PG8_BAR; PG8_MMA(0, 0, At, B0); PG8_MMA(0, 1, At, B1); PG8_BAR; PG8_SCHED;
            PG8_LDA(At, 1, 1); PG8_STAGE(PG8_SB(1, 0), b3, voffB); PG8_STAGE(PG8_SB(1, 1), b3 + hstep, voffB); PG8_STAGE(PG8_SA(1, 0), a3, voffA);
            PG8_WAIT_V(8); PG8_WAIT_L(0); PG8_BAR; PG8_MMA(1, 0, At, B0); PG8_MMA(1, 1, At, B1); PG8_BAR; PG8_SCHED;
            } else {
            PG8_LDB(B0, 0, 0); PG8_SCHED; PG8_LDA(At, 0, 0); PG8_STAGE(PG8_SA(1, 1), a1 + hstep, voffA);
            PG8_WAIT_L(8); PG8_BAR; PG8_WAIT_L(0); PG8_MMA(0, 0, At, B0); PG8_BAR; PG8_SCHED;
            PG8_LDB(B1, 0, 1); PG8_STAGE(PG8_SB(0, 0), b2, voffB);
            PG8_BAR; PG8_WAIT_L(0); PG8_MMA(0, 1, At, B1); PG8_BAR;
            PG8_LDA(At, 0, 1); PG8_STAGE(PG8_SA(0, 0), a2, voffA);
            PG8_BAR; PG8_WAIT_L(0); PG8_MMA(1, 0, At, B0); PG8_BAR; PG8_SCHED;
            PG8_STAGE(PG8_SB(0, 1), b2 + hstep, voffB);
            PG8_WAIT_V(6); PG8_BAR; PG8_MMA(1, 1, At, B1); PG8_BAR;
            PG8_LDB(B0, 1, 0); PG8_SCHED; PG8_LDA(At, 1, 0); PG8_STAGE(PG8_SA(0, 1), a2 + hstep, voffA);
            PG8_WAIT_L(8); PG8_BAR; PG8_WAIT_L(0); PG8_MMA(0, 0, At, B0); PG8_BAR; PG8_SCHED;
            PG8_LDB(B1, 1, 1); PG8_STAGE(PG8_SB(1, 0), b3, voffB);
            PG8_BAR; PG8_WAIT_L(0); PG8_MMA(0, 1, At, B1); PG8_BAR;
            PG8_LDA(At, 1, 1); PG8_STAGE(PG8_SA(1, 0), a3, voffA);
            PG8_BAR; PG8_WAIT_L(0); PG8_MMA(1, 0, At, B0); PG8_BAR; PG8_SCHED;
            PG8_STAGE(PG8_SB(1, 1), b3 + hstep, voffB);
            PG8_WAIT_V(6); PG8_BAR; PG8_MMA(1, 1, At, B1); PG8_BAR;
            }
        }
        if constexpr (ALIGN_EPI) { if (wr == 0) PG8_BAR; }
        E(acc, cur, wr, wc, fr, fq);
        if (!has_next) break;
#pragma unroll
        for (int a = 0; a < 2; ++a)
#pragma unroll
            for (int b = 0; b < 2; ++b)
#pragma unroll
                for (int m = 0; m < 4; ++m)
#pragma unroll
                    for (int n = 0; n < 2; ++n) acc[a][b][m][n] = (f32x4){0.f, 0.f, 0.f, 0.f};
        cur = nxt; cA = nA; cB = nB; ++ui;
        if constexpr (ALIGN_EPI) { if (wr == 1) PG8_BAR; }
    }
    PG8_WAIT_V(0);
    if constexpr (!ALIGN_EPI) { if (wr == 0) PG8_BAR; }
    PG8_BAR;
#undef PG8_SA
#undef PG8_SB
#undef PG8_STAGE
#undef PG8_LDA
#undef PG8_LDB
#undef PG8_MMA
#undef PG8_WAIT_V
#undef PG8_WAIT_L
#undef PG8_BAR
#undef PG8_SCHED
}
}
typedef GAS unsigned gu32;
#define RLX_AGENT __ATOMIC_RELAXED, __HIP_MEMORY_SCOPE_AGENT
#define XB_TMO      128
#define XB_XCNT(j)  (256  + 64 * (j))
#define XB_XSUB(j)  (1280 + 64 * (j))
#define XB_XGEN(j)  (2304 + 64 * (j))
#define XB_TOP      3328
#define XB_TOPGEN   3392
#define XCD_BAR_WORDS 3456
#define XB_SPIN_CAP (1u << 18)

__device__ __forceinline__ unsigned xb_ld(unsigned* p)              { return __hip_atomic_load(p, __ATOMIC_RELAXED, __HIP_MEMORY_SCOPE_AGENT); }
__device__ __forceinline__ unsigned xb_add(unsigned* p, unsigned v) { return __hip_atomic_fetch_add(p, v, __ATOMIC_RELAXED, __HIP_MEMORY_SCOPE_AGENT); }
__device__ __forceinline__ unsigned xb_xcc_id() { return (unsigned)__builtin_amdgcn_s_getreg((3 << 11) | 20) & 0xFu; }
#define XB_SPIN(cond, bar) do { unsigned _sp = 0; while (cond) { __builtin_amdgcn_s_sleep(1); \
    if ((++_sp & 255u) == 0u) { if (xb_ld(&(bar)[XB_TMO])) break; if (_sp > XB_SPIN_CAP) { atomicAdd(&(bar)[XB_TMO], 1u); break; } } } } while (0)

struct XcdBarrier {
    unsigned* bar; unsigned x; int wv;
    volatile LAS unsigned* st;
};
__device__ __forceinline__ XcdBarrier xcd_barrier_post(unsigned* bar, volatile LAS unsigned* st, int wv) {
    XcdBarrier b; b.bar = bar; b.x = xb_xcc_id(); b.st = st; b.wv = wv;
    if (wv == 0 && lane_id() == 0) (void)xb_add(&bar[XB_XCNT(b.x)], 1u);
    return b;
}
__device__ __forceinline__ void xcd_barrier_complete(unsigned* bar, unsigned x, unsigned& nloc, unsigned& nx) {
    const unsigned G = gridDim.x * gridDim.y * gridDim.z;
    unsigned sum, cnt, mine, sp = 0u;
    for (;;) {
        sum = 0u; cnt = 0u; mine = 0u;
#pragma unroll
        for (unsigned j = 0; j < 16; ++j) { const unsigned c = xb_ld(&bar[XB_XCNT(j)]); sum += c; cnt += (c > 0u) ? 1u : 0u; mine = (j == x) ? c : mine; }
        if (sum == G) break;
        __builtin_amdgcn_s_sleep(1);
        if ((++sp & 255u) == 0u) { if (xb_ld(&bar[XB_TMO])) break; if (sp > XB_SPIN_CAP) { atomicAdd(&bar[XB_TMO], 1u); break; } }
    }
    nloc = mine > 0u ? mine : 1u; nx = cnt > 0u ? cnt : 1u;
}
__device__ __forceinline__ void xcd_barrier(const XcdBarrier& b) {
    asm volatile("s_waitcnt vmcnt(0)" ::: "memory");
    __syncthreads();
    if (b.wv == 0 && lane_id() == 0) {
        unsigned* bar = b.bar;
        __builtin_amdgcn_s_waitcnt(0);
        unsigned nloc = b.st[0], nx = b.st[1];
        if (nloc == 0u) { xcd_barrier_complete(bar, b.x, nloc, nx); b.st[0] = nloc; b.st[1] = nx; }
        const unsigned old = xb_add(&bar[XB_XSUB(b.x)], 1u);
        const unsigned gen = old / nloc;
        if (old + 1u == (gen + 1u) * nloc) {
            __builtin_amdgcn_fence(__ATOMIC_RELEASE, "agent");
            asm volatile("s_waitcnt vmcnt(0)" ::: "memory");
            const unsigned og = xb_add(&bar[XB_TOP], 1u);
            const unsigned tg = og / nx;
            if (og + 1u == (tg + 1u) * nx) xb_add(&bar[XB_TOPGEN], 1u);
            else XB_SPIN(xb_ld(&bar[XB_TOPGEN]) == tg, bar);
            __builtin_amdgcn_fence(__ATOMIC_ACQUIRE, "agent");
            xb_add(&bar[XB_XGEN(b.x)], 1u);
            asm volatile("s_waitcnt vmcnt(0)" ::: "memory");
        } else {
            XB_SPIN(xb_ld(&bar[XB_XGEN(b.x)]) == gen, bar);
            __builtin_amdgcn_fence(__ATOMIC_ACQUIRE, "agent");
            asm volatile("s_waitcnt vmcnt(0)" ::: "memory");
        }
    }
    __syncthreads();
}

namespace att {
__device__ __forceinline__ int crow(int r, int hi) { return (r & 3) + 8 * (r >> 2) + 4 * hi; }
__device__ __forceinline__ void glds16(const void* gsrc, unsigned lds_dst) { unsigned keep;
    asm volatile("s_mov_b32 %0, m0\n\ts_mov_b32 m0, %2\n\ts_nop 0\n\tglobal_load_lds_dwordx4 %1, off\n\ts_mov_b32 m0, %0" : "=&s"(keep) : "v"(gsrc), "s"(lds_dst) : "memory"); }
#define ATT_WAIT_BAR(N) asm volatile("s_waitcnt vmcnt(" #N ") lgkmcnt(0)\n\ts_barrier" ::: "memory")
#define ATT_MX3(a, b, c) __builtin_fmaxf(__builtin_fmaxf((a), (b)), (c))
typedef LAS const unsigned char* lcp;
typedef short v4i16_t __attribute__((ext_vector_type(4)));
__device__ __forceinline__ s16x4 vtr(lcp p) { return __builtin_bit_cast(s16x4, __builtin_amdgcn_ds_read_tr16_b64_v4i16((LAS v4i16_t*)p)); }
__device__ __forceinline__ float rowmax(const f32x16& p0, const f32x16& p1) {
    float a = ATT_MX3(p0[0], p0[1], p1[0]), b = ATT_MX3(p0[2], p0[3], p1[1]); a = ATT_MX3(a, p1[2], p1[3]);
#pragma unroll
    for (int r = 4; r < 16; r += 4) { a = ATT_MX3(a, p0[r], p0[r + 1]); b = ATT_MX3(b, p0[r + 2], p0[r + 3]); a = ATT_MX3(a, p1[r], p1[r + 1]); b = ATT_MX3(b, p1[r + 2], p1[r + 3]); }
    float m = __builtin_fmaxf(a, b); auto rr = __builtin_amdgcn_permlane32_swap(__float_as_uint(m), __float_as_uint(m), false, false);
    return __builtin_fmaxf(__uint_as_float(rr[0]), __uint_as_float(rr[1])); }
template <bool FAKEV = false> __device__ __forceinline__ void pv(f32x16* o, lcp vp, const u32x4 pw0, const u32x4 pw1, const u32x4 pw2, const u32x4 pw3) {
#pragma unroll
    for (int ks = 0; ks < 4; ++ks) {
        const u32x4 pw = ks == 0 ? pw0 : ks == 1 ? pw1 : ks == 2 ? pw2 : pw3;
#pragma unroll
        for (int d0 = 0; d0 < 2; ++d0) {
            bf16x8 vf;
            if (FAKEV) vf = __builtin_bit_cast(bf16x8, ks & 1 ? pw0 : pw2);
            else { const s16x4 lo = vtr(vp + d0 * 4096 + ks * 1024), hi = vtr(vp + d0 * 4096 + ks * 1024 + 512); vf = (bf16x8){lo[0], lo[1], lo[2], lo[3], hi[0], hi[1], hi[2], hi[3]}; }
            o[d0] = __builtin_amdgcn_mfma_f32_32x32x16_bf16(__builtin_bit_cast(bf16x8, pw), vf, o[d0], 0, 0, 0);
        }
    }
}
__device__ __forceinline__ void store_o(const f32x16* o, const float* rsc  , LAS unsigned char* stage, bf16_t* Ow, int pitch, int lane, int r32, int hi) {
    LAS bf16_t* stg = (LAS bf16_t*)stage;
#pragma unroll
    for (int r = 0; r < 16; ++r) { const int orow = crow(r, hi);
#pragma unroll
        for (int d0 = 0; d0 < 2; ++d0) stg[orow * 64 + d0 * 32 + r32] = (bf16_t)(pk_bf16(o[d0][r] * rsc[r], 0.f) & 0xffffu); }
    asm volatile("s_waitcnt lgkmcnt(0)" ::: "memory");
#pragma unroll
    for (int i = 0; i < 4; ++i) { const int row = i * 8 + (lane >> 3), ch = lane & 7; const u32x4 v = *(const LAS u32x4*)(stg + row * 64 + ch * 8); *(u32x4*)(Ow + (size_t)row * pitch + ch * 8) = v; }
}

namespace mla {
constexpr int KSLOT = 12288, VSLOT = 8192, NS = 3;
constexpr int L_K = 0, L_V = NS * KSLOT, L_WS = L_V + NS * VSLOT, L_OST = L_WS + 2048, L_END = L_OST + 8 * 4096;
#define MLA_BAR_L() asm volatile("s_waitcnt lgkmcnt(0)\n\ts_barrier" ::: "memory")
template <int ABL> __device__ __forceinline__ void unit(int b, int h, int qb, const bf16_t* Q, const bf16_t* KT, const bf16_t* VT, bf16_t* O, LAS unsigned char* shm, int wv) {
    int tid_ = wv * 64 + lane_id(); asm volatile("" : "+v"(tid_));
    const int tid = tid_, lane = tid & 63, r32 = lane & 31, hi = lane >> 5; const int wid = __builtin_amdgcn_readfirstlane(tid >> 6);
    const int grp = wid >> 2;
    const long rowbase = (long)b * SEQL; const int q0 = qb * 256;
    const bf16_t* Qw = Q + (size_t)(rowbase + q0 + wid * 32) * 768 + h * 96;
    const bf16_t* Kh = KT + (size_t)((b * 8 + h) * 128) * 6144 + lane * 8;
    const bf16_t* Vh = VT + (size_t)((b * 8 + h) * 128) * 4096 + lane * 8;
    const unsigned lds0 = (unsigned)(uintptr_t)shm;
    LAS float* wsf = (LAS float*)(shm + L_WS) + wid * 64;
    const int NT = (q0 + 256) / 64;
    const int kc2 = 8 + (wid & 3);
    bf16x8 qr[6];
#pragma unroll
    for (int d0 = 0; d0 < 6; ++d0) qr[d0] = *(const bf16x8*)(Qw + (size_t)r32 * 768 + d0 * 16 + hi * 8);
#define MLA_DMA_K(t, sl) do { const bf16_t* kt_ = Kh + (size_t)(t) * 6144; \
        glds16(kt_ + wid * 512, (unsigned)__builtin_amdgcn_readfirstlane(lds0 + L_K + (sl) * KSLOT + wid * 1024)); \
        glds16(kt_ + kc2 * 512, (unsigned)__builtin_amdgcn_readfirstlane(lds0 + L_K + (sl) * KSLOT + kc2 * 1024)); } while (0)
#define MLA_DMA_V(t, sl) glds16(Vh + (size_t)(t) * 4096 + wid * 512, (unsigned)__builtin_amdgcn_readfirstlane(lds0 + L_V + (sl) * VSLOT + wid * 1024))
#define MLA_GROUP(g, s0, s2) do { if ((g) + 3 < NT) MLA_DMA_K((g) + 3, s0); if ((g) + 2 < NT) MLA_DMA_V((g) + 2, s2); } while (0)
#define MLA_LOADK(sl) do { const lcp kb_ = (lcp)shm + L_K + (sl) * KSLOT + hi * 1024 + r32 * 16; _Pragma("unroll") for (int d0 = 0; d0 < 6; ++d0) { kf[2 * d0] = *(const LAS bf16x8*)(kb_ + d0 * 2048); kf[2 * d0 + 1] = *(const LAS bf16x8*)(kb_ + d0 * 2048 + 512); } } while (0)
    MLA_DMA_K(0, 0); MLA_DMA_K(1, 1); MLA_DMA_V(0, 0); MLA_DMA_K(2, 2); MLA_DMA_V(1, 1);
    float m = 0.f, l = 0.f; f32x16 o[2], negm;
#pragma unroll
    for (int r = 0; r < 16; ++r) { o[0][r] = 0.f; o[1][r] = 0.f; negm[r] = 0.f; }
    const int qrel = wid * 32 + r32;
    bf16x8 kf[12], vf[8]; u32x4 pw0 = {0u, 0u, 0u, 0u}, pw1 = pw0, pw2 = pw0, pw3 = pw0;
    ATT_WAIT_BAR(6);
    MLA_LOADK(0);
    if (grp == 1) ATT_WAIT_BAR(3);
    int s0 = 0, s1 = 1, s2 = 2;
    bool act_prev = false;
    for (int t = 0; t < NT; ++t) {
        if (grp == 1) MLA_GROUP(t, s0, s2);
        const int jb = t - (NT - 4);
        const bool act = ABL != 5 && (jb <= 0 || 64 * jb <= wid * 32 + 31);
        f32x16 p0 = negm, p1 = negm;
        if (act) {
#pragma unroll
            for (int d0 = 0; d0 < 6; ++d0) { p0 = __builtin_amdgcn_mfma_f32_32x32x16_bf16(kf[2 * d0], qr[d0], p0, 0, 0, 0); p1 = __builtin_amdgcn_mfma_f32_32x32x16_bf16(kf[2 * d0 + 1], qr[d0], p1, 0, 0, 0); }
        }
        if (act_prev) {
#pragma unroll
            for (int ks = 0; ks < 4; ++ks) { const u32x4 pw = ks == 0 ? pw0 : ks == 1 ? pw1 : ks == 2 ? pw2 : pw3;
                o[0] = __builtin_amdgcn_mfma_f32_32x32x16_bf16(__builtin_bit_cast(bf16x8, pw), vf[ks], o[0], 0, 0, 0);
                o[1] = __builtin_amdgcn_mfma_f32_32x32x16_bf16(__builtin_bit_cast(bf16x8, pw), vf[4 + ks], o[1], 0, 0, 0); }
        }
        if (grp == 0) { if (t + 2 < NT) ATT_WAIT_BAR(3); else ATT_WAIT_BAR(0); MLA_GROUP(t, s0, s2); }
        else MLA_BAR_L();
        if (act) {
            { const lcp vp = (lcp)shm + L_V + s0 * VSLOT + ((lane >> 4) & 1) * 32 + (lane & 3) * 8 + (4 * hi + ((lane & 15) >> 2)) * 64;
#pragma unroll
                for (int d0 = 0; d0 < 2; ++d0)
#pragma unroll
                    for (int ks = 0; ks < 4; ++ks) { const s16x4 lo = vtr(vp + d0 * 4096 + ks * 1024), hh = vtr(vp + d0 * 4096 + ks * 1024 + 512);
                        vf[d0 * 4 + ks] = (bf16x8){lo[0], lo[1], lo[2], lo[3], hh[0], hh[1], hh[2], hh[3]}; } }
        }
        if (t + 1 < NT) MLA_LOADK(s1);
        if (act) {
            if (jb >= 0) {
#pragma unroll
                for (int r = 0; r < 16; ++r) { const int kv = 64 * jb + crow(r, hi); if (kv > qrel) p0[r] = -INFINITY; if (kv + 32 > qrel) p1[r] = -INFINITY; }
            }
            const float rm = rowmax(p0, p1);
            if (t == 0 || __any(rm > 8.0f)) {
                const float dl = t == 0 ? rm : __builtin_fmaxf(rm, 0.f); m += dl;
#pragma unroll
                for (int r = 0; r < 16; ++r) { p0[r] -= dl; p1[r] -= dl; negm[r] = -m; }
                const float alpha = fast_exp2(-dl); l *= alpha; if (hi == 0) wsf[r32] = alpha;
#pragma unroll
                for (int r = 0; r < 16; ++r) { const float a = wsf[crow(r, hi)]; o[0][r] *= a; o[1][r] *= a; }
            }
            float sa = 0.f, sb = 0.f;
#pragma unroll
            for (int r = 0; r < 16; ++r) { if (ABL != 1) { p0[r] = fast_exp2(p0[r]); p1[r] = fast_exp2(p1[r]); } sa += p0[r]; sb += p1[r]; }
            l += sa + sb;
            pw0 = (u32x4){pk_bf16(p0[0], p0[1]), pk_bf16(p0[2], p0[3]), pk_bf16(p0[4], p0[5]), pk_bf16(p0[6], p0[7])};
            pw1 = (u32x4){pk_bf16(p0[8], p0[9]), pk_bf16(p0[10], p0[11]), pk_bf16(p0[12], p0[13]), pk_bf16(p0[14], p0[15])};
            pw2 = (u32x4){pk_bf16(p1[0], p1[1]), pk_bf16(p1[2], p1[3]), pk_bf16(p1[4], p1[5]), pk_bf16(p1[6], p1[7])};
            pw3 = (u32x4){pk_bf16(p1[8], p1[9]), pk_bf16(p1[10], p1[11]), pk_bf16(p1[12], p1[13]), pk_bf16(p1[14], p1[15])};
        }
        act_prev = act;
        if (grp == 0) MLA_BAR_L();
        else { if (t + 3 < NT) ATT_WAIT_BAR(3); else ATT_WAIT_BAR(0); }
        { const int tmp = s0; s0 = s1; s1 = s2; s2 = tmp; }
    }
#undef MLA_DMA_K
#undef MLA_DMA_V
#undef MLA_GROUP
#undef MLA_LOADK
    if (act_prev) {
#pragma unroll
        for (int ks = 0; ks < 4; ++ks) { const u32x4 pw = ks == 0 ? pw0 : ks == 1 ? pw1 : ks == 2 ? pw2 : pw3;
            o[0] = __builtin_amdgcn_mfma_f32_32x32x16_bf16(__builtin_bit_cast(bf16x8, pw), vf[ks], o[0], 0, 0, 0);
            o[1] = __builtin_amdgcn_mfma_f32_32x32x16_bf16(__builtin_bit_cast(bf16x8, pw), vf[4 + ks], o[1], 0, 0, 0); }
    }
    if (grp == 0) MLA_BAR_L();
    { auto rr = __builtin_amdgcn_permlane32_swap(__float_as_uint(l), __float_as_uint(l), false, false); l = __uint_as_float(rr[0]) + __uint_as_float(rr[1]); }
    if (hi == 0) wsf[32 + r32] = l;
    float rli[16];
#pragma unroll
    for (int r = 0; r < 16; ++r) rli[r] = fast_rcp(wsf[32 + crow(r, hi)]);
    store_o(o, rli, shm + L_OST + wid * 4096, O + (size_t)(rowbase + q0 + wid * 32) * 512 + h * 64, 512, lane, r32, hi);
    MLA_BAR_L();
}
template <int ABL> __device__ __forceinline__ void phase(int vcu, int G, const bf16_t* Q, const bf16_t* KT, const bf16_t* VT, bf16_t* O, LAS unsigned char* shm, int wv) {
    for (int v = vcu; v < 256; v += G) { const int bh = v >> 4, s = v & 15;
        unit<ABL>(bh >> 3, bh & 7, 31 - s, Q, KT, VT, O, shm, wv);
        unit<ABL>(bh >> 3, bh & 7, s, Q, KT, VT, O, shm, wv); }
}
}

namespace sba {
constexpr int KSLOT = 8192, VSLOT = 8192, NS = 3;
constexpr int L_K = 0, L_V = NS * KSLOT, L_WS = L_V + NS * VSLOT, L_FLAG = L_WS + 2048, L_OST = L_FLAG + 256, L_END = L_OST + 8 * 4096;
constexpr float SB_EXIT = 1.0e-42f;
__device__ __forceinline__ void unit(int b, int kh, int qb64, const bf16_t* Q, const bf16_t* KT, const bf16_t* VT, bf16_t* O, LAS unsigned char* shm, int wv) {
    int tid_ = wv * 64 + lane_id(); asm volatile("" : "+v"(tid_));
    const int tid = tid_, lane = tid & 63, r32 = lane & 31, hi = lane >> 5; const int wid = __builtin_amdgcn_readfirstlane(tid >> 6);
    const int h = kh * 4 + (wid >> 1), half = wid & 1;
    const long rowbase = (long)b * SEQL; const int q0 = qb64 * 64;
    const bf16_t* Qw = Q + (size_t)(rowbase + q0 + half * 32) * 1024 + h * 64;
    const bf16_t* Kh = KT + (size_t)((b * 4 + kh) * 128) * 4096 + wid * 512 + lane * 8;
    const bf16_t* Vh = VT + (size_t)((b * 4 + kh) * 128) * 4096 + wid * 512 + lane * 8;
    const unsigned lds0 = (unsigned)(uintptr_t)shm;
    LAS int* flags = (LAS int*)(shm + L_FLAG);
    const int NT = qb64 + 1;
#define SBA_DMA(k, sl) do { const int tile_ = qb64 - (k); \
        glds16(Kh + (size_t)tile_ * 4096, (unsigned)__builtin_amdgcn_readfirstlane(lds0 + L_K + (sl) * KSLOT + wid * 1024)); \
        glds16(Vh + (size_t)tile_ * 4096, (unsigned)__builtin_amdgcn_readfirstlane(lds0 + L_V + (sl) * VSLOT + wid * 1024)); } while (0)
    SBA_DMA(0, 0); if (NT > 1) SBA_DMA(1, 1);
    bf16x8 qr[4];
#pragma unroll
    for (int d0 = 0; d0 < 4; ++d0) qr[d0] = *(const bf16x8*)(Qw + (size_t)r32 * 1024 + d0 * 16 + hi * 8);
    float R = 1.f; f32x16 o[2];
#pragma unroll
    for (int r = 0; r < 16; ++r) { o[0][r] = 0.f; o[1][r] = 0.f; }
    const int qrel = half * 32 + r32;
    int slot = 0;
    for (int k = 0; k < NT; ++k) {
        if (k + 1 < NT) ATT_WAIT_BAR(2); else ATT_WAIT_BAR(0);
        if (k > 0) { const LAS int* f = flags + ((k - 1) & 1) * 8; int all = 1;
#pragma unroll
            for (int w = 0; w < 8; ++w) all &= f[w];
            if (all) break; }
        if (k + 2 < NT) { const int s2 = slot == 0 ? 2 : slot - 1; SBA_DMA(k + 2, s2); }
        {
            const lcp kb = (lcp)shm + L_K + slot * KSLOT + hi * 1024 + r32 * 16;
            f32x16 p0, p1;
#pragma unroll
            for (int r = 0; r < 16; ++r) { p0[r] = 0.f; p1[r] = 0.f; }
#pragma unroll
            for (int d0 = 0; d0 < 4; ++d0) { const bf16x8 b0 = *(const LAS bf16x8*)(kb + d0 * 2048), b1 = *(const LAS bf16x8*)(kb + d0 * 2048 + 512);
                p0 = __builtin_amdgcn_mfma_f32_32x32x16_bf16(b0, qr[d0], p0, 0, 0, 0); p1 = __builtin_amdgcn_mfma_f32_32x32x16_bf16(b1, qr[d0], p1, 0, 0, 0); }
            f32x16 N0, N1;
#pragma unroll
            for (int r = 0; r < 16; ++r) {
                const float e0 = fast_exp2(-__builtin_amdgcn_fmed3f(p0[r], -100.f, 100.f)), e1 = fast_exp2(-__builtin_amdgcn_fmed3f(p1[r], -100.f, 100.f));
                float b0 = fast_rcp(1.0f + e0), b1 = fast_rcp(1.0f + e1); float n0 = e0 * b0, n1 = e1 * b1;
                if (k == 0) { const int kv = crow(r, hi); if (kv >= qrel) { b0 = 0.f; n0 = 1.f; } if (kv + 32 >= qrel) { b1 = 0.f; n1 = 1.f; } }
                p0[r] = b0; p1[r] = b1; N0[r] = n0; N1[r] = n1; }
            float G[16];
#pragma unroll
            for (int j = 0; j < 8; ++j) { const f32x16& NN = j < 4 ? N0 : N1; const int rb = 4 * (j & 3);
                const float gp = (NN[rb] * NN[rb + 1]) * (NN[rb + 2] * NN[rb + 3]);
                auto rr = __builtin_amdgcn_permlane32_swap(__float_as_uint(gp), __float_as_uint(gp), false, false);
                G[2 * j] = __uint_as_float(rr[0]); G[2 * j + 1] = __uint_as_float(rr[1]); }
            float SG[16]; SG[15] = 1.f;
#pragma unroll
            for (int g = 14; g >= 0; --g) SG[g] = SG[g + 1] * G[g + 1];
            const float T = SG[0] * G[0];
#pragma unroll
            for (int j = 0; j < 8; ++j) { f32x16& NN = j < 4 ? N0 : N1; f32x16& PP = j < 4 ? p0 : p1; const int rb = 4 * (j & 3);
                const float base = (R * SG[2 * j + 1]) * (hi ? 1.f : G[2 * j + 1]);
                const float r3 = base, r2 = r3 * NN[rb + 3], r1 = r2 * NN[rb + 2], r0 = r1 * NN[rb + 1];
                PP[rb + 3] *= r3; PP[rb + 2] *= r2; PP[rb + 1] *= r1; PP[rb] *= r0; }
            R *= T;
            const u32x4 pw0 = {pk_bf16(p0[0], p0[1]), pk_bf16(p0[2], p0[3]), pk_bf16(p0[4], p0[5]), pk_bf16(p0[6], p0[7])};
            const u32x4 pw1 = {pk_bf16(p0[8], p0[9]), pk_bf16(p0[10], p0[11]), pk_bf16(p0[12], p0[13]), pk_bf16(p0[14], p0[15])};
            const u32x4 pw2 = {pk_bf16(p1[0], p1[1]), pk_bf16(p1[2], p1[3]), pk_bf16(p1[4], p1[5]), pk_bf16(p1[6], p1[7])};
            const u32x4 pw3 = {pk_bf16(p1[8], p1[9]), pk_bf16(p1[10], p1[11]), pk_bf16(p1[12], p1[13]), pk_bf16(p1[14], p1[15])};
            const lcp vp = (lcp)shm + L_V + slot * VSLOT + ((lane >> 4) & 1) * 32 + (lane & 3) * 8 + (4 * hi + ((lane & 15) >> 2)) * 64;
            pv(o, vp, pw0, pw1, pw2, pw3);
            const int dn = __all(R < SB_EXIT) ? 1 : 0;
            if (lane == 0) flags[(k & 1) * 8 + wid] = dn;
        }
        slot = slot == 2 ? 0 : slot + 1;
    }
#undef SBA_DMA
    ATT_WAIT_BAR(0);
    float one[16];
#pragma unroll
    for (int r = 0; r < 16; ++r) one[r] = 1.0f;
    store_o(o, one, shm + L_OST + wid * 4096, O + (size_t)(rowbase + q0 + half * 32) * 1024 + h * 64, 1024, lane, r32, hi);
    asm volatile("s_waitcnt lgkmcnt(0)\n\ts_barrier" ::: "memory");
}
__device__ __forceinline__ void phase(int vcu, int G, const bf16_t* Q, const bf16_t* KT, const bf16_t* VT, bf16_t* O, LAS unsigned char* shm, int wv) {
    for (int u = vcu * 4; u < 1024; u += G * 4)
        for (int i = 0; i < 4; ++i) { const int uu = u + i, qb64 = uu & 127, bk = uu >> 7; unit(bk >> 2, bk & 3, qb64, Q, KT, VT, O, shm, wv); }
}
}
}
namespace fw {
constexpr size_t MiB = 1u << 20;
constexpr int NWAVES = 8, NTHR = 512;
constexpr int MAXSLOT = 34816;
constexpr size_t WS_CTL = 0, CTL_ZERO_BYTES = 64 * 1024;
constexpr size_t WS_TOKE = 1 * MiB;
constexpr size_t WS_TOKG = WS_TOKE + 64 * 1024;
constexpr size_t WS_TOKRS = WS_TOKG + 128 * 1024;
constexpr size_t WS_SLOT12 = WS_TOKRS + 64 * 1024;
constexpr size_t WS_SLOTG = WS_SLOT12 + 128 * 1024;
constexpr size_t WS_SLOTRS = WS_SLOTG + 256 * 1024;
constexpr size_t WS_CNT = WS_SLOTRS + 256 * 1024;
constexpr size_t WS_PSTART = WS_CNT + 16 * 1024;
constexpr size_t WS_CS = 4 * MiB;
constexpr size_t WS_SSQ = 6 * MiB;
constexpr size_t WS_SSQQ = 8 * MiB;
constexpr size_t WS_SSQKV = WS_SSQQ + 512 * 1024;
constexpr size_t WS_KPE = 9 * MiB;
constexpr size_t WS_SSPE = 11 * MiB;
constexpr size_t WS_W = 16 * MiB;
constexpr size_t W_AIN = WS_W, W_QUP = W_AIN + 3 * MiB, W_KVUP = W_QUP + 2 * MiB, W_AOUT = W_KVUP + 1 * MiB, W_KVS = W_AOUT + 2 * MiB, W_QB = W_KVS + 1 * MiB,
                 W_OB = W_QB + 4 * MiB, W_PG = W_OB + 4 * MiB, W_PU = W_PG + 8 * MiB, W_FGU = W_PU + 2 * MiB, W_FDN = W_FGU + 22 * MiB, W_EGU = W_FDN + 11 * MiB,
                 W_EDN = W_EGU + 176 * MiB, W_END = W_EDN + 88 * MiB;
constexpr size_t WS_PB = W_END;
constexpr size_t WS_HB = WS_PB + 32 * MiB;
constexpr size_t WS_U = WS_HB + 64 * MiB;
constexpr size_t WS_SKT = WS_U + 128 * MiB, WS_SVT = WS_SKT + 8 * MiB;
constexpr size_t WS_X = WS_SVT + 8 * MiB;
constexpr size_t X_AQ = WS_X, X_AKV = X_AQ + 12 * MiB, X_QRAW = X_AKV + 8 * MiB, X_KVRAW = X_QRAW + 24 * MiB, X_Q = X_KVRAW + 32 * MiB, X_KT = X_Q + 24 * MiB, X_VT = X_KT + 24 * MiB, X_O = X_VT + 16 * MiB;
constexpr size_t X_SQ = WS_X, X_SO = X_SQ + 32 * MiB;
constexpr size_t X_HID = WS_X;
constexpr size_t X_XG = WS_X, X_HG = X_XG + 68 * MiB, X_YG = X_HG + 187 * MiB, X_END = X_YG + 68 * MiB;
constexpr size_t WS_END = X_END;
static_assert(X_O + 16 * MiB <= X_END && (size_t)MAXSLOT * 2816 * 2 <= 187 * MiB && (size_t)MAXSLOT * 1024 * 2 <= 68 * MiB, "ws map");
constexpr int CW_BAR = 1024;
constexpr int RING_OFF = 0, RING_BYTES = 131072, LDSCTL_OFF = RING_BYTES, MISC_OFF = LDSCTL_OFF + 320, XS_OFF = LDSCTL_OFF + 1024  , LDS_BYTES = 147456;
static_assert(att::mla::L_END <= RING_BYTES && att::sba::L_END <= RING_BYTES, "attention LDS");
constexpr float QSCALE_MLA = 0.10206207261596577f * LOG2E;
constexpr float QSCALE_SB = 0.125f * LOG2E;

struct EpiQ {
    static constexpr bool PERM = true, AFTER_DRAIN = false;
    unsigned char* ws; const float* gq;
    __device__ __forceinline__ void operator()(const f32x4 (&acc)[2][2][4][2], const pg8::Unit& u, int wr, int wc, int fr_, int fq_) const {
        const int ln_ = lane_id(), fr = ln_ & 15, fq = ln_ >> 4; (void)fr_; (void)fq_;
        const int row0 = u.pm * pg8::BM + wr * 64 + fr, c = wc * 32 + 8 * fq;
        LAS float* xs = (LAS float*)(uintptr_t)XS_OFF;
        bf16_t* Q = (bf16_t*)(ws + X_Q); const float* CS = (const float*)(ws + WS_CS); const pg8::RowScale rs{(const float*)(ws + WS_SSQQ), 3}; const float qscale = QSCALE_MLA;
        float rsv[2][4]; rs.get8(rsv, row0, fq);
#pragma unroll
        for (int ai = 0; ai < 2; ++ai)
#pragma unroll
            for (int m = 0; m < 4; ++m) { const int rl = ai * pg8::HALF + wr * 64 + m * 16 + fr; const float s = rsv[ai][m];
#pragma unroll
                for (int bj = 0; bj < 2; ++bj) { const float q = pg8::red_fq(pg8::sumsq8(acc[ai][bj][m][0], acc[ai][bj][m][1])) * (s * s); if (fq == 0) xs[(rl * 2 + bj) * 4 + wc] = q; }
                asm volatile("" ::: "memory"); }
        asm volatile("s_waitcnt lgkmcnt(0)" ::: "memory"); __builtin_amdgcn_s_barrier(); asm volatile("" ::: "memory");
        const int cg = wc < 3 ? c : 0;
#pragma unroll
        for (int ai = 0; ai < 2; ++ai)
#pragma unroll
            for (int m = 0; m < 4; ++m) { const int rl = ai * pg8::HALF + wr * 64 + m * 16 + fr, row = row0 + ai * pg8::HALF + m * 16;
                const f32x4 g0 = *(const f32x4*)(gq + cg), g1 = *(const f32x4*)(gq + cg + 4);
#pragma unroll
                for (int bj = 0; bj < 2; ++bj) { const f32x4 p4 = *(const LAS f32x4*)(xs + (rl * 2 + bj) * 4);
                    const float ss = (p4[0] + p4[1]) + (p4[2] + p4[3]); const float sc = rsv[ai][m] * (1.0f / sqrtf(ss * (1.0f / 96.0f) + RMS_EPS)) * qscale;
                    f32x4 v0 = acc[ai][bj][m][0] * g0 * sc, v1 = acc[ai][bj][m][1] * g1 * sc;
                    if (wc == 2) pg8::rope8(v0, v1, CS + (size_t)row * 32, fq);
                    if (wc < 3) *(u32x4*)(Q + (size_t)row * 768 + (2 * u.pn + bj) * 96 + c) = pack8(v0, v1); }
                asm volatile("" ::: "memory"); }
    }
};
struct EpiKV {
    static constexpr bool PERM = true, AFTER_DRAIN = false;
    unsigned char* ws; const float* gk;
    __device__ __forceinline__ void operator()(const f32x4 (&acc)[2][2][4][2], const pg8::Unit& u, int wr, int wc, int fr_, int fq_) const {
        const int ln_ = lane_id(), fr = ln_ & 15, fq = ln_ >> 4; (void)fr_; (void)fq_;
        const int row0 = u.pm * pg8::BM + wr * 64 + fr, c = (wc & 1) * 32 + 8 * fq;
        LAS float* xs = (LAS float*)(uintptr_t)XS_OFF;
        bf16_t* KT = (bf16_t*)(ws + X_KT); bf16_t* VT = (bf16_t*)(ws + X_VT); const float* KPE = (const float*)(ws + WS_KPE); const float* SSPE = (const float*)(ws + WS_SSPE); const pg8::RowScale rs{(const float*)(ws + WS_SSQKV), 4};
        float rsv[2][4]; rs.get8(rsv, row0, fq);
#pragma unroll
        for (int ai = 0; ai < 2; ++ai)
#pragma unroll
            for (int m = 0; m < 4; ++m) { const int rl = ai * pg8::HALF + wr * 64 + m * 16 + fr; const float s = rsv[ai][m];
#pragma unroll
                for (int bj = 0; bj < 2; ++bj) { const float q = pg8::red_fq(pg8::sumsq8(acc[ai][bj][m][0], acc[ai][bj][m][1])) * (s * s); if (fq == 0 && wc < 2) xs[(rl * 2 + bj) * 2 + wc] = q; }
                asm volatile("" ::: "memory"); }
        asm volatile("s_waitcnt lgkmcnt(0)" ::: "memory"); __builtin_amdgcn_s_barrier(); asm volatile("" ::: "memory");
#pragma unroll
        for (int ai = 0; ai < 2; ++ai)
#pragma unroll
            for (int m = 0; m < 4; ++m) { const int rl = ai * pg8::HALF + wr * 64 + m * 16 + fr, row = row0 + ai * pg8::HALF + m * 16; const float s = rsv[ai][m];
                const f32x4 g0 = *(const f32x4*)(gk + c), g1 = *(const f32x4*)(gk + c + 4);
                const int b = row >> 13, sq = row & 8191, tile = sq >> 6, rr = sq & 63;
                const f32x4 k0 = *(const f32x4*)(KPE + (size_t)row * 32 + 8 * fq), k1 = *(const f32x4*)(KPE + (size_t)row * 32 + 8 * fq + 4);
                const float sspe = SSPE[row];
#pragma unroll
                for (int bj = 0; bj < 2; ++bj) { const int h = 2 * u.pn + bj; const size_t tb = (size_t)((b * 8 + h) * 128 + tile);
                    const float ssn = xs[(rl * 2 + bj) * 2] + xs[(rl * 2 + bj) * 2 + 1];
                    const float rk = 1.0f / sqrtf((ssn + sspe) * (1.0f / 96.0f) + RMS_EPS);
                    if (wc < 2) *(u32x4*)(KT + tb * 6144 + (c >> 3) * 512 + rr * 8) = pack8(acc[ai][bj][m][0] * g0 * (s * rk), acc[ai][bj][m][1] * g1 * (s * rk));
                    else *(u32x4*)(VT + tb * 4096 + (wc - 2) * 2048 + rr * 32 + 8 * fq) = pack8(acc[ai][bj][m][0] * s, acc[ai][bj][m][1] * s);
                    if (wc == 2) *(u32x4*)(KT + tb * 6144 + (8 + fq) * 512 + rr * 8) = pack8(k0 * rk, k1 * rk); }
                asm volatile("" ::: "memory"); }
    }
};
constexpr int PH_PER_LAYER = 12, PH_TOTAL = 2 + 4 * PH_PER_LAYER;
__host__ __device__ inline bool phase_active(int idx) {
    if (idx < 2) return true;
    const int l = (idx - 2) / PH_PER_LAYER, s = (idx - 2) % PH_PER_LAYER; const bool mla = l < 2, moe = (l & 1) != 0;
    if (s == 1 || s == 3) return mla;
    if (s == 2) return false;
    if (s >= 7 && s <= 9) return moe;
    if (s == 11) return l == 1;
    return true;
}

struct Args { const float* in[26]; float* out; unsigned char* ws; int ph_lo, ph_hi; };

struct Frame { LAS unsigned char* lds; int tid, lane, wave, vcu, G; };

__device__ __forceinline__ float shx(float v, int k, int lane) { return __uint_as_float((unsigned)__builtin_amdgcn_ds_bpermute((lane ^ k) << 2, (int)__float_as_uint(v))); }
__device__ __forceinline__ int shi(int v, int src, int lane) { (void)lane; return __builtin_amdgcn_ds_bpermute(src << 2, v); }
__device__ __forceinline__ float wave_sum(float v, int lane) {
#pragma unroll
    for (int o = 1; o < 64; o <<= 1) v += shx(v, o, lane);
    return v;
}
template <bool NT> __device__ __forceinline__ void transpose_item(const float* W, int ldw, int sca, int scb, const float* gain, bf16_t* WT, int K, int drow0, int k0, LAS float* scr, int lane) {
    const int r8 = lane >> 3, pc = lane & 7, c = lane & 7;
    f32x4 va[8], vb[8]; float g[8];
    const f32x4 z4 = {0.f, 0.f, 0.f, 0.f};
#pragma unroll
    for (int i = 0; i < 8; ++i) { const float* rp = W + (size_t)(k0 + i * 8 + r8) * ldw + 4 * pc;
        if (NT) { va[i] = sca >= 0 ? __builtin_nontemporal_load((const f32x4*)(rp + sca)) : z4; vb[i] = scb >= 0 ? __builtin_nontemporal_load((const f32x4*)(rp + scb)) : z4; }
        else { va[i] = sca >= 0 ? *(const f32x4*)(rp + sca) : z4; vb[i] = scb >= 0 ? *(const f32x4*)(rp + scb) : z4; }
        g[i] = gain ? gain[k0 + i * 8 + r8] : 1.0f; }
#pragma unroll
    for (int hf = 0; hf < 2; ++hf) {
#pragma unroll
        for (int i = 0; i < 8; ++i) { const f32x4 v = (hf == 0 ? va[i] : vb[i]) * g[i]; LAS float* d = scr + (i * 8 + r8) * 33 + 4 * pc; d[0] = v[0]; d[1] = v[1]; d[2] = v[2]; d[3] = v[3]; }
        asm volatile("s_waitcnt lgkmcnt(0)" ::: "memory");
#pragma unroll
        for (int j = 0; j < 4; ++j) { const int n = (lane >> 3) + 8 * j; const LAS float* s = scr + (8 * c) * 33 + n;
            u32x4 o; o.x = pk_bf16(s[0 * 33], s[1 * 33]); o.y = pk_bf16(s[2 * 33], s[3 * 33]); o.z = pk_bf16(s[4 * 33], s[5 * 33]); o.w = pk_bf16(s[6 * 33], s[7 * 33]);
            if (NT) __builtin_nontemporal_store(o, (u32x4*)(WT + (size_t)(drow0 + hf * 32 + n) * K + k0 + 8 * c)); else *(u32x4*)(WT + (size_t)(drow0 + hf * 32 + n) * K + k0 + 8 * c) = o; }
        asm volatile("s_waitcnt lgkmcnt(0)" ::: "memory");
    }
}
struct Fam { int src, count, K, Nd, ldw, map, gain, gstride; size_t sstride, dst, dstride; };
__device__ __forceinline__ int fam_items(const Fam& f) { return f.count * (f.K / 64) * (f.Nd / 64); }
__device__ __forceinline__ int fam_src_col(int map, int n0) {
    if (map == 1) return n0 < 384 ? n0 : (n0 < 416 ? 640 + (n0 - 384) : (n0 < 512 ? -1 : 384 + (n0 - 512)));
    if (map == 2) { const int pn = n0 >> 8, jj = n0 & 255; return jj < 128 ? pn * 128 + jj : 2816 + pn * 128 + (jj - 128); }
    if (map == 3) { const int h = n0 >> 7, off = n0 & 127; return off < 96 ? 96 * h + off : -1; }
    return n0;
}
template <bool NT = false> __device__ __forceinline__ void fam_item(const Args& a, const Fam& f, int fid, int it, LAS float* scr, int lane, int mi_off = 0) {
    const int per = (f.K / 64) * (f.Nd / 64), mi = it / per + mi_off, r = it % per, nblk = f.Nd / 64, kb = r / nblk, nb = r % nblk, n0 = nb * 64;
    const float* gain = nullptr;
    if (f.gain >= 0) gain = a.in[f.gain] + (fid == 11 ? (size_t)(2 * (mi >> 3) + 1) * 1024 : (size_t)mi * f.gstride);
    transpose_item<NT>(a.in[f.src] + (size_t)mi * f.sstride, f.ldw, fam_src_col(f.map, n0), fam_src_col(f.map, n0 + 32), gain, (bf16_t*)(a.ws + f.dst + (size_t)mi * f.dstride), f.K, n0, kb * 64, scr, lane);
}
__constant__ const Fam FAMS[13] = {
        {4, 2, 1024, 768, 672, 1, 3, 1024, (size_t)1024 * 672, W_AIN, (size_t)768 * 1024 * 2},
        {7, 2, 384, 1024, 768, 3, 5, 384, (size_t)384 * 768, W_QUP, (size_t)1024 * 384 * 2},
        {8, 2, 256, 1024, 1024, 0, 6, 256, (size_t)256 * 1024, W_KVUP, (size_t)1024 * 256 * 2},
        {11, 2, 512, 1024, 1024, 0, -1, 0, (size_t)512 * 1024, W_AOUT, (size_t)1024 * 512 * 2},
        {13, 1, 1024, 512, 512, 0, 12, 0, 0, W_KVS, 0},
        {15, 2, 1024, 1024, 1024, 0, 14, 1024, (size_t)1024 * 1024, W_QB, (size_t)1024 * 1024 * 2},
        {16, 2, 1024, 1024, 1024, 0, -1, 0, (size_t)1024 * 1024, W_OB, (size_t)1024 * 1024 * 2},
        {24, 4, 1024, 1024, 1024, 0, 23, 1024, (size_t)1024 * 1024, W_PG, (size_t)1024 * 1024 * 2},
        {25, 4, 256, 1024, 1024, 0, -1, 0, (size_t)256 * 1024, W_PU, (size_t)1024 * 256 * 2},
        {18, 1, 1024, 5632, 5632, 2, 17, 2048, (size_t)1024 * 5632, W_FGU, (size_t)5632 * 1024 * 2},
        {19, 1, 2816, 1024, 1024, 0, -1, 0, (size_t)2816 * 1024, W_FDN, (size_t)1024 * 2816 * 2},
        {21, 8, 1024, 5632, 5632, 2, 17, 0, (size_t)1024 * 5632, W_EGU, (size_t)5632 * 1024 * 2},
        {22, 8, 2816, 1024, 1024, 0, -1, 0, (size_t)2816 * 1024, W_EDN, (size_t)1024 * 2816 * 2}};
constexpr int DEF_N0 = 1408, DEF_N1 = DEF_N0 + 704, DEF_N2 = DEF_N1 + 11264, DEF_N3 = DEF_N2 + 5632;
#ifndef FILL_A
#define FILL_A 0
#define FILL_B 0
#define FILL_C 0
#define FILL_D 0
#endif
constexpr int DEF_QA = FILL_A, DEF_QB = DEF_QA + FILL_B, DEF_QC = DEF_QB + FILL_C, DEF_QD = DEF_QC + FILL_D;
constexpr int CW_FILL = 512;
__device__ __forceinline__ void prologue(const Args& a, Frame& F) {
    LAS float* scr = (LAS float*)(F.lds + RING_OFF + F.wave * 16384);
    const int gw = F.vcu * NWAVES + F.wave, NGW = F.G * NWAVES;
    int base = 0;
#pragma unroll 1
    for (int fid = 0; fid < 13; ++fid) { const Fam f = FAMS[fid]; const int n = fam_items(f);
        int it = gw - (base % NGW); if (it < 0) it += NGW;
#pragma unroll 1
        for (; it < n; it += NGW) fam_item(a, f, fid, it, scr, F.lane);
        base += n; }
    for (int id = DEF_QD + gw; id < DEF_N3; id += NGW) {
        if (id < DEF_N0) fam_item(a, FAMS[9], 9, id, scr, F.lane, 1);
        else if (id < DEF_N1) fam_item(a, FAMS[10], 10, id - DEF_N0, scr, F.lane, 1);
        else if (id < DEF_N2) fam_item(a, FAMS[11], 11, id - DEF_N1, scr, F.lane, 8);
        else fam_item(a, FAMS[12], 12, id - DEF_N2, scr, F.lane, 8);
    }
    { const f32x4* src = (const f32x4*)a.in[1]; u32x2* dst = (u32x2*)(a.ws + WS_PB); const size_t n4 = (size_t)4 * MT * 256 / 4, S = (size_t)NGW * 64;
        for (size_t i = (size_t)gw * 64 + F.lane; i < n4; i += 4 * S) { f32x4 v[4];
#pragma unroll
            for (int q = 0; q < 4; ++q) v[q] = (i + q * S < n4) ? src[i + q * S] : (f32x4){0.f, 0.f, 0.f, 0.f};
#pragma unroll
            for (int q = 0; q < 4; ++q) if (i + q * S < n4) { u32x2 o; o.x = pk_bf16(v[q][0], v[q][1]); o.y = pk_bf16(v[q][2], v[q][3]); dst[i + q * S] = o; } } }
    { bf16_t* HB = (bf16_t*)(a.ws + WS_HB); float* SSQ = (float*)(a.ws + WS_SSQ);
        for (int row = gw; row < MT; row += NGW) { const f32x4* xr = (const f32x4*)(a.in[0] + (size_t)row * DMODEL) + F.lane;
            u32x2* hb = (u32x2*)(HB + (size_t)row * DMODEL) + F.lane; float s = 0.f; f32x4 v4[4];
#pragma unroll
            for (int j = 0; j < 4; ++j) v4[j] = xr[64 * j];
#pragma unroll
            for (int j = 0; j < 4; ++j) { const f32x4 v = v4[j]; u32x2 o; o.x = pk_bf16(v[0], v[1]); o.y = pk_bf16(v[2], v[3]); hb[64 * j] = o; s += (v[0] * v[0] + v[1] * v[1]) + (v[2] * v[2] + v[3] * v[3]); }
            s = wave_sum(s, F.lane); if (F.lane < 16) SSQ[(size_t)row * 16 + F.lane] = F.lane == 0 ? s : 0.f; } }
    { float* cs = (float*)(a.ws + WS_CS); const int* pos = (const int*)a.in[2];
        for (int i = gw * 64 + F.lane; i < MT * 16; i += NGW * 64) { const int row = i >> 4, f = i & 15;
            const float invf = (float)exp(-9.210340371976184 * (double)f / 16.0);
            const double ang = (double)((float)pos[row] * invf);
            const double rev = ang * 0.15915494309189535, fr = rev - rint(rev); const float x = (float)(fr * 6.283185307179586);
            cs[(size_t)row * 32 + f] = cosf(x); cs[(size_t)row * 32 + 16 + f] = sinf(x); } }
}
#define THIN_LAUNDER() Frame F = F_; unsigned char* wsl = a.ws; F.lane = lane_id(); F.tid = F.wave * 64 + F.lane; asm volatile("" : "+v"(F.tid), "+v"(F.lane), "+s"(F.vcu), "+s"(F.G), "+s"(wsl))
__device__ __forceinline__ void filler(const Args& a, const Frame& F_, int qi, int start, int end) {
    Frame F = F_; { int t_ = F_.wave * 64 + lane_id(); asm volatile("" : "+v"(t_)); F.tid = t_; F.lane = t_ & 63; }
    unsigned char* wsl = a.ws; asm volatile("" : "+s"(wsl));
    LAS float* scr = (LAS float*)(F.lds + RING_OFF + F.wave * 16384);
    unsigned* ctr = (unsigned*)(wsl + WS_CTL) + CW_FILL + qi;
    for (;;) {
        int id = 0; if (F.lane == 0) id = (int)__hip_atomic_fetch_add(ctr, 1u, __ATOMIC_RELAXED, __HIP_MEMORY_SCOPE_AGENT) + start;
        id = __builtin_amdgcn_readfirstlane(id);
        if (id >= end) break;
        if (id < DEF_N0) fam_item<true>(a, FAMS[9], 9, id, scr, F.lane, 1);
        else if (id < DEF_N1) fam_item<true>(a, FAMS[10], 10, id - DEF_N0, scr, F.lane, 1);
        else if (id < DEF_N2) fam_item<true>(a, FAMS[11], 11, id - DEF_N1, scr, F.lane, 8);
        else fam_item<true>(a, FAMS[12], 12, id - DEF_N2, scr, F.lane, 8);
    }
}
__device__ __forceinline__ void moe_route(const Args& a, const Frame& F_, int layer, int cur) { THIN_LAUNDER();
    const bf16_t* HB = (const bf16_t*)(wsl + WS_HB) + (size_t)cur * MT * DMODEL; const float* gain = a.in[17] + (size_t)layer * 1024; const float* wr = a.in[20] + (size_t)(layer >> 1) * 1024 * 8;
    int* TOKE = (int*)(wsl + WS_TOKE); float* TOKG = (float*)(wsl + WS_TOKG); float* TOKRS = (float*)(wsl + WS_TOKRS); int* CNT = (int*)(wsl + WS_CNT);
    constexpr int LDW = 1032;
    LAS bf16_t* WB = (LAS bf16_t*)(F.lds + RING_OFF);
    LAS int* lcnt = (LAS int*)(F.lds + RING_OFF + 36864);
    LAS float* LG = (LAS float*)(F.lds + RING_OFF + 37888) + F.wave * 128;
    for (int i = F.tid; i < 1024 * 8; i += NTHR) { const int k = i >> 3, e = i & 7; const float x = wr[i] * gain[k];
        const unsigned hi = pk_bf16(x, 0.f) & 0xffffu; const float lo = x - __uint_as_float(hi << 16);
        WB[e * LDW + k] = (bf16_t)hi; WB[(8 + e) * LDW + k] = (bf16_t)(pk_bf16(lo, 0.f) & 0xffffu); }
    const int n = F.lane & 15, q = F.lane >> 4;
    for (int chunk = F.vcu; chunk < MT / 64; chunk += F.G) {
        if (F.tid < 8) lcnt[F.tid] = 0;
        __syncthreads();
        if (F.wave < 4) {
            const int tok0 = chunk * 64 + F.wave * 16;
            const bf16_t* arow = HB + (size_t)(tok0 + n) * DMODEL + 8 * q; const LAS bf16_t* brow = WB + n * LDW + 8 * q;
            f32x4 acc = {0.f, 0.f, 0.f, 0.f}; float ss = 0.f;
#pragma unroll 8
            for (int s = 0; s < 32; ++s) { const u32x4 av = *(const u32x4*)(arow + 32 * s); const bf16x8 bv = *(const LAS bf16x8*)(brow + 32 * s);
                acc = __builtin_amdgcn_mfma_f32_16x16x32_bf16(__builtin_bit_cast(bf16x8, av), bv, acc, 0, 0, 0);
                f32x4 x0, x1; unpack8(av, x0, x1); ss += pg8::sumsq8(x0, x1); }
            ss = pg8::red_fq(ss);
#pragma unroll
            for (int i = 0; i < 4; ++i) { const float v = acc[i] + shx(acc[i], 8, F.lane); if (n < 8) LG[(4 * q + i) * 8 + n] = v; }
            asm volatile("s_waitcnt lgkmcnt(0)" ::: "memory");
            if (F.lane < 16) { const int tok = tok0 + F.lane; const LAS f32x4* lp = (const LAS f32x4*)(LG + F.lane * 8); const f32x4 l0 = lp[0], l1 = lp[1];
                const float lg[8] = {l0[0], l0[1], l0[2], l0[3], l1[0], l1[1], l1[2], l1[3]};
                const float r = 1.0f / sqrtf(ss * (1.0f / 1024.0f) + RMS_EPS);
                int e1 = 0; float v1 = lg[0];
#pragma unroll
                for (int e = 1; e < 8; ++e) if (lg[e] > v1) { v1 = lg[e]; e1 = e; }
                int e2 = 0; float v2 = -3.0e38f;
#pragma unroll
                for (int e = 0; e < 8; ++e) if (e != e1 && lg[e] > v2) { v2 = lg[e]; e2 = e; }
                const float p2 = __expf((v2 - v1) * r), g1 = 1.0f / (1.0f + p2), g2 = p2 / (1.0f + p2);
                TOKE[tok] = e1 | (e2 << 8); TOKG[tok * 2] = g1; TOKG[tok * 2 + 1] = g2; TOKRS[tok] = r;
                __hip_atomic_fetch_add(lcnt + e1, 1, __ATOMIC_RELAXED, __HIP_MEMORY_SCOPE_WORKGROUP); __hip_atomic_fetch_add(lcnt + e2, 1, __ATOMIC_RELAXED, __HIP_MEMORY_SCOPE_WORKGROUP); }
        }
        __syncthreads();
        if (F.tid < 8) CNT[chunk * 8 + F.tid] = lcnt[F.tid];
        __syncthreads();
    }
}
__device__ __forceinline__ void moe_scatter(const Args& a, const Frame& F_, int cur) { THIN_LAUNDER();
    const int* TOKE = (const int*)(wsl + WS_TOKE); const float* TOKG = (const float*)(wsl + WS_TOKG); const float* TOKRS = (const float*)(wsl + WS_TOKRS); const int* CNT = (const int*)(wsl + WS_CNT);
    int* SLOT12 = (int*)(wsl + WS_SLOT12); float* SLOTG = (float*)(wsl + WS_SLOTG); float* SLOTRS = (float*)(wsl + WS_SLOTRS); int* PSTART = (int*)(wsl + WS_PSTART);
    const bf16_t* HB = (const bf16_t*)(wsl + WS_HB) + (size_t)cur * MT * DMODEL; bf16_t* XG = (bf16_t*)(wsl + X_XG);
    LAS int* sm = (LAS int*)(F.lds + RING_OFF);
    for (int chunk = F.vcu; chunk < MT / 64; chunk += F.G) {
        { const int e = F.wave; int c4[4]; int s = 0;
#pragma unroll
            for (int i = 0; i < 4; ++i) { c4[i] = CNT[(4 * F.lane + i) * 8 + e]; s += c4[i]; }
            int inc = s;
#pragma unroll
            for (int o = 1; o < 64; o <<= 1) { const int t = shi(inc, F.lane >= o ? F.lane - o : F.lane, F.lane); if (F.lane >= o) inc += t; }
            const int total = shi(inc, 63, F.lane); int pre = inc - s;
            if (F.lane == (chunk >> 2)) { const int cm = chunk & 3; pre += (cm > 0 ? c4[0] : 0) + (cm > 1 ? c4[1] : 0) + (cm > 2 ? c4[2] : 0); sm[8 + e] = pre; }
            if (F.lane == 0) sm[e] = total; }
        __syncthreads();
        if (F.tid == 0) { int p = 0; for (int e = 0; e < 8; ++e) { sm[16 + e] = p; p += (sm[e] + 255) >> 8; } sm[24] = p; }
        __syncthreads();
        if (F.tid < 9) PSTART[F.tid] = sm[16 + F.tid];
        if (F.wave == 0) { const int tok = chunk * 64 + F.lane; const int ev = TOKE[tok], e1 = ev & 255, e2 = ev >> 8; int s1 = 0, s2 = 0;
            const unsigned long long below = (1ull << F.lane) - 1ull;
#pragma unroll
            for (int e = 0; e < 8; ++e) { const unsigned long long m1 = __ballot(e1 == e), m2 = __ballot(e2 == e);
                const int rank = __popcll(m1 & below) + __popcll(m2 & below), slot = sm[16 + e] * 256 + sm[8 + e] + rank;
                if (e1 == e) s1 = slot; if (e2 == e) s2 = slot; }
            SLOT12[tok * 2] = s1; SLOT12[tok * 2 + 1] = s2; const float r = TOKRS[tok];
            SLOTG[s1] = TOKG[tok * 2]; SLOTG[s2] = TOKG[tok * 2 + 1]; SLOTRS[s1] = r; SLOTRS[s2] = r;
            sm[32 + 2 * F.lane] = s1; sm[32 + 2 * F.lane + 1] = s2; }
        __syncthreads();
        for (int i = 0; i < 16; ++i) { const int pr = F.wave * 16 + i, tok = chunk * 64 + (pr >> 1), slot = sm[32 + pr];
            const u32x4* src = (const u32x4*)(HB + (size_t)tok * DMODEL) + F.lane; u32x4* dst = (u32x4*)(XG + (size_t)slot * DMODEL) + F.lane;
            dst[0] = src[0]; dst[64] = src[64]; }
        __syncthreads();
    }
}
__device__ __forceinline__ void moe_combine(const Args& a, const Frame& F_, int cur, bool dummy) { THIN_LAUNDER();
    const int* SLOT12 = (const int*)(wsl + WS_SLOT12); const bf16_t* YG = (const bf16_t*)(wsl + X_YG);
    const bf16_t* HBi = (const bf16_t*)(wsl + WS_HB) + (size_t)cur * MT * DMODEL;
    bf16_t* HB = dummy ? (bf16_t*)(wsl + WS_END + 66 * MiB) : (bf16_t*)(wsl + WS_HB) + (size_t)cur * MT * DMODEL; float* SSQ = dummy ? (float*)(wsl + WS_END + 99 * MiB) : (float*)(wsl + WS_SSQ) + (size_t)cur * MT * 16;
    const int gw = F.vcu * NWAVES + F.wave, NGW = F.G * NWAVES;
    for (int row = gw; row < MT; row += NGW) { const int s1 = SLOT12[row * 2], s2 = SLOT12[row * 2 + 1];
        const u32x2* hr = (const u32x2*)(HBi + (size_t)row * DMODEL) + F.lane; u32x2* hb = (u32x2*)(HB + (size_t)row * DMODEL) + F.lane;
        const u32x2* y1 = (const u32x2*)(YG + (size_t)s1 * DMODEL) + F.lane; const u32x2* y2 = (const u32x2*)(YG + (size_t)s2 * DMODEL) + F.lane; float s = 0.f;
        u32x2 hv[4], pv_[4], qv[4];
#pragma unroll
        for (int j = 0; j < 4; ++j) { hv[j] = hr[64 * j]; pv_[j] = y1[64 * j]; qv[j] = y2[64 * j]; }
#pragma unroll
        for (int j = 0; j < 4; ++j) { const u32x2 h = hv[j], p = pv_[j], q = qv[j]; f32x4 v;
            v[0] = bf_lo(h.x) + (bf_lo(p.x) + bf_lo(q.x)); v[1] = bf_hi(h.x) + (bf_hi(p.x) + bf_hi(q.x)); v[2] = bf_lo(h.y) + (bf_lo(p.y) + bf_lo(q.y)); v[3] = bf_hi(h.y) + (bf_hi(p.y) + bf_hi(q.y));
            u32x2 o; o.x = pk_bf16(v[0], v[1]); o.y = pk_bf16(v[2], v[3]); hb[64 * j] = o; s += (v[0] * v[0] + v[1] * v[1]) + (v[2] * v[2] + v[3] * v[3]); }
        s = wave_sum(s, F.lane); if (F.lane < 16) SSQ[(size_t)row * 16 + F.lane] = F.lane == 0 ? s : 0.f; }
}

__global__ void __launch_bounds__(NTHR, 2) yoco_fwd(Args args) {
    extern __shared__ __attribute__((aligned(16))) unsigned char lds_raw[];
    Frame F; F.lds = (LAS unsigned char*)lds_raw;
    volatile LAS unsigned* MISC = (volatile LAS unsigned*)(F.lds + MISC_OFF);
    F.wave = __builtin_amdgcn_readfirstlane((int)threadIdx.x >> 6); F.lane = lane_id(); F.tid = F.wave * 64 + F.lane;
    F.G = gridDim.x; { const int bx = blockIdx.x; F.vcu = (F.G % 8 == 0) ? (bx % 8) * (F.G / 8) + bx / 8 : bx; }
    for (int u = F.tid; u < (LDS_BYTES - LDSCTL_OFF) / 4; u += NTHR) ((LAS unsigned*)(F.lds + LDSCTL_OFF))[u] = 0u;
    __syncthreads();
    unsigned char* ws = args.ws;
#define WS_LAUNDER() do { F.lane = lane_id(); F.tid = F.wave * 64 + F.lane; asm volatile("" : "+s"(ws), "+s"(bx), "+s"(F.G), "+s"(F.vcu), "+v"(F.tid), "+v"(F.lane)); } while (0)
    const bool single = (args.ph_hi - args.ph_lo) > 1;
    XcdBarrier bar; bar.bar = (unsigned*)(ws + WS_CTL) + CW_BAR; bar.x = 0; bar.st = nullptr; bar.wv = F.wave;
    if (single) bar = xcd_barrier_post((unsigned*)(ws + WS_CTL) + CW_BAR, MISC + 8, F.wave);
    const int lo = args.ph_lo, hi = args.ph_hi;
#ifndef GU_ALIGN
#define GU_ALIGN true
#endif
#ifndef EN_MASK
#define EN_MASK 0xFFFFFFFFu
#endif
#define EN(b) (((EN_MASK) >> (b)) & 1u)
#define IN(k) (lo <= (k) && (k) < hi)
#ifdef REP_MASK
#define NREPS(k) ((((unsigned long long)(REP_MASK) >> (k)) & 1ull) ? (REP_N) + 1 : 1)
#else
#define NREPS(k) 1
#endif
#define REPLOOP(k) for (int rep_ = 0, nrep_ = NREPS(k); rep_ < nrep_; ++rep_)
#define DUMMY (rep_ + 1 < nrep_)
#define OUT_HB(set) (DUMMY ? (bf16_t*)(ws + WS_END + 66 * MiB) : (bf16_t*)(ws + WS_HB) + (size_t)(set) * MT * DMODEL)
#define OUT_SSQ(set) (DUMMY ? (float*)(ws + WS_END + 99 * MiB) : (float*)(ws + WS_SSQ) + (size_t)(set) * MT * 16)
#define SEAM(k) do { if (single && (k) + 1 < hi) { XcdBarrier b_ = bar; asm volatile("" : "+s"(b_.bar), "+s"(b_.x)); xcd_barrier(b_); } } while (0)

    LAS unsigned char* ring = F.lds + RING_OFF;
    int bx = (int)blockIdx.x;

    if (EN(0) && IN(0)) REPLOOP(0) { WS_LAUNDER(); prologue(args, F); SEAM(0); }
    if (EN(1) && IN(1)) REPLOOP(1) { WS_LAUNDER();
#pragma unroll 1
        for (int i = 0; i < 4; ++i) {
            pg8::Gemm g{(const bf16_t*)(ws + WS_PB) + (size_t)i * MT * 256, (const bf16_t*)(ws + W_PU) + (size_t)i * 1024 * 256, MT, 1024, 256};
            pg8::StaticOrder S; S.init(MT, 1024, F.G, bx);
            pg8::EpiScale E{(bf16_t*)(ws + WS_U) + (size_t)i * MT * DMODEL, 1024, pg8::RowScale{nullptr, 0}, 1.0f};
            pg8::gemm_phase<pg8::EpiScale, pg8::StaticOrder, true, true>(ring, g, S, E, F.wave);
        }
        SEAM(1);
    }
#ifdef EXTRA_BARRIERS
    if (single) for (int xb_ = 0; xb_ < EXTRA_BARRIERS; ++xb_) { XcdBarrier b_ = bar; asm volatile("" : "+s"(b_.bar), "+s"(b_.x)); xcd_barrier(b_); }
#endif
#pragma unroll 1
    for (int l = 0; l < 4; ++l) {
        const int base = 2 + PH_PER_LAYER * l; const bool is_mla = l < 2, is_moe = (l & 1) != 0; const int cur = l & 1, j = l & 1;
#define HBc ((const bf16_t*)(ws + WS_HB) + (size_t)cur * MT * DMODEL)
#define HBw ((bf16_t*)(ws + WS_HB) + (size_t)cur * MT * DMODEL)
#define SSQc ((float*)(ws + WS_SSQ) + (size_t)cur * MT * 16)
        if (IN(base + 0)) REPLOOP(base + 0) { WS_LAUNDER();
            if (EN(2) && is_mla) {
                pg8::Gemm g{HBc, (const bf16_t*)(ws + W_AIN) + (size_t)l * 768 * 1024, MT, 768, 1024};
                pg8::StaticOrder S; S.init(MT, 768, F.G, bx);
                pg8::EpiAin E{(bf16_t*)(ws + X_AQ), (bf16_t*)(ws + X_AKV), (float*)(ws + WS_KPE), (float*)(ws + WS_SSQQ), (float*)(ws + WS_SSQKV), pg8::RowScale{SSQc, 1}, args.in[10] + l * 96, (const float*)(ws + WS_CS), (float*)(ws + WS_SSPE)};
                pg8::gemm_phase<pg8::EpiAin, pg8::StaticOrder, true, true>(ring, g, S, E, F.wave);
            } else if (EN(3) && !is_mla) {
                pg8::Gemm g{HBc, (const bf16_t*)(ws + W_QB) + (size_t)j * 1024 * 1024, MT, 1024, 1024};
                pg8::StaticOrder S; S.init(MT, 1024, F.G, bx);
                pg8::EpiScale E{(bf16_t*)(ws + X_SQ), 1024, pg8::RowScale{SSQc, 1}, QSCALE_SB};
                pg8::gemm_phase<pg8::EpiScale, pg8::StaticOrder, true, true>(ring, g, S, E, F.wave);
                asm volatile("s_waitcnt vmcnt(0)" ::: "memory"); __syncthreads();
                __builtin_amdgcn_fence(__ATOMIC_ACQUIRE, "agent"); asm volatile("s_waitcnt vmcnt(0)" ::: "memory");
                WS_LAUNDER();
                pg8::StaticOrder S2; S2.init(MT, 1024, F.G, bx); pg8::Unit uu;
                for (int ui = 0; S2.next(ui, uu); ++ui)
                    for (int i4 = 0; i4 < 4; ++i4) att::sba::unit(uu.pm >> 5, uu.pn, (uu.pm & 31) * 4 + i4, (const bf16_t*)(ws + X_SQ), (const bf16_t*)(ws + WS_SKT), (const bf16_t*)(ws + WS_SVT), (bf16_t*)(ws + X_SO), ring, F.wave);
            }
            SEAM(base + 0);
        }
        if (EN(4) && is_mla && IN(base + 1)) REPLOOP(base + 1) { WS_LAUNDER();
            { pg8::Gemm g{(const bf16_t*)(ws + X_AQ), (const bf16_t*)(ws + W_QUP) + (size_t)l * 1024 * 384, MT, 1024, 384};
              pg8::StaticOrder S; S.init(MT, 1024, F.G, bx);
              EpiQ E{ws, args.in[9] + l * 96};
              pg8::gemm_phase<EpiQ, pg8::StaticOrder, true, true>(ring, g, S, E, F.wave); }
            { pg8::Gemm g{(const bf16_t*)(ws + X_AKV), (const bf16_t*)(ws + W_KVUP) + (size_t)l * 1024 * 256, MT, 1024, 256};
              pg8::StaticOrder S; S.init(MT, 1024, F.G, bx);
              EpiKV E{ws, args.in[10] + l * 96};
              pg8::gemm_phase<EpiKV, pg8::StaticOrder, true, true>(ring, g, S, E, F.wave); }
            SEAM(base + 1);
        }
        if (is_mla && IN(base + 3)) REPLOOP(base + 3) { WS_LAUNDER();
#if defined(MLA_ABL)
            if (EN(6) && is_mla && DUMMY) att::mla::phase<MLA_ABL>(F.vcu, F.G, (const bf16_t*)(ws + X_Q), (const bf16_t*)(ws + X_KT), (const bf16_t*)(ws + X_VT), (bf16_t*)(ws + WS_END + 66 * MiB), ring, F.wave);
            else
#endif
            if (EN(6) && is_mla) att::mla::phase<0>(F.vcu, F.G, (const bf16_t*)(ws + X_Q), (const bf16_t*)(ws + X_KT), (const bf16_t*)(ws + X_VT), (bf16_t*)(ws + X_O), ring, F.wave);
            SEAM(base + 3);
        }
        if (EN(8) && IN(base + 4)) REPLOOP(base + 4) { WS_LAUNDER();
            pg8::Gemm g = is_mla ? pg8::Gemm{(const bf16_t*)(ws + X_O), (const bf16_t*)(ws + W_AOUT) + (size_t)l * 1024 * 512, MT, 1024, 512}
                                 : pg8::Gemm{(const bf16_t*)(ws + X_SO), (const bf16_t*)(ws + W_OB) + (size_t)j * 1024 * 1024, MT, 1024, 1024};
            pg8::StaticOrder S; S.init(MT, 1024, F.G, bx);
            pg8::EpiRes<false> E{HBc, OUT_HB(cur), OUT_SSQ(cur), nullptr, pg8::RowScale{nullptr, 0}, nullptr};
            pg8::gemm_phase<pg8::EpiRes<false>, pg8::StaticOrder, true, true>(ring, g, S, E, F.wave);
            SEAM(base + 4);
        }
        if (!is_moe) {
            if (EN(9) && IN(base + 5)) REPLOOP(base + 5) { WS_LAUNDER();
                pg8::Gemm g{HBc, (const bf16_t*)(ws + W_FGU) + (size_t)(l >> 1) * 5632 * 1024, MT, 5632, 1024};
                pg8::GroupOrder S; S.init_dense(MT, 5632, F.G, bx);
                pg8::EpiSwiglu E{(bf16_t*)(ws + X_HID), pg8::RowScale{SSQc, 1}};
                pg8::gemm_phase<pg8::EpiSwiglu, pg8::GroupOrder, GU_ALIGN, true>(ring, g, S, E, F.wave);
#if FILL_A + FILL_D > 0
                filler(args, F, l == 0 ? 0 : 3, l == 0 ? 0 : DEF_QC, l == 0 ? DEF_QA : DEF_QD);
#endif
                SEAM(base + 5);
            }
            if (EN(10) && IN(base + 6)) REPLOOP(base + 6) { WS_LAUNDER();
                pg8::Gemm g{(const bf16_t*)(ws + X_HID), (const bf16_t*)(ws + W_FDN) + (size_t)(l >> 1) * 1024 * 2816, MT, 1024, 2816};
                pg8::StaticOrder S; S.init(MT, 1024, F.G, bx);
                pg8::EpiRes<false> E{HBc, OUT_HB(cur), OUT_SSQ(cur), nullptr, pg8::RowScale{nullptr, 0}, nullptr};
                pg8::gemm_phase<pg8::EpiRes<false>, pg8::StaticOrder, true, true>(ring, g, S, E, F.wave);
                SEAM(base + 6);
            }
        } else {
            if (EN(11) && IN(base + 5)) REPLOOP(base + 5) { WS_LAUNDER(); moe_route(args, F, l, cur); SEAM(base + 5); }
            if (EN(12) && IN(base + 6)) REPLOOP(base + 6) { WS_LAUNDER(); moe_scatter(args, F, cur); SEAM(base + 6); }
            if (EN(13) && IN(base + 7)) REPLOOP(base + 7) { WS_LAUNDER();
                pg8::Gemm g{(const bf16_t*)(ws + X_XG), (const bf16_t*)(ws + W_EGU) + (size_t)(l >> 1) * 8 * 5632 * 1024, MAXSLOT, 5632, 1024};
                pg8::GroupOrder S; S.init((const int*)(ws + WS_PSTART), 5632, F.G, bx, (size_t)5632 * 1024 * 2);
                pg8::EpiSwiglu E{(bf16_t*)(ws + X_HG), pg8::RowScale{(const float*)(ws + WS_SLOTRS), 2}};
                pg8::gemm_phase<pg8::EpiSwiglu, pg8::GroupOrder, GU_ALIGN, true>(ring, g, S, E, F.wave);
#if FILL_B > 0
                if (l == 1) filler(args, F, 1, DEF_QA, DEF_QB);
#endif
                SEAM(base + 7);
            }
            if (EN(14) && IN(base + 8)) REPLOOP(base + 8) { WS_LAUNDER();
                pg8::Gemm g{(const bf16_t*)(ws + X_HG), (const bf16_t*)(ws + W_EDN) + (size_t)(l >> 1) * 8 * 1024 * 2816, MAXSLOT, 1024, 2816};
                pg8::GroupOrder S; S.init((const int*)(ws + WS_PSTART), 1024, F.G, bx, (size_t)1024 * 2816 * 2);
                pg8::EpiScale E{(bf16_t*)(ws + X_YG), 1024, pg8::RowScale{(const float*)(ws + WS_SLOTG), 2}, 1.0f};
                pg8::gemm_phase<pg8::EpiScale, pg8::GroupOrder, true, true>(ring, g, S, E, F.wave);
#if FILL_C > 0
                if (l == 1) filler(args, F, 2, DEF_QB, DEF_QC);
#endif
                SEAM(base + 8);
            }
            if (EN(15) && IN(base + 9)) REPLOOP(base + 9) { WS_LAUNDER(); moe_combine(args, F, cur, DUMMY); SEAM(base + 9); }
        }
        if (EN(16) && IN(base + 10)) REPLOOP(base + 10) { WS_LAUNDER();
            pg8::Gemm g{HBc, (const bf16_t*)(ws + W_PG) + (size_t)l * 1024 * 1024, MT, 1024, 1024};
            pg8::StaticOrder S; S.init(MT, 1024, F.G, bx);
            pg8::EpiRes<true> E{HBc, OUT_HB(cur ^ 1), OUT_SSQ(cur ^ 1),
                                (const bf16_t*)(ws + WS_U) + (size_t)l * MT * DMODEL, pg8::RowScale{SSQc, 1}, (l == 3 && !DUMMY) ? args.out : nullptr};
            pg8::gemm_phase<pg8::EpiRes<true>, pg8::StaticOrder, true, true>(ring, g, S, E, F.wave);
            SEAM(base + 10);
        }
        if (EN(17) && l == 1 && IN(base + 11)) REPLOOP(base + 11) { WS_LAUNDER();
            pg8::Gemm g{(const bf16_t*)(ws + WS_HB) + (size_t)(cur ^ 1) * MT * DMODEL, (const bf16_t*)(ws + W_KVS), MT, 512, 1024};
            pg8::StaticOrder S; S.init(MT, 512, F.G, bx);
            pg8::EpiKvs E{(bf16_t*)(ws + WS_SKT), (bf16_t*)(ws + WS_SVT), pg8::RowScale{(const float*)(ws + WS_SSQ) + (size_t)(cur ^ 1) * MT * 16, 1}};
            pg8::gemm_phase<pg8::EpiKvs, pg8::StaticOrder, true, true>(ring, g, S, E, F.wave);
            SEAM(base + 11);
        }
    }
#undef IN
#undef SEAM
}
}
#define MULTI_LAUNCH 0
extern "C" void kernel_launch(void* const* d_in, const int* in_sizes, int n_in, void* d_out, int out_size, void* d_ws, size_t ws_size, hipStream_t stream) {
    using namespace fw;
    static int grid = 0;
    if (grid == 0) {
        if (n_in != 26 || out_size != MT * DMODEL || ws_size < WS_END) { fprintf(stderr, "kernel_launch: unexpected n_in %d / out %d / ws %zu\n", n_in, out_size, ws_size); grid = -1; return; }
        if (hipFuncSetAttribute((const void*)yoco_fwd, hipFuncAttributeMaxDynamicSharedMemorySize, LDS_BYTES) != hipSuccess) { fprintf(stderr, "kernel_launch: hipFuncSetAttribute failed\n"); grid = -1; return; }
        int dev = 0, cus = 0, per_cu = 0;
        (void)hipGetDevice(&dev); (void)hipDeviceGetAttribute(&cus, hipDeviceAttributeMultiprocessorCount, dev);
        (void)hipOccupancyMaxActiveBlocksPerMultiprocessor(&per_cu, (const void*)yoco_fwd, NTHR, LDS_BYTES);
        (void)hipGetLastError();
        grid = (cus > 0 && per_cu >= 1) ? cus : 256;
        if (grid > 256) grid = 256;
    }
    if (grid < 0) return;
    (void)hipMemsetAsync((unsigned char*)d_ws + WS_CTL, 0, CTL_ZERO_BYTES, stream);
    Args a{};
    for (int i = 0; i < 26; ++i) a.in[i] = (const float*)d_in[i];
    a.out = (float*)d_out; a.ws = (unsigned char*)d_ws;
#if MULTI_LAUNCH
    for (int k = 0; k < PH_TOTAL; ++k) { if (!phase_active(k)) continue; a.ph_lo = k; a.ph_hi = k + 1; hipLaunchKernelGGL(yoco_fwd, dim3(grid), dim3(NTHR), LDS_BYTES, stream, a); }
#else
#ifdef PROBE_MASK
    a.ph_lo = 0; a.ph_hi = PH_TOTAL;
#else
    a.ph_lo = 0; a.ph_hi = PH_TOTAL - 1;
#endif
    hipLaunchKernelGGL(yoco_fwd, dim3(grid), dim3(NTHR), LDS_BYTES, stream, a);
#endif
}
```

```cpp
#include <hip/hip_runtime.h>
#include <cstdio>
#include <cstdint>
#include <cmath>
#define LAS __attribute__((address_space(3)))
#define GAS __attribute__((address_space(1)))
typedef unsigned short bf16_t;
typedef short bf16x8 __attribute__((ext_vector_type(8)));
typedef float f32x4 __attribute__((ext_vector_type(4)));
typedef float f32x2 __attribute__((ext_vector_type(2)));
typedef float f32x16 __attribute__((ext_vector_type(16)));
typedef unsigned u32x4 __attribute__((ext_vector_type(4)));
typedef unsigned u32x2 __attribute__((ext_vector_type(2)));
typedef short s16x4 __attribute__((ext_vector_type(4)));
typedef __bf16 bf16x2_t __attribute__((ext_vector_type(2)));

constexpr int MT = 16384, DMODEL = 1024, SEQL = 8192;
constexpr float RMS_EPS = 1e-6f;
constexpr float LOG2E = 1.4426950408889634f;

__device__ __forceinline__ unsigned pk_bf16(float lo, float hi) { f32x2 v = {lo, hi}; bf16x2_t b = __builtin_convertvector(v, bf16x2_t); return __builtin_bit_cast(unsigned, b); }
__device__ __forceinline__ float bf_lo(unsigned w) { return __uint_as_float(w << 16); }
__device__ __forceinline__ float bf_hi(unsigned w) { return __uint_as_float(w & 0xffff0000u); }
__device__ __forceinline__ unsigned cvt_pk_bf16(float lo, float hi) { unsigned r; asm volatile("v_cvt_pk_bf16_f32 %0, %1, %2" : "=v"(r) : "v"(lo), "v"(hi)); return r; }
__device__ __forceinline__ u32x4 pack8(const f32x4 a, const f32x4 b) { u32x4 w; w.x = cvt_pk_bf16(a[0], a[1]); w.y = cvt_pk_bf16(a[2], a[3]); w.z = cvt_pk_bf16(b[0], b[1]); w.w = cvt_pk_bf16(b[2], b[3]); return w; }
__device__ __forceinline__ u32x2 pack8_fp8(const f32x4 a, const f32x4 b) {
    u32x2 w; int lo = 0, hi = 0;
    lo = __builtin_amdgcn_cvt_pk_fp8_f32(__builtin_amdgcn_fmed3f(a[0], -448.f, 448.f), __builtin_amdgcn_fmed3f(a[1], -448.f, 448.f), lo, false); lo = __builtin_amdgcn_cvt_pk_fp8_f32(__builtin_amdgcn_fmed3f(a[2], -448.f, 448.f), __builtin_amdgcn_fmed3f(a[3], -448.f, 448.f), lo, true);
    hi = __builtin_amdgcn_cvt_pk_fp8_f32(__builtin_amdgcn_fmed3f(b[0], -448.f, 448.f), __builtin_amdgcn_fmed3f(b[1], -448.f, 448.f), hi, false); hi = __builtin_amdgcn_cvt_pk_fp8_f32(__builtin_amdgcn_fmed3f(b[2], -448.f, 448.f), __builtin_amdgcn_fmed3f(b[3], -448.f, 448.f), hi, true);
    w.x = (unsigned)lo; w.y = (unsigned)hi; return w; }
__device__ __forceinline__ void unpack8(const u32x4 w, f32x4& a, f32x4& b) { a = (f32x4){bf_lo(w.x), bf_hi(w.x), bf_lo(w.y), bf_hi(w.y)}; b = (f32x4){bf_lo(w.z), bf_hi(w.z), bf_lo(w.w), bf_hi(w.w)}; }
__device__ __forceinline__ float fast_rcp(float x) { return __builtin_amdgcn_rcpf(x); }
__device__ __forceinline__ float fast_exp2(float x) { return __builtin_amdgcn_exp2f(x); }
__device__ __forceinline__ float fast_log2(float x) { return __builtin_amdgcn_logf(x); }
__device__ __forceinline__ int lane_id() { int l; asm volatile("v_mbcnt_lo_u32_b32 %0, -1, 0\n\tv_mbcnt_hi_u32_b32 %0, -1, %0" : "=v"(l)); return l; }
__device__ __forceinline__ float sigmoidf_(float x) { return fast_rcp(1.0f + fast_exp2(-x * LOG2E)); }
__device__ __forceinline__ f32x4 sigmoid4(const f32x4 a, float nsl) { const f32x4 t = a * nsl; f32x4 e = {fast_exp2(t[0]), fast_exp2(t[1]), fast_exp2(t[2]), fast_exp2(t[3])}; e = e + 1.0f; return (f32x4){fast_rcp(e[0]), fast_rcp(e[1]), fast_rcp(e[2]), fast_rcp(e[3])}; }

#ifndef GROUP_WGM
#define GROUP_WGM 8
#endif
namespace pg8 {
constexpr int BM = 256, BK = 64, HALF = 128, HTB = HALF * BK * 2, STAGE_BYTES = 8 * HTB, NXCD = 8, WGM = 8;
__host__ __device__ __forceinline__ int lds_byte(int r, int c) { const int st = (r >> 4) * 2 + (c >> 5), rr = r & 15, cc = c & 31, ob = rr * 64 + cc * 2; return st * 1024 + (ob ^ (((ob >> 9) & 1) << 5)); }
__host__ __device__ __forceinline__ void stage_rc(int b, int& R, int& C) { const int st = b / 1024, sb = b % 1024, swz = sb ^ (((sb >> 9) & 1) << 5); R = (st >> 1) * 16 + swz / 64; C = (st & 1) * 32 + (swz % 64) / 2; }
__host__ __device__ __forceinline__ int perm32(int rho) { const int n = rho >> 4, i = rho & 15; return 8 * (i >> 2) + 4 * n + (i & 3); }

struct Unit { int pm, pn; size_t boff; };
struct Gemm { const bf16_t* A; const bf16_t* Bt; int M, N, K; };

struct StaticOrder {
    int nM, nN, nwg, G, c;
    __device__ __forceinline__ void init(int M, int N, int G_, int c_) { nM = M / BM; nN = N / BM; nwg = nM * nN; G = G_; c = c_; }
    __device__ __forceinline__ bool next(int i, Unit& u) const {
        const long L = (long)i * G + c; if (L >= nwg) return false;
        int wgid = (int)L; { const int q = nwg / NXCD, r = nwg % NXCD, xcd = wgid % NXCD, off = wgid / NXCD; wgid = (xcd < r ? xcd * (q + 1) : r * (q + 1) + (xcd - r) * q) + off; }
        const int nig = WGM * nN, gid = wgid / nig, fm = gid * WGM, gsz = (nM - fm) < WGM ? (nM - fm) : WGM;
        u.pm = fm + ((wgid % nig) % gsz); u.pn = (wgid % nig) / gsz; u.boff = 0; return true;
    }
};
struct GroupOrder {
    int ps[9]; int nN, nwg, G, c; size_t estride;
    __device__ __forceinline__ void init(const int* pstart, int N, int G_, int c_, size_t estride_) {
#pragma unroll
        for (int e = 0; e < 9; ++e) ps[e] = __builtin_amdgcn_readfirstlane(pstart[e]);
        nN = N / BM; nwg = ps[8] * nN; G = G_; c = c_; estride = estride_; }
    __device__ __forceinline__ void init_dense(int M, int N, int G_, int c_) {
        ps[0] = 0;
#pragma unroll
        for (int e = 1; e < 9; ++e) ps[e] = M / BM;
        nN = N / BM; nwg = ps[8] * nN; G = G_; c = c_; estride = 0; }
    __device__ __forceinline__ bool next(int i, Unit& u) const {
        const long L = (long)i * G + c; if (L >= nwg) return false;
        int wgid = (int)L; { const int q = nwg / NXCD, r = nwg % NXCD, xcd = wgid % NXCD, off = wgid / NXCD; wgid = (xcd < r ? xcd * (q + 1) : r * (q + 1) + (xcd - r) * q) + off; }
        int e = 0;
#pragma unroll
        for (int k = 1; k < 8; ++k) if (wgid >= ps[k] * nN) e = k;
        int p0 = ps[0], p1 = ps[1];
#pragma unroll
        for (int k = 1; k < 8; ++k) if (e == k) { p0 = ps[k]; p1 = ps[k + 1]; }
        const int local = wgid - p0 * nN, np = p1 - p0;
        constexpr int GW = GROUP_WGM;
        const int nig = GW * nN, gid = local / nig, fm = gid * GW, gsz = (np - fm) < GW ? (np - fm) : GW;
        u.pm = p0 + fm + ((local % nig) % gsz); u.pn = (local % nig) / gsz; u.boff = (size_t)e * estride; return true;
    }
};


__device__ __forceinline__ float sumsq8(const f32x4 a, const f32x4 b) { return ((a[0] * a[0] + a[1] * a[1]) + (a[2] * a[2] + a[3] * a[3])) + ((b[0] * b[0] + b[1] * b[1]) + (b[2] * b[2] + b[3] * b[3])); }
__device__ __forceinline__ float red_fq(float s) {
    { auto rr = __builtin_amdgcn_permlane16_swap(__float_as_uint(s), __float_as_uint(s), false, false); s = __uint_as_float(rr[0]) + __uint_as_float(rr[1]); }
    { auto rr = __builtin_amdgcn_permlane32_swap(__float_as_uint(s), __float_as_uint(s), false, false); s = __uint_as_float(rr[0]) + __uint_as_float(rr[1]); }
    return s; }
__device__ __forceinline__ float xor32(float v, int upper) {
    auto rr = __builtin_amdgcn_permlane32_swap(__float_as_uint(v), __float_as_uint(v), false, false); return __uint_as_float(upper ? rr[0] : rr[1]); }
struct RowScale {
    const float* p; int mode;
    __device__ __forceinline__ float get(int row, int fq) const {
        if (mode == 0) return 1.0f;
        if (mode == 2) return p[row];
        if (mode == 1) { const f32x4 a = *(const f32x4*)(p + (size_t)row * 16 + 4 * fq); const float s = red_fq((a[0] + a[1]) + (a[2] + a[3])); return 1.0f / sqrtf(s * (1.0f / 1024.0f) + RMS_EPS); }
        if (mode == 3) { const f32x4 a = *(const f32x4*)(p + (size_t)row * 8 + 4 * (fq & 1)); const float s = red_fq(fq < 2 ? (a[0] + a[1]) + (a[2] + a[3]) : 0.f); return 1.0f / sqrtf(s * (1.0f / 384.0f) + RMS_EPS); }
        { const float s = red_fq(p[(size_t)row * 4 + fq]); return 1.0f / sqrtf(s * (1.0f / 256.0f) + RMS_EPS); }
    }
    __device__ __forceinline__ void get8(float (&rsv)[2][4], int row0, int fq) const {
#pragma unroll
        for (int ai = 0; ai < 2; ++ai)
#pragma unroll
            for (int m = 0; m < 4; ++m) rsv[ai][m] = get(row0 + ai * 128 + m * 16, fq);
        asm volatile("" ::: "memory");
    }
};

struct EpiScale {
    static constexpr bool PERM = true, AFTER_DRAIN = false;
    bf16_t* O; int ldc; RowScale rs; float cs;
    __device__ __forceinline__ void operator()(const f32x4 (&acc)[2][2][4][2], const Unit& u, int wr, int wc, int fr_, int fq_) const {
        const int ln_ = lane_id(), fr = ln_ & 15, fq = ln_ >> 4; (void)fr_; (void)fq_;
        const int row0 = u.pm * BM + wr * 64 + fr, col0 = u.pn * BM + wc * 32 + 8 * fq;
        float rsv[2][4]; rs.get8(rsv, row0, fq);
#pragma unroll
        for (int ai = 0; ai < 2; ++ai)
#pragma unroll
            for (int m = 0; m < 4; ++m) { const int row = row0 + ai * HALF + m * 16; const float s = rsv[ai][m] * cs; bf16_t* rowp = O + (size_t)row * ldc + col0;
#pragma unroll
                for (int bj = 0; bj < 2; ++bj) *(u32x4*)(rowp + bj * HALF) = pack8(acc[ai][bj][m][0] * s, acc[ai][bj][m][1] * s); }
    }
};
__device__ __forceinline__ void rope8(f32x4& v0, f32x4& v1, const float* cs_row, int fq) {
    f32x4 p0, p1;
#pragma unroll
    for (int j = 0; j < 4; ++j) { p0[j] = xor32(v0[j], fq >> 1); p1[j] = xor32(v1[j], fq >> 1); }
    const int f0 = 8 * (fq & 1);
    const f32x4 c0 = *(const f32x4*)(cs_row + f0), c1 = *(const f32x4*)(cs_row + f0 + 4), s0 = *(const f32x4*)(cs_row + 16 + f0), s1 = *(const f32x4*)(cs_row + 16 + f0 + 4);
    if (fq < 2) { v0 = v0 * c0 - p0 * s0; v1 = v1 * c1 - p1 * s1; } else { v0 = v0 * c0 + p0 * s0; v1 = v1 * c1 + p1 * s1; }
}
struct EpiAin {
    static constexpr bool PERM = true, AFTER_DRAIN = false;
    bf16_t* AQ; bf16_t* AKV; float* KPE; float* SSQQ; float* SSQKV; RowScale rs; const float* gk; const float* CS; float* SSPE;
    __device__ __forceinline__ void operator()(const f32x4 (&acc)[2][2][4][2], const Unit& u, int wr, int wc, int fr_, int fq_) const {
        const int ln_ = lane_id(), fr = ln_ & 15, fq = ln_ >> 4; (void)fr_; (void)fq_;
        const int row0 = u.pm * BM + wr * 64 + fr, c8 = wc * 32 + 8 * fq;
        float rsv[2][4]; rs.get8(rsv, row0, fq);
#pragma unroll
        for (int ai = 0; ai < 2; ++ai)
#pragma unroll
            for (int m = 0; m < 4; ++m) { const int row = row0 + ai * HALF + m * 16; const float s = rsv[ai][m];
                const f32x4 a0 = acc[ai][0][m][0] * s, a1 = acc[ai][0][m][1] * s, b0 = acc[ai][1][m][0] * s, b1 = acc[ai][1][m][1] * s;
                if (u.pn == 0) {
                    *(u32x4*)(AQ + (size_t)row * 384 + c8) = pack8(a0, a1); *(u32x4*)(AQ + (size_t)row * 384 + 128 + c8) = pack8(b0, b1);
                    const float q = red_fq(sumsq8(a0, a1) + sumsq8(b0, b1)); if (fq == 0) SSQQ[(size_t)row * 8 + wc] = q;
                } else if (u.pn == 1) {
                    *(u32x4*)(AQ + (size_t)row * 384 + 256 + c8) = pack8(a0, a1);
                    const float q = red_fq(sumsq8(a0, a1)); if (fq == 0) SSQQ[(size_t)row * 8 + 4 + wc] = q;
                    if (wc == 0) { const float qp = red_fq(sumsq8(b0, b1)); if (fq == 0) SSPE[row] = qp;
                        f32x4 y0 = b0 * *(const f32x4*)(gk + 64 + 8 * fq), y1 = b1 * *(const f32x4*)(gk + 64 + 8 * fq + 4); rope8(y0, y1, CS + (size_t)row * 32, fq);
                        *(f32x4*)(KPE + (size_t)row * 32 + 8 * fq) = y0; *(f32x4*)(KPE + (size_t)row * 32 + 8 * fq + 4) = y1; }
                } else {
                    *(u32x4*)(AKV + (size_t)row * 256 + c8) = pack8(a0, a1); *(u32x4*)(AKV + (size_t)row * 256 + 128 + c8) = pack8(b0, b1);
                    const float q = red_fq(sumsq8(a0, a1) + sumsq8(b0, b1)); if (fq == 0) SSQKV[(size_t)row * 4 + wc] = q;
                } }
    }
};
struct EpiSwiglu {
    static constexpr bool PERM = true, AFTER_DRAIN = false;
    bf16_t* HID; RowScale rs; int abl; int f8; float cs;
    __device__ __forceinline__ void operator()(const f32x4 (&acc)[2][2][4][2], const Unit& u, int wr, int wc, int fr_, int fq_) const {
        if (abl == 1) return;
        const int ln_ = lane_id(), fr = ln_ & 15, fq = ln_ >> 4; (void)fr_; (void)fq_;
        const int row0 = u.pm * BM + wr * 64 + fr, col0 = u.pn * 128 + wc * 32 + 8 * fq;
        float rsv[2][4]; rs.get8(rsv, row0, fq);
#pragma unroll
        for (int ai = 0; ai < 2; ++ai)
#pragma unroll
            for (int m = 0; m < 4; ++m) { const int row = row0 + ai * HALF + m * 16; const float s = rsv[ai][m] * cs;
                f32x4 o[2];
#pragma unroll
                for (int n = 0; n < 2; ++n) {
                    const f32x4 gu = acc[ai][0][m][n] * acc[ai][1][m][n];
                    if (abl == 2) o[n] = gu * (s * s); else o[n] = gu * (sigmoid4(acc[ai][0][m][n], -s * LOG2E) * (s * s)); }
                if (f8) *(u32x2*)((unsigned char*)HID + (size_t)row * 2816 + col0) = pack8_fp8(o[0], o[1]);
                else *(u32x4*)(HID + (size_t)row * 2816 + col0) = pack8(o[0], o[1]); }
    }
};
template <bool GATED> struct EpiRes {
    static constexpr bool PERM = true, AFTER_DRAIN = false;
    const bf16_t* HBi; bf16_t* HBo; float* SSQo; const bf16_t* U; RowScale rs; float* OUTF; float ascale;
    __device__ __forceinline__ void operator()(const f32x4 (&acc)[2][2][4][2], const Unit& u, int wr, int wc, int fr_, int fq_) const {
        const int ln_ = lane_id(), fr = ln_ & 15, fq = ln_ >> 4; (void)fr_; (void)fq_;
        const int row0 = u.pm * BM + wr * 64 + fr, col0 = u.pn * BM + wc * 32 + 8 * fq;
        float rsv[2][4]; if (GATED) rs.get8(rsv, row0, fq);
        u32x4 hq[3][2], uq[3][2];
#define EPIRES_LOAD(it_, b_) do { const size_t off_ = (size_t)(row0 + ((it_) >> 2) * HALF + ((it_) & 3) * 16) * DMODEL + col0; \
            hq[b_][0] = *(const u32x4*)(HBi + off_); hq[b_][1] = *(const u32x4*)(HBi + off_ + HALF); \
            if (GATED) { uq[b_][0] = *(const u32x4*)(U + off_); uq[b_][1] = *(const u32x4*)(U + off_ + HALF); } } while (0)
        EPIRES_LOAD(0, 0); EPIRES_LOAD(1, 1);
#pragma unroll
        for (int it = 0; it < 8; ++it) { const int ai = it >> 2, m = it & 3, cb = it % 3; const int row = row0 + ai * HALF + m * 16; const size_t off = (size_t)row * DMODEL + col0;
                if (it + 2 < 8) EPIRES_LOAD(it + 2, (it + 2) % 3);
                float s = 1.0f; if (GATED) s = rsv[ai][m];
                float q = 0.f;
#pragma unroll
                for (int bj = 0; bj < 2; ++bj) { f32x4 a0 = acc[ai][bj][m][0] * ascale, a1 = acc[ai][bj][m][1] * ascale;
                    f32x4 h0, h1; unpack8(hq[cb][bj], h0, h1);
                    if (GATED) { f32x4 u0, u1; unpack8(uq[cb][bj], u0, u1);
                        a0 = sigmoid4(a0, -s * LOG2E) * u0; a1 = sigmoid4(a1, -s * LOG2E) * u1; }
                    h0 += a0; h1 += a1;
                    if (GATED) { if (OUTF) { *(f32x4*)(OUTF + off + bj * HALF) = h0; *(f32x4*)(OUTF + off + bj * HALF + 4) = h1; } }
                    *(u32x4*)(HBo + off + bj * HALF) = pack8(h0, h1);
                    q += sumsq8(h0, h1); }
                q = red_fq(q); if (fq == 0) SSQo[(size_t)row * 16 + u.pn * 4 + wc] = q;
                asm volatile("" ::: "memory"); }
#undef EPIRES_LOAD
    }
};
struct EpiKvs {
    static constexpr bool PERM = true, AFTER_DRAIN = false;
    bf16_t* KT; bf16_t* VT; RowScale rs;
    __device__ __forceinline__ void operator()(const f32x4 (&acc)[2][2][4][2], const Unit& u, int wr, int wc, int fr_, int fq_) const {
        const int ln_ = lane_id(), fr = ln_ & 15, fq = ln_ >> 4; (void)fr_; (void)fq_;
        const int row0 = u.pm * BM + wr * 64 + fr;
        float rsv[2][4]; rs.get8(rsv, row0, fq);
#pragma unroll
        for (int ai = 0; ai < 2; ++ai)
#pragma unroll
            for (int m = 0; m < 4; ++m) { const int row = row0 + ai * HALF + m * 16; const float s = rsv[ai][m];
                const int b = row >> 13, sq = row & 8191, tile = sq >> 6, rr = sq & 63;
#pragma unroll
                for (int bj = 0; bj < 2; ++bj) { const int c = bj * HALF + wc * 32 + 8 * fq, kh = c >> 6, d = c & 63;
                    const size_t tb = (size_t)((b * 4 + kh) * 128 + tile) * 4096;
                    const u32x4 w = pack8(acc[ai][bj][m][0] * s, acc[ai][bj][m][1] * s);
                    if (u.pn == 0) *(u32x4*)(KT + tb + (d >> 3) * 512 + rr * 8) = w;
                    else *(u32x4*)(VT + tb + (d >> 5) * 2048 + rr * 32 + (d & 31)) = w; } }
    }
};

#define PG8_LAS LAS
template <class Epi, class Sched, bool ALIGN_EPI = false, bool SP2 = false, bool MX8 = false, bool SADDR = MX8>
__device__ __forceinline__ void gemm_phase(PG8_LAS unsigned char* lds, const Gemm g, const Sched& S, const Epi& E, int wv  ) {
    int tid_ = wv * 64 + lane_id(); asm volatile("" : "+v"(tid_));
    const int tid = tid_, wid = __builtin_amdgcn_readfirstlane(tid >> 6), lane = tid & 63, wr = wid >> 2, wc = wid & 3, fr = lane & 15, fq = lane >> 4;
    const int K = g.K, nt = K / BK;
    unsigned voffA[2], voffB[2];
#pragma unroll
    for (int i = 0; i < 2; ++i) { int R, C; stage_rc(tid * 16 + i * 8192, R, C); const int Rb = Epi::PERM ? ((R & ~31) + perm32(R & 31)) : R;
        voffA[i] = (unsigned)(R * K + C) * 2u; voffB[i] = (unsigned)(Rb * K + C) * 2u; }
    const size_t kstep = (size_t)(BK * 2);
    const size_t hstep = (size_t)HALF * K * 2;
    const size_t tstep = 2 * hstep;
    const unsigned ldsw = (unsigned)wid * 1024u; const unsigned lds0_ = (unsigned)(uintptr_t)lds; (void)lds0_;
    const int aoff = lds_byte(wr * 64 + fr, fq * 8), boff = lds_byte(wc * 32 + fr, fq * 8);
#define PG8_SA(b, h) (((b) * 2 + (h)) * HTB)
#define PG8_SB(b, h) ((4 + (b) * 2 + (h)) * HTB)
#define PG8_STAGE(bufoff, gbase, voff) do { _Pragma("unroll") for (int _i = 0; _i < 2; ++_i) { \
        if constexpr (SADDR) { unsigned keep_; const unsigned dst_ = (unsigned)__builtin_amdgcn_readfirstlane((int)(lds0_ + (unsigned)(bufoff) + ldsw + _i * 8192)); \
            asm volatile("s_mov_b32 %0, m0\n\ts_mov_b32 m0, %3\n\ts_nop 0\n\tglobal_load_lds_dwordx4 %1, %2\n\ts_mov_b32 m0, %0" : "=&s"(keep_) : "v"((voff)[_i]), "s"((const char*)(gbase)), "s"(dst_) : "memory"); } \
        else __builtin_amdgcn_global_load_lds((const unsigned*)((const char*)(gbase) + (voff)[_i]), (PG8_LAS unsigned*)(lds + (bufoff) + ldsw + _i * 8192), 16, 0, 0); } } while (0)
#define PG8_LDA(dst, b, h) do { _Pragma("unroll") for (int m = 0; m < 4; ++m) _Pragma("unroll") for (int k = 0; k < 2; ++k) dst[m][k] = *(const PG8_LAS bf16x8*)(lds + PG8_SA(b, h) + aoff + m * 2048 + k * 1024); } while (0)
#define PG8_LDB(dst, b, h) do { _Pragma("unroll") for (int n = 0; n < 2; ++n) _Pragma("unroll") for (int k = 0; k < 2; ++k) dst[n][k] = *(const PG8_LAS bf16x8*)(lds + PG8_SB(b, h) + boff + n * 2048 + k * 1024); } while (0)
#define PG8_MMA(ai, bj, At, Bt) do { __builtin_amdgcn_s_setprio(1); _Pragma("unroll") for (int m = 0; m < 4; ++m) _Pragma("unroll") for (int n = 0; n < 2; ++n) { \
        if constexpr (MX8) { typedef int i32x8_ __attribute__((ext_vector_type(8))); typedef int i32x4_ __attribute__((ext_vector_type(4))); \
            const i32x4_ b0_ = __builtin_bit_cast(i32x4_, Bt[n][0]), b1_ = __builtin_bit_cast(i32x4_, Bt[n][1]), a0_ = __builtin_bit_cast(i32x4_, At[m][0]), a1_ = __builtin_bit_cast(i32x4_, At[m][1]); \
            const i32x8_ bb_ = __builtin_shufflevector(b0_, b1_, 0, 1, 2, 3, 4, 5, 6, 7), aa_ = __builtin_shufflevector(a0_, a1_, 0, 1, 2, 3, 4, 5, 6, 7); \
            acc[ai][bj][m][n] = __builtin_amdgcn_mfma_scale_f32_16x16x128_f8f6f4(bb_, aa_, acc[ai][bj][m][n], 0, 0, 0, 0x7F7F7F7F, 0, 0x7F7F7F7F); } \
        else { _Pragma("unroll") for (int k = 0; k < 2; ++k) acc[ai][bj][m][n] = __builtin_amdgcn_mfma_f32_16x16x32_bf16(Bt[n][k], At[m][k], acc[ai][bj][m][n], 0, 0, 0); } } \
        __builtin_amdgcn_s_setprio(0); } while (0)
#define PG8_WAIT_V(n) asm volatile("s_waitcnt vmcnt(" #n ")" ::: "memory")
#define PG8_WAIT_L(n) asm volatile("s_waitcnt lgkmcnt(" #n ")" ::: "memory")
#define PG8_BAR __builtin_amdgcn_s_barrier()
#define PG8_SCHED __builtin_amdgcn_sched_barrier(0)
    Unit cur, nxt; int ui = 0;
    if (!S.next(0, cur)) return;
    f32x4 acc[2][2][4][2];
#pragma unroll
    for (int a = 0; a < 2; ++a)
#pragma unroll
        for (int b = 0; b < 2; ++b)
#pragma unroll
            for (int m = 0; m < 4; ++m)
#pragma unroll
                for (int n = 0; n < 2; ++n) acc[a][b][m][n] = (f32x4){0.f, 0.f, 0.f, 0.f};
    bf16x8 At[4][2], B0[2][2], B1[2][2];
    const char* cA = (const char*)g.A + (size_t)cur.pm * tstep; const char* cB = (const char*)g.Bt + cur.boff + (size_t)cur.pn * tstep;
    if constexpr (SP2) {
        PG8_STAGE(PG8_SB(0, 0), cB, voffB); PG8_STAGE(PG8_SB(0, 1), cB + hstep, voffB); PG8_STAGE(PG8_SA(0, 0), cA, voffA); PG8_STAGE(PG8_SA(0, 1), cA + hstep, voffA);
        if (wr == 1) PG8_BAR;
        PG8_WAIT_V(2); PG8_BAR;
        PG8_STAGE(PG8_SB(1, 0), cB + kstep, voffB); PG8_STAGE(PG8_SA(1, 0), cA + kstep, voffA); PG8_STAGE(PG8_SB(1, 1), cB + hstep + kstep, voffB);
        PG8_WAIT_V(6); PG8_BAR;
    } else {
        PG8_STAGE(PG8_SB(0, 0), cB, voffB); PG8_STAGE(PG8_SA(0, 0), cA, voffA); PG8_STAGE(PG8_SB(0, 1), cB + hstep, voffB); PG8_STAGE(PG8_SA(0, 1), cA + hstep, voffA);
        if (wr == 1) PG8_BAR;
        PG8_WAIT_V(4); PG8_BAR;
        PG8_STAGE(PG8_SB(1, 0), cB + kstep, voffB); PG8_STAGE(PG8_SA(1, 0), cA + kstep, voffA); PG8_STAGE(PG8_SB(1, 1), cB + hstep + kstep, voffB);
        PG8_WAIT_V(6); PG8_BAR;
    }
    for (;;) {
        const bool has_next = S.next(ui + 1, nxt);
        const char* nA = has_next ? (const char*)g.A + (size_t)nxt.pm * tstep : cA; const char* nB = has_next ? (const char*)g.Bt + nxt.boff + (size_t)nxt.pn * tstep : cB;
        for (int t = 0; t < nt; t += 2) {
            const bool last = (t == nt - 2);
            const char* a1 = cA + (size_t)(t + 1) * kstep;
            const char* a2 = last ? nA : cA + (size_t)(t + 2) * kstep; const char* b2 = last ? nB : cB + (size_t)(t + 2) * kstep;
            const char* a3 = a2 + kstep; const char* b3 = b2 + kstep;
            if constexpr (SP2) {
            PG8_LDB(B0, 0, 0); PG8_LDB(B1, 0, 1); PG8_SCHED; PG8_LDA(At, 0, 0); PG8_STAGE(PG8_SA(1, 1), a1 + hstep, voffA);
            PG8_WAIT_V(8); PG8_WAIT_L(0); PG8_BAR; PG8_MMA(0, 0, At, B0); PG8_MMA(0, 1, At, B1); PG8_BAR; PG8_SCHED;
            PG8_LDA(At, 0, 1); PG8_STAGE(PG8_SB(0, 0), b2, voffB); PG8_STAGE(PG8_SB(0, 1), b2 + hstep, voffB); PG8_STAGE(PG8_SA(0, 0), a2, voffA);
            PG8_WAIT_V(8); PG8_WAIT_L(0); PG8_BAR; PG8_MMA(1, 0, At, B0); PG8_MMA(1, 1, At, B1); PG8_BAR; PG8_SCHED;
            PG8_LDB(B0, 1, 0); PG8_LDB(B1, 1, 1); PG8_SCHED; PG8_LDA(At, 1, 0); PG8_STAGE(PG8_SA(0, 1), a2 + hstep, voffA);
            PG8_WAIT_V(8); PG8_WAIT_L(0); PG8_BAR; PG8_MMA(0, 0, At, B0); PG8_MMA(0, 1, At, B1); PG8_BAR; PG8_SCHED;
            PG8_LDA(At, 1, 1); PG8_STAGE(PG8_SB(1, 0), b3, voffB); PG8_STAGE(PG8_SB(1, 1), b3 + hstep, voffB); PG8_STAGE(PG8_SA(1, 0), a3, voffA);
            PG8_WAIT_V(8); PG8_WAIT_L(0); PG8_BAR; PG8_MMA(1, 0, At, B0); PG8_MMA(1, 1, At, B1); PG8_BAR; PG8_SCHED;
            } else {
            PG8_LDB(B0, 0, 0); PG8_SCHED; PG8_LDA(At, 0, 0); PG8_STAGE(PG8_SA(1, 1), a1 + hstep, voffA);
            PG8_WAIT_L(8); PG8_BAR; PG8_WAIT_L(0); PG8_MMA(0, 0, At, B0); PG8_BAR; PG8_SCHED;
            PG8_LDB(B1, 0, 1); PG8_STAGE(PG8_SB(0, 0), b2, voffB);
            PG8_BAR; PG8_WAIT_L(0); PG8_MMA(0, 1, At, B1); PG8_BAR;
            PG8_LDA(At, 0, 1); PG8_STAGE(PG8_SA(0, 0), a2, voffA);
            PG8_BAR; PG8_WAIT_L(0); PG8_MMA(1, 0, At, B0); PG8_BAR; PG8_SCHED;
            PG8_STAGE(PG8_SB(0, 1), b2 + hstep, voffB);
            PG8_WAIT_V(6); PG8_BAR; PG8_MMA(1, 1, At, B1); PG8_BAR;
            PG8_LDB(B0, 1, 0); PG8_SCHED; PG8_LDA(At, 1, 0); PG8_STAGE(PG8_SA(0, 1), a2 + hstep, voffA);
            PG8_WAIT_L(8); PG8_BAR; PG8_WAIT_L(0); PG8_MMA(0, 0, At, B0); PG8_BAR; PG8_SCHED;
            PG8_LDB(B1, 1, 1); PG8_STAGE(PG8_SB(1, 0), b3, voffB);
            PG8_BAR; PG8_WAIT_L(0); PG8_MMA(0, 1, At, B1); PG8_BAR;
            PG8_LDA(At, 1, 1); PG8_STAGE(PG8_SA(1, 0), a3, voffA);
            PG8_BAR; PG8_WAIT_L(0); PG8_MMA(1, 0, At, B0); PG8_BAR; PG8_SCHED;
            PG8_STAGE(PG8_SB(1, 1), b3 + hstep, voffB);
            PG8_WAIT_V(6); PG8_BAR; PG8_MMA(1, 1, At, B1); PG8_BAR;
            }
        }
        if constexpr (ALIGN_EPI) { if (wr == 0) PG8_BAR; }
        E(acc, cur, wr, wc, fr, fq);
        if (!has_next) break;
#pragma unroll
        for (int a = 0; a < 2; ++a)
#pragma unroll
            for (int b = 0; b < 2; ++b)
#pragma unroll
                for (int m = 0; m < 4; ++m)
#pragma unroll
                    for (int n = 0; n < 2; ++n) acc[a][b][m][n] = (f32x4){0.f, 0.f, 0.f, 0.f};
        cur = nxt; cA = nA; cB = nB; ++ui;
        if constexpr (ALIGN_EPI) { if (wr == 1) PG8_BAR; }
    }
    PG8_WAIT_V(0);
    if constexpr (!ALIGN_EPI) { if (wr == 0) PG8_BAR; }
    PG8_BAR;
#undef PG8_SA
#undef PG8_SB
#undef PG8_STAGE
#undef PG8_LDA
#undef PG8_LDB
#undef PG8_MMA
#undef PG8_WAIT_V
#undef PG8_WAIT_L
#undef PG8_BAR
#undef PG8_SCHED
}
}
typedef GAS unsigned gu32;
#define RLX_AGENT __ATOMIC_RELAXED, __HIP_MEMORY_SCOPE_AGENT
#define XB_TMO      128
#define XB_XCNT(j)  (256  + 64 * (j))
#define XB_XSUB(j)  (1280 + 64 * (j))
#define XB_XGEN(j)  (2304 + 64 * (j))
#define XB_TOP      3328
#define XB_TOPGEN   3392
#define XCD_BAR_WORDS 3456
#define XB_SPIN_CAP (1u << 18)

__device__ __forceinline__ unsigned xb_ld(unsigned* p)              { return __hip_atomic_load(p, __ATOMIC_RELAXED, __HIP_MEMORY_SCOPE_AGENT); }
__device__ __forceinline__ unsigned xb_add(unsigned* p, unsigned v) { return __hip_atomic_fetch_add(p, v, __ATOMIC_RELAXED, __HIP_MEMORY_SCOPE_AGENT); }
__device__ __forceinline__ unsigned xb_xcc_id() { return (unsigned)__builtin_amdgcn_s_getreg((3 << 11) | 20) & 0xFu; }
#define XB_SPIN(cond, bar) do { unsigned _sp = 0; while (cond) { __builtin_amdgcn_s_sleep(1); \
    if ((++_sp & 255u) == 0u) { if (xb_ld(&(bar)[XB_TMO])) break; if (_sp > XB_SPIN_CAP) { atomicAdd(&(bar)[XB_TMO], 1u); break; } } } } while (0)

struct XcdBarrier {
    unsigned* bar; unsigned x; int wv;
    volatile LAS unsigned* st;
};
__device__ __forceinline__ XcdBarrier xcd_barrier_post(unsigned* bar, volatile LAS unsigned* st, int wv) {
    XcdBarrier b; b.bar = bar; b.x = xb_xcc_id(); b.st = st; b.wv = wv;
    if (wv == 0 && lane_id() == 0) (void)xb_add(&bar[XB_XCNT(b.x)], 1u);
    return b;
}
__device__ __forceinline__ void xcd_barrier_complete(unsigned* bar, unsigned x, unsigned& nloc, unsigned& nx) {
    const unsigned G = gridDim.x * gridDim.y * gridDim.z;
    unsigned sum, cnt, mine, sp = 0u;
    for (;;) {
        sum = 0u; cnt = 0u; mine = 0u;
#pragma unroll
        for (unsigned j = 0; j < 16; ++j) { const unsigned c = xb_ld(&bar[XB_XCNT(j)]); sum += c; cnt += (c > 0u) ? 1u : 0u; mine = (j == x) ? c : mine; }
        if (sum == G) break;
        __builtin_amdgcn_s_sleep(1);
        if ((++sp & 255u) == 0u) { if (xb_ld(&bar[XB_TMO])) break; if (sp > XB_SPIN_CAP) { atomicAdd(&bar[XB_TMO], 1u); break; } }
    }
    nloc = mine > 0u ? mine : 1u; nx = cnt > 0u ? cnt : 1u;
}
__device__ __forceinline__ void xcd_barrier(const XcdBarrier& b) {
    asm volatile("s_waitcnt vmcnt(0)" ::: "memory");
    __syncthreads();
    if (b.wv == 0 && lane_id() == 0) {
        unsigned* bar = b.bar;
        __builtin_amdgcn_s_waitcnt(0);
        unsigned nloc = b.st[0], nx = b.st[1];
        if (nloc == 0u) { xcd_barrier_complete(bar, b.x, nloc, nx); b.st[0] = nloc; b.st[1] = nx; }
        const unsigned old = xb_add(&bar[XB_XSUB(b.x)], 1u);
        const unsigned gen = old / nloc;
        if (old + 1u == (gen + 1u) * nloc) {
            __builtin_amdgcn_fence(__ATOMIC_RELEASE, "agent");
            asm volatile("s_waitcnt vmcnt(0)" ::: "memory");
            const unsigned og = xb_add(&bar[XB_TOP], 1u);
            const unsigned tg = og / nx;
            if (og + 1u == (tg + 1u) * nx) xb_add(&bar[XB_TOPGEN], 1u);
            else XB_SPIN(xb_ld(&bar[XB_TOPGEN]) == tg, bar);
            __builtin_amdgcn_fence(__ATOMIC_ACQUIRE, "agent");
            xb_add(&bar[XB_XGEN(b.x)], 1u);
            asm volatile("s_waitcnt vmcnt(0)" ::: "memory");
        } else {
            XB_SPIN(xb_ld(&bar[XB_XGEN(b.x)]) == gen, bar);
            __builtin_amdgcn_fence(__ATOMIC_ACQUIRE, "agent");
            asm volatile("s_waitcnt vmcnt(0)" ::: "memory");
        }
    }
    __syncthreads();
}

#define XB_LSUB(j)  (3456 + 64 * (j))
#define XB_LGEN(j)  (3456 + 1024 + 64 * (j))
#define XB_CHK      (3456 + 2048)
#define XCD_BAR_WORDS_EXT (3456 + 2048 + 256)
__device__ __forceinline__ void xcd_local_barrier(const XcdBarrier& b) {
    asm volatile("s_waitcnt vmcnt(0)" ::: "memory");
    __syncthreads();
    if (b.wv == 0 && lane_id() == 0) {
        unsigned* bar = b.bar;
        __builtin_amdgcn_s_waitcnt(0);
        const unsigned nloc = b.st[0];
        const unsigned old = xb_add(&bar[XB_LSUB(b.x)], 1u);
        const unsigned gen = old / nloc;
        if (old + 1u == (gen + 1u) * nloc) xb_add(&bar[XB_LGEN(b.x)], 1u);
        else XB_SPIN(xb_ld(&bar[XB_LGEN(b.x)]) == gen, bar);
        __builtin_amdgcn_fence(__ATOMIC_ACQUIRE, "agent");
        asm volatile("s_waitcnt vmcnt(0)" ::: "memory");
    }
    __syncthreads();
}

namespace att {
__device__ __forceinline__ int crow(int r, int hi) { return (r & 3) + 8 * (r >> 2) + 4 * hi; }
__device__ __forceinline__ void glds16(const void* gsrc, unsigned lds_dst) { unsigned keep;
    asm volatile("s_mov_b32 %0, m0\n\ts_mov_b32 m0, %2\n\ts_nop 0\n\tglobal_load_lds_dwordx4 %1, off\n\ts_mov_b32 m0, %0" : "=&s"(keep) : "v"(gsrc), "s"(lds_dst) : "memory"); }
#define ATT_WAIT_BAR(N) asm volatile("s_waitcnt vmcnt(" #N ") lgkmcnt(0)\n\ts_barrier" ::: "memory")
#define ATT_MX3(a, b, c) __builtin_fmaxf(__builtin_fmaxf((a), (b)), (c))
typedef LAS const unsigned char* lcp;
typedef short v4i16_t __attribute__((ext_vector_type(4)));
__device__ __forceinline__ s16x4 vtr(lcp p) { return __builtin_bit_cast(s16x4, __builtin_amdgcn_ds_read_tr16_b64_v4i16((LAS v4i16_t*)p)); }
__device__ __forceinline__ float rowmax(const f32x16& p0, const f32x16& p1) {
    float a = ATT_MX3(p0[0], p0[1], p1[0]), b = ATT_MX3(p0[2], p0[3], p1[1]); a = ATT_MX3(a, p1[2], p1[3]);
#pragma unroll
    for (int r = 4; r < 16; r += 4) { a = ATT_MX3(a, p0[r], p0[r + 1]); b = ATT_MX3(b, p0[r + 2], p0[r + 3]); a = ATT_MX3(a, p1[r], p1[r + 1]); b = ATT_MX3(b, p1[r + 2], p1[r + 3]); }
    float m = __builtin_fmaxf(a, b); auto rr = __builtin_amdgcn_permlane32_swap(__float_as_uint(m), __float_as_uint(m), false, false);
    return __builtin_fmaxf(__uint_as_float(rr[0]), __uint_as_float(rr[1])); }
template <bool FAKEV = false> __device__ __forceinline__ void pv(f32x16* o, lcp vp, const u32x4 pw0, const u32x4 pw1, const u32x4 pw2, const u32x4 pw3) {
#pragma unroll
    for (int ks = 0; ks < 4; ++ks) {
        const u32x4 pw = ks == 0 ? pw0 : ks == 1 ? pw1 : ks == 2 ? pw2 : pw3;
#pragma unroll
        for (int d0 = 0; d0 < 2; ++d0) {
            bf16x8 vf;
            if (FAKEV) vf = __builtin_bit_cast(bf16x8, ks & 1 ? pw0 : pw2);
            else { const s16x4 lo = vtr(vp + d0 * 4096 + ks * 1024), hi = vtr(vp + d0 * 4096 + ks * 1024 + 512); vf = (bf16x8){lo[0], lo[1], lo[2], lo[3], hi[0], hi[1], hi[2], hi[3]}; }
            o[d0] = __builtin_amdgcn_mfma_f32_32x32x16_bf16(__builtin_bit_cast(bf16x8, pw), vf, o[d0], 0, 0, 0);
        }
    }
}
__device__ __forceinline__ void store_o(const f32x16* o, const float* rsc  , LAS unsigned char* stage, bf16_t* Ow, int pitch, int lane, int r32, int hi) {
    LAS bf16_t* stg = (LAS bf16_t*)stage;
#pragma unroll
    for (int r = 0; r < 16; ++r) { const int orow = crow(r, hi);
#pragma unroll
        for (int d0 = 0; d0 < 2; ++d0) stg[orow * 64 + d0 * 32 + r32] = (bf16_t)(pk_bf16(o[d0][r] * rsc[r], 0.f) & 0xffffu); }
    asm volatile("s_waitcnt lgkmcnt(0)" ::: "memory");
#pragma unroll
    for (int i = 0; i < 4; ++i) { const int row = i * 8 + (lane >> 3), ch = lane & 7; const u32x4 v = *(const LAS u32x4*)(stg + row * 64 + ch * 8); *(u32x4*)(Ow + (size_t)row * pitch + ch * 8) = v; }
}

namespace mla {
constexpr int KSLOT = 12288, VSLOT = 8192, NS = 4;
constexpr int L_K = 0, L_V = NS * KSLOT, L_WS = L_V + NS * VSLOT, L_OST = L_WS + 2048, L_END = L_OST + 8 * 4096;
#define MLA_BAR_L() asm volatile("s_waitcnt lgkmcnt(0)\n\ts_barrier" ::: "memory")
template <int ABL> __device__ __forceinline__ void unit(int b, int h, int qb, const bf16_t* Q, const bf16_t* KT, const bf16_t* VT, bf16_t* O, LAS unsigned char* shm, int wv) {
    int tid_ = wv * 64 + lane_id(); asm volatile("" : "+v"(tid_));
    const int tid = tid_, lane = tid & 63, r32 = lane & 31, hi = lane >> 5; const int wid = __builtin_amdgcn_readfirstlane(tid >> 6);
    const int grp = wid >> 2;
    const long rowbase = (long)b * SEQL; const int q0 = qb * 256;
    const bf16_t* Qw = Q + (size_t)(rowbase + q0 + wid * 32) * 768 + h * 96;
    const bf16_t* Kh = KT + (size_t)((b * 8 + h) * 128) * 6144 + lane * 8;
    const bf16_t* Vh = VT + (size_t)((b * 8 + h) * 128) * 4096 + lane * 8;
    const unsigned lds0 = (unsigned)(uintptr_t)shm;
    LAS float* wsf = (LAS float*)(shm + L_WS) + wid * 64;
    const int NT = (q0 + 256) / 64;
    const int kc2 = 8 + (wid & 3);
    bf16x8 qr[6];
#pragma unroll
    for (int d0 = 0; d0 < 6; ++d0) qr[d0] = *(const bf16x8*)(Qw + (size_t)r32 * 768 + d0 * 16 + hi * 8);
#define MLA_DMA_K(t, sl) do { const bf16_t* kt_ = Kh + (size_t)(t) * 6144; \
        glds16(kt_ + wid * 512, (unsigned)__builtin_amdgcn_readfirstlane(lds0 + L_K + (sl) * KSLOT + wid * 1024)); \
        glds16(kt_ + kc2 * 512, (unsigned)__builtin_amdgcn_readfirstlane(lds0 + L_K + (sl) * KSLOT + kc2 * 1024)); } while (0)
#define MLA_DMA_V(t, sl) glds16(Vh + (size_t)(t) * 4096 + wid * 512, (unsigned)__builtin_amdgcn_readfirstlane(lds0 + L_V + (sl) * VSLOT + wid * 1024))
#define MLA_GROUP(g) do { if ((g) + 4 < NT) MLA_DMA_K((g) + 4, (g) & 3); if ((g) + 3 < NT) MLA_DMA_V((g) + 3, ((g) + 3) & 3); } while (0)
#define MLA_LOADK(sl) do { const lcp kb_ = (lcp)shm + L_K + (sl) * KSLOT + hi * 1024 + r32 * 16; _Pragma("unroll") for (int d0 = 0; d0 < 6; ++d0) { kf[2 * d0] = *(const LAS bf16x8*)(kb_ + d0 * 2048); kf[2 * d0 + 1] = *(const LAS bf16x8*)(kb_ + d0 * 2048 + 512); } } while (0)
    MLA_DMA_K(0, 0); MLA_DMA_K(1, 1); MLA_DMA_V(0, 0); MLA_DMA_K(2, 2); MLA_DMA_V(1, 1); MLA_DMA_K(3, 3); MLA_DMA_V(2, 2);
    float m = 0.f; f32x16 o[2], negm, lsum;
#pragma unroll
    for (int r = 0; r < 16; ++r) { o[0][r] = 0.f; o[1][r] = 0.f; negm[r] = 0.f; lsum[r] = 0.f; }
    const bf16x8 ones = {0x3F80, 0x3F80, 0x3F80, 0x3F80, 0x3F80, 0x3F80, 0x3F80, 0x3F80};
    const int qrel = wid * 32 + r32;
    bf16x8 kf[12], vf[8]; u32x4 pw0 = {0u, 0u, 0u, 0u}, pw1 = pw0, pw2 = pw0, pw3 = pw0;
    ATT_WAIT_BAR(9);
    MLA_LOADK(0);
    if (grp == 1) ATT_WAIT_BAR(6);
    bool act_prev = false;
    for (int t = 0; t < NT; ++t) {
        const int s0 = t & 3, s1 = (t + 1) & 3;
        if (grp == 1) MLA_GROUP(t);
        const int jb = t - (NT - 4);
        const bool act = ABL != 5 && (jb <= 0 || 64 * jb <= wid * 32 + 31);
        f32x16 p0 = negm, p1 = negm;
        if (act) {
#pragma unroll
            for (int d0 = 0; d0 < 6; ++d0) { p0 = __builtin_amdgcn_mfma_f32_32x32x16_bf16(kf[2 * d0], qr[d0], p0, 0, 0, 0); p1 = __builtin_amdgcn_mfma_f32_32x32x16_bf16(kf[2 * d0 + 1], qr[d0], p1, 0, 0, 0); }
        }
        if (act_prev) {
#pragma unroll
            for (int ks = 0; ks < 4; ++ks) { const u32x4 pw = ks == 0 ? pw0 : ks == 1 ? pw1 : ks == 2 ? pw2 : pw3;
                o[0] = __builtin_amdgcn_mfma_f32_32x32x16_bf16(__builtin_bit_cast(bf16x8, pw), vf[ks], o[0], 0, 0, 0);
                o[1] = __builtin_amdgcn_mfma_f32_32x32x16_bf16(__builtin_bit_cast(bf16x8, pw), vf[4 + ks], o[1], 0, 0, 0);
                lsum = __builtin_amdgcn_mfma_f32_32x32x16_bf16(__builtin_bit_cast(bf16x8, pw), ones, lsum, 0, 0, 0); }
        }
        if (grp == 0) { if (t + 3 < NT) ATT_WAIT_BAR(6); else ATT_WAIT_BAR(0); MLA_GROUP(t); }
        else MLA_BAR_L();
        if (act && (ABL != 7 || t == 0)) {
            { const lcp vp = (lcp)shm + L_V + s0 * VSLOT + ((lane >> 4) & 1) * 32 + (lane & 3) * 8 + (4 * hi + ((lane & 15) >> 2)) * 64;
#pragma unroll
                for (int d0 = 0; d0 < 2; ++d0)
#pragma unroll
                    for (int ks = 0; ks < 4; ++ks) { const s16x4 lo = vtr(vp + d0 * 4096 + ks * 1024), hh = vtr(vp + d0 * 4096 + ks * 1024 + 512);
                        vf[d0 * 4 + ks] = (bf16x8){lo[0], lo[1], lo[2], lo[3], hh[0], hh[1], hh[2], hh[3]}; } }
        }
        if (t + 1 < NT && ABL != 6) MLA_LOADK(s1);
        if (act) {
            if (jb >= 0) {
#pragma unroll
                for (int r = 0; r < 16; ++r) { const int kv = 64 * jb + crow(r, hi); if (kv > qrel) p0[r] = -INFINITY; if (kv + 32 > qrel) p1[r] = -INFINITY; }
            }
            const float rm = rowmax(p0, p1);
            if (t == 0 || __any(rm > 8.0f)) {
                const float dl = t == 0 ? rm : __builtin_fmaxf(rm, 0.f); m += dl;
#pragma unroll
                for (int r = 0; r < 16; ++r) { p0[r] -= dl; p1[r] -= dl; negm[r] = -m; }
                const float alpha = fast_exp2(-dl); if (hi == 0) wsf[r32] = alpha;
#pragma unroll
                for (int r = 0; r < 16; ++r) { const float a = wsf[crow(r, hi)]; o[0][r] *= a; o[1][r] *= a; lsum[r] *= a; }
            }
#pragma unroll
            for (int r = 0; r < 16; ++r) { if (ABL != 1) { p0[r] = fast_exp2(p0[r]); p1[r] = fast_exp2(p1[r]); } }
            pw0 = (u32x4){pk_bf16(p0[0], p0[1]), pk_bf16(p0[2], p0[3]), pk_bf16(p0[4], p0[5]), pk_bf16(p0[6], p0[7])};
            pw1 = (u32x4){pk_bf16(p0[8], p0[9]), pk_bf16(p0[10], p0[11]), pk_bf16(p0[12], p0[13]), pk_bf16(p0[14], p0[15])};
            pw2 = (u32x4){pk_bf16(p1[0], p1[1]), pk_bf16(p1[2], p1[3]), pk_bf16(p1[4], p1[5]), pk_bf16(p1[6], p1[7])};
            pw3 = (u32x4){pk_bf16(p1[8], p1[9]), pk_bf16(p1[10], p1[11]), pk_bf16(p1[12], p1[13]), pk_bf16(p1[14], p1[15])};
        }
        act_prev = act;
        if (grp == 0) MLA_BAR_L();
        else { if (t + 4 < NT) ATT_WAIT_BAR(6); else ATT_WAIT_BAR(0); }
    }
#undef MLA_DMA_K
#undef MLA_DMA_V
#undef MLA_GROUP
#undef MLA_LOADK
    if (act_prev) {
#pragma unroll
        for (int ks = 0; ks < 4; ++ks) { const u32x4 pw = ks == 0 ? pw0 : ks == 1 ? pw1 : ks == 2 ? pw2 : pw3;
            o[0] = __builtin_amdgcn_mfma_f32_32x32x16_bf16(__builtin_bit_cast(bf16x8, pw), vf[ks], o[0], 0, 0, 0);
            o[1] = __builtin_amdgcn_mfma_f32_32x32x16_bf16(__builtin_bit_cast(bf16x8, pw), vf[4 + ks], o[1], 0, 0, 0);
                lsum = __builtin_amdgcn_mfma_f32_32x32x16_bf16(__builtin_bit_cast(bf16x8, pw), ones, lsum, 0, 0, 0); }
    }
    if (grp == 0) MLA_BAR_L();
    float rli[16];
#pragma unroll
    for (int r = 0; r < 16; ++r) rli[r] = fast_rcp(lsum[r]);
    store_o(o, rli, shm + L_OST + wid * 4096, O + (size_t)(rowbase + q0 + wid * 32) * 512 + h * 64, 512, lane, r32, hi);
    MLA_BAR_L();
}
template <int ABL> __device__ __forceinline__ void phase(int vcu, int G, const bf16_t* Q, const bf16_t* KT, const bf16_t* VT, bf16_t* O, LAS unsigned char* shm, int wv) {
    for (int v = vcu; v < 256; v += G) { const int bh = v >> 4, s = v & 15;
        unit<ABL>(bh >> 3, bh & 7, 31 - s, Q, KT, VT, O, shm, wv);
        unit<ABL>(bh >> 3, bh & 7, s, Q, KT, VT, O, shm, wv); }
}
}

namespace sba {
constexpr int KSLOT = 8192, VSLOT = 8192, NS = 3;
constexpr int L_K = 0, L_V = NS * KSLOT, L_WS = L_V + NS * VSLOT, L_FLAG = L_WS + 2048, L_OST = L_FLAG + 256, L_END = L_OST + 8 * 4096;
constexpr float SB_EXIT = 1.0e-42f;
template <int ABL = 0> __device__ __forceinline__ void unit(int b, int kh, int qb64, const bf16_t* Q, const bf16_t* KT, const bf16_t* VT, bf16_t* O, LAS unsigned char* shm, int wv) {
    int tid_ = wv * 64 + lane_id(); asm volatile("" : "+v"(tid_));
    const int tid = tid_, lane = tid & 63, r32 = lane & 31, hi = lane >> 5; const int wid = __builtin_amdgcn_readfirstlane(tid >> 6);
    const int h = kh * 4 + (wid >> 1), half = wid & 1;
    const long rowbase = (long)b * SEQL; const int q0 = qb64 * 64;
    const bf16_t* Qw = Q + (size_t)(rowbase + q0 + half * 32) * 1024 + h * 64;
    const bf16_t* Kh = KT + (size_t)((b * 4 + kh) * 128) * 4096 + wid * 512 + lane * 8;
    const bf16_t* Vh = VT + (size_t)((b * 4 + kh) * 128) * 4096 + wid * 512 + lane * 8;
    const unsigned lds0 = (unsigned)(uintptr_t)shm;
    LAS int* flags = (LAS int*)(shm + L_FLAG);
    const int NT = qb64 + 1;
#define SBA_DMA(k, sl) do { const int tile_ = qb64 - (k); \
        glds16(Kh + (size_t)tile_ * 4096, (unsigned)__builtin_amdgcn_readfirstlane(lds0 + L_K + (sl) * KSLOT + wid * 1024)); \
        glds16(Vh + (size_t)tile_ * 4096, (unsigned)__builtin_amdgcn_readfirstlane(lds0 + L_V + (sl) * VSLOT + wid * 1024)); } while (0)
    SBA_DMA(0, 0); if (NT > 1) SBA_DMA(1, 1);
    bf16x8 qr[4];
#pragma unroll
    for (int d0 = 0; d0 < 4; ++d0) qr[d0] = *(const bf16x8*)(Qw + (size_t)r32 * 1024 + d0 * 16 + hi * 8);
    float R = 1.f; f32x16 o[2];
#pragma unroll
    for (int r = 0; r < 16; ++r) { o[0][r] = 0.f; o[1][r] = 0.f; }
    const int qrel = half * 32 + r32;
    int slot = 0;
    for (int k = 0; k < NT; ++k) {
        if (k + 1 < NT) ATT_WAIT_BAR(2); else ATT_WAIT_BAR(0);
        if (k > 0) { const LAS int* f = flags + ((k - 1) & 1) * 8; int all = 1;
#pragma unroll
            for (int w = 0; w < 8; ++w) all &= f[w];
            if (all) break; }
        if (k + 2 < NT) { const int s2 = slot == 0 ? 2 : slot - 1; SBA_DMA(k + 2, s2); }
        if (ABL == 3) { if (lane == 0) flags[(k & 1) * 8 + wid] = (k >= 2); } else {
            const lcp kb = (lcp)shm + L_K + slot * KSLOT + hi * 1024 + r32 * 16;
            f32x16 p0, p1;
#pragma unroll
            for (int r = 0; r < 16; ++r) { p0[r] = 0.f; p1[r] = 0.f; }
#pragma unroll
            for (int d0 = 0; d0 < 4; ++d0) { const bf16x8 b0 = *(const LAS bf16x8*)(kb + d0 * 2048), b1 = *(const LAS bf16x8*)(kb + d0 * 2048 + 512);
                p0 = __builtin_amdgcn_mfma_f32_32x32x16_bf16(b0, qr[d0], p0, 0, 0, 0); p1 = __builtin_amdgcn_mfma_f32_32x32x16_bf16(b1, qr[d0], p1, 0, 0, 0); }
            f32x16 N0, N1;
#pragma unroll
            for (int r = 0; r < 16; r += 2) {
                f32x2 e0, e1; e0.x = fast_exp2(-p0[r]); e0.y = fast_exp2(-p0[r + 1]); e1.x = fast_exp2(-p1[r]); e1.y = fast_exp2(-p1[r + 1]);
                const f32x2 d0 = e0 + 1.0f, d1 = e1 + 1.0f;
                f32x2 b0, b1; b0.x = fast_rcp(d0.x); b0.y = fast_rcp(d0.y); b1.x = fast_rcp(d1.x); b1.y = fast_rcp(d1.y);
                f32x2 n0 = 1.0f - b0, n1 = 1.0f - b1;
                if (k == 0) { const int kv = crow(r, hi), kw = crow(r + 1, hi);
                    if (kv >= qrel) { b0.x = 0.f; n0.x = 1.f; } if (kw >= qrel) { b0.y = 0.f; n0.y = 1.f; } if (kv + 32 >= qrel) { b1.x = 0.f; n1.x = 1.f; } if (kw + 32 >= qrel) { b1.y = 0.f; n1.y = 1.f; } }
                p0[r] = b0.x; p0[r + 1] = b0.y; p1[r] = b1.x; p1[r + 1] = b1.y; N0[r] = n0.x; N0[r + 1] = n0.y; N1[r] = n1.x; N1[r + 1] = n1.y; }
            float G[16];
#pragma unroll
            for (int j = 0; j < 8; ++j) { const f32x16& NN = j < 4 ? N0 : N1; const int rb = 4 * (j & 3);
                const f32x2 t2 = (f32x2){NN[rb], NN[rb + 1]} * (f32x2){NN[rb + 2], NN[rb + 3]}; const float gp = t2.x * t2.y;
                auto rr = __builtin_amdgcn_permlane32_swap(__float_as_uint(gp), __float_as_uint(gp), false, false);
                G[2 * j] = __uint_as_float(rr[0]); G[2 * j + 1] = __uint_as_float(rr[1]); }
            float SG[16]; SG[15] = 1.f;
#pragma unroll
            for (int g = 14; g >= 0; --g) SG[g] = SG[g + 1] * G[g + 1];
            const float T = SG[0] * G[0];
#pragma unroll
            for (int j = 0; j < 8; ++j) { f32x16& NN = j < 4 ? N0 : N1; f32x16& PP = j < 4 ? p0 : p1; const int rb = 4 * (j & 3);
                const float base = (R * SG[2 * j + 1]) * (hi ? 1.f : G[2 * j + 1]);
                const float r3 = base, r2 = r3 * NN[rb + 3], r1 = r2 * NN[rb + 2], r0 = r1 * NN[rb + 1];
                const f32x2 ph = (f32x2){PP[rb + 2], PP[rb + 3]} * (f32x2){r2, r3}, pl = (f32x2){PP[rb], PP[rb + 1]} * (f32x2){r0, r1};
                PP[rb + 3] = ph.y; PP[rb + 2] = ph.x; PP[rb + 1] = pl.y; PP[rb] = pl.x; }
            R *= T;
            const u32x4 pw0 = {pk_bf16(p0[0], p0[1]), pk_bf16(p0[2], p0[3]), pk_bf16(p0[4], p0[5]), pk_bf16(p0[6], p0[7])};
            const u32x4 pw1 = {pk_bf16(p0[8], p0[9]), pk_bf16(p0[10], p0[11]), pk_bf16(p0[12], p0[13]), pk_bf16(p0[14], p0[15])};
            const u32x4 pw2 = {pk_bf16(p1[0], p1[1]), pk_bf16(p1[2], p1[3]), pk_bf16(p1[4], p1[5]), pk_bf16(p1[6], p1[7])};
            const u32x4 pw3 = {pk_bf16(p1[8], p1[9]), pk_bf16(p1[10], p1[11]), pk_bf16(p1[12], p1[13]), pk_bf16(p1[14], p1[15])};
            const lcp vp = (lcp)shm + L_V + slot * VSLOT + ((lane >> 4) & 1) * 32 + (lane & 3) * 8 + (4 * hi + ((lane & 15) >> 2)) * 64;
            if (ABL != 2) pv(o, vp, pw0, pw1, pw2, pw3); else o[0][0] += __uint_as_float(pw0.x ^ pw1.y ^ pw2.z ^ pw3.w);
            const int dn = (ABL == 4 || __all(R < SB_EXIT)) ? 1 : 0;
            if (lane == 0) flags[(k & 1) * 8 + wid] = dn;
        }
        slot = slot == 2 ? 0 : slot + 1;
    }
#undef SBA_DMA
    ATT_WAIT_BAR(0);
    float one[16];
#pragma unroll
    for (int r = 0; r < 16; ++r) one[r] = 1.0f;
    store_o(o, one, shm + L_OST + wid * 4096, O + (size_t)(rowbase + q0 + half * 32) * 1024 + h * 64, 1024, lane, r32, hi);
    asm volatile("s_waitcnt lgkmcnt(0)\n\ts_barrier" ::: "memory");
}
__device__ __forceinline__ void phase(int vcu, int G, const bf16_t* Q, const bf16_t* KT, const bf16_t* VT, bf16_t* O, LAS unsigned char* shm, int wv) {
    for (int u = vcu * 4; u < 1024; u += G * 4)
        for (int i = 0; i < 4; ++i) { const int uu = u + i, qb64 = uu & 127, bk = uu >> 7; unit(bk >> 2, bk & 3, qb64, Q, KT, VT, O, shm, wv); }
}
}
}
#ifndef FP8_FDN
#define FP8_FDN 0
#endif
#ifndef FP8_EGU
#define FP8_EGU 1
#endif
#ifndef FP8_EDN
#define FP8_EDN 1
#endif
#ifndef FP8_DOWN
#define FP8_DOWN (FP8_FDN || FP8_EDN)
#endif
namespace fw {
constexpr size_t MiB = 1u << 20;
constexpr int NWAVES = 8, NTHR = 512;
constexpr int MAXSLOT = 34816;
constexpr size_t WS_CTL = 0, CTL_ZERO_BYTES = 64 * 1024;
constexpr size_t WS_TOKE = 1 * MiB;
constexpr size_t WS_TOKG = WS_TOKE + 64 * 1024;
constexpr size_t WS_TOKRS = WS_TOKG + 128 * 1024;
constexpr size_t WS_SLOT12 = WS_TOKRS + 64 * 1024;
constexpr size_t WS_SLOTG = WS_SLOT12 + 128 * 1024;
constexpr size_t WS_SLOTRS = WS_SLOTG + 256 * 1024;
constexpr size_t WS_CNT = WS_SLOTRS + 256 * 1024;
constexpr size_t WS_PSTART = WS_CNT + 16 * 1024;
constexpr size_t WS_CS = 4 * MiB;
constexpr size_t WS_SSQ = 6 * MiB;
constexpr size_t WS_SSQQ = 8 * MiB;
constexpr size_t WS_SSQKV = WS_SSQQ + 512 * 1024;
constexpr size_t WS_KPE = 9 * MiB;
constexpr size_t WS_SSPE = 11 * MiB;
constexpr size_t WS_W = 16 * MiB;
constexpr size_t W_AIN = WS_W, W_QUP = W_AIN + 3 * MiB, W_KVUP = W_QUP + 2 * MiB, W_AOUT = W_KVUP + 1 * MiB, W_KVS = W_AOUT + 2 * MiB, W_QB = W_KVS + 1 * MiB,
                 W_OB = W_QB + 4 * MiB, W_PG = W_OB + 4 * MiB, W_PU = W_PG + 8 * MiB, W_FGU = W_PU + 2 * MiB, W_FDN = W_FGU + 22 * MiB, W_EGU = W_FDN + 11 * MiB,
                 W_EDN = W_EGU + 176 * MiB, W_END = W_EDN + 88 * MiB;
constexpr size_t WS_PB = W_END;
constexpr size_t WS_HB = WS_PB + 32 * MiB;
constexpr size_t WS_U = WS_HB + 64 * MiB;
constexpr size_t WS_SKT = WS_U + 128 * MiB, WS_SVT = WS_SKT + 8 * MiB;
constexpr size_t WS_X = WS_SVT + 8 * MiB;
constexpr size_t X_AQ = WS_X, X_AKV = X_AQ + 12 * MiB, X_QRAW = X_AKV + 8 * MiB, X_KVRAW = X_QRAW + 24 * MiB, X_Q = X_KVRAW + 32 * MiB, X_KT = X_Q + 24 * MiB, X_VT = X_KT + 24 * MiB, X_O = X_VT + 16 * MiB;
constexpr size_t X_SQ = WS_X, X_SO = X_SQ + 32 * MiB;
constexpr size_t X_XG = WS_X, X_HG = X_XG + 68 * MiB, X_YG = X_HG + 187 * MiB, X_END = X_YG + 68 * MiB;
constexpr size_t WS_END = X_END;
constexpr size_t X_HID = WS_END + 128 * MiB;
constexpr size_t WS_NEED = X_HID + 88 * MiB;
static_assert(X_O + 16 * MiB <= X_END && (size_t)MAXSLOT * 2816 * 2 <= 187 * MiB && (size_t)MAXSLOT * 1024 * 2 <= 68 * MiB, "ws map");
constexpr int CW_BAR = 1024;
constexpr int RING_OFF = 0, RING_BYTES = 131072, LDSCTL_OFF = RING_BYTES, MISC_OFF = LDSCTL_OFF + 320, XS_OFF = LDSCTL_OFF + 1024  , LDS_BYTES = 147456;
static_assert(att::mla::L_END <= RING_BYTES && att::sba::L_END <= RING_BYTES, "attention LDS");
constexpr float QSCALE_MLA = 0.10206207261596577f * LOG2E;
constexpr float QSCALE_SB = 0.125f * LOG2E;

struct EpiQ {
    static constexpr bool PERM = true, AFTER_DRAIN = false;
    unsigned char* ws; const float* gq;
    __device__ __forceinline__ void operator()(const f32x4 (&acc)[2][2][4][2], const pg8::Unit& u, int wr, int wc, int fr_, int fq_) const {
        const int ln_ = lane_id(), fr = ln_ & 15, fq = ln_ >> 4; (void)fr_; (void)fq_;
        const int row0 = u.pm * pg8::BM + wr * 64 + fr, c = wc * 32 + 8 * fq;
        LAS float* xs = (LAS float*)(uintptr_t)XS_OFF;
        bf16_t* Q = (bf16_t*)(ws + X_Q); const float* CS = (const float*)(ws + WS_CS); const pg8::RowScale rs{(const float*)(ws + WS_SSQQ), 3}; const float qscale = QSCALE_MLA;
        float rsv[2][4]; rs.get8(rsv, row0, fq);
#pragma unroll
        for (int ai = 0; ai < 2; ++ai)
#pragma unroll
            for (int m = 0; m < 4; ++m) { const int rl = ai * pg8::HALF + wr * 64 + m * 16 + fr; const float s = rsv[ai][m];
#pragma unroll
                for (int bj = 0; bj < 2; ++bj) { const float q = pg8::red_fq(pg8::sumsq8(acc[ai][bj][m][0], acc[ai][bj][m][1])) * (s * s); if (fq == 0) xs[(rl * 2 + bj) * 4 + wc] = q; }
                asm volatile("" ::: "memory"); }
        asm volatile("s_waitcnt lgkmcnt(0)" ::: "memory"); __builtin_amdgcn_s_barrier(); asm volatile("" ::: "memory");
        const int cg = wc < 3 ? c : 0;
#pragma unroll
        for (int ai = 0; ai < 2; ++ai)
#pragma unroll
            for (int m = 0; m < 4; ++m) { const int rl = ai * pg8::HALF + wr * 64 + m * 16 + fr, row = row0 + ai * pg8::HALF + m * 16;
                const f32x4 g0 = *(const f32x4*)(gq + cg), g1 = *(const f32x4*)(gq + cg + 4);
#pragma unroll
                for (int bj = 0; bj < 2; ++bj) { const f32x4 p4 = *(const LAS f32x4*)(xs + (rl * 2 + bj) * 4);
                    const float ss = (p4[0] + p4[1]) + (p4[2] + p4[3]); const float sc = rsv[ai][m] * (1.0f / sqrtf(ss * (1.0f / 96.0f) + RMS_EPS)) * qscale;
                    f32x4 v0 = acc[ai][bj][m][0] * g0 * sc, v1 = acc[ai][bj][m][1] * g1 * sc;
                    if (wc == 2) pg8::rope8(v0, v1, CS + (size_t)row * 32, fq);
                    if (wc < 3) *(u32x4*)(Q + (size_t)row * 768 + (2 * u.pn + bj) * 96 + c) = pack8(v0, v1); }
                asm volatile("" ::: "memory"); }
    }
};
struct EpiKV {
    static constexpr bool PERM = true, AFTER_DRAIN = false;
    unsigned char* ws; const float* gk;
    __device__ __forceinline__ void operator()(const f32x4 (&acc)[2][2][4][2], const pg8::Unit& u, int wr, int wc, int fr_, int fq_) const {
        const int ln_ = lane_id(), fr = ln_ & 15, fq = ln_ >> 4; (void)fr_; (void)fq_;
        const int row0 = u.pm * pg8::BM + wr * 64 + fr, c = (wc & 1) * 32 + 8 * fq;
        LAS float* xs = (LAS float*)(uintptr_t)XS_OFF;
        bf16_t* KT = (bf16_t*)(ws + X_KT); bf16_t* VT = (bf16_t*)(ws + X_VT); const float* KPE = (const float*)(ws + WS_KPE); const float* SSPE = (const float*)(ws + WS_SSPE); const pg8::RowScale rs{(const float*)(ws + WS_SSQKV), 4};
        float rsv[2][4]; rs.get8(rsv, row0, fq);
#pragma unroll
        for (int ai = 0; ai < 2; ++ai)
#pragma unroll
            for (int m = 0; m < 4; ++m) { const int rl = ai * pg8::HALF + wr * 64 + m * 16 + fr; const float s = rsv[ai][m];
#pragma unroll
                for (int bj = 0; bj < 2; ++bj) { const float q = pg8::red_fq(pg8::sumsq8(acc[ai][bj][m][0], acc[ai][bj][m][1])) * (s * s); if (fq == 0 && wc < 2) xs[(rl * 2 + bj) * 2 + wc] = q; }
                asm volatile("" ::: "memory"); }
        asm volatile("s_waitcnt lgkmcnt(0)" ::: "memory"); __builtin_amdgcn_s_barrier(); asm volatile("" ::: "memory");
#pragma unroll
        for (int ai = 0; ai < 2; ++ai)
#pragma unroll
            for (int m = 0; m < 4; ++m) { const int rl = ai * pg8::HALF + wr * 64 + m * 16 + fr, row = row0 + ai * pg8::HALF + m * 16; const float s = rsv[ai][m];
                const f32x4 g0 = *(const f32x4*)(gk + c), g1 = *(const f32x4*)(gk + c + 4);
                const int b = row >> 13, sq = row & 8191, tile = sq >> 6, rr = sq & 63;
                const f32x4 k0 = *(const f32x4*)(KPE + (size_t)row * 32 + 8 * fq), k1 = *(const f32x4*)(KPE + (size_t)row * 32 + 8 * fq + 4);
                const float sspe = SSPE[row];
#pragma unroll
                for (int bj = 0; bj < 2; ++bj) { const int h = 2 * u.pn + bj; const size_t tb = (size_t)((b * 8 + h) * 128 + tile);
                    const float ssn = xs[(rl * 2 + bj) * 2] + xs[(rl * 2 + bj) * 2 + 1];
                    const float rk = 1.0f / sqrtf((ssn + sspe) * (1.0f / 96.0f) + RMS_EPS);
                    if (wc < 2) *(u32x4*)(KT + tb * 6144 + (c >> 3) * 512 + rr * 8) = pack8(acc[ai][bj][m][0] * g0 * (s * rk), acc[ai][bj][m][1] * g1 * (s * rk));
                    else *(u32x4*)(VT + tb * 4096 + (wc - 2) * 2048 + rr * 32 + 8 * fq) = pack8(acc[ai][bj][m][0] * s, acc[ai][bj][m][1] * s);
                    if (wc == 2) *(u32x4*)(KT + tb * 6144 + (8 + fq) * 512 + rr * 8) = pack8(k0 * rk, k1 * rk); }
                asm volatile("" ::: "memory"); }
    }
};
constexpr int PH_PER_LAYER = 12, PH_TOTAL = 2 + 4 * PH_PER_LAYER;
__host__ __device__ inline bool phase_active(int idx) {
    if (idx == 0) return true;
    if (idx == 1) return false;
    const int l = (idx - 2) / PH_PER_LAYER, s = (idx - 2) % PH_PER_LAYER; const bool mla = l < 2, moe = (l & 1) != 0;
    if (s == 1 || s == 3) return mla;
    if (s == 2) return false;
    if (s >= 7 && s <= 9) return moe;
    if (s == 11) return l == 1;
    return true;
}

struct Args { const float* in[26]; float* out; unsigned char* ws; int ph_lo, ph_hi; };

struct Frame { LAS unsigned char* lds; int tid, lane, wave, vcu, G; };

__device__ __forceinline__ float shx(float v, int k, int lane) { return __uint_as_float((unsigned)__builtin_amdgcn_ds_bpermute((lane ^ k) << 2, (int)__float_as_uint(v))); }
__device__ __forceinline__ int shi(int v, int src, int lane) { (void)lane; return __builtin_amdgcn_ds_bpermute(src << 2, v); }
__device__ __forceinline__ float wave_sum(float v, int lane) {
#pragma unroll
    for (int o = 1; o < 64; o <<= 1) v += shx(v, o, lane);
    return v;
}
template <bool NT, bool F8 = false> __device__ __forceinline__ void transpose_item(const float* W, int ldw, int sca, int scb, const float* gain, bf16_t* WT, int K, int drow0, int k0, LAS float* scr, int lane, float f8s = 64.f) {
    const int r8 = lane >> 3, pc = lane & 7, c = lane & 7;
    f32x4 va[8], vb[8]; float g[8];
    const f32x4 z4 = {0.f, 0.f, 0.f, 0.f};
#pragma unroll
    for (int i = 0; i < 8; ++i) { const float* rp = W + (size_t)(k0 + i * 8 + r8) * ldw + 4 * pc;
        if (NT) { va[i] = sca >= 0 ? __builtin_nontemporal_load((const f32x4*)(rp + sca)) : z4; vb[i] = scb >= 0 ? __builtin_nontemporal_load((const f32x4*)(rp + scb)) : z4; }
        else { va[i] = sca >= 0 ? *(const f32x4*)(rp + sca) : z4; vb[i] = scb >= 0 ? *(const f32x4*)(rp + scb) : z4; }
        g[i] = gain ? gain[k0 + i * 8 + r8] : 1.0f; }
#pragma unroll
    for (int hf = 0; hf < 2; ++hf) {
#pragma unroll
        for (int i = 0; i < 8; ++i) { const f32x4 v = (hf == 0 ? va[i] : vb[i]) * g[i]; LAS float* d = scr + (i * 8 + r8) * 33 + 4 * pc; d[0] = v[0]; d[1] = v[1]; d[2] = v[2]; d[3] = v[3]; }
        asm volatile("s_waitcnt lgkmcnt(0)" ::: "memory");
#pragma unroll
        for (int j = 0; j < 4; ++j) { const int n = (lane >> 3) + 8 * j; const LAS float* s = scr + (8 * c) * 33 + n;
            u32x4 o; o.x = pk_bf16(s[0 * 33], s[1 * 33]); o.y = pk_bf16(s[2 * 33], s[3 * 33]); o.z = pk_bf16(s[4 * 33], s[5 * 33]); o.w = pk_bf16(s[6 * 33], s[7 * 33]);
            if (F8) { const f32x4 q0 = {s[0 * 33] * f8s, s[1 * 33] * f8s, s[2 * 33] * f8s, s[3 * 33] * f8s}, q1 = {s[4 * 33] * f8s, s[5 * 33] * f8s, s[6 * 33] * f8s, s[7 * 33] * f8s};
                *(u32x2*)((unsigned char*)WT + (size_t)(drow0 + hf * 32 + n) * K + k0 + 8 * c) = pack8_fp8(q0, q1); }
            else if (NT) __builtin_nontemporal_store(o, (u32x4*)(WT + (size_t)(drow0 + hf * 32 + n) * K + k0 + 8 * c)); else *(u32x4*)(WT + (size_t)(drow0 + hf * 32 + n) * K + k0 + 8 * c) = o; }
        asm volatile("s_waitcnt lgkmcnt(0)" ::: "memory");
    }
}
struct Fam { int src, count, K, Nd, ldw, map, gain, gstride; size_t sstride, dst, dstride; };
__device__ __forceinline__ int fam_items(const Fam& f) { return f.count * (f.K / 64) * (f.Nd / 64); }
__device__ __forceinline__ int fam_src_col(int map, int n0) {
    if (map == 1) return n0 < 384 ? n0 : (n0 < 416 ? 640 + (n0 - 384) : (n0 < 512 ? -1 : 384 + (n0 - 512)));
    if (map == 2) { const int pn = n0 >> 8, jj = n0 & 255; return jj < 128 ? pn * 128 + jj : 2816 + pn * 128 + (jj - 128); }
    if (map == 3) { const int h = n0 >> 7, off = n0 & 127; return off < 96 ? 96 * h + off : -1; }
    return n0;
}
template <bool NT = false> __device__ __forceinline__ void fam_item(const Args& a, const Fam& f, int fid, int it, LAS float* scr, int lane, int mi_off = 0) {
    const int per = (f.K / 64) * (f.Nd / 64), mi = it / per + mi_off, r = it % per, nblk = f.Nd / 64, kb = r / nblk, nb = r % nblk, n0 = nb * 64;
    const float* gain = nullptr;
    if (f.gain >= 0) gain = a.in[f.gain] + (fid == 11 ? (size_t)(2 * (mi >> 3) + 1) * 1024 : (size_t)mi * f.gstride);
#if FP8_DOWN || FP8_EGU
    if ((FP8_FDN && fid == 10) || (FP8_EDN && fid == 12) || (FP8_EGU && fid == 11)) { transpose_item<NT, true>(a.in[f.src] + (size_t)mi * f.sstride, f.ldw, fam_src_col(f.map, n0), fam_src_col(f.map, n0 + 32), gain, (bf16_t*)(a.ws + f.dst + (size_t)mi * f.dstride), f.K, n0, kb * 64, scr, lane, fid == 11 ? 32.f : 64.f); return; }
#endif
    transpose_item<NT>(a.in[f.src] + (size_t)mi * f.sstride, f.ldw, fam_src_col(f.map, n0), fam_src_col(f.map, n0 + 32), gain, (bf16_t*)(a.ws + f.dst + (size_t)mi * f.dstride), f.K, n0, kb * 64, scr, lane);
}
__constant__ const Fam FAMS[13] = {
        {4, 2, 1024, 768, 672, 1, 3, 1024, (size_t)1024 * 672, W_AIN, (size_t)768 * 1024 * 2},
        {7, 2, 384, 1024, 768, 3, 5, 384, (size_t)384 * 768, W_QUP, (size_t)1024 * 384 * 2},
        {8, 2, 256, 1024, 1024, 0, 6, 256, (size_t)256 * 1024, W_KVUP, (size_t)1024 * 256 * 2},
        {11, 2, 512, 1024, 1024, 0, -1, 0, (size_t)512 * 1024, W_AOUT, (size_t)1024 * 512 * 2},
        {13, 1, 1024, 512, 512, 0, 12, 0, 0, W_KVS, 0},
        {15, 2, 1024, 1024, 1024, 0, 14, 1024, (size_t)1024 * 1024, W_QB, (size_t)1024 * 1024 * 2},
        {16, 2, 1024, 1024, 1024, 0, -1, 0, (size_t)1024 * 1024, W_OB, (size_t)1024 * 1024 * 2},
        {24, 4, 1024, 1024, 1024, 0, 23, 1024, (size_t)1024 * 1024, W_PG, (size_t)1024 * 1024 * 2},
        {25, 4, 256, 1024, 1024, 0, -1, 0, (size_t)256 * 1024, W_PU, (size_t)1024 * 256 * 2},
        {18, 1, 1024, 5632, 5632, 2, 17, 2048, (size_t)1024 * 5632, W_FGU, (size_t)5632 * 1024 * 2},
        {19, 1, 2816, 1024, 1024, 0, -1, 0, (size_t)2816 * 1024, W_FDN, (size_t)1024 * 2816 * 2},
        {21, 8, 1024, 5632, 5632, 2, 17, 0, (size_t)1024 * 5632, W_EGU, (size_t)5632 * 1024 * 2},
        {22, 8, 2816, 1024, 1024, 0, -1, 0, (size_t)2816 * 1024, W_EDN, (size_t)1024 * 2816 * 2}};
constexpr int DEF_N0 = 1408, DEF_N1 = DEF_N0 + 704, DEF_N2 = DEF_N1 + 11264, DEF_N3 = DEF_N2 + 5632;
#ifndef FILL_A
#define FILL_A 0
#define FILL_B 0
#define FILL_C 0
#define FILL_D 0
#endif
constexpr int DEF_QA = FILL_A, DEF_QB = DEF_QA + FILL_B, DEF_QC = DEF_QB + FILL_C, DEF_QD = DEF_QC + FILL_D;
constexpr int CW_FILL = 512;
__device__ __forceinline__ void prologue(const Args& a, Frame& F) {
    LAS float* scr = (LAS float*)(F.lds + RING_OFF + F.wave * 16384);
    const int gw = F.vcu * NWAVES + F.wave, NGW = F.G * NWAVES;
    int base = 0;
#pragma unroll 1
    for (int fid = 0; fid < 13; ++fid) { const Fam f = FAMS[fid]; const int n = fam_items(f);
        int it = gw - (base % NGW); if (it < 0) it += NGW;
#pragma unroll 1
        for (; it < n; it += NGW) fam_item(a, f, fid, it, scr, F.lane);
        base += n; }
    for (int id = DEF_QD + gw; id < DEF_N3; id += NGW) {
        if (id < DEF_N0) fam_item(a, FAMS[9], 9, id, scr, F.lane, 1);
        else if (id < DEF_N1) fam_item(a, FAMS[10], 10, id - DEF_N0, scr, F.lane, 1);
        else if (id < DEF_N2) fam_item(a, FAMS[11], 11, id - DEF_N1, scr, F.lane, 8);
        else fam_item(a, FAMS[12], 12, id - DEF_N2, scr, F.lane, 8);
    }
    { const f32x4* src = (const f32x4*)a.in[1]; u32x2* dst = (u32x2*)(a.ws + WS_PB); const size_t n4 = (size_t)4 * MT * 256 / 4, S = (size_t)NGW * 64;
        for (size_t i = (size_t)gw * 64 + F.lane; i < n4; i += 4 * S) { f32x4 v[4];
#pragma unroll
            for (int q = 0; q < 4; ++q) v[q] = (i + q * S < n4) ? src[i + q * S] : (f32x4){0.f, 0.f, 0.f, 0.f};
#pragma unroll
            for (int q = 0; q < 4; ++q) if (i + q * S < n4) { u32x2 o; o.x = pk_bf16(v[q][0], v[q][1]); o.y = pk_bf16(v[q][2], v[q][3]); dst[i + q * S] = o; } } }
    { bf16_t* HB = (bf16_t*)(a.ws + WS_HB); float* SSQ = (float*)(a.ws + WS_SSQ);
        for (int row = gw; row < MT; row += NGW) { const f32x4* xr = (const f32x4*)(a.in[0] + (size_t)row * DMODEL) + F.lane;
            u32x2* hb = (u32x2*)(HB + (size_t)row * DMODEL) + F.lane; float s = 0.f; f32x4 v4[4];
#pragma unroll
            for (int j = 0; j < 4; ++j) v4[j] = xr[64 * j];
#pragma unroll
            for (int j = 0; j < 4; ++j) { const f32x4 v = v4[j]; u32x2 o; o.x = pk_bf16(v[0], v[1]); o.y = pk_bf16(v[2], v[3]); hb[64 * j] = o; s += (v[0] * v[0] + v[1] * v[1]) + (v[2] * v[2] + v[3] * v[3]); }
            s = wave_sum(s, F.lane); if (F.lane < 16) SSQ[(size_t)row * 16 + F.lane] = F.lane == 0 ? s : 0.f; } }
    { float* cs = (float*)(a.ws + WS_CS); const int* pos = (const int*)a.in[2];
        for (int i = gw * 64 + F.lane; i < MT * 16; i += NGW * 64) { const int row = i >> 4, f = i & 15;
            const float invf = (float)exp(-9.210340371976184 * (double)f / 16.0);
            const double ang = (double)((float)pos[row] * invf);
            const double rev = ang * 0.15915494309189535, fr = rev - rint(rev); const float x = (float)(fr * 6.283185307179586);
            cs[(size_t)row * 32 + f] = cosf(x); cs[(size_t)row * 32 + 16 + f] = sinf(x); } }
}
#define THIN_LAUNDER() Frame F = F_; unsigned char* wsl = a.ws; F.lane = lane_id(); F.tid = F.wave * 64 + F.lane; asm volatile("" : "+v"(F.tid), "+v"(F.lane), "+s"(F.vcu), "+s"(F.G), "+s"(wsl))
__device__ __forceinline__ void filler(const Args& a, const Frame& F_, int qi, int start, int end) {
    Frame F = F_; { int t_ = F_.wave * 64 + lane_id(); asm volatile("" : "+v"(t_)); F.tid = t_; F.lane = t_ & 63; }
    unsigned char* wsl = a.ws; asm volatile("" : "+s"(wsl));
    LAS float* scr = (LAS float*)(F.lds + RING_OFF + F.wave * 16384);
    unsigned* ctr = (unsigned*)(wsl + WS_CTL) + CW_FILL + qi;
    for (;;) {
        int id = 0; if (F.lane == 0) id = (int)__hip_atomic_fetch_add(ctr, 1u, __ATOMIC_RELAXED, __HIP_MEMORY_SCOPE_AGENT) + start;
        id = __builtin_amdgcn_readfirstlane(id);
        if (id >= end) break;
        if (id < DEF_N0) fam_item<true>(a, FAMS[9], 9, id, scr, F.lane, 1);
        else if (id < DEF_N1) fam_item<true>(a, FAMS[10], 10, id - DEF_N0, scr, F.lane, 1);
        else if (id < DEF_N2) fam_item<true>(a, FAMS[11], 11, id - DEF_N1, scr, F.lane, 8);
        else fam_item<true>(a, FAMS[12], 12, id - DEF_N2, scr, F.lane, 8);
    }
}
__device__ __forceinline__ void moe_route(const Args& a, const Frame& F_, int layer, int cur) { THIN_LAUNDER();
    const bf16_t* HB = (const bf16_t*)(wsl + WS_HB) + (size_t)cur * MT * DMODEL; const float* gain = a.in[17] + (size_t)layer * 1024; const float* wr = a.in[20] + (size_t)(layer >> 1) * 1024 * 8;
    int* TOKE = (int*)(wsl + WS_TOKE); float* TOKG = (float*)(wsl + WS_TOKG); float* TOKRS = (float*)(wsl + WS_TOKRS); int* CNT = (int*)(wsl + WS_CNT);
    constexpr int LDW = 1032;
    LAS bf16_t* WB = (LAS bf16_t*)(F.lds + RING_OFF);
    LAS int* lcnt = (LAS int*)(F.lds + RING_OFF + 36864);
    LAS float* LG = (LAS float*)(F.lds + RING_OFF + 37888) + F.wave * 128;
    {
        const f32x4* w4p = (const f32x4*)wr + 4 * F.tid; const f32x4 w0 = w4p[0], w1 = w4p[1], w2 = w4p[2], w3 = w4p[3]; const float g0 = gain[2 * F.tid], g1 = gain[2 * F.tid + 1];
        const float xa[8] = {w0[0] * g0, w0[1] * g0, w0[2] * g0, w0[3] * g0, w1[0] * g0, w1[1] * g0, w1[2] * g0, w1[3] * g0};
        const float xb[8] = {w2[0] * g1, w2[1] * g1, w2[2] * g1, w2[3] * g1, w3[0] * g1, w3[1] * g1, w3[2] * g1, w3[3] * g1};
#pragma unroll
        for (int e = 0; e < 8; ++e) { const unsigned ha = pk_bf16(xa[e], 0.f) & 0xffffu, hb = pk_bf16(xb[e], 0.f) & 0xffffu;
            const float la = xa[e] - __uint_as_float(ha << 16), lb = xb[e] - __uint_as_float(hb << 16);
            *(LAS unsigned*)(WB + e * LDW + 2 * F.tid) = ha | (hb << 16); *(LAS unsigned*)(WB + (8 + e) * LDW + 2 * F.tid) = pk_bf16(la, lb); } }
    LAS float* SSW = (LAS float*)(F.lds + RING_OFF + 37888 + 4096);
    const int n = F.lane & 15, q = F.lane >> 4;
    for (int chunk = F.vcu; chunk < MT / 64; chunk += F.G) {
        if (F.tid < 8) lcnt[F.tid] = 0;
        __syncthreads();
        {
            const int tokw = chunk * 64 + (F.wave & 3) * 16, kh = (F.wave >> 2) * 512;
            const bf16_t* arow = HB + (size_t)(tokw + n) * DMODEL + 8 * q + kh; const LAS bf16_t* brow = WB + n * LDW + 8 * q + kh;
            f32x4 acc = {0.f, 0.f, 0.f, 0.f}; float ss = 0.f;
#pragma unroll
            for (int s = 0; s < 16; ++s) { const u32x4 av = *(const u32x4*)(arow + 32 * s); const bf16x8 bv = *(const LAS bf16x8*)(brow + 32 * s);
                acc = __builtin_amdgcn_mfma_f32_16x16x32_bf16(__builtin_bit_cast(bf16x8, av), bv, acc, 0, 0, 0);
                f32x4 x0, x1; unpack8(av, x0, x1); ss += pg8::sumsq8(x0, x1); }
            ss = pg8::red_fq(ss);
#pragma unroll
            for (int i = 0; i < 4; ++i) { const float v = acc[i] + shx(acc[i], 8, F.lane); if (n < 8) LG[(4 * q + i) * 8 + n] = v; }
            if (q == 0) SSW[F.wave * 16 + n] = ss;
        }
        __syncthreads();
        if (F.wave < 4) {
            const int tok0 = chunk * 64 + F.wave * 16;
            asm volatile("s_waitcnt lgkmcnt(0)" ::: "memory");
            if (F.lane < 16) { const int tok = tok0 + F.lane; const LAS f32x4* lp = (const LAS f32x4*)(LG + F.lane * 8); const f32x4 l0 = lp[0] + lp[128], l1 = lp[1] + lp[129];
                const float ss = SSW[F.wave * 16 + F.lane] + SSW[(F.wave + 4) * 16 + F.lane];
                const float lg[8] = {l0[0], l0[1], l0[2], l0[3], l1[0], l1[1], l1[2], l1[3]};
                const float r = 1.0f / sqrtf(ss * (1.0f / 1024.0f) + RMS_EPS);
                int e1 = 0; float v1 = lg[0];
#pragma unroll
                for (int e = 1; e < 8; ++e) if (lg[e] > v1) { v1 = lg[e]; e1 = e; }
                int e2 = 0; float v2 = -3.0e38f;
#pragma unroll
                for (int e = 0; e < 8; ++e) if (e != e1 && lg[e] > v2) { v2 = lg[e]; e2 = e; }
                const float p2 = __expf((v2 - v1) * r), g1 = 1.0f / (1.0f + p2), g2 = p2 / (1.0f + p2);
                TOKE[tok] = e1 | (e2 << 8); TOKG[tok * 2] = g1; TOKG[tok * 2 + 1] = g2; TOKRS[tok] = r;
                __hip_atomic_fetch_add(lcnt + e1, 1, __ATOMIC_RELAXED, __HIP_MEMORY_SCOPE_WORKGROUP); __hip_atomic_fetch_add(lcnt + e2, 1, __ATOMIC_RELAXED, __HIP_MEMORY_SCOPE_WORKGROUP); }
        }
        __syncthreads();
        if (F.tid < 8) CNT[chunk * 8 + F.tid] = lcnt[F.tid];
        __syncthreads();
    }
}
__device__ __forceinline__ void moe_scatter(const Args& a, const Frame& F_, int cur) { THIN_LAUNDER();
    const int* TOKE = (const int*)(wsl + WS_TOKE); const float* TOKG = (const float*)(wsl + WS_TOKG); const float* TOKRS = (const float*)(wsl + WS_TOKRS); const int* CNT = (const int*)(wsl + WS_CNT);
    int* SLOT12 = (int*)(wsl + WS_SLOT12); float* SLOTG = (float*)(wsl + WS_SLOTG); float* SLOTRS = (float*)(wsl + WS_SLOTRS); int* PSTART = (int*)(wsl + WS_PSTART);
    const bf16_t* HB = (const bf16_t*)(wsl + WS_HB) + (size_t)cur * MT * DMODEL; bf16_t* XG = (bf16_t*)(wsl + X_XG);
    LAS int* sm = (LAS int*)(F.lds + RING_OFF);
    for (int chunk = F.vcu; chunk < MT / 64; chunk += F.G) {
        { const int e = F.wave; int c4[4]; int s = 0;
#pragma unroll
            for (int i = 0; i < 4; ++i) { c4[i] = CNT[(4 * F.lane + i) * 8 + e]; s += c4[i]; }
            int inc = s;
#pragma unroll
            for (int o = 1; o < 64; o <<= 1) { const int t = shi(inc, F.lane >= o ? F.lane - o : F.lane, F.lane); if (F.lane >= o) inc += t; }
            const int total = shi(inc, 63, F.lane); int pre = inc - s;
            if (F.lane == (chunk >> 2)) { const int cm = chunk & 3; pre += (cm > 0 ? c4[0] : 0) + (cm > 1 ? c4[1] : 0) + (cm > 2 ? c4[2] : 0); sm[8 + e] = pre; }
            if (F.lane == 0) sm[e] = total; }
        __syncthreads();
        if (F.tid == 0) { int p = 0; for (int e = 0; e < 8; ++e) { sm[16 + e] = p; p += (sm[e] + 255) >> 8; } sm[24] = p; }
        __syncthreads();
        if (F.tid < 9) PSTART[F.tid] = sm[16 + F.tid];
        if (F.wave == 0) { const int tok = chunk * 64 + F.lane; const int ev = TOKE[tok], e1 = ev & 255, e2 = ev >> 8; int s1 = 0, s2 = 0;
            const unsigned long long below = (1ull << F.lane) - 1ull;
#pragma unroll
            for (int e = 0; e < 8; ++e) { const unsigned long long m1 = __ballot(e1 == e), m2 = __ballot(e2 == e);
                const int rank = __popcll(m1 & below) + __popcll(m2 & below), slot = sm[16 + e] * 256 + sm[8 + e] + rank;
                if (e1 == e) s1 = slot; if (e2 == e) s2 = slot; }
            SLOT12[tok * 2] = s1; SLOT12[tok * 2 + 1] = s2; const float r = TOKRS[tok];
            SLOTG[s1] = TOKG[tok * 2]; SLOTG[s2] = TOKG[tok * 2 + 1]; SLOTRS[s1] = r; SLOTRS[s2] = r;
            sm[32 + 2 * F.lane] = s1; sm[32 + 2 * F.lane + 1] = s2; }
        __syncthreads();
#if FP8_EGU
        {
            u32x4 a0[8], a1[8]; float rr[8]; int sl1[8], sl2[8];
#pragma unroll
            for (int i = 0; i < 8; ++i) { const int tl = F.wave * 8 + i, tok = chunk * 64 + tl; const u32x4* src = (const u32x4*)(HB + (size_t)tok * DMODEL) + 2 * F.lane;
                a0[i] = src[0]; a1[i] = src[1]; rr[i] = TOKRS[tok]; sl1[i] = sm[32 + 2 * tl]; sl2[i] = sm[32 + 2 * tl + 1]; }
#pragma unroll
            for (int i = 0; i < 8; ++i) { f32x4 x0, x1, y0, y1; unpack8(a0[i], x0, x1); unpack8(a1[i], y0, y1); const float r = rr[i];
                const u32x2 lo = pack8_fp8(x0 * r, x1 * r), hi = pack8_fp8(y0 * r, y1 * r); const u32x4 o = {lo.x, lo.y, hi.x, hi.y};
                *((u32x4*)((unsigned char*)XG + (size_t)sl1[i] * DMODEL) + F.lane) = o; *((u32x4*)((unsigned char*)XG + (size_t)sl2[i] * DMODEL) + F.lane) = o; }
        }
#else
        for (int i = 0; i < 16; ++i) { const int pr = F.wave * 16 + i, tok = chunk * 64 + (pr >> 1), slot = sm[32 + pr];
            const u32x4* src = (const u32x4*)(HB + (size_t)tok * DMODEL) + F.lane; u32x4* dst = (u32x4*)(XG + (size_t)slot * DMODEL) + F.lane;
            dst[0] = src[0]; dst[64] = src[64]; }
#endif
        __syncthreads();
    }
}
__device__ __forceinline__ void moe_combine(const Args& a, const Frame& F_, int cur, bool dummy) { THIN_LAUNDER();
    const int* SLOT12 = (const int*)(wsl + WS_SLOT12); const bf16_t* YG = (const bf16_t*)(wsl + X_YG); const float* TOKG = (const float*)(wsl + WS_TOKG);
    const bf16_t* HBi = (const bf16_t*)(wsl + WS_HB) + (size_t)cur * MT * DMODEL;
    bf16_t* HB = dummy ? (bf16_t*)(wsl + WS_END + 66 * MiB) : (bf16_t*)(wsl + WS_HB) + (size_t)cur * MT * DMODEL; float* SSQ = dummy ? (float*)(wsl + WS_END + 99 * MiB) : (float*)(wsl + WS_SSQ) + (size_t)cur * MT * 16;
    const int gw = F.vcu * NWAVES + F.wave, NGW = F.G * NWAVES;
    for (int r0 = F.vcu * 64; r0 < MT; r0 += F.G * 64) {
        const int rw = r0 + F.wave * 8;
        u32x2 sl = {0u, 0u}; f32x2 gg = {0.f, 0.f};
        if (F.lane < 8) { sl = *(const u32x2*)(SLOT12 + (size_t)(rw + F.lane) * 2); gg = *(const f32x2*)(TOKG + (size_t)(rw + F.lane) * 2); }
#pragma unroll
        for (int k2 = 0; k2 < 8; k2 += 2) {
            u32x2 hv[2][4], pv_[2][4], qv[2][4]; float g1[2], g2[2];
#pragma unroll
            for (int t = 0; t < 2; ++t) { const int row = rw + k2 + t; const int s1 = __builtin_amdgcn_readlane((int)sl.x, k2 + t), s2 = __builtin_amdgcn_readlane((int)sl.y, k2 + t);
                g1[t] = __uint_as_float(__builtin_amdgcn_readlane(__float_as_uint(gg.x), k2 + t)); g2[t] = __uint_as_float(__builtin_amdgcn_readlane(__float_as_uint(gg.y), k2 + t));
                const u32x2* hr = (const u32x2*)(HBi + (size_t)row * DMODEL) + F.lane; const u32x2* y1 = (const u32x2*)(YG + (size_t)s1 * DMODEL) + F.lane; const u32x2* y2 = (const u32x2*)(YG + (size_t)s2 * DMODEL) + F.lane;
#pragma unroll
                for (int j = 0; j < 4; ++j) { hv[t][j] = hr[64 * j]; pv_[t][j] = y1[64 * j]; qv[t][j] = y2[64 * j]; } }
#pragma unroll
            for (int t = 0; t < 2; ++t) { const int row = rw + k2 + t; u32x2* hb = (u32x2*)(HB + (size_t)row * DMODEL) + F.lane; float s = 0.f;
#pragma unroll
                for (int j = 0; j < 4; ++j) { const u32x2 h = hv[t][j], p = pv_[t][j], q = qv[t][j]; f32x4 v;
                    v[0] = bf_lo(h.x) + (g1[t] * bf_lo(p.x) + g2[t] * bf_lo(q.x)); v[1] = bf_hi(h.x) + (g1[t] * bf_hi(p.x) + g2[t] * bf_hi(q.x)); v[2] = bf_lo(h.y) + (g1[t] * bf_lo(p.y) + g2[t] * bf_lo(q.y)); v[3] = bf_hi(h.y) + (g1[t] * bf_hi(p.y) + g2[t] * bf_hi(q.y));
                    u32x2 o; o.x = pk_bf16(v[0], v[1]); o.y = pk_bf16(v[2], v[3]); hb[64 * j] = o; s += (v[0] * v[0] + v[1] * v[1]) + (v[2] * v[2] + v[3] * v[3]); }
                s = wave_sum(s, F.lane); if (F.lane < 16) SSQ[(size_t)row * 16 + F.lane] = F.lane == 0 ? s : 0.f; }
        }
    }
}

__global__ void __launch_bounds__(NTHR, 2) yoco_fwd(Args args) {
    extern __shared__ __attribute__((aligned(16))) unsigned char lds_raw[];
    Frame F; F.lds = (LAS unsigned char*)lds_raw;
    volatile LAS unsigned* MISC = (volatile LAS unsigned*)(F.lds + MISC_OFF);
    F.wave = __builtin_amdgcn_readfirstlane((int)threadIdx.x >> 6); F.lane = lane_id(); F.tid = F.wave * 64 + F.lane;
    F.G = gridDim.x; { const int bx = blockIdx.x; F.vcu = (F.G % 8 == 0) ? (bx % 8) * (F.G / 8) + bx / 8 : bx; }
    for (int u = F.tid; u < (LDS_BYTES - LDSCTL_OFF) / 4; u += NTHR) ((LAS unsigned*)(F.lds + LDSCTL_OFF))[u] = 0u;
    __syncthreads();
    unsigned char* ws = args.ws;
#define WS_LAUNDER() do { F.lane = lane_id(); F.tid = F.wave * 64 + F.lane; asm volatile("" : "+s"(ws), "+s"(bx), "+s"(F.G), "+s"(F.vcu), "+v"(F.tid), "+v"(F.lane)); } while (0)
    const bool single = (args.ph_hi - args.ph_lo) > 1;
    XcdBarrier bar; bar.bar = (unsigned*)(ws + WS_CTL) + CW_BAR; bar.x = 0; bar.st = nullptr; bar.wv = F.wave;
    if (single) bar = xcd_barrier_post((unsigned*)(ws + WS_CTL) + CW_BAR, MISC + 8, F.wave);
    if (single && F.wave == 0 && lane_id() == 0) __hip_atomic_store((unsigned*)(ws + WS_CTL) + CW_BAR + XB_CHK + (int)blockIdx.x, bar.x + 1u, __ATOMIC_RELAXED, __HIP_MEMORY_SCOPE_AGENT);
    if (F.tid == 0) {
        const int wn_[4] = {1024, 768, 512, 5632};
#pragma unroll
        for (int q = 0; q < 4; ++q) { pg8::StaticOrder sw_; sw_.init(MT, wn_[q], (int)gridDim.x, (int)blockIdx.x); pg8::Unit wu_; MISC[16 + q] = sw_.next(0, wu_) ? (unsigned)wu_.pn : 0xffffffffu; } }
    __syncthreads();
    const int lo = args.ph_lo, hi = args.ph_hi;
    bool local_ok = false;
#ifndef GU_ALIGN
#define GU_ALIGN true
#endif
#ifndef EN_MASK
#define EN_MASK 0xFFFFFFFFu
#endif
#define EN(b) (((EN_MASK) >> (b)) & 1u)
#define IN(k) (lo <= (k) && (k) < hi)
#define WARM_DECL() unsigned w0_ = 0u, w1_ = 0u
#define WARM_ISSUE(A_, B_, BT, NI_, RB_) do { const int pn_ = __builtin_amdgcn_readfirstlane((int)MISC[16 + (NI_)]); if (pn_ >= 0) { \
        const unsigned char* wb_ = (const unsigned char*)(BT) + (size_t)pn_ * 256 * (RB_) + (size_t)(F.tid >> 1) * (RB_) + (F.tid & 1) * 256; \
        asm volatile("global_load_dword %0, %2, off\n\tglobal_load_dword %1, %2, off offset:128" : "=&v"(A_), "=&v"(B_) : "v"(wb_) : "memory"); } } while (0)
#define WARM_RETIRE() do { asm volatile("s_waitcnt vmcnt(0)" ::: "memory"); asm volatile("" :: "v"(w0_), "v"(w1_)); } while (0)
#define PU_TAIL(NWG) do { WS_LAUNDER(); const int r_ = (NWG) % F.G, ni_ = r_ ? F.G - r_ : F.G; \
        pg8::Gemm g2{(const bf16_t*)(ws + WS_PB) + (size_t)l * MT * 256, (const bf16_t*)(ws + W_PU) + (size_t)l * 1024 * 256, MT, 1024, 256}; \
        pg8::StaticOrder S2; S2.init(MT, 1024, ni_, bx >= r_ ? bx - r_ : (1 << 24)); \
        pg8::EpiScale E2{(bf16_t*)(ws + WS_U) + (size_t)l * MT * DMODEL, 1024, pg8::RowScale{nullptr, 0}, 1.0f}; \
        pg8::gemm_phase<pg8::EpiScale, pg8::StaticOrder, true, true>(ring, g2, S2, E2, F.wave); } while (0)
#ifdef REP_MASK
#define NREPS(k) ((((unsigned long long)(REP_MASK) >> (k)) & 1ull) ? (REP_N) + 1 : 1)
#else
#define NREPS(k) 1
#endif
#define REPLOOP(k) for (int rep_ = 0, nrep_ = NREPS(k); rep_ < nrep_; ++rep_)
#define DUMMY (rep_ + 1 < nrep_)
#define OUT_HB(set) (DUMMY ? (bf16_t*)(ws + WS_END + 66 * MiB) : (bf16_t*)(ws + WS_HB) + (size_t)(set) * MT * DMODEL)
#define OUT_SSQ(set) (DUMMY ? (float*)(ws + WS_END + 99 * MiB) : (float*)(ws + WS_SSQ) + (size_t)(set) * MT * 16)
#define SEAM(k) do { if (single && (k) + 1 < hi) { XcdBarrier b_ = bar; asm volatile("" : "+s"(b_.bar), "+s"(b_.x)); xcd_barrier(b_); } } while (0)
#define SEAM_L(k) do { if (single && (k) + 1 < hi) { XcdBarrier b_ = bar; asm volatile("" : "+s"(b_.bar), "+s"(b_.x)); if (local_ok) xcd_local_barrier(b_); else xcd_barrier(b_); } } while (0)

    LAS unsigned char* ring = F.lds + RING_OFF;
    int bx = (int)blockIdx.x;

    if (EN(0) && IN(0)) REPLOOP(0) { WS_LAUNDER(); prologue(args, F); { WARM_DECL(); WARM_ISSUE(w0_, w1_, ws + W_AIN, 1, 2048); SEAM(0); WARM_RETIRE(); } }
#ifndef NO_LOCAL_SEAMS
    if (single && lo == 0 && hi > 1) {
        const int t_ = F.wave * 64 + lane_id(); unsigned* chk = (unsigned*)(ws + WS_CTL) + CW_BAR + XB_CHK;
        int good = (F.G == 256);
        if (good && t_ < 256) { const unsigned a = __hip_atomic_load(chk + t_, __ATOMIC_RELAXED, __HIP_MEMORY_SCOPE_AGENT), r = __hip_atomic_load(chk + (t_ & 7), __ATOMIC_RELAXED, __HIP_MEMORY_SCOPE_AGENT); good = (a != 0u && a == r); }
        local_ok = __syncthreads_and(good) != 0;
    }
#endif
#ifdef EXTRA_BARRIERS
    if (single) for (int xb_ = 0; xb_ < EXTRA_BARRIERS; ++xb_) { XcdBarrier b_ = bar; asm volatile("" : "+s"(b_.bar), "+s"(b_.x)); xcd_barrier(b_); }
#endif
#pragma unroll 1
    for (int l = 0; l < 4; ++l) {
        const int base = 2 + PH_PER_LAYER * l; const bool is_mla = l < 2, is_moe = (l & 1) != 0; const int cur = l & 1, j = l & 1;
#define HBc ((const bf16_t*)(ws + WS_HB) + (size_t)cur * MT * DMODEL)
#define HBw ((bf16_t*)(ws + WS_HB) + (size_t)cur * MT * DMODEL)
#define SSQc ((float*)(ws + WS_SSQ) + (size_t)cur * MT * 16)
        if (IN(base + 0)) REPLOOP(base + 0) { WS_LAUNDER();
            if (EN(2) && is_mla) {
                pg8::Gemm g{HBc, (const bf16_t*)(ws + W_AIN) + (size_t)l * 768 * 1024, MT, 768, 1024};
                pg8::StaticOrder S; S.init(MT, 768, F.G, bx);
                pg8::EpiAin E{(bf16_t*)(ws + X_AQ), (bf16_t*)(ws + X_AKV), (float*)(ws + WS_KPE), (float*)(ws + WS_SSQQ), (float*)(ws + WS_SSQKV), pg8::RowScale{SSQc, 1}, args.in[10] + l * 96, (const float*)(ws + WS_CS), (float*)(ws + WS_SSPE)};
                pg8::gemm_phase<pg8::EpiAin, pg8::StaticOrder, true, true>(ring, g, S, E, F.wave);
            } else if (EN(3) && !is_mla) {
                pg8::Gemm g{HBc, (const bf16_t*)(ws + W_QB) + (size_t)j * 1024 * 1024, MT, 1024, 1024};
                pg8::StaticOrder S; S.init(MT, 1024, F.G, bx);
                pg8::EpiScale E{(bf16_t*)(ws + X_SQ), 1024, pg8::RowScale{SSQc, 1}, QSCALE_SB};
                pg8::gemm_phase<pg8::EpiScale, pg8::StaticOrder, true, true>(ring, g, S, E, F.wave);
                asm volatile("s_waitcnt vmcnt(0)" ::: "memory"); __syncthreads();
                __builtin_amdgcn_fence(__ATOMIC_ACQUIRE, "agent"); asm volatile("s_waitcnt vmcnt(0)" ::: "memory");
                WS_LAUNDER();
                pg8::StaticOrder S2; S2.init(MT, 1024, F.G, bx); pg8::Unit uu;
                for (int ui = 0; S2.next(ui, uu); ++ui)
                    for (int i4 = 0; i4 < 4; ++i4) {
#ifdef SBA_ABL
                        if (DUMMY) att::sba::unit<SBA_ABL>(uu.pm >> 5, uu.pn, (uu.pm & 31) * 4 + i4, (const bf16_t*)(ws + X_SQ), (const bf16_t*)(ws + WS_SKT), (const bf16_t*)(ws + WS_SVT), (bf16_t*)(ws + WS_END + 66 * MiB), ring, F.wave); else
#endif
                        att::sba::unit<0>(uu.pm >> 5, uu.pn, (uu.pm & 31) * 4 + i4, (const bf16_t*)(ws + X_SQ), (const bf16_t*)(ws + WS_SKT), (const bf16_t*)(ws + WS_SVT), (bf16_t*)(ws + X_SO), ring, F.wave); }
            }
            { WARM_DECL(); if (is_mla) { WARM_ISSUE(w0_, w1_, ws + W_QUP + (size_t)l * 1024 * 384 * 2, 0, 768); } else WARM_ISSUE(w0_, w1_, ws + W_OB + (size_t)j * 1024 * 1024 * 2, 0, 2048);
              SEAM_L(base + 0); WARM_RETIRE(); }
        }
        if (EN(4) && is_mla && IN(base + 1)) REPLOOP(base + 1) { WS_LAUNDER();
            { pg8::Gemm g{(const bf16_t*)(ws + X_AQ), (const bf16_t*)(ws + W_QUP) + (size_t)l * 1024 * 384, MT, 1024, 384};
              pg8::StaticOrder S; S.init(MT, 1024, F.G, bx);
              EpiQ E{ws, args.in[9] + l * 96};
              pg8::gemm_phase<EpiQ, pg8::StaticOrder, true, true, false, true>(ring, g, S, E, F.wave); }
            { pg8::Gemm g{(const bf16_t*)(ws + X_AKV), (const bf16_t*)(ws + W_KVUP) + (size_t)l * 1024 * 256, MT, 1024, 256};
              pg8::StaticOrder S; S.init(MT, 1024, F.G, bx);
              EpiKV E{ws, args.in[10] + l * 96};
              pg8::gemm_phase<EpiKV, pg8::StaticOrder, true, true, false, true>(ring, g, S, E, F.wave); }
            SEAM(base + 1);
        }
        if (is_mla && IN(base + 3)) REPLOOP(base + 3) { WS_LAUNDER();
#if defined(MLA_ABL)
            if (EN(6) && is_mla && DUMMY) att::mla::phase<MLA_ABL>(F.vcu, F.G, (const bf16_t*)(ws + X_Q), (const bf16_t*)(ws + X_KT), (const bf16_t*)(ws + X_VT), (bf16_t*)(ws + WS_END + 66 * MiB), ring, F.wave);
            else
#endif
            if (EN(6) && is_mla) att::mla::phase<0>(F.vcu, F.G, (const bf16_t*)(ws + X_Q), (const bf16_t*)(ws + X_KT), (const bf16_t*)(ws + X_VT), (bf16_t*)(ws + X_O), ring, F.wave);
            { WARM_DECL(); WARM_ISSUE(w0_, w1_, ws + W_AOUT + (size_t)l * 1024 * 512 * 2, 0, 1024); SEAM(base + 3); WARM_RETIRE(); }
        }
        if (EN(8) && IN(base + 4)) REPLOOP(base + 4) { WS_LAUNDER();
            pg8::Gemm g = is_mla ? pg8::Gemm{(const bf16_t*)(ws + X_O), (const bf16_t*)(ws + W_AOUT) + (size_t)l * 1024 * 512, MT, 1024, 512}
                                 : pg8::Gemm{(const bf16_t*)(ws + X_SO), (const bf16_t*)(ws + W_OB) + (size_t)j * 1024 * 1024, MT, 1024, 1024};
            pg8::StaticOrder S; S.init(MT, 1024, F.G, bx);
            pg8::EpiRes<false> E{HBc, OUT_HB(cur), OUT_SSQ(cur), nullptr, pg8::RowScale{nullptr, 0}, nullptr, 1.0f};
            pg8::gemm_phase<pg8::EpiRes<false>, pg8::StaticOrder, true, true>(ring, g, S, E, F.wave);
            { WARM_DECL(); if (!is_moe) WARM_ISSUE(w0_, w1_, ws + W_FGU + (size_t)(l >> 1) * 5632 * 1024 * 2, 3, 2048); SEAM_L(base + 4); WARM_RETIRE(); }
        }
        if (!is_moe) {
            if (EN(9) && IN(base + 5)) REPLOOP(base + 5) { WS_LAUNDER();
                pg8::Gemm g{HBc, (const bf16_t*)(ws + W_FGU) + (size_t)(l >> 1) * 5632 * 1024, MT, 5632, 1024};
                pg8::GroupOrder S; S.init_dense(MT, 5632, F.G, bx);
                pg8::EpiSwiglu E{(bf16_t*)(ws + X_HID), pg8::RowScale{SSQc, 1}, 0, FP8_FDN, 1.0f};
                pg8::gemm_phase<pg8::EpiSwiglu, pg8::GroupOrder, GU_ALIGN, true>(ring, g, S, E, F.wave);
                PU_TAIL((MT / 256) * 22);
#if FILL_A + FILL_D > 0
                filler(args, F, l == 0 ? 0 : 3, l == 0 ? 0 : DEF_QC, l == 0 ? DEF_QA : DEF_QD);
#endif
                { WARM_DECL(); WARM_ISSUE(w0_, w1_, ws + W_FDN + (size_t)(l >> 1) * 1024 * 2816 * 2, 0, 5632); SEAM_L(base + 5); WARM_RETIRE(); }
            }
            if (EN(10) && IN(base + 6)) REPLOOP(base + 6) { WS_LAUNDER();
                pg8::Gemm g{(const bf16_t*)(ws + X_HID), (const bf16_t*)(ws + W_FDN) + (size_t)(l >> 1) * 1024 * 2816, MT, 1024, FP8_FDN ? 1408 : 2816};
                pg8::StaticOrder S; S.init(MT, 1024, F.G, bx);
                pg8::EpiRes<false> E{HBc, OUT_HB(cur), OUT_SSQ(cur), nullptr, pg8::RowScale{nullptr, 0}, nullptr, FP8_FDN ? 1.0f / 64.0f : 1.0f};
                pg8::gemm_phase<pg8::EpiRes<false>, pg8::StaticOrder, true, true, FP8_FDN != 0>(ring, g, S, E, F.wave);
                { WARM_DECL(); WARM_ISSUE(w0_, w1_, ws + W_PG + (size_t)l * 1024 * 1024 * 2, 0, 2048); SEAM_L(base + 6); WARM_RETIRE(); }
            }
        } else {
            if (EN(11) && IN(base + 5)) REPLOOP(base + 5) { WS_LAUNDER(); moe_route(args, F, l, cur); SEAM(base + 5); }
            if (EN(12) && IN(base + 6)) REPLOOP(base + 6) { WS_LAUNDER(); moe_scatter(args, F, cur); SEAM(base + 6); }
            if (EN(13) && IN(base + 7)) REPLOOP(base + 7) { WS_LAUNDER();
                pg8::Gemm g{(const bf16_t*)(ws + X_XG), (const bf16_t*)(ws + W_EGU) + (size_t)(l >> 1) * 8 * 5632 * 1024, MAXSLOT, 5632, FP8_EGU ? 512 : 1024};
                pg8::GroupOrder S; S.init((const int*)(ws + WS_PSTART), 5632, F.G, bx, (size_t)5632 * 1024 * 2);
                #ifndef EPI_ABL
#define EPI_ABL 0
#endif
                pg8::EpiSwiglu E{(bf16_t*)(ws + X_HG), FP8_EGU ? pg8::RowScale{nullptr, 0} : pg8::RowScale{(const float*)(ws + WS_SLOTRS), 2}, DUMMY ? EPI_ABL : 0, FP8_EDN, FP8_EGU ? 1.0f / 32.0f : 1.0f};
                pg8::gemm_phase<pg8::EpiSwiglu, pg8::GroupOrder, GU_ALIGN, true, FP8_EGU != 0>(ring, g, S, E, F.wave);
#if FILL_B > 0
                if (l == 1) filler(args, F, 1, DEF_QA, DEF_QB);
#endif
                SEAM(base + 7);
            }
            if (EN(14) && IN(base + 8)) REPLOOP(base + 8) { WS_LAUNDER();
                pg8::Gemm g{(const bf16_t*)(ws + X_HG), (const bf16_t*)(ws + W_EDN) + (size_t)(l >> 1) * 8 * 1024 * 2816, MAXSLOT, 1024, FP8_EDN ? 1408 : 2816};
                pg8::GroupOrder S; S.init((const int*)(ws + WS_PSTART), 1024, F.G, bx, (size_t)1024 * 2816 * 2);
                pg8::EpiScale E{(bf16_t*)(ws + X_YG), 1024, pg8::RowScale{nullptr, 0}, FP8_EDN ? 1.0f / 64.0f : 1.0f};
                pg8::gemm_phase<pg8::EpiScale, pg8::GroupOrder, true, true, FP8_EDN != 0>(ring, g, S, E, F.wave);
                { const int nwg_e = __builtin_amdgcn_readfirstlane(((const int*)(ws + WS_PSTART))[8]) * 4; PU_TAIL(nwg_e); }
#if FILL_C > 0
                if (l == 1) filler(args, F, 2, DEF_QB, DEF_QC);
#endif
                SEAM(base + 8);
            }
            if (EN(15) && IN(base + 9)) REPLOOP(base + 9) { WS_LAUNDER(); moe_combine(args, F, cur, DUMMY); { WARM_DECL(); WARM_ISSUE(w0_, w1_, ws + W_PG + (size_t)l * 1024 * 1024 * 2, 0, 2048); SEAM_L(base + 9); WARM_RETIRE(); } }
        }
        if (EN(16) && IN(base + 10)) REPLOOP(base + 10) { WS_LAUNDER();
            pg8::Gemm g{HBc, (const bf16_t*)(ws + W_PG) + (size_t)l * 1024 * 1024, MT, 1024, 1024};
            pg8::StaticOrder S; S.init(MT, 1024, F.G, bx);
            pg8::EpiRes<true> E{HBc, OUT_HB(cur ^ 1), OUT_SSQ(cur ^ 1),
                                (const bf16_t*)(ws + WS_U) + (size_t)l * MT * DMODEL, pg8::RowScale{SSQc, 1}, (l == 3 && !DUMMY) ? args.out : nullptr, 1.0f};
            pg8::gemm_phase<pg8::EpiRes<true>, pg8::StaticOrder, true, true>(ring, g, S, E, F.wave);
            if (l == 3) SEAM(base + 10); else { WARM_DECL(); if (l == 0) WARM_ISSUE(w0_, w1_, ws + W_AIN + (size_t)768 * 1024 * 2, 1, 2048); else if (l == 1) WARM_ISSUE(w0_, w1_, ws + W_KVS, 2, 2048); else WARM_ISSUE(w0_, w1_, ws + W_QB + (size_t)1024 * 1024 * 2, 0, 2048); SEAM_L(base + 10); WARM_RETIRE(); }
        }
        if (EN(17) && l == 1 && IN(base + 11)) REPLOOP(base + 11) { WS_LAUNDER();
            pg8::Gemm g{(const bf16_t*)(ws + WS_HB) + (size_t)(cur ^ 1) * MT * DMODEL, (const bf16_t*)(ws + W_KVS), MT, 512, 1024};
            pg8::StaticOrder S; S.init(MT, 512, F.G, bx);
            pg8::EpiKvs E{(bf16_t*)(ws + WS_SKT), (bf16_t*)(ws + WS_SVT), pg8::RowScale{(const float*)(ws + WS_SSQ) + (size_t)(cur ^ 1) * MT * 16, 1}};
            pg8::gemm_phase<pg8::EpiKvs, pg8::StaticOrder, true, true>(ring, g, S, E, F.wave);
            { WARM_DECL(); WARM_ISSUE(w0_, w1_, ws + W_QB, 0, 2048); SEAM(base + 11); WARM_RETIRE(); }
        }
    }
#undef IN
#undef SEAM
}
}
#define MULTI_LAUNCH 0
extern "C" void kernel_launch(void* const* d_in, const int* in_sizes, int n_in, void* d_out, int out_size, void* d_ws, size_t ws_size, hipStream_t stream) {
    using namespace fw;
    static int grid = 0;
    if (grid == 0) {
        if (n_in != 26 || out_size != MT * DMODEL || ws_size < WS_NEED) { fprintf(stderr, "kernel_launch: unexpected n_in %d / out %d / ws %zu\n", n_in, out_size, ws_size); grid = -1; return; }
        if (hipFuncSetAttribute((const void*)yoco_fwd, hipFuncAttributeMaxDynamicSharedMemorySize, LDS_BYTES) != hipSuccess) { fprintf(stderr, "kernel_launch: hipFuncSetAttribute failed\n"); grid = -1; return; }
        int dev = 0, cus = 0, per_cu = 0;
        (void)hipGetDevice(&dev); (void)hipDeviceGetAttribute(&cus, hipDeviceAttributeMultiprocessorCount, dev);
        (void)hipOccupancyMaxActiveBlocksPerMultiprocessor(&per_cu, (const void*)yoco_fwd, NTHR, LDS_BYTES);
        (void)hipGetLastError();
        grid = (cus > 0 && per_cu >= 1) ? cus : 256;
        if (grid > 256) grid = 256;
    }
    if (grid < 0) return;
    (void)hipMemsetAsync((unsigned char*)d_ws + WS_CTL, 0, CTL_ZERO_BYTES, stream);
    Args a{};
    for (int i = 0; i < 26; ++i) a.in[i] = (const float*)d_in[i];
    a.out = (float*)d_out; a.ws = (unsigned char*)d_ws;
#if MULTI_LAUNCH
    for (int k = 0; k < PH_TOTAL; ++k) { if (!phase_active(k)) continue; a.ph_lo = k; a.ph_hi = k + 1; hipLaunchKernelGGL(yoco_fwd, dim3(grid), dim3(NTHR), LDS_BYTES, stream, a); }
#else
#ifdef PROBE_MASK
    a.ph_lo = 0; a.ph_hi = PH_TOTAL;
#else
    a.ph_lo = 0; a.ph_hi = PH_TOTAL - 1;
#endif
    hipLaunchKernelGGL(yoco_fwd, dim3(grid), dim3(NTHR), LDS_BYTES, stream, a);
#endif
}
```

```cpp
#include <hip/hip_runtime.h>
#include <cstdio>
#include <cstdint>
#include <cmath>
#define LAS __attribute__((address_space(3)))
#define GAS __attribute__((address_space(1)))
typedef unsigned short bf16_t;
typedef short bf16x8 __attribute__((ext_vector_type(8)));
typedef float f32x4 __attribute__((ext_vector_type(4)));
typedef float f32x2 __attribute__((ext_vector_type(2)));
typedef float f32x16 __attribute__((ext_vector_type(16)));
typedef unsigned u32x4 __attribute__((ext_vector_type(4)));
typedef unsigned u32x2 __attribute__((ext_vector_type(2)));
typedef short s16x4 __attribute__((ext_vector_type(4)));
typedef __bf16 bf16x2_t __attribute__((ext_vector_type(2)));

constexpr int MT = 16384, DMODEL = 1024, SEQL = 8192;
constexpr float RMS_EPS = 1e-6f;
constexpr float LOG2E = 1.4426950408889634f;

__device__ __forceinline__ unsigned pk_bf16(float lo, float hi) { f32x2 v = {lo, hi}; bf16x2_t b = __builtin_convertvector(v, bf16x2_t); return __builtin_bit_cast(unsigned, b); }
__device__ __forceinline__ float bf_lo(unsigned w) { return __uint_as_float(w << 16); }
__device__ __forceinline__ float bf_hi(unsigned w) { return __uint_as_float(w & 0xffff0000u); }
__device__ __forceinline__ unsigned cvt_pk_bf16(float lo, float hi) { unsigned r; asm volatile("v_cvt_pk_bf16_f32 %0, %1, %2" : "=v"(r) : "v"(lo), "v"(hi)); return r; }
__device__ __forceinline__ u32x4 pack8(const f32x4 a, const f32x4 b) { u32x4 w; w.x = cvt_pk_bf16(a[0], a[1]); w.y = cvt_pk_bf16(a[2], a[3]); w.z = cvt_pk_bf16(b[0], b[1]); w.w = cvt_pk_bf16(b[2], b[3]); return w; }
__device__ __forceinline__ u32x2 pack8_fp8(const f32x4 a, const f32x4 b) {
    u32x2 w; int lo = 0, hi = 0;
    lo = __builtin_amdgcn_cvt_pk_fp8_f32(__builtin_amdgcn_fmed3f(a[0], -448.f, 448.f), __builtin_amdgcn_fmed3f(a[1], -448.f, 448.f), lo, false); lo = __builtin_amdgcn_cvt_pk_fp8_f32(__builtin_amdgcn_fmed3f(a[2], -448.f, 448.f), __builtin_amdgcn_fmed3f(a[3], -448.f, 448.f), lo, true);
    hi = __builtin_amdgcn_cvt_pk_fp8_f32(__builtin_amdgcn_fmed3f(b[0], -448.f, 448.f), __builtin_amdgcn_fmed3f(b[1], -448.f, 448.f), hi, false); hi = __builtin_amdgcn_cvt_pk_fp8_f32(__builtin_amdgcn_fmed3f(b[2], -448.f, 448.f), __builtin_amdgcn_fmed3f(b[3], -448.f, 448.f), hi, true);
    w.x = (unsigned)lo; w.y = (unsigned)hi; return w; }
__device__ __forceinline__ void unpack8(const u32x4 w, f32x4& a, f32x4& b) { a = (f32x4){bf_lo(w.x), bf_hi(w.x), bf_lo(w.y), bf_hi(w.y)}; b = (f32x4){bf_lo(w.z), bf_hi(w.z), bf_lo(w.w), bf_hi(w.w)}; }
__device__ __forceinline__ float fast_rcp(float x) { return __builtin_amdgcn_rcpf(x); }
__device__ __forceinline__ float fast_exp2(float x) { return __builtin_amdgcn_exp2f(x); }
__device__ __forceinline__ float fast_log2(float x) { return __builtin_amdgcn_logf(x); }
__device__ __forceinline__ int lane_id() { int l; asm volatile("v_mbcnt_lo_u32_b32 %0, -1, 0\n\tv_mbcnt_hi_u32_b32 %0, -1, %0" : "=v"(l)); return l; }
__device__ __forceinline__ float sigmoidf_(float x) { return fast_rcp(1.0f + fast_exp2(-x * LOG2E)); }
__device__ __forceinline__ f32x4 sigmoid4(const f32x4 a, float nsl) { const f32x4 t = a * nsl; f32x4 e = {fast_exp2(t[0]), fast_exp2(t[1]), fast_exp2(t[2]), fast_exp2(t[3])}; e = e + 1.0f; return (f32x4){fast_rcp(e[0]), fast_rcp(e[1]), fast_rcp(e[2]), fast_rcp(e[3])}; }

#ifndef GROUP_WGM
#define GROUP_WGM 8
#endif
namespace pg8 {
constexpr int BM = 256, BK = 64, HALF = 128, HTB = HALF * BK * 2, STAGE_BYTES = 8 * HTB, NXCD = 8, WGM = 8;
__host__ __device__ __forceinline__ int lds_byte(int r, int c) { const int st = (r >> 4) * 2 + (c >> 5), rr = r & 15, cc = c & 31, ob = rr * 64 + cc * 2; return st * 1024 + (ob ^ (((ob >> 9) & 1) << 5)); }
__host__ __device__ __forceinline__ void stage_rc(int b, int& R, int& C) { const int st = b / 1024, sb = b % 1024, swz = sb ^ (((sb >> 9) & 1) << 5); R = (st >> 1) * 16 + swz / 64; C = (st & 1) * 32 + (swz % 64) / 2; }
__host__ __device__ __forceinline__ int perm32(int rho) { const int n = rho >> 4, i = rho & 15; return 8 * (i >> 2) + 4 * n + (i & 3); }

struct Unit { int pm, pn; size_t boff; };
struct Gemm { const bf16_t* A; const bf16_t* Bt; int M, N, K; };

struct StaticOrder {
    int nM, nN, nwg, G, c;
    __device__ __forceinline__ void init(int M, int N, int G_, int c_) { nM = M / BM; nN = N / BM; nwg = nM * nN; G = G_; c = c_; }
    __device__ __forceinline__ bool next(int i, Unit& u) const {
        const long L = (long)i * G + c; if (L >= nwg) return false;
        int wgid = (int)L; { const int q = nwg / NXCD, r = nwg % NXCD, xcd = wgid % NXCD, off = wgid / NXCD; wgid = (xcd < r ? xcd * (q + 1) : r * (q + 1) + (xcd - r) * q) + off; }
        const int nig = WGM * nN, gid = wgid / nig, fm = gid * WGM, gsz = (nM - fm) < WGM ? (nM - fm) : WGM;
        u.pm = fm + ((wgid % nig) % gsz); u.pn = (wgid % nig) / gsz; u.boff = 0; return true;
    }
};
struct GroupOrder {
    int ps[9]; int nN, nwg, G, c; size_t estride;
    __device__ __forceinline__ void init(const int* pstart, int N, int G_, int c_, size_t estride_) {
#pragma unroll
        for (int e = 0; e < 9; ++e) ps[e] = __builtin_amdgcn_readfirstlane(pstart[e]);
        nN = N / BM; nwg = ps[8] * nN; G = G_; c = c_; estride = estride_; }
    __device__ __forceinline__ void init_dense(int M, int N, int G_, int c_) {
        ps[0] = 0;
#pragma unroll
        for (int e = 1; e < 9; ++e) ps[e] = M / BM;
        nN = N / BM; nwg = ps[8] * nN; G = G_; c = c_; estride = 0; }
    __device__ __forceinline__ bool next(int i, Unit& u) const {
        const long L = (long)i * G + c; if (L >= nwg) return false;
        int wgid = (int)L; { const int q = nwg / NXCD, r = nwg % NXCD, xcd = wgid % NXCD, off = wgid / NXCD; wgid = (xcd < r ? xcd * (q + 1) : r * (q + 1) + (xcd - r) * q) + off; }
        int e = 0;
#pragma unroll
        for (int k = 1; k < 8; ++k) if (wgid >= ps[k] * nN) e = k;
        int p0 = ps[0], p1 = ps[1];
#pragma unroll
        for (int k = 1; k < 8; ++k) if (e == k) { p0 = ps[k]; p1 = ps[k + 1]; }
        const int local = wgid - p0 * nN, np = p1 - p0;
        constexpr int GW = GROUP_WGM;
        const int nig = GW * nN, gid = local / nig, fm = gid * GW, gsz = (np - fm) < GW ? (np - fm) : GW;
        u.pm = p0 + fm + ((local % nig) % gsz); u.pn = (local % nig) / gsz; u.boff = (size_t)e * estride; return true;
    }
};


__device__ __forceinline__ float sumsq8(const f32x4 a, const f32x4 b) { return ((a[0] * a[0] + a[1] * a[1]) + (a[2] * a[2] + a[3] * a[3])) + ((b[0] * b[0] + b[1] * b[1]) + (b[2] * b[2] + b[3] * b[3])); }
__device__ __forceinline__ float red_fq(float s) {
    { auto rr = __builtin_amdgcn_permlane16_swap(__float_as_uint(s), __float_as_uint(s), false, false); s = __uint_as_float(rr[0]) + __uint_as_float(rr[1]); }
    { auto rr = __builtin_amdgcn_permlane32_swap(__float_as_uint(s), __float_as_uint(s), false, false); s = __uint_as_float(rr[0]) + __uint_as_float(rr[1]); }
    return s; }
__device__ __forceinline__ float xor32(float v, int upper) {
    auto rr = __builtin_amdgcn_permlane32_swap(__float_as_uint(v), __float_as_uint(v), false, false); return __uint_as_float(upper ? rr[0] : rr[1]); }
struct RowScale {
    const float* p; int mode;
    __device__ __forceinline__ float get(int row, int fq) const {
        if (mode == 0) return 1.0f;
        if (mode == 2) return p[row];
        if (mode == 1) { const f32x4 a = *(const f32x4*)(p + (size_t)row * 16 + 4 * fq); const float s = red_fq((a[0] + a[1]) + (a[2] + a[3])); return 1.0f / sqrtf(s * (1.0f / 1024.0f) + RMS_EPS); }
        if (mode == 3) { const f32x4 a = *(const f32x4*)(p + (size_t)row * 8 + 4 * (fq & 1)); const float s = red_fq(fq < 2 ? (a[0] + a[1]) + (a[2] + a[3]) : 0.f); return 1.0f / sqrtf(s * (1.0f / 384.0f) + RMS_EPS); }
        { const float s = red_fq(p[(size_t)row * 4 + fq]); return 1.0f / sqrtf(s * (1.0f / 256.0f) + RMS_EPS); }
    }
    __device__ __forceinline__ void get8(float (&rsv)[2][4], int row0, int fq) const {
#pragma unroll
        for (int ai = 0; ai < 2; ++ai)
#pragma unroll
            for (int m = 0; m < 4; ++m) rsv[ai][m] = get(row0 + ai * 128 + m * 16, fq);
        asm volatile("" ::: "memory");
    }
};

struct EpiScale {
    static constexpr bool PERM = true, AFTER_DRAIN = false;
    bf16_t* O; int ldc; RowScale rs; float cs;
    __device__ __forceinline__ void operator()(const f32x4 (&acc)[2][2][4][2], const Unit& u, int wr, int wc, int fr_, int fq_) const {
        const int ln_ = lane_id(), fr = ln_ & 15, fq = ln_ >> 4; (void)fr_; (void)fq_;
        const int row0 = u.pm * BM + wr * 64 + fr, col0 = u.pn * BM + wc * 32 + 8 * fq;
        float rsv[2][4]; rs.get8(rsv, row0, fq);
#pragma unroll
        for (int ai = 0; ai < 2; ++ai)
#pragma unroll
            for (int m = 0; m < 4; ++m) { const int row = row0 + ai * HALF + m * 16; const float s = rsv[ai][m] * cs; bf16_t* rowp = O + (size_t)row * ldc + col0;
#pragma unroll
                for (int bj = 0; bj < 2; ++bj) *(u32x4*)(rowp + bj * HALF) = pack8(acc[ai][bj][m][0] * s, acc[ai][bj][m][1] * s); }
    }
};
__device__ __forceinline__ void rope8(f32x4& v0, f32x4& v1, const float* cs_row, int fq) {
    f32x4 p0, p1;
#pragma unroll
    for (int j = 0; j < 4; ++j) { p0[j] = xor32(v0[j], fq >> 1); p1[j] = xor32(v1[j], fq >> 1); }
    const int f0 = 8 * (fq & 1);
    const f32x4 c0 = *(const f32x4*)(cs_row + f0), c1 = *(const f32x4*)(cs_row + f0 + 4), s0 = *(const f32x4*)(cs_row + 16 + f0), s1 = *(const f32x4*)(cs_row + 16 + f0 + 4);
    if (fq < 2) { v0 = v0 * c0 - p0 * s0; v1 = v1 * c1 - p1 * s1; } else { v0 = v0 * c0 + p0 * s0; v1 = v1 * c1 + p1 * s1; }
}
struct EpiAin {
    static constexpr bool PERM = true, AFTER_DRAIN = false;
    bf16_t* AQ; bf16_t* AKV; float* KPE; float* SSQQ; float* SSQKV; RowScale rs; const float* gk; const float* CS; float* SSPE;
    __device__ __forceinline__ void operator()(const f32x4 (&acc)[2][2][4][2], const Unit& u, int wr, int wc, int fr_, int fq_) const {
        const int ln_ = lane_id(), fr = ln_ & 15, fq = ln_ >> 4; (void)fr_; (void)fq_;
        const int row0 = u.pm * BM + wr * 64 + fr, c8 = wc * 32 + 8 * fq;
        float rsv[2][4]; rs.get8(rsv, row0, fq);
#pragma unroll
        for (int ai = 0; ai < 2; ++ai)
#pragma unroll
            for (int m = 0; m < 4; ++m) { const int row = row0 + ai * HALF + m * 16; const float s = rsv[ai][m];
                const f32x4 a0 = acc[ai][0][m][0] * s, a1 = acc[ai][0][m][1] * s, b0 = acc[ai][1][m][0] * s, b1 = acc[ai][1][m][1] * s;
                if (u.pn == 0) {
                    *(u32x4*)(AQ + (size_t)row * 384 + c8) = pack8(a0, a1); *(u32x4*)(AQ + (size_t)row * 384 + 128 + c8) = pack8(b0, b1);
                    const float q = red_fq(sumsq8(a0, a1) + sumsq8(b0, b1)); if (fq == 0) SSQQ[(size_t)row * 8 + wc] = q;
                } else if (u.pn == 1) {
                    *(u32x4*)(AQ + (size_t)row * 384 + 256 + c8) = pack8(a0, a1);
                    const float q = red_fq(sumsq8(a0, a1)); if (fq == 0) SSQQ[(size_t)row * 8 + 4 + wc] = q;
                    if (wc == 0) { const float qp = red_fq(sumsq8(b0, b1)); if (fq == 0) SSPE[row] = qp;
                        f32x4 y0 = b0 * *(const f32x4*)(gk + 64 + 8 * fq), y1 = b1 * *(const f32x4*)(gk + 64 + 8 * fq + 4); rope8(y0, y1, CS + (size_t)row * 32, fq);
                        *(f32x4*)(KPE + (size_t)row * 32 + 8 * fq) = y0; *(f32x4*)(KPE + (size_t)row * 32 + 8 * fq + 4) = y1; }
                } else {
                    *(u32x4*)(AKV + (size_t)row * 256 + c8) = pack8(a0, a1); *(u32x4*)(AKV + (size_t)row * 256 + 128 + c8) = pack8(b0, b1);
                    const float q = red_fq(sumsq8(a0, a1) + sumsq8(b0, b1)); if (fq == 0) SSQKV[(size_t)row * 4 + wc] = q;
                } }
    }
};
struct EpiSwiglu {
    static constexpr bool PERM = true, AFTER_DRAIN = false;
    bf16_t* HID; RowScale rs; int abl; int f8; float cs;
    __device__ __forceinline__ void operator()(const f32x4 (&acc)[2][2][4][2], const Unit& u, int wr, int wc, int fr_, int fq_) const {
        if (abl == 1) return;
        const int ln_ = lane_id(), fr = ln_ & 15, fq = ln_ >> 4; (void)fr_; (void)fq_;
        const int row0 = u.pm * BM + wr * 64 + fr, col0 = u.pn * 128 + wc * 32 + 8 * fq;
        float rsv[2][4]; rs.get8(rsv, row0, fq);
#pragma unroll
        for (int ai = 0; ai < 2; ++ai)
#pragma unroll
            for (int m = 0; m < 4; ++m) { const int row = row0 + ai * HALF + m * 16; const float s = rsv[ai][m] * cs;
                f32x4 o[2];
#pragma unroll
                for (int n = 0; n < 2; ++n) {
                    const f32x4 gu = acc[ai][0][m][n] * acc[ai][1][m][n];
                    if (abl == 2) o[n] = gu * (s * s); else o[n] = gu * (sigmoid4(acc[ai][0][m][n], -s * LOG2E) * (s * s)); }
                if (f8) *(u32x2*)((unsigned char*)HID + (size_t)row * 2816 + col0) = pack8_fp8(o[0], o[1]);
                else *(u32x4*)(HID + (size_t)row * 2816 + col0) = pack8(o[0], o[1]); }
    }
};
template <bool GATED> struct EpiRes {
    static constexpr bool PERM = true, AFTER_DRAIN = false;
    const bf16_t* HBi; bf16_t* HBo; float* SSQo; const bf16_t* U; RowScale rs; float* OUTF; float ascale;
    __device__ __forceinline__ void operator()(const f32x4 (&acc)[2][2][4][2], const Unit& u, int wr, int wc, int fr_, int fq_) const {
        const int ln_ = lane_id(), fr = ln_ & 15, fq = ln_ >> 4; (void)fr_; (void)fq_;
        const int row0 = u.pm * BM + wr * 64 + fr, col0 = u.pn * BM + wc * 32 + 8 * fq;
        float rsv[2][4]; if (GATED) rs.get8(rsv, row0, fq);
        u32x4 hq[3][2], uq[3][2];
#define EPIRES_LOAD(it_, b_) do { const size_t off_ = (size_t)(row0 + ((it_) >> 2) * HALF + ((it_) & 3) * 16) * DMODEL + col0; \
            hq[b_][0] = *(const u32x4*)(HBi + off_); hq[b_][1] = *(const u32x4*)(HBi + off_ + HALF); \
            if (GATED) { uq[b_][0] = *(const u32x4*)(U + off_); uq[b_][1] = *(const u32x4*)(U + off_ + HALF); } } while (0)
        EPIRES_LOAD(0, 0); EPIRES_LOAD(1, 1);
#pragma unroll
        for (int it = 0; it < 8; ++it) { const int ai = it >> 2, m = it & 3, cb = it % 3; const int row = row0 + ai * HALF + m * 16; const size_t off = (size_t)row * DMODEL + col0;
                if (it + 2 < 8) EPIRES_LOAD(it + 2, (it + 2) % 3);
                float s = 1.0f; if (GATED) s = rsv[ai][m];
                float q = 0.f;
#pragma unroll
                for (int bj = 0; bj < 2; ++bj) { f32x4 a0 = acc[ai][bj][m][0] * ascale, a1 = acc[ai][bj][m][1] * ascale;
                    f32x4 h0, h1; unpack8(hq[cb][bj], h0, h1);
                    if (GATED) { f32x4 u0, u1; unpack8(uq[cb][bj], u0, u1);
                        a0 = sigmoid4(a0, -s * LOG2E) * u0; a1 = sigmoid4(a1, -s * LOG2E) * u1; }
                    h0 += a0; h1 += a1;
                    if (GATED) { if (OUTF) { *(f32x4*)(OUTF + off + bj * HALF) = h0; *(f32x4*)(OUTF + off + bj * HALF + 4) = h1; } }
                    *(u32x4*)(HBo + off + bj * HALF) = pack8(h0, h1);
                    q += sumsq8(h0, h1); }
                q = red_fq(q); if (fq == 0) SSQo[(size_t)row * 16 + u.pn * 4 + wc] = q;
                asm volatile("" ::: "memory"); }
#undef EPIRES_LOAD
    }
};
struct EpiKvs {
    static constexpr bool PERM = true, AFTER_DRAIN = false;
    bf16_t* KT; bf16_t* VT; RowScale rs;
    __device__ __forceinline__ void operator()(const f32x4 (&acc)[2][2][4][2], const Unit& u, int wr, int wc, int fr_, int fq_) const {
        const int ln_ = lane_id(), fr = ln_ & 15, fq = ln_ >> 4; (void)fr_; (void)fq_;
        const int row0 = u.pm * BM + wr * 64 + fr;
        float rsv[2][4]; rs.get8(rsv, row0, fq);
#pragma unroll
        for (int ai = 0; ai < 2; ++ai)
#pragma unroll
            for (int m = 0; m < 4; ++m) { const int row = row0 + ai * HALF + m * 16; const float s = rsv[ai][m];
                const int b = row >> 13, sq = row & 8191, tile = sq >> 6, rr = sq & 63;
#pragma unroll
                for (int bj = 0; bj < 2; ++bj) { const int c = bj * HALF + wc * 32 + 8 * fq, kh = c >> 6, d = c & 63;
                    const size_t tb = (size_t)((b * 4 + kh) * 128 + tile) * 4096;
                    const u32x4 w = pack8(acc[ai][bj][m][0] * s, acc[ai][bj][m][1] * s);
                    if (u.pn == 0) *(u32x4*)(KT + tb + (d >> 3) * 512 + rr * 8) = w;
                    else *(u32x4*)(VT + tb + (d >> 5) * 2048 + rr * 32 + (d & 31)) = w; } }
    }
};

#define PG8_LAS LAS
template <class Epi, class Sched, bool ALIGN_EPI = false, bool SP2 = false, bool MX8 = false, bool SADDR = MX8>
__device__ __forceinline__ void gemm_phase(PG8_LAS unsigned char* lds, const Gemm g, const Sched& S, const Epi& E, int wv  ) {
    int tid_ = wv * 64 + lane_id(); asm volatile("" : "+v"(tid_));
    const int tid = tid_, wid = __builtin_amdgcn_readfirstlane(tid >> 6), lane = tid & 63, wr = wid >> 2, wc = wid & 3, fr = lane & 15, fq = lane >> 4;
    const int K = g.K, nt = K / BK;
    unsigned voffA[2], voffB[2];
#pragma unroll
    for (int i = 0; i < 2; ++i) { int R, C; stage_rc(tid * 16 + i * 8192, R, C); const int Rb = Epi::PERM ? ((R & ~31) + perm32(R & 31)) : R;
        voffA[i] = (unsigned)(R * K + C) * 2u; voffB[i] = (unsigned)(Rb * K + C) * 2u; }
    const size_t kstep = (size_t)(BK * 2);
    const size_t hstep = (size_t)HALF * K * 2;
    const size_t tstep = 2 * hstep;
    const unsigned ldsw = (unsigned)wid * 1024u; const unsigned lds0_ = (unsigned)(uintptr_t)lds; (void)lds0_;
    const int aoff = lds_byte(wr * 64 + fr, fq * 8), boff = lds_byte(wc * 32 + fr, fq * 8);
#define PG8_SA(b, h) (((b) * 2 + (h)) * HTB)
#define PG8_SB(b, h) ((4 + (b) * 2 + (h)) * HTB)
#define PG8_STAGE(bufoff, gbase, voff) do { _Pragma("unroll") for (int _i = 0; _i < 2; ++_i) { \
        if constexpr (SADDR) { unsigned keep_; const unsigned dst_ = (unsigned)__builtin_amdgcn_readfirstlane((int)(lds0_ + (unsigned)(bufoff) + ldsw + _i * 8192)); \
            asm volatile("s_mov_b32 %0, m0\n\ts_mov_b32 m0, %3\n\ts_nop 0\n\tglobal_load_lds_dwordx4 %1, %2\n\ts_mov_b32 m0, %0" : "=&s"(keep_) : "v"((voff)[_i]), "s"((const char*)(gbase)), "s"(dst_) : "memory"); } \
        else __builtin_amdgcn_global_load_lds((const unsigned*)((const char*)(gbase) + (voff)[_i]), (PG8_LAS unsigned*)(lds + (bufoff) + ldsw + _i * 8192), 16, 0, 0); } } while (0)
#define PG8_LDA(dst, b, h) do { _Pragma("unroll") for (int m = 0; m < 4; ++m) _Pragma("unroll") for (int k = 0; k < 2; ++k) dst[m][k] = *(const PG8_LAS bf16x8*)(lds + PG8_SA(b, h) + aoff + m * 2048 + k * 1024); } while (0)
#define PG8_LDB(dst, b, h) do { _Pragma("unroll") for (int n = 0; n < 2; ++n) _Pragma("unroll") for (int k = 0; k < 2; ++k) dst[n][k] = *(const PG8_LAS bf16x8*)(lds + PG8_SB(b, h) + boff + n * 2048 + k * 1024); } while (0)
#define PG8_MMA(ai, bj, At, Bt) do { __builtin_amdgcn_s_setprio(1); _Pragma("unroll") for (int m = 0; m < 4; ++m) _Pragma("unroll") for (int n = 0; n < 2; ++n) { \
        if constexpr (MX8) { typedef int i32x8_ __attribute__((ext_vector_type(8))); typedef int i32x4_ __attribute__((ext_vector_type(4))); \
            const i32x4_ b0_ = __builtin_bit_cast(i32x4_, Bt[n][0]), b1_ = __builtin_bit_cast(i32x4_, Bt[n][1]), a0_ = __builtin_bit_cast(i32x4_, At[m][0]), a1_ = __builtin_bit_cast(i32x4_, At[m][1]); \
            const i32x8_ bb_ = __builtin_shufflevector(b0_, b1_, 0, 1, 2, 3, 4, 5, 6, 7), aa_ = __builtin_shufflevector(a0_, a1_, 0, 1, 2, 3, 4, 5, 6, 7); \
            acc[ai][bj][m][n] = __builtin_amdgcn_mfma_scale_f32_16x16x128_f8f6f4(bb_, aa_, acc[ai][bj][m][n], 0, 0, 0, 0x7F7F7F7F, 0, 0x7F7F7F7F); } \
        else { _Pragma("unroll") for (int k = 0; k < 2; ++k) acc[ai][bj][m][n] = __builtin_amdgcn_mfma_f32_16x16x32_bf16(Bt[n][k], At[m][k], acc[ai][bj][m][n], 0, 0, 0); } } \
        __builtin_amdgcn_s_setprio(0); } while (0)
#define PG8_WAIT_V(n) asm volatile("s_waitcnt vmcnt(" #n ")" ::: "memory")
#define PG8_WAIT_L(n) asm volatile("s_waitcnt lgkmcnt(" #n ")" ::: "memory")
#define PG8_BAR __builtin_amdgcn_s_barrier()
#define PG8_SCHED __builtin_amdgcn_sched_barrier(0)
    Unit cur, nxt; int ui = 0;
    if (!S.next(0, cur)) return;
    f32x4 acc[2][2][4][2];
#pragma unroll
    for (int a = 0; a < 2; ++a)
#pragma unroll
        for (int b = 0; b < 2; ++b)
#pragma unroll
            for (int m = 0; m < 4; ++m)
#pragma unroll
                for (int n = 0; n < 2; ++n) acc[a][b][m][n] = (f32x4){0.f, 0.f, 0.f, 0.f};
    bf16x8 At[4][2], B0[2][2], B1[2][2];
    const char* cA = (const char*)g.A + (size_t)cur.pm * tstep; const char* cB = (const char*)g.Bt + cur.boff + (size_t)cur.pn * tstep;
    if constexpr (SP2) {
        PG8_STAGE(PG8_SB(0, 0), cB, voffB); PG8_STAGE(PG8_SB(0, 1), cB + hstep, voffB); PG8_STAGE(PG8_SA(0, 0), cA, voffA); PG8_STAGE(PG8_SA(0, 1), cA + hstep, voffA);
        if (wr == 1) PG8_BAR;
        PG8_WAIT_V(2); PG8_BAR;
        PG8_STAGE(PG8_SB(1, 0), cB + kstep, voffB); PG8_STAGE(PG8_SA(1, 0), cA + kstep, voffA); PG8_STAGE(PG8_SB(1, 1), cB + hstep + kstep, voffB);
        PG8_WAIT_V(6); PG8_BAR;
    } else {
        PG8_STAGE(PG8_SB(0, 0), cB, voffB); PG8_STAGE(PG8_SA(0, 0), cA, voffA); PG8_STAGE(PG8_SB(0, 1), cB + hstep, voffB); PG8_STAGE(PG8_SA(0, 1), cA + hstep, voffA);
        if (wr == 1) PG8_BAR;
        PG8_WAIT_V(4); PG8_BAR;
        PG8_STAGE(PG8_SB(1, 0), cB + kstep, voffB); PG8_STAGE(PG8_SA(1, 0), cA + kstep, voffA); PG8_STAGE(PG8_SB(1, 1), cB + hstep + kstep, voffB);
        PG8_WAIT_V(6); PG8_BAR;
    }
    for (;;) {
        const bool has_next = S.next(ui + 1, nxt);
        const char* nA = has_next ? (const char*)g.A + (size_t)nxt.pm * tstep : cA; const char* nB = has_next ? (const char*)g.Bt + nxt.boff + (size_t)nxt.pn * tstep : cB;
        for (int t = 0; t < nt; t += 2) {
            const bool last = (t == nt - 2);
            const char* a1 = cA + (size_t)(t + 1) * kstep;
            const char* a2 = last ? nA : cA + (size_t)(t + 2) * kstep; const char* b2 = last ? nB : cB + (size_t)(t + 2) * kstep;
            const char* a3 = a2 + kstep; const char* b3 = b2 + kstep;
            if constexpr (SP2) {
            PG8_LDB(B0, 0, 0); PG8_LDB(B1, 0, 1); PG8_SCHED; PG8_LDA(At, 0, 0); PG8_STAGE(PG8_SA(1, 1), a1 + hstep, voffA);
            PG8_WAIT_V(8); PG8_WAIT_L(0); PG8_BAR; PG8_MMA(0, 0, At, B0); PG8_MMA(0, 1, At, B1); PG8_BAR; PG8_SCHED;
            PG8_LDA(At, 0, 1); PG8_STAGE(PG8_SB(0, 0), b2, voffB); PG8_STAGE(PG8_SB(0, 1), b2 + hstep, voffB); PG8_STAGE(PG8_SA(0, 0), a2, voffA);
            PG8_WAIT_V(8); PG8_WAIT_L(0); PG8_BAR; PG8_MMA(1, 0, At, B0); PG8_MMA(1, 1, At, B1); PG8_BAR; PG8_SCHED;
            PG8_LDB(B0, 1, 0); PG8_LDB(B1, 1, 1); PG8_SCHED; PG8_LDA(At, 1, 0); PG8_STAGE(PG8_SA(0, 1), a2 + hstep, voffA);
            PG8_WAIT_V(8); PG8_WAIT_L(0); PG8_BAR; PG8_MMA(0, 0, At, B0); PG8_MMA(0, 1, At, B1); PG8_BAR; PG8_SCHED;
            PG8_LDA(At, 1, 1); PG8_STAGE(PG8_SB(1, 0), b3, voffB); PG8_STAGE(PG8_SB(1, 1), b3 + hstep, voffB); PG8_STAGE(PG8_SA(1, 0), a3, voffA);
            PG8_WAIT_V(8); PG8_WAIT_L(0); PG8_BAR; PG8_MMA(1, 0, At, B0); PG8_MMA(1, 1, At, B1); PG8_BAR; PG8_SCHED;
            } else {
            PG8_LDB(B0, 0, 0); PG8_SCHED; PG8_LDA(At, 0, 0); PG8_STAGE(PG8_SA(1, 1), a1 + hstep, voffA);
            PG8_WAIT_L(8); PG8_BAR; PG8_WAIT_L(0); PG8_MMA(0, 0, At, B0); PG8_BAR; PG8_SCHED;
            PG8_LDB(B1, 0, 1); PG8_STAGE(PG8_SB(0, 0), b2, voffB);
            PG8_BAR; PG8_WAIT_L(0); PG8_MMA(0, 1, At, B1); PG8_BAR;
            PG8_LDA(At, 0, 1); PG8_STAGE(PG8_SA(0, 0), a2, voffA);
            PG8_BAR; PG8_WAIT_L(0); PG8_MMA(1, 0, At, B0); PG8_BAR; PG8_SCHED;
            PG8_STAGE(PG8_SB(0, 1), b2 + hstep, voffB);
            PG8_WAIT_V(6); PG8_BAR; PG8_MMA(1, 1, At, B1); PG8_BAR;
            PG8_LDB(B0, 1, 0); PG8_SCHED; PG8_LDA(At, 1, 0); PG8_STAGE(PG8_SA(0, 1), a2 + hstep, voffA);
            PG8_WAIT_L(8); PG8_BAR; PG8_WAIT_L(0); PG8_MMA(0, 0, At, B0); PG8_BAR; PG8_SCHED;
            PG8_LDB(B1, 1, 1); PG8_STAGE(PG8_SB(1, 0), b3, voffB);
            PG8_BAR; PG8_WAIT_L(0); PG8_MMA(0, 1, At, B1); PG8_BAR;
            PG8_LDA(At, 1, 1); PG8_STAGE(PG8_SA(1, 0), a3, voffA);
            PG8_BAR; PG8_WAIT_L(0); PG8_MMA(1, 0, At, B0); PG8_BAR; PG8_SCHED;
            PG8_STAGE(PG8_SB(1, 1), b3 + hstep, voffB);
            PG8_WAIT_V(6); PG8_BAR; PG8_MMA(1, 1, At, B1); PG8_BAR;
            }
        }
        if constexpr (ALIGN_EPI) { if (wr == 0) PG8_BAR; }
        E(acc, cur, wr, wc, fr, fq);
        if (!has_next) break;
#pragma unroll
        for (int a = 0; a < 2; ++a)
#pragma unroll
            for (int b = 0; b < 2; ++b)
#pragma unroll
                for (int m = 0; m < 4; ++m)
#pragma unroll
                    for (int n = 0; n < 2; ++n) acc[a][b][m][n] = (f32x4){0.f, 0.f, 0.f, 0.f};
        cur = nxt; cA = nA; cB = nB; ++ui;
        if constexpr (ALIGN_EPI) { if (wr == 1) PG8_BAR; }
    }
    PG8_WAIT_V(0);
    if constexpr (!ALIGN_EPI) { if (wr == 0) PG8_BAR; }
    PG8_BAR;
#undef PG8_SA
#undef PG8_SB
#undef PG8_STAGE
#undef PG8_LDA
#undef PG8_LDB
#undef PG8_MMA
#undef PG8_WAIT_V
#undef PG8_WAIT_L
#undef PG8_BAR
#undef PG8_SCHED
}
}
typedef GAS unsigned gu32;
#define RLX_AGENT __ATOMIC_RELAXED, __HIP_MEMORY_SCOPE_AGENT
#define XB_TMO      128
#define XB_XCNT(j)  (256  + 64 * (j))
#define XB_XSUB(j)  (1280 + 64 * (j))
#define XB_XGEN(j)  (2304 + 64 * (j))
#define XB_TOP      3328
#define XB_TOPGEN   3392
#define XCD_BAR_WORDS 3456
#define XB_SPIN_CAP (1u << 18)

__device__ __forceinline__ unsigned xb_ld(unsigned* p)              { return __hip_atomic_load(p, __ATOMIC_RELAXED, __HIP_MEMORY_SCOPE_AGENT); }
__device__ __forceinline__ unsigned xb_add(unsigned* p, unsigned v) { return __hip_atomic_fetch_add(p, v, __ATOMIC_RELAXED, __HIP_MEMORY_SCOPE_AGENT); }
__device__ __forceinline__ unsigned xb_xcc_id() { return (unsigned)__builtin_amdgcn_s_getreg((3 << 11) | 20) & 0xFu; }
#define XB_SPIN(cond, bar) do { unsigned _sp = 0; while (cond) { __builtin_amdgcn_s_sleep(1); \
    if ((++_sp & 255u) == 0u) { if (xb_ld(&(bar)[XB_TMO])) break; if (_sp > XB_SPIN_CAP) { atomicAdd(&(bar)[XB_TMO], 1u); break; } } } } while (0)

struct XcdBarrier {
    unsigned* bar; unsigned x; int wv;
    volatile LAS unsigned* st;
};
__device__ __forceinline__ XcdBarrier xcd_barrier_post(unsigned* bar, volatile LAS unsigned* st, int wv) {
    XcdBarrier b; b.bar = bar; b.x = xb_xcc_id(); b.st = st; b.wv = wv;
    if (wv == 0 && lane_id() == 0) (void)xb_add(&bar[XB_XCNT(b.x)], 1u);
    return b;
}
__device__ __forceinline__ void xcd_barrier_complete(unsigned* bar, unsigned x, unsigned& nloc, unsigned& nx) {
    const unsigned G = gridDim.x * gridDim.y * gridDim.z;
    unsigned sum, cnt, mine, sp = 0u;
    for (;;) {
        sum = 0u; cnt = 0u; mine = 0u;
#pragma unroll
        for (unsigned j = 0; j < 16; ++j) { const unsigned c = xb_ld(&bar[XB_XCNT(j)]); sum += c; cnt += (c > 0u) ? 1u : 0u; mine = (j == x) ? c : mine; }
        if (sum == G) break;
        __builtin_amdgcn_s_sleep(1);
        if ((++sp & 255u) == 0u) { if (xb_ld(&bar[XB_TMO])) break; if (sp > XB_SPIN_CAP) { atomicAdd(&bar[XB_TMO], 1u); break; } }
    }
    nloc = mine > 0u ? mine : 1u; nx = cnt > 0u ? cnt : 1u;
}
__device__ __forceinline__ void xcd_barrier(const XcdBarrier& b) {
    asm volatile("s_waitcnt vmcnt(0)" ::: "memory");
    __syncthreads();
    if (b.wv == 0 && lane_id() == 0) {
        unsigned* bar = b.bar;
        __builtin_amdgcn_s_waitcnt(0);
        unsigned nloc = b.st[0], nx = b.st[1];
        if (nloc == 0u) { xcd_barrier_complete(bar, b.x, nloc, nx); b.st[0] = nloc; b.st[1] = nx; }
        const unsigned old = xb_add(&bar[XB_XSUB(b.x)], 1u);
        const unsigned gen = old / nloc;
        if (old + 1u == (gen + 1u) * nloc) {
            __builtin_amdgcn_fence(__ATOMIC_RELEASE, "agent");
            asm volatile("s_waitcnt vmcnt(0)" ::: "memory");
            const unsigned og = xb_add(&bar[XB_TOP], 1u);
            const unsigned tg = og / nx;
            if (og + 1u == (tg + 1u) * nx) xb_add(&bar[XB_TOPGEN], 1u);
            else XB_SPIN(xb_ld(&bar[XB_TOPGEN]) == tg, bar);
            __builtin_amdgcn_fence(__ATOMIC_ACQUIRE, "agent");
            xb_add(&bar[XB_XGEN(b.x)], 1u);
            asm volatile("s_waitcnt vmcnt(0)" ::: "memory");
        } else {
            XB_SPIN(xb_ld(&bar[XB_XGEN(b.x)]) == gen, bar);
            __builtin_amdgcn_fence(__ATOMIC_ACQUIRE, "agent");
            asm volatile("s_waitcnt vmcnt(0)" ::: "memory");
        }
    }
    __syncthreads();
}

#define XB_LSUB(j)  (3456 + 64 * (j))
#define XB_LGEN(j)  (3456 + 1024 + 64 * (j))
#define XB_CHK      (3456 + 2048)
#define XCD_BAR_WORDS_EXT (3456 + 2048 + 256)
__device__ __forceinline__ void xcd_local_barrier(const XcdBarrier& b) {
    asm volatile("s_waitcnt vmcnt(0)" ::: "memory");
    __syncthreads();
    if (b.wv == 0 && lane_id() == 0) {
        unsigned* bar = b.bar;
        __builtin_amdgcn_s_waitcnt(0);
        const unsigned nloc = b.st[0];
        const unsigned old = xb_add(&bar[XB_LSUB(b.x)], 1u);
        const unsigned gen = old / nloc;
        if (old + 1u == (gen + 1u) * nloc) xb_add(&bar[XB_LGEN(b.x)], 1u);
        else XB_SPIN(xb_ld(&bar[XB_LGEN(b.x)]) == gen, bar);
        __builtin_amdgcn_fence(__ATOMIC_ACQUIRE, "agent");
        asm volatile("s_waitcnt vmcnt(0)" ::: "memory");
    }
    __syncthreads();
}

namespace att {
__device__ __forceinline__ int crow(int r, int hi) { return (r & 3) + 8 * (r >> 2) + 4 * hi; }
__device__ __forceinline__ void glds16(const void* gsrc, unsigned lds_dst) { unsigned keep;
    asm volatile("s_mov_b32 %0, m0\n\ts_mov_b32 m0, %2\n\ts_nop 0\n\tglobal_load_lds_dwordx4 %1, off\n\ts_mov_b32 m0, %0" : "=&s"(keep) : "v"(gsrc), "s"(lds_dst) : "memory"); }
#define ATT_WAIT_BAR(N) asm volatile("s_waitcnt vmcnt(" #N ") lgkmcnt(0)\n\ts_barrier" ::: "memory")
#define ATT_MX3(a, b, c) __builtin_fmaxf(__builtin_fmaxf((a), (b)), (c))
typedef LAS const unsigned char* lcp;
typedef short v4i16_t __attribute__((ext_vector_type(4)));
__device__ __forceinline__ s16x4 vtr(lcp p) { return __builtin_bit_cast(s16x4, __builtin_amdgcn_ds_read_tr16_b64_v4i16((LAS v4i16_t*)p)); }
__device__ __forceinline__ float rowmax(const f32x16& p0, const f32x16& p1) {
    float a = ATT_MX3(p0[0], p0[1], p1[0]), b = ATT_MX3(p0[2], p0[3], p1[1]); a = ATT_MX3(a, p1[2], p1[3]);
#pragma unroll
    for (int r = 4; r < 16; r += 4) { a = ATT_MX3(a, p0[r], p0[r + 1]); b = ATT_MX3(b, p0[r + 2], p0[r + 3]); a = ATT_MX3(a, p1[r], p1[r + 1]); b = ATT_MX3(b, p1[r + 2], p1[r + 3]); }
    float m = __builtin_fmaxf(a, b); auto rr = __builtin_amdgcn_permlane32_swap(__float_as_uint(m), __float_as_uint(m), false, false);
    return __builtin_fmaxf(__uint_as_float(rr[0]), __uint_as_float(rr[1])); }
template <bool FAKEV = false> __device__ __forceinline__ void pv(f32x16* o, lcp vp, const u32x4 pw0, const u32x4 pw1, const u32x4 pw2, const u32x4 pw3) {
#pragma unroll
    for (int ks = 0; ks < 4; ++ks) {
        const u32x4 pw = ks == 0 ? pw0 : ks == 1 ? pw1 : ks == 2 ? pw2 : pw3;
#pragma unroll
        for (int d0 = 0; d0 < 2; ++d0) {
            bf16x8 vf;
            if (FAKEV) vf = __builtin_bit_cast(bf16x8, ks & 1 ? pw0 : pw2);
            else { const s16x4 lo = vtr(vp + d0 * 4096 + ks * 1024), hi = vtr(vp + d0 * 4096 + ks * 1024 + 512); vf = (bf16x8){lo[0], lo[1], lo[2], lo[3], hi[0], hi[1], hi[2], hi[3]}; }
            o[d0] = __builtin_amdgcn_mfma_f32_32x32x16_bf16(__builtin_bit_cast(bf16x8, pw), vf, o[d0], 0, 0, 0);
        }
    }
}
__device__ __forceinline__ void store_o(const f32x16* o, const float* rsc  , LAS unsigned char* stage, bf16_t* Ow, int pitch, int lane, int r32, int hi) {
    LAS bf16_t* stg = (LAS bf16_t*)stage;
#pragma unroll
    for (int r = 0; r < 16; ++r) { const int orow = crow(r, hi);
#pragma unroll
        for (int d0 = 0; d0 < 2; ++d0) stg[orow * 64 + d0 * 32 + r32] = (bf16_t)(pk_bf16(o[d0][r] * rsc[r], 0.f) & 0xffffu); }
    asm volatile("s_waitcnt lgkmcnt(0)" ::: "memory");
#pragma unroll
    for (int i = 0; i < 4; ++i) { const int row = i * 8 + (lane >> 3), ch = lane & 7; const u32x4 v = *(const LAS u32x4*)(stg + row * 64 + ch * 8); *(u32x4*)(Ow + (size_t)row * pitch + ch * 8) = v; }
}

namespace mla {
constexpr int KSLOT = 12288, VSLOT = 8192, NS = 4;
constexpr int L_K = 0, L_V = NS * KSLOT, L_WS = L_V + NS * VSLOT, L_OST = L_WS + 2048, L_END = L_OST + 8 * 4096;
#define MLA_BAR_L() asm volatile("s_waitcnt lgkmcnt(0)\n\ts_barrier" ::: "memory")
template <int ABL> __device__ __forceinline__ void unit(int b, int h, int qb, const bf16_t* Q, const bf16_t* KT, const bf16_t* VT, bf16_t* O, LAS unsigned char* shm, int wv) {
    int tid_ = wv * 64 + lane_id(); asm volatile("" : "+v"(tid_));
    const int tid = tid_, lane = tid & 63, r32 = lane & 31, hi = lane >> 5; const int wid = __builtin_amdgcn_readfirstlane(tid >> 6);
    const int grp = wid >> 2;
    const long rowbase = (long)b * SEQL; const int q0 = qb * 256;
    const bf16_t* Qw = Q + (size_t)(rowbase + q0 + wid * 32) * 768 + h * 96;
    const bf16_t* Kh = KT + (size_t)((b * 8 + h) * 128) * 6144 + lane * 8;
    const bf16_t* Vh = VT + (size_t)((b * 8 + h) * 128) * 4096 + lane * 8;
    const unsigned lds0 = (unsigned)(uintptr_t)shm;
    LAS float* wsf = (LAS float*)(shm + L_WS) + wid * 64;
    const int NT = (q0 + 256) / 64;
    const int kc2 = 8 + (wid & 3);
    bf16x8 qr[6];
#pragma unroll
    for (int d0 = 0; d0 < 6; ++d0) qr[d0] = *(const bf16x8*)(Qw + (size_t)r32 * 768 + d0 * 16 + hi * 8);
#define MLA_DMA_K(t, sl) do { const bf16_t* kt_ = Kh + (size_t)(t) * 6144; \
        glds16(kt_ + wid * 512, (unsigned)__builtin_amdgcn_readfirstlane(lds0 + L_K + (sl) * KSLOT + wid * 1024)); \
        glds16(kt_ + kc2 * 512, (unsigned)__builtin_amdgcn_readfirstlane(lds0 + L_K + (sl) * KSLOT + kc2 * 1024)); } while (0)
#define MLA_DMA_V(t, sl) glds16(Vh + (size_t)(t) * 4096 + wid * 512, (unsigned)__builtin_amdgcn_readfirstlane(lds0 + L_V + (sl) * VSLOT + wid * 1024))
#define MLA_GROUP(g) do { if ((g) + 4 < NT) MLA_DMA_K((g) + 4, (g) & 3); if ((g) + 3 < NT) MLA_DMA_V((g) + 3, ((g) + 3) & 3); } while (0)
#define MLA_LOADK(sl) do { const lcp kb_ = (lcp)shm + L_K + (sl) * KSLOT + hi * 1024 + r32 * 16; _Pragma("unroll") for (int d0 = 0; d0 < 6; ++d0) { kf[2 * d0] = *(const LAS bf16x8*)(kb_ + d0 * 2048); kf[2 * d0 + 1] = *(const LAS bf16x8*)(kb_ + d0 * 2048 + 512); } } while (0)
    MLA_DMA_K(0, 0); MLA_DMA_K(1, 1); MLA_DMA_V(0, 0); MLA_DMA_K(2, 2); MLA_DMA_V(1, 1); MLA_DMA_K(3, 3); MLA_DMA_V(2, 2);
    float m = 0.f; f32x16 o[2], negm, lsum;
#pragma unroll
    for (int r = 0; r < 16; ++r) { o[0][r] = 0.f; o[1][r] = 0.f; negm[r] = 0.f; lsum[r] = 0.f; }
    const bf16x8 ones = {0x3F80, 0x3F80, 0x3F80, 0x3F80, 0x3F80, 0x3F80, 0x3F80, 0x3F80};
    const int qrel = wid * 32 + r32;
    bf16x8 kf[12], vf[8]; u32x4 pw0 = {0u, 0u, 0u, 0u}, pw1 = pw0, pw2 = pw0, pw3 = pw0;
    ATT_WAIT_BAR(9);
    MLA_LOADK(0);
    if (grp == 1) ATT_WAIT_BAR(6);
    bool act_prev = false;
    for (int t = 0; t < NT; ++t) {
        const int s0 = t & 3, s1 = (t + 1) & 3;
        if (grp == 1) MLA_GROUP(t);
        const int jb = t - (NT - 4);
        const bool act = ABL != 5 && (jb <= 0 || 64 * jb <= wid * 32 + 31);
        f32x16 p0 = negm, p1 = negm;
        if (act) {
#pragma unroll
            for (int d0 = 0; d0 < 6; ++d0) { p0 = __builtin_amdgcn_mfma_f32_32x32x16_bf16(kf[2 * d0], qr[d0], p0, 0, 0, 0); p1 = __builtin_amdgcn_mfma_f32_32x32x16_bf16(kf[2 * d0 + 1], qr[d0], p1, 0, 0, 0); }
        }
        if (act_prev) {
#pragma unroll
            for (int ks = 0; ks < 4; ++ks) { const u32x4 pw = ks == 0 ? pw0 : ks == 1 ? pw1 : ks == 2 ? pw2 : pw3;
                o[0] = __builtin_amdgcn_mfma_f32_32x32x16_bf16(__builtin_bit_cast(bf16x8, pw), vf[ks], o[0], 0, 0, 0);
                o[1] = __builtin_amdgcn_mfma_f32_32x32x16_bf16(__builtin_bit_cast(bf16x8, pw), vf[4 + ks], o[1], 0, 0, 0);
                lsum = __builtin_amdgcn_mfma_f32_32x32x16_bf16(__builtin_bit_cast(bf16x8, pw), ones, lsum, 0, 0, 0); }
        }
        if (grp == 0) { if (t + 3 < NT) ATT_WAIT_BAR(6); else ATT_WAIT_BAR(0); MLA_GROUP(t); }
        else MLA_BAR_L();
        if (act && (ABL != 7 || t == 0)) {
            { const lcp vp = (lcp)shm + L_V + s0 * VSLOT + ((lane >> 4) & 1) * 32 + (lane & 3) * 8 + (4 * hi + ((lane & 15) >> 2)) * 64;
#pragma unroll
                for (int d0 = 0; d0 < 2; ++d0)
#pragma unroll
                    for (int ks = 0; ks < 4; ++ks) { const s16x4 lo = vtr(vp + d0 * 4096 + ks * 1024), hh = vtr(vp + d0 * 4096 + ks * 1024 + 512);
                        vf[d0 * 4 + ks] = (bf16x8){lo[0], lo[1], lo[2], lo[3], hh[0], hh[1], hh[2], hh[3]}; } }
        }
        if (t + 1 < NT && ABL != 6) MLA_LOADK(s1);
        if (act) {
            if (jb >= 0) {
#pragma unroll
                for (int r = 0; r < 16; ++r) { const int kv = 64 * jb + crow(r, hi); if (kv > qrel) p0[r] = -INFINITY; if (kv + 32 > qrel) p1[r] = -INFINITY; }
            }
            const float rm = rowmax(p0, p1);
            if (t == 0 || __any(rm > 8.0f)) {
                const float dl = t == 0 ? rm : __builtin_fmaxf(rm, 0.f); m += dl;
#pragma unroll
                for (int r = 0; r < 16; ++r) { p0[r] -= dl; p1[r] -= dl; negm[r] = -m; }
                const float alpha = fast_exp2(-dl); if (hi == 0) wsf[r32] = alpha;
#pragma unroll
                for (int r = 0; r < 16; ++r) { const float a = wsf[crow(r, hi)]; o[0][r] *= a; o[1][r] *= a; lsum[r] *= a; }
            }
#pragma unroll
            for (int r = 0; r < 16; ++r) { if (ABL != 1) { p0[r] = fast_exp2(p0[r]); p1[r] = fast_exp2(p1[r]); } }
            pw0 = (u32x4){pk_bf16(p0[0], p0[1]), pk_bf16(p0[2], p0[3]), pk_bf16(p0[4], p0[5]), pk_bf16(p0[6], p0[7])};
            pw1 = (u32x4){pk_bf16(p0[8], p0[9]), pk_bf16(p0[10], p0[11]), pk_bf16(p0[12], p0[13]), pk_bf16(p0[14], p0[15])};
            pw2 = (u32x4){pk_bf16(p1[0], p1[1]), pk_bf16(p1[2], p1[3]), pk_bf16(p1[4], p1[5]), pk_bf16(p1[6], p1[7])};
            pw3 = (u32x4){pk_bf16(p1[8], p1[9]), pk_bf16(p1[10], p1[11]), pk_bf16(p1[12], p1[13]), pk_bf16(p1[14], p1[15])};
        }
        act_prev = act;
        if (grp == 0) MLA_BAR_L();
        else { if (t + 4 < NT) ATT_WAIT_BAR(6); else ATT_WAIT_BAR(0); }
    }
#undef MLA_DMA_K
#undef MLA_DMA_V
#undef MLA_GROUP
#undef MLA_LOADK
    if (act_prev) {
#pragma unroll
        for (int ks = 0; ks < 4; ++ks) { const u32x4 pw = ks == 0 ? pw0 : ks == 1 ? pw1 : ks == 2 ? pw2 : pw3;
            o[0] = __builtin_amdgcn_mfma_f32_32x32x16_bf16(__builtin_bit_cast(bf16x8, pw), vf[ks], o[0], 0, 0, 0);
            o[1] = __builtin_amdgcn_mfma_f32_32x32x16_bf16(__builtin_bit_cast(bf16x8, pw), vf[4 + ks], o[1], 0, 0, 0);
                lsum = __builtin_amdgcn_mfma_f32_32x32x16_bf16(__builtin_bit_cast(bf16x8, pw), ones, lsum, 0, 0, 0); }
    }
    if (grp == 0) MLA_BAR_L();
    float rli[16];
#pragma unroll
    for (int r = 0; r < 16; ++r) rli[r] = fast_rcp(lsum[r]);
    store_o(o, rli, shm + L_OST + wid * 4096, O + (size_t)(rowbase + q0 + wid * 32) * 512 + h * 64, 512, lane, r32, hi);
    MLA_BAR_L();
}
template <int ABL> __device__ __forceinline__ void phase(int vcu, int G, const bf16_t* Q, const bf16_t* KT, const bf16_t* VT, bf16_t* O, LAS unsigned char* shm, int wv) {
    for (int v = vcu; v < 256; v += G) { const int bh = v >> 4, s = v & 15;
        unit<ABL>(bh >> 3, bh & 7, 31 - s, Q, KT, VT, O, shm, wv);
        unit<ABL>(bh >> 3, bh & 7, s, Q, KT, VT, O, shm, wv); }
}
}

namespace sba {
constexpr int KSLOT = 8192, VSLOT = 8192, NS = 3;
constexpr int L_K = 0, L_V = NS * KSLOT, L_WS = L_V + NS * VSLOT, L_FLAG = L_WS + 2048, L_OST = L_FLAG + 256, L_END = L_OST + 8 * 4096;
constexpr float SB_EXIT = 1.0e-42f;
template <int ABL = 0> __device__ __forceinline__ void unit(int b, int kh, int qb64, const bf16_t* Q, const bf16_t* KT, const bf16_t* VT, bf16_t* O, LAS unsigned char* shm, int wv) {
    int tid_ = wv * 64 + lane_id(); asm volatile("" : "+v"(tid_));
    const int tid = tid_, lane = tid & 63, r32 = lane & 31, hi = lane >> 5; const int wid = __builtin_amdgcn_readfirstlane(tid >> 6);
    const int h = kh * 4 + (wid >> 1), half = wid & 1;
    const long rowbase = (long)b * SEQL; const int q0 = qb64 * 64;
    const bf16_t* Qw = Q + (size_t)(rowbase + q0 + half * 32) * 1024 + h * 64;
    const bf16_t* Kh = KT + (size_t)((b * 4 + kh) * 128) * 4096 + wid * 512 + lane * 8;
    const bf16_t* Vh = VT + (size_t)((b * 4 + kh) * 128) * 4096 + wid * 512 + lane * 8;
    const unsigned lds0 = (unsigned)(uintptr_t)shm;
    LAS int* flags = (LAS int*)(shm + L_FLAG);
    const int NT = qb64 + 1;
#define SBA_DMA(k, sl) do { const int tile_ = qb64 - (k); \
        glds16(Kh + (size_t)tile_ * 4096, (unsigned)__builtin_amdgcn_readfirstlane(lds0 + L_K + (sl) * KSLOT + wid * 1024)); \
        glds16(Vh + (size_t)tile_ * 4096, (unsigned)__builtin_amdgcn_readfirstlane(lds0 + L_V + (sl) * VSLOT + wid * 1024)); } while (0)
    SBA_DMA(0, 0); if (NT > 1) SBA_DMA(1, 1);
    bf16x8 qr[4];
#pragma unroll
    for (int d0 = 0; d0 < 4; ++d0) qr[d0] = *(const bf16x8*)(Qw + (size_t)r32 * 1024 + d0 * 16 + hi * 8);
    float R = 1.f; f32x16 o[2];
#pragma unroll
    for (int r = 0; r < 16; ++r) { o[0][r] = 0.f; o[1][r] = 0.f; }
    const int qrel = half * 32 + r32;
    int slot = 0;
    for (int k = 0; k < NT; ++k) {
        if (k + 1 < NT) ATT_WAIT_BAR(2); else ATT_WAIT_BAR(0);
        if (k > 0) { const LAS int* f = flags + ((k - 1) & 1) * 8; int all = 1;
#pragma unroll
            for (int w = 0; w < 8; ++w) all &= f[w];
            if (all) break; }
        if (k + 2 < NT) { const int s2 = slot == 0 ? 2 : slot - 1; SBA_DMA(k + 2, s2); }
        if (ABL == 3) { if (lane == 0) flags[(k & 1) * 8 + wid] = (k >= 2); } else {
            const lcp kb = (lcp)shm + L_K + slot * KSLOT + hi * 1024 + r32 * 16;
            f32x16 p0, p1;
#pragma unroll
            for (int r = 0; r < 16; ++r) { p0[r] = 0.f; p1[r] = 0.f; }
#pragma unroll
            for (int d0 = 0; d0 < 4; ++d0) { const bf16x8 b0 = *(const LAS bf16x8*)(kb + d0 * 2048), b1 = *(const LAS bf16x8*)(kb + d0 * 2048 + 512);
                p0 = __builtin_amdgcn_mfma_f32_32x32x16_bf16(b0, qr[d0], p0, 0, 0, 0); p1 = __builtin_amdgcn_mfma_f32_32x32x16_bf16(b1, qr[d0], p1, 0, 0, 0); }
            f32x16 N0, N1;
#pragma unroll
            for (int r = 0; r < 16; r += 2) {
                f32x2 e0, e1; e0.x = fast_exp2(-p0[r]); e0.y = fast_exp2(-p0[r + 1]); e1.x = fast_exp2(-p1[r]); e1.y = fast_exp2(-p1[r + 1]);
                const f32x2 d0 = e0 + 1.0f, d1 = e1 + 1.0f;
                f32x2 b0, b1; b0.x = fast_rcp(d0.x); b0.y = fast_rcp(d0.y); b1.x = fast_rcp(d1.x); b1.y = fast_rcp(d1.y);
                f32x2 n0 = 1.0f - b0, n1 = 1.0f - b1;
                if (k == 0) { const int kv = crow(r, hi), kw = crow(r + 1, hi);
                    if (kv >= qrel) { b0.x = 0.f; n0.x = 1.f; } if (kw >= qrel) { b0.y = 0.f; n0.y = 1.f; } if (kv + 32 >= qrel) { b1.x = 0.f; n1.x = 1.f; } if (kw + 32 >= qrel) { b1.y = 0.f; n1.y = 1.f; } }
                p0[r] = b0.x; p0[r + 1] = b0.y; p1[r] = b1.x; p1[r + 1] = b1.y; N0[r] = n0.x; N0[r + 1] = n0.y; N1[r] = n1.x; N1[r + 1] = n1.y; }
            float G[16];
#pragma unroll
            for (int j = 0; j < 8; ++j) { const f32x16& NN = j < 4 ? N0 : N1; const int rb = 4 * (j & 3);
                const f32x2 t2 = (f32x2){NN[rb], NN[rb + 1]} * (f32x2){NN[rb + 2], NN[rb + 3]}; const float gp = t2.x * t2.y;
                auto rr = __builtin_amdgcn_permlane32_swap(__float_as_uint(gp), __float_as_uint(gp), false, false);
                G[2 * j] = __uint_as_float(rr[0]); G[2 * j + 1] = __uint_as_float(rr[1]); }
            float SG[16]; SG[15] = 1.f;
#pragma unroll
            for (int g = 14; g >= 0; --g) SG[g] = SG[g + 1] * G[g + 1];
            const float T = SG[0] * G[0];
#pragma unroll
            for (int j = 0; j < 8; ++j) { f32x16& NN = j < 4 ? N0 : N1; f32x16& PP = j < 4 ? p0 : p1; const int rb = 4 * (j & 3);
                const float base = (R * SG[2 * j + 1]) * (hi ? 1.f : G[2 * j + 1]);
                const float r3 = base, r2 = r3 * NN[rb + 3], r1 = r2 * NN[rb + 2], r0 = r1 * NN[rb + 1];
                const f32x2 ph = (f32x2){PP[rb + 2], PP[rb + 3]} * (f32x2){r2, r3}, pl = (f32x2){PP[rb], PP[rb + 1]} * (f32x2){r0, r1};
                PP[rb + 3] = ph.y; PP[rb + 2] = ph.x; PP[rb + 1] = pl.y; PP[rb] = pl.x; }
            R *= T;
            const u32x4 pw0 = {pk_bf16(p0[0], p0[1]), pk_bf16(p0[2], p0[3]), pk_bf16(p0[4], p0[5]), pk_bf16(p0[6], p0[7])};
            const u32x4 pw1 = {pk_bf16(p0[8], p0[9]), pk_bf16(p0[10], p0[11]), pk_bf16(p0[12], p0[13]), pk_bf16(p0[14], p0[15])};
            const u32x4 pw2 = {pk_bf16(p1[0], p1[1]), pk_bf16(p1[2], p1[3]), pk_bf16(p1[4], p1[5]), pk_bf16(p1[6], p1[7])};
            const u32x4 pw3 = {pk_bf16(p1[8], p1[9]), pk_bf16(p1[10], p1[11]), pk_bf16(p1[12], p1[13]), pk_bf16(p1[14], p1[15])};
            const lcp vp = (lcp)shm + L_V + slot * VSLOT + ((lane >> 4) & 1) * 32 + (lane & 3) * 8 + (4 * hi + ((lane & 15) >> 2)) * 64;
            if (ABL != 2) pv(o, vp, pw0, pw1, pw2, pw3); else o[0][0] += __uint_as_float(pw0.x ^ pw1.y ^ pw2.z ^ pw3.w);
            const int dn = (ABL == 4 || __all(R < SB_EXIT)) ? 1 : 0;
            if (lane == 0) flags[(k & 1) * 8 + wid] = dn;
        }
        slot = slot == 2 ? 0 : slot + 1;
    }
#undef SBA_DMA
    ATT_WAIT_BAR(0);
    float one[16];
#pragma unroll
    for (int r = 0; r < 16; ++r) one[r] = 1.0f;
    store_o(o, one, shm + L_OST + wid * 4096, O + (size_t)(rowbase + q0 + half * 32) * 1024 + h * 64, 1024, lane, r32, hi);
    asm volatile("s_waitcnt lgkmcnt(0)\n\ts_barrier" ::: "memory");
}
__device__ __forceinline__ void phase(int vcu, int G, const bf16_t* Q, const bf16_t* KT, const bf16_t* VT, bf16_t* O, LAS unsigned char* shm, int wv) {
    for (int u = vcu * 4; u < 1024; u += G * 4)
        for (int i = 0; i < 4; ++i) { const int uu = u + i, qb64 = uu & 127, bk = uu >> 7; unit(bk >> 2, bk & 3, qb64, Q, KT, VT, O, shm, wv); }
}
}
}
#ifndef FP8_FDN
#define FP8_FDN 0
#endif
#ifndef FP8_EGU
#define FP8_EGU 1
#endif
#ifndef FP8_EDN
#define FP8_EDN 1
#endif
#ifndef FP8_DOWN
#define FP8_DOWN (FP8_FDN || FP8_EDN)
#endif
namespace fw {
constexpr size_t MiB = 1u << 20;
constexpr int NWAVES = 8, NTHR = 512;
constexpr int MAXSLOT = 34816;
constexpr size_t WS_CTL = 0, CTL_ZERO_BYTES = 64 * 1024;
constexpr size_t WS_TOKE = 1 * MiB;
constexpr size_t WS_TOKG = WS_TOKE + 64 * 1024;
constexpr size_t WS_TOKRS = WS_TOKG + 128 * 1024;
constexpr size_t WS_SLOT12 = WS_TOKRS + 64 * 1024;
constexpr size_t WS_SLOTG = WS_SLOT12 + 128 * 1024;
constexpr size_t WS_SLOTRS = WS_SLOTG + 256 * 1024;
constexpr size_t WS_CNT = WS_SLOTRS + 256 * 1024;
constexpr size_t WS_PSTART = WS_CNT + 16 * 1024;
constexpr size_t WS_CS = 4 * MiB;
constexpr size_t WS_SSQ = 6 * MiB;
constexpr size_t WS_SSQQ = 8 * MiB;
constexpr size_t WS_SSQKV = WS_SSQQ + 512 * 1024;
constexpr size_t WS_KPE = 9 * MiB;
constexpr size_t WS_SSPE = 11 * MiB;
constexpr size_t WS_W = 16 * MiB;
constexpr size_t W_AIN = WS_W, W_QUP = W_AIN + 3 * MiB, W_KVUP = W_QUP + 2 * MiB, W_AOUT = W_KVUP + 1 * MiB, W_KVS = W_AOUT + 2 * MiB, W_QB = W_KVS + 1 * MiB,
                 W_OB = W_QB + 4 * MiB, W_PG = W_OB + 4 * MiB, W_PU = W_PG + 8 * MiB, W_FGU = W_PU + 2 * MiB, W_FDN = W_FGU + 22 * MiB, W_EGU = W_FDN + 11 * MiB,
                 W_EDN = W_EGU + 176 * MiB, W_END = W_EDN + 88 * MiB;
constexpr size_t WS_PB = W_END;
constexpr size_t WS_HB = WS_PB + 32 * MiB;
constexpr size_t WS_U = WS_HB + 64 * MiB;
constexpr size_t WS_SKT = WS_U + 128 * MiB, WS_SVT = WS_SKT + 8 * MiB;
constexpr size_t WS_X = WS_SVT + 8 * MiB;
constexpr size_t X_AQ = WS_X, X_AKV = X_AQ + 12 * MiB, X_QRAW = X_AKV + 8 * MiB, X_KVRAW = X_QRAW + 24 * MiB, X_Q = X_KVRAW + 32 * MiB, X_KT = X_Q + 24 * MiB, X_VT = X_KT + 24 * MiB, X_O = X_VT + 16 * MiB;
constexpr size_t X_SQ = WS_X, X_SO = X_SQ + 32 * MiB;
constexpr size_t X_XG = WS_X, X_HG = X_XG + 68 * MiB, X_YG = X_HG + 187 * MiB, X_END = X_YG + 68 * MiB;
constexpr size_t WS_END = X_END;
constexpr size_t X_HID = WS_END + 128 * MiB;
constexpr size_t WS_NEED = X_HID + 88 * MiB;
static_assert(X_O + 16 * MiB <= X_END && (size_t)MAXSLOT * 2816 * 2 <= 187 * MiB && (size_t)MAXSLOT * 1024 * 2 <= 68 * MiB, "ws map");
constexpr int CW_BAR = 1024;
constexpr int RING_OFF = 0, RING_BYTES = 131072, LDSCTL_OFF = RING_BYTES, MISC_OFF = LDSCTL_OFF + 320, XS_OFF = LDSCTL_OFF + 1024  , LDS_BYTES = 147456;
static_assert(att::mla::L_END <= RING_BYTES && att::sba::L_END <= RING_BYTES, "attention LDS");
constexpr float QSCALE_MLA = 0.10206207261596577f * LOG2E;
constexpr float QSCALE_SB = 0.125f * LOG2E;

struct EpiQ {
    static constexpr bool PERM = true, AFTER_DRAIN = false;
    unsigned char* ws; const float* gq;
    __device__ __forceinline__ void operator()(const f32x4 (&acc)[2][2][4][2], const pg8::Unit& u, int wr, int wc, int fr_, int fq_) const {
        const int ln_ = lane_id(), fr = ln_ & 15, fq = ln_ >> 4; (void)fr_; (void)fq_;
        const int row0 = u.pm * pg8::BM + wr * 64 + fr, c = wc * 32 + 8 * fq;
        LAS float* xs = (LAS float*)(uintptr_t)XS_OFF;
        bf16_t* Q = (bf16_t*)(ws + X_Q); const float* CS = (const float*)(ws + WS_CS); const pg8::RowScale rs{(const float*)(ws + WS_SSQQ), 3}; const float qscale = QSCALE_MLA;
        float rsv[2][4]; rs.get8(rsv, row0, fq);
#pragma unroll
        for (int ai = 0; ai < 2; ++ai)
#pragma unroll
            for (int m = 0; m < 4; ++m) { const int rl = ai * pg8::HALF + wr * 64 + m * 16 + fr; const float s = rsv[ai][m];
#pragma unroll
                for (int bj = 0; bj < 2; ++bj) { const float q = pg8::red_fq(pg8::sumsq8(acc[ai][bj][m][0], acc[ai][bj][m][1])) * (s * s); if (fq == 0) xs[(rl * 2 + bj) * 4 + wc] = q; }
                asm volatile("" ::: "memory"); }
        asm volatile("s_waitcnt lgkmcnt(0)" ::: "memory"); __builtin_amdgcn_s_barrier(); asm volatile("" ::: "memory");
        const int cg = wc < 3 ? c : 0;
#pragma unroll
        for (int ai = 0; ai < 2; ++ai)
#pragma unroll
            for (int m = 0; m < 4; ++m) { const int rl = ai * pg8::HALF + wr * 64 + m * 16 + fr, row = row0 + ai * pg8::HALF + m * 16;
                const f32x4 g0 = *(const f32x4*)(gq + cg), g1 = *(const f32x4*)(gq + cg + 4);
#pragma unroll
                for (int bj = 0; bj < 2; ++bj) { const f32x4 p4 = *(const LAS f32x4*)(xs + (rl * 2 + bj) * 4);
                    const float ss = (p4[0] + p4[1]) + (p4[2] + p4[3]); const float sc = rsv[ai][m] * (1.0f / sqrtf(ss * (1.0f / 96.0f) + RMS_EPS)) * qscale;
                    f32x4 v0 = acc[ai][bj][m][0] * g0 * sc, v1 = acc[ai][bj][m][1] * g1 * sc;
                    if (wc == 2) pg8::rope8(v0, v1, CS + (size_t)row * 32, fq);
                    if (wc < 3) *(u32x4*)(Q + (size_t)row * 768 + (2 * u.pn + bj) * 96 + c) = pack8(v0, v1); }
                asm volatile("" ::: "memory"); }
    }
};
struct EpiKV {
    static constexpr bool PERM = true, AFTER_DRAIN = false;
    unsigned char* ws; const float* gk;
    __device__ __forceinline__ void operator()(const f32x4 (&acc)[2][2][4][2], const pg8::Unit& u, int wr, int wc, int fr_, int fq_) const {
        const int ln_ = lane_id(), fr = ln_ & 15, fq = ln_ >> 4; (void)fr_; (void)fq_;
        const int row0 = u.pm * pg8::BM + wr * 64 + fr, c = (wc & 1) * 32 + 8 * fq;
        LAS float* xs = (LAS float*)(uintptr_t)XS_OFF;
        bf16_t* KT = (bf16_t*)(ws + X_KT); bf16_t* VT = (bf16_t*)(ws + X_VT); const float* KPE = (const float*)(ws + WS_KPE); const float* SSPE = (const float*)(ws + WS_SSPE); const pg8::RowScale rs{(const float*)(ws + WS_SSQKV), 4};
        float rsv[2][4]; rs.get8(rsv, row0, fq);
#pragma unroll
        for (int ai = 0; ai < 2; ++ai)
#pragma unroll
            for (int m = 0; m < 4; ++m) { const int rl = ai * pg8::HALF + wr * 64 + m * 16 + fr; const float s = rsv[ai][m];
#pragma unroll
                for (int bj = 0; bj < 2; ++bj) { const float q = pg8::red_fq(pg8::sumsq8(acc[ai][bj][m][0], acc[ai][bj][m][1])) * (s * s); if (fq == 0 && wc < 2) xs[(rl * 2 + bj) * 2 + wc] = q; }
                asm volatile("" ::: "memory"); }
        asm volatile("s_waitcnt lgkmcnt(0)" ::: "memory"); __builtin_amdgcn_s_barrier(); asm volatile("" ::: "memory");
#pragma unroll
        for (int ai = 0; ai < 2; ++ai)
#pragma unroll
            for (int m = 0; m < 4; ++m) { const int rl = ai * pg8::HALF + wr * 64 + m * 16 + fr, row = row0 + ai * pg8::HALF + m * 16; const float s = rsv[ai][m];
                const f32x4 g0 = *(const f32x4*)(gk + c), g1 = *(const f32x4*)(gk + c + 4);
                const int b = row >> 13, sq = row & 8191, tile = sq >> 6, rr = sq & 63;
                const f32x4 k0 = *(const f32x4*)(KPE + (size_t)row * 32 + 8 * fq), k1 = *(const f32x4*)(KPE + (size_t)row * 32 + 8 * fq + 4);
                const float sspe = SSPE[row];
#pragma unroll
                for (int bj = 0; bj < 2; ++bj) { const int h = 2 * u.pn + bj; const size_t tb = (size_t)((b * 8 + h) * 128 + tile);
                    const float ssn = xs[(rl * 2 + bj) * 2] + xs[(rl * 2 + bj) * 2 + 1];
                    const float rk = 1.0f / sqrtf((ssn + sspe) * (1.0f / 96.0f) + RMS_EPS);
                    if (wc < 2) *(u32x4*)(KT + tb * 6144 + (c >> 3) * 512 + rr * 8) = pack8(acc[ai][bj][m][0] * g0 * (s * rk), acc[ai][bj][m][1] * g1 * (s * rk));
                    else *(u32x4*)(VT + tb * 4096 + (wc - 2) * 2048 + rr * 32 + 8 * fq) = pack8(acc[ai][bj][m][0] * s, acc[ai][bj][m][1] * s);
                    if (wc == 2) *(u32x4*)(KT + tb * 6144 + (8 + fq) * 512 + rr * 8) = pack8(k0 * rk, k1 * rk); }
                asm volatile("" ::: "memory"); }
    }
};
constexpr int PH_PER_LAYER = 12, PH_TOTAL = 2 + 4 * PH_PER_LAYER;
__host__ __device__ inline bool phase_active(int idx) {
    if (idx == 0) return true;
    if (idx == 1) return false;
    const int l = (idx - 2) / PH_PER_LAYER, s = (idx - 2) % PH_PER_LAYER; const bool mla = l < 2, moe = (l & 1) != 0;
    if (s == 1 || s == 3) return mla;
    if (s == 2) return false;
    if (s >= 7 && s <= 9) return moe;
    if (s == 11) return l == 1;
    return true;
}

struct Args { const float* in[26]; float* out; unsigned char* ws; int ph_lo, ph_hi; };

struct Frame { LAS unsigned char* lds; int tid, lane, wave, vcu, G; };

__device__ __forceinline__ float shx(float v, int k, int lane) { return __uint_as_float((unsigned)__builtin_amdgcn_ds_bpermute((lane ^ k) << 2, (int)__float_as_uint(v))); }
__device__ __forceinline__ int shi(int v, int src, int lane) { (void)lane; return __builtin_amdgcn_ds_bpermute(src << 2, v); }
__device__ __forceinline__ float wave_sum(float v, int lane) {
#pragma unroll
    for (int o = 1; o < 64; o <<= 1) v += shx(v, o, lane);
    return v;
}
template <bool NT, bool F8 = false> __device__ __forceinline__ void transpose_item(const float* W, int ldw, int sca, int scb, const float* gain, bf16_t* WT, int K, int drow0, int k0, LAS float* scr, int lane, float f8s = 64.f) {
    const int r8 = lane >> 3, pc = lane & 7, c = lane & 7;
    f32x4 va[8], vb[8]; float g[8];
    const f32x4 z4 = {0.f, 0.f, 0.f, 0.f};
#pragma unroll
    for (int i = 0; i < 8; ++i) { const float* rp = W + (size_t)(k0 + i * 8 + r8) * ldw + 4 * pc;
        if (NT) { va[i] = sca >= 0 ? __builtin_nontemporal_load((const f32x4*)(rp + sca)) : z4; vb[i] = scb >= 0 ? __builtin_nontemporal_load((const f32x4*)(rp + scb)) : z4; }
        else { va[i] = sca >= 0 ? *(const f32x4*)(rp + sca) : z4; vb[i] = scb >= 0 ? *(const f32x4*)(rp + scb) : z4; }
        g[i] = gain ? gain[k0 + i * 8 + r8] : 1.0f; }
#pragma unroll
    for (int hf = 0; hf < 2; ++hf) {
#pragma unroll
        for (int i = 0; i < 8; ++i) { const f32x4 v = (hf == 0 ? va[i] : vb[i]) * g[i]; LAS float* d = scr + (i * 8 + r8) * 33 + 4 * pc; d[0] = v[0]; d[1] = v[1]; d[2] = v[2]; d[3] = v[3]; }
        asm volatile("s_waitcnt lgkmcnt(0)" ::: "memory");
#pragma unroll
        for (int j = 0; j < 4; ++j) { const int n = (lane >> 3) + 8 * j; const LAS float* s = scr + (8 * c) * 33 + n;
            u32x4 o; o.x = pk_bf16(s[0 * 33], s[1 * 33]); o.y = pk_bf16(s[2 * 33], s[3 * 33]); o.z = pk_bf16(s[4 * 33], s[5 * 33]); o.w = pk_bf16(s[6 * 33], s[7 * 33]);
            if (F8) { const f32x4 q0 = {s[0 * 33] * f8s, s[1 * 33] * f8s, s[2 * 33] * f8s, s[3 * 33] * f8s}, q1 = {s[4 * 33] * f8s, s[5 * 33] * f8s, s[6 * 33] * f8s, s[7 * 33] * f8s};
                *(u32x2*)((unsigned char*)WT + (size_t)(drow0 + hf * 32 + n) * K + k0 + 8 * c) = pack8_fp8(q0, q1); }
            else if (NT) __builtin_nontemporal_store(o, (u32x4*)(WT + (size_t)(drow0 + hf * 32 + n) * K + k0 + 8 * c)); else *(u32x4*)(WT + (size_t)(drow0 + hf * 32 + n) * K + k0 + 8 * c) = o; }
        asm volatile("s_waitcnt lgkmcnt(0)" ::: "memory");
    }
}
struct Fam { int src, count, K, Nd, ldw, map, gain, gstride; size_t sstride, dst, dstride; };
__device__ __forceinline__ int fam_items(const Fam& f) { return f.count * (f.K / 64) * (f.Nd / 64); }
__device__ __forceinline__ int fam_src_col(int map, int n0) {
    if (map == 1) return n0 < 384 ? n0 : (n0 < 416 ? 640 + (n0 - 384) : (n0 < 512 ? -1 : 384 + (n0 - 512)));
    if (map == 2) { const int pn = n0 >> 8, jj = n0 & 255; return jj < 128 ? pn * 128 + jj : 2816 + pn * 128 + (jj - 128); }
    if (map == 3) { const int h = n0 >> 7, off = n0 & 127; return off < 96 ? 96 * h + off : -1; }
    return n0;
}
template <bool NT = false> __device__ __forceinline__ void fam_item(const Args& a, const Fam& f, int fid, int it, LAS float* scr, int lane, int mi_off = 0) {
    const int per = (f.K / 64) * (f.Nd / 64), mi = it / per + mi_off, r = it % per, nblk = f.Nd / 64, kb = r / nblk, nb = r % nblk, n0 = nb * 64;
    const float* gain = nullptr;
    if (f.gain >= 0) gain = a.in[f.gain] + (fid == 11 ? (size_t)(2 * (mi >> 3) + 1) * 1024 : (size_t)mi * f.gstride);
#if FP8_DOWN || FP8_EGU
    if ((FP8_FDN && fid == 10) || (FP8_EDN && fid == 12) || (FP8_EGU && fid == 11)) { transpose_item<NT, true>(a.in[f.src] + (size_t)mi * f.sstride, f.ldw, fam_src_col(f.map, n0), fam_src_col(f.map, n0 + 32), gain, (bf16_t*)(a.ws + f.dst + (size_t)mi * f.dstride), f.K, n0, kb * 64, scr, lane, fid == 11 ? 32.f : 64.f); return; }
#endif
    transpose_item<NT>(a.in[f.src] + (size_t)mi * f.sstride, f.ldw, fam_src_col(f.map, n0), fam_src_col(f.map, n0 + 32), gain, (bf16_t*)(a.ws + f.dst + (size_t)mi * f.dstride), f.K, n0, kb * 64, scr, lane);
}
__constant__ const Fam FAMS[13] = {
        {4, 2, 1024, 768, 672, 1, 3, 1024, (size_t)1024 * 672, W_AIN, (size_t)768 * 1024 * 2},
        {7, 2, 384, 1024, 768, 3, 5, 384, (size_t)384 * 768, W_QUP, (size_t)1024 * 384 * 2},
        {8, 2, 256, 1024, 1024, 0, 6, 256, (size_t)256 * 1024, W_KVUP, (size_t)1024 * 256 * 2},
        {11, 2, 512, 1024, 1024, 0, -1, 0, (size_t)512 * 1024, W_AOUT, (size_t)1024 * 512 * 2},
        {13, 1, 1024, 512, 512, 0, 12, 0, 0, W_KVS, 0},
        {15, 2, 1024, 1024, 1024, 0, 14, 1024, (size_t)1024 * 1024, W_QB, (size_t)1024 * 1024 * 2},
        {16, 2, 1024, 1024, 1024, 0, -1, 0, (size_t)1024 * 1024, W_OB, (size_t)1024 * 1024 * 2},
        {24, 4, 1024, 1024, 1024, 0, 23, 1024, (size_t)1024 * 1024, W_PG, (size_t)1024 * 1024 * 2},
        {25, 4, 256, 1024, 1024, 0, -1, 0, (size_t)256 * 1024, W_PU, (size_t)1024 * 256 * 2},
        {18, 1, 1024, 5632, 5632, 2, 17, 2048, (size_t)1024 * 5632, W_FGU, (size_t)5632 * 1024 * 2},
        {19, 1, 2816, 1024, 1024, 0, -1, 0, (size_t)2816 * 1024, W_FDN, (size_t)1024 * 2816 * 2},
        {21, 8, 1024, 5632, 5632, 2, 17, 0, (size_t)1024 * 5632, W_EGU, (size_t)5632 * 1024 * 2},
        {22, 8, 2816, 1024, 1024, 0, -1, 0, (size_t)2816 * 1024, W_EDN, (size_t)1024 * 2816 * 2}};
constexpr int DEF_N0 = 1408, DEF_N1 = DEF_N0 + 704, DEF_N2 = DEF_N1 + 11264, DEF_N3 = DEF_N2 + 5632;
#ifndef FILL_A
#define FILL_A 0
#define FILL_B 0
#define FILL_C 0
#define FILL_D 0
#endif
constexpr int DEF_QA = FILL_A, DEF_QB = DEF_QA + FILL_B, DEF_QC = DEF_QB + FILL_C, DEF_QD = DEF_QC + FILL_D;
constexpr int CW_FILL = 512;
__device__ __forceinline__ void prologue(const Args& a, Frame& F) {
    LAS float* scr = (LAS float*)(F.lds + RING_OFF + F.wave * 16384);
    const int gw = F.vcu * NWAVES + F.wave, NGW = F.G * NWAVES;
    int base = 0;
#pragma unroll 1
    for (int fid = 0; fid < 13; ++fid) { const Fam f = FAMS[fid]; const int n = fam_items(f);
        int it = gw - (base % NGW); if (it < 0) it += NGW;
#pragma unroll 1
        for (; it < n; it += NGW) fam_item(a, f, fid, it, scr, F.lane);
        base += n; }
    for (int id = DEF_QD + gw; id < DEF_N3; id += NGW) {
        if (id < DEF_N0) fam_item(a, FAMS[9], 9, id, scr, F.lane, 1);
        else if (id < DEF_N1) fam_item(a, FAMS[10], 10, id - DEF_N0, scr, F.lane, 1);
        else if (id < DEF_N2) fam_item(a, FAMS[11], 11, id - DEF_N1, scr, F.lane, 8);
        else fam_item(a, FAMS[12], 12, id - DEF_N2, scr, F.lane, 8);
    }
    { const f32x4* src = (const f32x4*)a.in[1]; u32x2* dst = (u32x2*)(a.ws + WS_PB); const size_t n4 = (size_t)4 * MT * 256 / 4, S = (size_t)NGW * 64;
        for (size_t i = (size_t)gw * 64 + F.lane; i < n4; i += 4 * S) { f32x4 v[4];
#pragma unroll
            for (int q = 0; q < 4; ++q) v[q] = (i + q * S < n4) ? src[i + q * S] : (f32x4){0.f, 0.f, 0.f, 0.f};
#pragma unroll
            for (int q = 0; q < 4; ++q) if (i + q * S < n4) { u32x2 o; o.x = pk_bf16(v[q][0], v[q][1]); o.y = pk_bf16(v[q][2], v[q][3]); dst[i + q * S] = o; } } }
    { bf16_t* HB = (bf16_t*)(a.ws + WS_HB); float* SSQ = (float*)(a.ws + WS_SSQ);
        for (int row = gw; row < MT; row += NGW) { const f32x4* xr = (const f32x4*)(a.in[0] + (size_t)row * DMODEL) + F.lane;
            u32x2* hb = (u32x2*)(HB + (size_t)row * DMODEL) + F.lane; float s = 0.f; f32x4 v4[4];
#pragma unroll
            for (int j = 0; j < 4; ++j) v4[j] = xr[64 * j];
#pragma unroll
            for (int j = 0; j < 4; ++j) { const f32x4 v = v4[j]; u32x2 o; o.x = pk_bf16(v[0], v[1]); o.y = pk_bf16(v[2], v[3]); hb[64 * j] = o; s += (v[0] * v[0] + v[1] * v[1]) + (v[2] * v[2] + v[3] * v[3]); }
            s = wave_sum(s, F.lane); if (F.lane < 16) SSQ[(size_t)row * 16 + F.lane] = F.lane == 0 ? s : 0.f; } }
    { float* cs = (float*)(a.ws + WS_CS); const int* pos = (const int*)a.in[2];
        for (int i = gw * 64 + F.lane; i < MT * 16; i += NGW * 64) { const int row = i >> 4, f = i & 15;
            const float invf = (float)exp(-9.210340371976184 * (double)f / 16.0);
            const double ang = (double)((float)pos[row] * invf);
            const double rev = ang * 0.15915494309189535, fr = rev - rint(rev); const float x = (float)(fr * 6.283185307179586);
            cs[(size_t)row * 32 + f] = cosf(x); cs[(size_t)row * 32 + 16 + f] = sinf(x); } }
}
#define THIN_LAUNDER() Frame F = F_; unsigned char* wsl = a.ws; F.lane = lane_id(); F.tid = F.wave * 64 + F.lane; asm volatile("" : "+v"(F.tid), "+v"(F.lane), "+s"(F.vcu), "+s"(F.G), "+s"(wsl))
__device__ __forceinline__ void filler(const Args& a, const Frame& F_, int qi, int start, int end) {
    Frame F = F_; { int t_ = F_.wave * 64 + lane_id(); asm volatile("" : "+v"(t_)); F.tid = t_; F.lane = t_ & 63; }
    unsigned char* wsl = a.ws; asm volatile("" : "+s"(wsl));
    LAS float* scr = (LAS float*)(F.lds + RING_OFF + F.wave * 16384);
    unsigned* ctr = (unsigned*)(wsl + WS_CTL) + CW_FILL + qi;
    for (;;) {
        int id = 0; if (F.lane == 0) id = (int)__hip_atomic_fetch_add(ctr, 1u, __ATOMIC_RELAXED, __HIP_MEMORY_SCOPE_AGENT) + start;
        id = __builtin_amdgcn_readfirstlane(id);
        if (id >= end) break;
        if (id < DEF_N0) fam_item<true>(a, FAMS[9], 9, id, scr, F.lane, 1);
        else if (id < DEF_N1) fam_item<true>(a, FAMS[10], 10, id - DEF_N0, scr, F.lane, 1);
        else if (id < DEF_N2) fam_item<true>(a, FAMS[11], 11, id - DEF_N1, scr, F.lane, 8);
        else fam_item<true>(a, FAMS[12], 12, id - DEF_N2, scr, F.lane, 8);
    }
}
__device__ __forceinline__ void moe_route(const Args& a, const Frame& F_, int layer, int cur) { THIN_LAUNDER();
    const bf16_t* HB = (const bf16_t*)(wsl + WS_HB) + (size_t)cur * MT * DMODEL; const float* gain = a.in[17] + (size_t)layer * 1024; const float* wr = a.in[20] + (size_t)(layer >> 1) * 1024 * 8;
    int* TOKE = (int*)(wsl + WS_TOKE); float* TOKG = (float*)(wsl + WS_TOKG); float* TOKRS = (float*)(wsl + WS_TOKRS); int* CNT = (int*)(wsl + WS_CNT);
    constexpr int LDW = 1032;
    LAS bf16_t* WB = (LAS bf16_t*)(F.lds + RING_OFF);
    LAS int* lcnt = (LAS int*)(F.lds + RING_OFF + 36864);
    LAS float* LG = (LAS float*)(F.lds + RING_OFF + 37888) + F.wave * 128;
    {
        const f32x4* w4p = (const f32x4*)wr + 4 * F.tid; const f32x4 w0 = w4p[0], w1 = w4p[1], w2 = w4p[2], w3 = w4p[3]; const float g0 = gain[2 * F.tid], g1 = gain[2 * F.tid + 1];
        const float xa[8] = {w0[0] * g0, w0[1] * g0, w0[2] * g0, w0[3] * g0, w1[0] * g0, w1[1] * g0, w1[2] * g0, w1[3] * g0};
        const float xb[8] = {w2[0] * g1, w2[1] * g1, w2[2] * g1, w2[3] * g1, w3[0] * g1, w3[1] * g1, w3[2] * g1, w3[3] * g1};
#pragma unroll
        for (int e = 0; e < 8; ++e) { const unsigned ha = pk_bf16(xa[e], 0.f) & 0xffffu, hb = pk_bf16(xb[e], 0.f) & 0xffffu;
            const float la = xa[e] - __uint_as_float(ha << 16), lb = xb[e] - __uint_as_float(hb << 16);
            *(LAS unsigned*)(WB + e * LDW + 2 * F.tid) = ha | (hb << 16); *(LAS unsigned*)(WB + (8 + e) * LDW + 2 * F.tid) = pk_bf16(la, lb); } }
    LAS float* SSW = (LAS float*)(F.lds + RING_OFF + 37888 + 4096);
    const int n = F.lane & 15, q = F.lane >> 4;
    for (int chunk = F.vcu; chunk < MT / 64; chunk += F.G) {
        if (F.tid < 8) lcnt[F.tid] = 0;
        __syncthreads();
        {
            const int tokw = chunk * 64 + (F.wave & 3) * 16, kh = (F.wave >> 2) * 512;
            const bf16_t* arow = HB + (size_t)(tokw + n) * DMODEL + 8 * q + kh; const LAS bf16_t* brow = WB + n * LDW + 8 * q + kh;
            f32x4 acc = {0.f, 0.f, 0.f, 0.f}; float ss = 0.f;
#pragma unroll
            for (int s = 0; s < 16; ++s) { const u32x4 av = *(const u32x4*)(arow + 32 * s); const bf16x8 bv = *(const LAS bf16x8*)(brow + 32 * s);
                acc = __builtin_amdgcn_mfma_f32_16x16x32_bf16(__builtin_bit_cast(bf16x8, av), bv, acc, 0, 0, 0);
                f32x4 x0, x1; unpack8(av, x0, x1); ss += pg8::sumsq8(x0, x1); }
            ss = pg8::red_fq(ss);
#pragma unroll
            for (int i = 0; i < 4; ++i) { const float v = acc[i] + shx(acc[i], 8, F.lane); if (n < 8) LG[(4 * q + i) * 8 + n] = v; }
            if (q == 0) SSW[F.wave * 16 + n] = ss;
        }
        __syncthreads();
        if (F.wave < 4) {
            const int tok0 = chunk * 64 + F.wave * 16;
            asm volatile("s_waitcnt lgkmcnt(0)" ::: "memory");
            if (F.lane < 16) { const int tok = tok0 + F.lane; const LAS f32x4* lp = (const LAS f32x4*)(LG + F.lane * 8); const f32x4 l0 = lp[0] + lp[128], l1 = lp[1] + lp[129];
                const float ss = SSW[F.wave * 16 + F.lane] + SSW[(F.wave + 4) * 16 + F.lane];
                const float lg[8] = {l0[0], l0[1], l0[2], l0[3], l1[0], l1[1], l1[2], l1[3]};
                const float r = 1.0f / sqrtf(ss * (1.0f / 1024.0f) + RMS_EPS);
                int e1 = 0; float v1 = lg[0];
#pragma unroll
                for (int e = 1; e < 8; ++e) if (lg[e] > v1) { v1 = lg[e]; e1 = e; }
                int e2 = 0; float v2 = -3.0e38f;
#pragma unroll
                for (int e = 0; e < 8; ++e) if (e != e1 && lg[e] > v2) { v2 = lg[e]; e2 = e; }
                const float p2 = __expf((v2 - v1) * r), g1 = 1.0f / (1.0f + p2), g2 = p2 / (1.0f + p2);
                TOKE[tok] = e1 | (e2 << 8); TOKG[tok * 2] = g1; TOKG[tok * 2 + 1] = g2; TOKRS[tok] = r;
                __hip_atomic_fetch_add(lcnt + e1, 1, __ATOMIC_RELAXED, __HIP_MEMORY_SCOPE_WORKGROUP); __hip_atomic_fetch_add(lcnt + e2, 1, __ATOMIC_RELAXED, __HIP_MEMORY_SCOPE_WORKGROUP); }
        }
        __syncthreads();
        if (F.tid < 8) CNT[chunk * 8 + F.tid] = lcnt[F.tid];
        __syncthreads();
    }
}
__device__ __forceinline__ void moe_scatter(const Args& a, const Frame& F_, int cur) { THIN_LAUNDER();
    const int* TOKE = (const int*)(wsl + WS_TOKE); const float* TOKG = (const float*)(wsl + WS_TOKG); const float* TOKRS = (const float*)(wsl + WS_TOKRS); const int* CNT = (const int*)(wsl + WS_CNT);
    int* SLOT12 = (int*)(wsl + WS_SLOT12); float* SLOTG = (float*)(wsl + WS_SLOTG); float* SLOTRS = (float*)(wsl + WS_SLOTRS); int* PSTART = (int*)(wsl + WS_PSTART);
    const bf16_t* HB = (const bf16_t*)(wsl + WS_HB) + (size_t)cur * MT * DMODEL; bf16_t* XG = (bf16_t*)(wsl + X_XG);
    LAS int* sm = (LAS int*)(F.lds + RING_OFF);
    for (int chunk = F.vcu; chunk < MT / 64; chunk += F.G) {
        { const int e = F.wave; int c4[4]; int s = 0;
#pragma unroll
            for (int i = 0; i < 4; ++i) { c4[i] = CNT[(4 * F.lane + i) * 8 + e]; s += c4[i]; }
            int inc = s;
#pragma unroll
            for (int o = 1; o < 64; o <<= 1) { const int t = shi(inc, F.lane >= o ? F.lane - o : F.lane, F.lane); if (F.lane >= o) inc += t; }
            const int total = shi(inc, 63, F.lane); int pre = inc - s;
            if (F.lane == (chunk >> 2)) { const int cm = chunk & 3; pre += (cm > 0 ? c4[0] : 0) + (cm > 1 ? c4[1] : 0) + (cm > 2 ? c4[2] : 0); sm[8 + e] = pre; }
            if (F.lane == 0) sm[e] = total; }
        __syncthreads();
        if (F.tid == 0) { int p = 0; for (int e = 0; e < 8; ++e) { sm[16 + e] = p; p += (sm[e] + 255) >> 8; } sm[24] = p; }
        __syncthreads();
        if (F.tid < 9) PSTART[F.tid] = sm[16 + F.tid];
        if (F.wave == 0) { const int tok = chunk * 64 + F.lane; const int ev = TOKE[tok], e1 = ev & 255, e2 = ev >> 8; int s1 = 0, s2 = 0;
            const unsigned long long below = (1ull << F.lane) - 1ull;
#pragma unroll
            for (int e = 0; e < 8; ++e) { const unsigned long long m1 = __ballot(e1 == e), m2 = __ballot(e2 == e);
                const int rank = __popcll(m1 & below) + __popcll(m2 & below), slot = sm[16 + e] * 256 + sm[8 + e] + rank;
                if (e1 == e) s1 = slot; if (e2 == e) s2 = slot; }
            SLOT12[tok * 2] = s1; SLOT12[tok * 2 + 1] = s2; const float r = TOKRS[tok];
            SLOTG[s1] = TOKG[tok * 2]; SLOTG[s2] = TOKG[tok * 2 + 1]; SLOTRS[s1] = r; SLOTRS[s2] = r;
            sm[32 + 2 * F.lane] = s1; sm[32 + 2 * F.lane + 1] = s2; }
        __syncthreads();
#if FP8_EGU
        {
            u32x4 a0[8], a1[8]; float rr[8]; int sl1[8], sl2[8];
#pragma unroll
            for (int i = 0; i < 8; ++i) { const int tl = F.wave * 8 + i, tok = chunk * 64 + tl; const u32x4* src = (const u32x4*)(HB + (size_t)tok * DMODEL) + 2 * F.lane;
                a0[i] = src[0]; a1[i] = src[1]; rr[i] = TOKRS[tok]; sl1[i] = sm[32 + 2 * tl]; sl2[i] = sm[32 + 2 * tl + 1]; }
#pragma unroll
            for (int i = 0; i < 8; ++i) { f32x4 x0, x1, y0, y1; unpack8(a0[i], x0, x1); unpack8(a1[i], y0, y1); const float r = rr[i];
                const u32x2 lo = pack8_fp8(x0 * r, x1 * r), hi = pack8_fp8(y0 * r, y1 * r); const u32x4 o = {lo.x, lo.y, hi.x, hi.y};
                *((u32x4*)((unsigned char*)XG + (size_t)sl1[i] * DMODEL) + F.lane) = o; *((u32x4*)((unsigned char*)XG + (size_t)sl2[i] * DMODEL) + F.lane) = o; }
        }
#else
        for (int i = 0; i < 16; ++i) { const int pr = F.wave * 16 + i, tok = chunk * 64 + (pr >> 1), slot = sm[32 + pr];
            const u32x4* src = (const u32x4*)(HB + (size_t)tok * DMODEL) + F.lane; u32x4* dst = (u32x4*)(XG + (size_t)slot * DMODEL) + F.lane;
            dst[0] = src[0]; dst[64] = src[64]; }
#endif
        __syncthreads();
    }
}
__device__ __forceinline__ void moe_combine(const Args& a, const Frame& F_, int cur, bool dummy) { THIN_LAUNDER();
    const int* SLOT12 = (const int*)(wsl + WS_SLOT12); const bf16_t* YG = (const bf16_t*)(wsl + X_YG); const float* TOKG = (const float*)(wsl + WS_TOKG);
    const bf16_t* HBi = (const bf16_t*)(wsl + WS_HB) + (size_t)cur * MT * DMODEL;
    bf16_t* HB = dummy ? (bf16_t*)(wsl + WS_END + 66 * MiB) : (bf16_t*)(wsl + WS_HB) + (size_t)cur * MT * DMODEL; float* SSQ = dummy ? (float*)(wsl + WS_END + 99 * MiB) : (float*)(wsl + WS_SSQ) + (size_t)cur * MT * 16;
    const int gw = F.vcu * NWAVES + F.wave, NGW = F.G * NWAVES;
    for (int r0 = F.vcu * 64; r0 < MT; r0 += F.G * 64) {
        const int rw = r0 + F.wave * 8;
        u32x2 sl = {0u, 0u}; f32x2 gg = {0.f, 0.f};
        if (F.lane < 8) { sl = *(const u32x2*)(SLOT12 + (size_t)(rw + F.lane) * 2); gg = *(const f32x2*)(TOKG + (size_t)(rw + F.lane) * 2); }
#pragma unroll
        for (int k2 = 0; k2 < 8; k2 += 2) {
            u32x2 hv[2][4], pv_[2][4], qv[2][4]; float g1[2], g2[2];
#pragma unroll
            for (int t = 0; t < 2; ++t) { const int row = rw + k2 + t; const int s1 = __builtin_amdgcn_readlane((int)sl.x, k2 + t), s2 = __builtin_amdgcn_readlane((int)sl.y, k2 + t);
                g1[t] = __uint_as_float(__builtin_amdgcn_readlane(__float_as_uint(gg.x), k2 + t)); g2[t] = __uint_as_float(__builtin_amdgcn_readlane(__float_as_uint(gg.y), k2 + t));
                const u32x2* hr = (const u32x2*)(HBi + (size_t)row * DMODEL) + F.lane; const u32x2* y1 = (const u32x2*)(YG + (size_t)s1 * DMODEL) + F.lane; const u32x2* y2 = (const u32x2*)(YG + (size_t)s2 * DMODEL) + F.lane;
#pragma unroll
                for (int j = 0; j < 4; ++j) { hv[t][j] = hr[64 * j]; pv_[t][j] = y1[64 * j]; qv[t][j] = y2[64 * j]; } }
#pragma unroll
            for (int t = 0; t < 2; ++t) { const int row = rw + k2 + t; u32x2* hb = (u32x2*)(HB + (size_t)row * DMODEL) + F.lane; float s = 0.f;
#pragma unroll
                for (int j = 0; j < 4; ++j) { const u32x2 h = hv[t][j], p = pv_[t][j], q = qv[t][j]; f32x4 v;
                    v[0] = bf_lo(h.x) + (g1[t] * bf_lo(p.x) + g2[t] * bf_lo(q.x)); v[1] = bf_hi(h.x) + (g1[t] * bf_hi(p.x) + g2[t] * bf_hi(q.x)); v[2] = bf_lo(h.y) + (g1[t] * bf_lo(p.y) + g2[t] * bf_lo(q.y)); v[3] = bf_hi(h.y) + (g1[t] * bf_hi(p.y) + g2[t] * bf_hi(q.y));
                    u32x2 o; o.x = pk_bf16(v[0], v[1]); o.y = pk_bf16(v[2], v[3]); hb[64 * j] = o; s += (v[0] * v[0] + v[1] * v[1]) + (v[2] * v[2] + v[3] * v[3]); }
                s = wave_sum(s, F.lane); if (F.lane < 16) SSQ[(size_t)row * 16 + F.lane] = F.lane == 0 ? s : 0.f; }
        }
    }
}

__global__ void __launch_bounds__(NTHR, 2) yoco_fwd(Args args) {
    extern __shared__ __attribute__((aligned(16))) unsigned char lds_raw[];
    Frame F; F.lds = (LAS unsigned char*)lds_raw;
    volatile LAS unsigned* MISC = (volatile LAS unsigned*)(F.lds + MISC_OFF);
    F.wave = __builtin_amdgcn_readfirstlane((int)threadIdx.x >> 6); F.lane = lane_id(); F.tid = F.wave * 64 + F.lane;
    F.G = gridDim.x; { const int bx = blockIdx.x; F.vcu = (F.G % 8 == 0) ? (bx % 8) * (F.G / 8) + bx / 8 : bx; }
    for (int u = F.tid; u < (LDS_BYTES - LDSCTL_OFF) / 4; u += NTHR) ((LAS unsigned*)(F.lds + LDSCTL_OFF))[u] = 0u;
    __syncthreads();
    unsigned char* ws = args.ws;
#define WS_LAUNDER() do { F.lane = lane_id(); F.tid = F.wave * 64 + F.lane; asm volatile("" : "+s"(ws), "+s"(bx), "+s"(F.G), "+s"(F.vcu), "+v"(F.tid), "+v"(F.lane)); } while (0)
    const bool single = (args.ph_hi - args.ph_lo) > 1;
    XcdBarrier bar; bar.bar = (unsigned*)(ws + WS_CTL) + CW_BAR; bar.x = 0; bar.st = nullptr; bar.wv = F.wave;
    if (single) bar = xcd_barrier_post((unsigned*)(ws + WS_CTL) + CW_BAR, MISC + 8, F.wave);
    if (single && F.wave == 0 && lane_id() == 0) __hip_atomic_store((unsigned*)(ws + WS_CTL) + CW_BAR + XB_CHK + (int)blockIdx.x, bar.x + 1u, __ATOMIC_RELAXED, __HIP_MEMORY_SCOPE_AGENT);
    if (F.tid == 0) {
        const int wn_[4] = {1024, 768, 512, 5632};
#pragma unroll
        for (int q = 0; q < 4; ++q) { pg8::StaticOrder sw_; sw_.init(MT, wn_[q], (int)gridDim.x, (int)blockIdx.x); pg8::Unit wu_; MISC[16 + q] = sw_.next(0, wu_) ? (unsigned)wu_.pn : 0xffffffffu; } }
    __syncthreads();
    const int lo = args.ph_lo, hi = args.ph_hi;
    bool local_ok = false;
#ifndef GU_ALIGN
#define GU_ALIGN true
#endif
#ifndef EN_MASK
#define EN_MASK 0xFFFFFFFFu
#endif
#define EN(b) (((EN_MASK) >> (b)) & 1u)
#define IN(k) (lo <= (k) && (k) < hi)
#define WARM_DECL() unsigned w0_ = 0u, w1_ = 0u
#define WARM_ISSUE(A_, B_, BT, NI_, RB_) do { const int pn_ = __builtin_amdgcn_readfirstlane((int)MISC[16 + (NI_)]); if (pn_ >= 0) { \
        const unsigned char* wb_ = (const unsigned char*)(BT) + (size_t)pn_ * 256 * (RB_) + (size_t)(F.tid >> 1) * (RB_) + (F.tid & 1) * 256; \
        asm volatile("global_load_dword %0, %2, off\n\tglobal_load_dword %1, %2, off offset:128" : "=&v"(A_), "=&v"(B_) : "v"(wb_) : "memory"); } } while (0)
#define WARM_RETIRE() do { asm volatile("s_waitcnt vmcnt(0)" ::: "memory"); asm volatile("" :: "v"(w0_), "v"(w1_)); } while (0)
#define PU_TAIL(NWG) do { WS_LAUNDER(); const int r_ = (NWG) % F.G, ni_ = r_ ? F.G - r_ : F.G; \
        pg8::Gemm g2{(const bf16_t*)(ws + WS_PB) + (size_t)l * MT * 256, (const bf16_t*)(ws + W_PU) + (size_t)l * 1024 * 256, MT, 1024, 256}; \
        pg8::StaticOrder S2; S2.init(MT, 1024, ni_, bx >= r_ ? bx - r_ : (1 << 24)); \
        pg8::EpiScale E2{(bf16_t*)(ws + WS_U) + (size_t)l * MT * DMODEL, 1024, pg8::RowScale{nullptr, 0}, 1.0f}; \
        pg8::gemm_phase<pg8::EpiScale, pg8::StaticOrder, true, true>(ring, g2, S2, E2, F.wave); } while (0)
#ifdef REP_MASK
#define NREPS(k) ((((unsigned long long)(REP_MASK) >> (k)) & 1ull) ? (REP_N) + 1 : 1)
#else
#define NREPS(k) 1
#endif
#define REPLOOP(k) for (int rep_ = 0, nrep_ = NREPS(k); rep_ < nrep_; ++rep_)
#define DUMMY (rep_ + 1 < nrep_)
#define OUT_HB(set) (DUMMY ? (bf16_t*)(ws + WS_END + 66 * MiB) : (bf16_t*)(ws + WS_HB) + (size_t)(set) * MT * DMODEL)
#define OUT_SSQ(set) (DUMMY ? (float*)(ws + WS_END + 99 * MiB) : (float*)(ws + WS_SSQ) + (size_t)(set) * MT * 16)
#define SEAM(k) do { if (single && (k) + 1 < hi) { XcdBarrier b_ = bar; asm volatile("" : "+s"(b_.bar), "+s"(b_.x)); xcd_barrier(b_); } } while (0)
#define SEAM_L(k) do { if (single && (k) + 1 < hi) { XcdBarrier b_ = bar; asm volatile("" : "+s"(b_.bar), "+s"(b_.x)); if (local_ok) xcd_local_barrier(b_); else xcd_barrier(b_); } } while (0)

    LAS unsigned char* ring = F.lds + RING_OFF;
    int bx = (int)blockIdx.x;

    if (EN(0) && IN(0)) REPLOOP(0) { WS_LAUNDER(); prologue(args, F); SEAM(0); }
#ifndef NO_LOCAL_SEAMS
    if (single && lo == 0 && hi > 1) {
        const int t_ = F.wave * 64 + lane_id(); unsigned* chk = (unsigned*)(ws + WS_CTL) + CW_BAR + XB_CHK;
        int good = (F.G == 256);
        if (good && t_ < 256) { const unsigned a = __hip_atomic_load(chk + t_, __ATOMIC_RELAXED, __HIP_MEMORY_SCOPE_AGENT), r = __hip_atomic_load(chk + (t_ & 7), __ATOMIC_RELAXED, __HIP_MEMORY_SCOPE_AGENT); good = (a != 0u && a == r); }
        local_ok = __syncthreads_and(good) != 0;
    }
#endif
#ifdef EXTRA_BARRIERS
    if (single) for (int xb_ = 0; xb_ < EXTRA_BARRIERS; ++xb_) { XcdBarrier b_ = bar; asm volatile("" : "+s"(b_.bar), "+s"(b_.x)); xcd_barrier(b_); }
#endif
#pragma unroll 1
    for (int l = 0; l < 4; ++l) {
        const int base = 2 + PH_PER_LAYER * l; const bool is_mla = l < 2, is_moe = (l & 1) != 0; const int cur = l & 1, j = l & 1;
#define HBc ((const bf16_t*)(ws + WS_HB) + (size_t)cur * MT * DMODEL)
#define HBw ((bf16_t*)(ws + WS_HB) + (size_t)cur * MT * DMODEL)
#define SSQc ((float*)(ws + WS_SSQ) + (size_t)cur * MT * 16)
        if (IN(base + 0)) REPLOOP(base + 0) { WS_LAUNDER();
            if (EN(2) && is_mla) {
                pg8::Gemm g{HBc, (const bf16_t*)(ws + W_AIN) + (size_t)l * 768 * 1024, MT, 768, 1024};
                pg8::StaticOrder S; S.init(MT, 768, F.G, bx);
                pg8::EpiAin E{(bf16_t*)(ws + X_AQ), (bf16_t*)(ws + X_AKV), (float*)(ws + WS_KPE), (float*)(ws + WS_SSQQ), (float*)(ws + WS_SSQKV), pg8::RowScale{SSQc, 1}, args.in[10] + l * 96, (const float*)(ws + WS_CS), (float*)(ws + WS_SSPE)};
                pg8::gemm_phase<pg8::EpiAin, pg8::StaticOrder, true, true>(ring, g, S, E, F.wave);
            } else if (EN(3) && !is_mla) {
                pg8::Gemm g{HBc, (const bf16_t*)(ws + W_QB) + (size_t)j * 1024 * 1024, MT, 1024, 1024};
                pg8::StaticOrder S; S.init(MT, 1024, F.G, bx);
                pg8::EpiScale E{(bf16_t*)(ws + X_SQ), 1024, pg8::RowScale{SSQc, 1}, QSCALE_SB};
                pg8::gemm_phase<pg8::EpiScale, pg8::StaticOrder, true, true>(ring, g, S, E, F.wave);
                asm volatile("s_waitcnt vmcnt(0)" ::: "memory"); __syncthreads();
                __builtin_amdgcn_fence(__ATOMIC_ACQUIRE, "agent"); asm volatile("s_waitcnt vmcnt(0)" ::: "memory");
                WS_LAUNDER();
                pg8::StaticOrder S2; S2.init(MT, 1024, F.G, bx); pg8::Unit uu;
                for (int ui = 0; S2.next(ui, uu); ++ui)
                    for (int i4 = 0; i4 < 4; ++i4) {
#ifdef SBA_ABL
                        if (DUMMY) att::sba::unit<SBA_ABL>(uu.pm >> 5, uu.pn, (uu.pm & 31) * 4 + i4, (const bf16_t*)(ws + X_SQ), (const bf16_t*)(ws + WS_SKT), (const bf16_t*)(ws + WS_SVT), (bf16_t*)(ws + WS_END + 66 * MiB), ring, F.wave); else
#endif
                        att::sba::unit<0>(uu.pm >> 5, uu.pn, (uu.pm & 31) * 4 + i4, (const bf16_t*)(ws + X_SQ), (const bf16_t*)(ws + WS_SKT), (const bf16_t*)(ws + WS_SVT), (bf16_t*)(ws + X_SO), ring, F.wave); }
            }
            SEAM_L(base + 0);
        }
        if (EN(4) && is_mla && IN(base + 1)) REPLOOP(base + 1) { WS_LAUNDER();
            { pg8::Gemm g{(const bf16_t*)(ws + X_AQ), (const bf16_t*)(ws + W_QUP) + (size_t)l * 1024 * 384, MT, 1024, 384};
              pg8::StaticOrder S; S.init(MT, 1024, F.G, bx);
              EpiQ E{ws, args.in[9] + l * 96};
              pg8::gemm_phase<EpiQ, pg8::StaticOrder, true, true, false, true>(ring, g, S, E, F.wave); }
            { pg8::Gemm g{(const bf16_t*)(ws + X_AKV), (const bf16_t*)(ws + W_KVUP) + (size_t)l * 1024 * 256, MT, 1024, 256};
              pg8::StaticOrder S; S.init(MT, 1024, F.G, bx);
              EpiKV E{ws, args.in[10] + l * 96};
              pg8::gemm_phase<EpiKV, pg8::StaticOrder, true, true, false, true>(ring, g, S, E, F.wave); }
            SEAM(base + 1);
        }
        if (is_mla && IN(base + 3)) REPLOOP(base + 3) { WS_LAUNDER();
#if defined(MLA_ABL)
            if (EN(6) && is_mla && DUMMY) att::mla::phase<MLA_ABL>(F.vcu, F.G, (const bf16_t*)(ws + X_Q), (const bf16_t*)(ws + X_KT), (const bf16_t*)(ws + X_VT), (bf16_t*)(ws + WS_END + 66 * MiB), ring, F.wave);
            else
#endif
            if (EN(6) && is_mla) att::mla::phase<0>(F.vcu, F.G, (const bf16_t*)(ws + X_Q), (const bf16_t*)(ws + X_KT), (const bf16_t*)(ws + X_VT), (bf16_t*)(ws + X_O), ring, F.wave);
            SEAM(base + 3);
        }
        if (EN(8) && IN(base + 4)) REPLOOP(base + 4) { WS_LAUNDER();
            pg8::Gemm g = is_mla ? pg8::Gemm{(const bf16_t*)(ws + X_O), (const bf16_t*)(ws + W_AOUT) + (size_t)l * 1024 * 512, MT, 1024, 512}
                                 : pg8::Gemm{(const bf16_t*)(ws + X_SO), (const bf16_t*)(ws + W_OB) + (size_t)j * 1024 * 1024, MT, 1024, 1024};
            pg8::StaticOrder S; S.init(MT, 1024, F.G, bx);
            pg8::EpiRes<false> E{HBc, OUT_HB(cur), OUT_SSQ(cur), nullptr, pg8::RowScale{nullptr, 0}, nullptr, 1.0f};
            pg8::gemm_phase<pg8::EpiRes<false>, pg8::StaticOrder, true, true>(ring, g, S, E, F.wave);
            SEAM_L(base + 4);
        }
        if (!is_moe) {
            if (EN(9) && IN(base + 5)) REPLOOP(base + 5) { WS_LAUNDER();
                pg8::Gemm g{HBc, (const bf16_t*)(ws + W_FGU) + (size_t)(l >> 1) * 5632 * 1024, MT, 5632, 1024};
                pg8::GroupOrder S; S.init_dense(MT, 5632, F.G, bx);
                pg8::EpiSwiglu E{(bf16_t*)(ws + X_HID), pg8::RowScale{SSQc, 1}, 0, FP8_FDN, 1.0f};
                pg8::gemm_phase<pg8::EpiSwiglu, pg8::GroupOrder, GU_ALIGN, true>(ring, g, S, E, F.wave);
                PU_TAIL((MT / 256) * 22);
#if FILL_A + FILL_D > 0
                filler(args, F, l == 0 ? 0 : 3, l == 0 ? 0 : DEF_QC, l == 0 ? DEF_QA : DEF_QD);
#endif
                SEAM_L(base + 5);
            }
            if (EN(10) && IN(base + 6)) REPLOOP(base + 6) { WS_LAUNDER();
                pg8::Gemm g{(const bf16_t*)(ws + X_HID), (const bf16_t*)(ws + W_FDN) + (size_t)(l >> 1) * 1024 * 2816, MT, 1024, FP8_FDN ? 1408 : 2816};
                pg8::StaticOrder S; S.init(MT, 1024, F.G, bx);
                pg8::EpiRes<false> E{HBc, OUT_HB(cur), OUT_SSQ(cur), nullptr, pg8::RowScale{nullptr, 0}, nullptr, FP8_FDN ? 1.0f / 64.0f : 1.0f};
                pg8::gemm_phase<pg8::EpiRes<false>, pg8::StaticOrder, true, true, FP8_FDN != 0>(ring, g, S, E, F.wave);
                { WARM_DECL(); WARM_ISSUE(w0_, w1_, ws + W_PG + (size_t)l * 1024 * 1024 * 2, 0, 2048); SEAM_L(base + 6); WARM_RETIRE(); }
            }
        } else {
            if (EN(11) && IN(base + 5)) REPLOOP(base + 5) { WS_LAUNDER(); moe_route(args, F, l, cur); SEAM(base + 5); }
            if (EN(12) && IN(base + 6)) REPLOOP(base + 6) { WS_LAUNDER(); moe_scatter(args, F, cur); SEAM(base + 6); }
            if (EN(13) && IN(base + 7)) REPLOOP(base + 7) { WS_LAUNDER();
                pg8::Gemm g{(const bf16_t*)(ws + X_XG), (const bf16_t*)(ws + W_EGU) + (size_t)(l >> 1) * 8 * 5632 * 1024, MAXSLOT, 5632, FP8_EGU ? 512 : 1024};
                pg8::GroupOrder S; S.init((const int*)(ws + WS_PSTART), 5632, F.G, bx, (size_t)5632 * 1024 * 2);
                #ifndef EPI_ABL
#define EPI_ABL 0
#endif
                pg8::EpiSwiglu E{(bf16_t*)(ws + X_HG), FP8_EGU ? pg8::RowScale{nullptr, 0} : pg8::RowScale{(const float*)(ws + WS_SLOTRS), 2}, DUMMY ? EPI_ABL : 0, FP8_EDN, FP8_EGU ? 1.0f / 32.0f : 1.0f};
                pg8::gemm_phase<pg8::EpiSwiglu, pg8::GroupOrder, GU_ALIGN, true, FP8_EGU != 0>(ring, g, S, E, F.wave);
#if FILL_B > 0
                if (l == 1) filler(args, F, 1, DEF_QA, DEF_QB);
#endif
                SEAM(base + 7);
            }
            if (EN(14) && IN(base + 8)) REPLOOP(base + 8) { WS_LAUNDER();
                pg8::Gemm g{(const bf16_t*)(ws + X_HG), (const bf16_t*)(ws + W_EDN) + (size_t)(l >> 1) * 8 * 1024 * 2816, MAXSLOT, 1024, FP8_EDN ? 1408 : 2816};
                pg8::GroupOrder S; S.init((const int*)(ws + WS_PSTART), 1024, F.G, bx, (size_t)1024 * 2816 * 2);
                pg8::EpiScale E{(bf16_t*)(ws + X_YG), 1024, pg8::RowScale{nullptr, 0}, FP8_EDN ? 1.0f / 64.0f : 1.0f};
                pg8::gemm_phase<pg8::EpiScale, pg8::GroupOrder, true, true, FP8_EDN != 0>(ring, g, S, E, F.wave);
                { const int nwg_e = __builtin_amdgcn_readfirstlane(((const int*)(ws + WS_PSTART))[8]) * 4; PU_TAIL(nwg_e); }
#if FILL_C > 0
                if (l == 1) filler(args, F, 2, DEF_QB, DEF_QC);
#endif
                SEAM(base + 8);
            }
            if (EN(15) && IN(base + 9)) REPLOOP(base + 9) { WS_LAUNDER(); moe_combine(args, F, cur, DUMMY); { WARM_DECL(); WARM_ISSUE(w0_, w1_, ws + W_PG + (size_t)l * 1024 * 1024 * 2, 0, 2048); SEAM_L(base + 9); WARM_RETIRE(); } }
        }
        if (EN(16) && IN(base + 10)) REPLOOP(base + 10) { WS_LAUNDER();
            pg8::Gemm g{HBc, (const bf16_t*)(ws + W_PG) + (size_t)l * 1024 * 1024, MT, 1024, 1024};
            pg8::StaticOrder S; S.init(MT, 1024, F.G, bx);
            pg8::EpiRes<true> E{HBc, OUT_HB(cur ^ 1), OUT_SSQ(cur ^ 1),
                                (const bf16_t*)(ws + WS_U) + (size_t)l * MT * DMODEL, pg8::RowScale{SSQc, 1}, (l == 3 && !DUMMY) ? args.out : nullptr, 1.0f};
            pg8::gemm_phase<pg8::EpiRes<true>, pg8::StaticOrder, true, true>(ring, g, S, E, F.wave);
            if (l == 3) SEAM(base + 10); else { WARM_DECL(); if (l == 0) WARM_ISSUE(w0_, w1_, ws + W_AIN + (size_t)768 * 1024 * 2, 1, 2048); else if (l == 1) WARM_ISSUE(w0_, w1_, ws + W_KVS, 2, 2048); else WARM_ISSUE(w0_, w1_, ws + W_QB + (size_t)1024 * 1024 * 2, 0, 2048); SEAM_L(base + 10); WARM_RETIRE(); }
        }
        if (EN(17) && l == 1 && IN(base + 11)) REPLOOP(base + 11) { WS_LAUNDER();
            pg8::Gemm g{(const bf16_t*)(ws + WS_HB) + (size_t)(cur ^ 1) * MT * DMODEL, (const bf16_t*)(ws + W_KVS), MT, 512, 1024};
            pg8::StaticOrder S; S.init(MT, 512, F.G, bx);
            pg8::EpiKvs E{(bf16_t*)(ws + WS_SKT), (bf16_t*)(ws + WS_SVT), pg8::RowScale{(const float*)(ws + WS_SSQ) + (size_t)(cur ^ 1) * MT * 16, 1}};
            pg8::gemm_phase<pg8::EpiKvs, pg8::StaticOrder, true, true>(ring, g, S, E, F.wave);
            { WARM_DECL(); WARM_ISSUE(w0_, w1_, ws + W_QB, 0, 2048); SEAM(base + 11); WARM_RETIRE(); }
        }
    }
#undef IN
#undef SEAM
}
}
#define MULTI_LAUNCH 0
extern "C" void kernel_launch(void* const* d_in, const int* in_sizes, int n_in, void* d_out, int out_size, void* d_ws, size_t ws_size, hipStream_t stream) {
    using namespace fw;
    static int grid = 0;
    if (grid == 0) {
        if (n_in != 26 || out_size != MT * DMODEL || ws_size < WS_NEED) { fprintf(stderr, "kernel_launch: unexpected n_in %d / out %d / ws %zu\n", n_in, out_size, ws_size); grid = -1; return; }
        if (hipFuncSetAttribute((const void*)yoco_fwd, hipFuncAttributeMaxDynamicSharedMemorySize, LDS_BYTES) != hipSuccess) { fprintf(stderr, "kernel_launch: hipFuncSetAttribute failed\n"); grid = -1; return; }
        int dev = 0, cus = 0, per_cu = 0;
        (void)hipGetDevice(&dev); (void)hipDeviceGetAttribute(&cus, hipDeviceAttributeMultiprocessorCount, dev);
        (void)hipOccupancyMaxActiveBlocksPerMultiprocessor(&per_cu, (const void*)yoco_fwd, NTHR, LDS_BYTES);
        (void)hipGetLastError();
        grid = (cus > 0 && per_cu >= 1) ? cus : 256;
        if (grid > 256) grid = 256;
    }
    if (grid < 0) return;
    (void)hipMemsetAsync((unsigned char*)d_ws + WS_CTL, 0, CTL_ZERO_BYTES, stream);
    Args a{};
    for (int i = 0; i < 26; ++i) a.in[i] = (const float*)d_in[i];
    a.out = (float*)d_out; a.ws = (unsigned char*)d_ws;
#if MULTI_LAUNCH
    for (int k = 0; k < PH_TOTAL; ++k) { if (!phase_active(k)) continue; a.ph_lo = k; a.ph_hi = k + 1; hipLaunchKernelGGL(yoco_fwd, dim3(grid), dim3(NTHR), LDS_BYTES, stream, a); }
#else
#ifdef PROBE_MASK
    a.ph_lo = 0; a.ph_hi = PH_TOTAL;
#else
    a.ph_lo = 0; a.ph_hi = PH_TOTAL - 1;
#endif
    hipLaunchKernelGGL(yoco_fwd, dim3(grid), dim3(NTHR), LDS_BYTES, stream, a);
#endif
}
```

```cpp
#include <hip/hip_runtime.h>
#include <cstdio>
#include <cstdint>
#include <cmath>
#define LAS __attribute__((address_space(3)))
#define GAS __attribute__((address_space(1)))
typedef unsigned short bf16_t;
typedef short bf16x8 __attribute__((ext_vector_type(8)));
typedef float f32x4 __attribute__((ext_vector_type(4)));
typedef float f32x2 __attribute__((ext_vector_type(2)));
typedef float f32x16 __attribute__((ext_vector_type(16)));
typedef unsigned u32x4 __attribute__((ext_vector_type(4)));
typedef unsigned u32x2 __attribute__((ext_vector_type(2)));
typedef short s16x4 __attribute__((ext_vector_type(4)));
typedef __bf16 bf16x2_t __attribute__((ext_vector_type(2)));

constexpr int MT = 16384, DMODEL = 1024, SEQL = 8192;
constexpr float RMS_EPS = 1e-6f;
constexpr float LOG2E = 1.4426950408889634f;

__device__ __forceinline__ unsigned pk_bf16(float lo, float hi) { f32x2 v = {lo, hi}; bf16x2_t b = __builtin_convertvector(v, bf16x2_t); return __builtin_bit_cast(unsigned, b); }
__device__ __forceinline__ float bf_lo(unsigned w) { return __uint_as_float(w << 16); }
__device__ __forceinline__ float bf_hi(unsigned w) { return __uint_as_float(w & 0xffff0000u); }
__device__ __forceinline__ unsigned cvt_pk_bf16(float lo, float hi) { unsigned r; asm volatile("v_cvt_pk_bf16_f32 %0, %1, %2" : "=v"(r) : "v"(lo), "v"(hi)); return r; }
__device__ __forceinline__ u32x4 pack8(const f32x4 a, const f32x4 b) { u32x4 w; w.x = cvt_pk_bf16(a[0], a[1]); w.y = cvt_pk_bf16(a[2], a[3]); w.z = cvt_pk_bf16(b[0], b[1]); w.w = cvt_pk_bf16(b[2], b[3]); return w; }
__device__ __forceinline__ u32x2 pack8_fp8(const f32x4 a, const f32x4 b) {
    u32x2 w; int lo = 0, hi = 0;
    lo = __builtin_amdgcn_cvt_pk_fp8_f32(__builtin_amdgcn_fmed3f(a[0], -448.f, 448.f), __builtin_amdgcn_fmed3f(a[1], -448.f, 448.f), lo, false); lo = __builtin_amdgcn_cvt_pk_fp8_f32(__builtin_amdgcn_fmed3f(a[2], -448.f, 448.f), __builtin_amdgcn_fmed3f(a[3], -448.f, 448.f), lo, true);
    hi = __builtin_amdgcn_cvt_pk_fp8_f32(__builtin_amdgcn_fmed3f(b[0], -448.f, 448.f), __builtin_amdgcn_fmed3f(b[1], -448.f, 448.f), hi, false); hi = __builtin_amdgcn_cvt_pk_fp8_f32(__builtin_amdgcn_fmed3f(b[2], -448.f, 448.f), __builtin_amdgcn_fmed3f(b[3], -448.f, 448.f), hi, true);
    w.x = (unsigned)lo; w.y = (unsigned)hi; return w; }
__device__ __forceinline__ void unpack8(const u32x4 w, f32x4& a, f32x4& b) { a = (f32x4){bf_lo(w.x), bf_hi(w.x), bf_lo(w.y), bf_hi(w.y)}; b = (f32x4){bf_lo(w.z), bf_hi(w.z), bf_lo(w.w), bf_hi(w.w)}; }
__device__ __forceinline__ float fast_rcp(float x) { return __builtin_amdgcn_rcpf(x); }
__device__ __forceinline__ float fast_exp2(float x) { return __builtin_amdgcn_exp2f(x); }
__device__ __forceinline__ float fast_log2(float x) { return __builtin_amdgcn_logf(x); }
__device__ __forceinline__ int lane_id() { int l; asm volatile("v_mbcnt_lo_u32_b32 %0, -1, 0\n\tv_mbcnt_hi_u32_b32 %0, -1, %0" : "=v"(l)); return l; }
__device__ __forceinline__ float sigmoidf_(float x) { return fast_rcp(1.0f + fast_exp2(-x * LOG2E)); }
__device__ __forceinline__ f32x4 sigmoid4(const f32x4 a, float nsl) { const f32x4 t = a * nsl; f32x4 e = {fast_exp2(t[0]), fast_exp2(t[1]), fast_exp2(t[2]), fast_exp2(t[3])}; e = e + 1.0f; return (f32x4){fast_rcp(e[0]), fast_rcp(e[1]), fast_rcp(e[2]), fast_rcp(e[3])}; }

#ifndef GROUP_WGM
#define GROUP_WGM 8
#endif
namespace pg8 {
constexpr int BM = 256, BK = 64, HALF = 128, HTB = HALF * BK * 2, STAGE_BYTES = 8 * HTB, NXCD = 8, WGM = 8;
__host__ __device__ __forceinline__ int lds_byte(int r, int c) { const int st = (r >> 4) * 2 + (c >> 5), rr = r & 15, cc = c & 31, ob = rr * 64 + cc * 2; return st * 1024 + (ob ^ (((ob >> 9) & 1) << 5)); }
__host__ __device__ __forceinline__ void stage_rc(int b, int& R, int& C) { const int st = b / 1024, sb = b % 1024, swz = sb ^ (((sb >> 9) & 1) << 5); R = (st >> 1) * 16 + swz / 64; C = (st & 1) * 32 + (swz % 64) / 2; }
__host__ __device__ __forceinline__ int perm32(int rho) { const int n = rho >> 4, i = rho & 15; return 8 * (i >> 2) + 4 * n + (i & 3); }

struct Unit { int pm, pn; size_t boff; };
struct Gemm { const bf16_t* A; const bf16_t* Bt; int M, N, K; };

struct StaticOrder {
    int nM, nN, nwg, G, c;
    __device__ __forceinline__ void init(int M, int N, int G_, int c_) { nM = M / BM; nN = N / BM; nwg = nM * nN; G = G_; c = c_; }
    __device__ __forceinline__ bool next(int i, Unit& u) const {
        const long L = (long)i * G + c; if (L >= nwg) return false;
        int wgid = (int)L; { const int q = nwg / NXCD, r = nwg % NXCD, xcd = wgid % NXCD, off = wgid / NXCD; wgid = (xcd < r ? xcd * (q + 1) : r * (q + 1) + (xcd - r) * q) + off; }
        const int nig = WGM * nN, gid = wgid / nig, fm = gid * WGM, gsz = (nM - fm) < WGM ? (nM - fm) : WGM;
        u.pm = fm + ((wgid % nig) % gsz); u.pn = (wgid % nig) / gsz; u.boff = 0; return true;
    }
};
struct GroupOrder {
    int ps[9]; int nN, nwg, G, c; size_t estride;
    __device__ __forceinline__ void init(const int* pstart, int N, int G_, int c_, size_t estride_) {
#pragma unroll
        for (int e = 0; e < 9; ++e) ps[e] = __builtin_amdgcn_readfirstlane(pstart[e]);
        nN = N / BM; nwg = ps[8] * nN; G = G_; c = c_; estride = estride_; }
    __device__ __forceinline__ void init_dense(int M, int N, int G_, int c_) {
        ps[0] = 0;
#pragma unroll
        for (int e = 1; e < 9; ++e) ps[e] = M / BM;
        nN = N / BM; nwg = ps[8] * nN; G = G_; c = c_; estride = 0; }
    __device__ __forceinline__ bool next(int i, Unit& u) const {
        const long L = (long)i * G + c; if (L >= nwg) return false;
        int wgid = (int)L; { const int q = nwg / NXCD, r = nwg % NXCD, xcd = wgid % NXCD, off = wgid / NXCD; wgid = (xcd < r ? xcd * (q + 1) : r * (q + 1) + (xcd - r) * q) + off; }
        int e = 0;
#pragma unroll
        for (int k = 1; k < 8; ++k) if (wgid >= ps[k] * nN) e = k;
        int p0 = ps[0], p1 = ps[1];
#pragma unroll
        for (int k = 1; k < 8; ++k) if (e == k) { p0 = ps[k]; p1 = ps[k + 1]; }
        const int local = wgid - p0 * nN, np = p1 - p0;
        constexpr int GW = GROUP_WGM;
        const int nig = GW * nN, gid = local / nig, fm = gid * GW, gsz = (np - fm) < GW ? (np - fm) : GW;
        u.pm = p0 + fm + ((local % nig) % gsz); u.pn = (local % nig) / gsz; u.boff = (size_t)e * estride; return true;
    }
};


__device__ __forceinline__ float sumsq8(const f32x4 a, const f32x4 b) { return ((a[0] * a[0] + a[1] * a[1]) + (a[2] * a[2] + a[3] * a[3])) + ((b[0] * b[0] + b[1] * b[1]) + (b[2] * b[2] + b[3] * b[3])); }
__device__ __forceinline__ float red_fq(float s) {
    { auto rr = __builtin_amdgcn_permlane16_swap(__float_as_uint(s), __float_as_uint(s), false, false); s = __uint_as_float(rr[0]) + __uint_as_float(rr[1]); }
    { auto rr = __builtin_amdgcn_permlane32_swap(__float_as_uint(s), __float_as_uint(s), false, false); s = __uint_as_float(rr[0]) + __uint_as_float(rr[1]); }
    return s; }
__device__ __forceinline__ float xor32(float v, int upper) {
    auto rr = __builtin_amdgcn_permlane32_swap(__float_as_uint(v), __float_as_uint(v), false, false); return __uint_as_float(upper ? rr[0] : rr[1]); }
struct RowScale {
    const float* p; int mode;
    __device__ __forceinline__ float get(int row, int fq) const {
        if (mode == 0) return 1.0f;
        if (mode == 2) return p[row];
        if (mode == 1) { const f32x4 a = *(const f32x4*)(p + (size_t)row * 16 + 4 * fq); const float s = red_fq((a[0] + a[1]) + (a[2] + a[3])); return 1.0f / sqrtf(s * (1.0f / 1024.0f) + RMS_EPS); }
        if (mode == 3) { const f32x4 a = *(const f32x4*)(p + (size_t)row * 8 + 4 * (fq & 1)); const float s = red_fq(fq < 2 ? (a[0] + a[1]) + (a[2] + a[3]) : 0.f); return 1.0f / sqrtf(s * (1.0f / 384.0f) + RMS_EPS); }
        { const float s = red_fq(p[(size_t)row * 4 + fq]); return 1.0f / sqrtf(s * (1.0f / 256.0f) + RMS_EPS); }
    }
    __device__ __forceinline__ void get8(float (&rsv)[2][4], int row0, int fq) const {
#pragma unroll
        for (int ai = 0; ai < 2; ++ai)
#pragma unroll
            for (int m = 0; m < 4; ++m) rsv[ai][m] = get(row0 + ai * 128 + m * 16, fq);
        asm volatile("" ::: "memory");
    }
};

struct EpiScale {
    static constexpr bool PERM = true, AFTER_DRAIN = false;
    bf16_t* O; int ldc; RowScale rs; float cs;
    __device__ __forceinline__ void operator()(const f32x4 (&acc)[2][2][4][2], const Unit& u, int wr, int wc, int fr_, int fq_) const {
        const int ln_ = lane_id(), fr = ln_ & 15, fq = ln_ >> 4; (void)fr_; (void)fq_;
        const int row0 = u.pm * BM + wr * 64 + fr, col0 = u.pn * BM + wc * 32 + 8 * fq;
        float rsv[2][4]; rs.get8(rsv, row0, fq);
#pragma unroll
        for (int ai = 0; ai < 2; ++ai)
#pragma unroll
            for (int m = 0; m < 4; ++m) { const int row = row0 + ai * HALF + m * 16; const float s = rsv[ai][m] * cs; bf16_t* rowp = O + (size_t)row * ldc + col0;
#pragma unroll
                for (int bj = 0; bj < 2; ++bj) *(u32x4*)(rowp + bj * HALF) = pack8(acc[ai][bj][m][0] * s, acc[ai][bj][m][1] * s); }
    }
};
__device__ __forceinline__ void rope8(f32x4& v0, f32x4& v1, const float* cs_row, int fq) {
    f32x4 p0, p1;
#pragma unroll
    for (int j = 0; j < 4; ++j) { p0[j] = xor32(v0[j], fq >> 1); p1[j] = xor32(v1[j], fq >> 1); }
    const int f0 = 8 * (fq & 1);
    const f32x4 c0 = *(const f32x4*)(cs_row + f0), c1 = *(const f32x4*)(cs_row + f0 + 4), s0 = *(const f32x4*)(cs_row + 16 + f0), s1 = *(const f32x4*)(cs_row + 16 + f0 + 4);
    if (fq < 2) { v0 = v0 * c0 - p0 * s0; v1 = v1 * c1 - p1 * s1; } else { v0 = v0 * c0 + p0 * s0; v1 = v1 * c1 + p1 * s1; }
}
struct EpiAin {
    static constexpr bool PERM = true, AFTER_DRAIN = false;
    bf16_t* AQ; bf16_t* AKV; float* KPE; float* SSQQ; float* SSQKV; RowScale rs; const float* gk; const float* CS; float* SSPE;
    __device__ __forceinline__ void operator()(const f32x4 (&acc)[2][2][4][2], const Unit& u, int wr, int wc, int fr_, int fq_) const {
        const int ln_ = lane_id(), fr = ln_ & 15, fq = ln_ >> 4; (void)fr_; (void)fq_;
        const int row0 = u.pm * BM + wr * 64 + fr, c8 = wc * 32 + 8 * fq;
        float rsv[2][4]; rs.get8(rsv, row0, fq);
#pragma unroll
        for (int ai = 0; ai < 2; ++ai)
#pragma unroll
            for (int m = 0; m < 4; ++m) { const int row = row0 + ai * HALF + m * 16; const float s = rsv[ai][m];
                const f32x4 a0 = acc[ai][0][m][0] * s, a1 = acc[ai][0][m][1] * s, b0 = acc[ai][1][m][0] * s, b1 = acc[ai][1][m][1] * s;
                if (u.pn == 0) {
                    *(u32x4*)(AQ + (size_t)row * 384 + c8) = pack8(a0, a1); *(u32x4*)(AQ + (size_t)row * 384 + 128 + c8) = pack8(b0, b1);
                    const float q = red_fq(sumsq8(a0, a1) + sumsq8(b0, b1)); if (fq == 0) SSQQ[(size_t)row * 8 + wc] = q;
                } else if (u.pn == 1) {
                    *(u32x4*)(AQ + (size_t)row * 384 + 256 + c8) = pack8(a0, a1);
                    const float q = red_fq(sumsq8(a0, a1)); if (fq == 0) SSQQ[(size_t)row * 8 + 4 + wc] = q;
                    if (wc == 0) { const float qp = red_fq(sumsq8(b0, b1)); if (fq == 0) SSPE[row] = qp;
                        f32x4 y0 = b0 * *(const f32x4*)(gk + 64 + 8 * fq), y1 = b1 * *(const f32x4*)(gk + 64 + 8 * fq + 4); rope8(y0, y1, CS + (size_t)row * 32, fq);
                        *(f32x4*)(KPE + (size_t)row * 32 + 8 * fq) = y0; *(f32x4*)(KPE + (size_t)row * 32 + 8 * fq + 4) = y1; }
                } else {
                    *(u32x4*)(AKV + (size_t)row * 256 + c8) = pack8(a0, a1); *(u32x4*)(AKV + (size_t)row * 256 + 128 + c8) = pack8(b0, b1);
                    const float q = red_fq(sumsq8(a0, a1) + sumsq8(b0, b1)); if (fq == 0) SSQKV[(size_t)row * 4 + wc] = q;
                } }
    }
};
struct EpiSwiglu {
    static constexpr bool PERM = true, AFTER_DRAIN = false;
    bf16_t* HID; RowScale rs; int abl; int f8; float cs;
    __device__ __forceinline__ void operator()(const f32x4 (&acc)[2][2][4][2], const Unit& u, int wr, int wc, int fr_, int fq_) const {
        if (abl == 1) return;
        const int ln_ = lane_id(), fr = ln_ & 15, fq = ln_ >> 4; (void)fr_; (void)fq_;
        const int row0 = u.pm * BM + wr * 64 + fr, col0 = u.pn * 128 + wc * 32 + 8 * fq;
        float rsv[2][4]; rs.get8(rsv, row0, fq);
#pragma unroll
        for (int ai = 0; ai < 2; ++ai)
#pragma unroll
            for (int m = 0; m < 4; ++m) { const int row = row0 + ai * HALF + m * 16; const float s = rsv[ai][m] * cs;
                f32x4 o[2];
#pragma unroll
                for (int n = 0; n < 2; ++n) {
                    const f32x4 gu = acc[ai][0][m][n] * acc[ai][1][m][n];
                    if (abl == 2) o[n] = gu * (s * s); else o[n] = gu * (sigmoid4(acc[ai][0][m][n], -s * LOG2E) * (s * s)); }
                if (f8) *(u32x2*)((unsigned char*)HID + (size_t)row * 2816 + col0) = pack8_fp8(o[0], o[1]);
                else *(u32x4*)(HID + (size_t)row * 2816 + col0) = pack8(o[0], o[1]); }
    }
};
template <bool GATED> struct EpiRes {
    static constexpr bool PERM = true, AFTER_DRAIN = false;
    const bf16_t* HBi; bf16_t* HBo; float* SSQo; const bf16_t* U; RowScale rs; float* OUTF; float ascale;
    __device__ __forceinline__ void operator()(const f32x4 (&acc)[2][2][4][2], const Unit& u, int wr, int wc, int fr_, int fq_) const {
        const int ln_ = lane_id(), fr = ln_ & 15, fq = ln_ >> 4; (void)fr_; (void)fq_;
        const int row0 = u.pm * BM + wr * 64 + fr, col0 = u.pn * BM + wc * 32 + 8 * fq;
        float rsv[2][4]; if (GATED) rs.get8(rsv, row0, fq);
        u32x4 hq[3][2], uq[3][2];
#define EPIRES_LOAD(it_, b_) do { const size_t off_ = (size_t)(row0 + ((it_) >> 2) * HALF + ((it_) & 3) * 16) * DMODEL + col0; \
            hq[b_][0] = *(const u32x4*)(HBi + off_); hq[b_][1] = *(const u32x4*)(HBi + off_ + HALF); \
            if (GATED) { uq[b_][0] = *(const u32x4*)(U + off_); uq[b_][1] = *(const u32x4*)(U + off_ + HALF); } } while (0)
        EPIRES_LOAD(0, 0); EPIRES_LOAD(1, 1);
#pragma unroll
        for (int it = 0; it < 8; ++it) { const int ai = it >> 2, m = it & 3, cb = it % 3; const int row = row0 + ai * HALF + m * 16; const size_t off = (size_t)row * DMODEL + col0;
                if (it + 2 < 8) EPIRES_LOAD(it + 2, (it + 2) % 3);
                float s = 1.0f; if (GATED) s = rsv[ai][m];
                float q = 0.f;
#pragma unroll
                for (int bj = 0; bj < 2; ++bj) { f32x4 a0 = acc[ai][bj][m][0] * ascale, a1 = acc[ai][bj][m][1] * ascale;
                    f32x4 h0, h1; unpack8(hq[cb][bj], h0, h1);
                    if (GATED) { f32x4 u0, u1; unpack8(uq[cb][bj], u0, u1);
                        a0 = sigmoid4(a0, -s * LOG2E) * u0; a1 = sigmoid4(a1, -s * LOG2E) * u1; }
                    h0 += a0; h1 += a1;
                    if (GATED) { if (OUTF) { *(f32x4*)(OUTF + off + bj * HALF) = h0; *(f32x4*)(OUTF + off + bj * HALF + 4) = h1; } }
                    *(u32x4*)(HBo + off + bj * HALF) = pack8(h0, h1);
                    q += sumsq8(h0, h1); }
                q = red_fq(q); if (fq == 0) SSQo[(size_t)row * 16 + u.pn * 4 + wc] = q;
                asm volatile("" ::: "memory"); }
#undef EPIRES_LOAD
    }
};
struct EpiKvs {
    static constexpr bool PERM = true, AFTER_DRAIN = false;
    bf16_t* KT; bf16_t* VT; RowScale rs;
    __device__ __forceinline__ void operator()(const f32x4 (&acc)[2][2][4][2], const Unit& u, int wr, int wc, int fr_, int fq_) const {
        const int ln_ = lane_id(), fr = ln_ & 15, fq = ln_ >> 4; (void)fr_; (void)fq_;
        const int row0 = u.pm * BM + wr * 64 + fr;
        float rsv[2][4]; rs.get8(rsv, row0, fq);
#pragma unroll
        for (int ai = 0; ai < 2; ++ai)
#pragma unroll
            for (int m = 0; m < 4; ++m) { const int row = row0 + ai * HALF + m * 16; const float s = rsv[ai][m];
                const int b = row >> 13, sq = row & 8191, tile = sq >> 6, rr = sq & 63;
#pragma unroll
                for (int bj = 0; bj < 2; ++bj) { const int c = bj * HALF + wc * 32 + 8 * fq, kh = c >> 6, d = c & 63;
                    const size_t tb = (size_t)((b * 4 + kh) * 128 + tile) * 4096;
                    const u32x4 w = pack8(acc[ai][bj][m][0] * s, acc[ai][bj][m][1] * s);
                    if (u.pn == 0) *(u32x4*)(KT + tb + (d >> 3) * 512 + rr * 8) = w;
                    else *(u32x4*)(VT + tb + (d >> 5) * 2048 + rr * 32 + (d & 31)) = w; } }
    }
};

#define PG8_LAS LAS
template <class Epi, class Sched, bool ALIGN_EPI = false, bool SP2 = false, bool MX8 = false, bool SADDR = MX8>
__device__ __forceinline__ void gemm_phase(PG8_LAS unsigned char* lds, const Gemm g, const Sched& S, const Epi& E, int wv  ) {
    int tid_ = wv * 64 + lane_id(); asm volatile("" : "+v"(tid_));
    const int tid = tid_, wid = __builtin_amdgcn_readfirstlane(tid >> 6), lane = tid & 63, wr = wid >> 2, wc = wid & 3, fr = lane & 15, fq = lane >> 4;
    const int K = g.K, nt = K / BK;
    unsigned voffA[2], voffB[2];
#pragma unroll
    for (int i = 0; i < 2; ++i) { int R, C; stage_rc(tid * 16 + i * 8192, R, C); const int Rb = Epi::PERM ? ((R & ~31) + perm32(R & 31)) : R;
        voffA[i] = (unsigned)(R * K + C) * 2u; voffB[i] = (unsigned)(Rb * K + C) * 2u; }
    const size_t kstep = (size_t)(BK * 2);
    const size_t hstep = (size_t)HALF * K * 2;
    const size_t tstep = 2 * hstep;
    const unsigned ldsw = (unsigned)wid * 1024u; const unsigned lds0_ = (unsigned)(uintptr_t)lds; (void)lds0_;
    const int aoff = lds_byte(wr * 64 + fr, fq * 8), boff = lds_byte(wc * 32 + fr, fq * 8);
#define PG8_SA(b, h) (((b) * 2 + (h)) * HTB)
#define PG8_SB(b, h) ((4 + (b) * 2 + (h)) * HTB)
#define PG8_STAGE(bufoff, gbase, voff) do { _Pragma("unroll") for (int _i = 0; _i < 2; ++_i) { \
        if constexpr (SADDR) { unsigned keep_; const unsigned dst_ = (unsigned)__builtin_amdgcn_readfirstlane((int)(lds0_ + (unsigned)(bufoff) + ldsw + _i * 8192)); \
            asm volatile("s_mov_b32 %0, m0\n\ts_mov_b32 m0, %3\n\ts_nop 0\n\tglobal_load_lds_dwordx4 %1, %2\n\ts_mov_b32 m0, %0" : "=&s"(keep_) : "v"((voff)[_i]), "s"((const char*)(gbase)), "s"(dst_) : "memory"); } \
        else __builtin_amdgcn_global_load_lds((const unsigned*)((const char*)(gbase) + (voff)[_i]), (PG8_LAS unsigned*)(lds + (bufoff) + ldsw + _i * 8192), 16, 0, 0); } } while (0)
#define PG8_LDA(dst, b, h) do { _Pragma("unroll") for (int m = 0; m < 4; ++m) _Pragma("unroll") for (int k = 0; k < 2; ++k) dst[m][k] = *(const PG8_LAS bf16x8*)(lds + PG8_SA(b, h) + aoff + m * 2048 + k * 1024); } while (0)
#define PG8_LDB(dst, b, h) do { _Pragma("unroll") for (int n = 0; n < 2; ++n) _Pragma("unroll") for (int k = 0; k < 2; ++k) dst[n][k] = *(const PG8_LAS bf16x8*)(lds + PG8_SB(b, h) + boff + n * 2048 + k * 1024); } while (0)
#define PG8_MMA(ai, bj, At, Bt) do { __builtin_amdgcn_s_setprio(1); _Pragma("unroll") for (int m = 0; m < 4; ++m) _Pragma("unroll") for (int n = 0; n < 2; ++n) { \
        if constexpr (MX8) { typedef int i32x8_ __attribute__((ext_vector_type(8))); typedef int i32x4_ __attribute__((ext_vector_type(4))); \
            const i32x4_ b0_ = __builtin_bit_cast(i32x4_, Bt[n][0]), b1_ = __builtin_bit_cast(i32x4_, Bt[n][1]), a0_ = __builtin_bit_cast(i32x4_, At[m][0]), a1_ = __builtin_bit_cast(i32x4_, At[m][1]); \
            const i32x8_ bb_ = __builtin_shufflevector(b0_, b1_, 0, 1, 2, 3, 4, 5, 6, 7), aa_ = __builtin_shufflevector(a0_, a1_, 0, 1, 2, 3, 4, 5, 6, 7); \
            acc[ai][bj][m][n] = __builtin_amdgcn_mfma_scale_f32_16x16x128_f8f6f4(bb_, aa_, acc[ai][bj][m][n], 0, 0, 0, 0x7F7F7F7F, 0, 0x7F7F7F7F); } \
        else { _Pragma("unroll") for (int k = 0; k < 2; ++k) acc[ai][bj][m][n] = __builtin_amdgcn_mfma_f32_16x16x32_bf16(Bt[n][k], At[m][k], acc[ai][bj][m][n], 0, 0, 0); } } \
        __builtin_amdgcn_s_setprio(0); } while (0)
#define PG8_WAIT_V(n) asm volatile("s_waitcnt vmcnt(" #n ")" ::: "memory")
#define PG8_WAIT_L(n) asm volatile("s_waitcnt lgkmcnt(" #n ")" ::: "memory")
#define PG8_BAR __builtin_amdgcn_s_barrier()
#define PG8_SCHED __builtin_amdgcn_sched_barrier(0)
    Unit cur, nxt; int ui = 0;
    if (!S.next(0, cur)) return;
    f32x4 acc[2][2][4][2];
#pragma unroll
    for (int a = 0; a < 2; ++a)
#pragma unroll
        for (int b = 0; b < 2; ++b)
#pragma unroll
            for (int m = 0; m < 4; ++m)
#pragma unroll
                for (int n = 0; n < 2; ++n) acc[a][b][m][n] = (f32x4){0.f, 0.f, 0.f, 0.f};
    bf16x8 At[4][2], B0[2][2], B1[2][2];
    const char* cA = (const char*)g.A + (size_t)cur.pm * tstep; const char* cB = (const char*)g.Bt + cur.boff + (size_t)cur.pn * tstep;
    if constexpr (SP2) {
        PG8_STAGE(PG8_SB(0, 0), cB, voffB); PG8_STAGE(PG8_SB(0, 1), cB + hstep, voffB); PG8_STAGE(PG8_SA(0, 0), cA, voffA); PG8_STAGE(PG8_SA(0, 1), cA + hstep, voffA);
        if (wr == 1) PG8_BAR;
        PG8_WAIT_V(2); PG8_BAR;
        PG8_STAGE(PG8_SB(1, 0), cB + kstep, voffB); PG8_STAGE(PG8_SA(1, 0), cA + kstep, voffA); PG8_STAGE(PG8_SB(1, 1), cB + hstep + kstep, voffB);
        PG8_WAIT_V(6); PG8_BAR;
    } else {
        PG8_STAGE(PG8_SB(0, 0), cB, voffB); PG8_STAGE(PG8_SA(0, 0), cA, voffA); PG8_STAGE(PG8_SB(0, 1), cB + hstep, voffB); PG8_STAGE(PG8_SA(0, 1), cA + hstep, voffA);
        if (wr == 1) PG8_BAR;
        PG8_WAIT_V(4); PG8_BAR;
        PG8_STAGE(PG8_SB(1, 0), cB + kstep, voffB); PG8_STAGE(PG8_SA(1, 0), cA + kstep, voffA); PG8_STAGE(PG8_SB(1, 1), cB + hstep + kstep, voffB);
        PG8_WAIT_V(6); PG8_BAR;
    }
    for (;;) {
        const bool has_next = S.next(ui + 1, nxt);
        const char* nA = has_next ? (const char*)g.A + (size_t)nxt.pm * tstep : cA; const char* nB = has_next ? (const char*)g.Bt + nxt.boff + (size_t)nxt.pn * tstep : cB;
        for (int t = 0; t < nt; t += 2) {
            const bool last = (t == nt - 2);
            const char* a1 = cA + (size_t)(t + 1) * kstep;
            const char* a2 = last ? nA : cA + (size_t)(t + 2) * kstep; const char* b2 = last ? nB : cB + (size_t)(t + 2) * kstep;
            const char* a3 = a2 + kstep; const char* b3 = b2 + kstep;
            if constexpr (SP2) {
            PG8_LDB(B0, 0, 0); PG8_LDB(B1, 0, 1); PG8_SCHED; PG8_LDA(At, 0, 0); PG8_STAGE(PG8_SA(1, 1), a1 + hstep, voffA);
            PG8_WAIT_V(8); PG8_WAIT_L(0); PG8_BAR; PG8_MMA(0, 0, At, B0); PG8_MMA(0, 1, At, B1); PG8_BAR; PG8_SCHED;
            PG8_LDA(At, 0, 1); PG8_STAGE(PG8_SB(0, 0), b2, voffB); PG8_STAGE(PG8_SB(0, 1), b2 + hstep, voffB); PG8_STAGE(PG8_SA(0, 0), a2, voffA);
            PG8_WAIT_V(8); PG8_WAIT_L(0); PG8_BAR; PG8_MMA(1, 0, At, B0); PG8_MMA(1, 1, At, B1); PG8_BAR; PG8_SCHED;
            PG8_LDB(B0, 1, 0); PG8_LDB(B1, 1, 1); PG8_SCHED; PG8_LDA(At, 1, 0); PG8_STAGE(PG8_SA(0, 1), a2 + hstep, voffA);
            PG8_WAIT_V(8); PG8_WAIT_L(0); PG8_BAR; PG8_MMA(0, 0, At, B0); PG8_MMA(0, 1, At, B1); PG8_BAR; PG8_SCHED;
            PG8_LDA(At, 1, 1); PG8_STAGE(PG8_SB(1, 0), b3, voffB); PG8_STAGE(PG8_SB(1, 1), b3 + hstep, voffB); PG8_STAGE(PG8_SA(1, 0), a3, voffA);
            PG8_WAIT_V(8); PG8_WAIT_L(0); PG8_BAR; PG8_MMA(1, 0, At, B0); PG8_MMA(1, 1, At, B1); PG8_BAR; PG8_SCHED;
            } else {
            PG8_LDB(B0, 0, 0); PG8_SCHED; PG8_LDA(At, 0, 0); PG8_STAGE(PG8_SA(1, 1), a1 + hstep, voffA);
            PG8_WAIT_L(8); PG8_BAR; PG8_WAIT_L(0); PG8_MMA(0, 0, At, B0); PG8_BAR; PG8_SCHED;
            PG8_LDB(B1, 0, 1); PG8_STAGE(PG8_SB(0, 0), b2, voffB);
            PG8_BAR; PG8_WAIT_L(0); PG8_MMA(0, 1, At, B1); PG8_BAR;
            PG8_LDA(At, 0, 1); PG8_STAGE(PG8_SA(0, 0), a2, voffA);
            PG8_BAR; PG8_WAIT_L(0); PG8_MMA(1, 0, At, B0); PG8_BAR; PG8_SCHED;
            PG8_STAGE(PG8_SB(0, 1), b2 + hstep, voffB);
            PG8_WAIT_V(6); PG8_BAR; PG8_MMA(1, 1, At, B1); PG8_BAR;
            PG8_LDB(B0, 1, 0); PG8_SCHED; PG8_LDA(At, 1, 0); PG8_STAGE(PG8_SA(0, 1), a2 + hstep, voffA);
            PG8_WAIT_L(8); PG8_BAR; PG8_WAIT_L(0); PG8_MMA(0, 0, At, B0); PG8_BAR; PG8_SCHED;
            PG8_LDB(B1, 1, 1); PG8_STAGE(PG8_SB(1, 0), b3, voffB);
            PG8_BAR; PG8_WAIT_L(0); PG8_MMA(0, 1, At, B1); PG8_BAR;
            PG8_LDA(At, 1, 1); PG8_STAGE(PG8_SA(1, 0), a3, voffA);
            PG8_BAR; PG8_WAIT_L(0); PG8_MMA(1, 0, At, B0); PG8_BAR; PG8_SCHED;
            PG8_STAGE(PG8_SB(1, 1), b3 + hstep, voffB);
            PG8_WAIT_V(6); PG8_BAR; PG8_MMA(1, 1, At, B1); PG8_BAR;
            }
        }
        if constexpr (ALIGN_EPI) { if (wr == 0) PG8_BAR; }
        E(acc, cur, wr, wc, fr, fq);
        if (!has_next) break;
#pragma unroll
        for (int a = 0; a < 2; ++a)
#pragma unroll
            for (int b = 0; b < 2; ++b)
#pragma unroll
                for (int m = 0; m < 4; ++m)
#pragma unroll
                    for (int n = 0; n < 2; ++n) acc[a][b][m][n] = (f32x4){0.f, 0.f, 0.f, 0.f};
        cur = nxt; cA = nA; cB = nB; ++ui;
        if constexpr (ALIGN_EPI) { if (wr == 1) PG8_BAR; }
    }
    PG8_WAIT_V(0);
    if constexpr (!ALIGN_EPI) { if (wr == 0) PG8_BAR; }
    PG8_BAR;
#undef PG8_SA
#undef PG8_SB
#undef PG8_STAGE
#undef PG8_LDA
#undef PG8_LDB
#undef PG8_MMA
#undef PG8_WAIT_V
#undef PG8_WAIT_L
#undef PG8_BAR
#undef PG8_SCHED
}
}
typedef GAS unsigned gu32;
#define RLX_AGENT __ATOMIC_RELAXED, __HIP_MEMORY_SCOPE_AGENT
#define XB_TMO      128
#define XB_XCNT(j)  (256  + 64 * (j))
#define XB_XSUB(j)  (1280 + 64 * (j))
#define XB_XGEN(j)  (2304 + 64 * (j))
#define XB_TOP      3328
#define XB_TOPGEN   3392
#define XCD_BAR_WORDS 3456
#define XB_SPIN_CAP (1u << 18)

__device__ __forceinline__ unsigned xb_ld(unsigned* p)              { return __hip_atomic_load(p, __ATOMIC_RELAXED, __HIP_MEMORY_SCOPE_AGENT); }
__device__ __forceinline__ unsigned xb_add(unsigned* p, unsigned v) { return __hip_atomic_fetch_add(p, v, __ATOMIC_RELAXED, __HIP_MEMORY_SCOPE_AGENT); }
__device__ __forceinline__ unsigned xb_xcc_id() { return (unsigned)__builtin_amdgcn_s_getreg((3 << 11) | 20) & 0xFu; }
#define XB_SPIN(cond, bar) do { unsigned _sp = 0; while (cond) { __builtin_amdgcn_s_sleep(1); \
    if ((++_sp & 255u) == 0u) { if (xb_ld(&(bar)[XB_TMO])) break; if (_sp > XB_SPIN_CAP) { atomicAdd(&(bar)[XB_TMO], 1u); break; } } } } while (0)

struct XcdBarrier {
    unsigned* bar; unsigned x; int wv;
    volatile LAS unsigned* st;
};
__device__ __forceinline__ XcdBarrier xcd_barrier_post(unsigned* bar, volatile LAS unsigned* st, int wv) {
    XcdBarrier b; b.bar = bar; b.x = xb_xcc_id(); b.st = st; b.wv = wv;
    if (wv == 0 && lane_id() == 0) (void)xb_add(&bar[XB_XCNT(b.x)], 1u);
    return b;
}
__device__ __forceinline__ void xcd_barrier_complete(unsigned* bar, unsigned x, unsigned& nloc, unsigned& nx) {
    const unsigned G = gridDim.x * gridDim.y * gridDim.z;
    unsigned sum, cnt, mine, sp = 0u;
    for (;;) {
        sum = 0u; cnt = 0u; mine = 0u;
#pragma unroll
        for (unsigned j = 0; j < 16; ++j) { const unsigned c = xb_ld(&bar[XB_XCNT(j)]); sum += c; cnt += (c > 0u) ? 1u : 0u; mine = (j == x) ? c : mine; }
        if (sum == G) break;
        __builtin_amdgcn_s_sleep(1);
        if ((++sp & 255u) == 0u) { if (xb_ld(&bar[XB_TMO])) break; if (sp > XB_SPIN_CAP) { atomicAdd(&bar[XB_TMO], 1u); break; } }
    }
    nloc = mine > 0u ? mine : 1u; nx = cnt > 0u ? cnt : 1u;
}
__device__ __forceinline__ void xcd_barrier(const XcdBarrier& b) {
    asm volatile("s_waitcnt vmcnt(0)" ::: "memory");
    __syncthreads();
    if (b.wv == 0 && lane_id() == 0) {
        unsigned* bar = b.bar;
        __builtin_amdgcn_s_waitcnt(0);
        unsigned nloc = b.st[0], nx = b.st[1];
        if (nloc == 0u) { xcd_barrier_complete(bar, b.x, nloc, nx); b.st[0] = nloc; b.st[1] = nx; }
        const unsigned old = xb_add(&bar[XB_XSUB(b.x)], 1u);
        const unsigned gen = old / nloc;
        if (old + 1u == (gen + 1u) * nloc) {
            __builtin_amdgcn_fence(__ATOMIC_RELEASE, "agent");
            asm volatile("s_waitcnt vmcnt(0)" ::: "memory");
            const unsigned og = xb_add(&bar[XB_TOP], 1u);
            const unsigned tg = og / nx;
            if (og + 1u == (tg + 1u) * nx) xb_add(&bar[XB_TOPGEN], 1u);
            else XB_SPIN(xb_ld(&bar[XB_TOPGEN]) == tg, bar);
            __builtin_amdgcn_fence(__ATOMIC_ACQUIRE, "agent");
            xb_add(&bar[XB_XGEN(b.x)], 1u);
            asm volatile("s_waitcnt vmcnt(0)" ::: "memory");
        } else {
            XB_SPIN(xb_ld(&bar[XB_XGEN(b.x)]) == gen, bar);
            __builtin_amdgcn_fence(__ATOMIC_ACQUIRE, "agent");
            asm volatile("s_waitcnt vmcnt(0)" ::: "memory");
        }
    }
    __syncthreads();
}

#define XB_LSUB(j)  (3456 + 64 * (j))
#define XB_LGEN(j)  (3456 + 1024 + 64 * (j))
#define XB_CHK      (3456 + 2048)
#define XCD_BAR_WORDS_EXT (3456 + 2048 + 256)
__device__ __forceinline__ void xcd_local_barrier(const XcdBarrier& b) {
    asm volatile("s_waitcnt vmcnt(0)" ::: "memory");
    __syncthreads();
    if (b.wv == 0 && lane_id() == 0) {
        unsigned* bar = b.bar;
        __builtin_amdgcn_s_waitcnt(0);
        const unsigned nloc = b.st[0];
        const unsigned old = xb_add(&bar[XB_LSUB(b.x)], 1u);
        const unsigned gen = old / nloc;
        if (old + 1u == (gen + 1u) * nloc) xb_add(&bar[XB_LGEN(b.x)], 1u);
        else XB_SPIN(xb_ld(&bar[XB_LGEN(b.x)]) == gen, bar);
        __builtin_amdgcn_fence(__ATOMIC_ACQUIRE, "agent");
        asm volatile("s_waitcnt vmcnt(0)" ::: "memory");
    }
    __syncthreads();
}

namespace att {
__device__ __forceinline__ int crow(int r, int hi) { return (r & 3) + 8 * (r >> 2) + 4 * hi; }
__device__ __forceinline__ void glds16(const void* gsrc, unsigned lds_dst) { unsigned keep;
    asm volatile("s_mov_b32 %0, m0\n\ts_mov_b32 m0, %2\n\ts_nop 0\n\tglobal_load_lds_dwordx4 %1, off\n\ts_mov_b32 m0, %0" : "=&s"(keep) : "v"(gsrc), "s"(lds_dst) : "memory"); }
#define ATT_WAIT_BAR(N) asm volatile("s_waitcnt vmcnt(" #N ") lgkmcnt(0)\n\ts_barrier" ::: "memory")
#define ATT_MX3(a, b, c) __builtin_fmaxf(__builtin_fmaxf((a), (b)), (c))
typedef LAS const unsigned char* lcp;
typedef short v4i16_t __attribute__((ext_vector_type(4)));
__device__ __forceinline__ s16x4 vtr(lcp p) { return __builtin_bit_cast(s16x4, __builtin_amdgcn_ds_read_tr16_b64_v4i16((LAS v4i16_t*)p)); }
__device__ __forceinline__ float rowmax(const f32x16& p0, const f32x16& p1) {
    float a = ATT_MX3(p0[0], p0[1], p1[0]), b = ATT_MX3(p0[2], p0[3], p1[1]); a = ATT_MX3(a, p1[2], p1[3]);
#pragma unroll
    for (int r = 4; r < 16; r += 4) { a = ATT_MX3(a, p0[r], p0[r + 1]); b = ATT_MX3(b, p0[r + 2], p0[r + 3]); a = ATT_MX3(a, p1[r], p1[r + 1]); b = ATT_MX3(b, p1[r + 2], p1[r + 3]); }
    float m = __builtin_fmaxf(a, b); auto rr = __builtin_amdgcn_permlane32_swap(__float_as_uint(m), __float_as_uint(m), false, false);
    return __builtin_fmaxf(__uint_as_float(rr[0]), __uint_as_float(rr[1])); }
template <bool FAKEV = false> __device__ __forceinline__ void pv(f32x16* o, lcp vp, const u32x4 pw0, const u32x4 pw1, const u32x4 pw2, const u32x4 pw3) {
#pragma unroll
    for (int ks = 0; ks < 4; ++ks) {
        const u32x4 pw = ks == 0 ? pw0 : ks == 1 ? pw1 : ks == 2 ? pw2 : pw3;
#pragma unroll
        for (int d0 = 0; d0 < 2; ++d0) {
            bf16x8 vf;
            if (FAKEV) vf = __builtin_bit_cast(bf16x8, ks & 1 ? pw0 : pw2);
            else { const s16x4 lo = vtr(vp + d0 * 4096 + ks * 1024), hi = vtr(vp + d0 * 4096 + ks * 1024 + 512); vf = (bf16x8){lo[0], lo[1], lo[2], lo[3], hi[0], hi[1], hi[2], hi[3]}; }
            o[d0] = __builtin_amdgcn_mfma_f32_32x32x16_bf16(__builtin_bit_cast(bf16x8, pw), vf, o[d0], 0, 0, 0);
        }
    }
}
__device__ __forceinline__ void store_o(const f32x16* o, const float* rsc  , LAS unsigned char* stage, bf16_t* Ow, int pitch, int lane, int r32, int hi) {
    LAS bf16_t* stg = (LAS bf16_t*)stage;
#pragma unroll
    for (int r = 0; r < 16; ++r) { const int orow = crow(r, hi);
#pragma unroll
        for (int d0 = 0; d0 < 2; ++d0) stg[orow * 64 + d0 * 32 + r32] = (bf16_t)(pk_bf16(o[d0][r] * rsc[r], 0.f) & 0xffffu); }
    asm volatile("s_waitcnt lgkmcnt(0)" ::: "memory");
#pragma unroll
    for (int i = 0; i < 4; ++i) { const int row = i * 8 + (lane >> 3), ch = lane & 7; const u32x4 v = *(const LAS u32x4*)(stg + row * 64 + ch * 8); *(u32x4*)(Ow + (size_t)row * pitch + ch * 8) = v; }
}

namespace mla {
constexpr int KSLOT = 12288, VSLOT = 8192, NS = 4;
constexpr int L_K = 0, L_V = NS * KSLOT, L_WS = L_V + NS * VSLOT, L_OST = L_WS + 2048, L_END = L_OST + 8 * 4096;
#define MLA_BAR_L() asm volatile("s_waitcnt lgkmcnt(0)\n\ts_barrier" ::: "memory")
template <int ABL> __device__ __forceinline__ void unit(int b, int h, int qb, const bf16_t* Q, const bf16_t* KT, const bf16_t* VT, bf16_t* O, LAS unsigned char* shm, int wv) {
    int tid_ = wv * 64 + lane_id(); asm volatile("" : "+v"(tid_));
    const int tid = tid_, lane = tid & 63, r32 = lane & 31, hi = lane >> 5; const int wid = __builtin_amdgcn_readfirstlane(tid >> 6);
    const int grp = wid >> 2;
    const long rowbase = (long)b * SEQL; const int q0 = qb * 256;
    const bf16_t* Qw = Q + (size_t)(rowbase + q0 + wid * 32) * 768 + h * 96;
    const bf16_t* Kh = KT + (size_t)((b * 8 + h) * 128) * 6144 + lane * 8;
    const bf16_t* Vh = VT + (size_t)((b * 8 + h) * 128) * 4096 + lane * 8;
    const unsigned lds0 = (unsigned)(uintptr_t)shm;
    LAS float* wsf = (LAS float*)(shm + L_WS) + wid * 64;
    const int NT = (q0 + 256) / 64;
    const int kc2 = 8 + (wid & 3);
    bf16x8 qr[6];
#pragma unroll
    for (int d0 = 0; d0 < 6; ++d0) qr[d0] = *(const bf16x8*)(Qw + (size_t)r32 * 768 + d0 * 16 + hi * 8);
#define MLA_DMA_K(t, sl) do { const bf16_t* kt_ = Kh + (size_t)(t) * 6144; \
        glds16(kt_ + wid * 512, (unsigned)__builtin_amdgcn_readfirstlane(lds0 + L_K + (sl) * KSLOT + wid * 1024)); \
        glds16(kt_ + kc2 * 512, (unsigned)__builtin_amdgcn_readfirstlane(lds0 + L_K + (sl) * KSLOT + kc2 * 1024)); } while (0)
#define MLA_DMA_V(t, sl) glds16(Vh + (size_t)(t) * 4096 + wid * 512, (unsigned)__builtin_amdgcn_readfirstlane(lds0 + L_V + (sl) * VSLOT + wid * 1024))
#define MLA_GROUP(g) do { if ((g) + 4 < NT) MLA_DMA_K((g) + 4, (g) & 3); if ((g) + 3 < NT) MLA_DMA_V((g) + 3, ((g) + 3) & 3); } while (0)
#define MLA_LOADK(sl) do { const lcp kb_ = (lcp)shm + L_K + (sl) * KSLOT + hi * 1024 + r32 * 16; _Pragma("unroll") for (int d0 = 0; d0 < 6; ++d0) { kf[2 * d0] = *(const LAS bf16x8*)(kb_ + d0 * 2048); kf[2 * d0 + 1] = *(const LAS bf16x8*)(kb_ + d0 * 2048 + 512); } } while (0)
    MLA_DMA_K(0, 0); MLA_DMA_K(1, 1); MLA_DMA_V(0, 0); MLA_DMA_K(2, 2); MLA_DMA_V(1, 1); MLA_DMA_K(3, 3); MLA_DMA_V(2, 2);
    float m = 0.f; f32x16 o[2], negm; f32x2 lsA = {0.f, 0.f}, lsB = {0.f, 0.f};
#pragma unroll
    for (int r = 0; r < 16; ++r) { o[0][r] = 0.f; o[1][r] = 0.f; negm[r] = 0.f; }
    const int qrel = wid * 32 + r32;
    bf16x8 kf[12], vf[8]; u32x4 pw0 = {0u, 0u, 0u, 0u}, pw1 = pw0, pw2 = pw0, pw3 = pw0;
    ATT_WAIT_BAR(9);
    MLA_LOADK(0);
    if (grp == 1) ATT_WAIT_BAR(6);
    bool act_prev = false;
    for (int t = 0; t < NT; ++t) {
        const int s0 = t & 3, s1 = (t + 1) & 3;
        if (grp == 1) MLA_GROUP(t);
        const int jb = t - (NT - 4);
        const bool act = ABL != 5 && (jb <= 0 || 64 * jb <= wid * 32 + 31);
        f32x16 p0 = negm, p1 = negm;
        if (act) {
#pragma unroll
            for (int d0 = 0; d0 < 6; ++d0) { p0 = __builtin_amdgcn_mfma_f32_32x32x16_bf16(kf[2 * d0], qr[d0], p0, 0, 0, 0); p1 = __builtin_amdgcn_mfma_f32_32x32x16_bf16(kf[2 * d0 + 1], qr[d0], p1, 0, 0, 0); }
        }
        if (act_prev) {
#pragma unroll
            for (int ks = 0; ks < 4; ++ks) { const u32x4 pw = ks == 0 ? pw0 : ks == 1 ? pw1 : ks == 2 ? pw2 : pw3;
                o[0] = __builtin_amdgcn_mfma_f32_32x32x16_bf16(__builtin_bit_cast(bf16x8, pw), vf[ks], o[0], 0, 0, 0);
                o[1] = __builtin_amdgcn_mfma_f32_32x32x16_bf16(__builtin_bit_cast(bf16x8, pw), vf[4 + ks], o[1], 0, 0, 0);
 }
        }
        if (grp == 0) { if (t + 3 < NT) ATT_WAIT_BAR(6); else ATT_WAIT_BAR(0); MLA_GROUP(t); }
        else MLA_BAR_L();
        if (act && (ABL != 7 || t == 0)) {
            { const lcp vp = (lcp)shm + L_V + s0 * VSLOT + ((lane >> 4) & 1) * 32 + (lane & 3) * 8 + (4 * hi + ((lane & 15) >> 2)) * 64;
#pragma unroll
                for (int d0 = 0; d0 < 2; ++d0)
#pragma unroll
                    for (int ks = 0; ks < 4; ++ks) { const s16x4 lo = vtr(vp + d0 * 4096 + ks * 1024), hh = vtr(vp + d0 * 4096 + ks * 1024 + 512);
                        vf[d0 * 4 + ks] = (bf16x8){lo[0], lo[1], lo[2], lo[3], hh[0], hh[1], hh[2], hh[3]}; } }
        }
        if (t + 1 < NT && ABL != 6) MLA_LOADK(s1);
        if (act) {
            if (jb >= 0) {
#pragma unroll
                for (int r = 0; r < 16; ++r) { const int kv = 64 * jb + crow(r, hi); if (kv > qrel) p0[r] = -INFINITY; if (kv + 32 > qrel) p1[r] = -INFINITY; }
            }
            const float rm = rowmax(p0, p1);
            if (t == 0 || __any(rm > 8.0f)) {
                const float dl = t == 0 ? rm : __builtin_fmaxf(rm, 0.f); m += dl;
#pragma unroll
                for (int r = 0; r < 16; ++r) { p0[r] -= dl; p1[r] -= dl; negm[r] = -m; }
                const float alpha = fast_exp2(-dl); if (hi == 0) wsf[r32] = alpha;
#pragma unroll
                for (int r = 0; r < 16; ++r) { const float a = wsf[crow(r, hi)]; o[0][r] *= a; o[1][r] *= a; }
                lsA *= alpha; lsB *= alpha;
            }
#pragma unroll
            for (int r = 0; r < 16; ++r) { if (ABL != 1) { p0[r] = fast_exp2(p0[r]); p1[r] = fast_exp2(p1[r]); } }
#pragma unroll
            for (int r = 0; r < 16; r += 2) { lsA += (f32x2){p0[r], p0[r + 1]}; lsB += (f32x2){p1[r], p1[r + 1]}; }
            pw0 = (u32x4){pk_bf16(p0[0], p0[1]), pk_bf16(p0[2], p0[3]), pk_bf16(p0[4], p0[5]), pk_bf16(p0[6], p0[7])};
            pw1 = (u32x4){pk_bf16(p0[8], p0[9]), pk_bf16(p0[10], p0[11]), pk_bf16(p0[12], p0[13]), pk_bf16(p0[14], p0[15])};
            pw2 = (u32x4){pk_bf16(p1[0], p1[1]), pk_bf16(p1[2], p1[3]), pk_bf16(p1[4], p1[5]), pk_bf16(p1[6], p1[7])};
            pw3 = (u32x4){pk_bf16(p1[8], p1[9]), pk_bf16(p1[10], p1[11]), pk_bf16(p1[12], p1[13]), pk_bf16(p1[14], p1[15])};
        }
        act_prev = act;
        if (grp == 0) MLA_BAR_L();
        else { if (t + 4 < NT) ATT_WAIT_BAR(6); else ATT_WAIT_BAR(0); }
    }
#undef MLA_DMA_K
#undef MLA_DMA_V
#undef MLA_GROUP
#undef MLA_LOADK
    if (act_prev) {
#pragma unroll
        for (int ks = 0; ks < 4; ++ks) { const u32x4 pw = ks == 0 ? pw0 : ks == 1 ? pw1 : ks == 2 ? pw2 : pw3;
            o[0] = __builtin_amdgcn_mfma_f32_32x32x16_bf16(__builtin_bit_cast(bf16x8, pw), vf[ks], o[0], 0, 0, 0);
            o[1] = __builtin_amdgcn_mfma_f32_32x32x16_bf16(__builtin_bit_cast(bf16x8, pw), vf[4 + ks], o[1], 0, 0, 0);
 }
    }
    if (grp == 0) MLA_BAR_L();
    float rli[16];
    { float l = (lsA.x + lsA.y) + (lsB.x + lsB.y); auto rr = __builtin_amdgcn_permlane32_swap(__float_as_uint(l), __float_as_uint(l), false, false); l = __uint_as_float(rr[0]) + __uint_as_float(rr[1]);
      if (hi == 0) wsf[r32] = fast_rcp(l); }
#pragma unroll
    for (int r = 0; r < 16; ++r) rli[r] = wsf[crow(r, hi)];
    store_o(o, rli, shm + L_OST + wid * 4096, O + (size_t)(rowbase + q0 + wid * 32) * 512 + h * 64, 512, lane, r32, hi);
    MLA_BAR_L();
}
template <int ABL> __device__ __forceinline__ void phase(int vcu, int G, const bf16_t* Q, const bf16_t* KT, const bf16_t* VT, bf16_t* O, LAS unsigned char* shm, int wv) {
    for (int v = vcu; v < 256; v += G) { const int bh = v >> 4, s = v & 15;
        unit<ABL>(bh >> 3, bh & 7, 31 - s, Q, KT, VT, O, shm, wv);
        unit<ABL>(bh >> 3, bh & 7, s, Q, KT, VT, O, shm, wv); }
}
}

namespace sba {
constexpr int KSLOT = 8192, VSLOT = 8192, NS = 3;
constexpr int L_K = 0, L_V = NS * KSLOT, L_WS = L_V + NS * VSLOT, L_FLAG = L_WS + 2048, L_OST = L_FLAG + 256, L_END = L_OST + 8 * 4096;
constexpr float SB_EXIT = 1.0e-42f;
template <int ABL = 0> __device__ __forceinline__ void unit(int b, int kh, int qb64, const bf16_t* Q, const bf16_t* KT, const bf16_t* VT, bf16_t* O, LAS unsigned char* shm, int wv) {
    int tid_ = wv * 64 + lane_id(); asm volatile("" : "+v"(tid_));
    const int tid = tid_, lane = tid & 63, r32 = lane & 31, hi = lane >> 5; const int wid = __builtin_amdgcn_readfirstlane(tid >> 6);
    const int h = kh * 4 + (wid >> 1), half = wid & 1;
    const long rowbase = (long)b * SEQL; const int q0 = qb64 * 64;
    const bf16_t* Qw = Q + (size_t)(rowbase + q0 + half * 32) * 1024 + h * 64;
    const bf16_t* Kh = KT + (size_t)((b * 4 + kh) * 128) * 4096 + wid * 512 + lane * 8;
    const bf16_t* Vh = VT + (size_t)((b * 4 + kh) * 128) * 4096 + wid * 512 + lane * 8;
    const unsigned lds0 = (unsigned)(uintptr_t)shm;
    LAS int* flags = (LAS int*)(shm + L_FLAG);
    const int NT = qb64 + 1;
#define SBA_DMA(k, sl) do { const int tile_ = qb64 - (k); \
        glds16(Kh + (size_t)tile_ * 4096, (unsigned)__builtin_amdgcn_readfirstlane(lds0 + L_K + (sl) * KSLOT + wid * 1024)); \
        glds16(Vh + (size_t)tile_ * 4096, (unsigned)__builtin_amdgcn_readfirstlane(lds0 + L_V + (sl) * VSLOT + wid * 1024)); } while (0)
    SBA_DMA(0, 0); if (NT > 1) SBA_DMA(1, 1);
    bf16x8 qr[4];
#pragma unroll
    for (int d0 = 0; d0 < 4; ++d0) qr[d0] = *(const bf16x8*)(Qw + (size_t)r32 * 1024 + d0 * 16 + hi * 8);
    float R = 1.f; f32x16 o[2];
#pragma unroll
    for (int r = 0; r < 16; ++r) { o[0][r] = 0.f; o[1][r] = 0.f; }
    const int qrel = half * 32 + r32;
    int slot = 0;
    for (int k = 0; k < NT; ++k) {
        if (k + 1 < NT) ATT_WAIT_BAR(2); else ATT_WAIT_BAR(0);
        if (k > 0) { const LAS int* f = flags + ((k - 1) & 1) * 8; int all = 1;
#pragma unroll
            for (int w = 0; w < 8; ++w) all &= f[w];
            if (all) break; }
        if (k + 2 < NT) { const int s2 = slot == 0 ? 2 : slot - 1; SBA_DMA(k + 2, s2); }
        if (ABL == 3) { if (lane == 0) flags[(k & 1) * 8 + wid] = (k >= 2); } else {
            const lcp kb = (lcp)shm + L_K + slot * KSLOT + hi * 1024 + r32 * 16;
            f32x16 p0, p1;
#pragma unroll
            for (int r = 0; r < 16; ++r) { p0[r] = 0.f; p1[r] = 0.f; }
#pragma unroll
            for (int d0 = 0; d0 < 4; ++d0) { const bf16x8 b0 = *(const LAS bf16x8*)(kb + d0 * 2048), b1 = *(const LAS bf16x8*)(kb + d0 * 2048 + 512);
                p0 = __builtin_amdgcn_mfma_f32_32x32x16_bf16(b0, qr[d0], p0, 0, 0, 0); p1 = __builtin_amdgcn_mfma_f32_32x32x16_bf16(b1, qr[d0], p1, 0, 0, 0); }
            f32x16 N0, N1;
#pragma unroll
            for (int r = 0; r < 16; r += 2) {
                f32x2 e0, e1; e0.x = fast_exp2(-p0[r]); e0.y = fast_exp2(-p0[r + 1]); e1.x = fast_exp2(-p1[r]); e1.y = fast_exp2(-p1[r + 1]);
                const f32x2 d0 = e0 + 1.0f, d1 = e1 + 1.0f;
                f32x2 b0, b1; b0.x = fast_rcp(d0.x); b0.y = fast_rcp(d0.y); b1.x = fast_rcp(d1.x); b1.y = fast_rcp(d1.y);
                f32x2 n0 = 1.0f - b0, n1 = 1.0f - b1;
                if (k == 0) { const int kv = crow(r, hi), kw = crow(r + 1, hi);
                    if (kv >= qrel) { b0.x = 0.f; n0.x = 1.f; } if (kw >= qrel) { b0.y = 0.f; n0.y = 1.f; } if (kv + 32 >= qrel) { b1.x = 0.f; n1.x = 1.f; } if (kw + 32 >= qrel) { b1.y = 0.f; n1.y = 1.f; } }
                p0[r] = b0.x; p0[r + 1] = b0.y; p1[r] = b1.x; p1[r + 1] = b1.y; N0[r] = n0.x; N0[r + 1] = n0.y; N1[r] = n1.x; N1[r + 1] = n1.y; }
            float G[16];
#pragma unroll
            for (int j = 0; j < 8; ++j) { const f32x16& NN = j < 4 ? N0 : N1; const int rb = 4 * (j & 3);
                const f32x2 t2 = (f32x2){NN[rb], NN[rb + 1]} * (f32x2){NN[rb + 2], NN[rb + 3]}; const float gp = t2.x * t2.y;
                auto rr = __builtin_amdgcn_permlane32_swap(__float_as_uint(gp), __float_as_uint(gp), false, false);
                G[2 * j] = __uint_as_float(rr[0]); G[2 * j + 1] = __uint_as_float(rr[1]); }
            float SG[16]; SG[15] = 1.f;
#pragma unroll
            for (int g = 14; g >= 0; --g) SG[g] = SG[g + 1] * G[g + 1];
            const float T = SG[0] * G[0];
#pragma unroll
            for (int j = 0; j < 8; ++j) { f32x16& NN = j < 4 ? N0 : N1; f32x16& PP = j < 4 ? p0 : p1; const int rb = 4 * (j & 3);
                const float base = (R * SG[2 * j + 1]) * (hi ? 1.f : G[2 * j + 1]);
                const float r3 = base, r2 = r3 * NN[rb + 3], r1 = r2 * NN[rb + 2], r0 = r1 * NN[rb + 1];
                const f32x2 ph = (f32x2){PP[rb + 2], PP[rb + 3]} * (f32x2){r2, r3}, pl = (f32x2){PP[rb], PP[rb + 1]} * (f32x2){r0, r1};
                PP[rb + 3] = ph.y; PP[rb + 2] = ph.x; PP[rb + 1] = pl.y; PP[rb] = pl.x; }
            R *= T;
            const u32x4 pw0 = {pk_bf16(p0[0], p0[1]), pk_bf16(p0[2], p0[3]), pk_bf16(p0[4], p0[5]), pk_bf16(p0[6], p0[7])};
            const u32x4 pw1 = {pk_bf16(p0[8], p0[9]), pk_bf16(p0[10], p0[11]), pk_bf16(p0[12], p0[13]), pk_bf16(p0[14], p0[15])};
            const u32x4 pw2 = {pk_bf16(p1[0], p1[1]), pk_bf16(p1[2], p1[3]), pk_bf16(p1[4], p1[5]), pk_bf16(p1[6], p1[7])};
            const u32x4 pw3 = {pk_bf16(p1[8], p1[9]), pk_bf16(p1[10], p1[11]), pk_bf16(p1[12], p1[13]), pk_bf16(p1[14], p1[15])};
            const lcp vp = (lcp)shm + L_V + slot * VSLOT + ((lane >> 4) & 1) * 32 + (lane & 3) * 8 + (4 * hi + ((lane & 15) >> 2)) * 64;
            if (ABL != 2) pv(o, vp, pw0, pw1, pw2, pw3); else o[0][0] += __uint_as_float(pw0.x ^ pw1.y ^ pw2.z ^ pw3.w);
            const int dn = (ABL == 4 || __all(R < SB_EXIT)) ? 1 : 0;
            if (lane == 0) flags[(k & 1) * 8 + wid] = dn;
        }
        slot = slot == 2 ? 0 : slot + 1;
    }
#undef SBA_DMA
    ATT_WAIT_BAR(0);
    float one[16];
#pragma unroll
    for (int r = 0; r < 16; ++r) one[r] = 1.0f;
    store_o(o, one, shm + L_OST + wid * 4096, O + (size_t)(rowbase + q0 + half * 32) * 1024 + h * 64, 1024, lane, r32, hi);
    asm volatile("s_waitcnt lgkmcnt(0)\n\ts_barrier" ::: "memory");
}
__device__ __forceinline__ void phase(int vcu, int G, const bf16_t* Q, const bf16_t* KT, const bf16_t* VT, bf16_t* O, LAS unsigned char* shm, int wv) {
    for (int u = vcu * 4; u < 1024; u += G * 4)
        for (int i = 0; i < 4; ++i) { const int uu = u + i, qb64 = uu & 127, bk = uu >> 7; unit(bk >> 2, bk & 3, qb64, Q, KT, VT, O, shm, wv); }
}
}
}
#ifndef FP8_FDN
#define FP8_FDN 0
#endif
#ifndef FP8_EGU
#define FP8_EGU 1
#endif
#ifndef FP8_EDN
#define FP8_EDN 1
#endif
#ifndef FP8_DOWN
#define FP8_DOWN (FP8_FDN || FP8_EDN)
#endif
namespace fw {
constexpr size_t MiB = 1u << 20;
constexpr int NWAVES = 8, NTHR = 512;
constexpr int MAXSLOT = 34816;
constexpr size_t WS_CTL = 0, CTL_ZERO_BYTES = 64 * 1024;
constexpr size_t WS_TOKE = 1 * MiB;
constexpr size_t WS_TOKG = WS_TOKE + 64 * 1024;
constexpr size_t WS_TOKRS = WS_TOKG + 128 * 1024;
constexpr size_t WS_SLOT12 = WS_TOKRS + 64 * 1024;
constexpr size_t WS_SLOTG = WS_SLOT12 + 128 * 1024;
constexpr size_t WS_SLOTRS = WS_SLOTG + 256 * 1024;
constexpr size_t WS_CNT = WS_SLOTRS + 256 * 1024;
constexpr size_t WS_PSTART = WS_CNT + 16 * 1024;
constexpr size_t WS_CS = 4 * MiB;
constexpr size_t WS_SSQ = 6 * MiB;
constexpr size_t WS_SSQQ = 8 * MiB;
constexpr size_t WS_SSQKV = WS_SSQQ + 512 * 1024;
constexpr size_t WS_KPE = 9 * MiB;
constexpr size_t WS_SSPE = 11 * MiB;
constexpr size_t WS_W = 16 * MiB;
constexpr size_t W_AIN = WS_W, W_QUP = W_AIN + 3 * MiB, W_KVUP = W_QUP + 2 * MiB, W_AOUT = W_KVUP + 1 * MiB, W_KVS = W_AOUT + 2 * MiB, W_QB = W_KVS + 1 * MiB,
                 W_OB = W_QB + 4 * MiB, W_PG = W_OB + 4 * MiB, W_PU = W_PG + 8 * MiB, W_FGU = W_PU + 2 * MiB, W_FDN = W_FGU + 22 * MiB, W_EGU = W_FDN + 11 * MiB,
                 W_EDN = W_EGU + 176 * MiB, W_END = W_EDN + 88 * MiB;
constexpr size_t WS_PB = W_END;
constexpr size_t WS_HB = WS_PB + 32 * MiB;
constexpr size_t WS_U = WS_HB + 64 * MiB;
constexpr size_t WS_SKT = WS_U + 128 * MiB, WS_SVT = WS_SKT + 8 * MiB;
constexpr size_t WS_X = WS_SVT + 8 * MiB;
constexpr size_t X_AQ = WS_X, X_AKV = X_AQ + 12 * MiB, X_QRAW = X_AKV + 8 * MiB, X_KVRAW = X_QRAW + 24 * MiB, X_Q = X_KVRAW + 32 * MiB, X_KT = X_Q + 24 * MiB, X_VT = X_KT + 24 * MiB, X_O = X_VT + 16 * MiB;
constexpr size_t X_SQ = WS_X, X_SO = X_SQ + 32 * MiB;
constexpr size_t X_XG = WS_X, X_HG = X_XG + 68 * MiB, X_YG = X_HG + 187 * MiB, X_END = X_YG + 68 * MiB;
constexpr size_t WS_END = X_END;
constexpr size_t X_HID = WS_END + 128 * MiB;
constexpr size_t WS_NEED = X_HID + 88 * MiB;
static_assert(X_O + 16 * MiB <= X_END && (size_t)MAXSLOT * 2816 * 2 <= 187 * MiB && (size_t)MAXSLOT * 1024 * 2 <= 68 * MiB, "ws map");
constexpr int CW_BAR = 1024;
constexpr int RING_OFF = 0, RING_BYTES = 131072, LDSCTL_OFF = RING_BYTES, MISC_OFF = LDSCTL_OFF + 320, XS_OFF = LDSCTL_OFF + 1024  , LDS_BYTES = 147456;
static_assert(att::mla::L_END <= RING_BYTES && att::sba::L_END <= RING_BYTES, "attention LDS");
constexpr float QSCALE_MLA = 0.10206207261596577f * LOG2E;
constexpr float QSCALE_SB = 0.125f * LOG2E;

struct EpiQ {
    static constexpr bool PERM = true, AFTER_DRAIN = false;
    unsigned char* ws; const float* gq;
    __device__ __forceinline__ void operator()(const f32x4 (&acc)[2][2][4][2], const pg8::Unit& u, int wr, int wc, int fr_, int fq_) const {
        const int ln_ = lane_id(), fr = ln_ & 15, fq = ln_ >> 4; (void)fr_; (void)fq_;
        const int row0 = u.pm * pg8::BM + wr * 64 + fr, c = wc * 32 + 8 * fq;
        LAS float* xs = (LAS float*)(uintptr_t)XS_OFF;
        bf16_t* Q = (bf16_t*)(ws + X_Q); const float* CS = (const float*)(ws + WS_CS); const pg8::RowScale rs{(const float*)(ws + WS_SSQQ), 3}; const float qscale = QSCALE_MLA;
        float rsv[2][4]; rs.get8(rsv, row0, fq);
#pragma unroll
        for (int ai = 0; ai < 2; ++ai)
#pragma unroll
            for (int m = 0; m < 4; ++m) { const int rl = ai * pg8::HALF + wr * 64 + m * 16 + fr; const float s = rsv[ai][m];
#pragma unroll
                for (int bj = 0; bj < 2; ++bj) { const float q = pg8::red_fq(pg8::sumsq8(acc[ai][bj][m][0], acc[ai][bj][m][1])) * (s * s); if (fq == 0) xs[(rl * 2 + bj) * 4 + wc] = q; }
                asm volatile("" ::: "memory"); }
        asm volatile("s_waitcnt lgkmcnt(0)" ::: "memory"); __builtin_amdgcn_s_barrier(); asm volatile("" ::: "memory");
        const int cg = wc < 3 ? c : 0;
#pragma unroll
        for (int ai = 0; ai < 2; ++ai)
#pragma unroll
            for (int m = 0; m < 4; ++m) { const int rl = ai * pg8::HALF + wr * 64 + m * 16 + fr, row = row0 + ai * pg8::HALF + m * 16;
                const f32x4 g0 = *(const f32x4*)(gq + cg), g1 = *(const f32x4*)(gq + cg + 4);
#pragma unroll
                for (int bj = 0; bj < 2; ++bj) { const f32x4 p4 = *(const LAS f32x4*)(xs + (rl * 2 + bj) * 4);
                    const float ss = (p4[0] + p4[1]) + (p4[2] + p4[3]); const float sc = rsv[ai][m] * (1.0f / sqrtf(ss * (1.0f / 96.0f) + RMS_EPS)) * qscale;
                    f32x4 v0 = acc[ai][bj][m][0] * g0 * sc, v1 = acc[ai][bj][m][1] * g1 * sc;
                    if (wc == 2) pg8::rope8(v0, v1, CS + (size_t)row * 32, fq);
                    if (wc < 3) *(u32x4*)(Q + (size_t)row * 768 + (2 * u.pn + bj) * 96 + c) = pack8(v0, v1); }
                asm volatile("" ::: "memory"); }
    }
};
struct EpiKV {
    static constexpr bool PERM = true, AFTER_DRAIN = false;
    unsigned char* ws; const float* gk;
    __device__ __forceinline__ void operator()(const f32x4 (&acc)[2][2][4][2], const pg8::Unit& u, int wr, int wc, int fr_, int fq_) const {
        const int ln_ = lane_id(), fr = ln_ & 15, fq = ln_ >> 4; (void)fr_; (void)fq_;
        const int row0 = u.pm * pg8::BM + wr * 64 + fr, c = (wc & 1) * 32 + 8 * fq;
        LAS float* xs = (LAS float*)(uintptr_t)XS_OFF;
        bf16_t* KT = (bf16_t*)(ws + X_KT); bf16_t* VT = (bf16_t*)(ws + X_VT); const float* KPE = (const float*)(ws + WS_KPE); const float* SSPE = (const float*)(ws + WS_SSPE); const pg8::RowScale rs{(const float*)(ws + WS_SSQKV), 4};
        float rsv[2][4]; rs.get8(rsv, row0, fq);
#pragma unroll
        for (int ai = 0; ai < 2; ++ai)
#pragma unroll
            for (int m = 0; m < 4; ++m) { const int rl = ai * pg8::HALF + wr * 64 + m * 16 + fr; const float s = rsv[ai][m];
#pragma unroll
                for (int bj = 0; bj < 2; ++bj) { const float q = pg8::red_fq(pg8::sumsq8(acc[ai][bj][m][0], acc[ai][bj][m][1])) * (s * s); if (fq == 0 && wc < 2) xs[(rl * 2 + bj) * 2 + wc] = q; }
                asm volatile("" ::: "memory"); }
        asm volatile("s_waitcnt lgkmcnt(0)" ::: "memory"); __builtin_amdgcn_s_barrier(); asm volatile("" ::: "memory");
#pragma unroll
        for (int ai = 0; ai < 2; ++ai)
#pragma unroll
            for (int m = 0; m < 4; ++m) { const int rl = ai * pg8::HALF + wr * 64 + m * 16 + fr, row = row0 + ai * pg8::HALF + m * 16; const float s = rsv[ai][m];
                const f32x4 g0 = *(const f32x4*)(gk + c), g1 = *(const f32x4*)(gk + c + 4);
                const int b = row >> 13, sq = row & 8191, tile = sq >> 6, rr = sq & 63;
                const f32x4 k0 = *(const f32x4*)(KPE + (size_t)row * 32 + 8 * fq), k1 = *(const f32x4*)(KPE + (size_t)row * 32 + 8 * fq + 4);
                const float sspe = SSPE[row];
#pragma unroll
                for (int bj = 0; bj < 2; ++bj) { const int h = 2 * u.pn + bj; const size_t tb = (size_t)((b * 8 + h) * 128 + tile);
                    const float ssn = xs[(rl * 2 + bj) * 2] + xs[(rl * 2 + bj) * 2 + 1];
                    const float rk = 1.0f / sqrtf((ssn + sspe) * (1.0f / 96.0f) + RMS_EPS);
                    if (wc < 2) *(u32x4*)(KT + tb * 6144 + (c >> 3) * 512 + rr * 8) = pack8(acc[ai][bj][m][0] * g0 * (s * rk), acc[ai][bj][m][1] * g1 * (s * rk));
                    else *(u32x4*)(VT + tb * 4096 + (wc - 2) * 2048 + rr * 32 + 8 * fq) = pack8(acc[ai][bj][m][0] * s, acc[ai][bj][m][1] * s);
                    if (wc == 2) *(u32x4*)(KT + tb * 6144 + (8 + fq) * 512 + rr * 8) = pack8(k0 * rk, k1 * rk); }
                asm volatile("" ::: "memory"); }
    }
};
constexpr int PH_PER_LAYER = 12, PH_TOTAL = 2 + 4 * PH_PER_LAYER;
__host__ __device__ inline bool phase_active(int idx) {
    if (idx == 0) return true;
    if (idx == 1) return false;
    const int l = (idx - 2) / PH_PER_LAYER, s = (idx - 2) % PH_PER_LAYER; const bool mla = l < 2, moe = (l & 1) != 0;
    if (s == 1 || s == 3) return mla;
    if (s == 2) return false;
    if (s >= 7 && s <= 9) return moe;
    if (s == 11) return l == 1;
    return true;
}

struct Args { const float* in[26]; float* out; unsigned char* ws; int ph_lo, ph_hi; };

struct Frame { LAS unsigned char* lds; int tid, lane, wave, vcu, G; };

__device__ __forceinline__ float shx(float v, int k, int lane) { return __uint_as_float((unsigned)__builtin_amdgcn_ds_bpermute((lane ^ k) << 2, (int)__float_as_uint(v))); }
__device__ __forceinline__ int shi(int v, int src, int lane) { (void)lane; return __builtin_amdgcn_ds_bpermute(src << 2, v); }
__device__ __forceinline__ float wave_sum(float v, int lane) {
#pragma unroll
    for (int o = 1; o < 64; o <<= 1) v += shx(v, o, lane);
    return v;
}
template <bool NT, bool F8 = false> __device__ __forceinline__ void transpose_item(const float* W, int ldw, int sca, int scb, const float* gain, bf16_t* WT, int K, int drow0, int k0, LAS float* scr, int lane, float f8s = 64.f) {
    const int r8 = lane >> 3, pc = lane & 7, c = lane & 7;
    f32x4 va[8], vb[8]; float g[8];
    const f32x4 z4 = {0.f, 0.f, 0.f, 0.f};
#pragma unroll
    for (int i = 0; i < 8; ++i) { const float* rp = W + (size_t)(k0 + i * 8 + r8) * ldw + 4 * pc;
        if (NT) { va[i] = sca >= 0 ? __builtin_nontemporal_load((const f32x4*)(rp + sca)) : z4; vb[i] = scb >= 0 ? __builtin_nontemporal_load((const f32x4*)(rp + scb)) : z4; }
        else { va[i] = sca >= 0 ? *(const f32x4*)(rp + sca) : z4; vb[i] = scb >= 0 ? *(const f32x4*)(rp + scb) : z4; }
        g[i] = gain ? gain[k0 + i * 8 + r8] : 1.0f; }
#pragma unroll
    for (int hf = 0; hf < 2; ++hf) {
#pragma unroll
        for (int i = 0; i < 8; ++i) { const f32x4 v = (hf == 0 ? va[i] : vb[i]) * g[i]; LAS float* d = scr + (i * 8 + r8) * 33 + 4 * pc; d[0] = v[0]; d[1] = v[1]; d[2] = v[2]; d[3] = v[3]; }
        asm volatile("s_waitcnt lgkmcnt(0)" ::: "memory");
#pragma unroll
        for (int j = 0; j < 4; ++j) { const int n = (lane >> 3) + 8 * j; const LAS float* s = scr + (8 * c) * 33 + n;
            u32x4 o; o.x = pk_bf16(s[0 * 33], s[1 * 33]); o.y = pk_bf16(s[2 * 33], s[3 * 33]); o.z = pk_bf16(s[4 * 33], s[5 * 33]); o.w = pk_bf16(s[6 * 33], s[7 * 33]);
            if (F8) { const f32x4 q0 = {s[0 * 33] * f8s, s[1 * 33] * f8s, s[2 * 33] * f8s, s[3 * 33] * f8s}, q1 = {s[4 * 33] * f8s, s[5 * 33] * f8s, s[6 * 33] * f8s, s[7 * 33] * f8s};
                *(u32x2*)((unsigned char*)WT + (size_t)(drow0 + hf * 32 + n) * K + k0 + 8 * c) = pack8_fp8(q0, q1); }
            else if (NT) __builtin_nontemporal_store(o, (u32x4*)(WT + (size_t)(drow0 + hf * 32 + n) * K + k0 + 8 * c)); else *(u32x4*)(WT + (size_t)(drow0 + hf * 32 + n) * K + k0 + 8 * c) = o; }
        asm volatile("s_waitcnt lgkmcnt(0)" ::: "memory");
    }
}
struct Fam { int src, count, K, Nd, ldw, map, gain, gstride; size_t sstride, dst, dstride; };
__device__ __forceinline__ int fam_items(const Fam& f) { return f.count * (f.K / 64) * (f.Nd / 64); }
__device__ __forceinline__ int fam_src_col(int map, int n0) {
    if (map == 1) return n0 < 384 ? n0 : (n0 < 416 ? 640 + (n0 - 384) : (n0 < 512 ? -1 : 384 + (n0 - 512)));
    if (map == 2) { const int pn = n0 >> 8, jj = n0 & 255; return jj < 128 ? pn * 128 + jj : 2816 + pn * 128 + (jj - 128); }
    if (map == 3) { const int h = n0 >> 7, off = n0 & 127; return off < 96 ? 96 * h + off : -1; }
    return n0;
}
template <bool NT = false> __device__ __forceinline__ void fam_item(const Args& a, const Fam& f, int fid, int it, LAS float* scr, int lane, int mi_off = 0) {
    const int per = (f.K / 64) * (f.Nd / 64), mi = it / per + mi_off, r = it % per, nblk = f.Nd / 64, kb = r / nblk, nb = r % nblk, n0 = nb * 64;
    const float* gain = nullptr;
    if (f.gain >= 0) gain = a.in[f.gain] + (fid == 11 ? (size_t)(2 * (mi >> 3) + 1) * 1024 : (size_t)mi * f.gstride);
#if FP8_DOWN || FP8_EGU
    if ((FP8_FDN && fid == 10) || (FP8_EDN && fid == 12) || (FP8_EGU && fid == 11)) { transpose_item<NT, true>(a.in[f.src] + (size_t)mi * f.sstride, f.ldw, fam_src_col(f.map, n0), fam_src_col(f.map, n0 + 32), gain, (bf16_t*)(a.ws + f.dst + (size_t)mi * f.dstride), f.K, n0, kb * 64, scr, lane, fid == 11 ? 32.f : 64.f); return; }
#endif
    transpose_item<NT>(a.in[f.src] + (size_t)mi * f.sstride, f.ldw, fam_src_col(f.map, n0), fam_src_col(f.map, n0 + 32), gain, (bf16_t*)(a.ws + f.dst + (size_t)mi * f.dstride), f.K, n0, kb * 64, scr, lane);
}
__constant__ const Fam FAMS[13] = {
        {4, 2, 1024, 768, 672, 1, 3, 1024, (size_t)1024 * 672, W_AIN, (size_t)768 * 1024 * 2},
        {7, 2, 384, 1024, 768, 3, 5, 384, (size_t)384 * 768, W_QUP, (size_t)1024 * 384 * 2},
        {8, 2, 256, 1024, 1024, 0, 6, 256, (size_t)256 * 1024, W_KVUP, (size_t)1024 * 256 * 2},
        {11, 2, 512, 1024, 1024, 0, -1, 0, (size_t)512 * 1024, W_AOUT, (size_t)1024 * 512 * 2},
        {13, 1, 1024, 512, 512, 0, 12, 0, 0, W_KVS, 0},
        {15, 2, 1024, 1024, 1024, 0, 14, 1024, (size_t)1024 * 1024, W_QB, (size_t)1024 * 1024 * 2},
        {16, 2, 1024, 1024, 1024, 0, -1, 0, (size_t)1024 * 1024, W_OB, (size_t)1024 * 1024 * 2},
        {24, 4, 1024, 1024, 1024, 0, 23, 1024, (size_t)1024 * 1024, W_PG, (size_t)1024 * 1024 * 2},
        {25, 4, 256, 1024, 1024, 0, -1, 0, (size_t)256 * 1024, W_PU, (size_t)1024 * 256 * 2},
        {18, 1, 1024, 5632, 5632, 2, 17, 2048, (size_t)1024 * 5632, W_FGU, (size_t)5632 * 1024 * 2},
        {19, 1, 2816, 1024, 1024, 0, -1, 0, (size_t)2816 * 1024, W_FDN, (size_t)1024 * 2816 * 2},
        {21, 8, 1024, 5632, 5632, 2, 17, 0, (size_t)1024 * 5632, W_EGU, (size_t)5632 * 1024 * 2},
        {22, 8, 2816, 1024, 1024, 0, -1, 0, (size_t)2816 * 1024, W_EDN, (size_t)1024 * 2816 * 2}};
constexpr int DEF_N0 = 1408, DEF_N1 = DEF_N0 + 704, DEF_N2 = DEF_N1 + 11264, DEF_N3 = DEF_N2 + 5632;
#ifndef FILL_A
#define FILL_A 0
#define FILL_B 0
#define FILL_C 0
#define FILL_D 0
#endif
constexpr int DEF_QA = FILL_A, DEF_QB = DEF_QA + FILL_B, DEF_QC = DEF_QB + FILL_C, DEF_QD = DEF_QC + FILL_D;
constexpr int CW_FILL = 512;
__device__ __forceinline__ void prologue(const Args& a, Frame& F) {
    LAS float* scr = (LAS float*)(F.lds + RING_OFF + F.wave * 16384);
    const int gw = F.vcu * NWAVES + F.wave, NGW = F.G * NWAVES;
    int base = 0;
#pragma unroll 1
    for (int fid = 0; fid < 13; ++fid) { const Fam f = FAMS[fid]; const int n = fam_items(f);
        int it = gw - (base % NGW); if (it < 0) it += NGW;
#pragma unroll 1
        for (; it < n; it += NGW) fam_item(a, f, fid, it, scr, F.lane);
        base += n; }
    for (int id = DEF_QD + gw; id < DEF_N3; id += NGW) {
        if (id < DEF_N0) fam_item(a, FAMS[9], 9, id, scr, F.lane, 1);
        else if (id < DEF_N1) fam_item(a, FAMS[10], 10, id - DEF_N0, scr, F.lane, 1);
        else if (id < DEF_N2) fam_item(a, FAMS[11], 11, id - DEF_N1, scr, F.lane, 8);
        else fam_item(a, FAMS[12], 12, id - DEF_N2, scr, F.lane, 8);
    }
    { const f32x4* src = (const f32x4*)a.in[1]; u32x2* dst = (u32x2*)(a.ws + WS_PB); const size_t n4 = (size_t)4 * MT * 256 / 4, S = (size_t)NGW * 64;
        for (size_t i = (size_t)gw * 64 + F.lane; i < n4; i += 4 * S) { f32x4 v[4];
#pragma unroll
            for (int q = 0; q < 4; ++q) v[q] = (i + q * S < n4) ? src[i + q * S] : (f32x4){0.f, 0.f, 0.f, 0.f};
#pragma unroll
            for (int q = 0; q < 4; ++q) if (i + q * S < n4) { u32x2 o; o.x = pk_bf16(v[q][0], v[q][1]); o.y = pk_bf16(v[q][2], v[q][3]); dst[i + q * S] = o; } } }
    { bf16_t* HB = (bf16_t*)(a.ws + WS_HB); float* SSQ = (float*)(a.ws + WS_SSQ);
        for (int row = gw; row < MT; row += NGW) { const f32x4* xr = (const f32x4*)(a.in[0] + (size_t)row * DMODEL) + F.lane;
            u32x2* hb = (u32x2*)(HB + (size_t)row * DMODEL) + F.lane; float s = 0.f; f32x4 v4[4];
#pragma unroll
            for (int j = 0; j < 4; ++j) v4[j] = xr[64 * j];
#pragma unroll
            for (int j = 0; j < 4; ++j) { const f32x4 v = v4[j]; u32x2 o; o.x = pk_bf16(v[0], v[1]); o.y = pk_bf16(v[2], v[3]); hb[64 * j] = o; s += (v[0] * v[0] + v[1] * v[1]) + (v[2] * v[2] + v[3] * v[3]); }
            s = wave_sum(s, F.lane); if (F.lane < 16) SSQ[(size_t)row * 16 + F.lane] = F.lane == 0 ? s : 0.f; } }
    { float* cs = (float*)(a.ws + WS_CS); const int* pos = (const int*)a.in[2];
        for (int i = gw * 64 + F.lane; i < MT * 16; i += NGW * 64) { const int row = i >> 4, f = i & 15;
            const float invf = (float)exp(-9.210340371976184 * (double)f / 16.0);
            const double ang = (double)((float)pos[row] * invf);
            const double rev = ang * 0.15915494309189535, fr = rev - rint(rev); const float x = (float)(fr * 6.283185307179586);
            cs[(size_t)row * 32 + f] = cosf(x); cs[(size_t)row * 32 + 16 + f] = sinf(x); } }
}
#define THIN_LAUNDER() Frame F = F_; unsigned char* wsl = a.ws; F.lane = lane_id(); F.tid = F.wave * 64 + F.lane; asm volatile("" : "+v"(F.tid), "+v"(F.lane), "+s"(F.vcu), "+s"(F.G), "+s"(wsl))
__device__ __forceinline__ void filler(const Args& a, const Frame& F_, int qi, int start, int end) {
    Frame F = F_; { int t_ = F_.wave * 64 + lane_id(); asm volatile("" : "+v"(t_)); F.tid = t_; F.lane = t_ & 63; }
    unsigned char* wsl = a.ws; asm volatile("" : "+s"(wsl));
    LAS float* scr = (LAS float*)(F.lds + RING_OFF + F.wave * 16384);
    unsigned* ctr = (unsigned*)(wsl + WS_CTL) + CW_FILL + qi;
    for (;;) {
        int id = 0; if (F.lane == 0) id = (int)__hip_atomic_fetch_add(ctr, 1u, __ATOMIC_RELAXED, __HIP_MEMORY_SCOPE_AGENT) + start;
        id = __builtin_amdgcn_readfirstlane(id);
        if (id >= end) break;
        if (id < DEF_N0) fam_item<true>(a, FAMS[9], 9, id, scr, F.lane, 1);
        else if (id < DEF_N1) fam_item<true>(a, FAMS[10], 10, id - DEF_N0, scr, F.lane, 1);
        else if (id < DEF_N2) fam_item<true>(a, FAMS[11], 11, id - DEF_N1, scr, F.lane, 8);
        else fam_item<true>(a, FAMS[12], 12, id - DEF_N2, scr, F.lane, 8);
    }
}
__device__ __forceinline__ void moe_route(const Args& a, const Frame& F_, int layer, int cur) { THIN_LAUNDER();
    const bf16_t* HB = (const bf16_t*)(wsl + WS_HB) + (size_t)cur * MT * DMODEL; const float* gain = a.in[17] + (size_t)layer * 1024; const float* wr = a.in[20] + (size_t)(layer >> 1) * 1024 * 8;
    int* TOKE = (int*)(wsl + WS_TOKE); float* TOKG = (float*)(wsl + WS_TOKG); float* TOKRS = (float*)(wsl + WS_TOKRS); int* CNT = (int*)(wsl + WS_CNT);
    constexpr int LDW = 1032;
    LAS bf16_t* WB = (LAS bf16_t*)(F.lds + RING_OFF);
    LAS int* lcnt = (LAS int*)(F.lds + RING_OFF + 36864);
    LAS float* LG = (LAS float*)(F.lds + RING_OFF + 37888) + F.wave * 128;
    {
        const f32x4* w4p = (const f32x4*)wr + 4 * F.tid; const f32x4 w0 = w4p[0], w1 = w4p[1], w2 = w4p[2], w3 = w4p[3]; const float g0 = gain[2 * F.tid], g1 = gain[2 * F.tid + 1];
        const float xa[8] = {w0[0] * g0, w0[1] * g0, w0[2] * g0, w0[3] * g0, w1[0] * g0, w1[1] * g0, w1[2] * g0, w1[3] * g0};
        const float xb[8] = {w2[0] * g1, w2[1] * g1, w2[2] * g1, w2[3] * g1, w3[0] * g1, w3[1] * g1, w3[2] * g1, w3[3] * g1};
#pragma unroll
        for (int e = 0; e < 8; ++e) { const unsigned ha = pk_bf16(xa[e], 0.f) & 0xffffu, hb = pk_bf16(xb[e], 0.f) & 0xffffu;
            const float la = xa[e] - __uint_as_float(ha << 16), lb = xb[e] - __uint_as_float(hb << 16);
            *(LAS unsigned*)(WB + e * LDW + 2 * F.tid) = ha | (hb << 16); *(LAS unsigned*)(WB + (8 + e) * LDW + 2 * F.tid) = pk_bf16(la, lb); } }
    LAS float* SSW = (LAS float*)(F.lds + RING_OFF + 37888 + 4096);
    const int n = F.lane & 15, q = F.lane >> 4;
    for (int chunk = F.vcu; chunk < MT / 64; chunk += F.G) {
        if (F.tid < 8) lcnt[F.tid] = 0;
        __syncthreads();
        {
            const int tokw = chunk * 64 + (F.wave & 3) * 16, kh = (F.wave >> 2) * 512;
            const bf16_t* arow = HB + (size_t)(tokw + n) * DMODEL + 8 * q + kh; const LAS bf16_t* brow = WB + n * LDW + 8 * q + kh;
            f32x4 acc = {0.f, 0.f, 0.f, 0.f}; float ss = 0.f;
#pragma unroll
            for (int s = 0; s < 16; ++s) { const u32x4 av = *(const u32x4*)(arow + 32 * s); const bf16x8 bv = *(const LAS bf16x8*)(brow + 32 * s);
                acc = __builtin_amdgcn_mfma_f32_16x16x32_bf16(__builtin_bit_cast(bf16x8, av), bv, acc, 0, 0, 0);
                f32x4 x0, x1; unpack8(av, x0, x1); ss += pg8::sumsq8(x0, x1); }
            ss = pg8::red_fq(ss);
#pragma unroll
            for (int i = 0; i < 4; ++i) { const float v = acc[i] + shx(acc[i], 8, F.lane); if (n < 8) LG[(4 * q + i) * 8 + n] = v; }
            if (q == 0) SSW[F.wave * 16 + n] = ss;
        }
        __syncthreads();
        if (F.wave < 4) {
            const int tok0 = chunk * 64 + F.wave * 16;
            asm volatile("s_waitcnt lgkmcnt(0)" ::: "memory");
            if (F.lane < 16) { const int tok = tok0 + F.lane; const LAS f32x4* lp = (const LAS f32x4*)(LG + F.lane * 8); const f32x4 l0 = lp[0] + lp[128], l1 = lp[1] + lp[129];
                const float ss = SSW[F.wave * 16 + F.lane] + SSW[(F.wave + 4) * 16 + F.lane];
                const float lg[8] = {l0[0], l0[1], l0[2], l0[3], l1[0], l1[1], l1[2], l1[3]};
                const float r = 1.0f / sqrtf(ss * (1.0f / 1024.0f) + RMS_EPS);
                int e1 = 0; float v1 = lg[0];
#pragma unroll
                for (int e = 1; e < 8; ++e) if (lg[e] > v1) { v1 = lg[e]; e1 = e; }
                int e2 = 0; float v2 = -3.0e38f;
#pragma unroll
                for (int e = 0; e < 8; ++e) if (e != e1 && lg[e] > v2) { v2 = lg[e]; e2 = e; }
                const float p2 = __expf((v2 - v1) * r), g1 = 1.0f / (1.0f + p2), g2 = p2 / (1.0f + p2);
                TOKE[tok] = e1 | (e2 << 8); TOKG[tok * 2] = g1; TOKG[tok * 2 + 1] = g2; TOKRS[tok] = r;
                __hip_atomic_fetch_add(lcnt + e1, 1, __ATOMIC_RELAXED, __HIP_MEMORY_SCOPE_WORKGROUP); __hip_atomic_fetch_add(lcnt + e2, 1, __ATOMIC_RELAXED, __HIP_MEMORY_SCOPE_WORKGROUP); }
        }
        __syncthreads();
        if (F.tid < 8) CNT[chunk * 8 + F.tid] = lcnt[F.tid];
        __syncthreads();
    }
}
__device__ __forceinline__ void moe_scatter(const Args& a, const Frame& F_, int cur) { THIN_LAUNDER();
    const int* TOKE = (const int*)(wsl + WS_TOKE); const float* TOKG = (const float*)(wsl + WS_TOKG); const float* TOKRS = (const float*)(wsl + WS_TOKRS); const int* CNT = (const int*)(wsl + WS_CNT);
    int* SLOT12 = (int*)(wsl + WS_SLOT12); float* SLOTG = (float*)(wsl + WS_SLOTG); float* SLOTRS = (float*)(wsl + WS_SLOTRS); int* PSTART = (int*)(wsl + WS_PSTART);
    const bf16_t* HB = (const bf16_t*)(wsl + WS_HB) + (size_t)cur * MT * DMODEL; bf16_t* XG = (bf16_t*)(wsl + X_XG);
    LAS int* sm = (LAS int*)(F.lds + RING_OFF);
    for (int chunk = F.vcu; chunk < MT / 64; chunk += F.G) {
        { const int e = F.wave; int c4[4]; int s = 0;
#pragma unroll
            for (int i = 0; i < 4; ++i) { c4[i] = CNT[(4 * F.lane + i) * 8 + e]; s += c4[i]; }
            int inc = s;
#pragma unroll
            for (int o = 1; o < 64; o <<= 1) { const int t = shi(inc, F.lane >= o ? F.lane - o : F.lane, F.lane); if (F.lane >= o) inc += t; }
            const int total = shi(inc, 63, F.lane); int pre = inc - s;
            if (F.lane == (chunk >> 2)) { const int cm = chunk & 3; pre += (cm > 0 ? c4[0] : 0) + (cm > 1 ? c4[1] : 0) + (cm > 2 ? c4[2] : 0); sm[8 + e] = pre; }
            if (F.lane == 0) sm[e] = total; }
        __syncthreads();
        if (F.tid == 0) { int p = 0; for (int e = 0; e < 8; ++e) { sm[16 + e] = p; p += (sm[e] + 255) >> 8; } sm[24] = p; }
        __syncthreads();
        if (F.tid < 9) PSTART[F.tid] = sm[16 + F.tid];
        if (F.wave == 0) { const int tok = chunk * 64 + F.lane; const int ev = TOKE[tok], e1 = ev & 255, e2 = ev >> 8; int s1 = 0, s2 = 0;
            const unsigned long long below = (1ull << F.lane) - 1ull;
#pragma unroll
            for (int e = 0; e < 8; ++e) { const unsigned long long m1 = __ballot(e1 == e), m2 = __ballot(e2 == e);
                const int rank = __popcll(m1 & below) + __popcll(m2 & below), slot = sm[16 + e] * 256 + sm[8 + e] + rank;
                if (e1 == e) s1 = slot; if (e2 == e) s2 = slot; }
            SLOT12[tok * 2] = s1; SLOT12[tok * 2 + 1] = s2; const float r = TOKRS[tok];
            SLOTG[s1] = TOKG[tok * 2]; SLOTG[s2] = TOKG[tok * 2 + 1]; SLOTRS[s1] = r; SLOTRS[s2] = r;
            sm[32 + 2 * F.lane] = s1; sm[32 + 2 * F.lane + 1] = s2; }
        __syncthreads();
#if FP8_EGU
        {
            u32x4 a0[8], a1[8]; float rr[8]; int sl1[8], sl2[8];
#pragma unroll
            for (int i = 0; i < 8; ++i) { const int tl = F.wave * 8 + i, tok = chunk * 64 + tl; const u32x4* src = (const u32x4*)(HB + (size_t)tok * DMODEL) + 2 * F.lane;
                a0[i] = src[0]; a1[i] = src[1]; rr[i] = TOKRS[tok]; sl1[i] = sm[32 + 2 * tl]; sl2[i] = sm[32 + 2 * tl + 1]; }
#pragma unroll
            for (int i = 0; i < 8; ++i) { f32x4 x0, x1, y0, y1; unpack8(a0[i], x0, x1); unpack8(a1[i], y0, y1); const float r = rr[i];
                const u32x2 lo = pack8_fp8(x0 * r, x1 * r), hi = pack8_fp8(y0 * r, y1 * r); const u32x4 o = {lo.x, lo.y, hi.x, hi.y};
                *((u32x4*)((unsigned char*)XG + (size_t)sl1[i] * DMODEL) + F.lane) = o; *((u32x4*)((unsigned char*)XG + (size_t)sl2[i] * DMODEL) + F.lane) = o; }
        }
#else
        for (int i = 0; i < 16; ++i) { const int pr = F.wave * 16 + i, tok = chunk * 64 + (pr >> 1), slot = sm[32 + pr];
            const u32x4* src = (const u32x4*)(HB + (size_t)tok * DMODEL) + F.lane; u32x4* dst = (u32x4*)(XG + (size_t)slot * DMODEL) + F.lane;
            dst[0] = src[0]; dst[64] = src[64]; }
#endif
        __syncthreads();
    }
}
__device__ __forceinline__ void moe_combine(const Args& a, const Frame& F_, int cur, bool dummy) { THIN_LAUNDER();
    const int* SLOT12 = (const int*)(wsl + WS_SLOT12); const bf16_t* YG = (const bf16_t*)(wsl + X_YG); const float* TOKG = (const float*)(wsl + WS_TOKG);
    const bf16_t* HBi = (const bf16_t*)(wsl + WS_HB) + (size_t)cur * MT * DMODEL;
    bf16_t* HB = dummy ? (bf16_t*)(wsl + WS_END + 66 * MiB) : (bf16_t*)(wsl + WS_HB) + (size_t)cur * MT * DMODEL; float* SSQ = dummy ? (float*)(wsl + WS_END + 99 * MiB) : (float*)(wsl + WS_SSQ) + (size_t)cur * MT * 16;
    const int gw = F.vcu * NWAVES + F.wave, NGW = F.G * NWAVES;
    for (int r0 = F.vcu * 64; r0 < MT; r0 += F.G * 64) {
        const int rw = r0 + F.wave * 8;
        u32x2 sl = {0u, 0u}; f32x2 gg = {0.f, 0.f};
        if (F.lane < 8) { sl = *(const u32x2*)(SLOT12 + (size_t)(rw + F.lane) * 2); gg = *(const f32x2*)(TOKG + (size_t)(rw + F.lane) * 2); }
#pragma unroll
        for (int k2 = 0; k2 < 8; k2 += 2) {
            u32x2 hv[2][4], pv_[2][4], qv[2][4]; float g1[2], g2[2];
#pragma unroll
            for (int t = 0; t < 2; ++t) { const int row = rw + k2 + t; const int s1 = __builtin_amdgcn_readlane((int)sl.x, k2 + t), s2 = __builtin_amdgcn_readlane((int)sl.y, k2 + t);
                g1[t] = __uint_as_float(__builtin_amdgcn_readlane(__float_as_uint(gg.x), k2 + t)); g2[t] = __uint_as_float(__builtin_amdgcn_readlane(__float_as_uint(gg.y), k2 + t));
                const u32x2* hr = (const u32x2*)(HBi + (size_t)row * DMODEL) + F.lane; const u32x2* y1 = (const u32x2*)(YG + (size_t)s1 * DMODEL) + F.lane; const u32x2* y2 = (const u32x2*)(YG + (size_t)s2 * DMODEL) + F.lane;
#pragma unroll
                for (int j = 0; j < 4; ++j) { hv[t][j] = hr[64 * j]; pv_[t][j] = y1[64 * j]; qv[t][j] = y2[64 * j]; } }
#pragma unroll
            for (int t = 0; t < 2; ++t) { const int row = rw + k2 + t; u32x2* hb = (u32x2*)(HB + (size_t)row * DMODEL) + F.lane; float s = 0.f;
#pragma unroll
                for (int j = 0; j < 4; ++j) { const u32x2 h = hv[t][j], p = pv_[t][j], q = qv[t][j]; f32x4 v;
                    v[0] = bf_lo(h.x) + (g1[t] * bf_lo(p.x) + g2[t] * bf_lo(q.x)); v[1] = bf_hi(h.x) + (g1[t] * bf_hi(p.x) + g2[t] * bf_hi(q.x)); v[2] = bf_lo(h.y) + (g1[t] * bf_lo(p.y) + g2[t] * bf_lo(q.y)); v[3] = bf_hi(h.y) + (g1[t] * bf_hi(p.y) + g2[t] * bf_hi(q.y));
                    u32x2 o; o.x = pk_bf16(v[0], v[1]); o.y = pk_bf16(v[2], v[3]); hb[64 * j] = o; s += (v[0] * v[0] + v[1] * v[1]) + (v[2] * v[2] + v[3] * v[3]); }
                s = wave_sum(s, F.lane); if (F.lane < 16) SSQ[(size_t)row * 16 + F.lane] = F.lane == 0 ? s : 0.f; }
        }
    }
}

__global__ void __launch_bounds__(NTHR, 2) yoco_fwd(Args args) {
    extern __shared__ __attribute__((aligned(16))) unsigned char lds_raw[];
    Frame F; F.lds = (LAS unsigned char*)lds_raw;
    volatile LAS unsigned* MISC = (volatile LAS unsigned*)(F.lds + MISC_OFF);
    F.wave = __builtin_amdgcn_readfirstlane((int)threadIdx.x >> 6); F.lane = lane_id(); F.tid = F.wave * 64 + F.lane;
    F.G = gridDim.x; { const int bx = blockIdx.x; F.vcu = (F.G % 8 == 0) ? (bx % 8) * (F.G / 8) + bx / 8 : bx; }
    for (int u = F.tid; u < (LDS_BYTES - LDSCTL_OFF) / 4; u += NTHR) ((LAS unsigned*)(F.lds + LDSCTL_OFF))[u] = 0u;
    __syncthreads();
    unsigned char* ws = args.ws;
#define WS_LAUNDER() do { F.lane = lane_id(); F.tid = F.wave * 64 + F.lane; asm volatile("" : "+s"(ws), "+s"(bx), "+s"(F.G), "+s"(F.vcu), "+v"(F.tid), "+v"(F.lane)); } while (0)
    const bool single = (args.ph_hi - args.ph_lo) > 1;
    XcdBarrier bar; bar.bar = (unsigned*)(ws + WS_CTL) + CW_BAR; bar.x = 0; bar.st = nullptr; bar.wv = F.wave;
    if (single) bar = xcd_barrier_post((unsigned*)(ws + WS_CTL) + CW_BAR, MISC + 8, F.wave);
    if (single && F.wave == 0 && lane_id() == 0) __hip_atomic_store((unsigned*)(ws + WS_CTL) + CW_BAR + XB_CHK + (int)blockIdx.x, bar.x + 1u, __ATOMIC_RELAXED, __HIP_MEMORY_SCOPE_AGENT);
    const int lo = args.ph_lo, hi = args.ph_hi;
    bool local_ok = false;
#ifndef GU_ALIGN
#define GU_ALIGN true
#endif
#ifndef EN_MASK
#define EN_MASK 0xFFFFFFFFu
#endif
#define EN(b) (((EN_MASK) >> (b)) & 1u)
#define IN(k) (lo <= (k) && (k) < hi)
#define B_WARM_ISSUE(BT, N_, K_) unsigned w0_ = 0u, w1_ = 0u; do { pg8::StaticOrder sw_; sw_.init(MT, (N_), F.G, bx); pg8::Unit wu_; if (sw_.next(0, wu_)) { \
        const unsigned char* wb_ = (const unsigned char*)((BT) + (size_t)wu_.pn * 256 * (K_)) + (size_t)(F.tid >> 1) * (K_) * 2 + (F.tid & 1) * 256; \
        asm volatile("global_load_dword %0, %2, off\n\tglobal_load_dword %1, %2, off offset:128" : "=&v"(w0_), "=&v"(w1_) : "v"(wb_) : "memory"); } } while (0)
#define B_WARM_RETIRE() do { asm volatile("s_waitcnt vmcnt(0)" ::: "memory"); asm volatile("" :: "v"(w0_), "v"(w1_)); } while (0)
#define PU_TAIL(NWG) do { WS_LAUNDER(); const int r_ = (NWG) % F.G, ni_ = r_ ? F.G - r_ : F.G; \
        pg8::Gemm g2{(const bf16_t*)(ws + WS_PB) + (size_t)l * MT * 256, (const bf16_t*)(ws + W_PU) + (size_t)l * 1024 * 256, MT, 1024, 256}; \
        pg8::StaticOrder S2; S2.init(MT, 1024, ni_, bx >= r_ ? bx - r_ : (1 << 24)); \
        pg8::EpiScale E2{(bf16_t*)(ws + WS_U) + (size_t)l * MT * DMODEL, 1024, pg8::RowScale{nullptr, 0}, 1.0f}; \
        pg8::gemm_phase<pg8::EpiScale, pg8::StaticOrder, true, true>(ring, g2, S2, E2, F.wave); } while (0)
#ifdef REP_MASK
#define NREPS(k) ((((unsigned long long)(REP_MASK) >> (k)) & 1ull) ? (REP_N) + 1 : 1)
#else
#define NREPS(k) 1
#endif
#define REPLOOP(k) for (int rep_ = 0, nrep_ = NREPS(k); rep_ < nrep_; ++rep_)
#define DUMMY (rep_ + 1 < nrep_)
#define OUT_HB(set) (DUMMY ? (bf16_t*)(ws + WS_END + 66 * MiB) : (bf16_t*)(ws + WS_HB) + (size_t)(set) * MT * DMODEL)
#define OUT_SSQ(set) (DUMMY ? (float*)(ws + WS_END + 99 * MiB) : (float*)(ws + WS_SSQ) + (size_t)(set) * MT * 16)
#define SEAM(k) do { if (single && (k) + 1 < hi) { XcdBarrier b_ = bar; asm volatile("" : "+s"(b_.bar), "+s"(b_.x)); xcd_barrier(b_); } } while (0)
#define SEAM_L(k) do { if (single && (k) + 1 < hi) { XcdBarrier b_ = bar; asm volatile("" : "+s"(b_.bar), "+s"(b_.x)); if (local_ok) xcd_local_barrier(b_); else xcd_barrier(b_); } } while (0)

    LAS unsigned char* ring = F.lds + RING_OFF;
    int bx = (int)blockIdx.x;

    if (EN(0) && IN(0)) REPLOOP(0) { WS_LAUNDER(); prologue(args, F); SEAM(0); }
#ifndef NO_LOCAL_SEAMS
    if (single && lo == 0 && hi > 1) {
        const int t_ = F.wave * 64 + lane_id(); unsigned* chk = (unsigned*)(ws + WS_CTL) + CW_BAR + XB_CHK;
        int good = (F.G == 256);
        if (good && t_ < 256) { const unsigned a = __hip_atomic_load(chk + t_, __ATOMIC_RELAXED, __HIP_MEMORY_SCOPE_AGENT), r = __hip_atomic_load(chk + (t_ & 7), __ATOMIC_RELAXED, __HIP_MEMORY_SCOPE_AGENT); good = (a != 0u && a == r); }
        local_ok = __syncthreads_and(good) != 0;
    }
#endif
#ifdef EXTRA_BARRIERS
    if (single) for (int xb_ = 0; xb_ < EXTRA_BARRIERS; ++xb_) { XcdBarrier b_ = bar; asm volatile("" : "+s"(b_.bar), "+s"(b_.x)); xcd_barrier(b_); }
#endif
#pragma unroll 1
    for (int l = 0; l < 4; ++l) {
        const int base = 2 + PH_PER_LAYER * l; const bool is_mla = l < 2, is_moe = (l & 1) != 0; const int cur = l & 1, j = l & 1;
#define HBc ((const bf16_t*)(ws + WS_HB) + (size_t)cur * MT * DMODEL)
#define HBw ((bf16_t*)(ws + WS_HB) + (size_t)cur * MT * DMODEL)
#define SSQc ((float*)(ws + WS_SSQ) + (size_t)cur * MT * 16)
        if (IN(base + 0)) REPLOOP(base + 0) { WS_LAUNDER();
            if (EN(2) && is_mla) {
                pg8::Gemm g{HBc, (const bf16_t*)(ws + W_AIN) + (size_t)l * 768 * 1024, MT, 768, 1024};
                pg8::StaticOrder S; S.init(MT, 768, F.G, bx);
                pg8::EpiAin E{(bf16_t*)(ws + X_AQ), (bf16_t*)(ws + X_AKV), (float*)(ws + WS_KPE), (float*)(ws + WS_SSQQ), (float*)(ws + WS_SSQKV), pg8::RowScale{SSQc, 1}, args.in[10] + l * 96, (const float*)(ws + WS_CS), (float*)(ws + WS_SSPE)};
                pg8::gemm_phase<pg8::EpiAin, pg8::StaticOrder, true, true>(ring, g, S, E, F.wave);
            } else if (EN(3) && !is_mla) {
                pg8::Gemm g{HBc, (const bf16_t*)(ws + W_QB) + (size_t)j * 1024 * 1024, MT, 1024, 1024};
                pg8::StaticOrder S; S.init(MT, 1024, F.G, bx);
                pg8::EpiScale E{(bf16_t*)(ws + X_SQ), 1024, pg8::RowScale{SSQc, 1}, QSCALE_SB};
                pg8::gemm_phase<pg8::EpiScale, pg8::StaticOrder, true, true>(ring, g, S, E, F.wave);
                asm volatile("s_waitcnt vmcnt(0)" ::: "memory"); __syncthreads();
                __builtin_amdgcn_fence(__ATOMIC_ACQUIRE, "agent"); asm volatile("s_waitcnt vmcnt(0)" ::: "memory");
                WS_LAUNDER();
                pg8::StaticOrder S2; S2.init(MT, 1024, F.G, bx); pg8::Unit uu;
                for (int ui = 0; S2.next(ui, uu); ++ui)
                    for (int i4 = 0; i4 < 4; ++i4) {
#ifdef SBA_ABL
                        if (DUMMY) att::sba::unit<SBA_ABL>(uu.pm >> 5, uu.pn, (uu.pm & 31) * 4 + i4, (const bf16_t*)(ws + X_SQ), (const bf16_t*)(ws + WS_SKT), (const bf16_t*)(ws + WS_SVT), (bf16_t*)(ws + WS_END + 66 * MiB), ring, F.wave); else
#endif
                        att::sba::unit<0>(uu.pm >> 5, uu.pn, (uu.pm & 31) * 4 + i4, (const bf16_t*)(ws + X_SQ), (const bf16_t*)(ws + WS_SKT), (const bf16_t*)(ws + WS_SVT), (bf16_t*)(ws + X_SO), ring, F.wave); }
            }
            SEAM_L(base + 0);
        }
        if (EN(4) && is_mla && IN(base + 1)) REPLOOP(base + 1) { WS_LAUNDER();
            { pg8::Gemm g{(const bf16_t*)(ws + X_AQ), (const bf16_t*)(ws + W_QUP) + (size_t)l * 1024 * 384, MT, 1024, 384};
              pg8::StaticOrder S; S.init(MT, 1024, F.G, bx);
              EpiQ E{ws, args.in[9] + l * 96};
              pg8::gemm_phase<EpiQ, pg8::StaticOrder, true, true, false, true>(ring, g, S, E, F.wave); }
            { pg8::Gemm g{(const bf16_t*)(ws + X_AKV), (const bf16_t*)(ws + W_KVUP) + (size_t)l * 1024 * 256, MT, 1024, 256};
              pg8::StaticOrder S; S.init(MT, 1024, F.G, bx);
              EpiKV E{ws, args.in[10] + l * 96};
              pg8::gemm_phase<EpiKV, pg8::StaticOrder, true, true, false, true>(ring, g, S, E, F.wave); }
            SEAM(base + 1);
        }
        if (is_mla && IN(base + 3)) REPLOOP(base + 3) { WS_LAUNDER();
#if defined(MLA_ABL)
            if (EN(6) && is_mla && DUMMY) att::mla::phase<MLA_ABL>(F.vcu, F.G, (const bf16_t*)(ws + X_Q), (const bf16_t*)(ws + X_KT), (const bf16_t*)(ws + X_VT), (bf16_t*)(ws + WS_END + 66 * MiB), ring, F.wave);
            else
#endif
            if (EN(6) && is_mla) att::mla::phase<0>(F.vcu, F.G, (const bf16_t*)(ws + X_Q), (const bf16_t*)(ws + X_KT), (const bf16_t*)(ws + X_VT), (bf16_t*)(ws + X_O), ring, F.wave);
            SEAM(base + 3);
        }
        if (EN(8) && IN(base + 4)) REPLOOP(base + 4) { WS_LAUNDER();
            pg8::Gemm g = is_mla ? pg8::Gemm{(const bf16_t*)(ws + X_O), (const bf16_t*)(ws + W_AOUT) + (size_t)l * 1024 * 512, MT, 1024, 512}
                                 : pg8::Gemm{(const bf16_t*)(ws + X_SO), (const bf16_t*)(ws + W_OB) + (size_t)j * 1024 * 1024, MT, 1024, 1024};
            pg8::StaticOrder S; S.init(MT, 1024, F.G, bx);
            pg8::EpiRes<false> E{HBc, OUT_HB(cur), OUT_SSQ(cur), nullptr, pg8::RowScale{nullptr, 0}, nullptr, 1.0f};
            pg8::gemm_phase<pg8::EpiRes<false>, pg8::StaticOrder, true, true>(ring, g, S, E, F.wave);
            SEAM_L(base + 4);
        }
        if (!is_moe) {
            if (EN(9) && IN(base + 5)) REPLOOP(base + 5) { WS_LAUNDER();
                pg8::Gemm g{HBc, (const bf16_t*)(ws + W_FGU) + (size_t)(l >> 1) * 5632 * 1024, MT, 5632, 1024};
                pg8::GroupOrder S; S.init_dense(MT, 5632, F.G, bx);
                pg8::EpiSwiglu E{(bf16_t*)(ws + X_HID), pg8::RowScale{SSQc, 1}, 0, FP8_FDN, 1.0f};
                pg8::gemm_phase<pg8::EpiSwiglu, pg8::GroupOrder, GU_ALIGN, true>(ring, g, S, E, F.wave);
                PU_TAIL((MT / 256) * 22);
#if FILL_A + FILL_D > 0
                filler(args, F, l == 0 ? 0 : 3, l == 0 ? 0 : DEF_QC, l == 0 ? DEF_QA : DEF_QD);
#endif
                SEAM_L(base + 5);
            }
            if (EN(10) && IN(base + 6)) REPLOOP(base + 6) { WS_LAUNDER();
                pg8::Gemm g{(const bf16_t*)(ws + X_HID), (const bf16_t*)(ws + W_FDN) + (size_t)(l >> 1) * 1024 * 2816, MT, 1024, FP8_FDN ? 1408 : 2816};
                pg8::StaticOrder S; S.init(MT, 1024, F.G, bx);
                pg8::EpiRes<false> E{HBc, OUT_HB(cur), OUT_SSQ(cur), nullptr, pg8::RowScale{nullptr, 0}, nullptr, FP8_FDN ? 1.0f / 64.0f : 1.0f};
                pg8::gemm_phase<pg8::EpiRes<false>, pg8::StaticOrder, true, true, FP8_FDN != 0>(ring, g, S, E, F.wave);
                B_WARM_ISSUE((const bf16_t*)(ws + W_PG) + (size_t)l * 1024 * 1024, 1024, 1024);
                SEAM_L(base + 6);
                B_WARM_RETIRE();
            }
        } else {
            if (EN(11) && IN(base + 5)) REPLOOP(base + 5) { WS_LAUNDER(); moe_route(args, F, l, cur); SEAM(base + 5); }
            if (EN(12) && IN(base + 6)) REPLOOP(base + 6) { WS_LAUNDER(); moe_scatter(args, F, cur); SEAM(base + 6); }
            if (EN(13) && IN(base + 7)) REPLOOP(base + 7) { WS_LAUNDER();
                pg8::Gemm g{(const bf16_t*)(ws + X_XG), (const bf16_t*)(ws + W_EGU) + (size_t)(l >> 1) * 8 * 5632 * 1024, MAXSLOT, 5632, FP8_EGU ? 512 : 1024};
                pg8::GroupOrder S; S.init((const int*)(ws + WS_PSTART), 5632, F.G, bx, (size_t)5632 * 1024 * 2);
                #ifndef EPI_ABL
#define EPI_ABL 0
#endif
                pg8::EpiSwiglu E{(bf16_t*)(ws + X_HG), FP8_EGU ? pg8::RowScale{nullptr, 0} : pg8::RowScale{(const float*)(ws + WS_SLOTRS), 2}, DUMMY ? EPI_ABL : 0, FP8_EDN, FP8_EGU ? 1.0f / 32.0f : 1.0f};
                pg8::gemm_phase<pg8::EpiSwiglu, pg8::GroupOrder, GU_ALIGN, true, FP8_EGU != 0>(ring, g, S, E, F.wave);
#if FILL_B > 0
                if (l == 1) filler(args, F, 1, DEF_QA, DEF_QB);
#endif
                SEAM(base + 7);
            }
            if (EN(14) && IN(base + 8)) REPLOOP(base + 8) { WS_LAUNDER();
                pg8::Gemm g{(const bf16_t*)(ws + X_HG), (const bf16_t*)(ws + W_EDN) + (size_t)(l >> 1) * 8 * 1024 * 2816, MAXSLOT, 1024, FP8_EDN ? 1408 : 2816};
                pg8::GroupOrder S; S.init((const int*)(ws + WS_PSTART), 1024, F.G, bx, (size_t)1024 * 2816 * 2);
                pg8::EpiScale E{(bf16_t*)(ws + X_YG), 1024, pg8::RowScale{nullptr, 0}, FP8_EDN ? 1.0f / 64.0f : 1.0f};
                pg8::gemm_phase<pg8::EpiScale, pg8::GroupOrder, true, true, FP8_EDN != 0>(ring, g, S, E, F.wave);
                { const int nwg_e = __builtin_amdgcn_readfirstlane(((const int*)(ws + WS_PSTART))[8]) * 4; PU_TAIL(nwg_e); }
#if FILL_C > 0
                if (l == 1) filler(args, F, 2, DEF_QB, DEF_QC);
#endif
                SEAM(base + 8);
            }
            if (EN(15) && IN(base + 9)) REPLOOP(base + 9) { WS_LAUNDER(); moe_combine(args, F, cur, DUMMY); B_WARM_ISSUE((const bf16_t*)(ws + W_PG) + (size_t)l * 1024 * 1024, 1024, 1024); SEAM_L(base + 9); B_WARM_RETIRE(); }
        }
        if (EN(16) && IN(base + 10)) REPLOOP(base + 10) { WS_LAUNDER();
            pg8::Gemm g{HBc, (const bf16_t*)(ws + W_PG) + (size_t)l * 1024 * 1024, MT, 1024, 1024};
            pg8::StaticOrder S; S.init(MT, 1024, F.G, bx);
            pg8::EpiRes<true> E{HBc, OUT_HB(cur ^ 1), OUT_SSQ(cur ^ 1),
                                (const bf16_t*)(ws + WS_U) + (size_t)l * MT * DMODEL, pg8::RowScale{SSQc, 1}, (l == 3 && !DUMMY) ? args.out : nullptr, 1.0f};
            pg8::gemm_phase<pg8::EpiRes<true>, pg8::StaticOrder, true, true>(ring, g, S, E, F.wave);
            if (l == 3) SEAM(base + 10); else SEAM_L(base + 10);
        }
        if (EN(17) && l == 1 && IN(base + 11)) REPLOOP(base + 11) { WS_LAUNDER();
            pg8::Gemm g{(const bf16_t*)(ws + WS_HB) + (size_t)(cur ^ 1) * MT * DMODEL, (const bf16_t*)(ws + W_KVS), MT, 512, 1024};
            pg8::StaticOrder S; S.init(MT, 512, F.G, bx);
            pg8::EpiKvs E{(bf16_t*)(ws + WS_SKT), (bf16_t*)(ws + WS_SVT), pg8::RowScale{(const float*)(ws + WS_SSQ) + (size_t)(cur ^ 1) * MT * 16, 1}};
            pg8::gemm_phase<pg8::EpiKvs, pg8::StaticOrder, true, true>(ring, g, S, E, F.wave);
            SEAM(base + 11);
        }
    }
#undef IN
#undef SEAM
}
}
#define MULTI_LAUNCH 0
extern "C" void kernel_launch(void* const* d_in, const int* in_sizes, int n_in, void* d_out, int out_size, void* d_ws, size_t ws_size, hipStream_t stream) {
    using namespace fw;
    static int grid = 0;
    if (grid == 0) {
        if (n_in != 26 || out_size != MT * DMODEL || ws_size < WS_NEED) { fprintf(stderr, "kernel_launch: unexpected n_in %d / out %d / ws %zu\n", n_in, out_size, ws_size); grid = -1; return; }
        if (hipFuncSetAttribute((const void*)yoco_fwd, hipFuncAttributeMaxDynamicSharedMemorySize, LDS_BYTES) != hipSuccess) { fprintf(stderr, "kernel_launch: hipFuncSetAttribute failed\n"); grid = -1; return; }
        int dev = 0, cus = 0, per_cu = 0;
        (void)hipGetDevice(&dev); (void)hipDeviceGetAttribute(&cus, hipDeviceAttributeMultiprocessorCount, dev);
        (void)hipOccupancyMaxActiveBlocksPerMultiprocessor(&per_cu, (const void*)yoco_fwd, NTHR, LDS_BYTES);
        (void)hipGetLastError();
        grid = (cus > 0 && per_cu >= 1) ? cus : 256;
        if (grid > 256) grid = 256;
    }
    if (grid < 0) return;
    (void)hipMemsetAsync((unsigned char*)d_ws + WS_CTL, 0, CTL_ZERO_BYTES, stream);
    Args a{};
    for (int i = 0; i < 26; ++i) a.in[i] = (const float*)d_in[i];
    a.out = (float*)d_out; a.ws = (unsigned char*)d_ws;
#if MULTI_LAUNCH
    for (int k = 0; k < PH_TOTAL; ++k) { if (!phase_active(k)) continue; a.ph_lo = k; a.ph_hi = k + 1; hipLaunchKernelGGL(yoco_fwd, dim3(grid), dim3(NTHR), LDS_BYTES, stream, a); }
#else
#ifdef PROBE_MASK
    a.ph_lo = 0; a.ph_hi = PH_TOTAL;
#else
    a.ph_lo = 0; a.ph_hi = PH_TOTAL - 1;
#endif
    hipLaunchKernelGGL(yoco_fwd, dim3(grid), dim3(NTHR), LDS_BYTES, stream, a);
#endif
}
```

```cpp
#include <hip/hip_runtime.h>
#include <cstdio>
#include <cstdint>
#include <cmath>
#define LAS __attribute__((address_space(3)))
#define GAS __attribute__((address_space(1)))
typedef unsigned short bf16_t;
typedef short bf16x8 __attribute__((ext_vector_type(8)));
typedef float f32x4 __attribute__((ext_vector_type(4)));
typedef float f32x2 __attribute__((ext_vector_type(2)));
typedef float f32x16 __attribute__((ext_vector_type(16)));
typedef unsigned u32x4 __attribute__((ext_vector_type(4)));
typedef unsigned u32x2 __attribute__((ext_vector_type(2)));
typedef short s16x4 __attribute__((ext_vector_type(4)));
typedef __bf16 bf16x2_t __attribute__((ext_vector_type(2)));

constexpr int MT = 16384, DMODEL = 1024, SEQL = 8192;
constexpr float RMS_EPS = 1e-6f;
constexpr float LOG2E = 1.4426950408889634f;

__device__ __forceinline__ unsigned pk_bf16(float lo, float hi) { f32x2 v = {lo, hi}; bf16x2_t b = __builtin_convertvector(v, bf16x2_t); return __builtin_bit_cast(unsigned, b); }
__device__ __forceinline__ float bf_lo(unsigned w) { return __uint_as_float(w << 16); }
__device__ __forceinline__ float bf_hi(unsigned w) { return __uint_as_float(w & 0xffff0000u); }
__device__ __forceinline__ unsigned cvt_pk_bf16(float lo, float hi) { unsigned r; asm volatile("v_cvt_pk_bf16_f32 %0, %1, %2" : "=v"(r) : "v"(lo), "v"(hi)); return r; }
__device__ __forceinline__ u32x4 pack8(const f32x4 a, const f32x4 b) { u32x4 w; w.x = cvt_pk_bf16(a[0], a[1]); w.y = cvt_pk_bf16(a[2], a[3]); w.z = cvt_pk_bf16(b[0], b[1]); w.w = cvt_pk_bf16(b[2], b[3]); return w; }
__device__ __forceinline__ u32x2 pack8_fp8(const f32x4 a, const f32x4 b) {
    u32x2 w; int lo = 0, hi = 0;
    lo = __builtin_amdgcn_cvt_pk_fp8_f32(__builtin_amdgcn_fmed3f(a[0], -448.f, 448.f), __builtin_amdgcn_fmed3f(a[1], -448.f, 448.f), lo, false); lo = __builtin_amdgcn_cvt_pk_fp8_f32(__builtin_amdgcn_fmed3f(a[2], -448.f, 448.f), __builtin_amdgcn_fmed3f(a[3], -448.f, 448.f), lo, true);
    hi = __builtin_amdgcn_cvt_pk_fp8_f32(__builtin_amdgcn_fmed3f(b[0], -448.f, 448.f), __builtin_amdgcn_fmed3f(b[1], -448.f, 448.f), hi, false); hi = __builtin_amdgcn_cvt_pk_fp8_f32(__builtin_amdgcn_fmed3f(b[2], -448.f, 448.f), __builtin_amdgcn_fmed3f(b[3], -448.f, 448.f), hi, true);
    w.x = (unsigned)lo; w.y = (unsigned)hi; return w; }
__device__ __forceinline__ void unpack8(const u32x4 w, f32x4& a, f32x4& b) { a = (f32x4){bf_lo(w.x), bf_hi(w.x), bf_lo(w.y), bf_hi(w.y)}; b = (f32x4){bf_lo(w.z), bf_hi(w.z), bf_lo(w.w), bf_hi(w.w)}; }
__device__ __forceinline__ float fast_rcp(float x) { return __builtin_amdgcn_rcpf(x); }
__device__ __forceinline__ float fast_rsq(float x) { return __builtin_amdgcn_rsqf(x); }
__device__ __forceinline__ float fast_exp2(float x) { return __builtin_amdgcn_exp2f(x); }
__device__ __forceinline__ float fast_log2(float x) { return __builtin_amdgcn_logf(x); }
__device__ __forceinline__ int lane_id() { int l; asm volatile("v_mbcnt_lo_u32_b32 %0, -1, 0\n\tv_mbcnt_hi_u32_b32 %0, -1, %0" : "=v"(l)); return l; }
__device__ __forceinline__ float sigmoidf_(float x) { return fast_rcp(1.0f + fast_exp2(-x * LOG2E)); }
__device__ __forceinline__ f32x4 sigmoid4s(const f32x4 a, float nsl, float ic) { const f32x4 t = a * nsl; f32x4 e = {fast_exp2(t[0]), fast_exp2(t[1]), fast_exp2(t[2]), fast_exp2(t[3])}; e = e * ic + ic; return (f32x4){fast_rcp(e[0]), fast_rcp(e[1]), fast_rcp(e[2]), fast_rcp(e[3])}; }
__device__ __forceinline__ f32x4 sigmoid4(const f32x4 a, float nsl) { const f32x4 t = a * nsl; f32x4 e = {fast_exp2(t[0]), fast_exp2(t[1]), fast_exp2(t[2]), fast_exp2(t[3])}; e = e + 1.0f; return (f32x4){fast_rcp(e[0]), fast_rcp(e[1]), fast_rcp(e[2]), fast_rcp(e[3])}; }

#ifndef GROUP_WGM
#define GROUP_WGM 8
#endif
namespace pg8 {
constexpr int BM = 256, BK = 64, HALF = 128, HTB = HALF * BK * 2, STAGE_BYTES = 8 * HTB, NXCD = 8, WGM = 8;
__host__ __device__ __forceinline__ int lds_byte(int r, int c) { const int st = (r >> 4) * 2 + (c >> 5), rr = r & 15, cc = c & 31, ob = rr * 64 + cc * 2; return st * 1024 + (ob ^ (((ob >> 9) & 1) << 5)); }
__host__ __device__ __forceinline__ void stage_rc(int b, int& R, int& C) { const int st = b / 1024, sb = b % 1024, swz = sb ^ (((sb >> 9) & 1) << 5); R = (st >> 1) * 16 + swz / 64; C = (st & 1) * 32 + (swz % 64) / 2; }
__host__ __device__ __forceinline__ int perm32(int rho) { const int n = rho >> 4, i = rho & 15; return 8 * (i >> 2) + 4 * n + (i & 3); }

struct Unit { int pm, pn; size_t boff; };
struct Gemm { const bf16_t* A; const bf16_t* Bt; int M, N, K; };

struct StaticOrder {
    int nM, nN, nwg, G, c;
    __device__ __forceinline__ void init(int M, int N, int G_, int c_) { nM = M / BM; nN = N / BM; nwg = nM * nN; G = G_; c = c_; }
    __device__ __forceinline__ bool next(int i, Unit& u) const {
        const long L = (long)i * G + c; if (L >= nwg) return false;
        int wgid = (int)L; { const int q = nwg / NXCD, r = nwg % NXCD, xcd = wgid % NXCD, off = wgid / NXCD; wgid = (xcd < r ? xcd * (q + 1) : r * (q + 1) + (xcd - r) * q) + off; }
        const int nig = WGM * nN, gid = wgid / nig, fm = gid * WGM, gsz = (nM - fm) < WGM ? (nM - fm) : WGM;
        u.pm = fm + ((wgid % nig) % gsz); u.pn = (wgid % nig) / gsz; u.boff = 0; return true;
    }
};
struct GroupOrder {
    int ps[9]; int nN, nwg, G, c; size_t estride;
    __device__ __forceinline__ void init(const int* pstart, int N, int G_, int c_, size_t estride_) {
#pragma unroll
        for (int e = 0; e < 9; ++e) ps[e] = __builtin_amdgcn_readfirstlane(pstart[e]);
        nN = N / BM; nwg = ps[8] * nN; G = G_; c = c_; estride = estride_; }
    __device__ __forceinline__ void init_dense(int M, int N, int G_, int c_) {
        ps[0] = 0;
#pragma unroll
        for (int e = 1; e < 9; ++e) ps[e] = M / BM;
        nN = N / BM; nwg = ps[8] * nN; G = G_; c = c_; estride = 0; }
    __device__ __forceinline__ bool next(int i, Unit& u) const {
        const long L = (long)i * G + c; if (L >= nwg) return false;
        int wgid = (int)L; { const int q = nwg / NXCD, r = nwg % NXCD, xcd = wgid % NXCD, off = wgid / NXCD; wgid = (xcd < r ? xcd * (q + 1) : r * (q + 1) + (xcd - r) * q) + off; }
        int e = 0;
#pragma unroll
        for (int k = 1; k < 8; ++k) if (wgid >= ps[k] * nN) e = k;
        int p0 = ps[0], p1 = ps[1];
#pragma unroll
        for (int k = 1; k < 8; ++k) if (e == k) { p0 = ps[k]; p1 = ps[k + 1]; }
        const int local = wgid - p0 * nN, np = p1 - p0;
        constexpr int GW = GROUP_WGM;
        const int nig = GW * nN, gid = local / nig, fm = gid * GW, gsz = (np - fm) < GW ? (np - fm) : GW;
        u.pm = p0 + fm + ((local % nig) % gsz); u.pn = (local % nig) / gsz; u.boff = (size_t)e * estride; return true;
    }
};


__device__ __forceinline__ float sumsq8(const f32x4 a, const f32x4 b) { return ((a[0] * a[0] + a[1] * a[1]) + (a[2] * a[2] + a[3] * a[3])) + ((b[0] * b[0] + b[1] * b[1]) + (b[2] * b[2] + b[3] * b[3])); }
__device__ __forceinline__ float red_fq(float s) {
    { auto rr = __builtin_amdgcn_permlane16_swap(__float_as_uint(s), __float_as_uint(s), false, false); s = __uint_as_float(rr[0]) + __uint_as_float(rr[1]); }
    { auto rr = __builtin_amdgcn_permlane32_swap(__float_as_uint(s), __float_as_uint(s), false, false); s = __uint_as_float(rr[0]) + __uint_as_float(rr[1]); }
    return s; }
__device__ __forceinline__ float xor32(float v, int upper) {
    auto rr = __builtin_amdgcn_permlane32_swap(__float_as_uint(v), __float_as_uint(v), false, false); return __uint_as_float(upper ? rr[0] : rr[1]); }
struct RowScale {
    const float* p; int mode;
    __device__ __forceinline__ float get(int row, int fq) const {
        if (mode == 0) return 1.0f;
        if (mode == 2) return p[row];
        if (mode == 1) { const f32x4 a = *(const f32x4*)(p + (size_t)row * 16 + 4 * fq); const float s = red_fq((a[0] + a[1]) + (a[2] + a[3])); return fast_rsq(s * (1.0f / 1024.0f) + RMS_EPS); }
        if (mode == 3) { const f32x4 a = *(const f32x4*)(p + (size_t)row * 8 + 4 * (fq & 1)); const float s = red_fq(fq < 2 ? (a[0] + a[1]) + (a[2] + a[3]) : 0.f); return fast_rsq(s * (1.0f / 384.0f) + RMS_EPS); }
        { const float s = red_fq(p[(size_t)row * 4 + fq]); return fast_rsq(s * (1.0f / 256.0f) + RMS_EPS); }
    }
    __device__ __forceinline__ void get8(float (&rsv)[2][4], int row0, int fq) const {
#pragma unroll
        for (int ai = 0; ai < 2; ++ai)
#pragma unroll
            for (int m = 0; m < 4; ++m) rsv[ai][m] = get(row0 + ai * 128 + m * 16, fq);
        asm volatile("" ::: "memory");
    }
};

struct EpiScale {
    static constexpr bool PERM = true, AFTER_DRAIN = false;
    bf16_t* O; int ldc; RowScale rs; float cs;
    __device__ __forceinline__ void operator()(const f32x4 (&acc)[2][2][4][2], const Unit& u, int wr, int wc, int fr_, int fq_) const {
        const int ln_ = lane_id(), fr = ln_ & 15, fq = ln_ >> 4; (void)fr_; (void)fq_;
        const int row0 = u.pm * BM + wr * 64 + fr, col0 = u.pn * BM + wc * 32 + 8 * fq;
        float rsv[2][4]; rs.get8(rsv, row0, fq);
#pragma unroll
        for (int ai = 0; ai < 2; ++ai)
#pragma unroll
            for (int m = 0; m < 4; ++m) { const int row = row0 + ai * HALF + m * 16; const float s = rsv[ai][m] * cs; bf16_t* rowp = O + (size_t)row * ldc + col0;
#pragma unroll
                for (int bj = 0; bj < 2; ++bj) *(u32x4*)(rowp + bj * HALF) = pack8(acc[ai][bj][m][0] * s, acc[ai][bj][m][1] * s); }
    }
};
__device__ __forceinline__ void rope8(f32x4& v0, f32x4& v1, const float* cs_row, int fq) {
    f32x4 p0, p1;
#pragma unroll
    for (int j = 0; j < 4; ++j) { p0[j] = xor32(v0[j], fq >> 1); p1[j] = xor32(v1[j], fq >> 1); }
    const int f0 = 8 * (fq & 1);
    const f32x4 c0 = *(const f32x4*)(cs_row + f0), c1 = *(const f32x4*)(cs_row + f0 + 4), s0 = *(const f32x4*)(cs_row + 16 + f0), s1 = *(const f32x4*)(cs_row + 16 + f0 + 4);
    if (fq < 2) { v0 = v0 * c0 - p0 * s0; v1 = v1 * c1 - p1 * s1; } else { v0 = v0 * c0 + p0 * s0; v1 = v1 * c1 + p1 * s1; }
}
__device__ __forceinline__ void rope8_ld(f32x4 (&cs4)[4], const float* cs_row, int fq) { const int f0 = 8 * (fq & 1);
    cs4[0] = *(const f32x4*)(cs_row + f0); cs4[1] = *(const f32x4*)(cs_row + f0 + 4); cs4[2] = *(const f32x4*)(cs_row + 16 + f0); cs4[3] = *(const f32x4*)(cs_row + 16 + f0 + 4); }
__device__ __forceinline__ void rope8_p(f32x4& v0, f32x4& v1, const f32x4 (&cs4)[4], int fq) {
    f32x4 p0, p1;
#pragma unroll
    for (int j = 0; j < 4; ++j) { p0[j] = xor32(v0[j], fq >> 1); p1[j] = xor32(v1[j], fq >> 1); }
    if (fq < 2) { v0 = v0 * cs4[0] - p0 * cs4[2]; v1 = v1 * cs4[1] - p1 * cs4[3]; } else { v0 = v0 * cs4[0] + p0 * cs4[2]; v1 = v1 * cs4[1] + p1 * cs4[3]; }
}
struct EpiAin {
    static constexpr bool PERM = true, AFTER_DRAIN = false;
    bf16_t* AQ; bf16_t* AKV; float* KPE; float* SSQQ; float* SSQKV; RowScale rs; const float* gk; const float* CS; float* SSPE;
    __device__ __forceinline__ void operator()(const f32x4 (&acc)[2][2][4][2], const Unit& u, int wr, int wc, int fr_, int fq_) const {
        const int ln_ = lane_id(), fr = ln_ & 15, fq = ln_ >> 4; (void)fr_; (void)fq_;
        const int row0 = u.pm * BM + wr * 64 + fr, c8 = wc * 32 + 8 * fq;
        float rsv[2][4]; rs.get8(rsv, row0, fq);
#pragma unroll
        for (int ai = 0; ai < 2; ++ai)
#pragma unroll
            for (int m = 0; m < 4; ++m) { const int row = row0 + ai * HALF + m * 16; const float s = rsv[ai][m];
                const f32x4 a0 = acc[ai][0][m][0] * s, a1 = acc[ai][0][m][1] * s, b0 = acc[ai][1][m][0] * s, b1 = acc[ai][1][m][1] * s;
                if (u.pn == 0) {
                    *(u32x4*)(AQ + (size_t)row * 384 + c8) = pack8(a0, a1); *(u32x4*)(AQ + (size_t)row * 384 + 128 + c8) = pack8(b0, b1);
                    const float q = red_fq(sumsq8(a0, a1) + sumsq8(b0, b1)); if (fq == 0) SSQQ[(size_t)row * 8 + wc] = q;
                } else if (u.pn == 1) {
                    *(u32x4*)(AQ + (size_t)row * 384 + 256 + c8) = pack8(a0, a1);
                    const float q = red_fq(sumsq8(a0, a1)); if (fq == 0) SSQQ[(size_t)row * 8 + 4 + wc] = q;
                    if (wc == 0) { const float qp = red_fq(sumsq8(b0, b1)); if (fq == 0) SSPE[row] = qp;
                        f32x4 y0 = b0 * *(const f32x4*)(gk + 64 + 8 * fq), y1 = b1 * *(const f32x4*)(gk + 64 + 8 * fq + 4); rope8(y0, y1, CS + (size_t)row * 32, fq);
                        *(f32x4*)(KPE + (size_t)row * 32 + 8 * fq) = y0; *(f32x4*)(KPE + (size_t)row * 32 + 8 * fq + 4) = y1; }
                } else {
                    *(u32x4*)(AKV + (size_t)row * 256 + c8) = pack8(a0, a1); *(u32x4*)(AKV + (size_t)row * 256 + 128 + c8) = pack8(b0, b1);
                    const float q = red_fq(sumsq8(a0, a1) + sumsq8(b0, b1)); if (fq == 0) SSQKV[(size_t)row * 4 + wc] = q;
                } }
    }
};
struct EpiSwiglu {
    static constexpr bool PERM = true, AFTER_DRAIN = false;
    bf16_t* HID; RowScale rs; int abl; int f8; float cs;
    __device__ __forceinline__ void operator()(const f32x4 (&acc)[2][2][4][2], const Unit& u, int wr, int wc, int fr_, int fq_) const {
        if (abl == 1) return;
        const int ln_ = lane_id(), fr = ln_ & 15, fq = ln_ >> 4; (void)fr_; (void)fq_;
        const int row0 = u.pm * BM + wr * 64 + fr, col0 = u.pn * 128 + wc * 32 + 8 * fq;
        float rsv[2][4]; rs.get8(rsv, row0, fq);
#pragma unroll
        for (int ai = 0; ai < 2; ++ai)
#pragma unroll
            for (int m = 0; m < 4; ++m) { const int row = row0 + ai * HALF + m * 16; const float s = rsv[ai][m] * cs, is2 = fast_rcp(s * s);
                f32x4 o[2];
#pragma unroll
                for (int n = 0; n < 2; ++n) {
                    const f32x4 gu = acc[ai][0][m][n] * acc[ai][1][m][n];
                    if (abl == 2) o[n] = gu * (s * s); else o[n] = gu * sigmoid4s(acc[ai][0][m][n], -s * LOG2E, is2); }
                if (f8) *(u32x2*)((unsigned char*)HID + (size_t)row * 2816 + col0) = pack8_fp8(o[0], o[1]);
                else *(u32x4*)(HID + (size_t)row * 2816 + col0) = pack8(o[0], o[1]); }
    }
};
template <bool GATED, bool F8COPY = false> struct EpiRes {
    static constexpr bool PERM = true, AFTER_DRAIN = false;
    const bf16_t* HBi; bf16_t* HBo; float* SSQo; const bf16_t* U; RowScale rs; float* OUTF; float ascale;
    __device__ __forceinline__ void operator()(const f32x4 (&acc)[2][2][4][2], const Unit& u, int wr, int wc, int fr_, int fq_) const {
        const int ln_ = lane_id(), fr = ln_ & 15, fq = ln_ >> 4; (void)fr_; (void)fq_;
        const int row0 = u.pm * BM + wr * 64 + fr, col0 = u.pn * BM + wc * 32 + 8 * fq;
        float rsv[2][4]; if (GATED) rs.get8(rsv, row0, fq);
        u32x4 hq[3][2], uq[3][2];
#define EPIRES_LOAD(it_, b_) do { const size_t off_ = (size_t)(row0 + ((it_) >> 2) * HALF + ((it_) & 3) * 16) * DMODEL + col0; \
            hq[b_][0] = *(const u32x4*)(HBi + off_); hq[b_][1] = *(const u32x4*)(HBi + off_ + HALF); \
            if (GATED) { uq[b_][0] = *(const u32x4*)(U + off_); uq[b_][1] = *(const u32x4*)(U + off_ + HALF); } } while (0)
        constexpr int AHEAD = F8COPY ? 0 : GATED ? 1 : 2;
        if (AHEAD >= 1) EPIRES_LOAD(0, 0); if (AHEAD == 2) EPIRES_LOAD(1, 1);
#pragma unroll
        for (int it = 0; it < 8; ++it) { const int ai = it >> 2, m = it & 3, cb = it % (AHEAD + 1); const int row = row0 + ai * HALF + m * 16; const size_t off = (size_t)row * DMODEL + col0;
                if (AHEAD == 0) EPIRES_LOAD(it, 0); else if (it + AHEAD < 8) EPIRES_LOAD(it + AHEAD, (it + AHEAD) % (AHEAD + 1));
                float s = 1.0f; if (GATED) s = rsv[ai][m];
                float q = 0.f;
#pragma unroll
                for (int bj = 0; bj < 2; ++bj) { f32x4 a0 = acc[ai][bj][m][0] * ascale, a1 = acc[ai][bj][m][1] * ascale;
                    f32x4 h0, h1; unpack8(hq[cb][bj], h0, h1);
                    if (GATED) { f32x4 u0, u1; unpack8(uq[cb][bj], u0, u1);
                        a0 = sigmoid4(a0, -s * LOG2E) * u0; a1 = sigmoid4(a1, -s * LOG2E) * u1; }
                    h0 += a0; h1 += a1;
                    const bool fin = GATED && OUTF != nullptr;
                    if (fin) { *(f32x4*)(OUTF + off + bj * HALF) = h0; *(f32x4*)(OUTF + off + bj * HALF + 4) = h1; }
                    if (F8COPY) { u32x2 w8 = pack8_fp8(h0, h1); asm volatile("" : "+v"(w8.x), "+v"(w8.y)); *(u32x2*)((unsigned char*)const_cast<bf16_t*>(U) + (unsigned)(row * DMODEL + col0 + bj * HALF)) = w8; }
                    if (!fin) { *(u32x4*)(HBo + off + bj * HALF) = pack8(h0, h1);
                        q += sumsq8(h0, h1); } }
                if (!(GATED && OUTF != nullptr)) { q = red_fq(q); if (fq == 0) SSQo[(size_t)row * 16 + u.pn * 4 + wc] = q; }
                asm volatile("" ::: "memory"); }
#undef EPIRES_LOAD
    }
};
struct EpiKvs {
    static constexpr bool PERM = true, AFTER_DRAIN = false;
    bf16_t* KT; bf16_t* VT; RowScale rs;
    __device__ __forceinline__ void operator()(const f32x4 (&acc)[2][2][4][2], const Unit& u, int wr, int wc, int fr_, int fq_) const {
        const int ln_ = lane_id(), fr = ln_ & 15, fq = ln_ >> 4; (void)fr_; (void)fq_;
        const int row0 = u.pm * BM + wr * 64 + fr;
        float rsv[2][4]; rs.get8(rsv, row0, fq);
#pragma unroll
        for (int ai = 0; ai < 2; ++ai)
#pragma unroll
            for (int m = 0; m < 4; ++m) { const int row = row0 + ai * HALF + m * 16; const float s = rsv[ai][m];
                const int b = row >> 13, sq = row & 8191, tile = sq >> 6, rr = sq & 63;
#pragma unroll
                for (int bj = 0; bj < 2; ++bj) { const int c = bj * HALF + wc * 32 + 8 * fq, kh = c >> 6, d = c & 63;
                    const size_t tb = (size_t)((b * 4 + kh) * 128 + tile) * 4096;
                    const u32x4 w = pack8(acc[ai][bj][m][0] * s, acc[ai][bj][m][1] * s);
                    if (u.pn == 0) *(u32x4*)(KT + tb + (d >> 3) * 512 + rr * 8) = w;
                    else *(u32x4*)(VT + tb + (d >> 5) * 2048 + rr * 32 + (d & 31)) = w; } }
    }
};

#define PG8_LAS LAS
template <class Epi, class Sched, bool ALIGN_EPI = false, bool SP2 = false, bool MX8 = false, bool SADDR = MX8>
__device__ __forceinline__ void gemm_phase(PG8_LAS unsigned char* lds, const Gemm g, const Sched& S, const Epi& E, int wv  ) {
    int tid_ = wv * 64 + lane_id(); asm volatile("" : "+v"(tid_));
    const int tid = tid_, wid = __builtin_amdgcn_readfirstlane(tid >> 6), lane = tid & 63, wr = wid >> 2, wc = wid & 3, fr = lane & 15, fq = lane >> 4;
    const int K = g.K, nt = K / BK;
    unsigned voffA[2], voffB[2];
#pragma unroll
    for (int i = 0; i < 2; ++i) { int R, C; stage_rc(tid * 16 + i * 8192, R, C); const int Rb = Epi::PERM ? ((R & ~31) + perm32(R & 31)) : R;
        voffA[i] = (unsigned)(R * K + C) * 2u; voffB[i] = (unsigned)(Rb * K + C) * 2u; }
    const size_t kstep = (size_t)(BK * 2);
    const size_t hstep = (size_t)HALF * K * 2;
    const size_t tstep = 2 * hstep;
    const unsigned ldsw = (unsigned)wid * 1024u; const unsigned lds0_ = (unsigned)(uintptr_t)lds; (void)lds0_;
    const int aoff = lds_byte(wr * 64 + fr, fq * 8), boff = lds_byte(wc * 32 + fr, fq * 8);
#define PG8_SA(b, h) (((b) * 2 + (h)) * HTB)
#define PG8_SB(b, h) ((4 + (b) * 2 + (h)) * HTB)
#define PG8_STAGE(bufoff, gbase, voff) do { _Pragma("unroll") for (int _i = 0; _i < 2; ++_i) { \
        if constexpr (SADDR) { unsigned keep_; const unsigned dst_ = (unsigned)__builtin_amdgcn_readfirstlane((int)(lds0_ + (unsigned)(bufoff) + ldsw + _i * 8192)); \
            asm volatile("s_mov_b32 %0, m0\n\ts_mov_b32 m0, %3\n\ts_nop 0\n\tglobal_load_lds_dwordx4 %1, %2\n\ts_mov_b32 m0, %0" : "=&s"(keep_) : "v"((voff)[_i]), "s"((const char*)(gbase)), "s"(dst_) : "memory"); } \
        else __builtin_amdgcn_global_load_lds((const unsigned*)((const char*)(gbase) + (voff)[_i]), (PG8_LAS unsigned*)(lds + (bufoff) + ldsw + _i * 8192), 16, 0, 0); } } while (0)
#define PG8_LDA(dst, b, h) do { _Pragma("unroll") for (int m = 0; m < 4; ++m) _Pragma("unroll") for (int k = 0; k < 2; ++k) dst[m][k] = *(const PG8_LAS bf16x8*)(lds + PG8_SA(b, h) + aoff + m * 2048 + k * 1024); } while (0)
#define PG8_LDB(dst, b, h) do { _Pragma("unroll") for (int n = 0; n < 2; ++n) _Pragma("unroll") for (int k = 0; k < 2; ++k) dst[n][k] = *(const PG8_LAS bf16x8*)(lds + PG8_SB(b, h) + boff + n * 2048 + k * 1024); } while (0)
#define PG8_MMA(ai, bj, At, Bt) do { __builtin_amdgcn_s_setprio(1); _Pragma("unroll") for (int m = 0; m < 4; ++m) _Pragma("unroll") for (int n = 0; n < 2; ++n) { \
        if constexpr (MX8) { typedef int i32x8_ __attribute__((ext_vector_type(8))); typedef int i32x4_ __attribute__((ext_vector_type(4))); \
            const i32x4_ b0_ = __builtin_bit_cast(i32x4_, Bt[n][0]), b1_ = __builtin_bit_cast(i32x4_, Bt[n][1]), a0_ = __builtin_bit_cast(i32x4_, At[m][0]), a1_ = __builtin_bit_cast(i32x4_, At[m][1]); \
            const i32x8_ bb_ = __builtin_shufflevector(b0_, b1_, 0, 1, 2, 3, 4, 5, 6, 7), aa_ = __builtin_shufflevector(a0_, a1_, 0, 1, 2, 3, 4, 5, 6, 7); \
            acc[ai][bj][m][n] = __builtin_amdgcn_mfma_scale_f32_16x16x128_f8f6f4(bb_, aa_, acc[ai][bj][m][n], 0, 0, 0, 0x7F7F7F7F, 0, 0x7F7F7F7F); } \
        else { _Pragma("unroll") for (int k = 0; k < 2; ++k) acc[ai][bj][m][n] = __builtin_amdgcn_mfma_f32_16x16x32_bf16(Bt[n][k], At[m][k], acc[ai][bj][m][n], 0, 0, 0); } } \
        __builtin_amdgcn_s_setprio(0); } while (0)
#define PG8_WAIT_V(n) asm volatile("s_waitcnt vmcnt(" #n ")" ::: "memory")
#define PG8_WAIT_L(n) asm volatile("s_waitcnt lgkmcnt(" #n ")" ::: "memory")
#define PG8_BAR __builtin_amdgcn_s_barrier()
#define PG8_SCHED __builtin_amdgcn_sched_barrier(0)
    Unit cur, nxt; int ui = 0;
    if (!S.next(0, cur)) return;
    f32x4 acc[2][2][4][2];
#pragma unroll
    for (int a = 0; a < 2; ++a)
#pragma unroll
        for (int b = 0; b < 2; ++b)
#pragma unroll
            for (int m = 0; m < 4; ++m)
#pragma unroll
                for (int n = 0; n < 2; ++n) acc[a][b][m][n] = (f32x4){0.f, 0.f, 0.f, 0.f};
    bf16x8 At[4][2], B0[2][2], B1[2][2];
    const char* cA = (const char*)g.A + (size_t)cur.pm * tstep; const char* cB = (const char*)g.Bt + cur.boff + (size_t)cur.pn * tstep;
    if constexpr (SP2) {
        PG8_STAGE(PG8_SB(0, 0), cB, voffB); PG8_STAGE(PG8_SB(0, 1), cB + hstep, voffB); PG8_STAGE(PG8_SA(0, 0), cA, voffA); PG8_STAGE(PG8_SA(0, 1), cA + hstep, voffA);
        if (wr == 1) PG8_BAR;
        PG8_WAIT_V(2); PG8_BAR;
        PG8_STAGE(PG8_SB(1, 0), cB + kstep, voffB); PG8_STAGE(PG8_SA(1, 0), cA + kstep, voffA); PG8_STAGE(PG8_SB(1, 1), cB + hstep + kstep, voffB);
        PG8_WAIT_V(6); PG8_BAR;
    } else {
        PG8_STAGE(PG8_SB(0, 0), cB, voffB); PG8_STAGE(PG8_SA(0, 0), cA, voffA); PG8_STAGE(PG8_SB(0, 1), cB + hstep, voffB); PG8_STAGE(PG8_SA(0, 1), cA + hstep, voffA);
        if (wr == 1) PG8_BAR;
        PG8_WAIT_V(4); PG8_BAR;
        PG8_STAGE(PG8_SB(1, 0), cB + kstep, voffB); PG8_STAGE(PG8_SA(1, 0), cA + kstep, voffA); PG8_STAGE(PG8_SB(1, 1), cB + hstep + kstep, voffB);
        PG8_WAIT_V(6); PG8_BAR;
    }
    for (;;) {
        const bool has_next = S.next(ui + 1, nxt);
        const char* nA = has_next ? (const char*)g.A + (size_t)nxt.pm * tstep : cA; const char* nB = has_next ? (const char*)g.Bt + nxt.boff + (size_t)nxt.pn * tstep : cB;
        for (int t = 0; t < nt; t += 2) {
            const bool last = (t == nt - 2);
            const char* a1 = cA + (size_t)(t + 1) * kstep;
            const char* a2 = last ? nA : cA + (size_t)(t + 2) * kstep; const char* b2 = last ? nB : cB + (size_t)(t + 2) * kstep;
            const char* a3 = a2 + kstep; const char* b3 = b2 + kstep;
            if constexpr (SP2) {
            PG8_LDB(B0, 0, 0); PG8_LDB(B1, 0, 1); PG8_SCHED; PG8_LDA(At, 0, 0); PG8_STAGE(PG8_SA(1, 1), a1 + hstep, voffA);
            PG8_WAIT_V(8); PG8_WAIT_L(0); PG8_BAR; PG8_MMA(0, 0, At, B0); PG8_MMA(0, 1, At, B1); PG8_BAR; PG8_SCHED;
            PG8_LDA(At, 0, 1); PG8_STAGE(PG8_SB(0, 0), b2, voffB); PG8_STAGE(PG8_SB(0, 1), b2 + hstep, voffB); PG8_STAGE(PG8_SA(0, 0), a2, voffA);
            PG8_WAIT_V(8); PG8_WAIT_L(0); PG8_BAR; PG8_MMA(1, 0, At, B0); PG8_MMA(1, 1, At, B1); PG8_BAR; PG8_SCHED;
            PG8_LDB(B0, 1, 0); PG8_LDB(B1, 1, 1); PG8_SCHED; PG8_LDA(At, 1, 0); PG8_STAGE(PG8_SA(0, 1), a2 + hstep, voffA);
            PG8_WAIT_V(8); PG8_WAIT_L(0); PG8_BAR; PG8_MMA(0, 0, At, B0); PG8_MMA(0, 1, At, B1); PG8_BAR; PG8_SCHED;
            PG8_LDA(At, 1, 1); PG8_STAGE(PG8_SB(1, 0), b3, voffB); PG8_STAGE(PG8_SB(1, 1), b3 + hstep, voffB); PG8_STAGE(PG8_SA(1, 0), a3, voffA);
            PG8_WAIT_V(8); PG8_WAIT_L(0); PG8_BAR; PG8_MMA(1, 0, At, B0); PG8_MMA(1, 1, At, B1); PG8_BAR; PG8_SCHED;
            } else {
            PG8_LDB(B0, 0, 0); PG8_SCHED; PG8_LDA(At, 0, 0); PG8_STAGE(PG8_SA(1, 1), a1 + hstep, voffA);
            PG8_WAIT_L(8); PG8_BAR; PG8_WAIT_L(0); PG8_MMA(0, 0, At, B0); PG8_BAR; PG8_SCHED;
            PG8_LDB(B1, 0, 1); PG8_STAGE(PG8_SB(0, 0), b2, voffB);
            PG8_BAR; PG8_WAIT_L(0); PG8_MMA(0, 1, At, B1); PG8_BAR;
            PG8_LDA(At, 0, 1); PG8_STAGE(PG8_SA(0, 0), a2, voffA);
            PG8_BAR; PG8_WAIT_L(0); PG8_MMA(1, 0, At, B0); PG8_BAR; PG8_SCHED;
            PG8_STAGE(PG8_SB(0, 1), b2 + hstep, voffB);
            PG8_WAIT_V(6); PG8_BAR; PG8_MMA(1, 1, At, B1); PG8_BAR;
            PG8_LDB(B0, 1, 0); PG8_SCHED; PG8_LDA(At, 1, 0); PG8_STAGE(PG8_SA(0, 1), a2 + hstep, voffA);
            PG8_WAIT_L(8); PG8_BAR; PG8_WAIT_L(0); PG8_MMA(0, 0, At, B0); PG8_BAR; PG8_SCHED;
            PG8_LDB(B1, 1, 1); PG8_STAGE(PG8_SB(1, 0), b3, voffB);
            PG8_BAR; PG8_WAIT_L(0); PG8_MMA(0, 1, At, B1); PG8_BAR;
            PG8_LDA(At, 1, 1); PG8_STAGE(PG8_SA(1, 0), a3, voffA);
            PG8_BAR; PG8_WAIT_L(0); PG8_MMA(1, 0, At, B0); PG8_BAR; PG8_SCHED;
            PG8_STAGE(PG8_SB(1, 1), b3 + hstep, voffB);
            PG8_WAIT_V(6); PG8_BAR; PG8_MMA(1, 1, At, B1); PG8_BAR;
            }
        }
        if constexpr (ALIGN_EPI) { if (wr == 0) PG8_BAR; }
        E(acc, cur, wr, wc, fr, fq);
        if (!has_next) break;
#pragma unroll
        for (int a = 0; a < 2; ++a)
#pragma unroll
            for (int b = 0; b < 2; ++b)
#pragma unroll
                for (int m = 0; m < 4; ++m)
#pragma unroll
                    for (int n = 0; n < 2; ++n) acc[a][b][m][n] = (f32x4){0.f, 0.f, 0.f, 0.f};
        cur = nxt; cA = nA; cB = nB; ++ui;
        if constexpr (ALIGN_EPI) { if (wr == 1) PG8_BAR; }
    }
    PG8_WAIT_V(0);
    if constexpr (!ALIGN_EPI) { if (wr == 0) PG8_BAR; }
    PG8_BAR;
#undef PG8_SA
#undef PG8_SB
#undef PG8_STAGE
#undef PG8_LDA
#undef PG8_LDB
#undef PG8_MMA
#undef PG8_WAIT_V
#undef PG8_WAIT_L
#undef PG8_BAR
#undef PG8_SCHED
}
}
typedef GAS unsigned gu32;
#define RLX_AGENT __ATOMIC_RELAXED, __HIP_MEMORY_SCOPE_AGENT
#define XB_TMO      128
#define XB_XCNT(j)  (256  + 64 * (j))
#define XB_XSUB(j)  (1280 + 64 * (j))
#define XB_XGEN(j)  (2304 + 64 * (j))
#define XB_TOP      3328
#define XB_TOPGEN   3392
#define XCD_BAR_WORDS 3456
#define XB_SPIN_CAP (1u << 18)

__device__ __forceinline__ unsigned xb_ld(unsigned* p)              { return __hip_atomic_load(p, __ATOMIC_RELAXED, __HIP_MEMORY_SCOPE_AGENT); }
__device__ __forceinline__ unsigned xb_add(unsigned* p, unsigned v) { return __hip_atomic_fetch_add(p, v, __ATOMIC_RELAXED, __HIP_MEMORY_SCOPE_AGENT); }
__device__ __forceinline__ unsigned xb_xcc_id() { return (unsigned)__builtin_amdgcn_s_getreg((3 << 11) | 20) & 0xFu; }
#define XB_SPIN(cond, bar) do { unsigned _sp = 0; while (cond) { __builtin_amdgcn_s_sleep(1); \
    if ((++_sp & 255u) == 0u) { if (xb_ld(&(bar)[XB_TMO])) break; if (_sp > XB_SPIN_CAP) { atomicAdd(&(bar)[XB_TMO], 1u); break; } } } } while (0)

struct XcdBarrier {
    unsigned* bar; unsigned x; int wv;
    volatile LAS unsigned* st;
};
__device__ __forceinline__ XcdBarrier xcd_barrier_post(unsigned* bar, volatile LAS unsigned* st, int wv) {
    XcdBarrier b; b.bar = bar; b.x = xb_xcc_id(); b.st = st; b.wv = wv;
    if (wv == 0 && lane_id() == 0) (void)xb_add(&bar[XB_XCNT(b.x)], 1u);
    return b;
}
__device__ __forceinline__ void xcd_barrier_complete(unsigned* bar, unsigned x, unsigned& nloc, unsigned& nx) {
    const unsigned G = gridDim.x * gridDim.y * gridDim.z;
    unsigned sum, cnt, mine, sp = 0u;
    for (;;) {
        sum = 0u; cnt = 0u; mine = 0u;
#pragma unroll
        for (unsigned j = 0; j < 16; ++j) { const unsigned c = xb_ld(&bar[XB_XCNT(j)]); sum += c; cnt += (c > 0u) ? 1u : 0u; mine = (j == x) ? c : mine; }
        if (sum == G) break;
        __builtin_amdgcn_s_sleep(1);
        if ((++sp & 255u) == 0u) { if (xb_ld(&bar[XB_TMO])) break; if (sp > XB_SPIN_CAP) { atomicAdd(&bar[XB_TMO], 1u); break; } }
    }
    nloc = mine > 0u ? mine : 1u; nx = cnt > 0u ? cnt : 1u;
}
__device__ __forceinline__ void xcd_barrier(const XcdBarrier& b) {
    asm volatile("s_waitcnt vmcnt(0)" ::: "memory");
    __syncthreads();
    if (b.wv == 0 && lane_id() == 0) {
        unsigned* bar = b.bar;
        __builtin_amdgcn_s_waitcnt(0);
        unsigned nloc = b.st[0], nx = b.st[1];
        if (nloc == 0u) { xcd_barrier_complete(bar, b.x, nloc, nx); b.st[0] = nloc; b.st[1] = nx; }
        const unsigned old = xb_add(&bar[XB_XSUB(b.x)], 1u);
        const unsigned gen = old / nloc;
        if (old + 1u == (gen + 1u) * nloc) {
            __builtin_amdgcn_fence(__ATOMIC_RELEASE, "agent");
            asm volatile("s_waitcnt vmcnt(0)" ::: "memory");
            const unsigned og = xb_add(&bar[XB_TOP], 1u);
            const unsigned tg = og / nx;
            if (og + 1u == (tg + 1u) * nx) xb_add(&bar[XB_TOPGEN], 1u);
            else XB_SPIN(xb_ld(&bar[XB_TOPGEN]) == tg, bar);
            __builtin_amdgcn_fence(__ATOMIC_ACQUIRE, "agent");
            xb_add(&bar[XB_XGEN(b.x)], 1u);
            asm volatile("s_waitcnt vmcnt(0)" ::: "memory");
        } else {
            XB_SPIN(xb_ld(&bar[XB_XGEN(b.x)]) == gen, bar);
            __builtin_amdgcn_fence(__ATOMIC_ACQUIRE, "agent");
            asm volatile("s_waitcnt vmcnt(0)" ::: "memory");
        }
    }
    __syncthreads();
}

#define XB_LSUB(j)  (3456 + 64 * (j))
#define XB_LGEN(j)  (3456 + 1024 + 64 * (j))
#define XB_CHK      (3456 + 2048)
#define XCD_BAR_WORDS_EXT (3456 + 2048 + 256)
__device__ __forceinline__ void xcd_local_barrier(const XcdBarrier& b) {
    asm volatile("s_waitcnt vmcnt(0)" ::: "memory");
    __syncthreads();
    if (b.wv == 0 && lane_id() == 0) {
        unsigned* bar = b.bar;
        __builtin_amdgcn_s_waitcnt(0);
        const unsigned nloc = b.st[0];
        const unsigned old = xb_add(&bar[XB_LSUB(b.x)], 1u);
        const unsigned gen = old / nloc;
        if (old + 1u == (gen + 1u) * nloc) xb_add(&bar[XB_LGEN(b.x)], 1u);
        else XB_SPIN(xb_ld(&bar[XB_LGEN(b.x)]) == gen, bar);
        __builtin_amdgcn_fence(__ATOMIC_ACQUIRE, "agent");
        asm volatile("s_waitcnt vmcnt(0)" ::: "memory");
    }
    __syncthreads();
}

namespace att {
__device__ __forceinline__ int crow(int r, int hi) { return (r & 3) + 8 * (r >> 2) + 4 * hi; }
__device__ __forceinline__ void glds16(const void* gsrc, unsigned lds_dst) { unsigned keep;
    asm volatile("s_mov_b32 %0, m0\n\ts_mov_b32 m0, %2\n\ts_nop 0\n\tglobal_load_lds_dwordx4 %1, off\n\ts_mov_b32 m0, %0" : "=&s"(keep) : "v"(gsrc), "s"(lds_dst) : "memory"); }
#define ATT_WAIT_BAR(N) asm volatile("s_waitcnt vmcnt(" #N ") lgkmcnt(0)\n\ts_barrier" ::: "memory")
#define ATT_MX3(a, b, c) __builtin_fmaxf(__builtin_fmaxf((a), (b)), (c))
typedef LAS const unsigned char* lcp;
typedef short v4i16_t __attribute__((ext_vector_type(4)));
__device__ __forceinline__ s16x4 vtr(lcp p) { return __builtin_bit_cast(s16x4, __builtin_amdgcn_ds_read_tr16_b64_v4i16((LAS v4i16_t*)p)); }
__device__ __forceinline__ float rowmax(const f32x16& p0, const f32x16& p1) {
    float a = ATT_MX3(p0[0], p0[1], p1[0]), b = ATT_MX3(p0[2], p0[3], p1[1]); a = ATT_MX3(a, p1[2], p1[3]);
#pragma unroll
    for (int r = 4; r < 16; r += 4) { a = ATT_MX3(a, p0[r], p0[r + 1]); b = ATT_MX3(b, p0[r + 2], p0[r + 3]); a = ATT_MX3(a, p1[r], p1[r + 1]); b = ATT_MX3(b, p1[r + 2], p1[r + 3]); }
    float m = __builtin_fmaxf(a, b); auto rr = __builtin_amdgcn_permlane32_swap(__float_as_uint(m), __float_as_uint(m), false, false);
    return __builtin_fmaxf(__uint_as_float(rr[0]), __uint_as_float(rr[1])); }
template <bool FAKEV = false> __device__ __forceinline__ void pv(f32x16* o, lcp vp, const u32x4 pw0, const u32x4 pw1, const u32x4 pw2, const u32x4 pw3) {
#pragma unroll
    for (int ks = 0; ks < 4; ++ks) {
        const u32x4 pw = ks == 0 ? pw0 : ks == 1 ? pw1 : ks == 2 ? pw2 : pw3;
#pragma unroll
        for (int d0 = 0; d0 < 2; ++d0) {
            bf16x8 vf;
            if (FAKEV) vf = __builtin_bit_cast(bf16x8, ks & 1 ? pw0 : pw2);
            else { const s16x4 lo = vtr(vp + d0 * 4096 + ks * 1024), hi = vtr(vp + d0 * 4096 + ks * 1024 + 512); vf = (bf16x8){lo[0], lo[1], lo[2], lo[3], hi[0], hi[1], hi[2], hi[3]}; }
            o[d0] = __builtin_amdgcn_mfma_f32_32x32x16_bf16(__builtin_bit_cast(bf16x8, pw), vf, o[d0], 0, 0, 0);
        }
    }
}
__device__ __forceinline__ void store_o(const f32x16* o, const float* rsc  , LAS unsigned char* stage, bf16_t* Ow, int pitch, int lane, int r32, int hi) {
    LAS bf16_t* stg = (LAS bf16_t*)stage;
#pragma unroll
    for (int r = 0; r < 16; ++r) { const int orow = crow(r, hi);
#pragma unroll
        for (int d0 = 0; d0 < 2; ++d0) stg[orow * 64 + d0 * 32 + r32] = (bf16_t)(pk_bf16(o[d0][r] * rsc[r], 0.f) & 0xffffu); }
    asm volatile("s_waitcnt lgkmcnt(0)" ::: "memory");
#pragma unroll
    for (int i = 0; i < 4; ++i) { const int row = i * 8 + (lane >> 3), ch = lane & 7; const u32x4 v = *(const LAS u32x4*)(stg + row * 64 + ch * 8); *(u32x4*)(Ow + (size_t)row * pitch + ch * 8) = v; }
}

namespace mla {
constexpr int KSLOT = 12288, VSLOT = 8192, NS = 4;
constexpr int L_K = 0, L_V = NS * KSLOT, L_WS = L_V + NS * VSLOT, L_OST = L_WS + 2048, L_END = L_OST + 8 * 4096;
#define MLA_BAR_L() asm volatile("s_waitcnt lgkmcnt(0)\n\ts_barrier" ::: "memory")
template <int ABL> __device__ __forceinline__ void unit(int b, int h, int qb, const bf16_t* Q, const bf16_t* KT, const bf16_t* VT, bf16_t* O, LAS unsigned char* shm, int wv) {
    int tid_ = wv * 64 + lane_id(); asm volatile("" : "+v"(tid_));
    const int tid = tid_, lane = tid & 63, r32 = lane & 31, hi = lane >> 5; const int wid = __builtin_amdgcn_readfirstlane(tid >> 6);
    const int grp = wid >> 2;
    const long rowbase = (long)b * SEQL; const int q0 = qb * 256;
    const bf16_t* Qw = Q + (size_t)(rowbase + q0 + wid * 32) * 768 + h * 96;
    const bf16_t* Kh = KT + (size_t)((b * 8 + h) * 128) * 6144 + lane * 8;
    const bf16_t* Vh = VT + (size_t)((b * 8 + h) * 128) * 4096 + lane * 8;
    const unsigned lds0 = (unsigned)(uintptr_t)shm;
    LAS float* wsf = (LAS float*)(shm + L_WS) + wid * 64;
    const int NT = (q0 + 256) / 64;
    const int kc2 = 8 + (wid & 3);
    bf16x8 qr[6];
#pragma unroll
    for (int d0 = 0; d0 < 6; ++d0) qr[d0] = *(const bf16x8*)(Qw + (size_t)r32 * 768 + d0 * 16 + hi * 8);
#define MLA_DMA_K(t, sl) do { const bf16_t* kt_ = Kh + (size_t)(t) * 6144; \
        glds16(kt_ + wid * 512, (unsigned)__builtin_amdgcn_readfirstlane(lds0 + L_K + (sl) * KSLOT + wid * 1024)); \
        glds16(kt_ + kc2 * 512, (unsigned)__builtin_amdgcn_readfirstlane(lds0 + L_K + (sl) * KSLOT + kc2 * 1024)); } while (0)
#define MLA_DMA_V(t, sl) glds16(Vh + (size_t)(t) * 4096 + wid * 512, (unsigned)__builtin_amdgcn_readfirstlane(lds0 + L_V + (sl) * VSLOT + wid * 1024))
#define MLA_GROUP(g) do { if ((g) + 4 < NT) MLA_DMA_K((g) + 4, (g) & 3); if ((g) + 3 < NT) MLA_DMA_V((g) + 3, ((g) + 3) & 3); } while (0)
#define MLA_LOADK(sl) do { const lcp kb_ = (lcp)shm + L_K + (sl) * KSLOT + hi * 1024 + r32 * 16; _Pragma("unroll") for (int d0 = 0; d0 < 6; ++d0) { kf[2 * d0] = *(const LAS bf16x8*)(kb_ + d0 * 2048); kf[2 * d0 + 1] = *(const LAS bf16x8*)(kb_ + d0 * 2048 + 512); } } while (0)
    MLA_DMA_K(0, 0); MLA_DMA_K(1, 1); MLA_DMA_V(0, 0); MLA_DMA_K(2, 2); MLA_DMA_V(1, 1); MLA_DMA_K(3, 3); MLA_DMA_V(2, 2);
    float m = 0.f; f32x16 o[2], negm; f32x2 lsA = {0.f, 0.f}, lsB = {0.f, 0.f};
#pragma unroll
    for (int r = 0; r < 16; ++r) { o[0][r] = 0.f; o[1][r] = 0.f; negm[r] = 0.f; }
    const int qrel = wid * 32 + r32;
    bf16x8 kf[12], vf[8]; u32x4 pw0 = {0u, 0u, 0u, 0u}, pw1 = pw0, pw2 = pw0, pw3 = pw0;
    ATT_WAIT_BAR(9);
    MLA_LOADK(0);
    if (grp == 1) ATT_WAIT_BAR(6);
    bool act_prev = false;
    for (int t = 0; t < NT; ++t) {
        const int s0 = t & 3, s1 = (t + 1) & 3;
        if (grp == 1) MLA_GROUP(t);
        const int jb = t - (NT - 4);
        const bool act = ABL != 5 && (jb <= 0 || 64 * jb <= wid * 32 + 31);
        f32x16 p0 = negm, p1 = negm;
        if (act) {
#pragma unroll
            for (int d0 = 0; d0 < 6; ++d0) { p0 = __builtin_amdgcn_mfma_f32_32x32x16_bf16(kf[2 * d0], qr[d0], p0, 0, 0, 0); p1 = __builtin_amdgcn_mfma_f32_32x32x16_bf16(kf[2 * d0 + 1], qr[d0], p1, 0, 0, 0); }
        }
        if (act_prev) {
#pragma unroll
            for (int ks = 0; ks < 4; ++ks) { const u32x4 pw = ks == 0 ? pw0 : ks == 1 ? pw1 : ks == 2 ? pw2 : pw3;
                o[0] = __builtin_amdgcn_mfma_f32_32x32x16_bf16(__builtin_bit_cast(bf16x8, pw), vf[ks], o[0], 0, 0, 0);
                o[1] = __builtin_amdgcn_mfma_f32_32x32x16_bf16(__builtin_bit_cast(bf16x8, pw), vf[4 + ks], o[1], 0, 0, 0);
 }
        }
        if (grp == 0) { if (t + 3 < NT) ATT_WAIT_BAR(6); else ATT_WAIT_BAR(0); MLA_GROUP(t); }
        else MLA_BAR_L();
        if (act && (ABL != 7 || t == 0)) {
            { const lcp vp = (lcp)shm + L_V + s0 * VSLOT + ((lane >> 4) & 1) * 32 + (lane & 3) * 8 + (4 * hi + ((lane & 15) >> 2)) * 64;
#pragma unroll
                for (int d0 = 0; d0 < 2; ++d0)
#pragma unroll
                    for (int ks = 0; ks < 4; ++ks) { const s16x4 lo = vtr(vp + d0 * 4096 + ks * 1024), hh = vtr(vp + d0 * 4096 + ks * 1024 + 512);
                        vf[d0 * 4 + ks] = (bf16x8){lo[0], lo[1], lo[2], lo[3], hh[0], hh[1], hh[2], hh[3]}; } }
        }
        if (t + 1 < NT && ABL != 6) MLA_LOADK(s1);
        if (act) {
            if (jb >= 0) {
#pragma unroll
                for (int r = 0; r < 16; ++r) { const int kv = 64 * jb + crow(r, hi); if (kv > qrel) p0[r] = -INFINITY; if (kv + 32 > qrel) p1[r] = -INFINITY; }
            }
            const float rm = rowmax(p0, p1);
            if (t == 0 || __any(rm > 8.0f)) {
                const float dl = t == 0 ? rm : __builtin_fmaxf(rm, 0.f); m += dl;
#pragma unroll
                for (int r = 0; r < 16; ++r) { p0[r] -= dl; p1[r] -= dl; negm[r] = -m; }
                const float alpha = fast_exp2(-dl); if (hi == 0) wsf[r32] = alpha;
#pragma unroll
                for (int r = 0; r < 16; ++r) { const float a = wsf[crow(r, hi)]; o[0][r] *= a; o[1][r] *= a; }
                lsA *= alpha; lsB *= alpha;
            }
#pragma unroll
            for (int r = 0; r < 16; ++r) { if (ABL != 1) { p0[r] = fast_exp2(p0[r]); p1[r] = fast_exp2(p1[r]); } }
#pragma unroll
            for (int r = 0; r < 16; r += 2) { lsA += (f32x2){p0[r], p0[r + 1]}; lsB += (f32x2){p1[r], p1[r + 1]}; }
            pw0 = (u32x4){pk_bf16(p0[0], p0[1]), pk_bf16(p0[2], p0[3]), pk_bf16(p0[4], p0[5]), pk_bf16(p0[6], p0[7])};
            pw1 = (u32x4){pk_bf16(p0[8], p0[9]), pk_bf16(p0[10], p0[11]), pk_bf16(p0[12], p0[13]), pk_bf16(p0[14], p0[15])};
            pw2 = (u32x4){pk_bf16(p1[0], p1[1]), pk_bf16(p1[2], p1[3]), pk_bf16(p1[4], p1[5]), pk_bf16(p1[6], p1[7])};
            pw3 = (u32x4){pk_bf16(p1[8], p1[9]), pk_bf16(p1[10], p1[11]), pk_bf16(p1[12], p1[13]), pk_bf16(p1[14], p1[15])};
        }
        act_prev = act;
        if (grp == 0) MLA_BAR_L();
        else { if (t + 4 < NT) ATT_WAIT_BAR(6); else ATT_WAIT_BAR(0); }
    }
#undef MLA_DMA_K
#undef MLA_DMA_V
#undef MLA_GROUP
#undef MLA_LOADK
    if (act_prev) {
#pragma unroll
        for (int ks = 0; ks < 4; ++ks) { const u32x4 pw = ks == 0 ? pw0 : ks == 1 ? pw1 : ks == 2 ? pw2 : pw3;
            o[0] = __builtin_amdgcn_mfma_f32_32x32x16_bf16(__builtin_bit_cast(bf16x8, pw), vf[ks], o[0], 0, 0, 0);
            o[1] = __builtin_amdgcn_mfma_f32_32x32x16_bf16(__builtin_bit_cast(bf16x8, pw), vf[4 + ks], o[1], 0, 0, 0);
 }
    }
    if (grp == 0) MLA_BAR_L();
    float rli[16];
    { float l = (lsA.x + lsA.y) + (lsB.x + lsB.y); auto rr = __builtin_amdgcn_permlane32_swap(__float_as_uint(l), __float_as_uint(l), false, false); l = __uint_as_float(rr[0]) + __uint_as_float(rr[1]);
      if (hi == 0) wsf[r32] = fast_rcp(l); }
#pragma unroll
    for (int r = 0; r < 16; ++r) rli[r] = wsf[crow(r, hi)];
    store_o(o, rli, shm + L_OST + wid * 4096, O + (size_t)(rowbase + q0 + wid * 32) * 512 + h * 64, 512, lane, r32, hi);
    MLA_BAR_L();
}
template <int ABL> __device__ __forceinline__ void phase(int vcu, int G, const bf16_t* Q, const bf16_t* KT, const bf16_t* VT, bf16_t* O, LAS unsigned char* shm, int wv) {
    for (int v = vcu; v < 256; v += G) { const int bh = v >> 4, s = v & 15;
        unit<ABL>(bh >> 3, bh & 7, 31 - s, Q, KT, VT, O, shm, wv);
        unit<ABL>(bh >> 3, bh & 7, s, Q, KT, VT, O, shm, wv); }
}
}

namespace sba {
constexpr int KSLOT = 8192, VSLOT = 8192, NS = 3;
constexpr int L_K = 0, L_V = NS * KSLOT, L_WS = L_V + NS * VSLOT, L_FLAG = L_WS + 2048, L_OST = L_FLAG + 256, L_END = L_OST + 8 * 4096;
constexpr float SB_EXIT = 1.0e-42f;
template <int ABL = 0> __device__ __forceinline__ void unit(int b, int kh, int qb64, const bf16_t* Q, const bf16_t* KT, const bf16_t* VT, bf16_t* O, LAS unsigned char* shm, int wv) {
    int tid_ = wv * 64 + lane_id(); asm volatile("" : "+v"(tid_));
    const int tid = tid_, lane = tid & 63, r32 = lane & 31, hi = lane >> 5; const int wid = __builtin_amdgcn_readfirstlane(tid >> 6);
    const int h = kh * 4 + (wid >> 1), half = wid & 1;
    const long rowbase = (long)b * SEQL; const int q0 = qb64 * 64;
    const bf16_t* Qw = Q + (size_t)(rowbase + q0 + half * 32) * 1024 + h * 64;
    const bf16_t* Kh = KT + (size_t)((b * 4 + kh) * 128) * 4096 + wid * 512 + lane * 8;
    const bf16_t* Vh = VT + (size_t)((b * 4 + kh) * 128) * 4096 + wid * 512 + lane * 8;
    const unsigned lds0 = (unsigned)(uintptr_t)shm;
    LAS int* flags = (LAS int*)(shm + L_FLAG);
    const int NT = qb64 + 1;
#define SBA_DMA(k, sl) do { const int tile_ = qb64 - (k); \
        glds16(Kh + (size_t)tile_ * 4096, (unsigned)__builtin_amdgcn_readfirstlane(lds0 + L_K + (sl) * KSLOT + wid * 1024)); \
        glds16(Vh + (size_t)tile_ * 4096, (unsigned)__builtin_amdgcn_readfirstlane(lds0 + L_V + (sl) * VSLOT + wid * 1024)); } while (0)
    SBA_DMA(0, 0); if (NT > 1) SBA_DMA(1, 1);
    bf16x8 qr[4];
#pragma unroll
    for (int d0 = 0; d0 < 4; ++d0) qr[d0] = *(const bf16x8*)(Qw + (size_t)r32 * 1024 + d0 * 16 + hi * 8);
    float R = 1.f; f32x16 o[2];
#pragma unroll
    for (int r = 0; r < 16; ++r) { o[0][r] = 0.f; o[1][r] = 0.f; }
    const int qrel = half * 32 + r32;
    int slot = 0;
    for (int k = 0; k < NT; ++k) {
        if (k + 1 < NT) ATT_WAIT_BAR(2); else ATT_WAIT_BAR(0);
        if (k > 0) { const LAS int* f = flags + ((k - 1) & 1) * 8; int all = 1;
#pragma unroll
            for (int w = 0; w < 8; ++w) all &= f[w];
            if (all) break; }
        if (k + 2 < NT) { const int s2 = slot == 0 ? 2 : slot - 1; SBA_DMA(k + 2, s2); }
        if (ABL == 3) { if (lane == 0) flags[(k & 1) * 8 + wid] = (k >= 2); } else {
            const lcp kb = (lcp)shm + L_K + slot * KSLOT + hi * 1024 + r32 * 16;
            f32x16 p0, p1;
#pragma unroll
            for (int r = 0; r < 16; ++r) { p0[r] = 0.f; p1[r] = 0.f; }
#pragma unroll
            for (int d0 = 0; d0 < 4; ++d0) { const bf16x8 b0 = *(const LAS bf16x8*)(kb + d0 * 2048), b1 = *(const LAS bf16x8*)(kb + d0 * 2048 + 512);
                p0 = __builtin_amdgcn_mfma_f32_32x32x16_bf16(b0, qr[d0], p0, 0, 0, 0); p1 = __builtin_amdgcn_mfma_f32_32x32x16_bf16(b1, qr[d0], p1, 0, 0, 0); }
            f32x16 N0, N1;
#pragma unroll
            for (int r = 0; r < 16; r += 2) {
                f32x2 e0, e1; e0.x = fast_exp2(-p0[r]); e0.y = fast_exp2(-p0[r + 1]); e1.x = fast_exp2(-p1[r]); e1.y = fast_exp2(-p1[r + 1]);
                const f32x2 d0 = e0 + 1.0f, d1 = e1 + 1.0f;
                f32x2 b0, b1; b0.x = fast_rcp(d0.x); b0.y = fast_rcp(d0.y); b1.x = fast_rcp(d1.x); b1.y = fast_rcp(d1.y);
                f32x2 n0 = 1.0f - b0, n1 = 1.0f - b1;
                if (k == 0) { const int kv = crow(r, hi), kw = crow(r + 1, hi);
                    if (kv >= qrel) { b0.x = 0.f; n0.x = 1.f; } if (kw >= qrel) { b0.y = 0.f; n0.y = 1.f; } if (kv + 32 >= qrel) { b1.x = 0.f; n1.x = 1.f; } if (kw + 32 >= qrel) { b1.y = 0.f; n1.y = 1.f; } }
                p0[r] = b0.x; p0[r + 1] = b0.y; p1[r] = b1.x; p1[r + 1] = b1.y; N0[r] = n0.x; N0[r + 1] = n0.y; N1[r] = n1.x; N1[r + 1] = n1.y; }
            float G[16];
#pragma unroll
            for (int j = 0; j < 8; ++j) { const f32x16& NN = j < 4 ? N0 : N1; const int rb = 4 * (j & 3);
                const f32x2 t2 = (f32x2){NN[rb], NN[rb + 1]} * (f32x2){NN[rb + 2], NN[rb + 3]}; const float gp = t2.x * t2.y;
                auto rr = __builtin_amdgcn_permlane32_swap(__float_as_uint(gp), __float_as_uint(gp), false, false);
                G[2 * j] = __uint_as_float(rr[0]); G[2 * j + 1] = __uint_as_float(rr[1]); }
            float SG[16]; SG[15] = 1.f;
#pragma unroll
            for (int g = 14; g >= 0; --g) SG[g] = SG[g + 1] * G[g + 1];
            const float T = SG[0] * G[0];
#pragma unroll
            for (int j = 0; j < 8; ++j) { f32x16& NN = j < 4 ? N0 : N1; f32x16& PP = j < 4 ? p0 : p1; const int rb = 4 * (j & 3);
                const float base = (R * SG[2 * j + 1]) * (hi ? 1.f : G[2 * j + 1]);
                const float r3 = base, r2 = r3 * NN[rb + 3], r1 = r2 * NN[rb + 2], r0 = r1 * NN[rb + 1];
                const f32x2 ph = (f32x2){PP[rb + 2], PP[rb + 3]} * (f32x2){r2, r3}, pl = (f32x2){PP[rb], PP[rb + 1]} * (f32x2){r0, r1};
                PP[rb + 3] = ph.y; PP[rb + 2] = ph.x; PP[rb + 1] = pl.y; PP[rb] = pl.x; }
            R *= T;
            const u32x4 pw0 = {pk_bf16(p0[0], p0[1]), pk_bf16(p0[2], p0[3]), pk_bf16(p0[4], p0[5]), pk_bf16(p0[6], p0[7])};
            const u32x4 pw1 = {pk_bf16(p0[8], p0[9]), pk_bf16(p0[10], p0[11]), pk_bf16(p0[12], p0[13]), pk_bf16(p0[14], p0[15])};
            const u32x4 pw2 = {pk_bf16(p1[0], p1[1]), pk_bf16(p1[2], p1[3]), pk_bf16(p1[4], p1[5]), pk_bf16(p1[6], p1[7])};
            const u32x4 pw3 = {pk_bf16(p1[8], p1[9]), pk_bf16(p1[10], p1[11]), pk_bf16(p1[12], p1[13]), pk_bf16(p1[14], p1[15])};
            const lcp vp = (lcp)shm + L_V + slot * VSLOT + ((lane >> 4) & 1) * 32 + (lane & 3) * 8 + (4 * hi + ((lane & 15) >> 2)) * 64;
            if (ABL != 2) pv(o, vp, pw0, pw1, pw2, pw3); else o[0][0] += __uint_as_float(pw0.x ^ pw1.y ^ pw2.z ^ pw3.w);
            const int dn = (ABL == 4 || __all(R < SB_EXIT)) ? 1 : 0;
            if (lane == 0) flags[(k & 1) * 8 + wid] = dn;
        }
        slot = slot == 2 ? 0 : slot + 1;
    }
#undef SBA_DMA
    ATT_WAIT_BAR(0);
    float one[16];
#pragma unroll
    for (int r = 0; r < 16; ++r) one[r] = 1.0f;
    store_o(o, one, shm + L_OST + wid * 4096, O + (size_t)(rowbase + q0 + half * 32) * 1024 + h * 64, 1024, lane, r32, hi);
    asm volatile("s_waitcnt lgkmcnt(0)\n\ts_barrier" ::: "memory");
}
__device__ __forceinline__ void phase(int vcu, int G, const bf16_t* Q, const bf16_t* KT, const bf16_t* VT, bf16_t* O, LAS unsigned char* shm, int wv) {
    for (int u = vcu * 4; u < 1024; u += G * 4)
        for (int i = 0; i < 4; ++i) { const int uu = u + i, qb64 = uu & 127, bk = uu >> 7; unit(bk >> 2, bk & 3, qb64, Q, KT, VT, O, shm, wv); }
}
}
}
#ifndef FP8_FDN
#define FP8_FDN 1
#endif
#ifndef FP8_EGU
#define FP8_EGU 1
#endif
#ifndef FP8_EDN
#define FP8_EDN 1
#endif
#ifndef FP8_DOWN
#define FP8_PG 1
#define FP8_FGU2 1
#define FP8_DOWN (FP8_FDN || FP8_EDN || FP8_PG || FP8_FGU2)
#endif
namespace fw {
constexpr size_t MiB = 1u << 20;
constexpr int NWAVES = 8, NTHR = 512;
constexpr int MAXSLOT = 34816;
constexpr size_t WS_CTL = 0, CTL_ZERO_BYTES = 64 * 1024;
constexpr size_t WS_TOKE = 1 * MiB;
constexpr size_t WS_TOKG = WS_TOKE + 64 * 1024;
constexpr size_t WS_TOKRS = WS_TOKG + 128 * 1024;
constexpr size_t WS_SLOT12 = WS_TOKRS + 64 * 1024;
constexpr size_t WS_SLOTG = WS_SLOT12 + 128 * 1024;
constexpr size_t WS_SLOTRS = WS_SLOTG + 256 * 1024;
constexpr size_t WS_CNT = WS_SLOTRS + 256 * 1024;
constexpr size_t WS_PSTART = WS_CNT + 16 * 1024;
constexpr size_t WS_CS = 4 * MiB;
constexpr size_t WS_SSQ = 6 * MiB;
constexpr size_t WS_SSQQ = 8 * MiB;
constexpr size_t WS_SSQKV = WS_SSQQ + 512 * 1024;
constexpr size_t WS_KPE = 9 * MiB;
constexpr size_t WS_SSPE = 11 * MiB;
constexpr size_t WS_W = 16 * MiB;
constexpr size_t W_AIN = WS_W, W_QUP = W_AIN + 3 * MiB, W_KVUP = W_QUP + 2 * MiB, W_AOUT = W_KVUP + 1 * MiB, W_KVS = W_AOUT + 2 * MiB, W_QB = W_KVS + 1 * MiB,
                 W_OB = W_QB + 4 * MiB, W_PG = W_OB + 4 * MiB, W_PU = W_PG + 8 * MiB, W_FGU = W_PU + 2 * MiB, W_FDN = W_FGU + 22 * MiB, W_EGU = W_FDN + 11 * MiB,
                 W_EDN = W_EGU + 176 * MiB, W_END = W_EDN + 88 * MiB;
constexpr size_t WS_PB = W_END;
constexpr size_t WS_HB = WS_PB + 32 * MiB;
constexpr size_t WS_U = WS_HB + 64 * MiB;
constexpr size_t WS_SKT = WS_U + 128 * MiB, WS_SVT = WS_SKT + 8 * MiB;
constexpr size_t WS_X = WS_SVT + 8 * MiB;
constexpr size_t X_AQ = WS_X, X_AKV = X_AQ + 12 * MiB, X_QRAW = X_AKV + 8 * MiB, X_KVRAW = X_QRAW + 24 * MiB, X_Q = X_KVRAW + 32 * MiB, X_KT = X_Q + 24 * MiB, X_VT = X_KT + 24 * MiB, X_O = X_VT + 16 * MiB;
constexpr size_t X_SQ = WS_X, X_SO = X_SQ + 32 * MiB;
constexpr size_t X_XG = WS_X, X_HG = X_XG + 68 * MiB, X_YG = X_HG + 187 * MiB, X_END = X_YG + 68 * MiB;
constexpr size_t WS_END = X_END;
constexpr size_t X_HID = WS_END + 128 * MiB;
constexpr size_t X_HB8 = X_HID + 88 * MiB;
constexpr size_t WS_NEED = X_HB8 + 16 * MiB;
static_assert(X_O + 16 * MiB <= X_END && (size_t)MAXSLOT * 2816 * 2 <= 187 * MiB && (size_t)MAXSLOT * 1024 * 2 <= 68 * MiB, "ws map");
constexpr int CW_BAR = 1024;
constexpr int RING_OFF = 0, RING_BYTES = 131072, LDSCTL_OFF = RING_BYTES, MISC_OFF = LDSCTL_OFF + 320, XS_OFF = LDSCTL_OFF + 1024  , LDS_BYTES = 147456;
static_assert(att::mla::L_END <= RING_BYTES && att::sba::L_END <= RING_BYTES, "attention LDS");
constexpr float QSCALE_MLA = 0.10206207261596577f * LOG2E;
constexpr float QSCALE_SB = 0.125f * LOG2E;

struct EpiQ {
    static constexpr bool PERM = true, AFTER_DRAIN = false;
    unsigned char* ws; const float* gq;
    __device__ __forceinline__ void operator()(const f32x4 (&acc)[2][2][4][2], const pg8::Unit& u, int wr, int wc, int fr_, int fq_) const {
        const int ln_ = lane_id(), fr = ln_ & 15, fq = ln_ >> 4; (void)fr_; (void)fq_;
        const int row0 = u.pm * pg8::BM + wr * 64 + fr, c = wc * 32 + 8 * fq;
        LAS float* xs = (LAS float*)(uintptr_t)XS_OFF;
        bf16_t* Q = (bf16_t*)(ws + X_Q); const float* CS = (const float*)(ws + WS_CS); const pg8::RowScale rs{(const float*)(ws + WS_SSQQ), 3}; const float qscale = QSCALE_MLA;
        float rsv[2][4]; rs.get8(rsv, row0, fq);
#pragma unroll
        for (int ai = 0; ai < 2; ++ai)
#pragma unroll
            for (int m = 0; m < 4; ++m) { const int rl = ai * pg8::HALF + wr * 64 + m * 16 + fr; const float s = rsv[ai][m];
#pragma unroll
                for (int bj = 0; bj < 2; ++bj) { const float q = pg8::red_fq(pg8::sumsq8(acc[ai][bj][m][0], acc[ai][bj][m][1])) * (s * s); if (fq == 0) xs[(rl * 2 + bj) * 4 + wc] = q; }
                asm volatile("" ::: "memory"); }
        asm volatile("s_waitcnt lgkmcnt(0)" ::: "memory"); __builtin_amdgcn_s_barrier(); asm volatile("" ::: "memory");
        const int cg = wc < 3 ? c : 0;
        const f32x4 g0 = *(const f32x4*)(gq + cg), g1 = *(const f32x4*)(gq + cg + 4);
        f32x4 csq[2][4];
        if (wc == 2) pg8::rope8_ld(csq[0], CS + (size_t)row0 * 32, fq);
#pragma unroll
        for (int it = 0; it < 8; ++it) { const int ai = it >> 2, m = it & 3; const int rl = ai * pg8::HALF + wr * 64 + m * 16 + fr, row = row0 + ai * pg8::HALF + m * 16;
                if (wc == 2 && it + 1 < 8) pg8::rope8_ld(csq[(it + 1) & 1], CS + (size_t)(row0 + ((it + 1) >> 2) * pg8::HALF + ((it + 1) & 3) * 16) * 32, fq);
#pragma unroll
                for (int bj = 0; bj < 2; ++bj) { const f32x4 p4 = *(const LAS f32x4*)(xs + (rl * 2 + bj) * 4);
                    const float ss = (p4[0] + p4[1]) + (p4[2] + p4[3]); const float sc = rsv[ai][m] * (fast_rsq(ss * (1.0f / 96.0f) + RMS_EPS)) * qscale;
                    f32x4 v0 = acc[ai][bj][m][0] * g0 * sc, v1 = acc[ai][bj][m][1] * g1 * sc;
                    if (wc == 2) pg8::rope8_p(v0, v1, csq[it & 1], fq);
                    if (wc < 3) *(u32x4*)(Q + (size_t)row * 768 + (2 * u.pn + bj) * 96 + c) = pack8(v0, v1); }
                asm volatile("" ::: "memory"); }
    }
};
struct EpiKV {
    static constexpr bool PERM = true, AFTER_DRAIN = false;
    unsigned char* ws; const float* gk;
    __device__ __forceinline__ void operator()(const f32x4 (&acc)[2][2][4][2], const pg8::Unit& u, int wr, int wc, int fr_, int fq_) const {
        const int ln_ = lane_id(), fr = ln_ & 15, fq = ln_ >> 4; (void)fr_; (void)fq_;
        const int row0 = u.pm * pg8::BM + wr * 64 + fr, c = (wc & 1) * 32 + 8 * fq;
        LAS float* xs = (LAS float*)(uintptr_t)XS_OFF;
        bf16_t* KT = (bf16_t*)(ws + X_KT); bf16_t* VT = (bf16_t*)(ws + X_VT); const float* KPE = (const float*)(ws + WS_KPE); const float* SSPE = (const float*)(ws + WS_SSPE); const pg8::RowScale rs{(const float*)(ws + WS_SSQKV), 4};
        float rsv[2][4]; rs.get8(rsv, row0, fq);
#pragma unroll
        for (int ai = 0; ai < 2; ++ai)
#pragma unroll
            for (int m = 0; m < 4; ++m) { const int rl = ai * pg8::HALF + wr * 64 + m * 16 + fr; const float s = rsv[ai][m];
#pragma unroll
                for (int bj = 0; bj < 2; ++bj) { const float q = pg8::red_fq(pg8::sumsq8(acc[ai][bj][m][0], acc[ai][bj][m][1])) * (s * s); if (fq == 0 && wc < 2) xs[(rl * 2 + bj) * 2 + wc] = q; }
                asm volatile("" ::: "memory"); }
        asm volatile("s_waitcnt lgkmcnt(0)" ::: "memory"); __builtin_amdgcn_s_barrier(); asm volatile("" ::: "memory");
        const f32x4 g0 = *(const f32x4*)(gk + c), g1 = *(const f32x4*)(gk + c + 4);
        f32x4 kq[2][2]; float spq[2];
#define EPIKV_LOAD(it_, b_) do { const size_t row_ = (size_t)(row0 + ((it_) >> 2) * pg8::HALF + ((it_) & 3) * 16); kq[b_][0] = *(const f32x4*)(KPE + row_ * 32 + 8 * fq); kq[b_][1] = *(const f32x4*)(KPE + row_ * 32 + 8 * fq + 4); spq[b_] = SSPE[row_]; } while (0)
        EPIKV_LOAD(0, 0);
#pragma unroll
        for (int it = 0; it < 8; ++it) { const int ai = it >> 2, m = it & 3; const int rl = ai * pg8::HALF + wr * 64 + m * 16 + fr, row = row0 + ai * pg8::HALF + m * 16; const float s = rsv[ai][m];
                if (it + 1 < 8) EPIKV_LOAD(it + 1, (it + 1) & 1);
                const int b = row >> 13, sq = row & 8191, tile = sq >> 6, rr = sq & 63;
                const f32x4 k0 = kq[it & 1][0], k1 = kq[it & 1][1];
                const float sspe = spq[it & 1];
#pragma unroll
                for (int bj = 0; bj < 2; ++bj) { const int h = 2 * u.pn + bj; const size_t tb = (size_t)((b * 8 + h) * 128 + tile);
                    const float ssn = xs[(rl * 2 + bj) * 2] + xs[(rl * 2 + bj) * 2 + 1];
                    const float rk = fast_rsq((ssn + sspe) * (1.0f / 96.0f) + RMS_EPS);
                    if (wc < 2) *(u32x4*)(KT + tb * 6144 + (c >> 3) * 512 + rr * 8) = pack8(acc[ai][bj][m][0] * g0 * (s * rk), acc[ai][bj][m][1] * g1 * (s * rk));
                    else *(u32x4*)(VT + tb * 4096 + (wc - 2) * 2048 + rr * 32 + 8 * fq) = pack8(acc[ai][bj][m][0] * s, acc[ai][bj][m][1] * s);
                    if (wc == 2) *(u32x4*)(KT + tb * 6144 + (8 + fq) * 512 + rr * 8) = pack8(k0 * rk, k1 * rk); }
                asm volatile("" ::: "memory"); }
#undef EPIKV_LOAD
    }
};
constexpr int PH_PER_LAYER = 12, PH_TOTAL = 2 + 4 * PH_PER_LAYER;
__host__ __device__ inline bool phase_active(int idx) {
    if (idx == 0) return true;
    if (idx == 1) return false;
    const int l = (idx - 2) / PH_PER_LAYER, s = (idx - 2) % PH_PER_LAYER; const bool mla = l < 2, moe = (l & 1) != 0;
    if (s == 1 || s == 3) return mla;
    if (s == 2) return false;
    if (s >= 7 && s <= 9) return moe;
    if (s == 11) return l == 1;
    return true;
}

struct Args { const float* in[26]; float* out; unsigned char* ws; int ph_lo, ph_hi; };

struct Frame { LAS unsigned char* lds; int tid, lane, wave, vcu, G; };

__device__ __forceinline__ float shx(float v, int k, int lane) { return __uint_as_float((unsigned)__builtin_amdgcn_ds_bpermute((lane ^ k) << 2, (int)__float_as_uint(v))); }
__device__ __forceinline__ int shi(int v, int src, int lane) { (void)lane; return __builtin_amdgcn_ds_bpermute(src << 2, v); }
__device__ __forceinline__ float wave_sum(float v, int lane) {
#pragma unroll
    for (int o = 1; o < 64; o <<= 1) v += shx(v, o, lane);
    return v;
}
template <bool NT, bool F8 = false> __device__ __forceinline__ void transpose_item(const float* W, int ldw, int sca, int scb, const float* gain, bf16_t* WT, int K, int drow0, int k0, LAS float* scr, int lane, float f8s = 64.f) {
    const int r8 = lane >> 3, pc = lane & 7, c = lane & 7;
    f32x4 va[8], vb[8]; float g[8];
    const f32x4 z4 = {0.f, 0.f, 0.f, 0.f};
#pragma unroll
    for (int i = 0; i < 8; ++i) { const float* rp = W + (size_t)(k0 + i * 8 + r8) * ldw + 4 * pc;
        if (NT) { va[i] = sca >= 0 ? __builtin_nontemporal_load((const f32x4*)(rp + sca)) : z4; vb[i] = scb >= 0 ? __builtin_nontemporal_load((const f32x4*)(rp + scb)) : z4; }
        else { va[i] = sca >= 0 ? *(const f32x4*)(rp + sca) : z4; vb[i] = scb >= 0 ? *(const f32x4*)(rp + scb) : z4; }
        g[i] = gain ? gain[k0 + i * 8 + r8] : 1.0f; }
#pragma unroll
    for (int hf = 0; hf < 2; ++hf) {
#pragma unroll
        for (int i = 0; i < 8; ++i) { const f32x4 v = (hf == 0 ? va[i] : vb[i]) * g[i]; LAS float* d = scr + (i * 8 + r8) * 33 + 4 * pc; d[0] = v[0]; d[1] = v[1]; d[2] = v[2]; d[3] = v[3]; }
        asm volatile("s_waitcnt lgkmcnt(0)" ::: "memory");
#pragma unroll
        for (int j = 0; j < 4; ++j) { const int n = (lane >> 3) + 8 * j; const LAS float* s = scr + (8 * c) * 33 + n;
            u32x4 o; o.x = pk_bf16(s[0 * 33], s[1 * 33]); o.y = pk_bf16(s[2 * 33], s[3 * 33]); o.z = pk_bf16(s[4 * 33], s[5 * 33]); o.w = pk_bf16(s[6 * 33], s[7 * 33]);
            if (F8) { const f32x4 q0 = {s[0 * 33] * f8s, s[1 * 33] * f8s, s[2 * 33] * f8s, s[3 * 33] * f8s}, q1 = {s[4 * 33] * f8s, s[5 * 33] * f8s, s[6 * 33] * f8s, s[7 * 33] * f8s};
                *(u32x2*)((unsigned char*)WT + (size_t)(drow0 + hf * 32 + n) * K + k0 + 8 * c) = pack8_fp8(q0, q1); }
            else if (NT) __builtin_nontemporal_store(o, (u32x4*)(WT + (size_t)(drow0 + hf * 32 + n) * K + k0 + 8 * c)); else *(u32x4*)(WT + (size_t)(drow0 + hf * 32 + n) * K + k0 + 8 * c) = o; }
        asm volatile("s_waitcnt lgkmcnt(0)" ::: "memory");
    }
}
struct Fam { int src, count, K, Nd, ldw, map, gain, gstride; size_t sstride, dst, dstride; };
__device__ __forceinline__ int fam_items(const Fam& f) { return f.count * (f.K / 64) * (f.Nd / 64); }
__device__ __forceinline__ int fam_src_col(int map, int n0) {
    if (map == 1) return n0 < 384 ? n0 : (n0 < 416 ? 640 + (n0 - 384) : (n0 < 512 ? -1 : 384 + (n0 - 512)));
    if (map == 2) { const int pn = n0 >> 8, jj = n0 & 255; return jj < 128 ? pn * 128 + jj : 2816 + pn * 128 + (jj - 128); }
    if (map == 3) { const int h = n0 >> 7, off = n0 & 127; return off < 96 ? 96 * h + off : -1; }
    return n0;
}
template <bool NT = false> __device__ __forceinline__ void fam_item(const Args& a, const Fam& f, int fid, int it, LAS float* scr, int lane, int mi_off = 0) {
    const int per = (f.K / 64) * (f.Nd / 64), mi = it / per + mi_off, r = it % per, nblk = f.Nd / 64, kb = r / nblk, nb = r % nblk, n0 = nb * 64;
    const float* gain = nullptr;
    if (f.gain >= 0) gain = a.in[f.gain] + (fid == 11 ? (size_t)(2 * (mi >> 3) + 1) * 1024 : (size_t)mi * f.gstride);
#if FP8_DOWN || FP8_EGU
    if ((FP8_FDN && fid == 10) || (FP8_EDN && fid == 12) || (FP8_EGU && fid == 11) || (FP8_PG && fid == 7 && (mi & 1)) || (FP8_FGU2 && fid == 9 && mi == 1)) { transpose_item<NT, true>(a.in[f.src] + (size_t)mi * f.sstride, f.ldw, fam_src_col(f.map, n0), fam_src_col(f.map, n0 + 32), gain, (bf16_t*)(a.ws + f.dst + (size_t)mi * f.dstride), f.K, n0, kb * 64, scr, lane, (fid == 11 || fid == 9) ? 32.f : 64.f); return; }
#endif
    transpose_item<NT>(a.in[f.src] + (size_t)mi * f.sstride, f.ldw, fam_src_col(f.map, n0), fam_src_col(f.map, n0 + 32), gain, (bf16_t*)(a.ws + f.dst + (size_t)mi * f.dstride), f.K, n0, kb * 64, scr, lane);
}
__constant__ const Fam FAMS[13] = {
        {4, 2, 1024, 768, 672, 1, 3, 1024, (size_t)1024 * 672, W_AIN, (size_t)768 * 1024 * 2},
        {7, 2, 384, 1024, 768, 3, 5, 384, (size_t)384 * 768, W_QUP, (size_t)1024 * 384 * 2},
        {8, 2, 256, 1024, 1024, 0, 6, 256, (size_t)256 * 1024, W_KVUP, (size_t)1024 * 256 * 2},
        {11, 2, 512, 1024, 1024, 0, -1, 0, (size_t)512 * 1024, W_AOUT, (size_t)1024 * 512 * 2},
        {13, 1, 1024, 512, 512, 0, 12, 0, 0, W_KVS, 0},
        {15, 2, 1024, 1024, 1024, 0, 14, 1024, (size_t)1024 * 1024, W_QB, (size_t)1024 * 1024 * 2},
        {16, 2, 1024, 1024, 1024, 0, -1, 0, (size_t)1024 * 1024, W_OB, (size_t)1024 * 1024 * 2},
        {24, 4, 1024, 1024, 1024, 0, 23, 1024, (size_t)1024 * 1024, W_PG, (size_t)1024 * 1024 * 2},
        {25, 4, 256, 1024, 1024, 0, -1, 0, (size_t)256 * 1024, W_PU, (size_t)1024 * 256 * 2},
        {18, 1, 1024, 5632, 5632, 2, 17, 2048, (size_t)1024 * 5632, W_FGU, (size_t)5632 * 1024 * 2},
        {19, 1, 2816, 1024, 1024, 0, -1, 0, (size_t)2816 * 1024, W_FDN, (size_t)1024 * 2816 * 2},
        {21, 8, 1024, 5632, 5632, 2, 17, 0, (size_t)1024 * 5632, W_EGU, (size_t)5632 * 1024 * 2},
        {22, 8, 2816, 1024, 1024, 0, -1, 0, (size_t)2816 * 1024, W_EDN, (size_t)1024 * 2816 * 2}};
constexpr int DEF_N0 = 1408, DEF_N1 = DEF_N0 + 704, DEF_N2 = DEF_N1 + 11264, DEF_N3 = DEF_N2 + 5632;
#ifndef FILL_A
#define FILL_A 0
#define FILL_B 0
#define FILL_C 0
#define FILL_D 0
#endif
constexpr int DEF_QA = FILL_A, DEF_QB = DEF_QA + FILL_B, DEF_QC = DEF_QB + FILL_C, DEF_QD = DEF_QC + FILL_D;
constexpr int CV_NEXP = 7;
constexpr int CW_FILL = 512;
__device__ __forceinline__ void prologue(const Args& a, Frame& F) {
    LAS float* scr = (LAS float*)(F.lds + RING_OFF + F.wave * 16384);
    const int gw = F.vcu * NWAVES + F.wave, NGW = F.G * NWAVES;
    int base = 0;
    const bool split = (F.G == 256);
#pragma unroll 1
    for (int fid = 0; fid < (split ? 11 : 13); ++fid) { const Fam f = FAMS[fid]; const int n = fam_items(f);
        int it = gw - (base % NGW); if (it < 0) it += NGW;
#pragma unroll 1
        for (; it < n; it += NGW) fam_item(a, f, fid, it, scr, F.lane);
        base += n; }
    for (int id = DEF_QD + gw; id < (split ? DEF_N1 : DEF_N3); id += NGW) {
        if (id < DEF_N0) fam_item(a, FAMS[9], 9, id, scr, F.lane, 1);
        else if (id < DEF_N1) fam_item(a, FAMS[10], 10, id - DEF_N0, scr, F.lane, 1);
        else if (id < DEF_N2) fam_item(a, FAMS[11], 11, id - DEF_N1, scr, F.lane, 8);
        else fam_item(a, FAMS[12], 12, id - DEF_N2, scr, F.lane, 8);
    }
    if (split) {
        constexpr int P0 = 16 * 88, P1 = 44 * 16;
        for (int id = gw; id < 2 * (P0 + P1); id += NGW) { const int half = id >= (P0 + P1) ? 1 : 0, r = id - half * (P0 + P1);
            if (r < P0) fam_item(a, FAMS[11], 11, r, scr, F.lane, CV_NEXP + 8 * half); else fam_item(a, FAMS[12], 12, r - P0, scr, F.lane, CV_NEXP + 8 * half); } }
    { const f32x4* src = (const f32x4*)a.in[1]; u32x2* dst = (u32x2*)(a.ws + WS_PB); const size_t n4 = (size_t)4 * MT * 256 / 4, S = (size_t)NGW * 64;
        for (size_t i = (size_t)gw * 64 + F.lane; i < n4; i += 4 * S) { f32x4 v[4];
#pragma unroll
            for (int q = 0; q < 4; ++q) v[q] = (i + q * S < n4) ? src[i + q * S] : (f32x4){0.f, 0.f, 0.f, 0.f};
#pragma unroll
            for (int q = 0; q < 4; ++q) if (i + q * S < n4) { u32x2 o; o.x = pk_bf16(v[q][0], v[q][1]); o.y = pk_bf16(v[q][2], v[q][3]); dst[i + q * S] = o; } } }
    { bf16_t* HB = (bf16_t*)(a.ws + WS_HB); float* SSQ = (float*)(a.ws + WS_SSQ);
        for (int row = gw; row < MT; row += NGW) { const f32x4* xr = (const f32x4*)(a.in[0] + (size_t)row * DMODEL) + F.lane;
            u32x2* hb = (u32x2*)(HB + (size_t)row * DMODEL) + F.lane; float s = 0.f; f32x4 v4[4];
#pragma unroll
            for (int j = 0; j < 4; ++j) v4[j] = xr[64 * j];
#pragma unroll
            for (int j = 0; j < 4; ++j) { const f32x4 v = v4[j]; u32x2 o; o.x = pk_bf16(v[0], v[1]); o.y = pk_bf16(v[2], v[3]); hb[64 * j] = o; s += (v[0] * v[0] + v[1] * v[1]) + (v[2] * v[2] + v[3] * v[3]); }
            s = wave_sum(s, F.lane); if (F.lane < 16) SSQ[(size_t)row * 16 + F.lane] = F.lane == 0 ? s : 0.f; } }
    { float* cs = (float*)(a.ws + WS_CS); const int* pos = (const int*)a.in[2];
        for (int i = gw * 64 + F.lane; i < MT * 16; i += NGW * 64) { const int row = i >> 4, f = i & 15;
            const float invf = (float)exp(-9.210340371976184 * (double)f / 16.0);
            const double ang = (double)((float)pos[row] * invf);
            const double rev = ang * 0.15915494309189535, fr = rev - rint(rev); const float x = (float)(fr * 6.283185307179586);
            cs[(size_t)row * 32 + f] = cosf(x); cs[(size_t)row * 32 + 16 + f] = sinf(x); } }
}
#define THIN_LAUNDER() Frame F = F_; unsigned char* wsl = a.ws; F.lane = lane_id(); F.tid = F.wave * 64 + F.lane; asm volatile("" : "+v"(F.tid), "+v"(F.lane), "+s"(F.vcu), "+s"(F.G), "+s"(wsl))
__device__ __forceinline__ void filler(const Args& a, const Frame& F_, int qi, int start, int end) {
    Frame F = F_; { int t_ = F_.wave * 64 + lane_id(); asm volatile("" : "+v"(t_)); F.tid = t_; F.lane = t_ & 63; }
    unsigned char* wsl = a.ws; asm volatile("" : "+s"(wsl));
    LAS float* scr = (LAS float*)(F.lds + RING_OFF + F.wave * 16384);
    unsigned* ctr = (unsigned*)(wsl + WS_CTL) + CW_FILL + qi;
    for (;;) {
        int id = 0; if (F.lane == 0) id = (int)__hip_atomic_fetch_add(ctr, 1u, __ATOMIC_RELAXED, __HIP_MEMORY_SCOPE_AGENT) + start;
        id = __builtin_amdgcn_readfirstlane(id);
        if (id >= end) break;
        if (id < DEF_N0) fam_item<true>(a, FAMS[9], 9, id, scr, F.lane, 1);
        else if (id < DEF_N1) fam_item<true>(a, FAMS[10], 10, id - DEF_N0, scr, F.lane, 1);
        else if (id < DEF_N2) fam_item<true>(a, FAMS[11], 11, id - DEF_N1, scr, F.lane, 8);
        else fam_item<true>(a, FAMS[12], 12, id - DEF_N2, scr, F.lane, 8);
    }
}
__device__ __forceinline__ void moe_route(const Args& a, const Frame& F_, int layer, int cur) { THIN_LAUNDER();
    const bf16_t* HB = (const bf16_t*)(wsl + WS_HB) + (size_t)cur * MT * DMODEL; const float* gain = a.in[17] + (size_t)layer * 1024; const float* wr = a.in[20] + (size_t)(layer >> 1) * 1024 * 8;
    int* TOKE = (int*)(wsl + WS_TOKE); float* TOKG = (float*)(wsl + WS_TOKG); float* TOKRS = (float*)(wsl + WS_TOKRS); int* CNT = (int*)(wsl + WS_CNT);
    constexpr int LDW = 1032;
    LAS bf16_t* WB = (LAS bf16_t*)(F.lds + RING_OFF);
    LAS int* lcnt = (LAS int*)(F.lds + RING_OFF + 36864);
    LAS float* LG = (LAS float*)(F.lds + RING_OFF + 37888) + F.wave * 128;
    {
        const f32x4* w4p = (const f32x4*)wr + 4 * F.tid; const f32x4 w0 = w4p[0], w1 = w4p[1], w2 = w4p[2], w3 = w4p[3]; const float g0 = gain[2 * F.tid], g1 = gain[2 * F.tid + 1];
        const float xa[8] = {w0[0] * g0, w0[1] * g0, w0[2] * g0, w0[3] * g0, w1[0] * g0, w1[1] * g0, w1[2] * g0, w1[3] * g0};
        const float xb[8] = {w2[0] * g1, w2[1] * g1, w2[2] * g1, w2[3] * g1, w3[0] * g1, w3[1] * g1, w3[2] * g1, w3[3] * g1};
#pragma unroll
        for (int e = 0; e < 8; ++e) { const unsigned ha = pk_bf16(xa[e], 0.f) & 0xffffu, hb = pk_bf16(xb[e], 0.f) & 0xffffu;
            const float la = xa[e] - __uint_as_float(ha << 16), lb = xb[e] - __uint_as_float(hb << 16);
            *(LAS unsigned*)(WB + e * LDW + 2 * F.tid) = ha | (hb << 16); *(LAS unsigned*)(WB + (8 + e) * LDW + 2 * F.tid) = pk_bf16(la, lb); } }
    LAS float* SSW = (LAS float*)(F.lds + RING_OFF + 37888 + 4096);
    const int n = F.lane & 15, q = F.lane >> 4;
    for (int chunk = F.vcu; chunk < MT / 64; chunk += F.G) {
        if (F.tid < 8) lcnt[F.tid] = 0;
        __syncthreads();
        {
            const int tokw = chunk * 64 + (F.wave & 3) * 16, kh = (F.wave >> 2) * 512;
            const bf16_t* arow = HB + (size_t)(tokw + n) * DMODEL + 8 * q + kh; const LAS bf16_t* brow = WB + n * LDW + 8 * q + kh;
            f32x4 acc = {0.f, 0.f, 0.f, 0.f}; float ss = 0.f;
#pragma unroll
            for (int s = 0; s < 16; ++s) { const u32x4 av = *(const u32x4*)(arow + 32 * s); const bf16x8 bv = *(const LAS bf16x8*)(brow + 32 * s);
                acc = __builtin_amdgcn_mfma_f32_16x16x32_bf16(__builtin_bit_cast(bf16x8, av), bv, acc, 0, 0, 0);
                f32x4 x0, x1; unpack8(av, x0, x1); ss += pg8::sumsq8(x0, x1); }
            ss = pg8::red_fq(ss);
#pragma unroll
            for (int i = 0; i < 4; ++i) { const float v = acc[i] + shx(acc[i], 8, F.lane); if (n < 8) LG[(4 * q + i) * 8 + n] = v; }
            if (q == 0) SSW[F.wave * 16 + n] = ss;
        }
        __syncthreads();
        if (F.wave < 4) {
            const int tok0 = chunk * 64 + F.wave * 16;
            asm volatile("s_waitcnt lgkmcnt(0)" ::: "memory");
            if (F.lane < 16) { const int tok = tok0 + F.lane; const LAS f32x4* lp = (const LAS f32x4*)(LG + F.lane * 8); const f32x4 l0 = lp[0] + lp[128], l1 = lp[1] + lp[129];
                const float ss = SSW[F.wave * 16 + F.lane] + SSW[(F.wave + 4) * 16 + F.lane];
                const float lg[8] = {l0[0], l0[1], l0[2], l0[3], l1[0], l1[1], l1[2], l1[3]};
                const float r = fast_rsq(ss * (1.0f / 1024.0f) + RMS_EPS);
                int e1 = 0; float v1 = lg[0];
#pragma unroll
                for (int e = 1; e < 8; ++e) if (lg[e] > v1) { v1 = lg[e]; e1 = e; }
                int e2 = 0; float v2 = -3.0e38f;
#pragma unroll
                for (int e = 0; e < 8; ++e) if (e != e1 && lg[e] > v2) { v2 = lg[e]; e2 = e; }
                const float p2 = __expf((v2 - v1) * r), g1 = 1.0f / (1.0f + p2), g2 = p2 / (1.0f + p2);
                TOKE[tok] = e1 | (e2 << 8); TOKG[tok * 2] = g1; TOKG[tok * 2 + 1] = g2; TOKRS[tok] = r;
                __hip_atomic_fetch_add(lcnt + e1, 1, __ATOMIC_RELAXED, __HIP_MEMORY_SCOPE_WORKGROUP); __hip_atomic_fetch_add(lcnt + e2, 1, __ATOMIC_RELAXED, __HIP_MEMORY_SCOPE_WORKGROUP); }
        }
        __syncthreads();
        if (F.tid < 8) CNT[chunk * 8 + F.tid] = lcnt[F.tid];
        __syncthreads();
    }
}
__device__ __forceinline__ void moe_scatter(const Args& a, const Frame& F_, int cur) { THIN_LAUNDER();
    const int* TOKE = (const int*)(wsl + WS_TOKE); const float* TOKG = (const float*)(wsl + WS_TOKG); const float* TOKRS = (const float*)(wsl + WS_TOKRS); const int* CNT = (const int*)(wsl + WS_CNT);
    int* SLOT12 = (int*)(wsl + WS_SLOT12); float* SLOTG = (float*)(wsl + WS_SLOTG); float* SLOTRS = (float*)(wsl + WS_SLOTRS); int* PSTART = (int*)(wsl + WS_PSTART);
    const bf16_t* HB = (const bf16_t*)(wsl + WS_HB) + (size_t)cur * MT * DMODEL; bf16_t* XG = (bf16_t*)(wsl + X_XG);
    LAS int* sm = (LAS int*)(F.lds + RING_OFF);
    for (int chunk = F.vcu; chunk < MT / 64; chunk += F.G) {
        { const int e = F.wave; int c4[4]; int s = 0;
#pragma unroll
            for (int i = 0; i < 4; ++i) { c4[i] = CNT[(4 * F.lane + i) * 8 + e]; s += c4[i]; }
            int inc = s;
#pragma unroll
            for (int o = 1; o < 64; o <<= 1) { const int t = shi(inc, F.lane >= o ? F.lane - o : F.lane, F.lane); if (F.lane >= o) inc += t; }
            const int total = shi(inc, 63, F.lane); int pre = inc - s;
            if (F.lane == (chunk >> 2)) { const int cm = chunk & 3; pre += (cm > 0 ? c4[0] : 0) + (cm > 1 ? c4[1] : 0) + (cm > 2 ? c4[2] : 0); sm[8 + e] = pre; }
            if (F.lane == 0) sm[e] = total; }
        __syncthreads();
        if (F.tid == 0) { int p = 0; for (int e = 0; e < 8; ++e) { sm[16 + e] = p; p += (sm[e] + 255) >> 8; } sm[24] = p; }
        __syncthreads();
        if (F.tid < 9) PSTART[F.tid] = sm[16 + F.tid];
        if (F.wave == 0) { const int tok = chunk * 64 + F.lane; const int ev = TOKE[tok], e1 = ev & 255, e2 = ev >> 8; int s1 = 0, s2 = 0;
            const unsigned long long below = (1ull << F.lane) - 1ull;
#pragma unroll
            for (int e = 0; e < 8; ++e) { const unsigned long long m1 = __ballot(e1 == e), m2 = __ballot(e2 == e);
                const int rank = __popcll(m1 & below) + __popcll(m2 & below), slot = sm[16 + e] * 256 + sm[8 + e] + rank;
                if (e1 == e) s1 = slot; if (e2 == e) s2 = slot; }
            SLOT12[tok * 2] = s1; SLOT12[tok * 2 + 1] = s2; const float r = TOKRS[tok];
            SLOTG[s1] = TOKG[tok * 2]; SLOTG[s2] = TOKG[tok * 2 + 1]; SLOTRS[s1] = r; SLOTRS[s2] = r;
            sm[32 + 2 * F.lane] = s1; sm[32 + 2 * F.lane + 1] = s2; }
        __syncthreads();
#if FP8_EGU
        {
            u32x4 a0[8], a1[8]; float rr[8]; int sl1[8], sl2[8];
#pragma unroll
            for (int i = 0; i < 8; ++i) { const int tl = F.wave * 8 + i, tok = chunk * 64 + tl; const u32x4* src = (const u32x4*)(HB + (size_t)tok * DMODEL) + 2 * F.lane;
                a0[i] = src[0]; a1[i] = src[1]; rr[i] = TOKRS[tok]; sl1[i] = sm[32 + 2 * tl]; sl2[i] = sm[32 + 2 * tl + 1]; }
#pragma unroll
            for (int i = 0; i < 8; ++i) { f32x4 x0, x1, y0, y1; unpack8(a0[i], x0, x1); unpack8(a1[i], y0, y1); const float r = rr[i];
                const u32x2 lo = pack8_fp8(x0 * r, x1 * r), hi = pack8_fp8(y0 * r, y1 * r); const u32x4 o = {lo.x, lo.y, hi.x, hi.y};
                *((u32x4*)((unsigned char*)XG + (size_t)sl1[i] * DMODEL) + F.lane) = o; *((u32x4*)((unsigned char*)XG + (size_t)sl2[i] * DMODEL) + F.lane) = o; }
        }
#else
        for (int i = 0; i < 16; ++i) { const int pr = F.wave * 16 + i, tok = chunk * 64 + (pr >> 1), slot = sm[32 + pr];
            const u32x4* src = (const u32x4*)(HB + (size_t)tok * DMODEL) + F.lane; u32x4* dst = (u32x4*)(XG + (size_t)slot * DMODEL) + F.lane;
            dst[0] = src[0]; dst[64] = src[64]; }
#endif
        __syncthreads();
    }
}
__device__ __forceinline__ void moe_combine(const Args& a, const Frame& F_, int cur, bool dummy) { THIN_LAUNDER();
    const int* SLOT12 = (const int*)(wsl + WS_SLOT12); const bf16_t* YG = (const bf16_t*)(wsl + X_YG); const float* TOKG = (const float*)(wsl + WS_TOKG);
    const bf16_t* HBi = (const bf16_t*)(wsl + WS_HB) + (size_t)cur * MT * DMODEL;
    bf16_t* HB = dummy ? (bf16_t*)(wsl + WS_END + 66 * MiB) : (bf16_t*)(wsl + WS_HB) + (size_t)cur * MT * DMODEL; float* SSQ = dummy ? (float*)(wsl + WS_END + 99 * MiB) : (float*)(wsl + WS_SSQ) + (size_t)cur * MT * 16;
    const int gw = F.vcu * NWAVES + F.wave, NGW = F.G * NWAVES;
    for (int r0 = F.vcu * 64; r0 < MT; r0 += F.G * 64) {
        const int rw = r0 + F.wave * 8;
        u32x2 sl = {0u, 0u}; f32x2 gg = {0.f, 0.f};
        if (F.lane < 8) { sl = *(const u32x2*)(SLOT12 + (size_t)(rw + F.lane) * 2); gg = *(const f32x2*)(TOKG + (size_t)(rw + F.lane) * 2); }
#pragma unroll
        for (int k2 = 0; k2 < 8; k2 += 2) {
            u32x2 hv[2][4], pv_[2][4], qv[2][4]; float g1[2], g2[2];
#pragma unroll
            for (int t = 0; t < 2; ++t) { const int row = rw + k2 + t; const int s1 = __builtin_amdgcn_readlane((int)sl.x, k2 + t), s2 = __builtin_amdgcn_readlane((int)sl.y, k2 + t);
                g1[t] = __uint_as_float(__builtin_amdgcn_readlane(__float_as_uint(gg.x), k2 + t)); g2[t] = __uint_as_float(__builtin_amdgcn_readlane(__float_as_uint(gg.y), k2 + t));
                const u32x2* hr = (const u32x2*)(HBi + (size_t)row * DMODEL) + F.lane; const u32x2* y1 = (const u32x2*)(YG + (size_t)s1 * DMODEL) + F.lane; const u32x2* y2 = (const u32x2*)(YG + (size_t)s2 * DMODEL) + F.lane;
#pragma unroll
                for (int j = 0; j < 4; ++j) { hv[t][j] = hr[64 * j]; pv_[t][j] = y1[64 * j]; qv[t][j] = y2[64 * j]; } }
#pragma unroll
            for (int t = 0; t < 2; ++t) { const int row = rw + k2 + t; u32x2* hb = (u32x2*)(HB + (size_t)row * DMODEL) + F.lane; float s = 0.f;
#pragma unroll
                for (int j = 0; j < 4; ++j) { const u32x2 h = hv[t][j], p = pv_[t][j], q = qv[t][j]; f32x4 v;
                    v[0] = bf_lo(h.x) + (g1[t] * bf_lo(p.x) + g2[t] * bf_lo(q.x)); v[1] = bf_hi(h.x) + (g1[t] * bf_hi(p.x) + g2[t] * bf_hi(q.x)); v[2] = bf_lo(h.y) + (g1[t] * bf_lo(p.y) + g2[t] * bf_lo(q.y)); v[3] = bf_hi(h.y) + (g1[t] * bf_hi(p.y) + g2[t] * bf_hi(q.y));
                    u32x2 o; o.x = pk_bf16(v[0], v[1]); o.y = pk_bf16(v[2], v[3]); hb[64 * j] = o; s += (v[0] * v[0] + v[1] * v[1]) + (v[2] * v[2] + v[3] * v[3]);
#if FP8_PG
                    { int w8 = 0; w8 = __builtin_amdgcn_cvt_pk_fp8_f32(__builtin_amdgcn_fmed3f(v[0], -448.f, 448.f), __builtin_amdgcn_fmed3f(v[1], -448.f, 448.f), w8, false); w8 = __builtin_amdgcn_cvt_pk_fp8_f32(__builtin_amdgcn_fmed3f(v[2], -448.f, 448.f), __builtin_amdgcn_fmed3f(v[3], -448.f, 448.f), w8, true);
                      ((unsigned*)(wsl + X_HB8 + (size_t)row * DMODEL))[F.lane + 64 * j] = (unsigned)w8; }
#endif
                }
                s = wave_sum(s, F.lane); if (F.lane < 16) SSQ[(size_t)row * 16 + F.lane] = F.lane == 0 ? s : 0.f; }
        }
    }
}

__constant__ const unsigned short MLA_TAB[216][3] = {
    {189, 200, 65535}, {191, 294, 65535}, {31, 230, 65535}, {375, 71, 70}, {286, 355, 323}, {447, 357, 128}, {253, 104, 65535}, {415, 387, 130},
    {93, 36, 483}, {63, 451, 354}, {479, 421, 96}, {340, 270, 322}, {348, 359, 33}, {126, 6, 32}, {508, 458, 65535}, {185, 429, 65535},
    {219, 10, 65535}, {220, 360, 288}, {255, 101, 192}, {25, 40, 67}, {59, 42, 65535}, {478, 259, 419}, {118, 361, 37}, {410, 459, 65535},
    {218, 44, 65535}, {510, 486, 384}, {30, 231, 65535}, {446, 167, 65535}, {94, 293, 289}, {313, 198, 389}, {254, 38, 480}, {372, 498, 65535},
    {511, 292, 385}, {60, 5, 3}, {351, 166, 65535}, {505, 263, 132}, {95, 327, 65535}, {29, 232, 65535}, {383, 163, 162}, {409, 428, 65535},
    {61, 424, 65535}, {283, 106, 65535}, {150, 431, 65535}, {159, 262, 65535}, {90, 489, 97}, {316, 73, 65535}, {57, 102, 261}, {62, 356, 290},
    {377, 9, 34}, {124, 135, 193}, {344, 397, 65535}, {413, 260, 195}, {251, 266, 65535}, {190, 229, 65}, {445, 8, 65535}, {282, 171, 65535},
    {157, 456, 65535}, {248, 365, 65535}, {379, 295, 194}, {252, 457, 65535}, {346, 453, 133}, {123, 138, 65535}, {414, 196, 66}, {347, 362, 65535},
    {371, 82, 65535}, {310, 367, 65535}, {350, 487, 65535}, {158, 264, 65535}, {509, 105, 65535}, {186, 358, 100}, {342, 332, 98}, {91, 325, 388},
    {442, 331, 65535}, {349, 265, 65535}, {217, 108, 65535}, {152, 301, 65535}, {378, 422, 452}, {21, 392, 103}, {319, 35, 386}, {444, 39, 1},
    {27, 426, 65535}, {276, 81, 65535}, {183, 14, 65535}, {54, 111, 65535}, {473, 492, 65535}, {381, 168, 65535}, {86, 233, 69}, {502, 268, 418},
    {285, 136, 65535}, {223, 197, 352}, {119, 142, 65535}, {406, 298, 228}, {470, 493, 129}, {287, 134, 65535}, {476, 394, 65535}, {441, 396, 65535},
    {156, 169, 65535}, {440, 461, 65535}, {281, 140, 65535}, {125, 328, 65535}, {272, 80, 324}, {507, 202, 65535}, {278, 207, 65535}, {475, 490, 65535},
    {127, 454, 65535}, {400, 77, 7}, {53, 144, 65535}, {311, 430, 65535}, {275, 402, 65535}, {309, 297, 390}, {250, 11, 65535}, {439, 427, 450},
    {315, 74, 65535}, {92, 329, 65535}, {477, 484, 99}, {188, 201, 65535}, {376, 45, 65535}, {317, 296, 65535}, {55, 110, 65535}, {318, 455, 65535},
    {52, 369, 65535}, {499, 496, 481}, {443, 107, 65535}, {380, 170, 65535}, {506, 299, 65535}, {471, 204, 161}, {58, 75, 65535}, {279, 76, 225},
    {147, 366, 131}, {181, 143, 416}, {87, 271, 65535}, {503, 462, 65535}, {179, 178, 65535}, {382, 391, 65535}, {187, 137, 256}, {56, 234, 482},
    {213, 337, 65535}, {222, 423, 65535}, {180, 273, 65535}, {411, 363, 65535}, {504, 494, 65535}, {221, 72, 65535}, {314, 491, 65535}, {249, 300, 65535},
    {115, 335, 258}, {121, 267, 224}, {374, 334, 64}, {23, 12, 449}, {474, 235, 65535}, {472, 333, 65535}, {408, 206, 65535}, {436, 274, 65535},
    {212, 497, 65535}, {407, 398, 65535}, {242, 399, 291}, {120, 237, 65535}, {468, 209, 65535}, {83, 146, 65535}, {247, 109, 448}, {312, 199, 165},
    {500, 112, 0}, {151, 364, 353}, {26, 203, 65535}, {339, 303, 226}, {114, 465, 321}, {435, 307, 65535}, {277, 145, 65535}, {308, 434, 65535},
    {182, 240, 65535}, {467, 338, 65535}, {343, 238, 65535}, {280, 488, 164}, {149, 48, 65535}, {184, 205, 65535}, {245, 113, 65535}, {246, 495, 65535},
    {18, 174, 68}, {154, 139, 65535}, {117, 176, 65535}, {214, 15, 65535}, {244, 336, 160}, {341, 16, 65535}, {89, 460, 65535}, {373, 49, 65535},
    {85, 464, 65535}, {284, 393, 65535}, {438, 239, 65535}, {243, 51, 65535}, {432, 302, 326}, {404, 241, 65535}, {437, 368, 65535}, {210, 79, 227},
    {19, 47, 2}, {22, 175, 65535}, {122, 395, 65535}, {412, 425, 65535}, {155, 330, 65535}, {501, 43, 420}, {177, 46, 485}, {345, 236, 65535},
    {24, 173, 65535}, {216, 269, 65535}, {215, 78, 65535}, {20, 463, 257}, {50, 370, 320}, {153, 172, 65535}, {405, 208, 65535}, {148, 305, 65535},
    {116, 17, 65535}, {403, 13, 4}, {88, 141, 65535}, {466, 401, 417}, {211, 306, 65535}, {84, 433, 65535}, {469, 304, 65535}, {28, 41, 65535}};
struct CvItem { const float* W; const float* gain; unsigned char* WT; int ldw, sca, scb, K, drow0, k0; float f8s; };
struct CvRegs { f32x4 v[8]; };
constexpr int CV_GAIN_OFF = 8 * 16384 - 4096;
constexpr int CV_NE0 = CV_NEXP * 16 * 88, CV_NE1 = CV_NEXP * 44 * 16;
__device__ __forceinline__ CvItem cv_item(const Args& a, int id, int mi_off) {
    const bool gu = id < CV_NE0; const Fam f = FAMS[gu ? 11 : 12]; const int it = gu ? id : id - CV_NE0;
    const int per = (f.K / 64) * (f.Nd / 64), mi = it / per + mi_off, r = it % per, nblk = f.Nd / 64, kb = r / nblk, nb = r % nblk, n0 = nb * 64;
    CvItem c; c.W = a.in[f.src] + (size_t)mi * f.sstride; c.ldw = f.ldw; c.sca = fam_src_col(f.map, n0); c.scb = fam_src_col(f.map, n0 + 32);
    c.gain = gu ? (const float*)1 : nullptr; c.WT = a.ws + f.dst + (size_t)mi * f.dstride; c.K = f.K; c.drow0 = n0; c.k0 = kb * 64; c.f8s = gu ? 32.f : 64.f; return c; }
__device__ __forceinline__ void cv_load(CvRegs& R, const CvItem& c, int hf, int lane) { const int r8 = lane >> 3, pc = lane & 7; const int sc = hf ? c.scb : c.sca;
#pragma unroll
    for (int i = 0; i < 8; ++i) R.v[i] = *(const f32x4*)(c.W + (size_t)(c.k0 + i * 8 + r8) * c.ldw + 4 * pc + sc); }
__device__ __forceinline__ void cv_finish(const CvRegs& R, const CvItem& c, int hf, LAS float* scr, const LAS float* gl, int lane) { const int r8 = lane >> 3, pc = lane & 7, cc = lane & 7;
#pragma unroll
    for (int i = 0; i < 8; ++i) { const float gs = c.gain ? gl[c.k0 + i * 8 + r8] * c.f8s : c.f8s; const f32x4 v = R.v[i] * gs; LAS float* d = scr + (i * 8 + r8) * 33 + 4 * pc; d[0] = v[0]; d[1] = v[1]; d[2] = v[2]; d[3] = v[3]; }
    asm volatile("s_waitcnt lgkmcnt(0)" ::: "memory");
#pragma unroll
    for (int j = 0; j < 4; ++j) { const int n = (lane >> 3) + 8 * j; const LAS float* s = scr + (8 * cc) * 33 + n;
        const f32x4 q0 = {s[0 * 33], s[1 * 33], s[2 * 33], s[3 * 33]}, q1 = {s[4 * 33], s[5 * 33], s[6 * 33], s[7 * 33]};
        *(u32x2*)(c.WT + (size_t)(c.drow0 + hf * 32 + n) * c.K + c.k0 + 8 * cc) = pack8_fp8(q0, q1); }
    asm volatile("s_waitcnt lgkmcnt(0)" ::: "memory");
}
__device__ __forceinline__ void convert_experts(const Args& a, const Frame& F_, int mi_off, int cidx) { THIN_LAUNDER();
    LAS float* scr = (LAS float*)(F.lds + RING_OFF + F.wave * 16384);
    constexpr int N = CV_NE0 + CV_NE1, ST = 40 * NWAVES;
    LAS float* gl = (LAS float*)(F.lds + RING_OFF + CV_GAIN_OFF);
    { const float* gsrc = a.in[17] + (size_t)(2 * (mi_off >> 3) + 1) * 1024; gl[F.tid] = gsrc[F.tid]; gl[F.tid + NTHR] = gsrc[F.tid + NTHR]; }
    __syncthreads();
    const int id0 = cidx * NWAVES + F.wave; if (id0 >= N) return;
    const int S = 2 * ((N - id0 + ST - 1) / ST);
    CvRegs R[5];
#define CV_LD(SL, q_) cv_load(R[SL], cv_item(a, id0 + ((q_) >> 1) * ST, mi_off), (q_) & 1, F.lane)
#define CV_FIN(SL, q_) cv_finish(R[SL], cv_item(a, id0 + ((q_) >> 1) * ST, mi_off), (q_) & 1, scr, gl, F.lane)
    CV_LD(0, 0); CV_LD(1, 1); if (2 < S) CV_LD(2, 2); if (3 < S) CV_LD(3, 3);
#pragma unroll 1
    for (int q = 0; ; q += 5) {
        if (q + 4 < S) CV_LD(4, q + 4); CV_FIN(0, q);     if (q + 1 >= S) break;
        if (q + 5 < S) CV_LD(0, q + 5); CV_FIN(1, q + 1); if (q + 2 >= S) break;
        if (q + 6 < S) CV_LD(1, q + 6); CV_FIN(2, q + 2); if (q + 3 >= S) break;
        if (q + 7 < S) CV_LD(2, q + 7); CV_FIN(3, q + 3); if (q + 4 >= S) break;
        if (q + 8 < S) CV_LD(3, q + 8); CV_FIN(4, q + 4); if (q + 5 >= S) break;
    }
#undef CV_LD
#undef CV_FIN
}

__global__ void __launch_bounds__(NTHR, 2) yoco_fwd(Args args) {
    extern __shared__ __attribute__((aligned(16))) unsigned char lds_raw[];
    Frame F; F.lds = (LAS unsigned char*)lds_raw;
    volatile LAS unsigned* MISC = (volatile LAS unsigned*)(F.lds + MISC_OFF);
    F.wave = __builtin_amdgcn_readfirstlane((int)threadIdx.x >> 6); F.lane = lane_id(); F.tid = F.wave * 64 + F.lane;
    F.G = gridDim.x; { const int bx = blockIdx.x; F.vcu = (F.G % 8 == 0) ? (bx % 8) * (F.G / 8) + bx / 8 : bx; }
    for (int u = F.tid; u < (LDS_BYTES - LDSCTL_OFF) / 4; u += NTHR) ((LAS unsigned*)(F.lds + LDSCTL_OFF))[u] = 0u;
    __syncthreads();
    unsigned char* ws = args.ws;
#define WS_LAUNDER() do { F.lane = lane_id(); F.tid = F.wave * 64 + F.lane; asm volatile("" : "+s"(ws), "+s"(bx), "+s"(F.G), "+s"(F.vcu), "+v"(F.tid), "+v"(F.lane)); } while (0)
    const bool single = (args.ph_hi - args.ph_lo) > 1;
    XcdBarrier bar; bar.bar = (unsigned*)(ws + WS_CTL) + CW_BAR; bar.x = 0; bar.st = nullptr; bar.wv = F.wave;
    if (single) bar = xcd_barrier_post((unsigned*)(ws + WS_CTL) + CW_BAR, MISC + 8, F.wave);
    if (single && F.wave == 0 && lane_id() == 0) __hip_atomic_store((unsigned*)(ws + WS_CTL) + CW_BAR + XB_CHK + (int)blockIdx.x, bar.x + 1u, __ATOMIC_RELAXED, __HIP_MEMORY_SCOPE_AGENT);
    const int lo = args.ph_lo, hi = args.ph_hi;
    bool local_ok = false;
#ifndef GU_ALIGN
#define GU_ALIGN true
#endif
#ifndef EN_MASK
#define EN_MASK 0xFFFFFFFFu
#endif
#define EN(b) (((EN_MASK) >> (b)) & 1u)
#define IN(k) (lo <= (k) && (k) < hi)
#define B_WARM_ISSUE(BT, N_, K_) unsigned w0_ = 0u, w1_ = 0u; do { pg8::StaticOrder sw_; sw_.init(MT, (N_), F.G, bx); pg8::Unit wu_; if (sw_.next(0, wu_)) { \
        const unsigned char* wb_ = (const unsigned char*)((BT) + (size_t)wu_.pn * 256 * (K_)) + (size_t)(F.tid >> 1) * (K_) * 2 + (F.tid & 1) * 256; \
        asm volatile("global_load_dword %0, %2, off\n\tglobal_load_dword %1, %2, off offset:128" : "=&v"(w0_), "=&v"(w1_) : "v"(wb_) : "memory"); } } while (0)
#define B_WARM_RETIRE() do { asm volatile("s_waitcnt vmcnt(0)" ::: "memory"); asm volatile("" :: "v"(w0_), "v"(w1_)); } while (0)
#define PU_TAIL(NWG) do { WS_LAUNDER(); const int r_ = (NWG) % F.G, ni_ = r_ ? F.G - r_ : F.G; \
        pg8::Gemm g2{(const bf16_t*)(ws + WS_PB) + (size_t)l * MT * 256, (const bf16_t*)(ws + W_PU) + (size_t)l * 1024 * 256, MT, 1024, 256}; \
        pg8::StaticOrder S2; S2.init(MT, 1024, ni_, bx >= r_ ? bx - r_ : (1 << 24)); \
        pg8::EpiScale E2{(bf16_t*)(ws + WS_U) + (size_t)l * MT * DMODEL, 1024, pg8::RowScale{nullptr, 0}, 1.0f}; \
        pg8::gemm_phase<pg8::EpiScale, pg8::StaticOrder, true, true>(ring, g2, S2, E2, F.wave); } while (0)
#ifdef REP_MASK
#define NREPS(k) ((((unsigned long long)(REP_MASK) >> (k)) & 1ull) ? (REP_N) + 1 : 1)
#else
#define NREPS(k) 1
#endif
#define REPLOOP(k) for (int rep_ = 0, nrep_ = NREPS(k); rep_ < nrep_; ++rep_)
#define DUMMY (rep_ + 1 < nrep_)
#define OUT_HB(set) (DUMMY ? (bf16_t*)(ws + WS_END + 66 * MiB) : (bf16_t*)(ws + WS_HB) + (size_t)(set) * MT * DMODEL)
#define OUT_SSQ(set) (DUMMY ? (float*)(ws + WS_END + 99 * MiB) : (float*)(ws + WS_SSQ) + (size_t)(set) * MT * 16)
#define SEAM(k) do { if (single && (k) + 1 < hi) { XcdBarrier b_ = bar; asm volatile("" : "+s"(b_.bar), "+s"(b_.x)); xcd_barrier(b_); } } while (0)
#define SEAM_L(k) do { if (single && (k) + 1 < hi) { XcdBarrier b_ = bar; asm volatile("" : "+s"(b_.bar), "+s"(b_.x)); if (local_ok) xcd_local_barrier(b_); else xcd_barrier(b_); } } while (0)

    LAS unsigned char* ring = F.lds + RING_OFF;
    int bx = (int)blockIdx.x;

    if (EN(0) && IN(0)) REPLOOP(0) { WS_LAUNDER(); prologue(args, F); SEAM(0); }
#ifndef NO_LOCAL_SEAMS
    if (single && lo == 0 && hi > 1) {
        const int t_ = F.wave * 64 + lane_id(); unsigned* chk = (unsigned*)(ws + WS_CTL) + CW_BAR + XB_CHK;
        int good = (F.G == 256);
        if (good && t_ < 256) { const unsigned a = __hip_atomic_load(chk + t_, __ATOMIC_RELAXED, __HIP_MEMORY_SCOPE_AGENT), r = __hip_atomic_load(chk + (t_ & 7), __ATOMIC_RELAXED, __HIP_MEMORY_SCOPE_AGENT); good = (a != 0u && a == r); }
        local_ok = __syncthreads_and(good) != 0;
    }
#endif
#ifdef EXTRA_BARRIERS
    if (single) for (int xb_ = 0; xb_ < EXTRA_BARRIERS; ++xb_) { XcdBarrier b_ = bar; asm volatile("" : "+s"(b_.bar), "+s"(b_.x)); xcd_barrier(b_); }
#endif
#pragma unroll 1
    for (int l = 0; l < 4; ++l) {
        const int base = 2 + PH_PER_LAYER * l; const bool is_mla = l < 2, is_moe = (l & 1) != 0; const int cur = l & 1, j = l & 1;
#define HBc ((const bf16_t*)(ws + WS_HB) + (size_t)cur * MT * DMODEL)
#define HBw ((bf16_t*)(ws + WS_HB) + (size_t)cur * MT * DMODEL)
#define SSQc ((float*)(ws + WS_SSQ) + (size_t)cur * MT * 16)
        if (IN(base + 0)) REPLOOP(base + 0) { WS_LAUNDER();
            if (EN(2) && is_mla) {
                pg8::Gemm g{HBc, (const bf16_t*)(ws + W_AIN) + (size_t)l * 768 * 1024, MT, 768, 1024};
                pg8::StaticOrder S; S.init(MT, 768, F.G, bx);
                pg8::EpiAin E{(bf16_t*)(ws + X_AQ), (bf16_t*)(ws + X_AKV), (float*)(ws + WS_KPE), (float*)(ws + WS_SSQQ), (float*)(ws + WS_SSQKV), pg8::RowScale{SSQc, 1}, args.in[10] + l * 96, (const float*)(ws + WS_CS), (float*)(ws + WS_SSPE)};
                pg8::gemm_phase<pg8::EpiAin, pg8::StaticOrder, true, true>(ring, g, S, E, F.wave);
            } else if (EN(3) && !is_mla) {
                pg8::Gemm g{HBc, (const bf16_t*)(ws + W_QB) + (size_t)j * 1024 * 1024, MT, 1024, 1024};
                pg8::StaticOrder S; S.init(MT, 1024, F.G, bx);
                pg8::EpiScale E{(bf16_t*)(ws + X_SQ), 1024, pg8::RowScale{SSQc, 1}, QSCALE_SB};
                pg8::gemm_phase<pg8::EpiScale, pg8::StaticOrder, true, true>(ring, g, S, E, F.wave);
                asm volatile("s_waitcnt vmcnt(0)" ::: "memory"); __syncthreads();
                __builtin_amdgcn_fence(__ATOMIC_ACQUIRE, "agent"); asm volatile("s_waitcnt vmcnt(0)" ::: "memory");
                WS_LAUNDER();
                pg8::StaticOrder S2; S2.init(MT, 1024, F.G, bx); pg8::Unit uu;
                for (int ui = 0; S2.next(ui, uu); ++ui)
                    for (int i4 = 0; i4 < 4; ++i4) {
#ifdef SBA_ABL
                        if (DUMMY) att::sba::unit<SBA_ABL>(uu.pm >> 5, uu.pn, (uu.pm & 31) * 4 + i4, (const bf16_t*)(ws + X_SQ), (const bf16_t*)(ws + WS_SKT), (const bf16_t*)(ws + WS_SVT), (bf16_t*)(ws + WS_END + 66 * MiB), ring, F.wave); else
#endif
                        att::sba::unit<0>(uu.pm >> 5, uu.pn, (uu.pm & 31) * 4 + i4, (const bf16_t*)(ws + X_SQ), (const bf16_t*)(ws + WS_SKT), (const bf16_t*)(ws + WS_SVT), (bf16_t*)(ws + X_SO), ring, F.wave); }
            }
            SEAM_L(base + 0);
        }
        if (EN(4) && is_mla && IN(base + 1)) REPLOOP(base + 1) { WS_LAUNDER();
            { pg8::Gemm g{(const bf16_t*)(ws + X_AQ), (const bf16_t*)(ws + W_QUP) + (size_t)l * 1024 * 384, MT, 1024, 384};
              pg8::StaticOrder S; S.init(MT, 1024, F.G, bx);
              EpiQ E{ws, args.in[9] + l * 96};
              pg8::gemm_phase<EpiQ, pg8::StaticOrder, true, true, false, true>(ring, g, S, E, F.wave); }
            { pg8::Gemm g{(const bf16_t*)(ws + X_AKV), (const bf16_t*)(ws + W_KVUP) + (size_t)l * 1024 * 256, MT, 1024, 256};
              pg8::StaticOrder S; S.init(MT, 1024, F.G, bx);
              EpiKV E{ws, args.in[10] + l * 96};
              pg8::gemm_phase<EpiKV, pg8::StaticOrder, true, true, false, true>(ring, g, S, E, F.wave); }
            SEAM(base + 1);
        }
        if (is_mla && IN(base + 3)) REPLOOP(base + 3) { WS_LAUNDER();
#if defined(MLA_ABL)
            if (EN(6) && is_mla && DUMMY) att::mla::phase<MLA_ABL>(F.vcu, F.G, (const bf16_t*)(ws + X_Q), (const bf16_t*)(ws + X_KT), (const bf16_t*)(ws + X_VT), (bf16_t*)(ws + WS_END + 66 * MiB), ring, F.wave);
            else
#endif
            if (EN(6) && is_mla) {
                if (F.G != 256) att::mla::phase<0>(F.vcu, F.G, (const bf16_t*)(ws + X_Q), (const bf16_t*)(ws + X_KT), (const bf16_t*)(ws + X_VT), (bf16_t*)(ws + X_O), ring, F.wave);
                else if (bx >= 216) {
#ifdef CONV_ABL
                    if (!DUMMY)
#endif
                    convert_experts(args, F, l * 8, bx - 216); }
                else {
#pragma unroll 1
                    for (int k3 = 0; k3 < 3; ++k3) { const int e = (int)MLA_TAB[bx][k3]; if (e == 0xFFFF) break;
                        att::mla::unit<0>(e >> 8, (e >> 5) & 7, e & 31, (const bf16_t*)(ws + X_Q), (const bf16_t*)(ws + X_KT), (const bf16_t*)(ws + X_VT), DUMMY ? (bf16_t*)(ws + WS_END + 66 * MiB) : (bf16_t*)(ws + X_O), ring, F.wave); } }
            }
            SEAM(base + 3);
        }
        if (EN(8) && IN(base + 4)) REPLOOP(base + 4) { WS_LAUNDER();
            pg8::Gemm g = is_mla ? pg8::Gemm{(const bf16_t*)(ws + X_O), (const bf16_t*)(ws + W_AOUT) + (size_t)l * 1024 * 512, MT, 1024, 512}
                                 : pg8::Gemm{(const bf16_t*)(ws + X_SO), (const bf16_t*)(ws + W_OB) + (size_t)j * 1024 * 1024, MT, 1024, 1024};
            pg8::StaticOrder S; S.init(MT, 1024, F.G, bx);
            if (FP8_FGU2 && l == 2) { pg8::EpiRes<false, true> E{HBc, OUT_HB(cur), OUT_SSQ(cur), (const bf16_t*)(ws + X_HB8), pg8::RowScale{nullptr, 0}, nullptr, 1.0f};
                pg8::gemm_phase<pg8::EpiRes<false, true>, pg8::StaticOrder, true, true>(ring, g, S, E, F.wave); }
            else { pg8::EpiRes<false> E{HBc, OUT_HB(cur), OUT_SSQ(cur), nullptr, pg8::RowScale{nullptr, 0}, nullptr, 1.0f};
                pg8::gemm_phase<pg8::EpiRes<false>, pg8::StaticOrder, true, true>(ring, g, S, E, F.wave); }
            SEAM_L(base + 4);
        }
        if (!is_moe) {
            if (EN(9) && IN(base + 5)) REPLOOP(base + 5) { WS_LAUNDER();
                const bool gu8 = FP8_FGU2 && l == 2;
                pg8::Gemm g{gu8 ? (const bf16_t*)(ws + X_HB8) : HBc, (const bf16_t*)(ws + W_FGU) + (size_t)(l >> 1) * 5632 * 1024, MT, 5632, gu8 ? 512 : 1024};
                pg8::GroupOrder S; S.init_dense(MT, 5632, F.G, bx);
                pg8::EpiSwiglu E{(bf16_t*)(ws + X_HID), pg8::RowScale{SSQc, 1}, 0, FP8_FDN, gu8 ? 1.0f / 32.0f : 1.0f};
                if (gu8) pg8::gemm_phase<pg8::EpiSwiglu, pg8::GroupOrder, GU_ALIGN, true, true>(ring, g, S, E, F.wave);
                else pg8::gemm_phase<pg8::EpiSwiglu, pg8::GroupOrder, GU_ALIGN, true>(ring, g, S, E, F.wave);
                PU_TAIL((MT / 256) * 22);
#if FILL_A + FILL_D > 0
                filler(args, F, l == 0 ? 0 : 3, l == 0 ? 0 : DEF_QC, l == 0 ? DEF_QA : DEF_QD);
#endif
                SEAM_L(base + 5);
            }
            if (EN(10) && IN(base + 6)) REPLOOP(base + 6) { WS_LAUNDER();
                pg8::Gemm g{(const bf16_t*)(ws + X_HID), (const bf16_t*)(ws + W_FDN) + (size_t)(l >> 1) * 1024 * 2816, MT, 1024, FP8_FDN ? 1408 : 2816};
                pg8::StaticOrder S; S.init(MT, 1024, F.G, bx);
                pg8::EpiRes<false, false> E{HBc, OUT_HB(cur), OUT_SSQ(cur), nullptr, pg8::RowScale{nullptr, 0}, nullptr, FP8_FDN ? 1.0f / 64.0f : 1.0f};
                pg8::gemm_phase<pg8::EpiRes<false, false>, pg8::StaticOrder, true, true, FP8_FDN != 0>(ring, g, S, E, F.wave);
                SEAM_L(base + 6);
            }
        } else {
            if (EN(11) && IN(base + 5)) REPLOOP(base + 5) { WS_LAUNDER(); moe_route(args, F, l, cur); SEAM(base + 5); }
            if (EN(12) && IN(base + 6)) REPLOOP(base + 6) { WS_LAUNDER(); moe_scatter(args, F, cur); SEAM(base + 6); }
            if (EN(13) && IN(base + 7)) REPLOOP(base + 7) { WS_LAUNDER();
                pg8::Gemm g{(const bf16_t*)(ws + X_XG), (const bf16_t*)(ws + W_EGU) + (size_t)(l >> 1) * 8 * 5632 * 1024, MAXSLOT, 5632, FP8_EGU ? 512 : 1024};
                pg8::GroupOrder S; S.init((const int*)(ws + WS_PSTART), 5632, F.G, bx, (size_t)5632 * 1024 * 2);
                #ifndef EPI_ABL
#define EPI_ABL 0
#endif
                pg8::EpiSwiglu E{(bf16_t*)(ws + X_HG), FP8_EGU ? pg8::RowScale{nullptr, 0} : pg8::RowScale{(const float*)(ws + WS_SLOTRS), 2}, DUMMY ? EPI_ABL : 0, FP8_EDN, FP8_EGU ? 1.0f / 32.0f : 1.0f};
                pg8::gemm_phase<pg8::EpiSwiglu, pg8::GroupOrder, GU_ALIGN, true, FP8_EGU != 0>(ring, g, S, E, F.wave);
#if FILL_B > 0
                if (l == 1) filler(args, F, 1, DEF_QA, DEF_QB);
#endif
                SEAM(base + 7);
            }
            if (EN(14) && IN(base + 8)) REPLOOP(base + 8) { WS_LAUNDER();
                pg8::Gemm g{(const bf16_t*)(ws + X_HG), (const bf16_t*)(ws + W_EDN) + (size_t)(l >> 1) * 8 * 1024 * 2816, MAXSLOT, 1024, FP8_EDN ? 1408 : 2816};
                pg8::GroupOrder S; S.init((const int*)(ws + WS_PSTART), 1024, F.G, bx, (size_t)1024 * 2816 * 2);
                pg8::EpiScale E{(bf16_t*)(ws + X_YG), 1024, pg8::RowScale{nullptr, 0}, FP8_EDN ? 1.0f / 64.0f : 1.0f};
                pg8::gemm_phase<pg8::EpiScale, pg8::GroupOrder, true, true, FP8_EDN != 0>(ring, g, S, E, F.wave);
                { const int nwg_e = __builtin_amdgcn_readfirstlane(((const int*)(ws + WS_PSTART))[8]) * 4; PU_TAIL(nwg_e); }
#if FILL_C > 0
                if (l == 1) filler(args, F, 2, DEF_QB, DEF_QC);
#endif
                SEAM(base + 8);
            }
            if (EN(15) && IN(base + 9)) REPLOOP(base + 9) { WS_LAUNDER(); moe_combine(args, F, cur, DUMMY); B_WARM_ISSUE((const bf16_t*)(ws + W_PG) + (size_t)l * 1024 * 1024, 1024, FP8_PG ? 512 : 1024); SEAM_L(base + 9); B_WARM_RETIRE(); }
        }
        if (EN(16) && IN(base + 10)) REPLOOP(base + 10) { WS_LAUNDER();
            const bool pg8f = FP8_PG && is_moe;
            pg8::Gemm g{pg8f ? (const bf16_t*)(ws + X_HB8) : HBc, (const bf16_t*)(ws + W_PG) + (size_t)l * 1024 * 1024, MT, 1024, pg8f ? 512 : 1024};
            pg8::StaticOrder S; S.init(MT, 1024, F.G, bx);
            pg8::EpiRes<true> E{HBc, OUT_HB(cur ^ 1), OUT_SSQ(cur ^ 1),
                                (const bf16_t*)(ws + WS_U) + (size_t)l * MT * DMODEL, pg8::RowScale{SSQc, 1}, (l == 3 && !DUMMY) ? args.out : nullptr, pg8f ? 1.0f / 64.0f : 1.0f};
            if (pg8f) pg8::gemm_phase<pg8::EpiRes<true>, pg8::StaticOrder, true, true, true>(ring, g, S, E, F.wave);
            else pg8::gemm_phase<pg8::EpiRes<true>, pg8::StaticOrder, true, true>(ring, g, S, E, F.wave);
            if (l == 3) SEAM(base + 10); else SEAM_L(base + 10);
        }
        if (EN(17) && l == 1 && IN(base + 11)) REPLOOP(base + 11) { WS_LAUNDER();
            pg8::Gemm g{(const bf16_t*)(ws + WS_HB) + (size_t)(cur ^ 1) * MT * DMODEL, (const bf16_t*)(ws + W_KVS), MT, 512, 1024};
            pg8::StaticOrder S; S.init(MT, 512, F.G, bx);
            pg8::EpiKvs E{(bf16_t*)(ws + WS_SKT), (bf16_t*)(ws + WS_SVT), pg8::RowScale{(const float*)(ws + WS_SSQ) + (size_t)(cur ^ 1) * MT * 16, 1}};
            pg8::gemm_phase<pg8::EpiKvs, pg8::StaticOrder, true, true>(ring, g, S, E, F.wave);
            SEAM(base + 11);
        }
    }
#undef IN
#undef SEAM
}
}
#define MULTI_LAUNCH 0
extern "C" void kernel_launch(void* const* d_in, const int* in_sizes, int n_in, void* d_out, int out_size, void* d_ws, size_t ws_size, hipStream_t stream) {
    using namespace fw;
    static int grid = 0;
    if (grid == 0) {
        if (n_in != 26 || out_size != MT * DMODEL || ws_size < WS_NEED) { fprintf(stderr, "kernel_launch: unexpected n_in %d / out %d / ws %zu\n", n_in, out_size, ws_size); grid = -1; return; }
        if (hipFuncSetAttribute((const void*)yoco_fwd, hipFuncAttributeMaxDynamicSharedMemorySize, LDS_BYTES) != hipSuccess) { fprintf(stderr, "kernel_launch: hipFuncSetAttribute failed\n"); grid = -1; return; }
        int dev = 0, cus = 0, per_cu = 0;
        (void)hipGetDevice(&dev); (void)hipDeviceGetAttribute(&cus, hipDeviceAttributeMultiprocessorCount, dev);
        (void)hipOccupancyMaxActiveBlocksPerMultiprocessor(&per_cu, (const void*)yoco_fwd, NTHR, LDS_BYTES);
        (void)hipGetLastError();
        grid = (cus > 0 && per_cu >= 1) ? cus : 256;
        if (grid > 256) grid = 256;
    }
    if (grid < 0) return;
    (void)hipMemsetAsync((unsigned char*)d_ws + WS_CTL, 0, CTL_ZERO_BYTES, stream);
    Args a{};
    for (int i = 0; i < 26; ++i) a.in[i] = (const float*)d_in[i];
    a.out = (float*)d_out; a.ws = (unsigned char*)d_ws;
#if MULTI_LAUNCH
    for (int k = 0; k < PH_TOTAL; ++k) { if (!phase_active(k)) continue; a.ph_lo = k; a.ph_hi = k + 1; hipLaunchKernelGGL(yoco_fwd, dim3(grid), dim3(NTHR), LDS_BYTES, stream, a); }
#else
#ifdef PROBE_MASK
    a.ph_lo = 0; a.ph_hi = PH_TOTAL;
#else
    a.ph_lo = 0; a.ph_hi = PH_TOTAL - 1;
#endif
    hipLaunchKernelGGL(yoco_fwd, dim3(grid), dim3(NTHR), LDS_BYTES, stream, a);
#endif
}
```
